# Optimizing an MI355X kernel written in HIP

```python
import numpy as np
import jax
import jax.numpy as jnp
from jax import lax

D_MODEL = 1024
BATCH = 32
SEQ = 2048
DEPTH = 4

N_MIXERS = 3
N_NSA_LAYERS = (DEPTH + 2) // 3
N_MLSTM_LAYERS = (DEPTH + 1) // 3
N_HGRN_LAYERS = DEPTH // 3

NSA_HEADS = 16
NSA_KV_GROUPS = 4
NSA_HEAD_DIM = D_MODEL // NSA_HEADS
NSA_HPG = NSA_HEADS // NSA_KV_GROUPS
NSA_KV_WIDTH = NSA_KV_GROUPS * NSA_HEAD_DIM
NSA_IN = D_MODEL + 6 * NSA_KV_WIDTH + 3 * NSA_HEADS
CMP_BLOCK = 32
CMP_STRIDE = 16
CMP_HIDDEN = 4 * NSA_HEAD_DIM
SEL_BLOCK = 64
SEL_TOPK = 8
WINDOW = 512
NSA_QCHUNK = 32

MLSTM_HEADS = 4
MLSTM_QK_DIM = D_MODEL // (2 * MLSTM_HEADS)
MLSTM_V_DIM = D_MODEL // MLSTM_HEADS
MLSTM_QK_WIDTH = 2 * MLSTM_HEADS * MLSTM_QK_DIM
MLSTM_IN = MLSTM_QK_WIDTH + MLSTM_HEADS * MLSTM_V_DIM + D_MODEL + 2 * MLSTM_HEADS
MLSTM_CONV = 4
MLSTM_CHUNK = 64

HGRN_HEADS = 8
HGRN_DIM = D_MODEL // HGRN_HEADS
HGRN_CHUNK = 32

N_EXPERTS = 32
TOP_K = 4
D_FF = D_MODEL
SWIGLU_LIMIT = 7.0
SWIGLU_ALPHA = 1.702
MOE_BLOCK = 256

LN_EPS = 1e-5
RMS_EPS = 1e-6
DEEPNORM_ALPHA = (2 * DEPTH) ** 0.25
DEEPNORM_BETA = (8 * DEPTH) ** -0.25
NEG = -1e30

kernel_name = 'hybrid_nsa_mlstm_hgrn2_moe'


def layer_norm(x, g, b):
    xf = x.astype(jnp.float32)
    mu = jnp.mean(xf, axis=-1, keepdims=True)
    var = jnp.mean(jnp.square(xf - mu), axis=-1, keepdims=True)
    return ((xf - mu) * lax.rsqrt(var + LN_EPS)).astype(x.dtype) * g + b


def head_rms_norm(h, g):
    hf = h.astype(jnp.float32)
    hf = hf * lax.rsqrt(jnp.mean(jnp.square(hf), axis=-1, keepdims=True) + RMS_EPS)
    return hf.reshape(*h.shape[:-2], -1).astype(g.dtype) * g


def masked_softmax(s, mask):
    p = jax.nn.softmax(jnp.where(mask, s.astype(jnp.float32), NEG), axis=-1)
    return p * mask


def causal_depthwise_conv(x, w, b):
    width, ch = w.shape
    y = lax.conv_general_dilated(x, w[:, None, :], window_strides=(1,), padding=[(width - 1, 0)],
                                 dimension_numbers=('NWC', 'WIO', 'NWC'), feature_group_count=ch)
    return y + b


def nsa_mixer(x, w_in, cmp_pos, cmp_w1, cmp_b1, cmp_w2, cmp_b2, gate_b, w_out):
    B, T, _ = x.shape
    G, HPG, dh, QC = NSA_KV_GROUPS, NSA_HPG, NSA_HEAD_DIM, NSA_QCHUNK
    proj = x @ w_in
    splits = [D_MODEL + n * NSA_KV_WIDTH for n in range(7)]
    q, kc, vc, ks, vs, kw, vw, gates = jnp.split(proj, splits, axis=-1)
    q = q.reshape(B, T, G, HPG, dh).transpose(0, 2, 3, 1, 4) * dh ** -0.5

    def groups(a):
        return a.reshape(B, T, G, dh).transpose(0, 2, 1, 3)

    kc, vc, ks, vs, kw, vw = (groups(a) for a in (kc, vc, ks, vs, kw, vw))
    gates = jax.nn.sigmoid(gates + gate_b).reshape(B, T, G, HPG, 3).transpose(0, 2, 3, 1, 4)

    n_cmp = (T - CMP_BLOCK) // CMP_STRIDE + 1
    cmp_start = np.arange(n_cmp) * CMP_STRIDE
    cmp_idx = cmp_start[:, None] + np.arange(CMP_BLOCK)[None, :]

    def compress(a, j):
        blocks = (a[:, :, cmp_idx] + cmp_pos[j]).reshape(B, G, n_cmp, CMP_BLOCK * dh)
        return jax.nn.gelu(blocks @ cmp_w1[j] + cmp_b1[j]) @ cmp_w2[j] + cmp_b2[j]

    k_cmp, v_cmp = compress(kc, 0), compress(vc, 1)
    cmp_end = jnp.asarray(cmp_start + CMP_BLOCK - 1, jnp.int32)

    n_sel = T // SEL_BLOCK
    topk = min(SEL_TOPK, n_sel)
    sel_start = np.arange(n_sel) * SEL_BLOCK
    overlap = (np.minimum(cmp_start[:, None] + CMP_BLOCK, sel_start[None, :] + SEL_BLOCK)
               - np.maximum(cmp_start[:, None], sel_start[None, :]))
    cmp_to_sel = jnp.asarray((np.clip(overlap, 0, None) / CMP_STRIDE).astype(np.float32))
    ks_blk = ks.reshape(B, G, n_sel, SEL_BLOCK, dh)
    vs_blk = vs.reshape(B, G, n_sel, SEL_BLOCK, dh)

    kw_pad = jnp.pad(kw, ((0, 0), (0, 0), (WINDOW, 0), (0, 0)))
    vw_pad = jnp.pad(vw, ((0, 0), (0, 0), (WINDOW, 0), (0, 0)))

    b_ix = jnp.arange(B)[:, None, None, None]
    g_ix = jnp.arange(G)[None, :, None, None]
    blk = jnp.arange(n_sel)
    win_off = jnp.arange(WINDOW + QC)

    def chunk(c):
        t0 = c * QC
        t = t0 + jnp.arange(QC)
        qc = lax.dynamic_slice_in_dim(q, t0, QC, axis=3)
        gc = lax.dynamic_slice_in_dim(gates, t0, QC, axis=3)
        p_cmp = masked_softmax(jnp.einsum('bghqd,bgcd->bghqc', qc, k_cmp), cmp_end[None, :] <= t[:, None])
        o_cmp = jnp.einsum('bghqc,bgcd->bghqd', p_cmp.astype(v_cmp.dtype), v_cmp)
        imp = jnp.einsum('bghqc,cs->bgqs', p_cmp, cmp_to_sel)
        cur = (t // SEL_BLOCK)[:, None]
        forced = (blk == 0) | (blk == cur) | (blk == cur - 1)
        score = jnp.where(forced, -NEG, jnp.where(blk <= cur, imp, NEG))
        top_score, top_idx = lax.top_k(score, topk)
        k_sel = ks_blk[b_ix, g_ix, top_idx]
        v_sel = vs_blk[b_ix, g_ix, top_idx]
        key_pos = top_idx[..., None] * SEL_BLOCK + jnp.arange(SEL_BLOCK)
        m_sel = (key_pos <= t[:, None, None]) & (top_score > 0.5 * NEG)[..., None]
        s_sel = jnp.einsum('bghqd,bgqnld->bghqnl', qc, k_sel).reshape(B, G, HPG, QC, topk * SEL_BLOCK)
        p_sel = masked_softmax(s_sel, m_sel.reshape(B, G, 1, QC, topk * SEL_BLOCK))
        o_sel = jnp.einsum('bghqnl,bgqnld->bghqd',
                           p_sel.reshape(B, G, HPG, QC, topk, SEL_BLOCK).astype(v_sel.dtype), v_sel)
        k_win = lax.dynamic_slice_in_dim(kw_pad, t0, WINDOW + QC, axis=2)
        v_win = lax.dynamic_slice_in_dim(vw_pad, t0, WINDOW + QC, axis=2)
        win_pos = t0 - WINDOW + win_off
        lag = t[:, None] - win_pos[None, :]
        m_win = (lag >= 0) & (lag < WINDOW) & (win_pos >= 0)[None, :]
        p_win = masked_softmax(jnp.einsum('bghqd,bgkd->bghqk', qc, k_win), m_win)
        o_win = jnp.einsum('bghqk,bgkd->bghqd', p_win.astype(v_win.dtype), v_win)
        return gc[..., 0:1] * o_cmp + gc[..., 1:2] * o_sel + gc[..., 2:3] * o_win

    o = lax.map(chunk, jnp.arange(T // QC))
    o = o.transpose(1, 0, 4, 2, 3, 5).reshape(B, T, D_MODEL)
    return o @ w_out


def mlstm_mixer(x, w_in, conv_w, conv_b, gate_b, norm_g, w_out):
    B, T, _ = x.shape
    H, dk, dv, L = MLSTM_HEADS, MLSTM_QK_DIM, MLSTM_V_DIM, MLSTM_CHUNK
    nc = T // L
    f32 = jnp.float32
    qk, v, o_gate, gif = jnp.split(
        x @ w_in, [MLSTM_QK_WIDTH, MLSTM_QK_WIDTH + H * dv, MLSTM_QK_WIDTH + H * dv + D_MODEL], axis=-1)
    q, k = jnp.split(jax.nn.silu(causal_depthwise_conv(qk, conv_w, conv_b)), 2, axis=-1)

    def heads(a, d):
        return a.reshape(B, T, H, d).transpose(0, 2, 1, 3).astype(f32)

    q, k, v = heads(q, dk), heads(k, dk) * dk ** -0.5, heads(v, dv)
    gif = (gif + gate_b).astype(f32).transpose(0, 2, 1)
    log_i, log_f = gif[:, :H], jax.nn.log_sigmoid(gif[:, H:])

    def chunks(a):
        return jnp.moveaxis(a.reshape(B, H, nc, L, *a.shape[3:]), 2, 0)

    causal = jnp.tril(jnp.ones((L, L), dtype=bool))

    def step(carry, inp):
        C, n, m = carry
        qc, kc, vc, li, lf = inp
        b = jnp.cumsum(lf, axis=-1)
        d_mat = jnp.where(causal, b[..., :, None] - b[..., None, :] + li[..., None, :], NEG)
        m_t = jnp.maximum(b + m[..., None], jnp.max(d_mat, axis=-1))
        w_inter = jnp.exp(b + m[..., None] - m_t)
        s = jnp.einsum('bhtd,bhsd->bhts', qc, kc) * jnp.exp(d_mat - m_t[..., None])
        num = jnp.einsum('bhts,bhsv->bhtv', s, vc) + w_inter[..., None] * jnp.einsum('bhtk,bhvk->bhtv', qc, C)
        den = jnp.sum(s, axis=-1) + w_inter * jnp.einsum('bhtk,bhk->bht', qc, n)
        h = num / jnp.maximum(jnp.abs(den), jnp.exp(-m_t))[..., None]
        b_end = b[..., -1]
        decay = b_end[..., None] - b + li
        m_new = jnp.maximum(b_end + m, jnp.max(decay, axis=-1))
        w_k = jnp.exp(decay - m_new[..., None])
        carry_scale = jnp.exp(b_end + m - m_new)
        C_new = carry_scale[..., None, None] * C + jnp.einsum('bhsv,bhsk->bhvk', vc * w_k[..., None], kc)
        n_new = carry_scale[..., None] * n + jnp.einsum('bhs,bhsk->bhk', w_k, kc)
        return (C_new, n_new, m_new), h

    init = (jnp.zeros((B, H, dv, dk), f32), jnp.zeros((B, H, dk), f32), jnp.zeros((B, H), f32))
    _, h = lax.scan(step, init, (chunks(q), chunks(k), chunks(v), chunks(log_i), chunks(log_f)))
    h = jnp.moveaxis(h, 0, 2).reshape(B, H, T, dv).transpose(0, 2, 1, 3)
    h = head_rms_norm(h, norm_g) * jax.nn.sigmoid(o_gate)
    return h @ w_out


def hgrn2_mixer(x, layer_idx, w_in, lower_table, norm_g, w_out):
    B, T, _ = x.shape
    H, d, L = HGRN_HEADS, HGRN_DIM, HGRN_CHUNK
    nc = T // L
    f32 = jnp.float32
    q, f, i, g = jnp.split(x @ w_in, 4, axis=-1)
    lb_soft = jax.nn.softmax(lower_table.astype(f32), axis=0)
    lb = jnp.cumsum(lb_soft, axis=0)[layer_idx] - lb_soft[0]
    f = lb + (1.0 - lb) * jax.nn.sigmoid(f.astype(f32))

    def chunked(a):
        return a.astype(f32).reshape(B, nc, L, H, d).transpose(1, 0, 3, 2, 4)

    xs = (chunked(jax.nn.silu(q)), chunked(1.0 - f), chunked(i), chunked(jnp.log(f)))
    causal = jnp.tril(jnp.ones((L, L), dtype=bool))

    def step(S, inp):
        qc, kc, vc, lf = inp
        G = jnp.cumsum(lf, axis=2)
        q_dec = qc * jnp.exp(G)
        a_mat = jnp.where(causal, jnp.einsum('bhtk,bhsk->bhts', q_dec, kc * jnp.exp(-G)), 0.0)
        o = jnp.einsum('bhts,bhsv->bhtv', a_mat, vc) + jnp.einsum('bhtk,bhkv->bhtv', q_dec, S)
        G_end = G[:, :, -1]
        S_new = jnp.exp(G_end)[..., None] * S + jnp.einsum('bhsk,bhsv->bhkv', kc * jnp.exp(G_end[:, :, None] - G), vc)
        return S_new, o

    _, o = lax.scan(step, jnp.zeros((B, H, d, d), f32), xs)
    o = o.transpose(1, 0, 3, 2, 4).reshape(B, T, H, d)
    o = head_rms_norm(o, norm_g) * jax.nn.sigmoid(g)
    return o @ w_out


def moe_ffn(x, router_w, router_b, w_gu, b_gu, w_down, b_down):
    B, T, D = x.shape
    N = B * T
    A = N * TOP_K
    xf = x.reshape(N, D)
    logits = xf.astype(jnp.float32) @ router_w.astype(jnp.float32) + router_b.astype(jnp.float32)
    top_val, top_idx = lax.top_k(logits, TOP_K)
    gate = jax.nn.softmax(top_val, axis=-1)
    e_flat = top_idx.reshape(A)
    order = jnp.argsort(e_flat)
    e_sorted = e_flat[order]
    counts = jnp.bincount(e_flat, length=N_EXPERTS)
    padded = (counts + MOE_BLOCK - 1) // MOE_BLOCK * MOE_BLOCK
    start = jnp.cumsum(counts) - counts
    padded_end = jnp.cumsum(padded)
    padded_start = padded_end - padded
    dest = padded_start[e_sorted] + jnp.arange(A) - start[e_sorted]
    n_blocks = (A + N_EXPERTS * (MOE_BLOCK - 1) + MOE_BLOCK - 1) // MOE_BLOCK
    rows = n_blocks * MOE_BLOCK
    row_tok = jnp.full((rows,), N, jnp.int32).at[dest].set((order // TOP_K).astype(jnp.int32))
    row_gate = jnp.zeros((rows,), jnp.float32).at[dest].set(gate.reshape(A)[order])
    block_expert = jnp.minimum(
        jnp.searchsorted(padded_end, jnp.arange(n_blocks) * MOE_BLOCK, side='right'), N_EXPERTS - 1)
    x_pad = jnp.concatenate([xf, jnp.zeros((1, D), xf.dtype)], axis=0)

    def expert_block(args):
        e, tok, gw = args
        xb = x_pad[tok]
        h_gate, h_up = jnp.split(xb @ w_gu[e] + b_gu[e], 2, axis=-1)
        h_gate = jnp.minimum(h_gate, SWIGLU_LIMIT)
        h_up = jnp.clip(h_up, -SWIGLU_LIMIT, SWIGLU_LIMIT)
        h = (h_up + 1.0) * h_gate * jax.nn.sigmoid(SWIGLU_ALPHA * h_gate)
        return (h @ w_down[e] + b_down[e]) * gw[:, None].astype(xb.dtype)

    y = lax.map(expert_block, (block_expert, row_tok.reshape(n_blocks, MOE_BLOCK),
                               row_gate.reshape(n_blocks, MOE_BLOCK)))
    out = jax.ops.segment_sum(y.reshape(rows, D), row_tok, num_segments=N + 1)
    return out[:N].reshape(B, T, D)


def setup_inputs(seed: int = 0) -> dict:
    key = jax.random.key(seed)
    keys = iter(jax.random.split(key, 32))

    def rnd(shape, scale):
        return jax.random.normal(next(keys), shape, jnp.float32) * scale

    D, E, F = D_MODEL, N_EXPERTS, D_FF
    dh, H = NSA_HEAD_DIM, MLSTM_HEADS
    inv = D ** -0.5
    return {
        'x': rnd((BATCH, SEQ, D), 1.0),
        'ln_g': 1.0 + rnd((DEPTH, 2, D), 0.02),
        'ln_b': rnd((DEPTH, 2, D), 0.02),
        'nsa_w_in': rnd((N_NSA_LAYERS, D, NSA_IN), inv),
        'nsa_cmp_pos': rnd((N_NSA_LAYERS, 2, CMP_BLOCK, dh), 0.1),
        'nsa_cmp_w1': rnd((N_NSA_LAYERS, 2, CMP_BLOCK * dh, CMP_HIDDEN), (CMP_BLOCK * dh) ** -0.5),
        'nsa_cmp_b1': rnd((N_NSA_LAYERS, 2, CMP_HIDDEN), 0.02),
        'nsa_cmp_w2': rnd((N_NSA_LAYERS, 2, CMP_HIDDEN, dh), CMP_HIDDEN ** -0.5),
        'nsa_cmp_b2': rnd((N_NSA_LAYERS, 2, dh), 0.02),
        'nsa_gate_b': rnd((N_NSA_LAYERS, 3 * NSA_HEADS), 0.02),
        'nsa_w_out': rnd((N_NSA_LAYERS, D, D), inv * DEEPNORM_BETA),
        'ml_w_in': rnd((N_MLSTM_LAYERS, D, MLSTM_IN), inv),
        'ml_conv_w': rnd((N_MLSTM_LAYERS, MLSTM_CONV, MLSTM_QK_WIDTH), MLSTM_CONV ** -0.5),
        'ml_conv_b': rnd((N_MLSTM_LAYERS, MLSTM_QK_WIDTH), 0.02),
        'ml_gate_b': jnp.concatenate([rnd((N_MLSTM_LAYERS, H), 0.1),
                                      3.0 + rnd((N_MLSTM_LAYERS, H), 0.1)], axis=-1),
        'ml_norm_g': 1.0 + rnd((N_MLSTM_LAYERS, H * MLSTM_V_DIM), 0.02),
        'ml_w_out': rnd((N_MLSTM_LAYERS, D, D), inv * DEEPNORM_BETA),
        'hg_w_in': rnd((N_HGRN_LAYERS, D, 4 * D), inv),
        'hg_lower': rnd((DEPTH, D), 0.1),
        'hg_norm_g': 1.0 + rnd((N_HGRN_LAYERS, D), 0.02),
        'hg_w_out': rnd((N_HGRN_LAYERS, D, D), inv * DEEPNORM_BETA),
        'router_w': rnd((DEPTH, D, E), inv),
        'router_b': rnd((DEPTH, E), 0.01),
        'moe_w_gu': rnd((DEPTH, E, D, 2 * F), inv),
        'moe_b_gu': rnd((DEPTH, E, 2 * F), 0.02),
        'moe_w_down': rnd((DEPTH, E, F, D), F ** -0.5 * DEEPNORM_BETA),
        'moe_b_down': rnd((DEPTH, E, D), 0.02),
    }


def reference(x, ln_g, ln_b, nsa_w_in, nsa_cmp_pos, nsa_cmp_w1, nsa_cmp_b1, nsa_cmp_w2, nsa_cmp_b2,
              nsa_gate_b, nsa_w_out, ml_w_in, ml_conv_w, ml_conv_b, ml_gate_b, ml_norm_g, ml_w_out,
              hg_w_in, hg_lower, hg_norm_g, hg_w_out, router_w, router_b, moe_w_gu, moe_b_gu,
              moe_w_down, moe_b_down):
    for layer in range(DEPTH):
        kind, slot = layer % N_MIXERS, layer // N_MIXERS
        if kind == 0:
            h = nsa_mixer(x, nsa_w_in[slot], nsa_cmp_pos[slot], nsa_cmp_w1[slot], nsa_cmp_b1[slot],
                          nsa_cmp_w2[slot], nsa_cmp_b2[slot], nsa_gate_b[slot], nsa_w_out[slot])
        elif kind == 1:
            h = mlstm_mixer(x, ml_w_in[slot], ml_conv_w[slot], ml_conv_b[slot], ml_gate_b[slot],
                            ml_norm_g[slot], ml_w_out[slot])
        else:
            h = hgrn2_mixer(x, layer, hg_w_in[slot], hg_lower, hg_norm_g[slot], hg_w_out[slot])
        x = layer_norm(DEEPNORM_ALPHA * x + h, ln_g[layer, 0], ln_b[layer, 0])
        h = moe_ffn(x, router_w[layer], router_b[layer], moe_w_gu[layer], moe_b_gu[layer],
                    moe_w_down[layer], moe_b_down[layer])
        x = layer_norm(DEEPNORM_ALPHA * x + h, ln_g[layer, 1], ln_b[layer, 1])
    return x
```

```cpp
#include <hip/hip_runtime.h>
#include <cstdio>
#include <cstdint>

#define LAS __attribute__((address_space(3)))
#define GAS __attribute__((address_space(1)))
typedef unsigned short bf16_t;
typedef short bf16x8 __attribute__((ext_vector_type(8)));
typedef float f32x4 __attribute__((ext_vector_type(4)));
typedef float f32x2 __attribute__((ext_vector_type(2)));
typedef unsigned u32x4 __attribute__((ext_vector_type(4)));
typedef unsigned u32x2 __attribute__((ext_vector_type(2)));
#define RLX_AGENT __ATOMIC_RELAXED, __HIP_MEMORY_SCOPE_AGENT
#define LDS_WAIT() asm volatile("s_waitcnt lgkmcnt(0)" ::: "memory")
#define VM_WAIT() asm volatile("s_waitcnt vmcnt(0)" ::: "memory")

#ifndef MK_PER_PHASE
#define MK_PER_PHASE 0
#endif

constexpr int D = 1024, BATCH = 32, T = 2048, NTOK = BATCH * T, DEPTH = 4;
constexpr int NSA_IN = 2608, NSA_LD = 2816, ML_IN = 3080, ML_LD = 3328, HG_LD = 4096;
constexpr int NEXP = 32, TOPK = 4, DFF = 1024;
constexpr int MOE_ROWS = 270336;
constexpr float LN_EPS = 1e-5f, RMS_EPS = 1e-6f;
constexpr float DN_ALPHA = 1.681792830507429f;
constexpr int NCMP = 127;

constexpr size_t MiB = 1u << 20;
constexpr size_t OFF_CTL = 0, CTL_ZERO_BYTES = 1 * MiB;
constexpr size_t OFF_TAB = 1 * MiB;
constexpr size_t OFF_TOKE = 2 * MiB;
constexpr size_t OFF_TOKG = 3 * MiB;
constexpr size_t OFF_TOKP = 4 * MiB;
constexpr size_t OFF_ROWT = 5 * MiB;
constexpr size_t OFF_ROWG = 7 * MiB;
constexpr size_t OFF_KC = 9 * MiB;
constexpr size_t OFF_HC = 17 * MiB;
constexpr size_t OFF_W_NSAIN = 33 * MiB;
constexpr size_t OFF_W_NSAOUT = 44 * MiB;
constexpr size_t OFF_W_MLIN = 48 * MiB;
constexpr size_t OFF_W_MLOUT = 55 * MiB;
constexpr size_t OFF_W_HGIN = 57 * MiB;
constexpr size_t OFF_W_HGOUT = 65 * MiB;
constexpr size_t OFF_W_CMP1 = 67 * MiB;
constexpr size_t OFF_W_GU = 72 * MiB;
constexpr size_t OFF_W_DN = 584 * MiB;
constexpr size_t OFF_XA = 840 * MiB;
constexpr size_t OFF_XN = 1096 * MiB;
constexpr size_t OFF_PROJ = 1224 * MiB;
constexpr size_t OFF_ATT = 1740 * MiB;
constexpr size_t OFF_HM = 1868 * MiB;
constexpr size_t OFF_H = 1996 * MiB;
constexpr size_t OFF_Y = 2526 * MiB;
constexpr size_t WS_END = 3056 * MiB;
constexpr int TAB_CMPB = 0;
constexpr int TAB_LB = 4096;
constexpr int CW_BAR = 4096;
constexpr int CW_CNT = 16384;
constexpr int CW_CUR = 16384 + 1024;

constexpr int RING_BYTES = 131072;
constexpr int LDSCTL_OFF = 155648;
constexpr int LDS_BYTES = 156672;

__device__ __forceinline__ float bf2f(bf16_t b) { return __uint_as_float(((unsigned)b) << 16); }
__device__ __forceinline__ unsigned f2bf(float f) { unsigned u = __float_as_uint(f); return (u + 0x7fffu + ((u >> 16) & 1u)) >> 16; }
__device__ __forceinline__ unsigned pk2(float lo, float hi) { return f2bf(lo) | (f2bf(hi) << 16); }
__device__ __forceinline__ float wave_sum(float v) {
#pragma unroll
    for (int o = 1; o < 64; o <<= 1) v += __shfl_xor(v, o);
    return v;
}
__device__ __forceinline__ float wave_max(float v) {
#pragma unroll
    for (int o = 1; o < 64; o <<= 1) v = fmaxf(v, __shfl_xor(v, o));
    return v;
}
__device__ __forceinline__ float sigmoidf_(float x) { return 1.0f / (1.0f + __expf(-x)); }

#define XB_TMO      128
#define XB_XCNT(j)  (256  + 64 * (j))
#define XB_XSUB(j)  (1280 + 64 * (j))
#define XB_XGEN(j)  (2304 + 64 * (j))
#define XB_TOP      3328
#define XB_TOPGEN   3392
#define XCD_BAR_WORDS 3456
#define XB_SPIN_CAP (1u << 20)

__device__ __forceinline__ unsigned xb_ld(unsigned* p)              { return __hip_atomic_load(p, __ATOMIC_RELAXED, __HIP_MEMORY_SCOPE_AGENT); }
__device__ __forceinline__ unsigned xb_add(unsigned* p, unsigned v) { return __hip_atomic_fetch_add(p, v, __ATOMIC_RELAXED, __HIP_MEMORY_SCOPE_AGENT); }
__device__ __forceinline__ unsigned xb_xcc_id() { return (unsigned)__builtin_amdgcn_s_getreg((3 << 11) | 20) & 0xFu; }
#define XB_SPIN(cond, bar) do { unsigned _sp = 0; while (cond) { __builtin_amdgcn_s_sleep(1); \
    if ((++_sp & 255u) == 0u) { if (xb_ld(&(bar)[XB_TMO])) break; if (_sp > XB_SPIN_CAP) { atomicAdd(&(bar)[XB_TMO], 1u); break; } } } } while (0)

struct XcdBarrier { unsigned* bar; unsigned x; volatile LAS unsigned* st; };

__device__ __forceinline__ XcdBarrier xcd_barrier_post(unsigned* bar, volatile LAS unsigned* st) {
    XcdBarrier b; b.bar = bar; b.x = xb_xcc_id(); b.st = st;
    if (threadIdx.x == 0) (void)xb_add(&bar[XB_XCNT(b.x)], 1u);
    return b;
}
__device__ __forceinline__ void xcd_barrier_complete(unsigned* bar, unsigned x, unsigned& nloc, unsigned& nx) {
    const unsigned G = gridDim.x * gridDim.y * gridDim.z;
    unsigned sum, cnt, mine, sp = 0u;
    for (;;) {
        sum = 0u; cnt = 0u; mine = 0u;
#pragma unroll
        for (unsigned j = 0; j < 16; ++j) { const unsigned c = xb_ld(&bar[XB_XCNT(j)]); sum += c; cnt += (c > 0u) ? 1u : 0u; mine = (j == x) ? c : mine; }
        if (sum == G) break;
        __builtin_amdgcn_s_sleep(1);
        if ((++sp & 255u) == 0u) { if (xb_ld(&bar[XB_TMO])) break; if (sp > XB_SPIN_CAP) { atomicAdd(&bar[XB_TMO], 1u); break; } }
    }
    nloc = mine > 0u ? mine : 1u; nx = cnt > 0u ? cnt : 1u;
}
__device__ __forceinline__ void xcd_barrier(const XcdBarrier& b) {
    asm volatile("s_waitcnt vmcnt(0)" ::: "memory");
    __syncthreads();
    if (threadIdx.x == 0) {
        unsigned* bar = b.bar;
        __builtin_amdgcn_s_waitcnt(0);
        unsigned nloc = b.st[0], nx = b.st[1];
        if (nloc == 0u) { xcd_barrier_complete(bar, b.x, nloc, nx); b.st[0] = nloc; b.st[1] = nx; }
        const unsigned old = xb_add(&bar[XB_XSUB(b.x)], 1u);
        const unsigned gen = old / nloc;
        if (old + 1u == (gen + 1u) * nloc) {
            __builtin_amdgcn_fence(__ATOMIC_RELEASE, "agent");
            asm volatile("s_waitcnt vmcnt(0)" ::: "memory");
            const unsigned og = xb_add(&bar[XB_TOP], 1u);
            const unsigned tg = og / nx;
            if (og + 1u == (tg + 1u) * nx) xb_add(&bar[XB_TOPGEN], 1u);
            else XB_SPIN(xb_ld(&bar[XB_TOPGEN]) == tg, bar);
            __builtin_amdgcn_fence(__ATOMIC_ACQUIRE, "agent");
            xb_add(&bar[XB_XGEN(b.x)], 1u);
            asm volatile("s_waitcnt vmcnt(0)" ::: "memory");
        } else {
            XB_SPIN(xb_ld(&bar[XB_XGEN(b.x)]) == gen, bar);
            __builtin_amdgcn_fence(__ATOMIC_ACQUIRE, "agent");
            asm volatile("s_waitcnt vmcnt(0)" ::: "memory");
        }
    }
    __syncthreads();
}

namespace pg8 {
constexpr int BM = 256, BK = 64, HALF = 128, HTB = HALF * BK * 2, STAGE_BYTES = 8 * HTB, NXCD = 8, WGM = 8;
__host__ __device__ __forceinline__ int lds_byte(int r, int c) { const int st = (r >> 4) * 2 + (c >> 5), rr = r & 15, cc = c & 31, ob = rr * 64 + cc * 2; return st * 1024 + (ob ^ (((ob >> 9) & 1) << 5)); }
__host__ __device__ __forceinline__ void stage_rc(int b, int& R, int& C) { const int st = b / 1024, sb = b % 1024, swz = sb ^ (((sb >> 9) & 1) << 5); R = (st >> 1) * 16 + swz / 64; C = (st & 1) * 32 + (swz % 64) / 2; }
__host__ __device__ __forceinline__ int perm32(int rho) { const int n = rho >> 4, i = rho & 15; return 8 * (i >> 2) + 4 * n + (i & 3); }

struct Unit { int pm, pn, e; };

struct StaticOrder {
    int nM, nN, nwg, G, c;
    __device__ __forceinline__ void init(int nM_, int nN_, int G_, int c_) { nM = nM_; nN = nN_; nwg = nM * nN; G = G_; c = c_; }
    __device__ __forceinline__ bool next(int i, Unit& u) const {
        const long L = (long)i * G + c; if (L >= nwg) return false;
        int wgid = (int)L; { const int q = nwg / NXCD, r = nwg % NXCD, xcd = wgid % NXCD, off = wgid / NXCD; wgid = (xcd < r ? xcd * (q + 1) : r * (q + 1) + (xcd - r) * q) + off; }
        const int nig = WGM * nN, gid = wgid / nig, fm = gid * WGM, gsz = (nM - fm) < WGM ? (nM - fm) : WGM;
        u.pm = fm + ((wgid % nig) % gsz); u.pn = (wgid % nig) / gsz; u.e = 0; return true;
    }
};
struct MoeOrder : StaticOrder {
    const LAS int* pend;
    __device__ __forceinline__ bool next(int i, Unit& u) const {
        if (!StaticOrder::next(i, u)) return false;
        int e = 0;
#pragma unroll 8
        for (int j = 0; j < 31; ++j) e += (pend[j] <= u.pm) ? 1 : 0;
        u.e = __builtin_amdgcn_readfirstlane(e); return true;
    }
};
struct CmpOrder {
    int G, c;
    __device__ __forceinline__ bool next(int i, Unit& u) const { const int L = i * G + c; if (L >= 128) return false; u.e = L >> 6; u.pm = L & 63; u.pn = 0; return true; }
};

__device__ __forceinline__ unsigned cvt_pk_bf16(float lo, float hi) { unsigned r; asm volatile("v_cvt_pk_bf16_f32 %0, %1, %2" : "=v"(r) : "v"(lo), "v"(hi)); return r; }

struct APlain {
    static constexpr bool GATHER = false;
    const bf16_t* A; int lda;
    __device__ __forceinline__ int kstep() const { return BK * 2; }
    __device__ __forceinline__ const char* base(const Unit& u) const { return (const char*)A + (size_t)u.pm * BM * lda * 2; }
    __device__ __forceinline__ void offs(const Unit&, const int (&R)[2], const int (&C)[2], unsigned (&vo)[2][2]) const {
#pragma unroll
        for (int h = 0; h < 2; ++h)
#pragma unroll
            for (int i = 0; i < 2; ++i) vo[h][i] = (unsigned)((h * HALF + R[i]) * lda + C[i]) * 2u;
    }
};
struct AGather {
    static constexpr bool GATHER = true;
    const bf16_t* A; int lda; const int* idx;
    __device__ __forceinline__ int kstep() const { return BK * 2; }
    __device__ __forceinline__ const char* base(const Unit&) const { return (const char*)A; }
    __device__ __forceinline__ void offs(const Unit& u, const int (&R)[2], const int (&C)[2], unsigned (&vo)[2][2]) const {
#pragma unroll
        for (int h = 0; h < 2; ++h)
#pragma unroll
            for (int i = 0; i < 2; ++i) { const int row = idx[u.pm * BM + h * HALF + R[i]]; vo[h][i] = (unsigned)(row * lda + C[i]) * 2u; }
    }
};
struct ACmp {
    static constexpr bool GATHER = false;
    const bf16_t* P; int ld; int col0;
    __device__ __forceinline__ int kstep() const { return ld * 2; }
    __device__ __forceinline__ const char* base(const Unit& u) const { const int b = u.pm >> 1, g0 = (u.pm & 1) * 2; return (const char*)P + ((size_t)b * T * ld + col0 + u.e * 256 + g0 * 64) * 2; }
    __device__ __forceinline__ void offs(const Unit&, const int (&R)[2], const int (&C)[2], unsigned (&vo)[2][2]) const {
#pragma unroll
        for (int h = 0; h < 2; ++h)
#pragma unroll
            for (int i = 0; i < 2; ++i) vo[h][i] = (unsigned)(16 * R[i] * ld + h * 64 + C[i]) * 2u;
    }
};
struct BPlain { const bf16_t* Bt; int K; __device__ __forceinline__ const char* base(const Unit& u) const { return (const char*)Bt + (size_t)u.pn * BM * K * 2; } };
struct BGroup { const bf16_t* Bt; int K; size_t gstride;   __device__ __forceinline__ const char* base(const Unit& u) const { return (const char*)Bt + ((size_t)u.e * gstride + (size_t)u.pn * BM * K) * 2; } };

template <class Epi, class Sched, class ASrc, class BSrc, bool ALIGN_EPI = true, bool SP2 = true>
__device__ __forceinline__ void gemm_phase(LAS unsigned char* lds, const int K, const ASrc& AS, const BSrc& BS, const Sched& S, const Epi& E) {
    int tid = threadIdx.x; asm volatile("; phase-local tid" : "+v"(tid));
    const int wid = __builtin_amdgcn_readfirstlane(tid >> 6), lane = tid & 63, wr = wid >> 2, wc = wid & 3, fr = lane & 15, fq = lane >> 4;
    const int nt = K / BK;
    int Rs[2], Cs[2]; unsigned voffB[2];
#pragma unroll
    for (int i = 0; i < 2; ++i) { int R, C; stage_rc(tid * 16 + i * 8192, R, C); Rs[i] = R; Cs[i] = C; const int Rb = Epi::PERM ? ((R & ~31) + perm32(R & 31)) : R; voffB[i] = (unsigned)(Rb * K + C) * 2u; }
    const size_t kstepB = (size_t)(BK * 2), hstepB = (size_t)HALF * K * 2;
    const size_t kstepA = (size_t)AS.kstep();
    const unsigned ldsw = (unsigned)wid * 1024u;
    const int aoff = lds_byte(wr * 64 + fr, fq * 8), boff = lds_byte(wc * 32 + fr, fq * 8);
#define PG8_SA(b, h) (((b) * 2 + (h)) * HTB)
#define PG8_SB(b, h) ((4 + (b) * 2 + (h)) * HTB)
#define PG8_STAGEB(bufoff, gbase) do { _Pragma("unroll") for (int _i = 0; _i < 2; ++_i) \
        __builtin_amdgcn_global_load_lds((const unsigned*)((const char*)(gbase) + voffB[_i]), (LAS unsigned*)(lds + (bufoff) + ldsw + _i * 8192), 16, 0, 0); } while (0)
#define PG8_STAGEA(bufoff, gbase, o0, o1) do { \
        __builtin_amdgcn_global_load_lds((const unsigned*)((const char*)(gbase) + (o0)), (LAS unsigned*)(lds + (bufoff) + ldsw), 16, 0, 0); \
        __builtin_amdgcn_global_load_lds((const unsigned*)((const char*)(gbase) + (o1)), (LAS unsigned*)(lds + (bufoff) + ldsw + 8192), 16, 0, 0); } while (0)
#define PG8_LDA(dst, b, h) do { _Pragma("unroll") for (int m = 0; m < 4; ++m) _Pragma("unroll") for (int k = 0; k < 2; ++k) dst[m][k] = *(const LAS bf16x8*)(lds + PG8_SA(b, h) + aoff + m * 2048 + k * 1024); } while (0)
#define PG8_LDB(dst, b, h) do { _Pragma("unroll") for (int n = 0; n < 2; ++n) _Pragma("unroll") for (int k = 0; k < 2; ++k) dst[n][k] = *(const LAS bf16x8*)(lds + PG8_SB(b, h) + boff + n * 2048 + k * 1024); } while (0)
#define PG8_MMA(ai, bj, At, Bt) do { __builtin_amdgcn_s_setprio(1); _Pragma("unroll") for (int m = 0; m < 4; ++m) _Pragma("unroll") for (int n = 0; n < 2; ++n) _Pragma("unroll") for (int k = 0; k < 2; ++k) \
        acc[ai][bj][m][n] = __builtin_amdgcn_mfma_f32_16x16x32_bf16(Bt[n][k], At[m][k], acc[ai][bj][m][n], 0, 0, 0); __builtin_amdgcn_s_setprio(0); } while (0)
#define PG8_WAIT_V(n) asm volatile("s_waitcnt vmcnt(" #n ")" ::: "memory")
#define PG8_WAIT_L(n) asm volatile("s_waitcnt lgkmcnt(" #n ")" ::: "memory")
#define PG8_BAR __builtin_amdgcn_s_barrier()
#define PG8_SCHED __builtin_amdgcn_sched_barrier(0)
    Unit cur, nxt; int ui = 0;
    if (!S.next(0, cur)) return;
    f32x4 acc[2][2][4][2];
#pragma unroll
    for (int a = 0; a < 2; ++a)
#pragma unroll
        for (int b = 0; b < 2; ++b)
#pragma unroll
            for (int m = 0; m < 4; ++m)
#pragma unroll
                for (int n = 0; n < 2; ++n) acc[a][b][m][n] = (f32x4){0.f, 0.f, 0.f, 0.f};
    bf16x8 At[4][2], B0[2][2], B1[2][2];
    unsigned vC[2][2];
    AS.offs(cur, Rs, Cs, vC);
    unsigned x00 = vC[0][0], x01 = vC[0][1], x10 = vC[1][0], x11 = vC[1][1];
    const char* cA = AS.base(cur); const char* cB = BS.base(cur);
    if constexpr (SP2) {
        PG8_STAGEB(PG8_SB(0, 0), cB); PG8_STAGEB(PG8_SB(0, 1), cB + hstepB); PG8_STAGEA(PG8_SA(0, 0), cA, vC[0][0], vC[0][1]); PG8_STAGEA(PG8_SA(0, 1), cA, vC[1][0], vC[1][1]);
        if (wr == 1) PG8_BAR;
        PG8_WAIT_V(2); PG8_BAR;
        PG8_STAGEB(PG8_SB(1, 0), cB + kstepB); PG8_STAGEA(PG8_SA(1, 0), cA + kstepA, vC[0][0], vC[0][1]); PG8_STAGEB(PG8_SB(1, 1), cB + hstepB + kstepB);
        PG8_WAIT_V(6); PG8_BAR;
    } else {
        PG8_STAGEB(PG8_SB(0, 0), cB); PG8_STAGEA(PG8_SA(0, 0), cA, vC[0][0], vC[0][1]); PG8_STAGEB(PG8_SB(0, 1), cB + hstepB); PG8_STAGEA(PG8_SA(0, 1), cA, vC[1][0], vC[1][1]);
        if (wr == 1) PG8_BAR;
        PG8_WAIT_V(4); PG8_BAR;
        PG8_STAGEB(PG8_SB(1, 0), cB + kstepB); PG8_STAGEA(PG8_SA(1, 0), cA + kstepA, vC[0][0], vC[0][1]); PG8_STAGEB(PG8_SB(1, 1), cB + hstepB + kstepB);
        PG8_WAIT_V(6); PG8_BAR;
    }
    for (;;) {
        const bool has_next = S.next(ui + 1, nxt);
        const char* nA = has_next ? AS.base(nxt) : cA; const char* nB = has_next ? BS.base(nxt) : cB;
        for (int t = 0; t < nt; t += 2) {
            const bool last = (t == nt - 2);
            const char* a1 = cA + (size_t)(t + 1) * kstepA;
            const char* a2 = last ? nA : cA + (size_t)(t + 2) * kstepA; const char* b2 = last ? nB : cB + (size_t)(t + 2) * kstepB;
            const char* a3 = a2 + kstepA; const char* b3 = b2 + kstepB;
            if constexpr (ASrc::GATHER) { if (last && has_next) { unsigned vn[2][2]; AS.offs(nxt, Rs, Cs, vn); x00 = vn[0][0]; x01 = vn[0][1]; x10 = vn[1][0]; x11 = vn[1][1]; } }
            if constexpr (SP2) {
            PG8_LDB(B0, 0, 0); PG8_LDB(B1, 0, 1); PG8_SCHED; PG8_LDA(At, 0, 0); PG8_STAGEA(PG8_SA(1, 1), a1, vC[1][0], vC[1][1]);
            PG8_WAIT_V(8); PG8_WAIT_L(0); PG8_BAR; PG8_MMA(0, 0, At, B0); PG8_MMA(0, 1, At, B1); PG8_BAR; PG8_SCHED;
            PG8_LDA(At, 0, 1); PG8_STAGEB(PG8_SB(0, 0), b2); PG8_STAGEB(PG8_SB(0, 1), b2 + hstepB); PG8_STAGEA(PG8_SA(0, 0), a2, x00, x01);
            PG8_WAIT_V(8); PG8_WAIT_L(0); PG8_BAR; PG8_MMA(1, 0, At, B0); PG8_MMA(1, 1, At, B1); PG8_BAR; PG8_SCHED;
            PG8_LDB(B0, 1, 0); PG8_LDB(B1, 1, 1); PG8_SCHED; PG8_LDA(At, 1, 0); PG8_STAGEA(PG8_SA(0, 1), a2, x10, x11);
            PG8_WAIT_V(8); PG8_WAIT_L(0); PG8_BAR; PG8_MMA(0, 0, At, B0); PG8_MMA(0, 1, At, B1); PG8_BAR; PG8_SCHED;
            PG8_LDA(At, 1, 1); PG8_STAGEB(PG8_SB(1, 0), b3); PG8_STAGEB(PG8_SB(1, 1), b3 + hstepB); PG8_STAGEA(PG8_SA(1, 0), a3, x00, x01);
            PG8_WAIT_V(8); PG8_WAIT_L(0); PG8_BAR; PG8_MMA(1, 0, At, B0); PG8_MMA(1, 1, At, B1); PG8_BAR; PG8_SCHED;
            } else {
            PG8_LDB(B0, 0, 0); PG8_SCHED; PG8_LDA(At, 0, 0); PG8_STAGEA(PG8_SA(1, 1), a1, vC[1][0], vC[1][1]);
            PG8_WAIT_L(8); PG8_BAR; PG8_WAIT_L(0); PG8_MMA(0, 0, At, B0); PG8_BAR; PG8_SCHED;
            PG8_LDB(B1, 0, 1); PG8_STAGEB(PG8_SB(0, 0), b2);
            PG8_BAR; PG8_WAIT_L(0); PG8_MMA(0, 1, At, B1); PG8_BAR;
            PG8_LDA(At, 0, 1); PG8_STAGEA(PG8_SA(0, 0), a2, x00, x01);
            PG8_BAR; PG8_WAIT_L(0); PG8_MMA(1, 0, At, B0); PG8_BAR; PG8_SCHED;
            PG8_STAGEB(PG8_SB(0, 1), b2 + hstepB);
            PG8_WAIT_V(6); PG8_BAR; PG8_MMA(1, 1, At, B1); PG8_BAR;
            PG8_LDB(B0, 1, 0); PG8_SCHED; PG8_LDA(At, 1, 0); PG8_STAGEA(PG8_SA(0, 1), a2, x10, x11);
            PG8_WAIT_L(8); PG8_BAR; PG8_WAIT_L(0); PG8_MMA(0, 0, At, B0); PG8_BAR; PG8_SCHED;
            PG8_LDB(B1, 1, 1); PG8_STAGEB(PG8_SB(1, 0), b3);
            PG8_BAR; PG8_WAIT_L(0); PG8_MMA(0, 1, At, B1); PG8_BAR;
            PG8_LDA(At, 1, 1); PG8_STAGEA(PG8_SA(1, 0), a3, x00, x01);
            PG8_BAR; PG8_WAIT_L(0); PG8_MMA(1, 0, At, B0); PG8_BAR; PG8_SCHED;
            PG8_STAGEB(PG8_SB(1, 1), b3 + hstepB);
            PG8_WAIT_V(6); PG8_BAR; PG8_MMA(1, 1, At, B1); PG8_BAR;
            }
        }
        if constexpr (ALIGN_EPI) { if (wr == 0) PG8_BAR; }
        E(acc, cur, wr, wc, fr, fq);
        if (!has_next) break;
#pragma unroll
        for (int a = 0; a < 2; ++a)
#pragma unroll
            for (int b = 0; b < 2; ++b)
#pragma unroll
                for (int m = 0; m < 4; ++m)
#pragma unroll
                    for (int n = 0; n < 2; ++n) acc[a][b][m][n] = (f32x4){0.f, 0.f, 0.f, 0.f};
        cur = nxt; cA = nA; cB = nB; ++ui;
        if constexpr (ASrc::GATHER) { vC[0][0] = x00; vC[0][1] = x01; vC[1][0] = x10; vC[1][1] = x11; }
        if constexpr (ALIGN_EPI) { if (wr == 1) PG8_BAR; }
    }
    PG8_WAIT_V(0);
    if constexpr (!ALIGN_EPI) { if (wr == 0) PG8_BAR; }
    PG8_BAR;
#undef PG8_SA
#undef PG8_SB
#undef PG8_STAGEA
#undef PG8_STAGEB
#undef PG8_LDA
#undef PG8_LDB
#undef PG8_MMA
#undef PG8_WAIT_V
#undef PG8_WAIT_L
#undef PG8_BAR
#undef PG8_SCHED
}
}
namespace pg8 {
__device__ __forceinline__ float gelu_tanh(float x) {
    const float u = 0.7978845608028654f * (x + 0.044715f * x * x * x);
    const float e = __expf(-2.0f * fabsf(u)); float th = (1.0f - e) / (1.0f + e); th = u < 0.f ? -th : th;
    return 0.5f * x * (1.0f + th);
}
struct EpiStore {
    static constexpr bool PERM = true;
    bf16_t* O; int ldc;
    __device__ __forceinline__ void operator()(const f32x4 (&acc)[2][2][4][2], const Unit& u, int wr, int wc, int fr, int fq) const {
        const int row0 = u.pm * BM + wr * 64 + fr, col0 = u.pn * BM + wc * 32 + 8 * fq;
#pragma unroll
        for (int ai = 0; ai < 2; ++ai)
#pragma unroll
            for (int m = 0; m < 4; ++m) { bf16_t* rowp = O + (size_t)(row0 + ai * HALF + m * 16) * ldc + col0;
#pragma unroll
                for (int bj = 0; bj < 2; ++bj) { const f32x4 v0 = acc[ai][bj][m][0], v1 = acc[ai][bj][m][1];
                    u32x4 w; w.x = cvt_pk_bf16(v0[0], v0[1]); w.y = cvt_pk_bf16(v0[2], v0[3]); w.z = cvt_pk_bf16(v1[0], v1[1]); w.w = cvt_pk_bf16(v1[2], v1[3]);
                    *(u32x4*)(rowp + bj * HALF) = w; } }
    }
};
struct EpiCmpGelu {
    static constexpr bool PERM = true;
    bf16_t* O; const float* bias;
    __device__ __forceinline__ void operator()(const f32x4 (&acc)[2][2][4][2], const Unit& u, int wr, int wc, int fr, int fq) const {
        const int row0 = u.pm * BM + wr * 64 + fr, col0 = wc * 32 + 8 * fq;
        bf16_t* Oj = O + (size_t)u.e * 16384 * 256; const float* bj_ = bias + u.e * 256;
        f32x4 bv[2][2];
#pragma unroll
        for (int bj = 0; bj < 2; ++bj)
#pragma unroll
            for (int n = 0; n < 2; ++n) bv[bj][n] = *(const f32x4*)(bj_ + col0 + bj * HALF + 4 * n);
#pragma unroll
        for (int ai = 0; ai < 2; ++ai)
#pragma unroll
            for (int m = 0; m < 4; ++m) { bf16_t* rowp = Oj + (size_t)(row0 + ai * HALF + m * 16) * 256 + col0;
#pragma unroll
                for (int bj = 0; bj < 2; ++bj) { f32x4 v0 = acc[ai][bj][m][0] + bv[bj][0], v1 = acc[ai][bj][m][1] + bv[bj][1];
#pragma unroll
                    for (int j = 0; j < 4; ++j) { v0[j] = gelu_tanh(v0[j]); v1[j] = gelu_tanh(v1[j]); }
                    u32x4 w; w.x = cvt_pk_bf16(v0[0], v0[1]); w.y = cvt_pk_bf16(v0[2], v0[3]); w.z = cvt_pk_bf16(v1[0], v1[1]); w.w = cvt_pk_bf16(v1[2], v1[3]);
                    *(u32x4*)(rowp + bj * HALF) = w; } }
    }
};
struct EpiSwiglu {
    static constexpr bool PERM = true;
    bf16_t* H; const float* bgu;
    __device__ __forceinline__ void operator()(const f32x4 (&acc)[2][2][4][2], const Unit& u, int wr, int wc, int fr, int fq) const {
        const int row0 = u.pm * BM + wr * 64 + fr, col0 = u.pn * HALF + wc * 32 + 8 * fq;
        const float* bg = bgu + (size_t)u.e * 2048 + col0;
        f32x4 bgv[2], buv[2];
#pragma unroll
        for (int n = 0; n < 2; ++n) { bgv[n] = *(const f32x4*)(bg + 4 * n); buv[n] = *(const f32x4*)(bg + 1024 + 4 * n); }
#pragma unroll
        for (int ai = 0; ai < 2; ++ai)
#pragma unroll
            for (int m = 0; m < 4; ++m) { bf16_t* rowp = H + (size_t)(row0 + ai * HALF + m * 16) * DFF + col0;
                float o[8];
#pragma unroll
                for (int n = 0; n < 2; ++n) { const f32x4 g = acc[ai][0][m][n] + bgv[n], up = acc[ai][1][m][n] + buv[n];
#pragma unroll
                    for (int j = 0; j < 4; ++j) { const float gg = fminf(g[j], 7.0f), uu = fminf(fmaxf(up[j], -7.0f), 7.0f);
                        o[4 * n + j] = (uu + 1.0f) * gg * (1.0f / (1.0f + __expf(-1.702f * gg))); } }
                u32x4 w; w.x = cvt_pk_bf16(o[0], o[1]); w.y = cvt_pk_bf16(o[2], o[3]); w.z = cvt_pk_bf16(o[4], o[5]); w.w = cvt_pk_bf16(o[6], o[7]);
                *(u32x4*)rowp = w; }
    }
};
struct EpiDown {
    static constexpr bool PERM = true;
    bf16_t* Y; const float* bd; const float* rgate;
    __device__ __forceinline__ void operator()(const f32x4 (&acc)[2][2][4][2], const Unit& u, int wr, int wc, int fr, int fq) const {
        const int row0 = u.pm * BM + wr * 64 + fr, col0 = u.pn * BM + wc * 32 + 8 * fq;
        const float* b = bd + (size_t)u.e * 1024 + col0;
        f32x4 bv[2][2];
#pragma unroll
        for (int bj = 0; bj < 2; ++bj)
#pragma unroll
            for (int n = 0; n < 2; ++n) bv[bj][n] = *(const f32x4*)(b + bj * HALF + 4 * n);
#pragma unroll
        for (int ai = 0; ai < 2; ++ai)
#pragma unroll
            for (int m = 0; m < 4; ++m) { const int row = row0 + ai * HALF + m * 16; const float gt = rgate[row]; bf16_t* rowp = Y + (size_t)row * D + col0;
#pragma unroll
                for (int bj = 0; bj < 2; ++bj) { const f32x4 v0 = (acc[ai][bj][m][0] + bv[bj][0]) * gt, v1 = (acc[ai][bj][m][1] + bv[bj][1]) * gt;
                    u32x4 w; w.x = cvt_pk_bf16(v0[0], v0[1]); w.y = cvt_pk_bf16(v0[2], v0[3]); w.z = cvt_pk_bf16(v1[0], v1[1]); w.w = cvt_pk_bf16(v1[2], v1[3]);
                    *(u32x4*)(rowp + bj * HALF) = w; } }
    }
};
}
struct Frame {
    LAS unsigned char* lds;
    volatile LAS unsigned* LC;
    unsigned* ctl;
    unsigned char* ws;
    int tid, lane, wave, G;
    float* out;
};
__device__ __forceinline__ unsigned char* opaque_ws(unsigned char* p) { asm volatile("; ws" : "+s"(p)); return p; }
#define WSP(T_, off) ((T_*)(opaque_ws(F.ws) + (off)))
__device__ __forceinline__ const float* inptr(const Frame& F, int i) {
    const unsigned lo = __builtin_amdgcn_readfirstlane(F.LC[128 + 2 * i]), hi = __builtin_amdgcn_readfirstlane(F.LC[129 + 2 * i]);
    return (const float*)(((unsigned long long)hi << 32) | (unsigned long long)lo);
}
enum { I_X = 0, I_LN_G, I_LN_B, I_NSA_W_IN, I_NSA_CMP_POS, I_NSA_CMP_W1, I_NSA_CMP_B1, I_NSA_CMP_W2, I_NSA_CMP_B2, I_NSA_GATE_B, I_NSA_W_OUT,
       I_ML_W_IN, I_ML_CONV_W, I_ML_CONV_B, I_ML_GATE_B, I_ML_NORM_G, I_ML_W_OUT, I_HG_W_IN, I_HG_LOWER, I_HG_NORM_G, I_HG_W_OUT,
       I_ROUTER_W, I_ROUTER_B, I_MOE_W_GU, I_MOE_B_GU, I_MOE_W_DOWN, I_MOE_B_DOWN };

__device__ __forceinline__ void tr_item(const float* W, int K, int N, int nvalid, bf16_t* WT, int drow, int k0, int n0, LAS float* scr, int lane) {
    const int nn = n0 + (lane & 31); const bool ok = nn < nvalid;
#pragma unroll 8
    for (int i = 0; i < 32; ++i) { const int kk = 2 * i + (lane >> 5); scr[kk * 33 + (lane & 31)] = ok ? W[(size_t)(k0 + kk) * N + nn] : 0.f; }
    LDS_WAIT();
    const int c = lane & 7;
#pragma unroll
    for (int j = 0; j < 4; ++j) { const int n = (lane >> 3) + 8 * j; const LAS float* s = scr + (8 * c) * 33 + n;
        u32x4 o; o.x = pk2(s[0 * 33], s[1 * 33]); o.y = pk2(s[2 * 33], s[3 * 33]); o.z = pk2(s[4 * 33], s[5 * 33]); o.w = pk2(s[6 * 33], s[7 * 33]);
        *(u32x4*)(WT + (size_t)(drow + n) * K + k0 + 8 * c) = o; }
    LDS_WAIT();
}
__device__ __forceinline__ void tr_class(Frame& F, const float* W, int nmat, int K, int N, int Npad, bf16_t* WT, bool gu, LAS float* scr, int gw, int NGW) {
    const int nblk = Npad / 32, per = (K / 64) * nblk; const long total = (long)nmat * per;
    for (long it = gw; it < total; it += NGW) {
        const int mat = (int)(it / per), r = (int)(it % per), kb = r / nblk, nb = r % nblk, n0 = nb * 32;
        int drow = n0;
        if (gu) drow = (n0 < 1024) ? ((n0 >> 7) * 256 + (n0 & 127)) : ((((n0 - 1024) >> 7) * 256) + 128 + ((n0 - 1024) & 127));
        tr_item(W + (size_t)mat * K * N, K, N, N, WT + (size_t)mat * Npad * K, drow, kb * 64, n0, scr, F.lane);
    }
}
__device__ __forceinline__ void p0_prologue(Frame& F) {
    LAS float* scr = (LAS float*)(F.lds + F.wave * 16384);
    const int gw = blockIdx.x * 8 + F.wave, NGW = F.G * 8;
    tr_class(F, inptr(F, I_MOE_W_GU), DEPTH * NEXP, D, 2 * DFF, 2 * DFF, WSP(bf16_t, OFF_W_GU), true, scr, gw, NGW);
    tr_class(F, inptr(F, I_MOE_W_DOWN), DEPTH * NEXP, DFF, D, D, WSP(bf16_t, OFF_W_DN), false, scr, gw, NGW);
    tr_class(F, inptr(F, I_NSA_W_IN), 2, D, NSA_IN, NSA_LD, WSP(bf16_t, OFF_W_NSAIN), false, scr, gw, NGW);
    tr_class(F, inptr(F, I_NSA_W_OUT), 2, D, D, D, WSP(bf16_t, OFF_W_NSAOUT), false, scr, gw, NGW);
    tr_class(F, inptr(F, I_ML_W_IN), 1, D, ML_IN, ML_LD, WSP(bf16_t, OFF_W_MLIN), false, scr, gw, NGW);
    tr_class(F, inptr(F, I_ML_W_OUT), 1, D, D, D, WSP(bf16_t, OFF_W_MLOUT), false, scr, gw, NGW);
    tr_class(F, inptr(F, I_HG_W_IN), 1, D, HG_LD, HG_LD, WSP(bf16_t, OFF_W_HGIN), false, scr, gw, NGW);
    tr_class(F, inptr(F, I_HG_W_OUT), 1, D, D, D, WSP(bf16_t, OFF_W_HGOUT), false, scr, gw, NGW);
    tr_class(F, inptr(F, I_NSA_CMP_W1), 4, 2048, 256, 256, WSP(bf16_t, OFF_W_CMP1), false, scr, gw, NGW);
    const int gt = blockIdx.x * 512 + F.tid;
    float* tab = WSP(float, OFF_TAB);
    if (gt < 1024) {
        const int lj = gt >> 8, n = gt & 255; const float* pos = inptr(F, I_NSA_CMP_POS) + (size_t)lj * 2048; const float* w1 = inptr(F, I_NSA_CMP_W1) + (size_t)lj * 2048 * 256;
        float a = inptr(F, I_NSA_CMP_B1)[lj * 256 + n];
        for (int k = 0; k < 2048; ++k) a += pos[k] * w1[(size_t)k * 256 + n];
        tab[TAB_CMPB + gt] = a;
    } else if (gt < 2048) {
        const int c = gt - 1024; float v[DEPTH], mx = -1e30f;
#pragma unroll
        for (int i = 0; i < DEPTH; ++i) { v[i] = inptr(F, I_HG_LOWER)[i * D + c]; mx = fmaxf(mx, v[i]); }
        float s = 0.f;
#pragma unroll
        for (int i = 0; i < DEPTH; ++i) { v[i] = __expf(v[i] - mx); s += v[i]; }
        tab[TAB_LB + c] = (v[1] + v[2]) / s;
    }
    {
        const f32x4* xs = (const f32x4*)inptr(F, I_X); u32x2* xn = WSP(u32x2, OFF_XN);
        const size_t n4 = (size_t)NTOK * D / 4, stride = (size_t)F.G * 512;
        for (size_t i = (size_t)blockIdx.x * 512 + F.tid; i < n4; i += stride) { const f32x4 v = xs[i]; u32x2 o; o.x = pk2(v[0], v[1]); o.y = pk2(v[2], v[3]); xn[i] = o; }
    }
}

__device__ __forceinline__ void phase_ln_router(Frame& F, int layer, const float* xin) {
    LAS float* rwT = (LAS float*)F.lds;
    const float* rw = inptr(F, I_ROUTER_W) + (size_t)layer * D * NEXP;
    for (int i = F.tid; i < D * NEXP; i += 512) { const int k = i >> 5, e = i & 31; rwT[e * 1024 + k] = rw[i]; }
    if (F.tid < 32) F.LC[64 + F.tid] = 0u;
    __syncthreads();
    const float* g = inptr(F, I_LN_G) + (size_t)(layer * 2 + 0) * D; const float* bb = inptr(F, I_LN_B) + (size_t)(layer * 2 + 0) * D;
    const float* rb = inptr(F, I_ROUTER_B) + layer * NEXP;
    const bf16_t* HM = WSP(bf16_t, OFF_HM); float* XA = WSP(float, OFF_XA); bf16_t* XN = WSP(bf16_t, OFF_XN);
    int* toke = WSP(int, OFF_TOKE); float* tokg = WSP(float, OFF_TOKG);
    int lane = F.lane; asm volatile("; phase-local lane" : "+v"(lane));
    for (int blk = blockIdx.x; blk < NTOK / 256; blk += F.G) {
        for (int i = 0; i < 32; ++i) {
            const int m = blk * 256 + F.wave * 32 + i;
            const f32x4* xr = (const f32x4*)(xin + (size_t)m * D) + lane; const u32x2* hr = (const u32x2*)(HM + (size_t)m * D) + lane;
            f32x4 v[4]; float s = 0.f;
#pragma unroll
            for (int j = 0; j < 4; ++j) { const f32x4 xv = xr[64 * j]; const u32x2 hv = hr[64 * j];
                v[j][0] = DN_ALPHA * xv[0] + __uint_as_float(hv.x << 16); v[j][1] = DN_ALPHA * xv[1] + __uint_as_float(hv.x & 0xffff0000u);
                v[j][2] = DN_ALPHA * xv[2] + __uint_as_float(hv.y << 16); v[j][3] = DN_ALPHA * xv[3] + __uint_as_float(hv.y & 0xffff0000u);
                s += (v[j][0] + v[j][1]) + (v[j][2] + v[j][3]); }
            const float mean = wave_sum(s) * (1.f / D); float s2 = 0.f;
#pragma unroll
            for (int j = 0; j < 4; ++j) { v[j] = v[j] - mean; s2 += (v[j][0] * v[j][0] + v[j][1] * v[j][1]) + (v[j][2] * v[j][2] + v[j][3] * v[j][3]); }
            const float rstd = 1.0f / sqrtf(wave_sum(s2) * (1.f / D) + LN_EPS);
            f32x4* xo = (f32x4*)(XA + (size_t)m * D) + lane; u32x2* no = (u32x2*)(XN + (size_t)m * D) + lane;
#pragma unroll
            for (int j = 0; j < 4; ++j) { const f32x4 gv = *((const f32x4*)g + lane + 64 * j), bv = *((const f32x4*)bb + lane + 64 * j);
                v[j] = v[j] * rstd * gv + bv; xo[64 * j] = v[j]; u32x2 o; o.x = pk2(v[j][0], v[j][1]); o.y = pk2(v[j][2], v[j][3]); no[64 * j] = o; }
            float lg[NEXP];
#pragma unroll
            for (int e = 0; e < NEXP; ++e) { float p = 0.f;
#pragma unroll
                for (int j = 0; j < 4; ++j) { const f32x4 w = *((const LAS f32x4*)(rwT + e * 1024) + lane + 64 * j); p += (v[j][0] * w[0] + v[j][1] * w[1]) + (v[j][2] * w[2] + v[j][3] * w[3]); }
                lg[e] = wave_sum(p) + rb[e]; }
            unsigned taken = 0u; int se[TOPK]; float sv[TOPK];
#pragma unroll
            for (int k = 0; k < TOPK; ++k) { float best = -INFINITY; int bi = 0;
#pragma unroll
                for (int e = 0; e < NEXP; ++e) { const float c = ((taken >> e) & 1u) ? -INFINITY : lg[e]; if (c > best) { best = c; bi = e; } }
                se[k] = bi; sv[k] = best; taken |= 1u << bi; }
            float gs = 0.f, ge[TOPK];
#pragma unroll
            for (int k = 0; k < TOPK; ++k) { ge[k] = __expf(sv[k] - sv[0]); gs += ge[k]; }
            const float inv = 1.0f / gs;
            if (lane == 0) {
#pragma unroll
                for (int k = 0; k < TOPK; ++k) { toke[m * 4 + k] = se[k]; tokg[m * 4 + k] = ge[k] * inv; __hip_atomic_fetch_add((LAS unsigned*)&F.LC[64 + se[k]], 1u, __ATOMIC_RELAXED, __HIP_MEMORY_SCOPE_WORKGROUP); }
            }
        }
    }
    __syncthreads();
    if (F.tid < 32) { const unsigned c = F.LC[64 + F.tid]; if (c) __hip_atomic_fetch_add(F.ctl + CW_CNT + layer * 64 + F.tid, c, RLX_AGENT); }
    __syncthreads();
}

__device__ __forceinline__ void moe_tile_table(Frame& F, int layer) {
    if (F.tid == 0) { int acc = 0;
        for (int e = 0; e < NEXP; ++e) { const unsigned c = __hip_atomic_load(F.ctl + CW_CNT + layer * 64 + e, RLX_AGENT); acc += (int)((c + 255u) >> 8); F.LC[8 + e] = (unsigned)acc; }
        F.LC[40] = (unsigned)acc; }
    __syncthreads();
}
__device__ __forceinline__ void phase_moe_slots(Frame& F, int layer) {
    moe_tile_table(F, layer);
    const int* toke = WSP(int, OFF_TOKE); const float* tokg = WSP(float, OFF_TOKG);
    int* tokp = WSP(int, OFF_TOKP); int* rowt = WSP(int, OFF_ROWT); float* rowg = WSP(float, OFF_ROWG);
    for (int blk = blockIdx.x; blk < NTOK / 256; blk += F.G) {
        if (F.tid < 32) F.LC[64 + F.tid] = 0u;
        __syncthreads();
        int e[2], rank[2];
#pragma unroll
        for (int q = 0; q < 2; ++q) { const int a = blk * 1024 + q * 512 + F.tid; e[q] = toke[a]; rank[q] = (int)__hip_atomic_fetch_add((LAS unsigned*)&F.LC[64 + e[q]], 1u, __ATOMIC_RELAXED, __HIP_MEMORY_SCOPE_WORKGROUP); }
        __syncthreads();
        if (F.tid < 32) { const unsigned c = F.LC[64 + F.tid]; const unsigned pstart = (F.tid ? F.LC[8 + F.tid - 1] : 0u) * 256u;
            F.LC[96 + F.tid] = pstart + (c ? __hip_atomic_fetch_add(F.ctl + CW_CUR + layer * 64 + F.tid, c, RLX_AGENT) : 0u); }
        __syncthreads();
#pragma unroll
        for (int q = 0; q < 2; ++q) { const int a = blk * 1024 + q * 512 + F.tid; const int pos = (int)F.LC[96 + e[q]] + rank[q];
            rowt[pos] = a >> 2; rowg[pos] = tokg[a]; tokp[a] = pos; }
        __syncthreads();
    }
    for (int e2 = blockIdx.x; e2 < NEXP; e2 += F.G) {
        const unsigned c = __hip_atomic_load(F.ctl + CW_CNT + layer * 64 + e2, RLX_AGENT); const unsigned pstart = (e2 ? F.LC[8 + e2 - 1] : 0u) * 256u, pend = F.LC[8 + e2] * 256u;
        for (unsigned r = pstart + c + F.tid; r < pend; r += 512) { rowt[r] = 0; rowg[r] = 0.f; }
    }
}
__device__ __forceinline__ void phase_combine_ln(Frame& F, int layer, float* xo_base) {
    const float* g = inptr(F, I_LN_G) + (size_t)(layer * 2 + 1) * D; const float* bb = inptr(F, I_LN_B) + (size_t)(layer * 2 + 1) * D;
    const float* XA = WSP(float, OFF_XA); bf16_t* XN = WSP(bf16_t, OFF_XN); const bf16_t* Y = WSP(bf16_t, OFF_Y); const int* tokp = WSP(int, OFF_TOKP);
    int lane = F.lane; asm volatile("; phase-local lane" : "+v"(lane)); const int gw = blockIdx.x * 8 + F.wave, NGW = F.G * 8;
    for (int m = gw; m < NTOK; m += NGW) {
        const f32x4* xr = (const f32x4*)(XA + (size_t)m * D) + lane;
        int pos[TOPK];
#pragma unroll
        for (int k = 0; k < TOPK; ++k) pos[k] = tokp[m * 4 + k];
        f32x4 v[4]; float s = 0.f;
#pragma unroll
        for (int j = 0; j < 4; ++j) { v[j] = xr[64 * j] * DN_ALPHA; }
#pragma unroll
        for (int k = 0; k < TOPK; ++k) { const u32x2* yr = (const u32x2*)(Y + (size_t)pos[k] * D) + lane;
#pragma unroll
            for (int j = 0; j < 4; ++j) { const u32x2 hv = yr[64 * j];
                v[j][0] += __uint_as_float(hv.x << 16); v[j][1] += __uint_as_float(hv.x & 0xffff0000u); v[j][2] += __uint_as_float(hv.y << 16); v[j][3] += __uint_as_float(hv.y & 0xffff0000u); } }
#pragma unroll
        for (int j = 0; j < 4; ++j) s += (v[j][0] + v[j][1]) + (v[j][2] + v[j][3]);
        const float mean = wave_sum(s) * (1.f / D); float s2 = 0.f;
#pragma unroll
        for (int j = 0; j < 4; ++j) { v[j] = v[j] - mean; s2 += (v[j][0] * v[j][0] + v[j][1] * v[j][1]) + (v[j][2] * v[j][2] + v[j][3] * v[j][3]); }
        const float rstd = 1.0f / sqrtf(wave_sum(s2) * (1.f / D) + LN_EPS);
        f32x4* xo = (f32x4*)(xo_base + (size_t)m * D) + lane; u32x2* no = (u32x2*)(XN + (size_t)m * D) + lane;
#pragma unroll
        for (int j = 0; j < 4; ++j) { const f32x4 gv = *((const f32x4*)g + lane + 64 * j), bv = *((const f32x4*)bb + lane + 64 * j);
            v[j] = v[j] * rstd * gv + bv; xo[64 * j] = v[j]; u32x2 o; o.x = pk2(v[j][0], v[j][1]); o.y = pk2(v[j][2], v[j][3]); no[64 * j] = o; }
    }
}
__device__ __forceinline__ void phase_nsa_cmp2(Frame& F, int slot) {
    const bf16_t* HC = WSP(bf16_t, OFF_HC); float* KC = WSP(float, OFF_KC);
    const float* w2 = inptr(F, I_NSA_CMP_W2) + (size_t)slot * 2 * 256 * 64; const float* b2 = inptr(F, I_NSA_CMP_B2) + (size_t)slot * 2 * 64;
    const int total = 2 * 16384 * 64;
    int tid = F.tid; asm volatile("; phase-local tid" : "+v"(tid));
    for (int i = blockIdx.x * 512 + tid; i < total; i += F.G * 512) {
        const int d = i & 63, row = (i >> 6) & 16383, j = i >> 20;
        if ((row & 127) == 127) continue;
        const bf16_t* h = HC + ((size_t)j * 16384 + row) * 256; const float* w = w2 + (size_t)j * 256 * 64 + d;
        float a = b2[j * 64 + d];
        for (int n8 = 0; n8 < 32; ++n8) { const u32x4 hv = *(const u32x4*)(h + n8 * 8); const unsigned hw[4] = {hv.x, hv.y, hv.z, hv.w};
#pragma unroll
            for (int q = 0; q < 4; ++q) { a += __uint_as_float(hw[q] << 16) * w[(n8 * 8 + 2 * q) * 64]; a += __uint_as_float(hw[q] & 0xffff0000u) * w[(n8 * 8 + 2 * q + 1) * 64]; } }
        KC[i] = a;
    }
}

__device__ __forceinline__ void nsa_score_bf16(const bf16_t* krow, const LAS float* qs, float (&s)[4]) {
    s[0] = s[1] = s[2] = s[3] = 0.f;
#pragma unroll
    for (int c8 = 0; c8 < 8; ++c8) {
        const u32x4 kv = *(const u32x4*)(krow + c8 * 8); const unsigned kw[4] = {kv.x, kv.y, kv.z, kv.w};
        float k[8];
#pragma unroll
        for (int q = 0; q < 4; ++q) { k[2 * q] = __uint_as_float(kw[q] << 16); k[2 * q + 1] = __uint_as_float(kw[q] & 0xffff0000u); }
#pragma unroll
        for (int hh = 0; hh < 4; ++hh) { const f32x4 q0 = *(const LAS f32x4*)(qs + hh * 64 + c8 * 8), q1 = *(const LAS f32x4*)(qs + hh * 64 + c8 * 8 + 4);
            s[hh] += (k[0] * q0[0] + k[1] * q0[1]) + (k[2] * q0[2] + k[3] * q0[3]) + (k[4] * q1[0] + k[5] * q1[1]) + (k[6] * q1[2] + k[7] * q1[3]); }
    }
}
__device__ __forceinline__ void nsa_score_f32(const float* krow, const LAS float* qs, float (&s)[4]) {
    s[0] = s[1] = s[2] = s[3] = 0.f;
#pragma unroll
    for (int c4 = 0; c4 < 16; ++c4) {
        const f32x4 k = *(const f32x4*)(krow + c4 * 4);
#pragma unroll
        for (int hh = 0; hh < 4; ++hh) { const f32x4 q0 = *(const LAS f32x4*)(qs + hh * 64 + c4 * 4); s[hh] += (k[0] * q0[0] + k[1] * q0[1]) + (k[2] * q0[2] + k[3] * q0[3]); }
    }
}
__device__ __forceinline__ void nsa_tile_bf16(const bf16_t* krow, bool ok, const bf16_t* vb, long vstride, int nk, const LAS float* qs, LAS float* ps,
                                              float (&mr)[4], float (&lr)[4], float (&o)[4], int lane) {
    float s[4]; nsa_score_bf16(krow, qs, s);
    float p[4];
#pragma unroll
    for (int hh = 0; hh < 4; ++hh) {
        const float a = ok ? s[hh] : -1e30f; const float mn = fmaxf(mr[hh], wave_max(a)); const float alpha = __expf(mr[hh] - mn);
        p[hh] = ok ? __expf(a - mn) : 0.f; lr[hh] = lr[hh] * alpha + wave_sum(p[hh]); o[hh] *= alpha; mr[hh] = mn;
    }
    LDS_WAIT();
    *(LAS f32x4*)(ps + lane * 4) = (f32x4){p[0], p[1], p[2], p[3]};
    LDS_WAIT();
#pragma unroll 4
    for (int k = 0; k < nk; ++k) { const f32x4 pv = *(const LAS f32x4*)(ps + k * 4); const float v = bf2f(vb[(long)k * vstride]);
        o[0] += pv[0] * v; o[1] += pv[1] * v; o[2] += pv[2] * v; o[3] += pv[3] * v; }
    asm volatile("" ::: "memory");
}
__device__ __forceinline__ void phase_nsa_attn(Frame& F, int slot) {
    const bf16_t* P = WSP(bf16_t, OFF_PROJ); bf16_t* ATT = WSP(bf16_t, OFF_ATT);
    const float* KC = WSP(float, OFF_KC); const float* VC = KC + (size_t)128 * 128 * 64;
    const float* gb = inptr(F, I_NSA_GATE_B) + slot * 48;
    LAS float* wsm = (LAS float*)(F.lds + F.wave * 4096);
    LAS float* qs = wsm;
    LAS float* ps = wsm + 256;
    LAS float* Ps = wsm + 512;
    LAS float* gs = wsm + 704;
    int lane = F.lane; asm volatile("; phase-local lane" : "+v"(lane)); const int gw = blockIdx.x * 8 + F.wave, NGW = F.G * 8;
    const int ld = NSA_LD;
    for (int item = gw; item < NTOK * 4; item += NGW) {
        const int g = item & 3, m = item >> 2, b = m >> 11, t = m & (T - 1);
        const bf16_t* prow = P + (size_t)m * ld;
        const bf16_t* Pb = P + (size_t)b * T * ld;
#pragma unroll
        for (int hh = 0; hh < 4; ++hh) qs[hh * 64 + lane] = bf2f(prow[g * 256 + hh * 64 + lane]) * 0.125f;
        if (lane < 12) gs[lane] = sigmoidf_(bf2f(prow[2560 + g * 12 + lane]) + gb[g * 12 + lane]);
        LDS_WAIT();
        float oc[4] = {0.f, 0.f, 0.f, 0.f};
        const float* kcb = KC + (size_t)(b * 4 + g) * 128 * 64; const float* vcb = VC + (size_t)(b * 4 + g) * 128 * 64;
        {
            float sc[2][4]; bool ok[2];
#pragma unroll
            for (int tl = 0; tl < 2; ++tl) { const int c = tl * 64 + lane; ok[tl] = (c < NCMP) && (16 * c + 31 <= t); const int cc = c < NCMP ? c : NCMP - 1;
                nsa_score_f32(kcb + (size_t)cc * 64, qs, sc[tl]); asm volatile("" ::: "memory"); }
            float Pl[2] = {0.f, 0.f};
            float pr[2][4];
#pragma unroll
            for (int hh = 0; hh < 4; ++hh) {
                const float a0 = ok[0] ? sc[0][hh] : -1e30f, a1 = ok[1] ? sc[1][hh] : -1e30f;
                const float mx = wave_max(fmaxf(a0, a1));
                const float e0 = ok[0] ? __expf(a0 - mx) : 0.f, e1 = ok[1] ? __expf(a1 - mx) : 0.f;
                const float sm = wave_sum(e0 + e1); const float inv = sm > 0.f ? 1.0f / sm : 0.f;
                pr[0][hh] = e0 * inv; pr[1][hh] = e1 * inv; Pl[0] += pr[0][hh]; Pl[1] += pr[1][hh];
            }
            if (lane == 0) { Ps[0] = 0.f; Ps[129] = 0.f; }
            Ps[1 + lane] = Pl[0]; Ps[65 + lane] = Pl[1];
#pragma unroll
            for (int tl = 0; tl < 2; ++tl) {
                LDS_WAIT();
                *(LAS f32x4*)(ps + lane * 4) = (f32x4){pr[tl][0], pr[tl][1], pr[tl][2], pr[tl][3]};
                LDS_WAIT();
                const int nk = (tl == 0) ? 64 : 63;
#pragma unroll 4
                for (int k = 0; k < nk; ++k) { const f32x4 p = *(const LAS f32x4*)(ps + k * 4); const float v = vcb[(size_t)(tl * 64 + k) * 64 + lane];
                    oc[0] += p[0] * v; oc[1] += p[1] * v; oc[2] += p[2] * v; oc[3] += p[3] * v; }
            }
        }
        LDS_WAIT();
        const int cur = t >> 6;
        float osel[4] = {0.f, 0.f, 0.f, 0.f};
        {
            float imp = 0.f;
            if (lane < 32) imp = Ps[4 * lane] + 2.0f * (Ps[4 * lane + 1] + Ps[4 * lane + 2] + Ps[4 * lane + 3]) + Ps[4 * lane + 4];
            const bool forced = (lane == 0) || (lane == cur) || (lane == cur - 1);
            float sc = (lane < 32) ? (forced ? 1e30f : (lane <= cur ? imp : -1e30f)) : -INFINITY;
            float mr[4] = {-1e30f, -1e30f, -1e30f, -1e30f}, lr[4] = {0.f, 0.f, 0.f, 0.f};
            for (int j = 0; j < 8; ++j) {
                const float mx = wave_max(sc);
                if (!(mx > -0.5e30f)) break;
                const unsigned long long bal = __ballot(sc == mx);
                const int idx = __builtin_amdgcn_readfirstlane(__ffsll((long long)bal) - 1);
                if (lane == idx) sc = -INFINITY;
                const int pos = idx * 64 + lane;
                int nk = t - idx * 64 + 1; nk = nk > 64 ? 64 : nk;
                nsa_tile_bf16(Pb + (size_t)pos * ld + 1536 + g * 64, pos <= t, Pb + (size_t)(idx * 64) * ld + 1792 + g * 64 + lane, ld, nk, qs, ps, mr, lr, osel, lane);
            }
#pragma unroll
            for (int hh = 0; hh < 4; ++hh) osel[hh] = lr[hh] > 0.f ? osel[hh] / lr[hh] : 0.f;
        }
        float ow[4] = {0.f, 0.f, 0.f, 0.f};
        {
            const int lo = t - 511 > 0 ? t - 511 : 0;
            float mr[4] = {-1e30f, -1e30f, -1e30f, -1e30f}, lr[4] = {0.f, 0.f, 0.f, 0.f};
            for (int tb = lo >> 6; tb <= cur; ++tb) {
                const int pos = tb * 64 + lane; const int pc = pos <= t ? pos : t;
                int nk = t - tb * 64 + 1; nk = nk > 64 ? 64 : nk;
                nsa_tile_bf16(Pb + (size_t)pc * ld + 2048 + g * 64, (pos >= lo) && (pos <= t), Pb + (size_t)(tb * 64) * ld + 2304 + g * 64 + lane, ld, nk, qs, ps, mr, lr, ow, lane);
            }
#pragma unroll
            for (int hh = 0; hh < 4; ++hh) ow[hh] = lr[hh] > 0.f ? ow[hh] / lr[hh] : 0.f;
        }
#pragma unroll
        for (int hh = 0; hh < 4; ++hh) {
            const float o = gs[hh * 3 + 0] * oc[hh] + gs[hh * 3 + 1] * osel[hh] + gs[hh * 3 + 2] * ow[hh];
            ATT[(size_t)m * D + g * 256 + hh * 64 + lane] = (bf16_t)f2bf(o);
        }
        LDS_WAIT();
    }
}
__device__ __forceinline__ float logsigmoidf_(float x) { return fminf(x, 0.f) - log1pf(__expf(-fabsf(x))); }
__device__ __forceinline__ void phase_mlstm_scan(Frame& F) {
    constexpr int QP = 132;
    LAS float* qL = (LAS float*)F.lds;
    LAS float* kL = qL + 64 * QP;
    LAS float* vL = kL + 64 * QP;
    LAS float* SL = vL + 64 * 128;
    LAS float* vec = SL + 64 * 68;
    LAS float* bL = vec;
    LAS float* liL = vec + 64;
    LAS float* mtL = vec + 128;
    LAS float* wiL = vec + 192;
    LAS float* dnL = vec + 256;
    LAS float* wkL = vec + 320;
    LAS float* nL = vec + 384;
    LAS float* scl = vec + 512;
    LAS float* rsL = vec + 576;
    LAS float* qnL = vec + 640;
    const bf16_t* P = WSP(bf16_t, OFF_PROJ); bf16_t* HO = WSP(bf16_t, OFF_HM);
    int tid = F.tid; asm volatile("; phase-local tid" : "+v"(tid));
    const int lane = tid & 63, ld = ML_LD;
    int v_ = tid >> 2, kq = tid & 3;
    for (int item = blockIdx.x; item < BATCH * 4 * 2; item += F.G) {
        const int vh = item & 1, h = (item >> 1) & 3, b = item >> 3;
        float C[32];
#pragma unroll
        for (int j = 0; j < 32; ++j) C[j] = 0.f;
        if (tid < 128) nL[tid] = 0.f;
        if (tid == 0) scl[0] = 0.f;
        __syncthreads();
#pragma unroll 1
        for (int ch = 0; ch < T / 64; ++ch) {
            asm volatile("; chunk-local" : "+v"(v_), "+v"(kq), "+v"(tid));
            const int t0 = ch * 64; const bf16_t* Pc = P + (size_t)(b * T + t0) * ld;
            {
                const int c2 = tid & 255, part = tid >> 8;
                const int col = (c2 < 128) ? (h * 128 + c2) : (512 + h * 128 + (c2 - 128));
                const float w0 = inptr(F, I_ML_CONV_W)[0 * 1024 + col], w1 = inptr(F, I_ML_CONV_W)[1 * 1024 + col], w2 = inptr(F, I_ML_CONV_W)[2 * 1024 + col], w3 = inptr(F, I_ML_CONV_W)[3 * 1024 + col], cb = inptr(F, I_ML_CONV_B)[col];
                const float scale = (c2 < 128) ? 1.0f : 0.08838834764831845f;
                const int r0 = part * 32;
                float x0 = (t0 + r0 - 3 >= 0) ? bf2f(Pc[(long)(r0 - 3) * ld + col]) : 0.f;
                float x1 = (t0 + r0 - 2 >= 0) ? bf2f(Pc[(long)(r0 - 2) * ld + col]) : 0.f;
                float x2 = (t0 + r0 - 1 >= 0) ? bf2f(Pc[(long)(r0 - 1) * ld + col]) : 0.f;
                LAS float* dst = (c2 < 128) ? (qL + c2) : (kL + (c2 - 128));
                for (int r = r0; r < r0 + 32; ++r) { const float x3 = bf2f(Pc[(long)r * ld + col]);
                    const float y = w0 * x0 + w1 * x1 + w2 * x2 + w3 * x3 + cb; dst[r * QP] = y * sigmoidf_(y) * scale; x0 = x1; x1 = x2; x2 = x3; }
                const int vc = tid & 127, vp = tid >> 7;
                for (int r = vp * 16; r < vp * 16 + 16; ++r) vL[r * 128 + vc] = bf2f(Pc[(long)r * ld + 1024 + h * 256 + vh * 128 + vc]);
                if (tid < 64) { liL[tid] = bf2f(Pc[(long)tid * ld + 3072 + h]) + inptr(F, I_ML_GATE_B)[h];
                    bL[tid] = logsigmoidf_(bf2f(Pc[(long)tid * ld + 3076 + h]) + inptr(F, I_ML_GATE_B)[4 + h]); }
            }
            __syncthreads();
            if (tid < 64) {
                float bb = bL[lane];
#pragma unroll
                for (int o = 1; o < 64; o <<= 1) { const float u = __shfl_up(bb, o); if (lane >= o) bb += u; }
                const float li = liL[lane]; float pm = li - bb;
#pragma unroll
                for (int o = 1; o < 64; o <<= 1) { const float u = __shfl_up(pm, o); if (lane >= o) pm = fmaxf(pm, u); }
                const float mprev = scl[0];
                const float mt = fmaxf(bb + mprev, bb + pm);
                const float bend = __shfl(bb, 63);
                const float decay = bend - bb + li;
                const float mnew = fmaxf(bend + mprev, wave_max(decay));
                bL[lane] = bb; mtL[lane] = mt; wiL[lane] = __expf(bb + mprev - mt); wkL[lane] = __expf(decay - mnew);
                if (lane == 0) { scl[1] = __expf(bend + mprev - mnew); scl[2] = mnew; }
            }
            __syncthreads();
            {
                const int t = tid >> 3, sg = tid & 7;
                float a[8];
#pragma unroll
                for (int j = 0; j < 8; ++j) a[j] = 0.f;
#pragma unroll 1
                for (int k4 = 0; k4 < 32; ++k4) { const f32x4 qv = *(const LAS f32x4*)(qL + t * QP + k4 * 4);
#pragma unroll
                    for (int j = 0; j < 8; ++j) { const f32x4 kv = *(const LAS f32x4*)(kL + (sg + 8 * j) * QP + k4 * 4); a[j] += (qv[0] * kv[0] + qv[1] * kv[1]) + (qv[2] * kv[2] + qv[3] * kv[3]); } }
                const float bt = bL[t], mt = mtL[t];
#pragma unroll
                for (int j = 0; j < 8; ++j) { const int s = sg + 8 * j; SL[t * 68 + s] = (s <= t) ? a[j] * __expf(bt - bL[s] + liL[s] - mt) : 0.f; }
            }
            __syncthreads();
            if (tid < 64) { float rs = 0.f; for (int s = 0; s < 64; ++s) rs += SL[tid * 68 + s]; rsL[tid] = rs; }
            else if (tid < 128) { const int t = tid - 64; float qn = 0.f; for (int k = 0; k < 128; ++k) qn += qL[t * QP + k] * nL[k]; qnL[t] = qn; }
            __syncthreads();
            if (tid < 64) { const float den = rsL[tid] + wiL[tid] * qnL[tid]; dnL[tid] = 1.0f / fmaxf(fabsf(den), __expf(-mtL[tid])); }
            __syncthreads();
            {
                float vr[16];
#pragma unroll
                for (int j = 0; j < 16; ++j) vr[j] = vL[(kq * 16 + j) * 128 + v_];
#pragma unroll 1
                for (int tg = 0; tg < 4; ++tg) {
                    float res[4];
#pragma unroll
                    for (int ti = 0; ti < 16; ++ti) { const int t = tg * 16 + ti;
                        float aC = 0.f, aS = 0.f;
#pragma unroll
                        for (int j4 = 0; j4 < 8; ++j4) { const f32x4 qv = *(const LAS f32x4*)(qL + t * QP + kq * 32 + j4 * 4);
                            aC += (qv[0] * C[j4 * 4] + qv[1] * C[j4 * 4 + 1]) + (qv[2] * C[j4 * 4 + 2] + qv[3] * C[j4 * 4 + 3]); }
#pragma unroll
                        for (int j4 = 0; j4 < 4; ++j4) { const f32x4 sv = *(const LAS f32x4*)(SL + t * 68 + kq * 16 + j4 * 4);
                            aS += (sv[0] * vr[j4 * 4] + sv[1] * vr[j4 * 4 + 1]) + (sv[2] * vr[j4 * 4 + 2] + sv[3] * vr[j4 * 4 + 3]); }
                        float tot = aS + wiL[t] * aC;
                        tot += __shfl_xor(tot, 1); tot += __shfl_xor(tot, 2);
                        tot *= dnL[t];
                        if ((ti & 3) == kq) res[ti >> 2] = tot;
                        asm volatile("" ::: "memory");
                    }
#pragma unroll
                    for (int q = 0; q < 4; ++q) { const int t = tg * 16 + q * 4 + kq; HO[(size_t)(b * T + t0 + t) * D + h * 256 + vh * 128 + v_] = (bf16_t)f2bf(res[q]); }
                }
            }
            __syncthreads();
            {
                const float cs = scl[1];
#pragma unroll
                for (int j = 0; j < 32; ++j) C[j] *= cs;
#pragma unroll 2
                for (int s = 0; s < 64; ++s) { const float a = vL[s * 128 + v_] * wkL[s];
#pragma unroll
                    for (int j4 = 0; j4 < 8; ++j4) { const f32x4 kv = *(const LAS f32x4*)(kL + s * QP + kq * 32 + j4 * 4);
                        C[j4 * 4] += a * kv[0]; C[j4 * 4 + 1] += a * kv[1]; C[j4 * 4 + 2] += a * kv[2]; C[j4 * 4 + 3] += a * kv[3]; } }
                if (tid < 128) { float nn = nL[tid] * cs; for (int s = 0; s < 64; ++s) nn += wkL[s] * kL[s * QP + tid]; nL[tid] = nn; }
                if (tid == 0) scl[0] = scl[2];
            }
            __syncthreads();
        }
    }
}
template <int HD>
__device__ __forceinline__ void phase_norm_gate(Frame& F, const float* norm_g, int ld, int gate_col0) {
    const bf16_t* HI = WSP(bf16_t, OFF_HM); const bf16_t* P = WSP(bf16_t, OFF_PROJ); bf16_t* ATT = WSP(bf16_t, OFF_ATT);
    int lane = F.lane; asm volatile("; phase-local lane" : "+v"(lane)); const int gw = blockIdx.x * 8 + F.wave, NGW = F.G * 8;
    for (int m = gw; m < NTOK; m += NGW) {
        const u32x2* hr = (const u32x2*)(HI + (size_t)m * D) + lane; const u32x2* gr = (const u32x2*)(P + (size_t)m * ld + gate_col0) + lane;
        u32x2* orow = (u32x2*)(ATT + (size_t)m * D) + lane;
#pragma unroll
        for (int j = 0; j < 4; ++j) {
            const u32x2 hv = hr[64 * j], gv = gr[64 * j];
            float x[4] = {__uint_as_float(hv.x << 16), __uint_as_float(hv.x & 0xffff0000u), __uint_as_float(hv.y << 16), __uint_as_float(hv.y & 0xffff0000u)};
            const float gt[4] = {__uint_as_float(gv.x << 16), __uint_as_float(gv.x & 0xffff0000u), __uint_as_float(gv.y << 16), __uint_as_float(gv.y & 0xffff0000u)};
            float ss = (x[0] * x[0] + x[1] * x[1]) + (x[2] * x[2] + x[3] * x[3]);
#pragma unroll
            for (int o = 1; o < (HD == 256 ? 64 : 32); o <<= 1) ss += __shfl_xor(ss, o);
            const float r = 1.0f / sqrtf(ss * (1.0f / HD) + RMS_EPS);
            const f32x4 ng = *((const f32x4*)norm_g + lane + 64 * j);
            float o4[4];
#pragma unroll
            for (int q = 0; q < 4; ++q) o4[q] = x[q] * r * ng[q] * sigmoidf_(gt[q]);
            u32x2 o; o.x = pk2(o4[0], o4[1]); o.y = pk2(o4[2], o4[3]); orow[64 * j] = o;
        }
    }
}

__device__ __forceinline__ void phase_hgrn_scan(Frame& F) {
    constexpr int QP = 132;
    LAS float* qL = (LAS float*)F.lds;
    LAS float* kL = qL + 32 * QP;
    LAS float* vL = kL + 32 * QP;
    LAS float* AL = vL + 32 * 128;
    LAS float* geL = AL + 32 * 36;
    const bf16_t* P = WSP(bf16_t, OFF_PROJ); bf16_t* HO = WSP(bf16_t, OFF_HM);
    const float* lbt = WSP(float, OFF_TAB) + TAB_LB;
    int tid = F.tid; asm volatile("; phase-local tid" : "+v"(tid));
    const int ld = HG_LD;
    int v_ = tid >> 2, kq = tid & 3;
    for (int item = blockIdx.x; item < BATCH * 8; item += F.G) {
        const int h = item & 7, b = item >> 3;
        float S[32];
#pragma unroll
        for (int j = 0; j < 32; ++j) S[j] = 0.f;
#pragma unroll 1
        for (int ch = 0; ch < T / 32; ++ch) {
            asm volatile("; chunk-local" : "+v"(v_), "+v"(kq), "+v"(tid));
            const int t0 = ch * 32; const bf16_t* Pc = P + (size_t)(b * T + t0) * ld;
            { const int c = tid & 127, p4 = tid >> 7;
#pragma unroll 2
              for (int r = p4 * 8; r < p4 * 8 + 8; ++r) { qL[r * QP + c] = bf2f(Pc[(long)r * ld + h * 128 + c]); kL[r * QP + c] = bf2f(Pc[(long)r * ld + 1024 + h * 128 + c]); vL[r * 128 + c] = bf2f(Pc[(long)r * ld + 2048 + h * 128 + c]); } }
            __syncthreads();
            if (tid < 128) { const float lb = lbt[h * 128 + tid]; float G = 0.f;
#pragma unroll 2
                for (int r = 0; r < 32; ++r) { const float qr = qL[r * QP + tid], fr = kL[r * QP + tid];
                    const float f = lb + (1.0f - lb) * sigmoidf_(fr); G += __logf(f);
                    qL[r * QP + tid] = qr * sigmoidf_(qr) * __expf(G); kL[r * QP + tid] = (1.0f - f) * __expf(-G); }
                geL[tid] = __expf(G); }
            __syncthreads();
            { const int t = tid >> 4, sg = tid & 15;
              float a0 = 0.f, a1 = 0.f;
#pragma unroll 2
              for (int k4 = 0; k4 < 32; ++k4) { const f32x4 qv = *(const LAS f32x4*)(qL + t * QP + k4 * 4);
                  const f32x4 k0 = *(const LAS f32x4*)(kL + sg * QP + k4 * 4), k1 = *(const LAS f32x4*)(kL + (sg + 16) * QP + k4 * 4);
                  a0 += (qv[0] * k0[0] + qv[1] * k0[1]) + (qv[2] * k0[2] + qv[3] * k0[3]); a1 += (qv[0] * k1[0] + qv[1] * k1[1]) + (qv[2] * k1[2] + qv[3] * k1[3]); }
              AL[t * 36 + sg] = (sg <= t) ? a0 : 0.f; AL[t * 36 + sg + 16] = (sg + 16 <= t) ? a1 : 0.f; }
            __syncthreads();
            {
                float vr[8];
#pragma unroll
                for (int j = 0; j < 8; ++j) vr[j] = vL[(kq * 8 + j) * 128 + v_];
#pragma unroll 2
                for (int t = 0; t < 32; ++t) {
                    float a = 0.f;
#pragma unroll
                    for (int j4 = 0; j4 < 8; ++j4) { const f32x4 qv = *(const LAS f32x4*)(qL + t * QP + kq * 32 + j4 * 4);
                        a += (qv[0] * S[j4 * 4] + qv[1] * S[j4 * 4 + 1]) + (qv[2] * S[j4 * 4 + 2] + qv[3] * S[j4 * 4 + 3]); }
#pragma unroll
                    for (int j4 = 0; j4 < 2; ++j4) { const f32x4 sv = *(const LAS f32x4*)(AL + t * 36 + kq * 8 + j4 * 4);
                        a += (sv[0] * vr[j4 * 4] + sv[1] * vr[j4 * 4 + 1]) + (sv[2] * vr[j4 * 4 + 2] + sv[3] * vr[j4 * 4 + 3]); }
                    a += __shfl_xor(a, 1); a += __shfl_xor(a, 2);
                    if ((t & 3) == kq) HO[(size_t)(b * T + t0 + t) * D + h * 128 + v_] = (bf16_t)f2bf(a);
                    asm volatile("" ::: "memory");
                }
            }
            {
#pragma unroll 2
                for (int s = 0; s < 32; ++s) { const float a = vL[s * 128 + v_];
#pragma unroll
                    for (int j4 = 0; j4 < 8; ++j4) { const f32x4 kv = *(const LAS f32x4*)(kL + s * QP + kq * 32 + j4 * 4);
                        S[j4 * 4] += a * kv[0]; S[j4 * 4 + 1] += a * kv[1]; S[j4 * 4 + 2] += a * kv[2]; S[j4 * 4 + 3] += a * kv[3]; } }
#pragma unroll
                for (int j4 = 0; j4 < 8; ++j4) { const f32x4 ge = *(const LAS f32x4*)(geL + kq * 32 + j4 * 4);
                    S[j4 * 4] *= ge[0]; S[j4 * 4 + 1] *= ge[1]; S[j4 * 4 + 2] *= ge[2]; S[j4 * 4 + 3] *= ge[3]; }
            }
            __syncthreads();
        }
    }
}
constexpr int PH_PER_LAYER = 10, N_PHASES = 1 + PH_PER_LAYER * DEPTH;
struct Args { const float* in[27]; float* out; unsigned char* ws; int ph_lo, ph_hi; };
__global__ void __launch_bounds__(512, 2) mk_fwd(Args args) {
    extern __shared__ __attribute__((aligned(16))) unsigned char lds[];
    Frame F;
    F.lds = (LAS unsigned char*)lds;
    F.LC = (volatile LAS unsigned*)(F.lds + LDSCTL_OFF);
    F.tid = threadIdx.x; F.lane = F.tid & 63; F.wave = __builtin_amdgcn_readfirstlane(F.tid >> 6); F.G = gridDim.x;
    F.ws = args.ws; F.ctl = (unsigned*)(args.ws + OFF_CTL); F.out = args.out;
    for (int u = F.tid; u < (LDS_BYTES - LDSCTL_OFF) / 4; u += 512) F.LC[u] = 0u;
    __syncthreads();
    if (F.tid < 27) { const unsigned long long pv = (unsigned long long)args.in[F.tid]; F.LC[128 + 2 * F.tid] = (unsigned)pv; F.LC[129 + 2 * F.tid] = (unsigned)(pv >> 32); }
    __syncthreads();
    XcdBarrier bar; bar.bar = F.ctl + CW_BAR; bar.x = 0; bar.st = nullptr;
    if (!MK_PER_PHASE) bar = xcd_barrier_post(F.ctl + CW_BAR, F.LC);
    const int lo = args.ph_lo, hi = args.ph_hi;
#define IN(k) (lo <= (k) && (k) < hi)
#define SEAM(k) do { if (!MK_PER_PHASE && (k) + 1 < hi) xcd_barrier(bar); else __syncthreads(); } while (0)

    if (IN(0)) {
#ifndef NO_P0
 p0_prologue(F);
#endif
 SEAM(0); }

    for (int L = 0; L < DEPTH; ++L) {
        int Lo = L; asm volatile("; layer-local" : "+s"(Lo));
        const int kind = Lo % 3, slot = Lo / 3, pb = 1 + PH_PER_LAYER * Lo;
#define PHL Frame Fp = F; asm volatile("; phase-local" : "+v"(Fp.tid)); Fp.lane = Fp.tid & 63;
        const int ldp = kind == 0 ? NSA_LD : (kind == 1 ? ML_LD : HG_LD);
        if (IN(pb + 0)) { PHL
            const bf16_t* Wt = kind == 0 ? WSP(bf16_t, OFF_W_NSAIN) + (size_t)slot * NSA_LD * D : (kind == 1 ? WSP(bf16_t, OFF_W_MLIN) : WSP(bf16_t, OFF_W_HGIN));
            pg8::APlain AS{WSP(bf16_t, OFF_XN), D}; pg8::BPlain BS{Wt, D}; pg8::StaticOrder S; S.init(NTOK / 256, ldp / 256, Fp.G, (int)blockIdx.x);
            pg8::EpiStore E{WSP(bf16_t, OFF_PROJ), ldp};
            #ifndef NO_GIN
            pg8::gemm_phase<pg8::EpiStore, pg8::StaticOrder, pg8::APlain, pg8::BPlain>(Fp.lds, D, AS, BS, S, E);
#endif
            SEAM(pb + 0);
        }
        if (kind == 0) {
            if (IN(pb + 1)) { PHL
                pg8::ACmp AS{WSP(bf16_t, OFF_PROJ), NSA_LD, 1024}; pg8::BGroup BS{WSP(bf16_t, OFF_W_CMP1) + (size_t)slot * 2 * 256 * 2048, 2048, (size_t)256 * 2048};
                pg8::CmpOrder S{Fp.G, (int)blockIdx.x};
                pg8::EpiCmpGelu E{WSP(bf16_t, OFF_HC), WSP(float, OFF_TAB) + TAB_CMPB + slot * 512};
                #ifndef NO_GCMP
                pg8::gemm_phase<pg8::EpiCmpGelu, pg8::CmpOrder, pg8::ACmp, pg8::BGroup>(Fp.lds, 2048, AS, BS, S, E);
#endif
                SEAM(pb + 1);
            }
            if (IN(pb + 2)) { PHL
#ifndef NO_CMP2
 phase_nsa_cmp2(Fp, slot);
#endif
 SEAM(pb + 2); }
            if (IN(pb + 3)) { PHL
#ifndef NO_ATTN
 phase_nsa_attn(Fp, slot);
#endif
 SEAM(pb + 3); }
        } else if (kind == 1) {
            if (IN(pb + 1)) { PHL
#ifndef NO_MLS
 phase_mlstm_scan(Fp);
#endif
 SEAM(pb + 1); }
            if (IN(pb + 2)) { PHL
#ifndef NO_NG
 phase_norm_gate<256>(Fp, inptr(Fp, I_ML_NORM_G), ML_LD, 2048);
#endif
 SEAM(pb + 2); }
        } else {
            if (IN(pb + 1)) { PHL
#ifndef NO_HGS
 phase_hgrn_scan(Fp);
#endif
 SEAM(pb + 1); }
            if (IN(pb + 2)) { PHL
#ifndef NO_NG
 phase_norm_gate<128>(Fp, inptr(Fp, I_HG_NORM_G), HG_LD, 3072);
#endif
 SEAM(pb + 2); }
        }
        if (IN(pb + 4)) { PHL
            const bf16_t* Wt = kind == 0 ? WSP(bf16_t, OFF_W_NSAOUT) + (size_t)slot * D * D : (kind == 1 ? WSP(bf16_t, OFF_W_MLOUT) : WSP(bf16_t, OFF_W_HGOUT));
            pg8::APlain AS{WSP(bf16_t, OFF_ATT), D}; pg8::BPlain BS{Wt, D}; pg8::StaticOrder S; S.init(NTOK / 256, D / 256, Fp.G, (int)blockIdx.x);
            pg8::EpiStore E{WSP(bf16_t, OFF_HM), D};
            #ifndef NO_GOUT
            pg8::gemm_phase<pg8::EpiStore, pg8::StaticOrder, pg8::APlain, pg8::BPlain>(Fp.lds, D, AS, BS, S, E);
#endif
            SEAM(pb + 4);
        }
        if (IN(pb + 5)) { PHL
#ifndef NO_LNR
 phase_ln_router(Fp, Lo, Lo == 0 ? inptr(Fp, I_X) : WSP(float, OFF_XA));
#endif
 SEAM(pb + 5); }
        if (IN(pb + 6)) { PHL
#ifndef NO_SLOT
 phase_moe_slots(Fp, Lo);
#endif
 SEAM(pb + 6); }
        if (IN(pb + 7)) { PHL
            moe_tile_table(Fp, Lo);
            pg8::AGather AS{WSP(bf16_t, OFF_XN), D, WSP(int, OFF_ROWT)}; pg8::BGroup BS{WSP(bf16_t, OFF_W_GU) + (size_t)Lo * NEXP * 2048 * D, D, (size_t)2048 * D};
            pg8::MoeOrder S; S.init(__builtin_amdgcn_readfirstlane((int)Fp.LC[40]), 8, Fp.G, (int)blockIdx.x); S.pend = (const LAS int*)(Fp.lds + LDSCTL_OFF + 32);
            pg8::EpiSwiglu E{WSP(bf16_t, OFF_H), inptr(Fp, I_MOE_B_GU) + (size_t)Lo * NEXP * 2048};
            #ifndef NO_GUP
            pg8::gemm_phase<pg8::EpiSwiglu, pg8::MoeOrder, pg8::AGather, pg8::BGroup>(Fp.lds, D, AS, BS, S, E);
#endif
            SEAM(pb + 7);
        }
        if (IN(pb + 8)) { PHL
            moe_tile_table(Fp, Lo);
            pg8::APlain AS{WSP(bf16_t, OFF_H), DFF}; pg8::BGroup BS{WSP(bf16_t, OFF_W_DN) + (size_t)Lo * NEXP * D * DFF, DFF, (size_t)D * DFF};
            pg8::MoeOrder S; S.init(__builtin_amdgcn_readfirstlane((int)Fp.LC[40]), 4, Fp.G, (int)blockIdx.x); S.pend = (const LAS int*)(Fp.lds + LDSCTL_OFF + 32);
            pg8::EpiDown E{WSP(bf16_t, OFF_Y), inptr(Fp, I_MOE_B_DOWN) + (size_t)Lo * NEXP * D, WSP(float, OFF_ROWG)};
            #ifndef NO_GDN
            pg8::gemm_phase<pg8::EpiDown, pg8::MoeOrder, pg8::APlain, pg8::BGroup>(Fp.lds, DFF, AS, BS, S, E);
#endif
            SEAM(pb + 8);
        }
        if (IN(pb + 9)) { PHL
#ifndef NO_COMB
 phase_combine_ln(Fp, Lo, Lo == DEPTH - 1 ? Fp.out : WSP(float, OFF_XA));
#endif
 SEAM(pb + 9); }
    }
#undef IN
#undef SEAM
#undef PHL
}

extern "C" void kernel_launch(void* const* d_in, const int* in_sizes, int n_in, void* d_out, int out_size, void* d_ws, size_t ws_size, hipStream_t stream) {
    static int grid = 0;
    if (grid == 0) {
        if (n_in != 27 || out_size != NTOK * D || ws_size < WS_END) { fprintf(stderr, "kernel_launch: unexpected shapes (n_in %d, out %d, ws %zu)\n", n_in, out_size, ws_size); grid = -1; return; }
        int dev = 0, cus = 0;
        if (hipGetDevice(&dev) != hipSuccess || hipDeviceGetAttribute(&cus, hipDeviceAttributeMultiprocessorCount, dev) != hipSuccess) { grid = -1; return; }
        if (hipFuncSetAttribute((const void*)mk_fwd, hipFuncAttributeMaxDynamicSharedMemorySize, LDS_BYTES) != hipSuccess) { fprintf(stderr, "kernel_launch: hipFuncSetAttribute failed\n"); grid = -1; return; }
        int per_cu = 0;
        if (hipOccupancyMaxActiveBlocksPerMultiprocessor(&per_cu, (const void*)mk_fwd, 512, LDS_BYTES) != hipSuccess || per_cu < 1) fprintf(stderr, "kernel_launch: occupancy query reports %d\n", per_cu);
        (void)hipGetLastError();
        grid = cus;
    }
    if (grid < 0) return;
    (void)hipMemsetAsync((char*)d_ws + OFF_CTL, 0, CTL_ZERO_BYTES, stream);
    Args a{};
    for (int i = 0; i < 27; ++i) a.in[i] = (const float*)d_in[i];
    a.out = (float*)d_out; a.ws = (unsigned char*)d_ws;
#if MK_PER_PHASE
    for (int p = 0; p < N_PHASES; ++p) {
        if (p > 0) { const int L = (p - 1) / PH_PER_LAYER, k = (p - 1) % PH_PER_LAYER, kind = L % 3; if (k == 3 && kind != 0) continue; }
        a.ph_lo = p; a.ph_hi = p + 1;
        hipLaunchKernelGGL(mk_fwd, dim3(grid), dim3(512), LDS_BYTES, stream, a);
    }
#else
    a.ph_lo = 0; a.ph_hi = N_PHASES;
    hipLaunchKernelGGL(mk_fwd, dim3(grid), dim3(512), LDS_BYTES, stream, a);
#endif
}
```

```cpp
#include <hip/hip_runtime.h>
#include <cstdio>
#include <cstdint>

#define LAS __attribute__((address_space(3)))
#define GAS __attribute__((address_space(1)))
typedef unsigned short bf16_t;
typedef short bf16x8 __attribute__((ext_vector_type(8)));
typedef float f32x4 __attribute__((ext_vector_type(4)));
typedef float f32x2 __attribute__((ext_vector_type(2)));
typedef unsigned u32x4 __attribute__((ext_vector_type(4)));
typedef unsigned u32x2 __attribute__((ext_vector_type(2)));
#define RLX_AGENT __ATOMIC_RELAXED, __HIP_MEMORY_SCOPE_AGENT
#define LDS_WAIT() asm volatile("s_waitcnt lgkmcnt(0)" ::: "memory")
#define VM_WAIT() asm volatile("s_waitcnt vmcnt(0)" ::: "memory")

#ifndef MK_PER_PHASE
#define MK_PER_PHASE 0
#endif

constexpr int D = 1024, BATCH = 32, T = 2048, NTOK = BATCH * T, DEPTH = 4;
constexpr int NSA_IN = 2608, NSA_LD = 2816, ML_IN = 3080, ML_LD = 3328, HG_LD = 4096;
constexpr int NEXP = 32, TOPK = 4, DFF = 1024;
constexpr int MOE_ROWS = 270336;
constexpr float LN_EPS = 1e-5f, RMS_EPS = 1e-6f;
constexpr float DN_ALPHA = 1.681792830507429f;
constexpr int NCMP = 127;

constexpr size_t MiB = 1u << 20;
constexpr size_t OFF_CTL = 0, CTL_ZERO_BYTES = 1 * MiB;
constexpr size_t OFF_TAB = 1 * MiB;
constexpr size_t OFF_TOKE = 2 * MiB;
constexpr size_t OFF_TOKG = 3 * MiB;
constexpr size_t OFF_TOKP = 4 * MiB;
constexpr size_t OFF_ROWT = 5 * MiB;
constexpr size_t OFF_ROWG = 7 * MiB;
constexpr size_t OFF_KC = 9 * MiB;
constexpr size_t OFF_HC = 17 * MiB;
constexpr size_t OFF_W_NSAIN = 33 * MiB;
constexpr size_t OFF_W_NSAOUT = 44 * MiB;
constexpr size_t OFF_W_MLIN = 48 * MiB;
constexpr size_t OFF_W_MLOUT = 55 * MiB;
constexpr size_t OFF_W_HGIN = 57 * MiB;
constexpr size_t OFF_W_HGOUT = 65 * MiB;
constexpr size_t OFF_W_CMP2 = 71 * MiB;
constexpr size_t OFF_W_CMP1 = 67 * MiB;
constexpr size_t OFF_W_GU = 72 * MiB;
constexpr size_t OFF_W_DN = 584 * MiB;
constexpr size_t OFF_XA = 840 * MiB;
constexpr size_t OFF_XN = 1096 * MiB;
constexpr size_t OFF_PROJ = 1224 * MiB;
constexpr size_t OFF_ATT = 1740 * MiB;
constexpr size_t OFF_HM = 1868 * MiB;
constexpr size_t OFF_H = 1996 * MiB;
constexpr size_t OFF_Y = 2526 * MiB;
constexpr size_t WS_END = 3056 * MiB;
constexpr int TAB_CMPB = 0;
constexpr int TAB_LB = 4096;
constexpr int TAB_RWT = 8192;
constexpr int CW_BAR = 4096;
constexpr int CW_CNT = 16384;
constexpr int CW_CUR = 16384 + 1024;

constexpr int RING_BYTES = 131072;
constexpr int LDSCTL_OFF = 155648;
constexpr int LDS_BYTES = 156672;

__device__ __forceinline__ float bf2f(bf16_t b) { return __uint_as_float(((unsigned)b) << 16); }
typedef float f32x2_t_ __attribute__((ext_vector_type(2))); typedef __bf16 bf16x2_t_ __attribute__((ext_vector_type(2)));
__device__ __forceinline__ unsigned pk2(float lo, float hi) { const f32x2_t_ v = {lo, hi}; const bf16x2_t_ b = __builtin_convertvector(v, bf16x2_t_); return __builtin_bit_cast(unsigned, b); }
__device__ __forceinline__ unsigned f2bf(float f) { return pk2(f, f) & 0xffffu; }
template <int CTRL> __device__ __forceinline__ float dppf(float v) { return __builtin_bit_cast(float, __builtin_amdgcn_update_dpp(0, __builtin_bit_cast(int, v), CTRL, 0xF, 0xF, true)); }
__device__ __forceinline__ float rdl(float v, int l) { return __builtin_bit_cast(float, __builtin_amdgcn_readlane(__builtin_bit_cast(int, v), l)); }
__device__ __forceinline__ float wave_sum(float v) {
    v += dppf<0xB1>(v); v += dppf<0x4E>(v); v += dppf<0x141>(v); v += dppf<0x140>(v);
    return (rdl(v, 0) + rdl(v, 16)) + (rdl(v, 32) + rdl(v, 48));
}
__device__ __forceinline__ float wave_max(float v) {
    v = fmaxf(v, dppf<0xB1>(v)); v = fmaxf(v, dppf<0x4E>(v)); v = fmaxf(v, dppf<0x141>(v)); v = fmaxf(v, dppf<0x140>(v));
    return fmaxf(fmaxf(rdl(v, 0), rdl(v, 16)), fmaxf(rdl(v, 32), rdl(v, 48)));
}
__device__ __forceinline__ float sigmoidf_(float x) { return __builtin_amdgcn_rcpf(1.0f + __expf(-x)); }

#define XB_TMO      128
#define XB_XCNT(j)  (256  + 64 * (j))
#define XB_XSUB(j)  (1280 + 64 * (j))
#define XB_XGEN(j)  (2304 + 64 * (j))
#define XB_TOP      3328
#define XB_TOPGEN   3392
#define XCD_BAR_WORDS 3456
#define XB_SPIN_CAP (1u << 20)

__device__ __forceinline__ unsigned xb_ld(unsigned* p)              { return __hip_atomic_load(p, __ATOMIC_RELAXED, __HIP_MEMORY_SCOPE_AGENT); }
__device__ __forceinline__ unsigned xb_add(unsigned* p, unsigned v) { return __hip_atomic_fetch_add(p, v, __ATOMIC_RELAXED, __HIP_MEMORY_SCOPE_AGENT); }
__device__ __forceinline__ unsigned xb_xcc_id() { return (unsigned)__builtin_amdgcn_s_getreg((3 << 11) | 20) & 0xFu; }
#define XB_SPIN(cond, bar) do { unsigned _sp = 0; while (cond) { __builtin_amdgcn_s_sleep(1); \
    if ((++_sp & 255u) == 0u) { if (xb_ld(&(bar)[XB_TMO])) break; if (_sp > XB_SPIN_CAP) { atomicAdd(&(bar)[XB_TMO], 1u); break; } } } } while (0)

struct XcdBarrier { unsigned* bar; unsigned x; volatile LAS unsigned* st; };

__device__ __forceinline__ XcdBarrier xcd_barrier_post(unsigned* bar, volatile LAS unsigned* st) {
    XcdBarrier b; b.bar = bar; b.x = xb_xcc_id(); b.st = st;
    if (threadIdx.x == 0) (void)xb_add(&bar[XB_XCNT(b.x)], 1u);
    return b;
}
__device__ __forceinline__ void xcd_barrier_complete(unsigned* bar, unsigned x, unsigned& nloc, unsigned& nx) {
    const unsigned G = gridDim.x * gridDim.y * gridDim.z;
    unsigned sum, cnt, mine, sp = 0u;
    for (;;) {
        sum = 0u; cnt = 0u; mine = 0u;
#pragma unroll
        for (unsigned j = 0; j < 16; ++j) { const unsigned c = xb_ld(&bar[XB_XCNT(j)]); sum += c; cnt += (c > 0u) ? 1u : 0u; }
        mine = xb_ld(&bar[XB_XCNT(x)]);
        if (sum == G) break;
        __builtin_amdgcn_s_sleep(1);
        if ((++sp & 255u) == 0u) { if (xb_ld(&bar[XB_TMO])) break; if (sp > XB_SPIN_CAP) { atomicAdd(&bar[XB_TMO], 1u); break; } }
    }
    nloc = mine > 0u ? mine : 1u; nx = cnt > 0u ? cnt : 1u;
}
__device__ __forceinline__ void xcd_barrier(const XcdBarrier& b) {
    asm volatile("s_waitcnt vmcnt(0)" ::: "memory");
    __syncthreads();
    if (threadIdx.x == 0) {
        unsigned* bar = b.bar; asm volatile("; barrier words" : "+s"(bar));
        __builtin_amdgcn_s_waitcnt(0);
        unsigned nloc = b.st[0], nx = b.st[1];
        if (nloc == 0u) { xcd_barrier_complete(bar, b.x, nloc, nx); b.st[0] = nloc; b.st[1] = nx; }
        const unsigned old = xb_add(&bar[XB_XSUB(b.x)], 1u);
        const unsigned gen = old / nloc;
        if (old + 1u == (gen + 1u) * nloc) {
            __builtin_amdgcn_fence(__ATOMIC_RELEASE, "agent");
            asm volatile("s_waitcnt vmcnt(0)" ::: "memory");
            const unsigned og = xb_add(&bar[XB_TOP], 1u);
            const unsigned tg = og / nx;
            if (og + 1u == (tg + 1u) * nx) xb_add(&bar[XB_TOPGEN], 1u);
            else XB_SPIN(xb_ld(&bar[XB_TOPGEN]) == tg, bar);
            __builtin_amdgcn_fence(__ATOMIC_ACQUIRE, "agent");
            xb_add(&bar[XB_XGEN(b.x)], 1u);
            asm volatile("s_waitcnt vmcnt(0)" ::: "memory");
        } else {
            XB_SPIN(xb_ld(&bar[XB_XGEN(b.x)]) == gen, bar);
            __builtin_amdgcn_fence(__ATOMIC_ACQUIRE, "agent");
            asm volatile("s_waitcnt vmcnt(0)" ::: "memory");
        }
    }
    __syncthreads();
}

namespace pg8 {
constexpr int BM = 256, BK = 64, HALF = 128, HTB = HALF * BK * 2, STAGE_BYTES = 8 * HTB, NXCD = 8, WGM = 8;
__host__ __device__ __forceinline__ int lds_byte(int r, int c) { const int st = (r >> 4) * 2 + (c >> 5), rr = r & 15, cc = c & 31, ob = rr * 64 + cc * 2; return st * 1024 + (ob ^ (((ob >> 9) & 1) << 5)); }
__host__ __device__ __forceinline__ void stage_rc(int b, int& R, int& C) { const int st = b / 1024, sb = b % 1024, swz = sb ^ (((sb >> 9) & 1) << 5); R = (st >> 1) * 16 + swz / 64; C = (st & 1) * 32 + (swz % 64) / 2; }
__host__ __device__ __forceinline__ int perm32(int rho) { const int n = rho >> 4, i = rho & 15; return 8 * (i >> 2) + 4 * n + (i & 3); }

struct Unit { int pm, pn, e; };

struct StaticOrder {
    int nM, nN, nwg, G, c, wgm = WGM;
    __device__ __forceinline__ void init(int nM_, int nN_, int G_, int c_) { nM = nM_; nN = nN_; nwg = nM * nN; G = G_; c = c_; }
    __device__ __forceinline__ bool next(int i, Unit& u) const {
        const long L = (long)i * G + c; if (L >= nwg) return false;
        int wgid = (int)L; { const int q = nwg / NXCD, r = nwg % NXCD, xcd = wgid % NXCD, off = wgid / NXCD; wgid = (xcd < r ? xcd * (q + 1) : r * (q + 1) + (xcd - r) * q) + off; }
        const int nig = wgm * nN, gid = wgid / nig, fm = gid * wgm, gsz = (nM - fm) < wgm ? (nM - fm) : wgm;
        u.pm = fm + ((wgid % nig) % gsz); u.pn = (wgid % nig) / gsz; u.e = 0; return true;
    }
};
struct MoeOrder : StaticOrder {
    const LAS int* pend;
    __device__ __forceinline__ bool next(int i, Unit& u) const {
        if (!StaticOrder::next(i, u)) return false;
        int e = 0;
#pragma unroll 8
        for (int j = 0; j < 31; ++j) e += (pend[j] <= u.pm) ? 1 : 0;
        u.e = __builtin_amdgcn_readfirstlane(e); return true;
    }
};
struct CmpOrder {
    int G, c;
    __device__ __forceinline__ bool next(int i, Unit& u) const { const int L = i * G + c; if (L >= 128) return false; u.e = L >> 6; u.pm = L & 63; u.pn = 0; return true; }
};

__device__ __forceinline__ unsigned cvt_pk_bf16(float lo, float hi) { const f32x2_t_ v = {lo, hi}; const bf16x2_t_ b = __builtin_convertvector(v, bf16x2_t_); return __builtin_bit_cast(unsigned, b); }

struct APlain {
    static constexpr bool GATHER = false;
    const bf16_t* A; int lda;
    __device__ __forceinline__ int kstep() const { return BK * 2; }
    __device__ __forceinline__ const char* base(const Unit& u) const { return (const char*)A + (size_t)u.pm * BM * lda * 2; }
    __device__ __forceinline__ void offs(const Unit&, const int (&R)[2], const int (&C)[2], unsigned (&vo)[2][2]) const {
#pragma unroll
        for (int h = 0; h < 2; ++h)
#pragma unroll
            for (int i = 0; i < 2; ++i) vo[h][i] = (unsigned)((h * HALF + R[i]) * lda + C[i]) * 2u;
    }
};
struct AGather {
    static constexpr bool GATHER = true;
    const bf16_t* A; int lda; const int* idx;
    __device__ __forceinline__ int kstep() const { return BK * 2; }
    __device__ __forceinline__ const char* base(const Unit&) const { return (const char*)A; }
    __device__ __forceinline__ void offs(const Unit& u, const int (&R)[2], const int (&C)[2], unsigned (&vo)[2][2]) const {
#pragma unroll
        for (int h = 0; h < 2; ++h)
#pragma unroll
            for (int i = 0; i < 2; ++i) { const int row = idx[u.pm * BM + h * HALF + R[i]]; vo[h][i] = (unsigned)(row * lda + C[i]) * 2u; }
    }
};
struct ACmp {
    static constexpr bool GATHER = false;
    const bf16_t* P; int ld; int col0;
    __device__ __forceinline__ int kstep() const { return ld * 2; }
    __device__ __forceinline__ const char* base(const Unit& u) const { const int b = u.pm >> 1, g0 = (u.pm & 1) * 2; return (const char*)P + ((size_t)b * T * ld + col0 + u.e * 256 + g0 * 64) * 2; }
    __device__ __forceinline__ void offs(const Unit&, const int (&R)[2], const int (&C)[2], unsigned (&vo)[2][2]) const {
#pragma unroll
        for (int h = 0; h < 2; ++h)
#pragma unroll
            for (int i = 0; i < 2; ++i) vo[h][i] = (unsigned)(16 * R[i] * ld + h * 64 + C[i]) * 2u;
    }
};
struct BPlain { const bf16_t* Bt; int K; __device__ __forceinline__ const char* base(const Unit& u) const { return (const char*)Bt + (size_t)u.pn * BM * K * 2; } };
struct BGroup { const bf16_t* Bt; int K; size_t gstride;   __device__ __forceinline__ const char* base(const Unit& u) const { return (const char*)Bt + ((size_t)u.e * gstride + (size_t)u.pn * BM * K) * 2; } };

template <class Epi, class Sched, class ASrc, class BSrc, bool ALIGN_EPI = true, bool SP2 = true>
__device__ __forceinline__ void gemm_phase(LAS unsigned char* lds, const int K, const ASrc& AS, const BSrc& BS, const Sched& S, const Epi& E) {
    int tid = threadIdx.x; asm volatile("; phase-local tid" : "+v"(tid));
    const int wid = __builtin_amdgcn_readfirstlane(tid >> 6), lane = tid & 63, wr = wid >> 2, wc = wid & 3, fr = lane & 15, fq = lane >> 4;
    const int nt = K / BK;
    int Rs[2], Cs[2]; unsigned voffB[2];
#pragma unroll
    for (int i = 0; i < 2; ++i) { int R, C; stage_rc(tid * 16 + i * 8192, R, C); Rs[i] = R; Cs[i] = C; const int Rb = Epi::PERM ? ((R & ~31) + perm32(R & 31)) : R; voffB[i] = (unsigned)(Rb * K + C) * 2u; }
    const size_t kstepB = (size_t)(BK * 2), hstepB = (size_t)HALF * K * 2;
    const size_t kstepA = (size_t)AS.kstep();
    const unsigned ldsw = (unsigned)wid * 1024u;
    const int aoff = lds_byte(wr * 64 + fr, fq * 8), boff = lds_byte(wc * 32 + fr, fq * 8);
#define PG8_SA(b, h) (((b) * 2 + (h)) * HTB)
#define PG8_SB(b, h) ((4 + (b) * 2 + (h)) * HTB)
#define PG8_STAGEB(bufoff, gbase) do { _Pragma("unroll") for (int _i = 0; _i < 2; ++_i) \
        __builtin_amdgcn_global_load_lds((const unsigned*)((const char*)(gbase) + voffB[_i]), (LAS unsigned*)(lds + (bufoff) + ldsw + _i * 8192), 16, 0, 0); } while (0)
#define PG8_STAGEA(bufoff, gbase, o0, o1) do { \
        __builtin_amdgcn_global_load_lds((const unsigned*)((const char*)(gbase) + (o0)), (LAS unsigned*)(lds + (bufoff) + ldsw), 16, 0, 0); \
        __builtin_amdgcn_global_load_lds((const unsigned*)((const char*)(gbase) + (o1)), (LAS unsigned*)(lds + (bufoff) + ldsw + 8192), 16, 0, 0); } while (0)
#define PG8_LDA(dst, b, h) do { _Pragma("unroll") for (int m = 0; m < 4; ++m) _Pragma("unroll") for (int k = 0; k < 2; ++k) dst[m][k] = *(const LAS bf16x8*)(lds + PG8_SA(b, h) + aoff + m * 2048 + k * 1024); } while (0)
#define PG8_LDB(dst, b, h) do { _Pragma("unroll") for (int n = 0; n < 2; ++n) _Pragma("unroll") for (int k = 0; k < 2; ++k) dst[n][k] = *(const LAS bf16x8*)(lds + PG8_SB(b, h) + boff + n * 2048 + k * 1024); } while (0)
#define PG8_MMA(ai, bj, At, Bt) do { __builtin_amdgcn_s_setprio(1); _Pragma("unroll") for (int m = 0; m < 4; ++m) _Pragma("unroll") for (int n = 0; n < 2; ++n) _Pragma("unroll") for (int k = 0; k < 2; ++k) \
        acc[ai][bj][m][n] = __builtin_amdgcn_mfma_f32_16x16x32_bf16(Bt[n][k], At[m][k], acc[ai][bj][m][n], 0, 0, 0); __builtin_amdgcn_s_setprio(0); } while (0)
#define PG8_WAIT_V(n) asm volatile("s_waitcnt vmcnt(" #n ")" ::: "memory")
#define PG8_WAIT_L(n) asm volatile("s_waitcnt lgkmcnt(" #n ")" ::: "memory")
#define PG8_BAR __builtin_amdgcn_s_barrier()
#define PG8_SCHED __builtin_amdgcn_sched_barrier(0)
    Unit cur, nxt; int ui = 0;
    if (!S.next(0, cur)) return;
    f32x4 acc[2][2][4][2];
    E.init(acc, cur, wc, fq);
    bf16x8 At[4][2], B0[2][2], B1[2][2];
    unsigned vC[2][2];
    AS.offs(cur, Rs, Cs, vC);
    unsigned x00 = vC[0][0], x01 = vC[0][1], x10 = vC[1][0], x11 = vC[1][1];
    const char* cA = AS.base(cur); const char* cB = BS.base(cur);
    if constexpr (SP2) {
        PG8_STAGEB(PG8_SB(0, 0), cB); PG8_STAGEB(PG8_SB(0, 1), cB + hstepB); PG8_STAGEA(PG8_SA(0, 0), cA, vC[0][0], vC[0][1]); PG8_STAGEA(PG8_SA(0, 1), cA, vC[1][0], vC[1][1]);
        if (wr == 1) PG8_BAR;
        PG8_WAIT_V(2); PG8_BAR;
        PG8_STAGEB(PG8_SB(1, 0), cB + kstepB); PG8_STAGEA(PG8_SA(1, 0), cA + kstepA, vC[0][0], vC[0][1]); PG8_STAGEB(PG8_SB(1, 1), cB + hstepB + kstepB);
        PG8_WAIT_V(6); PG8_BAR;
    } else {
        PG8_STAGEB(PG8_SB(0, 0), cB); PG8_STAGEA(PG8_SA(0, 0), cA, vC[0][0], vC[0][1]); PG8_STAGEB(PG8_SB(0, 1), cB + hstepB); PG8_STAGEA(PG8_SA(0, 1), cA, vC[1][0], vC[1][1]);
        if (wr == 1) PG8_BAR;
        PG8_WAIT_V(4); PG8_BAR;
        PG8_STAGEB(PG8_SB(1, 0), cB + kstepB); PG8_STAGEA(PG8_SA(1, 0), cA + kstepA, vC[0][0], vC[0][1]); PG8_STAGEB(PG8_SB(1, 1), cB + hstepB + kstepB);
        PG8_WAIT_V(6); PG8_BAR;
    }
    for (;;) {
        const bool has_next = S.next(ui + 1, nxt);
        const char* nA = has_next ? AS.base(nxt) : cA; const char* nB = has_next ? BS.base(nxt) : cB;
        for (int t = 0; t < nt; t += 2) {
            const bool last = (t == nt - 2);
            const char* a1 = cA + (size_t)(t + 1) * kstepA;
            const char* a2 = last ? nA : cA + (size_t)(t + 2) * kstepA; const char* b2 = last ? nB : cB + (size_t)(t + 2) * kstepB;
            const char* a3 = a2 + kstepA; const char* b3 = b2 + kstepB;
            if constexpr (ASrc::GATHER) { if (last && has_next) { unsigned vn[2][2]; AS.offs(nxt, Rs, Cs, vn); x00 = vn[0][0]; x01 = vn[0][1]; x10 = vn[1][0]; x11 = vn[1][1]; } }
            if constexpr (SP2) {
            PG8_LDB(B0, 0, 0); PG8_LDB(B1, 0, 1); PG8_SCHED; PG8_LDA(At, 0, 0); PG8_STAGEA(PG8_SA(1, 1), a1, vC[1][0], vC[1][1]);
            PG8_WAIT_V(8); PG8_WAIT_L(0); PG8_BAR; PG8_MMA(0, 0, At, B0); PG8_MMA(0, 1, At, B1); PG8_BAR; PG8_SCHED;
            PG8_LDA(At, 0, 1); PG8_STAGEB(PG8_SB(0, 0), b2); PG8_STAGEB(PG8_SB(0, 1), b2 + hstepB); PG8_STAGEA(PG8_SA(0, 0), a2, x00, x01);
            PG8_WAIT_V(8); PG8_WAIT_L(0); PG8_BAR; PG8_MMA(1, 0, At, B0); PG8_MMA(1, 1, At, B1); PG8_BAR; PG8_SCHED;
            PG8_LDB(B0, 1, 0); PG8_LDB(B1, 1, 1); PG8_SCHED; PG8_LDA(At, 1, 0); PG8_STAGEA(PG8_SA(0, 1), a2, x10, x11);
            PG8_WAIT_V(8); PG8_WAIT_L(0); PG8_BAR; PG8_MMA(0, 0, At, B0); PG8_MMA(0, 1, At, B1); PG8_BAR; PG8_SCHED;
            PG8_LDA(At, 1, 1); PG8_STAGEB(PG8_SB(1, 0), b3); PG8_STAGEB(PG8_SB(1, 1), b3 + hstepB); PG8_STAGEA(PG8_SA(1, 0), a3, x00, x01);
            PG8_WAIT_V(8); PG8_WAIT_L(0); PG8_BAR; PG8_MMA(1, 0, At, B0); PG8_MMA(1, 1, At, B1); PG8_BAR; PG8_SCHED;
            } else {
            PG8_LDB(B0, 0, 0); PG8_SCHED; PG8_LDA(At, 0, 0); PG8_STAGEA(PG8_SA(1, 1), a1, vC[1][0], vC[1][1]);
            PG8_WAIT_L(8); PG8_BAR; PG8_WAIT_L(0); PG8_MMA(0, 0, At, B0); PG8_BAR; PG8_SCHED;
            PG8_LDB(B1, 0, 1); PG8_STAGEB(PG8_SB(0, 0), b2);
            PG8_BAR; PG8_WAIT_L(0); PG8_MMA(0, 1, At, B1); PG8_BAR;
            PG8_LDA(At, 0, 1); PG8_STAGEA(PG8_SA(0, 0), a2, x00, x01);
            PG8_BAR; PG8_WAIT_L(0); PG8_MMA(1, 0, At, B0); PG8_BAR; PG8_SCHED;
            PG8_STAGEB(PG8_SB(0, 1), b2 + hstepB);
            PG8_WAIT_V(6); PG8_BAR; PG8_MMA(1, 1, At, B1); PG8_BAR;
            PG8_LDB(B0, 1, 0); PG8_SCHED; PG8_LDA(At, 1, 0); PG8_STAGEA(PG8_SA(0, 1), a2, x10, x11);
            PG8_WAIT_L(8); PG8_BAR; PG8_WAIT_L(0); PG8_MMA(0, 0, At, B0); PG8_BAR; PG8_SCHED;
            PG8_LDB(B1, 1, 1); PG8_STAGEB(PG8_SB(1, 0), b3);
            PG8_BAR; PG8_WAIT_L(0); PG8_MMA(0, 1, At, B1); PG8_BAR;
            PG8_LDA(At, 1, 1); PG8_STAGEA(PG8_SA(1, 0), a3, x00, x01);
            PG8_BAR; PG8_WAIT_L(0); PG8_MMA(1, 0, At, B0); PG8_BAR; PG8_SCHED;
            PG8_STAGEB(PG8_SB(1, 1), b3 + hstepB);
            PG8_WAIT_V(6); PG8_BAR; PG8_MMA(1, 1, At, B1); PG8_BAR;
            }
        }
        if constexpr (ALIGN_EPI) { if (wr == 0) PG8_BAR; }
        E(acc, cur, wr, wc, fr, fq);
        if (!has_next) break;
        E.init(acc, nxt, wc, fq);
        cur = nxt; cA = nA; cB = nB; ++ui;
        if constexpr (ASrc::GATHER) { vC[0][0] = x00; vC[0][1] = x01; vC[1][0] = x10; vC[1][1] = x11; }
        if constexpr (ALIGN_EPI) { if (wr == 1) PG8_BAR; }
    }
    PG8_WAIT_V(0);
    if constexpr (!ALIGN_EPI) { if (wr == 0) PG8_BAR; }
    PG8_BAR;
#undef PG8_SA
#undef PG8_SB
#undef PG8_STAGEA
#undef PG8_STAGEB
#undef PG8_LDA
#undef PG8_LDB
#undef PG8_MMA
#undef PG8_WAIT_V
#undef PG8_WAIT_L
#undef PG8_BAR
#undef PG8_SCHED
}
}
namespace pg8 {
__device__ __forceinline__ float gelu_tanh(float x) {
    const float u = 0.7978845608028654f * (x + 0.044715f * x * x * x);
    const float e = __expf(-2.0f * fabsf(u)); float th = (1.0f - e) * __builtin_amdgcn_rcpf(1.0f + e); th = u < 0.f ? -th : th;
    return 0.5f * x * (1.0f + th);
}
struct EpiStore {
    static constexpr bool PERM = true;
    bf16_t* O; int ldc;
    __device__ __forceinline__ void init(f32x4 (&acc)[2][2][4][2], const Unit&, int, int) const {
#pragma unroll
        for (int a = 0; a < 2; ++a)
#pragma unroll
            for (int b = 0; b < 2; ++b)
#pragma unroll
                for (int m = 0; m < 4; ++m)
#pragma unroll
                    for (int n = 0; n < 2; ++n) acc[a][b][m][n] = (f32x4){0.f, 0.f, 0.f, 0.f};
    }
    __device__ __forceinline__ void operator()(const f32x4 (&acc)[2][2][4][2], const Unit& u, int wr, int wc, int fr, int fq) const {
        const int row0 = u.pm * BM + wr * 64 + fr, col0 = u.pn * BM + wc * 32 + 8 * fq;
#pragma unroll
        for (int ai = 0; ai < 2; ++ai)
#pragma unroll
            for (int m = 0; m < 4; ++m) { bf16_t* rowp = O + (size_t)(row0 + ai * HALF + m * 16) * ldc + col0;
#pragma unroll
                for (int bj = 0; bj < 2; ++bj) { const f32x4 v0 = acc[ai][bj][m][0], v1 = acc[ai][bj][m][1];
                    u32x4 w; w.x = cvt_pk_bf16(v0[0], v0[1]); w.y = cvt_pk_bf16(v0[2], v0[3]); w.z = cvt_pk_bf16(v1[0], v1[1]); w.w = cvt_pk_bf16(v1[2], v1[3]);
                    *(u32x4*)(rowp + bj * HALF) = w; } }
    }
};
struct EpiCmpGelu {
    static constexpr bool PERM = true;
    bf16_t* O; const float* bias;
    __device__ __forceinline__ void init(f32x4 (&acc)[2][2][4][2], const Unit&, int, int) const {
#pragma unroll
        for (int a = 0; a < 2; ++a)
#pragma unroll
            for (int b = 0; b < 2; ++b)
#pragma unroll
                for (int m = 0; m < 4; ++m)
#pragma unroll
                    for (int n = 0; n < 2; ++n) acc[a][b][m][n] = (f32x4){0.f, 0.f, 0.f, 0.f};
    }
    __device__ __forceinline__ void operator()(const f32x4 (&acc)[2][2][4][2], const Unit& u, int wr, int wc, int fr, int fq) const {
        const int row0 = u.pm * BM + wr * 64 + fr, col0 = wc * 32 + 8 * fq;
        bf16_t* Oj = O + (size_t)u.e * 16384 * 256; const float* bj_ = bias + u.e * 256;
        f32x4 bv[2][2];
#pragma unroll
        for (int bj = 0; bj < 2; ++bj)
#pragma unroll
            for (int n = 0; n < 2; ++n) bv[bj][n] = *(const f32x4*)(bj_ + col0 + bj * HALF + 4 * n);
#pragma unroll
        for (int ai = 0; ai < 2; ++ai)
#pragma unroll
            for (int m = 0; m < 4; ++m) { bf16_t* rowp = Oj + (size_t)(row0 + ai * HALF + m * 16) * 256 + col0;
#pragma unroll
                for (int bj = 0; bj < 2; ++bj) { f32x4 v0 = acc[ai][bj][m][0] + bv[bj][0], v1 = acc[ai][bj][m][1] + bv[bj][1];
#pragma unroll
                    for (int j = 0; j < 4; ++j) { v0[j] = gelu_tanh(v0[j]); v1[j] = gelu_tanh(v1[j]); }
                    u32x4 w; w.x = cvt_pk_bf16(v0[0], v0[1]); w.y = cvt_pk_bf16(v0[2], v0[3]); w.z = cvt_pk_bf16(v1[0], v1[1]); w.w = cvt_pk_bf16(v1[2], v1[3]);
                    *(u32x4*)(rowp + bj * HALF) = w; } }
    }
};
struct EpiSwiglu {
    static constexpr bool PERM = true;
    bf16_t* H; const float* bgu;
    __device__ __forceinline__ void init(f32x4 (&acc)[2][2][4][2], const Unit& u, int wc, int fq) const {
        const float* bg = bgu + (size_t)u.e * 2048 + u.pn * HALF + wc * 32 + 8 * fq;
#pragma unroll
        for (int n = 0; n < 2; ++n) { const f32x4 g = *(const f32x4*)(bg + 4 * n), up = *(const f32x4*)(bg + 1024 + 4 * n);
#pragma unroll
            for (int a = 0; a < 2; ++a)
#pragma unroll
                for (int m = 0; m < 4; ++m) { acc[a][0][m][n] = g; acc[a][1][m][n] = up; } }
    }
    __device__ __forceinline__ void operator()(const f32x4 (&acc)[2][2][4][2], const Unit& u, int wr, int wc, int fr, int fq) const {
        const int row0 = u.pm * BM + wr * 64 + fr, col0 = u.pn * HALF + wc * 32 + 8 * fq;
#pragma unroll
        for (int ai = 0; ai < 2; ++ai)
#pragma unroll
            for (int m = 0; m < 4; ++m) { bf16_t* rowp = H + (size_t)(row0 + ai * HALF + m * 16) * DFF + col0;
                unsigned wv[4];
#pragma unroll
                for (int n = 0; n < 2; ++n) { const f32x4 g = acc[ai][0][m][n], up = acc[ai][1][m][n];
#pragma unroll
                    for (int j = 0; j < 2; ++j) {
                        const f32x2 gg = {__builtin_amdgcn_fmed3f(g[2 * j], -3.0e38f, 7.0f), __builtin_amdgcn_fmed3f(g[2 * j + 1], -3.0e38f, 7.0f)};
                        const f32x2 uu = {__builtin_amdgcn_fmed3f(up[2 * j], -7.0f, 7.0f), __builtin_amdgcn_fmed3f(up[2 * j + 1], -7.0f, 7.0f)};
                        const f32x2 t = gg * -2.4554669595930156f;
                        f32x2 d = {__builtin_amdgcn_exp2f(t.x), __builtin_amdgcn_exp2f(t.y)}; d = d + 1.0f;
                        const f32x2 rr = {__builtin_amdgcn_rcpf(d.x), __builtin_amdgcn_rcpf(d.y)};
                        const f32x2 o = (uu + 1.0f) * gg * rr;
                        wv[2 * n + j] = cvt_pk_bf16(o.x, o.y); } }
                u32x4 w; w.x = wv[0]; w.y = wv[1]; w.z = wv[2]; w.w = wv[3];
                *(u32x4*)rowp = w; }
    }
};
struct EpiDown {
    static constexpr bool PERM = true;
    bf16_t* Y; const float* bd; const float* rgate;
    __device__ __forceinline__ void init(f32x4 (&acc)[2][2][4][2], const Unit& u, int wc, int fq) const {
        const float* b = bd + (size_t)u.e * 1024 + u.pn * BM + wc * 32 + 8 * fq;
#pragma unroll
        for (int bj = 0; bj < 2; ++bj)
#pragma unroll
            for (int n = 0; n < 2; ++n) { const f32x4 bv = *(const f32x4*)(b + bj * HALF + 4 * n);
#pragma unroll
                for (int a = 0; a < 2; ++a)
#pragma unroll
                    for (int m = 0; m < 4; ++m) acc[a][bj][m][n] = bv; }
    }
    __device__ __forceinline__ void operator()(const f32x4 (&acc)[2][2][4][2], const Unit& u, int wr, int wc, int fr, int fq) const {
        const int row0 = u.pm * BM + wr * 64 + fr, col0 = u.pn * BM + wc * 32 + 8 * fq;
#pragma unroll
        for (int ai = 0; ai < 2; ++ai)
#pragma unroll
            for (int m = 0; m < 4; ++m) { const int row = row0 + ai * HALF + m * 16; const float gt = rgate[row]; bf16_t* rowp = Y + (size_t)row * D + col0;
#pragma unroll
                for (int bj = 0; bj < 2; ++bj) { const f32x4 v0 = acc[ai][bj][m][0] * gt, v1 = acc[ai][bj][m][1] * gt;
                    u32x4 w; w.x = cvt_pk_bf16(v0[0], v0[1]); w.y = cvt_pk_bf16(v0[2], v0[3]); w.z = cvt_pk_bf16(v1[0], v1[1]); w.w = cvt_pk_bf16(v1[2], v1[3]);
                    *(u32x4*)(rowp + bj * HALF) = w; } }
    }
};
}
struct Frame {
    LAS unsigned char* lds;
    volatile LAS unsigned* LC;
    unsigned* ctl;
    unsigned char* ws;
    int tid, lane, wave, G, bx;
    float* out;
};
__device__ __forceinline__ size_t opaque_off(size_t o) { asm volatile("; ws offset" : "+s"(o)); return o; }
#define WSP(T_, off) ((T_*)(F.ws + opaque_off(off)))
__device__ __forceinline__ const float* inptr(const Frame& F, int i) {
    const unsigned lo = __builtin_amdgcn_readfirstlane(F.LC[128 + 2 * i]), hi = __builtin_amdgcn_readfirstlane(F.LC[129 + 2 * i]);
    const float* p = (const float*)(const GAS float*)(((unsigned long long)hi << 32) | (unsigned long long)lo);
    return p;
}
enum { I_X = 0, I_LN_G, I_LN_B, I_NSA_W_IN, I_NSA_CMP_POS, I_NSA_CMP_W1, I_NSA_CMP_B1, I_NSA_CMP_W2, I_NSA_CMP_B2, I_NSA_GATE_B, I_NSA_W_OUT,
       I_ML_W_IN, I_ML_CONV_W, I_ML_CONV_B, I_ML_GATE_B, I_ML_NORM_G, I_ML_W_OUT, I_HG_W_IN, I_HG_LOWER, I_HG_NORM_G, I_HG_W_OUT,
       I_ROUTER_W, I_ROUTER_B, I_MOE_W_GU, I_MOE_B_GU, I_MOE_W_DOWN, I_MOE_B_DOWN };

__device__ __forceinline__ void tr_load(f32x4 (&v)[16], const float* W, int N, int nvalid, int k0, int n0, int lane) {
    const int nn = n0 + 4 * (lane & 15); const bool ok = nn < nvalid; const int kr = lane >> 4;
#pragma unroll
    for (int i = 0; i < 16; ++i) v[i] = ok ? *(const f32x4*)(W + (size_t)(k0 + 4 * i + kr) * N + nn) : (f32x4){0.f, 0.f, 0.f, 0.f};
}
__device__ __forceinline__ void tr_store(const f32x4 (&v)[16], int K, bf16_t* WT, int drow, int k0, LAS float* scr, int lane) {
    const int kr = lane >> 4;
#pragma unroll
    for (int i = 0; i < 16; ++i) { LAS float* d = scr + (4 * i + kr) * 65 + 4 * (lane & 15); d[0] = v[i][0]; d[1] = v[i][1]; d[2] = v[i][2]; d[3] = v[i][3]; }
    LDS_WAIT();
    const int c = lane & 7;
#pragma unroll
    for (int j = 0; j < 8; ++j) { const int n = (lane >> 3) + 8 * j; const LAS float* s = scr + (8 * c) * 65 + n;
        u32x4 o; o.x = pk2(s[0 * 65], s[1 * 65]); o.y = pk2(s[2 * 65], s[3 * 65]); o.z = pk2(s[4 * 65], s[5 * 65]); o.w = pk2(s[6 * 65], s[7 * 65]);
        *(u32x4*)(WT + (size_t)(drow + n) * K + k0 + 8 * c) = o; }
    LDS_WAIT();
}
__device__ __forceinline__ void tr_class(Frame& F, const float* W, int nmat, int K, int N, int Npad, bf16_t* WT, bool gu, LAS float* scr, int gw, int NGW) {
    const int nblk = Npad / 64, per = (K / 64) * nblk; const long total = (long)nmat * per;
    f32x4 vbuf[16];
    long it = gw;
    if (it < total) { const int mat = (int)(it / per), r = (int)(it % per), kb = r / nblk, nb = r % nblk; tr_load(vbuf, W + (size_t)mat * K * N, N, N, kb * 64, nb * 64, F.lane); }
#pragma unroll 1
    for (; it < total; it += NGW) {
        const int mat = (int)(it / per), r = (int)(it % per), kb = r / nblk, nb = r % nblk, n0 = nb * 64;
        int drow = n0;
        if (gu) drow = (n0 < 1024) ? ((n0 >> 7) * 256 + (n0 & 127)) : ((((n0 - 1024) >> 7) * 256) + 128 + ((n0 - 1024) & 127));
        f32x4 cur[16];
#pragma unroll
        for (int i = 0; i < 16; ++i) cur[i] = vbuf[i];
        const long nx = it + NGW;
        if (nx < total) { const int mat2 = (int)(nx / per), r2 = (int)(nx % per), kb2 = r2 / nblk, nb2 = r2 % nblk; tr_load(vbuf, W + (size_t)mat2 * K * N, N, N, kb2 * 64, nb2 * 64, F.lane); }
        tr_store(cur, K, WT + (size_t)mat * Npad * K, drow, kb * 64, scr, F.lane);
    }
}
__device__ __forceinline__ void p0_prologue(Frame& F) {
    LAS float* scr = (LAS float*)(F.lds + F.wave * 16896);
    const int gw = F.bx * 8 + F.wave, NGW = F.G * 8;
    tr_class(F, inptr(F, I_MOE_W_GU), DEPTH * NEXP, D, 2 * DFF, 2 * DFF, WSP(bf16_t, OFF_W_GU), true, scr, gw, NGW);
    tr_class(F, inptr(F, I_MOE_W_DOWN), DEPTH * NEXP, DFF, D, D, WSP(bf16_t, OFF_W_DN), false, scr, gw, NGW);
    tr_class(F, inptr(F, I_NSA_W_IN), 2, D, NSA_IN, NSA_LD, WSP(bf16_t, OFF_W_NSAIN), false, scr, gw, NGW);
    tr_class(F, inptr(F, I_NSA_W_OUT), 2, D, D, D, WSP(bf16_t, OFF_W_NSAOUT), false, scr, gw, NGW);
    tr_class(F, inptr(F, I_ML_W_IN), 1, D, ML_IN, ML_LD, WSP(bf16_t, OFF_W_MLIN), false, scr, gw, NGW);
    tr_class(F, inptr(F, I_ML_W_OUT), 1, D, D, D, WSP(bf16_t, OFF_W_MLOUT), false, scr, gw, NGW);
    tr_class(F, inptr(F, I_HG_W_IN), 1, D, HG_LD, HG_LD, WSP(bf16_t, OFF_W_HGIN), false, scr, gw, NGW);
    tr_class(F, inptr(F, I_HG_W_OUT), 1, D, D, D, WSP(bf16_t, OFF_W_HGOUT), false, scr, gw, NGW);
    tr_class(F, inptr(F, I_NSA_CMP_W1), 4, 2048, 256, 256, WSP(bf16_t, OFF_W_CMP1), false, scr, gw, NGW);
    tr_class(F, inptr(F, I_NSA_CMP_W2), 4, 256, 64, 64, WSP(bf16_t, OFF_W_CMP2), false, scr, gw, NGW);
    const int gt = F.bx * 512 + F.tid;
    float* tab = WSP(float, OFF_TAB);
    if (gt < 1024) {
        const int lj = gt >> 8, n = gt & 255; const float* pos = inptr(F, I_NSA_CMP_POS) + (size_t)lj * 2048; const float* w1 = inptr(F, I_NSA_CMP_W1) + (size_t)lj * 2048 * 256;
        float a = inptr(F, I_NSA_CMP_B1)[lj * 256 + n];
        for (int k = 0; k < 2048; ++k) a += pos[k] * w1[(size_t)k * 256 + n];
        tab[TAB_CMPB + gt] = a;
    } else if (gt < 2048) {
        const int c = gt - 1024; float v[DEPTH], mx = -1e30f;
#pragma unroll
        for (int i = 0; i < DEPTH; ++i) { v[i] = inptr(F, I_HG_LOWER)[i * D + c]; mx = fmaxf(mx, v[i]); }
        float s = 0.f;
#pragma unroll
        for (int i = 0; i < DEPTH; ++i) { v[i] = __expf(v[i] - mx); s += v[i]; }
        tab[TAB_LB + c] = (v[1] + v[2]) / s;
    }
    { const float* rw = inptr(F, I_ROUTER_W); float* rwt = WSP(float, OFF_TAB) + TAB_RWT;
      for (int i = F.bx * 512 + F.tid; i < DEPTH * D * NEXP; i += F.G * 512) { const int l = i >> 15, r = i & 32767, k = r >> 5, e = r & 31; rwt[(l * NEXP + e) * D + k] = rw[i]; } }
    {
        const f32x4* xs = (const f32x4*)inptr(F, I_X); u32x2* xn = WSP(u32x2, OFF_XN);
        const size_t n4 = (size_t)NTOK * D / 4, stride = (size_t)F.G * 512;
        for (size_t i = (size_t)F.bx * 512 + F.tid; i < n4; i += stride) { const f32x4 v = xs[i]; u32x2 o; o.x = pk2(v[0], v[1]); o.y = pk2(v[2], v[3]); xn[i] = o; }
    }
}

__device__ __forceinline__ void phase_ln_router(Frame& F, int layer, bool dummy = false) {
    constexpr int SP = 1028;
    LAS float* LgL = (LAS float*)F.lds;
    LAS float* slab = LgL + 256 * 33;
    LAS float* part = slab + 16 * SP;
    if (F.tid < 32) F.LC[64 + F.tid] = 0u;
    __syncthreads();
    const float* g = inptr(F, I_LN_G) + (size_t)(layer * 2 + 0) * D; const float* bb = inptr(F, I_LN_B) + (size_t)(layer * 2 + 0) * D;
    const float* rb = inptr(F, I_ROUTER_B) + layer * NEXP;
    const float* rwt = WSP(float, OFF_TAB) + TAB_RWT + (size_t)layer * NEXP * D;
    const bf16_t* HM = WSP(bf16_t, OFF_HM); bf16_t* XN = dummy ? WSP(bf16_t, OFF_H + 256 * MiB) : WSP(bf16_t, OFF_XN);
    const bf16_t* XR = WSP(bf16_t, OFF_XN);
    int* toke = dummy ? WSP(int, OFF_H + 400 * MiB) : WSP(int, OFF_TOKE); float* tokg = dummy ? WSP(float, OFF_H + 402 * MiB) : WSP(float, OFF_TOKG);
    int lane = F.lane; asm volatile("; phase-local lane" : "+v"(lane));
    const int fr = lane & 15, fg = lane >> 4, wave = F.wave;
    for (int blk = F.bx; blk < NTOK / 256; blk += F.G) {
        u32x2 xn_[2][4], hn_[2][4];
        { const int m0 = blk * 256 + 2 * wave;
#pragma unroll
          for (int q = 0; q < 2; ++q) { const u32x2* xr = (const u32x2*)(XR + (size_t)(m0 + q) * D) + lane; const u32x2* hr = (const u32x2*)(HM + (size_t)(m0 + q) * D) + lane;
#pragma unroll
            for (int j = 0; j < 4; ++j) { xn_[q][j] = xr[64 * j]; hn_[q][j] = hr[64 * j]; } } }
#pragma unroll 1
        for (int sub = 0; sub < 16; ++sub) {
            const int mb = blk * 256 + sub * 16 + 2 * wave;
            f32x4 v[2][4]; float s[2] = {0.f, 0.f};
#pragma unroll
            for (int q = 0; q < 2; ++q)
#pragma unroll
                for (int j = 0; j < 4; ++j) { const u32x2 xv = xn_[q][j]; const u32x2 hv = hn_[q][j];
                    v[q][j][0] = DN_ALPHA * __uint_as_float(xv.x << 16) + __uint_as_float(hv.x << 16); v[q][j][1] = DN_ALPHA * __uint_as_float(xv.x & 0xffff0000u) + __uint_as_float(hv.x & 0xffff0000u);
                    v[q][j][2] = DN_ALPHA * __uint_as_float(xv.y << 16) + __uint_as_float(hv.y << 16); v[q][j][3] = DN_ALPHA * __uint_as_float(xv.y & 0xffff0000u) + __uint_as_float(hv.y & 0xffff0000u);
                    s[q] += (v[q][j][0] + v[q][j][1]) + (v[q][j][2] + v[q][j][3]); }
            if (sub + 1 < 16) {
#pragma unroll
                for (int q = 0; q < 2; ++q) { const u32x2* xr = (const u32x2*)(XR + (size_t)(mb + 16 + q) * D) + lane; const u32x2* hr = (const u32x2*)(HM + (size_t)(mb + 16 + q) * D) + lane;
#pragma unroll
                    for (int j = 0; j < 4; ++j) { xn_[q][j] = xr[64 * j]; hn_[q][j] = hr[64 * j]; } } }
#pragma unroll
            for (int q = 0; q < 2; ++q) {
                const float mean = wave_sum(s[q]) * (1.f / D); float s2 = 0.f;
#pragma unroll
                for (int j = 0; j < 4; ++j) { v[q][j] = v[q][j] - mean; s2 += (v[q][j][0] * v[q][j][0] + v[q][j][1] * v[q][j][1]) + (v[q][j][2] * v[q][j][2] + v[q][j][3] * v[q][j][3]); }
                const float rstd = __builtin_amdgcn_rsqf(wave_sum(s2) * (1.f / D) + LN_EPS);
                u32x2* no = (u32x2*)(XN + (size_t)(mb + q) * D) + lane; LAS f32x4* so = (LAS f32x4*)(slab + (2 * wave + q) * SP) + lane;
#pragma unroll
                for (int j = 0; j < 4; ++j) { const f32x4 gv = *((const f32x4*)g + lane + 64 * j), bv = *((const f32x4*)bb + lane + 64 * j);
                    const f32x4 y = v[q][j] * rstd * gv + bv; so[64 * j] = y; u32x2 o; o.x = pk2(y[0], y[1]); o.y = pk2(y[2], y[3]); no[64 * j] = o; }
            }
            __syncthreads();
            {
                const LAS f32x4* Ap = (const LAS f32x4*)(slab + fr * SP + 128 * wave) + fg;
                const f32x4* B0p = (const f32x4*)(rwt + (size_t)fr * D + 128 * wave) + fg; const f32x4* B1p = (const f32x4*)(rwt + (size_t)(16 + fr) * D + 128 * wave) + fg;
                f32x4 acc0 = (f32x4){0.f, 0.f, 0.f, 0.f}, acc1 = acc0;
#pragma unroll
                for (int t = 0; t < 8; ++t) { const f32x4 a = Ap[4 * t], b0 = B0p[4 * t], b1 = B1p[4 * t];
#pragma unroll
                    for (int j = 0; j < 4; ++j) { acc0 = __builtin_amdgcn_mfma_f32_16x16x4f32(a[j], b0[j], acc0, 0, 0, 0); acc1 = __builtin_amdgcn_mfma_f32_16x16x4f32(a[j], b1[j], acc1, 0, 0, 0); } }
#pragma unroll
                for (int e = 0; e < 4; ++e) { LAS float* pr = part + (wave * 16 + 4 * fg + e) * 33; pr[fr] = acc0[e]; pr[16 + fr] = acc1[e]; }
            }
            __syncthreads();
            { const int row = F.tid >> 5, e = F.tid & 31; float lg = rb[e];
#pragma unroll
              for (int w8 = 0; w8 < 8; ++w8) lg += part[(w8 * 16 + row) * 33 + e];
              LgL[(sub * 16 + row) * 33 + e] = lg; }
        }
        __syncthreads();
        if (F.tid < 256) {
            const int m = blk * 256 + F.tid; const LAS float* lr = LgL + F.tid * 33;
            unsigned taken = 0u; int se[TOPK]; float sv[TOPK];
#pragma unroll
            for (int k = 0; k < TOPK; ++k) { float best = -INFINITY; int bi = 0;
#pragma unroll 8
                for (int e = 0; e < NEXP; ++e) { const float c = ((taken >> e) & 1u) ? -INFINITY : lr[e]; if (c > best) { best = c; bi = e; } }
                se[k] = bi; sv[k] = best; taken |= 1u << bi; }
            float gs = 0.f, ge[TOPK];
#pragma unroll
            for (int k = 0; k < TOPK; ++k) { ge[k] = __expf(sv[k] - sv[0]); gs += ge[k]; }
            const float inv = __builtin_amdgcn_rcpf(gs);
#pragma unroll
            for (int k = 0; k < TOPK; ++k) { toke[m * 4 + k] = se[k]; tokg[m * 4 + k] = ge[k] * inv; __hip_atomic_fetch_add((LAS unsigned*)&F.LC[64 + se[k]], 1u, __ATOMIC_RELAXED, __HIP_MEMORY_SCOPE_WORKGROUP); }
        }
        __syncthreads();
    }
    if (F.tid < 32) { const unsigned c = F.LC[64 + F.tid]; if (c) __hip_atomic_fetch_add(F.ctl + (dummy ? 12288 : CW_CNT) + layer * 64 + F.tid, c, RLX_AGENT); }
    __syncthreads();
}

__device__ __forceinline__ void moe_tile_table(Frame& F, int layer) {
    if (F.tid < 64) {
        const int e = F.tid & 31;
        const unsigned c = __hip_atomic_load(F.ctl + CW_CNT + layer * 64 + e, RLX_AGENT);
        int acc = (int)((c + 255u) >> 8);
#pragma unroll
        for (int o = 1; o < 32; o <<= 1) { const int u = __shfl_up(acc, o); if (e >= o) acc += u; }
        if (F.tid < 32) { F.LC[8 + e] = (unsigned)acc; if (e == 31) F.LC[40] = (unsigned)acc; }
    }
    __syncthreads();
}
__device__ __forceinline__ void phase_moe_slots(Frame& F, int layer) {
    moe_tile_table(F, layer);
    const int* toke = WSP(int, OFF_TOKE); const float* tokg = WSP(float, OFF_TOKG);
    int* tokp = WSP(int, OFF_TOKP); int* rowt = WSP(int, OFF_ROWT); float* rowg = WSP(float, OFF_ROWG);
    for (int blk = F.bx; blk < NTOK / 256; blk += F.G) {
        if (F.tid < 32) F.LC[64 + F.tid] = 0u;
        __syncthreads();
        int e[2], rank[2];
#pragma unroll
        for (int q = 0; q < 2; ++q) { const int a = blk * 1024 + q * 512 + F.tid; e[q] = toke[a]; rank[q] = (int)__hip_atomic_fetch_add((LAS unsigned*)&F.LC[64 + e[q]], 1u, __ATOMIC_RELAXED, __HIP_MEMORY_SCOPE_WORKGROUP); }
        __syncthreads();
        if (F.tid < 32) { const unsigned c = F.LC[64 + F.tid]; const unsigned pstart = (F.tid ? F.LC[8 + F.tid - 1] : 0u) * 256u;
            F.LC[96 + F.tid] = pstart + (c ? __hip_atomic_fetch_add(F.ctl + CW_CUR + layer * 64 + F.tid, c, RLX_AGENT) : 0u); }
        __syncthreads();
#pragma unroll
        for (int q = 0; q < 2; ++q) { const int a = blk * 1024 + q * 512 + F.tid; const int pos = (int)F.LC[96 + e[q]] + rank[q];
            rowt[pos] = a >> 2; rowg[pos] = tokg[a]; tokp[a] = pos; }
        __syncthreads();
    }
    for (int e2 = F.bx; e2 < NEXP; e2 += F.G) {
        const unsigned c = __hip_atomic_load(F.ctl + CW_CNT + layer * 64 + e2, RLX_AGENT); const unsigned pstart = (e2 ? F.LC[8 + e2 - 1] : 0u) * 256u, pend = F.LC[8 + e2] * 256u;
        for (unsigned r = pstart + c + F.tid; r < pend; r += 512) { rowt[r] = 0; rowg[r] = 0.f; }
    }
}
__device__ __forceinline__ void phase_combine_ln(Frame& F, int layer, float* xo_base  , bool dummy = false) {
    const float* g = inptr(F, I_LN_G) + (size_t)(layer * 2 + 1) * D; const float* bb = inptr(F, I_LN_B) + (size_t)(layer * 2 + 1) * D;
    const bf16_t* XR = WSP(bf16_t, OFF_XN); bf16_t* XN = dummy ? WSP(bf16_t, OFF_H + 256 * MiB) : WSP(bf16_t, OFF_XN); const bf16_t* Y = WSP(bf16_t, OFF_Y); const int* tokp = WSP(int, OFF_TOKP);
    int lane = F.lane; asm volatile("; phase-local lane" : "+v"(lane)); const int gw = F.bx * 8 + F.wave, NGW = F.G * 8;
    u32x2 xq[4]; u32x2 yq[TOPK][4]; int posn[TOPK];
    {
        int p0[TOPK];
#pragma unroll
        for (int k = 0; k < TOPK; ++k) p0[k] = (gw < NTOK) ? tokp[gw * 4 + k] : 0;
        if (gw < NTOK) { const u32x2* xr = (const u32x2*)(XR + (size_t)gw * D) + lane;
#pragma unroll
            for (int j = 0; j < 4; ++j) xq[j] = xr[64 * j];
#pragma unroll
            for (int k = 0; k < TOPK; ++k) { const u32x2* yr = (const u32x2*)(Y + (size_t)p0[k] * D) + lane;
#pragma unroll
                for (int j = 0; j < 4; ++j) yq[k][j] = __builtin_nontemporal_load(yr + 64 * j); } }
#pragma unroll
        for (int k = 0; k < TOPK; ++k) posn[k] = (gw + NGW < NTOK) ? tokp[(gw + NGW) * 4 + k] : 0;
    }
#pragma unroll 1
    for (int m = gw; m < NTOK; m += NGW) {
        f32x4 v[4]; float s = 0.f;
#pragma unroll
        for (int j = 0; j < 4; ++j) { const u32x2 xv = xq[j]; v[j][0] = DN_ALPHA * __uint_as_float(xv.x << 16); v[j][1] = DN_ALPHA * __uint_as_float(xv.x & 0xffff0000u); v[j][2] = DN_ALPHA * __uint_as_float(xv.y << 16); v[j][3] = DN_ALPHA * __uint_as_float(xv.y & 0xffff0000u); }
#pragma unroll
        for (int k = 0; k < TOPK; ++k) {
#pragma unroll
            for (int j = 0; j < 4; ++j) { const u32x2 hv = yq[k][j];
                v[j][0] += __uint_as_float(hv.x << 16); v[j][1] += __uint_as_float(hv.x & 0xffff0000u); v[j][2] += __uint_as_float(hv.y << 16); v[j][3] += __uint_as_float(hv.y & 0xffff0000u); } }
        if (m + NGW < NTOK) {
            const u32x2* xr = (const u32x2*)(XR + (size_t)(m + NGW) * D) + lane;
#pragma unroll
            for (int j = 0; j < 4; ++j) xq[j] = xr[64 * j];
#pragma unroll
            for (int k = 0; k < TOPK; ++k) { const u32x2* yr = (const u32x2*)(Y + (size_t)posn[k] * D) + lane;
#pragma unroll
                for (int j = 0; j < 4; ++j) yq[k][j] = __builtin_nontemporal_load(yr + 64 * j); }
#pragma unroll
            for (int k = 0; k < TOPK; ++k) posn[k] = (m + 2 * NGW < NTOK) ? tokp[(m + 2 * NGW) * 4 + k] : 0;
        }
#pragma unroll
        for (int j = 0; j < 4; ++j) s += (v[j][0] + v[j][1]) + (v[j][2] + v[j][3]);
        const float mean = wave_sum(s) * (1.f / D); float s2 = 0.f;
#pragma unroll
        for (int j = 0; j < 4; ++j) { v[j] = v[j] - mean; s2 += (v[j][0] * v[j][0] + v[j][1] * v[j][1]) + (v[j][2] * v[j][2] + v[j][3] * v[j][3]); }
        const float rstd = __builtin_amdgcn_rsqf(wave_sum(s2) * (1.f / D) + LN_EPS);
        u32x2* no = (u32x2*)(XN + (size_t)m * D) + lane;
#pragma unroll
        for (int j = 0; j < 4; ++j) { const f32x4 gv = *((const f32x4*)g + lane + 64 * j), bv = *((const f32x4*)bb + lane + 64 * j);
            v[j] = v[j] * rstd * gv + bv;
            if (xo_base) *((f32x4*)(xo_base + (size_t)m * D) + lane + 64 * j) = v[j];
            else { u32x2 o; o.x = pk2(v[j][0], v[j][1]); o.y = pk2(v[j][2], v[j][3]); no[64 * j] = o; } }
    }
}
__device__ __forceinline__ void phase_nsa_cmp2(Frame& F, int slot) {
    const bf16_t* HC = WSP(bf16_t, OFF_HC); bf16_t* KC = WSP(bf16_t, OFF_KC);
    const bf16_t* W2t = WSP(bf16_t, OFF_W_CMP2) + (size_t)slot * 2 * 64 * 256;
    const float* b2 = inptr(F, I_NSA_CMP_B2) + (size_t)slot * 2 * 64;
    int lane = F.lane; asm volatile("; phase-local lane" : "+v"(lane));
    const int fr = lane & 15, fg = lane >> 4, gw = F.bx * 8 + F.wave, NGW = F.G * 8;
    for (int blk = gw; blk < 2 * 1024; blk += NGW) {
        const int j = blk >> 10, r0 = (blk & 1023) * 16;
        const bf16_t* A = HC + ((size_t)j * 16384 + r0 + fr) * 256 + 8 * fg;
        const bf16_t* B = W2t + ((size_t)j * 64 + fr) * 256 + 8 * fg;
        f32x4 acc[4];
#pragma unroll
        for (int t = 0; t < 4; ++t) acc[t] = (f32x4){0.f, 0.f, 0.f, 0.f};
#pragma unroll
        for (int ks = 0; ks < 8; ++ks) { const bf16x8 a = *(const bf16x8*)(A + 32 * ks);
#pragma unroll
            for (int t = 0; t < 4; ++t) acc[t] = __builtin_amdgcn_mfma_f32_16x16x32_bf16(*(const bf16x8*)(B + (size_t)t * 16 * 256 + 32 * ks), a, acc[t], 0, 0, 0); }
        const int row = r0 + fr;
#pragma unroll
        for (int t = 0; t < 4; ++t) { const int d0 = 16 * t + 4 * fg; const f32x4 bv = *(const f32x4*)(b2 + j * 64 + d0);
            f32x4 v = acc[t] + bv; if ((row & 127) == 127) v = (f32x4){0.f, 0.f, 0.f, 0.f};
            u32x2 w; w.x = pg8::cvt_pk_bf16(v[0], v[1]); w.y = pg8::cvt_pk_bf16(v[2], v[3]);
            *(u32x2*)(KC + ((size_t)j * 16384 + row) * 64 + d0) = w; }
    }
}
typedef float f32x16 __attribute__((ext_vector_type(16)));
#define PP_SYNC() do { __builtin_amdgcn_sched_barrier(0); __syncthreads(); __builtin_amdgcn_sched_barrier(0); } while (0)
#ifndef SP_SCALAR
#define SP_SCALAR 0
#endif
#ifndef SP_FILL
#define SP_FILL 12
#endif
#ifndef XCMP
#define XCMP 0
#endif
#ifndef XSELN
#define XSELN 0
#endif
#ifndef XOUT
#define XOUT 0
#endif
namespace na {
constexpr int KP = 144;
constexpr int VP = 144;
__device__ __forceinline__ int vcol(int key) { return (key & ~15) | (key & 3) | ((key & 8) >> 1) | ((key & 4) << 1); }
constexpr int TILEB = 64 * KP;
constexpr int L_K = 0, L_V = 2 * TILEB, L_PQ = 4 * TILEB, SLB = 64 * 33, L_SEL = L_PQ + 4 * SLB * 4, L_OA = L_SEL + 4864;
constexpr float NEG = -1e30f;
constexpr float C1 = 0.125f * 1.4426950408889634f;
__device__ __forceinline__ int crow(int r, int hi) { return (r & 3) + 8 * (r >> 2) + 4 * hi; }
__device__ __forceinline__ bf16x8 pack8(const f32x16& p, int s1) {
    u32x4 w; w.x = pg8::cvt_pk_bf16(p[8 * s1 + 0], p[8 * s1 + 1]); w.y = pg8::cvt_pk_bf16(p[8 * s1 + 2], p[8 * s1 + 3]);
    w.z = pg8::cvt_pk_bf16(p[8 * s1 + 4], p[8 * s1 + 5]); w.w = pg8::cvt_pk_bf16(p[8 * s1 + 6], p[8 * s1 + 7]);
    return __builtin_bit_cast(bf16x8, w);
}
__device__ __forceinline__ void qk(f32x16& p0, f32x16& p1, const LAS unsigned char* Kt, const bf16x8 (&qf)[4], int r, int h) {
    const f32x16 z = {0.f, 0.f, 0.f, 0.f, 0.f, 0.f, 0.f, 0.f, 0.f, 0.f, 0.f, 0.f, 0.f, 0.f, 0.f, 0.f};
    bf16x8 a0[4], a1[4];
#pragma unroll
    for (int s = 0; s < 4; ++s) { a0[s] = *(const LAS bf16x8*)(Kt + r * KP + (16 * s + 8 * h) * 2); a1[s] = *(const LAS bf16x8*)(Kt + (32 + r) * KP + (16 * s + 8 * h) * 2); }
    __builtin_amdgcn_sched_barrier(0);
#pragma unroll
    for (int s = 0; s < 4; ++s) {
        p0 = __builtin_amdgcn_mfma_f32_32x32x16_bf16(a0[s], qf[s], s == 0 ? z : p0, 0, 0, 0);
        p1 = __builtin_amdgcn_mfma_f32_32x32x16_bf16(a1[s], qf[s], s == 0 ? z : p1, 0, 0, 0);
    }
}
__device__ __forceinline__ void pv(f32x16& o0, f32x16& o1, const LAS unsigned char* Vt, const f32x16& p0, const f32x16& p1, int r, int h) {
#pragma unroll
    for (int s = 0; s < 4; ++s) {
        const int s1 = s & 1;
        const bf16x8 bfrag = (s < 2) ? pack8(p0, s1) : pack8(p1, s1);
        const int key0 = 32 * (s >> 1) + 16 * s1 + 4 * h;
#pragma unroll
        for (int dh = 0; dh < 2; ++dh) {
            const bf16x8 a = *(const LAS bf16x8*)(Vt + (32 * dh + r) * VP + (key0 - 4 * h + 8 * h) * 2);
            if (dh == 0) o0 = __builtin_amdgcn_mfma_f32_32x32x16_bf16(a, bfrag, o0, 0, 0, 0);
            else o1 = __builtin_amdgcn_mfma_f32_32x32x16_bf16(a, bfrag, o1, 0, 0, 0);
        }
    }
}
__device__ __forceinline__ void pack_p(bf16x8 (&pb)[4], const f32x16& p0, const f32x16& p1) { pb[0] = pack8(p0, 0); pb[1] = pack8(p0, 1); pb[2] = pack8(p1, 0); pb[3] = pack8(p1, 1); }
__device__ __forceinline__ void pv2(f32x16& o0, f32x16& o1, const LAS unsigned char* Vt, const bf16x8 (&pb)[4], int r, int h) {
    bf16x8 a[4][2];
#pragma unroll
    for (int s = 0; s < 4; ++s) {
        const int key0 = 32 * (s >> 1) + 16 * (s & 1) + 4 * h;
#pragma unroll
        for (int dh = 0; dh < 2; ++dh) {
            a[s][dh] = *(const LAS bf16x8*)(Vt + (32 * dh + r) * VP + (key0 - 4 * h + 8 * h) * 2);
        }
    }
    __builtin_amdgcn_sched_barrier(0);
#pragma unroll
    for (int s = 0; s < 4; ++s) {
        o0 = __builtin_amdgcn_mfma_f32_32x32x16_bf16(a[s][0], pb[s], o0, 0, 0, 0);
        o1 = __builtin_amdgcn_mfma_f32_32x32x16_bf16(a[s][1], pb[s], o1, 0, 0, 0);
    }
}
__device__ __forceinline__ void softmax_step(f32x16& p0, f32x16& p1, float& m, float& l, f32x16& o0, f32x16& o1, bool lane_on = true) {
    constexpr float THR = 8.0f / C1;
    float mx = fmaxf(fmaxf(fmaxf(p0[0], p1[5]), fmaxf(p0[10], p1[15])), fmaxf(fmaxf(p1[0], p0[5]), fmaxf(p1[10], p0[15])));
    mx = lane_on ? mx : NEG;
    mx = fmaxf(mx, __shfl_xor(mx, 32));
    const float mn = (mx > m + THR) ? mx : m;
    const float muse = (mn < -1e29f) ? 0.f : mn;
    const bool grow = mn != m;
    const float mc = lane_on ? muse * C1 : 3.0e38f;
    f32x2 lsa = {0.f, 0.f}, lsb = {0.f, 0.f}; const f32x2 c1v = {C1, C1}, nmc = {-mc, -mc};
#pragma unroll
    for (int i = 0; i < 8; ++i) {
        f32x2 a = {p0[2 * i], p0[2 * i + 1]}, b = {p1[2 * i], p1[2 * i + 1]};
        a = __builtin_elementwise_fma(a, c1v, nmc); b = __builtin_elementwise_fma(b, c1v, nmc);
        a.x = __builtin_amdgcn_exp2f(a.x); a.y = __builtin_amdgcn_exp2f(a.y); b.x = __builtin_amdgcn_exp2f(b.x); b.y = __builtin_amdgcn_exp2f(b.y);
        p0[2 * i] = a.x; p0[2 * i + 1] = a.y; p1[2 * i] = b.x; p1[2 * i + 1] = b.y; lsa += a; lsb += b; }
    const float ls = (lsa.x + lsa.y) + (lsb.x + lsb.y);
    if (__builtin_amdgcn_ballot_w64(grow) != 0ull) {
        const float alpha = __builtin_amdgcn_exp2f((((m < -1e29f) ? 0.f : m) - muse) * C1);
        l = l * alpha;
#pragma unroll
        for (int i = 0; i < 16; ++i) { o0[i] *= alpha; o1[i] *= alpha; }
        m = mn;
    }
    l += ls;
}
__device__ __forceinline__ void softmax_heavy(f32x16& p0, f32x16& p1, const float m, float& l, float& mxraw, bool lane_on) {
    const float mx = fmaxf(fmaxf(fmaxf(p0[0], p1[5]), fmaxf(p0[10], p1[15])), fmaxf(fmaxf(p1[0], p0[5]), fmaxf(p1[10], p0[15])));
    mxraw = lane_on ? mx : NEG;
    const float muse = (m < -1e29f) ? 0.f : m;
    const float mc = lane_on ? muse * C1 : 3.0e38f;
#if SP_SCALAR
    float ls0 = 0.f, ls1 = 0.f;
#pragma unroll
    for (int i = 0; i < 16; ++i) { p0[i] = __builtin_amdgcn_exp2f(p0[i] * C1 - mc); p1[i] = __builtin_amdgcn_exp2f(p1[i] * C1 - mc); ls0 += p0[i]; ls1 += p1[i]; }
    l += ls0 + ls1;
#else
    f32x2 lsa = {0.f, 0.f}, lsb = {0.f, 0.f}; const f32x2 c1v = {C1, C1}, nmc = {-mc, -mc};
#pragma unroll
    for (int i = 0; i < 8; ++i) {
        f32x2 a = {p0[2 * i], p0[2 * i + 1]}, b = {p1[2 * i], p1[2 * i + 1]};
        a = __builtin_elementwise_fma(a, c1v, nmc); b = __builtin_elementwise_fma(b, c1v, nmc);
        a.x = __builtin_amdgcn_exp2f(a.x); a.y = __builtin_amdgcn_exp2f(a.y); b.x = __builtin_amdgcn_exp2f(b.x); b.y = __builtin_amdgcn_exp2f(b.y);
        p0[2 * i] = a.x; p0[2 * i + 1] = a.y; p1[2 * i] = b.x; p1[2 * i + 1] = b.y; lsa += a; lsb += b; }
    l += (lsa.x + lsa.y) + (lsb.x + lsb.y);
#endif
}
__device__ __forceinline__ void softmax_light(float mxraw, float& m, float& l, f32x16& o0, f32x16& o1) {
    constexpr float THR = 8.0f / C1;
    const float mx = fmaxf(mxraw, __shfl_xor(mxraw, 32));
    const float mn = (mx > m + THR) ? mx : m;
    if (__builtin_amdgcn_ballot_w64(mn != m) != 0ull) {
        const float alpha = __builtin_amdgcn_exp2f((((m < -1e29f) ? 0.f : m) - ((mn < -1e29f) ? 0.f : mn)) * C1);
        l = l * alpha;
#pragma unroll
        for (int i = 0; i < 16; ++i) { o0[i] *= alpha; o1[i] *= alpha; }
        m = mn;
    }
}
struct Stage { u32x4 k, v; };
__device__ __forceinline__ void stage_load(Stage& st, const bf16_t* ksrc, const bf16_t* vsrc, long stride, int tid) {
    const int key = tid >> 3, dc = tid & 7, vkey = tid & 63, vdc = tid >> 6;
    st.k = *(const u32x4*)(ksrc + (long)key * stride + dc * 8); st.v = *(const u32x4*)(vsrc + (long)vkey * stride + vdc * 8);
}
__device__ __forceinline__ void stage_store(const Stage& st, LAS unsigned char* Kt, LAS unsigned char* Vt, int tid) {
    const int key = tid >> 3, dc = tid & 7, vkey = tid & 63, vdc = tid >> 6;
    *(LAS u32x4*)(Kt + key * KP + dc * 16) = st.k;
    const unsigned w[4] = {st.v.x, st.v.y, st.v.z, st.v.w};
#pragma unroll
    for (int e = 0; e < 4; ++e) { *(LAS unsigned short*)(Vt + (vdc * 8 + 2 * e) * VP + vcol(vkey) * 2) = (unsigned short)(w[e] & 0xffffu); *(LAS unsigned short*)(Vt + (vdc * 8 + 2 * e + 1) * VP + vcol(vkey) * 2) = (unsigned short)(w[e] >> 16); }
}
__device__ __forceinline__ void pp_load(u32x4 (&sg)[2], const bf16_t* src, long stride, int t256, int kind) {
    if (kind == 0) {
#pragma unroll
        for (int j = 0; j < 2; ++j) { const int c = t256 + 256 * j; sg[j] = *(const u32x4*)(src + (long)(c >> 3) * stride + (c & 7) * 8); }
    } else {
#pragma unroll
        for (int j = 0; j < 2; ++j) { const int c = t256 + 256 * j; sg[j] = *(const u32x4*)(src + (long)(c & 63) * stride + (c >> 6) * 8); }
    }
}
__device__ __forceinline__ void pp_store(const u32x4 (&sg)[2], LAS unsigned char* Kt, LAS unsigned char* Vt, int t256, int kind) {
    if (kind == 0) {
#pragma unroll
        for (int j = 0; j < 2; ++j) { const int c = t256 + 256 * j; *(LAS u32x4*)(Kt + (c >> 3) * KP + (c & 7) * 16) = sg[j]; }
    } else {
#pragma unroll
        for (int j = 0; j < 2; ++j) { const int c = t256 + 256 * j, vkey = c & 63, vdc = c >> 6; const unsigned w[4] = {sg[j].x, sg[j].y, sg[j].z, sg[j].w};
#pragma unroll
            for (int e = 0; e < 4; ++e) { *(LAS unsigned short*)(Vt + (vdc * 8 + 2 * e) * VP + vcol(vkey) * 2) = (unsigned short)(w[e] & 0xffffu); *(LAS unsigned short*)(Vt + (vdc * 8 + 2 * e + 1) * VP + vcol(vkey) * 2) = (unsigned short)(w[e] >> 16); } }
    }
}
template <int BR> __device__ __forceinline__ int pp_next(int kb, unsigned live) {
    if (BR == 1) return kb + 1;
    const unsigned rem = live & ~((2u << kb) - 1u);
    return rem ? __builtin_ctz(rem) : 32;
}
template <int BR>
__device__ __forceinline__ void pp_soft(f32x16& p0, f32x16& p1, int h, int kb, int qb, int qq, const LAS unsigned* selm, const float m, float& l, float& mxraw) {
    bool mine = true;
    if (BR == 0) mine = (selm[qq] >> kb) & 1u;
    if (kb == qb) {
#pragma unroll
        for (int e = 0; e < 16; ++e) { const int kk = crow(e, h); if (kk > qq) p0[e] = NEG; if (kk + 32 > qq) p1[e] = NEG; }
    } else if (BR == 1 && kb == qb - 8) {
#pragma unroll
        for (int e = 0; e < 16; ++e) { const int kk = crow(e, h); if (kk <= qq) p0[e] = NEG; if (kk + 32 <= qq) p1[e] = NEG; }
    }
    softmax_heavy(p0, p1, m, l, mxraw, mine);
}
template <int BR, bool PRE>
__device__ __forceinline__ void pp_stream(LAS unsigned char* lds, const bf16_t* Pb, int ld, int g, int qb, int qq, int qh, int t256, int r, int h, unsigned live, const LAS unsigned* selm,
                                          const bf16x8 (&qf)[4], u32x4 (&sg)[2], f32x16& o0, f32x16& o1, float& m, float& l) {
    const int kind = qh ^ 1;
    const int soff = (BR == 0 ? (kind == 0 ? 1536 : 1792) : (kind == 0 ? 2048 : 2304)) + g * 64;
    const int first = BR == 0 ? 0 : (qb > 8 ? qb - 8 : 0);
    const int n = BR == 0 ? __builtin_popcount(live) : (qb - first + 1);
    int kb_load = first;
    if (!PRE) pp_load(sg, Pb + (size_t)(kb_load * 64) * ld + soff, ld, t256, kind);
    kb_load = pp_next<BR>(kb_load, live);
    pp_store(sg, lds + L_K, lds + L_V, t256, kind);
    { const int kc = kb_load < qb ? kb_load : qb; pp_load(sg, Pb + (size_t)(kc * 64) * ld + soff, ld, t256, kind); kb_load = pp_next<BR>(kb_load, live); }
    __syncthreads();
    int kb = first;
    f32x16 p0, p1; float mxraw = NEG; bf16x8 pb[4];
    if (qh == 0) {
        qk(p0, p1, lds + L_K, qf, r, h);
#pragma unroll 1
        for (int i = 0; i < n; ++i) {
            pp_soft<BR>(p0, p1, h, kb, qb, qq, selm, m, l, mxraw);
            pack_p(pb, p0, p1);
            kb = pp_next<BR>(kb, live);
            PP_SYNC();
            if (i + 1 < n) pp_store(sg, lds + L_K + ((i + 1) & 1) * TILEB, lds + L_V + ((i + 1) & 1) * TILEB, t256, kind);
            { const int kc = kb_load < qb ? kb_load : qb; pp_load(sg, Pb + (size_t)(kc * 64) * ld + soff, ld, t256, kind); kb_load = pp_next<BR>(kb_load, live); }
            if (i + 1 < n) qk(p0, p1, lds + L_K + ((i + 1) & 1) * TILEB, qf, r, h);
            pv2(o0, o1, lds + L_V + (i & 1) * TILEB, pb, r, h);
            softmax_light(mxraw, m, l, o0, o1);
            PP_SYNC();
        }
    } else {
#pragma unroll 1
        for (int i = 0; i < n; ++i) {
            qk(p0, p1, lds + L_K + (i & 1) * TILEB, qf, r, h);
            if (i > 0) { pv2(o0, o1, lds + L_V + ((i - 1) & 1) * TILEB, pb, r, h); softmax_light(mxraw, m, l, o0, o1); }
            if (i + 1 < n) pp_store(sg, lds + L_K + ((i + 1) & 1) * TILEB, lds + L_V + ((i + 1) & 1) * TILEB, t256, kind);
            { const int kc = kb_load < qb ? kb_load : qb; pp_load(sg, Pb + (size_t)(kc * 64) * ld + soff, ld, t256, kind); kb_load = pp_next<BR>(kb_load, live); }
            PP_SYNC();
            pp_soft<BR>(p0, p1, h, kb, qb, qq, selm, m, l, mxraw);
            pack_p(pb, p0, p1);
            kb = pp_next<BR>(kb, live);
            PP_SYNC();
        }
        pv2(o0, o1, lds + L_V + ((n - 1) & 1) * TILEB, pb, r, h);
    }
}
__device__ __forceinline__ void st_store_k(const u32x4& k, LAS unsigned char* Kt, int tid) { const int key = tid >> 3, dc = tid & 7; *(LAS u32x4*)(Kt + key * KP + dc * 16) = k; }
__device__ __forceinline__ void st_store_v(const u32x4& v, LAS unsigned char* Vt, int tid) {
    const int vkey = tid & 63, vdc = tid >> 6; const unsigned w[4] = {v.x, v.y, v.z, v.w};
#pragma unroll
    for (int e = 0; e < 4; ++e) { *(LAS unsigned short*)(Vt + (vdc * 8 + 2 * e) * VP + vcol(vkey) * 2) = (unsigned short)(w[e] & 0xffffu); *(LAS unsigned short*)(Vt + (vdc * 8 + 2 * e + 1) * VP + vcol(vkey) * 2) = (unsigned short)(w[e] >> 16); }
}
__device__ __forceinline__ u32x4 st_load_k(const bf16_t* ksrc, long stride, int tid) { return *(const u32x4*)(ksrc + (long)(tid >> 3) * stride + (tid & 7) * 8); }
__device__ __forceinline__ u32x4 st_load_v(const bf16_t* vsrc, long stride, int tid) { return *(const u32x4*)(vsrc + (long)(tid & 63) * stride + (tid >> 6) * 8); }
template <int BR>
__device__ __forceinline__ void sp_mask(f32x16& p0, f32x16& p1, int h, int kb, int qb, int qq) {
    if (kb == qb) {
#pragma unroll
        for (int e = 0; e < 16; ++e) { const int kk = crow(e, h); if (kk > qq) p0[e] = NEG; if (kk + 32 > qq) p1[e] = NEG; }
    } else if (BR == 1 && kb == qb - 8) {
#pragma unroll
        for (int e = 0; e < 16; ++e) { const int kk = crow(e, h); if (kk <= qq) p0[e] = NEG; if (kk + 32 <= qq) p1[e] = NEG; }
    }
}
template <int BR, bool PRE>
__device__ __forceinline__ void sp_stream(LAS unsigned char* lds, const bf16_t* Pb, int ld, int g, int qb, int qq, int tid, int r, int h, unsigned live, const LAS unsigned* selm,
                                          const bf16x8 (&qf)[4], Stage& st, f32x16& o0, f32x16& o1, float& m, float& l) {
    const int koff = (BR == 0 ? 1536 : 2048) + g * 64, voff = (BR == 0 ? 1792 : 2304) + g * 64;
    const int first = BR == 0 ? 0 : (qb > 8 ? qb - 8 : 0);
    const int n = BR == 0 ? __builtin_popcount(live) : (qb - first + 1);
    int kbK = first, kbV = first;
    if (!PRE) stage_load(st, Pb + (size_t)(first * 64) * ld + koff, Pb + (size_t)(first * 64) * ld + voff, ld, tid);
    kbK = pp_next<BR>(kbK, live); kbV = kbK;
    Stage s1; { const int kc = kbK < qb ? kbK : qb; stage_load(s1, Pb + (size_t)(kc * 64) * ld + koff, Pb + (size_t)(kc * 64) * ld + voff, ld, tid); }
    kbK = pp_next<BR>(kbK, live); kbV = kbK;
    stage_store(st, lds + L_K, lds + L_V, tid);
    st_store_k(s1.k, lds + L_K + TILEB, tid); st.v = s1.v;
    { const int kc = kbK < qb ? kbK : qb; st.k = st_load_k(Pb + (size_t)(kc * 64) * ld + koff, ld, tid); kbK = pp_next<BR>(kbK, live); }
    __syncthreads();
    f32x16 p0, p1; float mxraw = NEG; bf16x8 pb[4];
    qk(p0, p1, lds + L_K, qf, r, h);
    int kb = first, rk1 = 1, rk2 = 2;
#pragma unroll 1
    for (int i = 0; i < n; ++i) {
        if (i + 2 < n) st_store_k(st.k, lds + (rk2 == 2 ? L_PQ : L_K + rk2 * TILEB), tid);
        if (i + 1 < n) st_store_v(st.v, lds + L_V + ((i + 1) & 1) * TILEB, tid);
        { const int kc = kbK < qb ? kbK : qb, vc = kbV < qb ? kbV : qb;
          st.k = st_load_k(Pb + (size_t)(kc * 64) * ld + koff, ld, tid); st.v = st_load_v(Pb + (size_t)(vc * 64) * ld + voff, ld, tid); kbK = pp_next<BR>(kbK, live); kbV = pp_next<BR>(kbV, live); }
        bool mine = true;
        if (BR == 0) mine = (selm[qq] >> kb) & 1u;
        sp_mask<BR>(p0, p1, h, kb, qb, qq);
        f32x16 n0, n1;
        {
            const LAS unsigned char* Kt = lds + (rk1 == 2 ? L_PQ : L_K + rk1 * TILEB);
            const f32x16 z = {0.f, 0.f, 0.f, 0.f, 0.f, 0.f, 0.f, 0.f, 0.f, 0.f, 0.f, 0.f, 0.f, 0.f, 0.f, 0.f};
            bf16x8 a0[4], a1[4];
#pragma unroll
            for (int s = 0; s < 4; ++s) { a0[s] = *(const LAS bf16x8*)(Kt + r * KP + (16 * s + 8 * h) * 2); a1[s] = *(const LAS bf16x8*)(Kt + (32 + r) * KP + (16 * s + 8 * h) * 2); }
            __builtin_amdgcn_sched_barrier(0);
#pragma unroll
            for (int s = 0; s < 4; ++s) {
                n0 = __builtin_amdgcn_mfma_f32_32x32x16_bf16(a0[s], qf[s], s == 0 ? z : n0, 0, 0, 0);
                n1 = __builtin_amdgcn_mfma_f32_32x32x16_bf16(a1[s], qf[s], s == 0 ? z : n1, 0, 0, 0);
            }
            softmax_heavy(p0, p1, m, l, mxraw, mine);
            pack_p(pb, p0, p1);
#pragma unroll
            for (int j = 0; j < 8; ++j) { __builtin_amdgcn_sched_group_barrier(0x008, 1, 0); __builtin_amdgcn_sched_group_barrier(0x002, SP_FILL, 0); }
            __builtin_amdgcn_sched_barrier(0);
        }
        pv2(o0, o1, lds + L_V + (i & 1) * TILEB, pb, r, h);
        softmax_light(mxraw, m, l, o0, o1);
        p0 = n0; p1 = n1; kb = pp_next<BR>(kb, live); rk1 = rk2; rk2 = rk2 == 2 ? 0 : rk2 + 1;
        __syncthreads();
    }
}
}

__device__ __forceinline__ void phase_nsa_attn_mfma(Frame& F, int slot) {
    using namespace na;
    const bf16_t* P = WSP(bf16_t, OFF_PROJ); bf16_t* ATT = WSP(bf16_t, OFF_ATT);
    const bf16_t* KCb = WSP(bf16_t, OFF_KC); const bf16_t* VCb = KCb + (size_t)128 * 128 * 64;
    const float* gb = inptr(F, I_NSA_GATE_B) + slot * 48;
    int tid = F.tid; asm volatile("; phase-local tid" : "+v"(tid));
    const int wave = __builtin_amdgcn_readfirstlane(tid >> 6), lane = tid & 63, r = lane & 31, h = lane >> 5, hh = wave & 3, qh = wave >> 2;
    const int t256 = tid & 255;
    LAS unsigned char* lds = F.lds;
    LAS float* Pq = (LAS float*)(lds + L_PQ); LAS unsigned* selm = (LAS unsigned*)(lds + L_SEL);
    const int ld = NSA_LD;
    const int qq = qh * 32 + r;
#pragma unroll 1
    for (int it = F.bx; it < 4096; it += F.G) {
        const int sl = it & 255, rnd = it >> 8, bg = sl >> 1, par = sl & 1, qb = (rnd & 1) ? (31 - 2 * (rnd >> 1) - par) : (2 * (rnd >> 1) + par);
        const int b = bg >> 2, g = bg & 3, t = qb * 64 + qq;
        const bf16_t* Pb = P + (size_t)b * T * ld;
        const bf16_t* prow = Pb + (size_t)t * ld;
        bf16x8 qf[4];
#pragma unroll
        for (int s = 0; s < 4; ++s) qf[s] = *(const bf16x8*)(prow + g * 256 + hh * 64 + 16 * s + 8 * h);
        float gt[3];
#pragma unroll
        for (int j = 0; j < 3; ++j) gt[j] = sigmoidf_(bf2f(prow[2560 + g * 12 + hh * 3 + j]) + gb[g * 12 + hh * 3 + j]);
        LAS float* gsave = (LAS float*)(lds + L_SEL + 512) + tid * 2; gsave[0] = gt[1]; gsave[1] = gt[2];
        if (tid == 0) selm[64] = 0u;
        Stage st0, st1;
        stage_load(st0, KCb + (size_t)bg * 128 * 64, VCb + (size_t)bg * 128 * 64, 64, tid);
        stage_load(st1, KCb + (size_t)bg * 128 * 64 + 64 * 64, VCb + (size_t)bg * 128 * 64 + 64 * 64, 64, tid);
        stage_store(st0, lds + L_K, lds + L_V, tid);
        stage_store(st1, lds + L_K + TILEB, lds + L_V + TILEB, tid);
        __syncthreads();
        LAS float* oaL = (LAS float*)(lds + L_OA) + tid;
#pragma unroll 1
        for (int xr_ = 0; xr_ <= XCMP; ++xr_)
        {
            const int cmax = (t >= 31) ? (((t - 31) >> 4) < 126 ? ((t - 31) >> 4) : 126) : -1;
            f32x16 o0, o1; float m = NEG, l = 0.f;
#pragma unroll
            for (int i = 0; i < 16; ++i) { o0[i] = 0.f; o1[i] = 0.f; }
#pragma unroll 1
            for (int tl = 0; tl < 2; ++tl) {
                f32x16 p0, p1;
                qk(p0, p1, lds + L_K + tl * TILEB, qf, r, h);
#pragma unroll
                for (int i = 0; i < 16; ++i) { const int c = 64 * tl + crow(i, h); if (c > cmax) p0[i] = NEG; if (c + 32 > cmax) p1[i] = NEG; }
                softmax_step(p0, p1, m, l, o0, o1);
                pv(o0, o1, lds + L_V + tl * TILEB, p0, p1, r, h);
            }
            l += __shfl_xor(l, 32);
            const float inv = l > 0.f ? 1.0f / l : 0.f;
            const float cf = gt[0] * inv;
#pragma unroll
            for (int i = 0; i < 16; ++i) { oaL[512 * i] = cf * o0[i]; oaL[512 * (16 + i)] = cf * o1[i]; }
            const float mc = ((m < -1e29f) ? 0.f : m) * C1;
            LAS float* slab = Pq + hh * SLB + qq * 33;
#pragma unroll 1
            for (int tl = 1; tl >= 0; --tl) {
                f32x16 p0, p1;
                qk(p0, p1, lds + L_K + tl * TILEB, qf, r, h);
#pragma unroll
                for (int i = 0; i < 16; ++i) { const int c = 64 * tl + crow(i, h);
                    p0[i] = (c > cmax) ? 0.f : __builtin_amdgcn_exp2f(p0[i] * C1 - mc) * inv; p1[i] = (c + 32 > cmax) ? 0.f : __builtin_amdgcn_exp2f(p1[i] * C1 - mc) * inv; }
#pragma unroll
                for (int k = 0; k < 4; ++k) {
                    slab[16 * tl + 2 * k + h] = 2.0f * (p0[4 * k] + p0[4 * k + 1] + p0[4 * k + 2]) + p0[4 * k + 3];
                    slab[16 * tl + 8 + 2 * k + h] = 2.0f * (p1[4 * k] + p1[4 * k + 1] + p1[4 * k + 2]) + p1[4 * k + 3]; }
                LDS_WAIT();
#pragma unroll
                for (int k = 0; k < 4; ++k) { const int s0 = 16 * tl + 2 * k + h + 1, s1 = 16 * tl + 8 + 2 * k + h + 1;
                    slab[s0] += p0[4 * k + 3]; if (s1 < 32) slab[s1] += p1[4 * k + 3]; }
                LDS_WAIT();
            }
        }
        __syncthreads();
        Stage st;
        stage_load(st, Pb + 1536 + g * 64, Pb + 1792 + g * 64, ld, tid);
#pragma unroll 1
        for (int xr_ = 0; xr_ <= XSELN; ++xr_)
        {
            const int cur = qb, q = tid >> 3, sub = tid & 7;
            float scv[4];
#pragma unroll
            for (int j = 0; j < 4; ++j) { const int s_ = 4 * sub + j; const LAS float* pr = Pq + q * 33 + s_;
                const float imp = (pr[0] + pr[SLB]) + (pr[2 * SLB] + pr[3 * SLB]);
                const bool forced = (s_ == 0) || (s_ == cur) || (s_ == cur - 1);
                scv[j] = forced ? 1e30f : (s_ <= cur ? imp : NEG); }
            unsigned mask = 0u;
#pragma unroll 1
            for (int rd = 0; rd < 8; ++rd) {
                float bv = scv[0]; int bi = 4 * sub;
#pragma unroll
                for (int j = 1; j < 4; ++j) if (scv[j] > bv) { bv = scv[j]; bi = 4 * sub + j; }
#define SEL_STEP(CTRL) { const float ov = dppf<CTRL>(bv); const int oi = __float_as_int(dppf<CTRL>(__int_as_float(bi))); if (ov > bv || (ov == bv && oi < bi)) { bv = ov; bi = oi; } }
                SEL_STEP(0xB1) SEL_STEP(0x4E) SEL_STEP(0x141)
#undef SEL_STEP
                if (bv > -0.5e30f) mask |= 1u << bi;
#pragma unroll
                for (int j = 0; j < 4; ++j) if (bi == 4 * sub + j) scv[j] = -INFINITY;
            }
            if (sub == 0) selm[q] = mask;
            unsigned any = mask;
#pragma unroll
            for (int o = 8; o < 64; o <<= 1) any |= __shfl_xor(any, o);
            if (lane == 0) __hip_atomic_fetch_or(selm + 64, any, __ATOMIC_RELAXED, __HIP_MEMORY_SCOPE_WORKGROUP);
            __syncthreads();
        }
        const unsigned anymask = __builtin_amdgcn_readfirstlane(selm[64]);
        {
            f32x16 o0, o1; float m = NEG, l = 0.f;
#pragma unroll
            for (int i = 0; i < 16; ++i) { o0[i] = 0.f; o1[i] = 0.f; }
            const unsigned live = anymask & (qb == 31 ? 0xffffffffu : ((2u << qb) - 1u));
            sp_stream<0, true>(lds, Pb, ld, g, qb, qq, tid, r, h, live, selm, qf, st, o0, o1, m, l);
            l += __shfl_xor(l, 32);
            const float cf = l > 0.f ? gsave[0] / l : 0.f;
#pragma unroll
            for (int i = 0; i < 16; ++i) { oaL[512 * i] += cf * o0[i]; oaL[512 * (16 + i)] += cf * o1[i]; }
        }
        __syncthreads();
        {
            f32x16 o0, o1; float m = NEG, l = 0.f;
#pragma unroll
            for (int i = 0; i < 16; ++i) { o0[i] = 0.f; o1[i] = 0.f; }
            sp_stream<1, false>(lds, Pb, ld, g, qb, qq, tid, r, h, 0u, selm, qf, st, o0, o1, m, l);
            l += __shfl_xor(l, 32);
            const float cf = l > 0.f ? gsave[1] / l : 0.f;
#pragma unroll
            for (int i = 0; i < 16; ++i) { o0[i] = oaL[512 * i] + cf * o0[i]; o1[i] = oaL[512 * (16 + i)] + cf * o1[i]; }
            bf16_t* orow = ATT + (size_t)(b * T + t) * D + (g * 4 + hh) * 64 + 4 * h;
#pragma unroll 1
            for (int xr_ = 0; xr_ <= XOUT; ++xr_)
#pragma unroll
            for (int k = 0; k < 4; ++k) {
                u32x2 w0, w1; w0.x = pg8::cvt_pk_bf16(o0[4 * k], o0[4 * k + 1]); w0.y = pg8::cvt_pk_bf16(o0[4 * k + 2], o0[4 * k + 3]);
                w1.x = pg8::cvt_pk_bf16(o1[4 * k], o1[4 * k + 1]); w1.y = pg8::cvt_pk_bf16(o1[4 * k + 2], o1[4 * k + 3]);
                *(u32x2*)(orow + 8 * k) = w0; *(u32x2*)(orow + 32 + 8 * k) = w1;
            }
        }
        __syncthreads();
    }
}
__device__ __forceinline__ float logsigmoidf_(float x) { return fminf(x, 0.f) - log1pf(__expf(-fabsf(x))); }
__device__ __forceinline__ void phase_mlstm_scan(Frame& F) {
    constexpr int QP = 132;
    LAS float* qL = (LAS float*)F.lds;
    LAS float* kL = qL + 64 * QP;
    LAS float* vL = kL + 64 * QP;
    LAS float* SL = vL + 64 * 128;
    LAS float* vec = SL + 64 * 68;
    LAS float* bL = vec;
    LAS float* liL = vec + 64;
    LAS float* mtL = vec + 128;
    LAS float* wiL = vec + 192;
    LAS float* dnL = vec + 256;
    LAS float* wkL = vec + 320;
    LAS float* nL = vec + 384;
    LAS float* scl = vec + 512;
    LAS float* rsL = vec + 576;
    LAS float* qnL = vec + 640;
    const bf16_t* P = WSP(bf16_t, OFF_PROJ); bf16_t* HO = WSP(bf16_t, OFF_HM);
    int tid = F.tid; asm volatile("; phase-local tid" : "+v"(tid));
    const int lane = tid & 63, ld = ML_LD;
    int v_ = tid >> 2, kq = tid & 3;
    for (int item = F.bx; item < BATCH * 4 * 2; item += F.G) {
        const int vh = item & 1, h = (item >> 1) & 3, b = item >> 3;
        float C[32];
#pragma unroll
        for (int j = 0; j < 32; ++j) C[j] = 0.f;
        if (tid < 128) nL[tid] = 0.f;
        if (tid == 0) scl[0] = 0.f;
        __syncthreads();
#pragma unroll 1
        for (int ch = 0; ch < T / 64; ++ch) {
            asm volatile("; chunk-local" : "+v"(v_), "+v"(kq), "+v"(tid));
            const int t0 = ch * 64; const bf16_t* Pc = P + (size_t)(b * T + t0) * ld;
            {
                const int c2 = tid & 255, part = tid >> 8;
                const int col = (c2 < 128) ? (h * 128 + c2) : (512 + h * 128 + (c2 - 128));
                const float w0 = inptr(F, I_ML_CONV_W)[0 * 1024 + col], w1 = inptr(F, I_ML_CONV_W)[1 * 1024 + col], w2 = inptr(F, I_ML_CONV_W)[2 * 1024 + col], w3 = inptr(F, I_ML_CONV_W)[3 * 1024 + col], cb = inptr(F, I_ML_CONV_B)[col];
                const float scale = (c2 < 128) ? 1.0f : 0.08838834764831845f;
                const int r0 = part * 32;
                float x0 = (t0 + r0 - 3 >= 0) ? bf2f(Pc[(long)(r0 - 3) * ld + col]) : 0.f;
                float x1 = (t0 + r0 - 2 >= 0) ? bf2f(Pc[(long)(r0 - 2) * ld + col]) : 0.f;
                float x2 = (t0 + r0 - 1 >= 0) ? bf2f(Pc[(long)(r0 - 1) * ld + col]) : 0.f;
                LAS float* dst = (c2 < 128) ? (qL + c2) : (kL + (c2 - 128));
                for (int r = r0; r < r0 + 32; ++r) { const float x3 = bf2f(Pc[(long)r * ld + col]);
                    const float y = w0 * x0 + w1 * x1 + w2 * x2 + w3 * x3 + cb; dst[r * QP] = y * sigmoidf_(y) * scale; x0 = x1; x1 = x2; x2 = x3; }
                const int vc = tid & 127, vp = tid >> 7;
                for (int r = vp * 16; r < vp * 16 + 16; ++r) vL[r * 128 + vc] = bf2f(Pc[(long)r * ld + 1024 + h * 256 + vh * 128 + vc]);
                if (tid < 64) { liL[tid] = bf2f(Pc[(long)tid * ld + 3072 + h]) + inptr(F, I_ML_GATE_B)[h];
                    bL[tid] = logsigmoidf_(bf2f(Pc[(long)tid * ld + 3076 + h]) + inptr(F, I_ML_GATE_B)[4 + h]); }
            }
            __syncthreads();
            if (tid < 64) {
                float bb = bL[lane];
#pragma unroll
                for (int o = 1; o < 64; o <<= 1) { const float u = __shfl_up(bb, o); if (lane >= o) bb += u; }
                const float li = liL[lane]; float pm = li - bb;
#pragma unroll
                for (int o = 1; o < 64; o <<= 1) { const float u = __shfl_up(pm, o); if (lane >= o) pm = fmaxf(pm, u); }
                const float mprev = scl[0];
                const float mt = fmaxf(bb + mprev, bb + pm);
                const float bend = __shfl(bb, 63);
                const float decay = bend - bb + li;
                const float mnew = fmaxf(bend + mprev, wave_max(decay));
                bL[lane] = bb; mtL[lane] = mt; wiL[lane] = __expf(bb + mprev - mt); wkL[lane] = __expf(decay - mnew);
                if (lane == 0) { scl[1] = __expf(bend + mprev - mnew); scl[2] = mnew; }
            }
            __syncthreads();
            {
                const int t = tid >> 3, sg = tid & 7;
                float a[8];
#pragma unroll
                for (int j = 0; j < 8; ++j) a[j] = 0.f;
#pragma unroll 1
                for (int k4 = 0; k4 < 32; ++k4) { const f32x4 qv = *(const LAS f32x4*)(qL + t * QP + k4 * 4);
#pragma unroll
                    for (int j = 0; j < 8; ++j) { const f32x4 kv = *(const LAS f32x4*)(kL + (sg + 8 * j) * QP + k4 * 4); a[j] += (qv[0] * kv[0] + qv[1] * kv[1]) + (qv[2] * kv[2] + qv[3] * kv[3]); } }
                const float bt = bL[t], mt = mtL[t];
#pragma unroll
                for (int j = 0; j < 8; ++j) { const int s = sg + 8 * j; SL[t * 68 + s] = (s <= t) ? a[j] * __expf(bt - bL[s] + liL[s] - mt) : 0.f; }
            }
            __syncthreads();
            if (tid < 64) { float rs = 0.f; for (int s = 0; s < 64; ++s) rs += SL[tid * 68 + s]; rsL[tid] = rs; }
            else if (tid < 128) { const int t = tid - 64; float qn = 0.f; for (int k = 0; k < 128; ++k) qn += qL[t * QP + k] * nL[k]; qnL[t] = qn; }
            __syncthreads();
            if (tid < 64) { const float den = rsL[tid] + wiL[tid] * qnL[tid]; dnL[tid] = 1.0f / fmaxf(fabsf(den), __expf(-mtL[tid])); }
            __syncthreads();
            {
                float vr[16];
#pragma unroll
                for (int j = 0; j < 16; ++j) vr[j] = vL[(kq * 16 + j) * 128 + v_];
#pragma unroll 1
                for (int tg = 0; tg < 4; ++tg) {
                    float res[4];
#pragma unroll
                    for (int ti = 0; ti < 16; ++ti) { const int t = tg * 16 + ti;
                        float aC = 0.f, aS = 0.f;
#pragma unroll
                        for (int j4 = 0; j4 < 8; ++j4) { const f32x4 qv = *(const LAS f32x4*)(qL + t * QP + kq * 32 + j4 * 4);
                            aC += (qv[0] * C[j4 * 4] + qv[1] * C[j4 * 4 + 1]) + (qv[2] * C[j4 * 4 + 2] + qv[3] * C[j4 * 4 + 3]); }
#pragma unroll
                        for (int j4 = 0; j4 < 4; ++j4) { const f32x4 sv = *(const LAS f32x4*)(SL + t * 68 + kq * 16 + j4 * 4);
                            aS += (sv[0] * vr[j4 * 4] + sv[1] * vr[j4 * 4 + 1]) + (sv[2] * vr[j4 * 4 + 2] + sv[3] * vr[j4 * 4 + 3]); }
                        float tot = aS + wiL[t] * aC;
                        tot += __shfl_xor(tot, 1); tot += __shfl_xor(tot, 2);
                        tot *= dnL[t];
                        if ((ti & 3) == kq) res[ti >> 2] = tot;
                        asm volatile("" ::: "memory");
                    }
#pragma unroll
                    for (int q = 0; q < 4; ++q) { const int t = tg * 16 + q * 4 + kq; HO[(size_t)(b * T + t0 + t) * D + h * 256 + vh * 128 + v_] = (bf16_t)f2bf(res[q]); }
                }
            }
            __syncthreads();
            {
                const float cs = scl[1];
#pragma unroll
                for (int j = 0; j < 32; ++j) C[j] *= cs;
#pragma unroll 2
                for (int s = 0; s < 64; ++s) { const float a = vL[s * 128 + v_] * wkL[s];
#pragma unroll
                    for (int j4 = 0; j4 < 8; ++j4) { const f32x4 kv = *(const LAS f32x4*)(kL + s * QP + kq * 32 + j4 * 4);
                        C[j4 * 4] += a * kv[0]; C[j4 * 4 + 1] += a * kv[1]; C[j4 * 4 + 2] += a * kv[2]; C[j4 * 4 + 3] += a * kv[3]; } }
                if (tid < 128) { float nn = nL[tid] * cs; for (int s = 0; s < 64; ++s) nn += wkL[s] * kL[s * QP + tid]; nL[tid] = nn; }
                if (tid == 0) scl[0] = scl[2];
            }
            __syncthreads();
        }
    }
}
template <int HD>
__device__ __forceinline__ void phase_norm_gate(Frame& F, const float* norm_g, int ld, int gate_col0) {
    const bf16_t* HI = WSP(bf16_t, OFF_HM); const bf16_t* P = WSP(bf16_t, OFF_PROJ); bf16_t* ATT = WSP(bf16_t, OFF_ATT);
    int lane = F.lane; asm volatile("; phase-local lane" : "+v"(lane)); const int gw = F.bx * 8 + F.wave, NGW = F.G * 8;
    u32x2 hq[4], gq[4];
    if (gw < NTOK) { const u32x2* hr = (const u32x2*)(HI + (size_t)gw * D) + lane; const u32x2* gr = (const u32x2*)(P + (size_t)gw * ld + gate_col0) + lane;
#pragma unroll
        for (int j = 0; j < 4; ++j) { hq[j] = hr[64 * j]; gq[j] = gr[64 * j]; } }
#pragma unroll 1
    for (int m = gw; m < NTOK; m += NGW) {
        u32x2 hc[4], gc[4];
#pragma unroll
        for (int j = 0; j < 4; ++j) { hc[j] = hq[j]; gc[j] = gq[j]; }
        if (m + NGW < NTOK) { const u32x2* hr = (const u32x2*)(HI + (size_t)(m + NGW) * D) + lane; const u32x2* gr = (const u32x2*)(P + (size_t)(m + NGW) * ld + gate_col0) + lane;
#pragma unroll
            for (int j = 0; j < 4; ++j) { hq[j] = hr[64 * j]; gq[j] = gr[64 * j]; } }
        u32x2* orow = (u32x2*)(ATT + (size_t)m * D) + lane;
#pragma unroll
        for (int j = 0; j < 4; ++j) {
            const u32x2 hv = hc[j], gv = gc[j];
            float x[4] = {__uint_as_float(hv.x << 16), __uint_as_float(hv.x & 0xffff0000u), __uint_as_float(hv.y << 16), __uint_as_float(hv.y & 0xffff0000u)};
            const float gt[4] = {__uint_as_float(gv.x << 16), __uint_as_float(gv.x & 0xffff0000u), __uint_as_float(gv.y << 16), __uint_as_float(gv.y & 0xffff0000u)};
            float ss = (x[0] * x[0] + x[1] * x[1]) + (x[2] * x[2] + x[3] * x[3]);
#pragma unroll
            for (int o = 1; o < (HD == 256 ? 64 : 32); o <<= 1) ss += __shfl_xor(ss, o);
            const float r = __builtin_amdgcn_rsqf(ss * (1.0f / HD) + RMS_EPS);
            const f32x4 ng = *((const f32x4*)norm_g + lane + 64 * j);
            float o4[4];
#pragma unroll
            for (int q = 0; q < 4; ++q) o4[q] = x[q] * r * ng[q] * sigmoidf_(gt[q]);
            u32x2 o; o.x = pk2(o4[0], o4[1]); o.y = pk2(o4[2], o4[3]); orow[64 * j] = o;
        }
    }
}

__device__ __forceinline__ void phase_hgrn_scan(Frame& F) {
    constexpr int QP = 132;
    LAS float* qL = (LAS float*)F.lds;
    LAS float* kL = qL + 32 * QP;
    LAS float* vL = kL + 32 * QP;
    LAS float* AL = vL + 32 * 128;
    LAS float* geL = AL + 32 * 36;
    const bf16_t* P = WSP(bf16_t, OFF_PROJ); bf16_t* HO = WSP(bf16_t, OFF_HM);
    const float* lbt = WSP(float, OFF_TAB) + TAB_LB;
    int tid = F.tid; asm volatile("; phase-local tid" : "+v"(tid));
    const int ld = HG_LD;
    int v_ = tid >> 2, kq = tid & 3;
    for (int item = F.bx; item < BATCH * 8; item += F.G) {
        const int h = item & 7, b = item >> 3;
        float S[32];
#pragma unroll
        for (int j = 0; j < 32; ++j) S[j] = 0.f;
#pragma unroll 1
        for (int ch = 0; ch < T / 32; ++ch) {
            asm volatile("; chunk-local" : "+v"(v_), "+v"(kq), "+v"(tid));
            const int t0 = ch * 32; const bf16_t* Pc = P + (size_t)(b * T + t0) * ld;
            { const int c = tid & 127, p4 = tid >> 7;
#pragma unroll 2
              for (int r = p4 * 8; r < p4 * 8 + 8; ++r) { qL[r * QP + c] = bf2f(Pc[(long)r * ld + h * 128 + c]); kL[r * QP + c] = bf2f(Pc[(long)r * ld + 1024 + h * 128 + c]); vL[r * 128 + c] = bf2f(Pc[(long)r * ld + 2048 + h * 128 + c]); } }
            __syncthreads();
            if (tid < 128) { const float lb = lbt[h * 128 + tid]; float G = 0.f;
#pragma unroll 2
                for (int r = 0; r < 32; ++r) { const float qr = qL[r * QP + tid], fr = kL[r * QP + tid];
                    const float f = lb + (1.0f - lb) * sigmoidf_(fr); G += __logf(f);
                    qL[r * QP + tid] = qr * sigmoidf_(qr) * __expf(G); kL[r * QP + tid] = (1.0f - f) * __expf(-G); }
                geL[tid] = __expf(G); }
            __syncthreads();
            { const int t = tid >> 4, sg = tid & 15;
              float a0 = 0.f, a1 = 0.f;
#pragma unroll 2
              for (int k4 = 0; k4 < 32; ++k4) { const f32x4 qv = *(const LAS f32x4*)(qL + t * QP + k4 * 4);
                  const f32x4 k0 = *(const LAS f32x4*)(kL + sg * QP + k4 * 4), k1 = *(const LAS f32x4*)(kL + (sg + 16) * QP + k4 * 4);
                  a0 += (qv[0] * k0[0] + qv[1] * k0[1]) + (qv[2] * k0[2] + qv[3] * k0[3]); a1 += (qv[0] * k1[0] + qv[1] * k1[1]) + (qv[2] * k1[2] + qv[3] * k1[3]); }
              AL[t * 36 + sg] = (sg <= t) ? a0 : 0.f; AL[t * 36 + sg + 16] = (sg + 16 <= t) ? a1 : 0.f; }
            __syncthreads();
            {
                float vr[8];
#pragma unroll
                for (int j = 0; j < 8; ++j) vr[j] = vL[(kq * 8 + j) * 128 + v_];
#pragma unroll 2
                for (int t = 0; t < 32; ++t) {
                    float a = 0.f;
#pragma unroll
                    for (int j4 = 0; j4 < 8; ++j4) { const f32x4 qv = *(const LAS f32x4*)(qL + t * QP + kq * 32 + j4 * 4);
                        a += (qv[0] * S[j4 * 4] + qv[1] * S[j4 * 4 + 1]) + (qv[2] * S[j4 * 4 + 2] + qv[3] * S[j4 * 4 + 3]); }
#pragma unroll
                    for (int j4 = 0; j4 < 2; ++j4) { const f32x4 sv = *(const LAS f32x4*)(AL + t * 36 + kq * 8 + j4 * 4);
                        a += (sv[0] * vr[j4 * 4] + sv[1] * vr[j4 * 4 + 1]) + (sv[2] * vr[j4 * 4 + 2] + sv[3] * vr[j4 * 4 + 3]); }
                    a += __shfl_xor(a, 1); a += __shfl_xor(a, 2);
                    if ((t & 3) == kq) HO[(size_t)(b * T + t0 + t) * D + h * 128 + v_] = (bf16_t)f2bf(a);
                    asm volatile("" ::: "memory");
                }
            }
            {
#pragma unroll 2
                for (int s = 0; s < 32; ++s) { const float a = vL[s * 128 + v_];
#pragma unroll
                    for (int j4 = 0; j4 < 8; ++j4) { const f32x4 kv = *(const LAS f32x4*)(kL + s * QP + kq * 32 + j4 * 4);
                        S[j4 * 4] += a * kv[0]; S[j4 * 4 + 1] += a * kv[1]; S[j4 * 4 + 2] += a * kv[2]; S[j4 * 4 + 3] += a * kv[3]; } }
#pragma unroll
                for (int j4 = 0; j4 < 8; ++j4) { const f32x4 ge = *(const LAS f32x4*)(geL + kq * 32 + j4 * 4);
                    S[j4 * 4] *= ge[0]; S[j4 * 4 + 1] *= ge[1]; S[j4 * 4 + 2] *= ge[2]; S[j4 * 4 + 3] *= ge[3]; }
            }
            __syncthreads();
        }
    }
}
namespace ml {
constexpr int PK = 272, PS = 144;
constexpr int L_Q = 0, L_KK = L_Q + 64 * PK, L_KWT = L_KK + 64 * PK, L_VT = L_KWT + 128 * PS, L_S = L_VT + 144 * PS, L_C = L_S + 64 * PS, L_VEC = L_C + 144 * PK;
typedef float f32x4_ __attribute__((ext_vector_type(4)));
__device__ __forceinline__ bf16x8 frag(const LAS unsigned char* base, int row, int pitch, int kelem) { return *(const LAS bf16x8*)(base + row * pitch + kelem * 2); }
}
__device__ __forceinline__ void phase_mlstm_scan_mfma(Frame& F) {
    using namespace ml;
    LAS unsigned char* lds = F.lds;
    LAS float* vec = (LAS float*)(lds + L_VEC);
    LAS float* bL = vec; LAS float* liL = vec + 64; LAS float* mtL = vec + 128; LAS float* wiL = vec + 192; LAS float* wkL = vec + 256; LAS float* scl = vec + 320;
    const bf16_t* P = WSP(bf16_t, OFF_PROJ); bf16_t* HO = WSP(bf16_t, OFF_HM);
    int tid = F.tid; asm volatile("; phase-local tid" : "+v"(tid));
    const int lane = tid & 63, wave = __builtin_amdgcn_readfirstlane(tid >> 6), ld = ML_LD;
    const int fr = lane & 15, fg = lane >> 4;
#pragma unroll 1
    for (int item = F.bx; item < BATCH * 4 * 2; item += F.G) {
        const int vh = item & 1, h = (item >> 1) & 3, b = item >> 3;
        f32x4 Cacc[9];
#pragma unroll
        for (int j = 0; j < 9; ++j) Cacc[j] = (f32x4){0.f, 0.f, 0.f, 0.f};
        for (int i = tid; i < 16 * 64; i += 512) { const int rr = i >> 6, s = i & 63; *(LAS unsigned short*)(lds + L_VT + (128 + rr) * PS + s * 2) = (rr == 0) ? (unsigned short)0x3F80 : (unsigned short)0; }
        for (int i = tid; i < 144 * PK / 4; i += 512) ((LAS unsigned*)(lds + L_C))[i] = 0u;
        if (tid == 0) scl[0] = 0.f;
        const int c2 = tid & 255, part = __builtin_amdgcn_readfirstlane(tid >> 8);
        const int col = (c2 < 128) ? (h * 128 + c2) : (512 + h * 128 + (c2 - 128));
        const float* cw = inptr(F, I_ML_CONV_W); const float* cbp = inptr(F, I_ML_CONV_B); const float* gbp = inptr(F, I_ML_GATE_B);
        const float w0 = cw[0 * 1024 + col], w1 = cw[1 * 1024 + col], w2 = cw[2 * 1024 + col], w3 = cw[3 * 1024 + col], cb = cbp[col];
        const float gbi = gbp[h], gbf = gbp[4 + h];
        const float qscale = (c2 < 128) ? 1.0f : 0.08838834764831845f;
        unsigned short xn[35]; u32x4 vn[2]; unsigned short gin = 0, gfn = 0;
        { const bf16_t* Pc = P + (size_t)(b * T) * ld; const int r0 = part * 32;
          const bf16_t* rp = Pc + (long)(r0 - 3) * ld;
#pragma unroll
          for (int i = 0; i < 35; ++i) { xn[i] = (r0 - 3 + i >= 0) ? rp[col] : (unsigned short)0; rp += ld; asm volatile("" : "+s"(rp)); }
          const int key = tid >> 3, dc = tid & 7;
#pragma unroll
          for (int q = 0; q < 2; ++q) vn[q] = *(const u32x4*)(Pc + (long)key * ld + 1024 + h * 256 + vh * 128 + (dc + 8 * q) * 8);
          if (wave == 0) { gin = Pc[(long)lane * ld + 3072 + h]; gfn = Pc[(long)lane * ld + 3076 + h]; } }
        __syncthreads();
#pragma unroll 1
        for (int ch = 0; ch < T / 64; ++ch) {
            const int t0 = ch * 64; const bf16_t* Pc = P + (size_t)(b * T + t0) * ld;
            if (wave == 0) {
                const float li = bf2f(gin) + gbi;
                float bb = logsigmoidf_(bf2f(gfn) + gbf);
#pragma unroll
                for (int o = 1; o < 64; o <<= 1) { const float u = __shfl_up(bb, o); if (lane >= o) bb += u; }
                float pm = li - bb;
#pragma unroll
                for (int o = 1; o < 64; o <<= 1) { const float u = __shfl_up(pm, o); if (lane >= o) pm = fmaxf(pm, u); }
                const float mprev = scl[0];
                const float mt = fmaxf(bb + mprev, bb + pm);
                const float bend = __shfl(bb, 63);
                const float decay = bend - bb + li;
                const float mnew = fmaxf(bend + mprev, wave_max(decay));
                bL[lane] = bb; liL[lane] = li; mtL[lane] = mt; wiL[lane] = __expf(bb + mprev - mt); wkL[lane] = __expf(decay - mnew);
                if (lane == 0) { scl[1] = __expf(bend + mprev - mnew); scl[2] = mnew; }
            }
            __syncthreads();
            {
                const int r0 = part * 32;
                LAS unsigned char* rowbase = lds + ((c2 < 128) ? L_Q : L_KK) + (c2 & 127) * 2;
#pragma unroll
                for (int i = 0; i < 32; ++i) { const int rr = r0 + i;
                    const float y = w0 * bf2f(xn[i]) + w1 * bf2f(xn[i + 1]) + w2 * bf2f(xn[i + 2]) + w3 * bf2f(xn[i + 3]) + cb; const float o = y * sigmoidf_(y) * qscale;
                    *(LAS unsigned short*)(rowbase + rr * PK) = (unsigned short)f2bf(o);
                    if (c2 >= 128) *(LAS unsigned short*)(lds + L_KWT + (c2 - 128) * PS + rr * 2) = (unsigned short)f2bf(o * wkL[rr]);
                    if ((i & 3) == 3) asm volatile("" ::: "memory"); }
                const int key = tid >> 3, dc = tid & 7;
#pragma unroll
                for (int q = 0; q < 2; ++q) { const unsigned w[4] = {vn[q].x, vn[q].y, vn[q].z, vn[q].w};
#pragma unroll
                    for (int e = 0; e < 4; ++e) { const int vrow = (dc + 8 * q) * 8 + 2 * e;
                        *(LAS unsigned short*)(lds + L_VT + vrow * PS + key * 2) = (unsigned short)(w[e] & 0xffffu); *(LAS unsigned short*)(lds + L_VT + (vrow + 1) * PS + key * 2) = (unsigned short)(w[e] >> 16); } }
            }
            if (ch + 1 < T / 64) {
                const bf16_t* Pn = Pc + (size_t)64 * ld; const int r0 = part * 32;
                const bf16_t* rp = Pn + (long)(r0 - 3) * ld;
#pragma unroll
                for (int i = 0; i < 35; ++i) { xn[i] = rp[col]; rp += ld; asm volatile("" : "+s"(rp)); }
                const int key = tid >> 3, dc = tid & 7;
#pragma unroll
                for (int q = 0; q < 2; ++q) vn[q] = *(const u32x4*)(Pn + (long)key * ld + 1024 + h * 256 + vh * 128 + (dc + 8 * q) * 8);
                if (wave == 0) { gin = Pn[(long)lane * ld + 3072 + h]; gfn = Pn[(long)lane * ld + 3076 + h]; }
            }
            __syncthreads();
#pragma unroll
            for (int q = 0; q < 2; ++q) {
                const int idx = 2 * wave + q, ti = idx >> 2, tj = idx & 3;
                f32x4 a = (f32x4){0.f, 0.f, 0.f, 0.f};
                if (ti <= tj) {
#pragma unroll
                    for (int ks = 0; ks < 4; ++ks) a = __builtin_amdgcn_mfma_f32_16x16x32_bf16(frag(lds + L_KK, 16 * ti + fr, PK, 32 * ks + 8 * fg), frag(lds + L_Q, 16 * tj + fr, PK, 32 * ks + 8 * fg), a, 0, 0, 0);
                    const int t = 16 * tj + fr; const float bt = bL[t], mt = mtL[t];
#pragma unroll
                    for (int e = 0; e < 4; ++e) { const int s = 16 * ti + 4 * fg + e; a[e] = (s <= t) ? a[e] * __expf(bt - bL[s] + liL[s] - mt) : 0.f; }
                }
                u32x2 w; w.x = pg8::cvt_pk_bf16(a[0], a[1]); w.y = pg8::cvt_pk_bf16(a[2], a[3]);
                *(LAS u32x2*)(lds + L_S + (16 * tj + fr) * PS + (16 * ti + 4 * fg) * 2) = w;
            }
            __syncthreads();
            {
#pragma unroll 1
                for (int tj = 0; tj < 4; ++tj) {
                    f32x4 a1 = (f32x4){0.f, 0.f, 0.f, 0.f}, a2 = a1, d1 = a1, d2 = a1;
#pragma unroll
                    for (int ks = 0; ks < 2; ++ks) { const bf16x8 bs = frag(lds + L_S, 16 * tj + fr, PS, 32 * ks + 8 * fg);
                        a1 = __builtin_amdgcn_mfma_f32_16x16x32_bf16(frag(lds + L_VT, 16 * wave + fr, PS, 32 * ks + 8 * fg), bs, a1, 0, 0, 0);
                        d1 = __builtin_amdgcn_mfma_f32_16x16x32_bf16(frag(lds + L_VT, 128 + fr, PS, 32 * ks + 8 * fg), bs, d1, 0, 0, 0); }
#pragma unroll
                    for (int ks = 0; ks < 4; ++ks) { const bf16x8 bq = frag(lds + L_Q, 16 * tj + fr, PK, 32 * ks + 8 * fg);
                        a2 = __builtin_amdgcn_mfma_f32_16x16x32_bf16(frag(lds + L_C, 16 * wave + fr, PK, 32 * ks + 8 * fg), bq, a2, 0, 0, 0);
                        d2 = __builtin_amdgcn_mfma_f32_16x16x32_bf16(frag(lds + L_C, 128 + fr, PK, 32 * ks + 8 * fg), bq, d2, 0, 0, 0); }
                    const int t = 16 * tj + fr; const float wi = wiL[t];
                    float den = d1[0] + wi * d2[0];
                    den = __shfl(den, fr);
                    const float inv = __builtin_amdgcn_rcpf(fmaxf(fabsf(den), __expf(-mtL[t])));
                    u32x2 w; w.x = pg8::cvt_pk_bf16((a1[0] + wi * a2[0]) * inv, (a1[1] + wi * a2[1]) * inv); w.y = pg8::cvt_pk_bf16((a1[2] + wi * a2[2]) * inv, (a1[3] + wi * a2[3]) * inv);
                    *(u32x2*)(HO + (size_t)(b * T + t0 + t) * D + h * 256 + vh * 128 + 16 * wave + 4 * fg) = w;
                }
            }
            __syncthreads();
            {
                const float cs = scl[1];
                const bf16x8 ka0 = frag(lds + L_KWT, 16 * wave + fr, PS, 8 * fg), ka1 = frag(lds + L_KWT, 16 * wave + fr, PS, 32 + 8 * fg);
#pragma unroll
                for (int j = 0; j < 9; ++j) {
                    Cacc[j] = Cacc[j] * cs;
                    Cacc[j] = __builtin_amdgcn_mfma_f32_16x16x32_bf16(ka0, frag(lds + L_VT, 16 * j + fr, PS, 8 * fg), Cacc[j], 0, 0, 0);
                    Cacc[j] = __builtin_amdgcn_mfma_f32_16x16x32_bf16(ka1, frag(lds + L_VT, 16 * j + fr, PS, 32 + 8 * fg), Cacc[j], 0, 0, 0);
                    u32x2 w; w.x = pg8::cvt_pk_bf16(Cacc[j][0], Cacc[j][1]); w.y = pg8::cvt_pk_bf16(Cacc[j][2], Cacc[j][3]);
                    *(LAS u32x2*)(lds + L_C + (16 * j + fr) * PK + (16 * wave + 4 * fg) * 2) = w;
                }
                if (tid == 0) scl[0] = scl[2];
            }
            __syncthreads();
        }
    }
}
namespace hg {
constexpr int PK = 272, PS = 144;
constexpr int L_QD = 0, L_KD = L_QD + 64 * PK, L_KDT = L_KD + 64 * PK, L_VT = L_KDT + 128 * PS, L_A = L_VT + 128 * PS, L_ST = L_A + 64 * PS, L_TOT = L_ST + 128 * PK, L_GE = L_TOT + 4 * 128 * 4, L_SSQ = L_GE + 128 * 4;
__device__ __forceinline__ bf16x8 frag(const LAS unsigned char* base, int row, int pitch, int kelem) { return *(const LAS bf16x8*)(base + row * pitch + kelem * 2); }
}
__device__ __forceinline__ void phase_hgrn_scan_mfma(Frame& F) {
    using namespace hg;
    LAS unsigned char* lds = F.lds;
    LAS float* totL = (LAS float*)(lds + L_TOT); LAS float* geL = (LAS float*)(lds + L_GE);
    const bf16_t* P = WSP(bf16_t, OFF_PROJ); bf16_t* ATT = WSP(bf16_t, OFF_ATT);
    const float* lbt = WSP(float, OFF_TAB) + TAB_LB; const float* norm_g = inptr(F, I_HG_NORM_G);
    LAS float* ssqL = (LAS float*)(F.lds + hg::L_SSQ);
    int tid = F.tid; asm volatile("; phase-local tid" : "+v"(tid));
    const int lane = tid & 63, wave = __builtin_amdgcn_readfirstlane(tid >> 6), ld = HG_LD;
    const int fr = lane & 15, fg = lane >> 4;
    const int kc = tid & 127, part = __builtin_amdgcn_readfirstlane(tid >> 7);
    const int vkey = tid >> 3, vdc = tid & 7;
#pragma unroll 1
    for (int item = F.bx; item < BATCH * 8; item += F.G) {
        const int h = item & 7, b = item >> 3;
        f32x4 Sacc[8];
#pragma unroll
        for (int j = 0; j < 8; ++j) Sacc[j] = (f32x4){0.f, 0.f, 0.f, 0.f};
        for (int i = tid; i < 128 * PK / 4; i += 512) ((LAS unsigned*)(lds + L_ST))[i] = 0u;
        const float lb = lbt[h * 128 + kc];
        const f32x4 ngv = *(const f32x4*)(norm_g + h * 128 + 16 * wave + 4 * fg);
        unsigned short qn[16], fn[16]; u32x4 vn[2];
        { const bf16_t* Pc = P + (size_t)(b * T) * ld;
          const bf16_t* rp = Pc + (long)(16 * part) * ld + h * 128;
#pragma unroll
          for (int i = 0; i < 16; ++i) { qn[i] = rp[kc]; fn[i] = rp[1024 + kc]; rp += ld; asm volatile("" : "+s"(rp)); }
#pragma unroll
          for (int q = 0; q < 2; ++q) vn[q] = *(const u32x4*)(Pc + (long)vkey * ld + 2048 + h * 128 + (vdc + 8 * q) * 8); }
        __syncthreads();
#pragma unroll 1
        for (int ch = 0; ch < T / 64; ++ch) {
            const int t0 = ch * 64;
            float qs[16], kk[16], G[16]; u32x4 vv[2];
            {
                float run = 0.f;
#pragma unroll
                for (int i = 0; i < 16; ++i) { const float qr = bf2f(qn[i]), fraw = bf2f(fn[i]);
                    const float f = lb + (1.0f - lb) * sigmoidf_(fraw);
                    run += __logf(f); G[i] = run; qs[i] = qr * sigmoidf_(qr); kk[i] = 1.0f - f; }
                totL[part * 128 + kc] = run; vv[0] = vn[0]; vv[1] = vn[1];
            }
            __syncthreads();
            if (ch + 1 < T / 64) {
                const bf16_t* Pn = P + (size_t)(b * T + t0 + 64) * ld;
                const bf16_t* rp = Pn + (long)(16 * part) * ld + h * 128;
#pragma unroll
                for (int i = 0; i < 16; ++i) { qn[i] = rp[kc]; fn[i] = rp[1024 + kc]; rp += ld; asm volatile("" : "+s"(rp)); }
#pragma unroll
                for (int q = 0; q < 2; ++q) vn[q] = *(const u32x4*)(Pn + (long)vkey * ld + 2048 + h * 128 + (vdc + 8 * q) * 8);
            }
            {
                float off = 0.f, tot = 0.f;
#pragma unroll
                for (int p = 0; p < 4; ++p) { const float tp = totL[p * 128 + kc]; if (p < part) off += tp; tot += tp; }
                if (part == 3) geL[kc] = __expf(tot);
#pragma unroll
                for (int i = 0; i < 16; ++i) { const int r = 16 * part + i; const float g = G[i] + off;
                    const unsigned short qd = (unsigned short)f2bf(qs[i] * __expf(g)), kd = (unsigned short)f2bf(kk[i] * __expf(-g));
                    *(LAS unsigned short*)(lds + L_QD + r * PK + kc * 2) = qd; *(LAS unsigned short*)(lds + L_KD + r * PK + kc * 2) = kd; *(LAS unsigned short*)(lds + L_KDT + kc * PS + r * 2) = kd; }
#pragma unroll
                for (int q = 0; q < 2; ++q) { const unsigned w[4] = {vv[q].x, vv[q].y, vv[q].z, vv[q].w};
#pragma unroll
                    for (int e = 0; e < 4; ++e) { const int vrow = (vdc + 8 * q) * 8 + 2 * e;
                        *(LAS unsigned short*)(lds + L_VT + vrow * PS + vkey * 2) = (unsigned short)(w[e] & 0xffffu); *(LAS unsigned short*)(lds + L_VT + (vrow + 1) * PS + vkey * 2) = (unsigned short)(w[e] >> 16); } }
            }
            __syncthreads();
#pragma unroll
            for (int q = 0; q < 2; ++q) {
                const int idx = 2 * wave + q, ti = idx >> 2, tj = idx & 3;
                f32x4 a = (f32x4){0.f, 0.f, 0.f, 0.f};
                if (ti <= tj) {
#pragma unroll
                    for (int ks = 0; ks < 4; ++ks) a = __builtin_amdgcn_mfma_f32_16x16x32_bf16(frag(lds + L_KD, 16 * ti + fr, PK, 32 * ks + 8 * fg), frag(lds + L_QD, 16 * tj + fr, PK, 32 * ks + 8 * fg), a, 0, 0, 0);
                    const int t = 16 * tj + fr;
#pragma unroll
                    for (int e = 0; e < 4; ++e) { const int s = 16 * ti + 4 * fg + e; a[e] = (s <= t) ? a[e] : 0.f; }
                }
                u32x2 w; w.x = pg8::cvt_pk_bf16(a[0], a[1]); w.y = pg8::cvt_pk_bf16(a[2], a[3]);
                *(LAS u32x2*)(lds + L_A + (16 * tj + fr) * PS + (16 * ti + 4 * fg) * 2) = w;
            }
            __syncthreads();
            f32x4 ot[4]; u32x2 gq[4];
            const bf16_t* Pg = P + (size_t)(b * T + t0) * ld + 3072 + h * 128 + 16 * wave + 4 * fg;
#pragma unroll
            for (int tj = 0; tj < 4; ++tj) {
                f32x4 a = (f32x4){0.f, 0.f, 0.f, 0.f};
                gq[tj] = *(const u32x2*)(Pg + (size_t)(16 * tj + fr) * ld);
#pragma unroll
                for (int ks = 0; ks < 2; ++ks) a = __builtin_amdgcn_mfma_f32_16x16x32_bf16(frag(lds + L_VT, 16 * wave + fr, PS, 32 * ks + 8 * fg), frag(lds + L_A, 16 * tj + fr, PS, 32 * ks + 8 * fg), a, 0, 0, 0);
#pragma unroll
                for (int ks = 0; ks < 4; ++ks) a = __builtin_amdgcn_mfma_f32_16x16x32_bf16(frag(lds + L_ST, 16 * wave + fr, PK, 32 * ks + 8 * fg), frag(lds + L_QD, 16 * tj + fr, PK, 32 * ks + 8 * fg), a, 0, 0, 0);
                ot[tj] = a;
                float ss = (a[0] * a[0] + a[1] * a[1]) + (a[2] * a[2] + a[3] * a[3]);
                ss += __shfl_xor(ss, 16); ss += __shfl_xor(ss, 32);
                if (fg == 0) ssqL[wave * 64 + 16 * tj + fr] = ss;
            }
            __syncthreads();
#pragma unroll
            for (int tj = 0; tj < 4; ++tj) {
                const int t = 16 * tj + fr; float tot = 0.f;
#pragma unroll
                for (int w8 = 0; w8 < 8; ++w8) tot += ssqL[w8 * 64 + t];
                const float rr = __builtin_amdgcn_rsqf(tot * (1.0f / 128.0f) + RMS_EPS);
                const float g0 = __uint_as_float(gq[tj].x << 16), g1 = __uint_as_float(gq[tj].x & 0xffff0000u), g2 = __uint_as_float(gq[tj].y << 16), g3 = __uint_as_float(gq[tj].y & 0xffff0000u);
                u32x2 w; w.x = pg8::cvt_pk_bf16(ot[tj][0] * rr * ngv[0] * sigmoidf_(g0), ot[tj][1] * rr * ngv[1] * sigmoidf_(g1));
                w.y = pg8::cvt_pk_bf16(ot[tj][2] * rr * ngv[2] * sigmoidf_(g2), ot[tj][3] * rr * ngv[3] * sigmoidf_(g3));
                *(u32x2*)(ATT + (size_t)(b * T + t0 + t) * D + h * 128 + 16 * wave + 4 * fg) = w;
            }
            {
                const bf16x8 ka0 = frag(lds + L_KDT, 16 * wave + fr, PS, 8 * fg), ka1 = frag(lds + L_KDT, 16 * wave + fr, PS, 32 + 8 * fg);
                const f32x4 ge = *(const LAS f32x4*)(geL + 16 * wave + 4 * fg);
#pragma unroll
                for (int j = 0; j < 8; ++j) {
                    Sacc[j] = __builtin_amdgcn_mfma_f32_16x16x32_bf16(ka0, frag(lds + L_VT, 16 * j + fr, PS, 8 * fg), Sacc[j], 0, 0, 0);
                    Sacc[j] = __builtin_amdgcn_mfma_f32_16x16x32_bf16(ka1, frag(lds + L_VT, 16 * j + fr, PS, 32 + 8 * fg), Sacc[j], 0, 0, 0);
                    Sacc[j] = Sacc[j] * ge;
                    u32x2 w; w.x = pg8::cvt_pk_bf16(Sacc[j][0], Sacc[j][1]); w.y = pg8::cvt_pk_bf16(Sacc[j][2], Sacc[j][3]);
                    *(LAS u32x2*)(lds + L_ST + (16 * j + fr) * PK + (16 * wave + 4 * fg) * 2) = w;
                }
            }
            __syncthreads();
        }
    }
}
constexpr int PH_PER_LAYER = 10, N_PHASES = 1 + PH_PER_LAYER * DEPTH;
struct Args { const float* in[27]; float* out; unsigned char* ws; int ph_lo, ph_hi; };
__global__ void __launch_bounds__(512, 2) mk_fwd(Args args) {
    extern __shared__ __attribute__((aligned(16))) unsigned char lds[];
    Frame F;
    F.lds = (LAS unsigned char*)lds;
    F.LC = (volatile LAS unsigned*)(F.lds + LDSCTL_OFF);
    F.tid = threadIdx.x; F.lane = F.tid & 63; F.wave = __builtin_amdgcn_readfirstlane(F.tid >> 6); F.G = gridDim.x; F.bx = blockIdx.x;
    F.ws = (unsigned char*)(GAS unsigned char*)args.ws; F.ctl = (unsigned*)(F.ws + OFF_CTL); F.out = (float*)(GAS float*)args.out;
    for (int u = F.tid; u < (LDS_BYTES - LDSCTL_OFF) / 4; u += 512) F.LC[u] = 0u;
    __syncthreads();
    if (F.tid < 27) { const unsigned long long pv = (unsigned long long)args.in[F.tid]; F.LC[128 + 2 * F.tid] = (unsigned)pv; F.LC[129 + 2 * F.tid] = (unsigned)(pv >> 32); }
    __syncthreads();
    XcdBarrier bar; bar.bar = F.ctl + CW_BAR; bar.x = 0; bar.st = nullptr;
    if (!MK_PER_PHASE) bar = xcd_barrier_post(F.ctl + CW_BAR, F.LC);
    const int lo = args.ph_lo, hi = args.ph_hi;
#define IN(k) (lo <= (k) && (k) < hi)
#ifndef DBL_LNR
#define DBL_LNR 1
#endif
#ifndef DBL_COMB
#define DBL_COMB 1
#endif
#ifndef DBL_NG
#define DBL_NG 1
#endif
#ifndef DBL_GIN
#define DBL_GIN 1
#endif
#ifndef DBL_GOUT
#define DBL_GOUT 1
#endif
#ifndef DBL_GCMP
#define DBL_GCMP 1
#endif
#ifndef DBL_GUP
#define DBL_GUP 1
#endif
#ifndef DBL_GDN
#define DBL_GDN 1
#endif
#ifndef DBL_SCAN
#define DBL_SCAN 1
#endif
#ifndef DBL_P0
#define DBL_P0 1
#endif
#ifndef DBL_ATT
#define DBL_ATT 1
#endif
#define REP(n) _Pragma("unroll 1") for (int rep_ = 0; rep_ < (n); ++rep_)
#ifdef PROBE_A
#define STAMP(k) do { if (blockIdx.x == 0 && F.tid == 0) ((unsigned long long*)(F.ws + OFF_TAB + 65536))[(k)] = wall_clock64(); } while (0)
#else
#define STAMP(k) do {} while (0)
#endif
#define SEAM(k) do { if (!MK_PER_PHASE && (k) + 1 < hi) xcd_barrier(bar); else __syncthreads(); } while (0)

    STAMP(0);
    if (IN(0)) {
#ifndef NO_P0
 REP(DBL_P0) p0_prologue(F);
#endif
 SEAM(0); }

    for (int L = 0; L < DEPTH; ++L) {
        int Lo = L; asm volatile("; layer-local" : "+s"(Lo));
        const int kind = Lo % 3, slot = Lo / 3, pb = 1 + PH_PER_LAYER * Lo;
#define PHL Frame Fp = F; asm volatile("; phase-local" : "+v"(Fp.tid), "+s"(Fp.bx)); Fp.lane = Fp.tid & 63;
        const int ldp = kind == 0 ? NSA_LD : (kind == 1 ? ML_LD : HG_LD);
        if (IN(pb + 0)) { PHL STAMP(pb + 0);
            const bf16_t* Wt = kind == 0 ? WSP(bf16_t, OFF_W_NSAIN) + (size_t)slot * NSA_LD * D : (kind == 1 ? WSP(bf16_t, OFF_W_MLIN) : WSP(bf16_t, OFF_W_HGIN));
            pg8::APlain AS{WSP(bf16_t, OFF_XN), D}; pg8::BPlain BS{Wt, D}; pg8::StaticOrder S; S.init(NTOK / 256, ldp / 256, Fp.G, Fp.bx);
            pg8::EpiStore E{WSP(bf16_t, OFF_PROJ), ldp};
            #ifndef NO_GIN
            REP(DBL_GIN) pg8::gemm_phase<pg8::EpiStore, pg8::StaticOrder, pg8::APlain, pg8::BPlain>(Fp.lds, D, AS, BS, S, E);
#endif
            SEAM(pb + 0);
        }
        if (kind == 0) {
            if (IN(pb + 1)) { PHL STAMP(pb + 1);
                pg8::ACmp AS{WSP(bf16_t, OFF_PROJ), NSA_LD, 1024}; pg8::BGroup BS{WSP(bf16_t, OFF_W_CMP1) + (size_t)slot * 2 * 256 * 2048, 2048, (size_t)256 * 2048};
                pg8::CmpOrder S{Fp.G, Fp.bx};
                pg8::EpiCmpGelu E{WSP(bf16_t, OFF_HC), WSP(float, OFF_TAB) + TAB_CMPB + slot * 512};
                #ifndef NO_GCMP
                REP(DBL_GCMP) pg8::gemm_phase<pg8::EpiCmpGelu, pg8::CmpOrder, pg8::ACmp, pg8::BGroup>(Fp.lds, 2048, AS, BS, S, E);
#endif
                SEAM(pb + 1);
            }
            if (IN(pb + 2)) { PHL STAMP(pb + 2);
#ifndef NO_CMP2
 REP(DBL_GCMP) phase_nsa_cmp2(Fp, slot);
#endif
 SEAM(pb + 2); }
            if (IN(pb + 3)) { PHL STAMP(pb + 3);
#ifndef NO_ATTN
 REP(DBL_ATT) phase_nsa_attn_mfma(Fp, slot);
#endif
 SEAM(pb + 3); }
        } else if (kind == 1) {
            if (IN(pb + 1)) { PHL STAMP(pb + 1);
#ifdef MLS_CHECK
                {
                    const size_t n16 = (size_t)NTOK * D * 2 / 16; u32x4* HMv = WSP(u32x4, OFF_HM); u32x4* Y1 = WSP(u32x4, OFF_Y); u32x4* Y2 = WSP(u32x4, OFF_Y + 160 * MiB);
#pragma unroll 1
                    for (int rep_ = 0; rep_ < 3; ++rep_) {
                        phase_mlstm_scan_mfma(Fp);
                        xcd_barrier(bar);
                        if (rep_ < 2) { u32x4* dst = rep_ == 0 ? Y1 : Y2;
                            for (size_t i = (size_t)blockIdx.x * 512 + Fp.tid; i < n16; i += (size_t)Fp.G * 512) dst[i] = HMv[i];
                            xcd_barrier(bar); }
                    }
                    unsigned bad_bits = 0u; float md = 0.f, mr = 0.f;
                    for (size_t i = (size_t)blockIdx.x * 512 + Fp.tid; i < n16; i += (size_t)Fp.G * 512) { const u32x4 a = HMv[i], b2 = Y2[i], c1 = Y1[i];
                        if (a.x != b2.x || a.y != b2.y || a.z != b2.z || a.w != b2.w) bad_bits = 1u;
                        const unsigned aw[4] = {a.x, a.y, a.z, a.w}, cw[4] = {c1.x, c1.y, c1.z, c1.w};
#pragma unroll
                        for (int q = 0; q < 4; ++q) { const float a0 = __uint_as_float(aw[q] << 16), a1 = __uint_as_float(aw[q] & 0xffff0000u), r0 = __uint_as_float(cw[q] << 16), r1 = __uint_as_float(cw[q] & 0xffff0000u);
                            md = fmaxf(md, fmaxf(fabsf(a0 - r0), fabsf(a1 - r1))); mr = fmaxf(mr, fmaxf(fabsf(r0), fabsf(r1))); if (!(a0 == a0) || !(a1 == a1)) bad_bits |= 4u; } }
                    md = wave_max(md); mr = wave_max(mr);
                    if (Fp.lane == 0) { atomicMax(F.ctl + 9000, __float_as_uint(md)); atomicMax(F.ctl + 9001, __float_as_uint(mr)); }
                    if (bad_bits) atomicOr(F.ctl + 9002, bad_bits);
                }
#else
#ifndef NO_MLS
 REP(DBL_SCAN) phase_mlstm_scan_mfma(Fp);
#endif
#endif
 SEAM(pb + 1); }
            if (IN(pb + 2)) { PHL STAMP(pb + 2);
#ifndef NO_NG
 REP(DBL_NG) phase_norm_gate<256>(Fp, inptr(Fp, I_ML_NORM_G), ML_LD, 2048);
#endif
 SEAM(pb + 2); }
        } else {
            if (IN(pb + 1)) { PHL STAMP(pb + 1);
#ifndef NO_HGS
 REP(DBL_SCAN) phase_hgrn_scan_mfma(Fp);
#endif
 SEAM(pb + 1); }
        }
        if (IN(pb + 4)) { PHL STAMP(pb + 4);
            const bf16_t* Wt = kind == 0 ? WSP(bf16_t, OFF_W_NSAOUT) + (size_t)slot * D * D : (kind == 1 ? WSP(bf16_t, OFF_W_MLOUT) : WSP(bf16_t, OFF_W_HGOUT));
            pg8::APlain AS{WSP(bf16_t, OFF_ATT), D}; pg8::BPlain BS{Wt, D}; pg8::StaticOrder S; S.init(NTOK / 256, D / 256, Fp.G, Fp.bx);
            pg8::EpiStore E{WSP(bf16_t, OFF_HM), D};
            #ifndef NO_GOUT
            REP(DBL_GOUT) pg8::gemm_phase<pg8::EpiStore, pg8::StaticOrder, pg8::APlain, pg8::BPlain>(Fp.lds, D, AS, BS, S, E);
#endif
            SEAM(pb + 4);
        }
        if (IN(pb + 5)) { PHL STAMP(pb + 5);
#ifndef NO_LNR
 if (DBL_LNR > 1) phase_ln_router(Fp, Lo, true);
 phase_ln_router(Fp, Lo);
#endif
 SEAM(pb + 5); }
        if (IN(pb + 6)) { PHL STAMP(pb + 6);
#ifndef NO_SLOT
 phase_moe_slots(Fp, Lo);
#endif
 SEAM(pb + 6); }
        if (IN(pb + 7)) { PHL STAMP(pb + 7);
            moe_tile_table(Fp, Lo);
            pg8::AGather AS{WSP(bf16_t, OFF_XN), D, WSP(int, OFF_ROWT)}; pg8::BGroup BS{WSP(bf16_t, OFF_W_GU) + (size_t)Lo * NEXP * 2048 * D, D, (size_t)2048 * D};
            pg8::MoeOrder S; S.init(__builtin_amdgcn_readfirstlane((int)Fp.LC[40]), 8, Fp.G, Fp.bx); S.pend = (const LAS int*)(Fp.lds + LDSCTL_OFF + 32);
            pg8::EpiSwiglu E{WSP(bf16_t, OFF_H), inptr(Fp, I_MOE_B_GU) + (size_t)Lo * NEXP * 2048};
            #ifndef NO_GUP
            REP(DBL_GUP) pg8::gemm_phase<pg8::EpiSwiglu, pg8::MoeOrder, pg8::AGather, pg8::BGroup>(Fp.lds, D, AS, BS, S, E);
#endif
            SEAM(pb + 7);
        }
        if (IN(pb + 8)) { PHL STAMP(pb + 8);
            moe_tile_table(Fp, Lo);
            pg8::APlain AS{WSP(bf16_t, OFF_H), DFF}; pg8::BGroup BS{WSP(bf16_t, OFF_W_DN) + (size_t)Lo * NEXP * D * DFF, DFF, (size_t)D * DFF};
            pg8::MoeOrder S; S.init(__builtin_amdgcn_readfirstlane((int)Fp.LC[40]), 4, Fp.G, Fp.bx); S.pend = (const LAS int*)(Fp.lds + LDSCTL_OFF + 32);
            pg8::EpiDown E{WSP(bf16_t, OFF_Y), inptr(Fp, I_MOE_B_DOWN) + (size_t)Lo * NEXP * D, WSP(float, OFF_ROWG)};
            #ifndef NO_GDN
            REP(DBL_GDN) pg8::gemm_phase<pg8::EpiDown, pg8::MoeOrder, pg8::APlain, pg8::BGroup>(Fp.lds, DFF, AS, BS, S, E);
#endif
            SEAM(pb + 8);
        }
        if (IN(pb + 9)) { PHL STAMP(pb + 9);
#ifndef NO_COMB
 if (DBL_COMB > 1) phase_combine_ln(Fp, Lo, (float*)nullptr, true);
 phase_combine_ln(Fp, Lo, Lo == DEPTH - 1 ? Fp.out : (float*)nullptr);
#endif
 SEAM(pb + 9); }
    }
#ifdef MLS_CHECK
    xcd_barrier(bar);
    { const float md = __uint_as_float(__hip_atomic_load(F.ctl + 9000, RLX_AGENT)), mr = __uint_as_float(__hip_atomic_load(F.ctl + 9001, RLX_AGENT)); const unsigned bb = __hip_atomic_load(F.ctl + 9002, RLX_AGENT);
      float code = 10.f; if (md > 0.02f * mr) code = 100.f; if (md > 0.2f * mr) code = 300.f; if (bb & 1u) code *= 10.f; if (bb & 4u) code *= 100.f;
      for (size_t i = (size_t)blockIdx.x * 512 + F.tid; i < (size_t)NTOK * D; i += (size_t)F.G * 512) F.out[i] = code; }
#endif
#ifdef PROBE_A
    STAMP(N_PHASES);
    xcd_barrier(bar);
    {
        const unsigned long long* st = (const unsigned long long*)(F.ws + OFF_TAB + 65536);
        float cat[6] = {0.f, 0.f, 0.f, 0.f, 0.f, 0.f};
        unsigned long long prev = __hip_atomic_load(st + 0, RLX_AGENT);
        int pc = 0;
        for (int p = 1; p <= N_PHASES; ++p) {
            int c = -1;
            if (p < N_PHASES) { const int Lq = (p - 1) / PH_PER_LAYER, k = (p - 1) % PH_PER_LAYER, kind = Lq % 3;
                if (k == 3 && kind != 0) continue;
                c = (k == 0 || k == 4 || k == 7 || k == 8) ? 1 : (k == 1 ? (kind == 0 ? 1 : (kind == 1 ? 3 : 4)) : (k == 3 ? 2 : 5)); }
            const unsigned long long now = __hip_atomic_load(st + p, RLX_AGENT);
            const float us = (float)(now - prev) * 0.01f;
#pragma unroll
            for (int q = 0; q < 6; ++q) if (q == pc) cat[q] += us;
            prev = now; pc = c;
        }
        float va = 0.f, vb = 0.f;
#pragma unroll
        for (int q = 0; q < 6; ++q) { if (q == PROBE_A) va = cat[q]; if (q == PROBE_B) vb = cat[q]; }
        const float kfill = sqrtf(va);
        for (size_t i = (size_t)blockIdx.x * 512 + F.tid; i < (size_t)NTOK * D; i += (size_t)F.G * 512) F.out[i] = (i == 0) ? vb : kfill;
    }
#endif
#undef IN
#undef SEAM
#undef PHL
}

extern "C" void kernel_launch(void* const* d_in, const int* in_sizes, int n_in, void* d_out, int out_size, void* d_ws, size_t ws_size, hipStream_t stream) {
    static int grid = 0;
    if (grid == 0) {
        if (n_in != 27 || out_size != NTOK * D || ws_size < WS_END) { fprintf(stderr, "kernel_launch: unexpected shapes (n_in %d, out %d, ws %zu)\n", n_in, out_size, ws_size); grid = -1; return; }
        int dev = 0, cus = 0;
        if (hipGetDevice(&dev) != hipSuccess || hipDeviceGetAttribute(&cus, hipDeviceAttributeMultiprocessorCount, dev) != hipSuccess) { grid = -1; return; }
        if (hipFuncSetAttribute((const void*)mk_fwd, hipFuncAttributeMaxDynamicSharedMemorySize, LDS_BYTES) != hipSuccess) { fprintf(stderr, "kernel_launch: hipFuncSetAttribute failed\n"); grid = -1; return; }
        int per_cu = 0;
        if (hipOccupancyMaxActiveBlocksPerMultiprocessor(&per_cu, (const void*)mk_fwd, 512, LDS_BYTES) != hipSuccess || per_cu < 1) fprintf(stderr, "kernel_launch: occupancy query reports %d\n", per_cu);
        (void)hipGetLastError();
        grid = cus;
    }
    if (grid < 0) return;
    (void)hipMemsetAsync((char*)d_ws + OFF_CTL, 0, CTL_ZERO_BYTES, stream);
    Args a{};
    for (int i = 0; i < 27; ++i) a.in[i] = (const float*)d_in[i];
    a.out = (float*)d_out; a.ws = (unsigned char*)d_ws;
#if MK_PER_PHASE
    for (int p = 0; p < N_PHASES; ++p) {
        if (p > 0) { const int L = (p - 1) / PH_PER_LAYER, k = (p - 1) % PH_PER_LAYER, kind = L % 3; if (k == 3 && kind != 0) continue; }
        a.ph_lo = p; a.ph_hi = p + 1;
        hipLaunchKernelGGL(mk_fwd, dim3(grid), dim3(512), LDS_BYTES, stream, a);
    }
#else
    a.ph_lo = 0; a.ph_hi = N_PHASES;
    hipLaunchKernelGGL(mk_fwd, dim3(grid), dim3(512), LDS_BYTES, stream, a);
#endif
}
```

```cpp
#include <hip/hip_runtime.h>
#include <cstdio>
#include <cstdint>

#define LAS __attribute__((address_space(3)))
#define GAS __attribute__((address_space(1)))
typedef unsigned short bf16_t;
typedef short bf16x8 __attribute__((ext_vector_type(8)));
typedef float f32x4 __attribute__((ext_vector_type(4)));
typedef float f32x2 __attribute__((ext_vector_type(2)));
typedef unsigned u32x4 __attribute__((ext_vector_type(4)));
typedef unsigned u32x2 __attribute__((ext_vector_type(2)));
#define RLX_AGENT __ATOMIC_RELAXED, __HIP_MEMORY_SCOPE_AGENT
#define LDS_WAIT() asm volatile("s_waitcnt lgkmcnt(0)" ::: "memory")
#define VM_WAIT() asm volatile("s_waitcnt vmcnt(0)" ::: "memory")

#ifndef MK_PER_PHASE
#define MK_PER_PHASE 0
#endif

constexpr int D = 1024, BATCH = 32, T = 2048, NTOK = BATCH * T, DEPTH = 4;
constexpr int NSA_IN = 2608, NSA_LD = 2816, ML_IN = 3080, ML_LD = 3328, HG_LD = 4096;
constexpr int NEXP = 32, TOPK = 4, DFF = 1024;
constexpr int MOE_ROWS = 270336;
constexpr float LN_EPS = 1e-5f, RMS_EPS = 1e-6f;
constexpr float DN_ALPHA = 1.681792830507429f;
constexpr int NCMP = 127;

constexpr size_t MiB = 1u << 20;
constexpr size_t OFF_CTL = 0, CTL_ZERO_BYTES = 1 * MiB;
constexpr size_t OFF_TAB = 1 * MiB;
constexpr size_t OFF_TOKE = 2 * MiB;
constexpr size_t OFF_TOKG = 3 * MiB;
constexpr size_t OFF_TOKP = 4 * MiB;
constexpr size_t OFF_ROWT = 5 * MiB;
constexpr size_t OFF_ROWG = 7 * MiB;
constexpr size_t OFF_KC = 9 * MiB;
constexpr size_t OFF_HC = 17 * MiB;
constexpr size_t OFF_W_NSAIN = 33 * MiB;
constexpr size_t OFF_W_NSAOUT = 44 * MiB;
constexpr size_t OFF_W_MLIN = 48 * MiB;
constexpr size_t OFF_W_MLOUT = 55 * MiB;
constexpr size_t OFF_W_HGIN = 57 * MiB;
constexpr size_t OFF_W_HGOUT = 65 * MiB;
constexpr size_t OFF_W_CMP2 = 71 * MiB;
constexpr size_t OFF_W_CMP1 = 67 * MiB;
constexpr size_t OFF_W_GU = 72 * MiB;
constexpr size_t OFF_W_DN = 584 * MiB;
constexpr size_t OFF_XA = 840 * MiB;
constexpr size_t OFF_XN = 1096 * MiB;
constexpr size_t OFF_PROJ = 1224 * MiB;
constexpr size_t OFF_ATT = 1740 * MiB;
constexpr size_t OFF_HM = 1868 * MiB;
constexpr size_t OFF_H = 1996 * MiB;
constexpr size_t OFF_Y = 2526 * MiB;
constexpr size_t WS_END = 3056 * MiB;
constexpr int TAB_CMPB = 0;
constexpr int TAB_LB = 4096;
constexpr int TAB_RWT = 8192;
constexpr int CW_BAR = 4096;
constexpr int CW_CNT = 16384;
constexpr int CW_CUR = 16384 + 1024;

constexpr int RING_BYTES = 131072;
constexpr int LDSCTL_OFF = 155648;
constexpr int LDS_BYTES = 156672;

__device__ __forceinline__ float bf2f(bf16_t b) { return __uint_as_float(((unsigned)b) << 16); }
typedef float f32x2_t_ __attribute__((ext_vector_type(2))); typedef __bf16 bf16x2_t_ __attribute__((ext_vector_type(2)));
__device__ __forceinline__ unsigned pk2(float lo, float hi) { const f32x2_t_ v = {lo, hi}; const bf16x2_t_ b = __builtin_convertvector(v, bf16x2_t_); return __builtin_bit_cast(unsigned, b); }
__device__ __forceinline__ unsigned f2bf(float f) { return pk2(f, f) & 0xffffu; }
template <int CTRL> __device__ __forceinline__ float dppf(float v) { return __builtin_bit_cast(float, __builtin_amdgcn_update_dpp(0, __builtin_bit_cast(int, v), CTRL, 0xF, 0xF, true)); }
__device__ __forceinline__ float rdl(float v, int l) { return __builtin_bit_cast(float, __builtin_amdgcn_readlane(__builtin_bit_cast(int, v), l)); }
__device__ __forceinline__ float wave_sum(float v) {
    v += dppf<0xB1>(v); v += dppf<0x4E>(v); v += dppf<0x141>(v); v += dppf<0x140>(v);
    return (rdl(v, 0) + rdl(v, 16)) + (rdl(v, 32) + rdl(v, 48));
}
__device__ __forceinline__ float wave_max(float v) {
    v = fmaxf(v, dppf<0xB1>(v)); v = fmaxf(v, dppf<0x4E>(v)); v = fmaxf(v, dppf<0x141>(v)); v = fmaxf(v, dppf<0x140>(v));
    return fmaxf(fmaxf(rdl(v, 0), rdl(v, 16)), fmaxf(rdl(v, 32), rdl(v, 48)));
}
__device__ __forceinline__ float sigmoidf_(float x) { return __builtin_amdgcn_rcpf(1.0f + __expf(-x)); }

#define XB_TMO      128
#define XB_XCNT(j)  (256  + 64 * (j))
#define XB_XSUB(j)  (1280 + 64 * (j))
#define XB_XGEN(j)  (2304 + 64 * (j))
#define XB_TOP      3328
#define XB_TOPGEN   3392
#define XCD_BAR_WORDS 3456
#define XB_SPIN_CAP (1u << 20)

__device__ __forceinline__ unsigned xb_ld(unsigned* p)              { return __hip_atomic_load(p, __ATOMIC_RELAXED, __HIP_MEMORY_SCOPE_AGENT); }
__device__ __forceinline__ unsigned xb_add(unsigned* p, unsigned v) { return __hip_atomic_fetch_add(p, v, __ATOMIC_RELAXED, __HIP_MEMORY_SCOPE_AGENT); }
__device__ __forceinline__ unsigned xb_xcc_id() { return (unsigned)__builtin_amdgcn_s_getreg((3 << 11) | 20) & 0xFu; }
#define XB_SPIN(cond, bar) do { unsigned _sp = 0; while (cond) { __builtin_amdgcn_s_sleep(1); \
    if ((++_sp & 255u) == 0u) { if (xb_ld(&(bar)[XB_TMO])) break; if (_sp > XB_SPIN_CAP) { atomicAdd(&(bar)[XB_TMO], 1u); break; } } } } while (0)

struct XcdBarrier { unsigned* bar; unsigned x; volatile LAS unsigned* st; };

__device__ __forceinline__ XcdBarrier xcd_barrier_post(unsigned* bar, volatile LAS unsigned* st) {
    XcdBarrier b; b.bar = bar; b.x = xb_xcc_id(); b.st = st;
    if (threadIdx.x == 0) (void)xb_add(&bar[XB_XCNT(b.x)], 1u);
    return b;
}
__device__ __forceinline__ void xcd_barrier_complete(unsigned* bar, unsigned x, unsigned& nloc, unsigned& nx) {
    const unsigned G = gridDim.x * gridDim.y * gridDim.z;
    unsigned sum, cnt, mine, sp = 0u;
    for (;;) {
        sum = 0u; cnt = 0u; mine = 0u;
#pragma unroll
        for (unsigned j = 0; j < 16; ++j) { const unsigned c = xb_ld(&bar[XB_XCNT(j)]); sum += c; cnt += (c > 0u) ? 1u : 0u; }
        mine = xb_ld(&bar[XB_XCNT(x)]);
        if (sum == G) break;
        __builtin_amdgcn_s_sleep(1);
        if ((++sp & 255u) == 0u) { if (xb_ld(&bar[XB_TMO])) break; if (sp > XB_SPIN_CAP) { atomicAdd(&bar[XB_TMO], 1u); break; } }
    }
    nloc = mine > 0u ? mine : 1u; nx = cnt > 0u ? cnt : 1u;
}
__device__ __forceinline__ void xcd_barrier(const XcdBarrier& b) {
    asm volatile("s_waitcnt vmcnt(0)" ::: "memory");
    __syncthreads();
    if (threadIdx.x == 0) {
        unsigned* bar = b.bar; asm volatile("; barrier words" : "+s"(bar));
        __builtin_amdgcn_s_waitcnt(0);
        unsigned nloc = b.st[0], nx = b.st[1];
        if (nloc == 0u) { xcd_barrier_complete(bar, b.x, nloc, nx); b.st[0] = nloc; b.st[1] = nx; }
        const unsigned old = xb_add(&bar[XB_XSUB(b.x)], 1u);
        const unsigned gen = old / nloc;
        if (old + 1u == (gen + 1u) * nloc) {
            __builtin_amdgcn_fence(__ATOMIC_RELEASE, "agent");
            asm volatile("s_waitcnt vmcnt(0)" ::: "memory");
            const unsigned og = xb_add(&bar[XB_TOP], 1u);
            const unsigned tg = og / nx;
            if (og + 1u == (tg + 1u) * nx) xb_add(&bar[XB_TOPGEN], 1u);
            else XB_SPIN(xb_ld(&bar[XB_TOPGEN]) == tg, bar);
            __builtin_amdgcn_fence(__ATOMIC_ACQUIRE, "agent");
            xb_add(&bar[XB_XGEN(b.x)], 1u);
            asm volatile("s_waitcnt vmcnt(0)" ::: "memory");
        } else {
            XB_SPIN(xb_ld(&bar[XB_XGEN(b.x)]) == gen, bar);
            __builtin_amdgcn_fence(__ATOMIC_ACQUIRE, "agent");
            asm volatile("s_waitcnt vmcnt(0)" ::: "memory");
        }
    }
    __syncthreads();
}

namespace pg8 {
constexpr int BM = 256, BK = 64, HALF = 128, HTB = HALF * BK * 2, STAGE_BYTES = 8 * HTB, NXCD = 8, WGM = 8;
__host__ __device__ __forceinline__ int lds_byte(int r, int c) { const int st = (r >> 4) * 2 + (c >> 5), rr = r & 15, cc = c & 31, ob = rr * 64 + cc * 2; return st * 1024 + (ob ^ (((ob >> 9) & 1) << 5)); }
__host__ __device__ __forceinline__ void stage_rc(int b, int& R, int& C) { const int st = b / 1024, sb = b % 1024, swz = sb ^ (((sb >> 9) & 1) << 5); R = (st >> 1) * 16 + swz / 64; C = (st & 1) * 32 + (swz % 64) / 2; }
__host__ __device__ __forceinline__ int perm32(int rho) { const int n = rho >> 4, i = rho & 15; return 8 * (i >> 2) + 4 * n + (i & 3); }

struct Unit { int pm, pn, e; };

struct StaticOrder {
    int nM, nN, nwg, G, c, wgm = WGM;
    __device__ __forceinline__ void init(int nM_, int nN_, int G_, int c_) { nM = nM_; nN = nN_; nwg = nM * nN; G = G_; c = c_; }
    __device__ __forceinline__ bool next(int i, Unit& u) const {
        const long L = (long)i * G + c; if (L >= nwg) return false;
        int wgid = (int)L; { const int q = nwg / NXCD, r = nwg % NXCD, xcd = wgid % NXCD, off = wgid / NXCD; wgid = (xcd < r ? xcd * (q + 1) : r * (q + 1) + (xcd - r) * q) + off; }
        const int nig = wgm * nN, gid = wgid / nig, fm = gid * wgm, gsz = (nM - fm) < wgm ? (nM - fm) : wgm;
        u.pm = fm + ((wgid % nig) % gsz); u.pn = (wgid % nig) / gsz; u.e = 0; return true;
    }
};
struct MoeOrder : StaticOrder {
    const LAS int* pend;
    __device__ __forceinline__ bool next(int i, Unit& u) const {
        if (!StaticOrder::next(i, u)) return false;
        int e = 0;
#pragma unroll 8
        for (int j = 0; j < 31; ++j) e += (pend[j] <= u.pm) ? 1 : 0;
        u.e = __builtin_amdgcn_readfirstlane(e); return true;
    }
};
struct CmpOrder {
    int G, c;
    __device__ __forceinline__ bool next(int i, Unit& u) const { const int L = i * G + c; if (L >= 128) return false; u.e = L >> 6; u.pm = L & 63; u.pn = 0; return true; }
};

__device__ __forceinline__ unsigned cvt_pk_bf16(float lo, float hi) { const f32x2_t_ v = {lo, hi}; const bf16x2_t_ b = __builtin_convertvector(v, bf16x2_t_); return __builtin_bit_cast(unsigned, b); }

struct APlain {
    static constexpr bool GATHER = false;
    const bf16_t* A; int lda;
    __device__ __forceinline__ int kstep() const { return BK * 2; }
    __device__ __forceinline__ const char* base(const Unit& u) const { return (const char*)A + (size_t)u.pm * BM * lda * 2; }
    __device__ __forceinline__ void offs(const Unit&, const int (&R)[2], const int (&C)[2], unsigned (&vo)[2][2]) const {
#pragma unroll
        for (int h = 0; h < 2; ++h)
#pragma unroll
            for (int i = 0; i < 2; ++i) vo[h][i] = (unsigned)((h * HALF + R[i]) * lda + C[i]) * 2u;
    }
};
struct AGather {
    static constexpr bool GATHER = true;
    const bf16_t* A; int lda; const int* idx;
    __device__ __forceinline__ int kstep() const { return BK * 2; }
    __device__ __forceinline__ const char* base(const Unit&) const { return (const char*)A; }
    __device__ __forceinline__ void offs(const Unit& u, const int (&R)[2], const int (&C)[2], unsigned (&vo)[2][2]) const {
#pragma unroll
        for (int h = 0; h < 2; ++h)
#pragma unroll
            for (int i = 0; i < 2; ++i) { const int row = idx[u.pm * BM + h * HALF + R[i]]; vo[h][i] = (unsigned)(row * lda + C[i]) * 2u; }
    }
};
struct ACmp {
    static constexpr bool GATHER = false;
    const bf16_t* P; int ld; int col0;
    __device__ __forceinline__ int kstep() const { return ld * 2; }
    __device__ __forceinline__ const char* base(const Unit& u) const { const int b = u.pm >> 1, g0 = (u.pm & 1) * 2; return (const char*)P + ((size_t)b * T * ld + col0 + u.e * 256 + g0 * 64) * 2; }
    __device__ __forceinline__ void offs(const Unit&, const int (&R)[2], const int (&C)[2], unsigned (&vo)[2][2]) const {
#pragma unroll
        for (int h = 0; h < 2; ++h)
#pragma unroll
            for (int i = 0; i < 2; ++i) vo[h][i] = (unsigned)(16 * R[i] * ld + h * 64 + C[i]) * 2u;
    }
};
struct BPlain { const bf16_t* Bt; int K; __device__ __forceinline__ const char* base(const Unit& u) const { return (const char*)Bt + (size_t)u.pn * BM * K * 2; } };
struct BGroup { const bf16_t* Bt; int K; size_t gstride;   __device__ __forceinline__ const char* base(const Unit& u) const { return (const char*)Bt + ((size_t)u.e * gstride + (size_t)u.pn * BM * K) * 2; } };

template <class Epi, class Sched, class ASrc, class BSrc, bool ALIGN_EPI = true, bool SP2 = true>
__device__ __forceinline__ void gemm_phase(LAS unsigned char* lds, const int K, const ASrc& AS, const BSrc& BS, const Sched& S, const Epi& E) {
    int tid = threadIdx.x; asm volatile("; phase-local tid" : "+v"(tid));
    const int wid = __builtin_amdgcn_readfirstlane(tid >> 6), lane = tid & 63, wr = wid >> 2, wc = wid & 3, fr = lane & 15, fq = lane >> 4;
    const int nt = K / BK;
    int Rs[2], Cs[2]; unsigned voffB[2];
#pragma unroll
    for (int i = 0; i < 2; ++i) { int R, C; stage_rc(tid * 16 + i * 8192, R, C); Rs[i] = R; Cs[i] = C; const int Rb = Epi::PERM ? ((R & ~31) + perm32(R & 31)) : R; voffB[i] = (unsigned)(Rb * K + C) * 2u; }
    const size_t kstepB = (size_t)(BK * 2), hstepB = (size_t)HALF * K * 2;
    const size_t kstepA = (size_t)AS.kstep();
    const unsigned ldsw = (unsigned)wid * 1024u;
    const int aoff = lds_byte(wr * 64 + fr, fq * 8), boff = lds_byte(wc * 32 + fr, fq * 8);
#define PG8_SA(b, h) (((b) * 2 + (h)) * HTB)
#define PG8_SB(b, h) ((4 + (b) * 2 + (h)) * HTB)
#define PG8_STAGEB(bufoff, gbase) do { _Pragma("unroll") for (int _i = 0; _i < 2; ++_i) \
        __builtin_amdgcn_global_load_lds((const unsigned*)((const char*)(gbase) + voffB[_i]), (LAS unsigned*)(lds + (bufoff) + ldsw + _i * 8192), 16, 0, 0); } while (0)
#define PG8_STAGEA(bufoff, gbase, o0, o1) do { \
        __builtin_amdgcn_global_load_lds((const unsigned*)((const char*)(gbase) + (o0)), (LAS unsigned*)(lds + (bufoff) + ldsw), 16, 0, 0); \
        __builtin_amdgcn_global_load_lds((const unsigned*)((const char*)(gbase) + (o1)), (LAS unsigned*)(lds + (bufoff) + ldsw + 8192), 16, 0, 0); } while (0)
#define PG8_LDA(dst, b, h) do { _Pragma("unroll") for (int m = 0; m < 4; ++m) _Pragma("unroll") for (int k = 0; k < 2; ++k) dst[m][k] = *(const LAS bf16x8*)(lds + PG8_SA(b, h) + aoff + m * 2048 + k * 1024); } while (0)
#define PG8_LDB(dst, b, h) do { _Pragma("unroll") for (int n = 0; n < 2; ++n) _Pragma("unroll") for (int k = 0; k < 2; ++k) dst[n][k] = *(const LAS bf16x8*)(lds + PG8_SB(b, h) + boff + n * 2048 + k * 1024); } while (0)
#define PG8_MMA(ai, bj, At, Bt) do { __builtin_amdgcn_s_setprio(1); _Pragma("unroll") for (int m = 0; m < 4; ++m) _Pragma("unroll") for (int n = 0; n < 2; ++n) _Pragma("unroll") for (int k = 0; k < 2; ++k) \
        acc[ai][bj][m][n] = __builtin_amdgcn_mfma_f32_16x16x32_bf16(Bt[n][k], At[m][k], acc[ai][bj][m][n], 0, 0, 0); __builtin_amdgcn_s_setprio(0); } while (0)
#define PG8_WAIT_V(n) asm volatile("s_waitcnt vmcnt(" #n ")" ::: "memory")
#define PG8_WAIT_L(n) asm volatile("s_waitcnt lgkmcnt(" #n ")" ::: "memory")
#define PG8_BAR __builtin_amdgcn_s_barrier()
#define PG8_SCHED __builtin_amdgcn_sched_barrier(0)
    Unit cur, nxt; int ui = 0;
    if (!S.next(0, cur)) return;
    f32x4 acc[2][2][4][2];
    E.init(acc, cur, wc, fq);
    bf16x8 At[4][2], B0[2][2], B1[2][2];
    unsigned vC[2][2];
    AS.offs(cur, Rs, Cs, vC);
    unsigned x00 = vC[0][0], x01 = vC[0][1], x10 = vC[1][0], x11 = vC[1][1];
    const char* cA = AS.base(cur); const char* cB = BS.base(cur);
    if constexpr (SP2) {
        PG8_STAGEB(PG8_SB(0, 0), cB); PG8_STAGEB(PG8_SB(0, 1), cB + hstepB); PG8_STAGEA(PG8_SA(0, 0), cA, vC[0][0], vC[0][1]); PG8_STAGEA(PG8_SA(0, 1), cA, vC[1][0], vC[1][1]);
        if (wr == 1) PG8_BAR;
        PG8_WAIT_V(2); PG8_BAR;
        PG8_STAGEB(PG8_SB(1, 0), cB + kstepB); PG8_STAGEA(PG8_SA(1, 0), cA + kstepA, vC[0][0], vC[0][1]); PG8_STAGEB(PG8_SB(1, 1), cB + hstepB + kstepB);
        PG8_WAIT_V(6); PG8_BAR;
    } else {
        PG8_STAGEB(PG8_SB(0, 0), cB); PG8_STAGEA(PG8_SA(0, 0), cA, vC[0][0], vC[0][1]); PG8_STAGEB(PG8_SB(0, 1), cB + hstepB); PG8_STAGEA(PG8_SA(0, 1), cA, vC[1][0], vC[1][1]);
        if (wr == 1) PG8_BAR;
        PG8_WAIT_V(4); PG8_BAR;
        PG8_STAGEB(PG8_SB(1, 0), cB + kstepB); PG8_STAGEA(PG8_SA(1, 0), cA + kstepA, vC[0][0], vC[0][1]); PG8_STAGEB(PG8_SB(1, 1), cB + hstepB + kstepB);
        PG8_WAIT_V(6); PG8_BAR;
    }
    for (;;) {
        const bool has_next = S.next(ui + 1, nxt);
        const char* nA = has_next ? AS.base(nxt) : cA; const char* nB = has_next ? BS.base(nxt) : cB;
        for (int t = 0; t < nt; t += 2) {
            const bool last = (t == nt - 2);
            const char* a1 = cA + (size_t)(t + 1) * kstepA;
            const char* a2 = last ? nA : cA + (size_t)(t + 2) * kstepA; const char* b2 = last ? nB : cB + (size_t)(t + 2) * kstepB;
            const char* a3 = a2 + kstepA; const char* b3 = b2 + kstepB;
            if constexpr (ASrc::GATHER) { if (last && has_next) { unsigned vn[2][2]; AS.offs(nxt, Rs, Cs, vn); x00 = vn[0][0]; x01 = vn[0][1]; x10 = vn[1][0]; x11 = vn[1][1]; } }
            if constexpr (SP2) {
            PG8_LDB(B0, 0, 0); PG8_LDB(B1, 0, 1); PG8_SCHED; PG8_LDA(At, 0, 0); PG8_STAGEA(PG8_SA(1, 1), a1, vC[1][0], vC[1][1]);
            PG8_WAIT_V(8); PG8_WAIT_L(0); PG8_BAR; PG8_MMA(0, 0, At, B0); PG8_MMA(0, 1, At, B1); PG8_BAR; PG8_SCHED;
            PG8_LDA(At, 0, 1); PG8_STAGEB(PG8_SB(0, 0), b2); PG8_STAGEB(PG8_SB(0, 1), b2 + hstepB); PG8_STAGEA(PG8_SA(0, 0), a2, x00, x01);
            PG8_WAIT_V(8); PG8_WAIT_L(0); PG8_BAR; PG8_MMA(1, 0, At, B0); PG8_MMA(1, 1, At, B1); PG8_BAR; PG8_SCHED;
            PG8_LDB(B0, 1, 0); PG8_LDB(B1, 1, 1); PG8_SCHED; PG8_LDA(At, 1, 0); PG8_STAGEA(PG8_SA(0, 1), a2, x10, x11);
            PG8_WAIT_V(8); PG8_WAIT_L(0); PG8_BAR; PG8_MMA(0, 0, At, B0); PG8_MMA(0, 1, At, B1); PG8_BAR; PG8_SCHED;
            PG8_LDA(At, 1, 1); PG8_STAGEB(PG8_SB(1, 0), b3); PG8_STAGEB(PG8_SB(1, 1), b3 + hstepB); PG8_STAGEA(PG8_SA(1, 0), a3, x00, x01);
            PG8_WAIT_V(8); PG8_WAIT_L(0); PG8_BAR; PG8_MMA(1, 0, At, B0); PG8_MMA(1, 1, At, B1); PG8_BAR; PG8_SCHED;
            } else {
            PG8_LDB(B0, 0, 0); PG8_SCHED; PG8_LDA(At, 0, 0); PG8_STAGEA(PG8_SA(1, 1), a1, vC[1][0], vC[1][1]);
            PG8_WAIT_L(8); PG8_BAR; PG8_WAIT_L(0); PG8_MMA(0, 0, At, B0); PG8_BAR; PG8_SCHED;
            PG8_LDB(B1, 0, 1); PG8_STAGEB(PG8_SB(0, 0), b2);
            PG8_BAR; PG8_WAIT_L(0); PG8_MMA(0, 1, At, B1); PG8_BAR;
            PG8_LDA(At, 0, 1); PG8_STAGEA(PG8_SA(0, 0), a2, x00, x01);
            PG8_BAR; PG8_WAIT_L(0); PG8_MMA(1, 0, At, B0); PG8_BAR; PG8_SCHED;
            PG8_STAGEB(PG8_SB(0, 1), b2 + hstepB);
            PG8_WAIT_V(6); PG8_BAR; PG8_MMA(1, 1, At, B1); PG8_BAR;
            PG8_LDB(B0, 1, 0); PG8_SCHED; PG8_LDA(At, 1, 0); PG8_STAGEA(PG8_SA(0, 1), a2, x10, x11);
            PG8_WAIT_L(8); PG8_BAR; PG8_WAIT_L(0); PG8_MMA(0, 0, At, B0); PG8_BAR; PG8_SCHED;
            PG8_LDB(B1, 1, 1); PG8_STAGEB(PG8_SB(1, 0), b3);
            PG8_BAR; PG8_WAIT_L(0); PG8_MMA(0, 1, At, B1); PG8_BAR;
            PG8_LDA(At, 1, 1); PG8_STAGEA(PG8_SA(1, 0), a3, x00, x01);
            PG8_BAR; PG8_WAIT_L(0); PG8_MMA(1, 0, At, B0); PG8_BAR; PG8_SCHED;
            PG8_STAGEB(PG8_SB(1, 1), b3 + hstepB);
            PG8_WAIT_V(6); PG8_BAR; PG8_MMA(1, 1, At, B1); PG8_BAR;
            }
        }
        if constexpr (ALIGN_EPI) { if (wr == 0) PG8_BAR; }
        E(acc, cur, wr, wc, fr, fq);
        if (!has_next) break;
        E.init(acc, nxt, wc, fq);
        cur = nxt; cA = nA; cB = nB; ++ui;
        if constexpr (ASrc::GATHER) { vC[0][0] = x00; vC[0][1] = x01; vC[1][0] = x10; vC[1][1] = x11; }
        if constexpr (ALIGN_EPI) { if (wr == 1) PG8_BAR; }
    }
    PG8_WAIT_V(0);
    if constexpr (!ALIGN_EPI) { if (wr == 0) PG8_BAR; }
    PG8_BAR;
#undef PG8_SA
#undef PG8_SB
#undef PG8_STAGEA
#undef PG8_STAGEB
#undef PG8_LDA
#undef PG8_LDB
#undef PG8_MMA
#undef PG8_WAIT_V
#undef PG8_WAIT_L
#undef PG8_BAR
#undef PG8_SCHED
}
}
namespace pg8 {
__device__ __forceinline__ float gelu_tanh(float x) {
    const float u = 0.7978845608028654f * (x + 0.044715f * x * x * x);
    const float e = __expf(-2.0f * fabsf(u)); float th = (1.0f - e) * __builtin_amdgcn_rcpf(1.0f + e); th = u < 0.f ? -th : th;
    return 0.5f * x * (1.0f + th);
}
struct EpiStore {
    static constexpr bool PERM = true;
    bf16_t* O; int ldc;
    __device__ __forceinline__ void init(f32x4 (&acc)[2][2][4][2], const Unit&, int, int) const {
#pragma unroll
        for (int a = 0; a < 2; ++a)
#pragma unroll
            for (int b = 0; b < 2; ++b)
#pragma unroll
                for (int m = 0; m < 4; ++m)
#pragma unroll
                    for (int n = 0; n < 2; ++n) acc[a][b][m][n] = (f32x4){0.f, 0.f, 0.f, 0.f};
    }
    __device__ __forceinline__ void operator()(const f32x4 (&acc)[2][2][4][2], const Unit& u, int wr, int wc, int fr, int fq) const {
        const int row0 = u.pm * BM + wr * 64 + fr, col0 = u.pn * BM + wc * 32 + 8 * fq;
#pragma unroll
        for (int ai = 0; ai < 2; ++ai)
#pragma unroll
            for (int m = 0; m < 4; ++m) { bf16_t* rowp = O + (size_t)(row0 + ai * HALF + m * 16) * ldc + col0;
#pragma unroll
                for (int bj = 0; bj < 2; ++bj) { const f32x4 v0 = acc[ai][bj][m][0], v1 = acc[ai][bj][m][1];
                    u32x4 w; w.x = cvt_pk_bf16(v0[0], v0[1]); w.y = cvt_pk_bf16(v0[2], v0[3]); w.z = cvt_pk_bf16(v1[0], v1[1]); w.w = cvt_pk_bf16(v1[2], v1[3]);
                    *(u32x4*)(rowp + bj * HALF) = w; } }
    }
};
struct EpiCmpGelu {
    static constexpr bool PERM = true;
    bf16_t* O; const float* bias;
    __device__ __forceinline__ void init(f32x4 (&acc)[2][2][4][2], const Unit&, int, int) const {
#pragma unroll
        for (int a = 0; a < 2; ++a)
#pragma unroll
            for (int b = 0; b < 2; ++b)
#pragma unroll
                for (int m = 0; m < 4; ++m)
#pragma unroll
                    for (int n = 0; n < 2; ++n) acc[a][b][m][n] = (f32x4){0.f, 0.f, 0.f, 0.f};
    }
    __device__ __forceinline__ void operator()(const f32x4 (&acc)[2][2][4][2], const Unit& u, int wr, int wc, int fr, int fq) const {
        const int row0 = u.pm * BM + wr * 64 + fr, col0 = wc * 32 + 8 * fq;
        bf16_t* Oj = O + (size_t)u.e * 16384 * 256; const float* bj_ = bias + u.e * 256;
        f32x4 bv[2][2];
#pragma unroll
        for (int bj = 0; bj < 2; ++bj)
#pragma unroll
            for (int n = 0; n < 2; ++n) bv[bj][n] = *(const f32x4*)(bj_ + col0 + bj * HALF + 4 * n);
#pragma unroll
        for (int ai = 0; ai < 2; ++ai)
#pragma unroll
            for (int m = 0; m < 4; ++m) { bf16_t* rowp = Oj + (size_t)(row0 + ai * HALF + m * 16) * 256 + col0;
#pragma unroll
                for (int bj = 0; bj < 2; ++bj) { f32x4 v0 = acc[ai][bj][m][0] + bv[bj][0], v1 = acc[ai][bj][m][1] + bv[bj][1];
#pragma unroll
                    for (int j = 0; j < 4; ++j) { v0[j] = gelu_tanh(v0[j]); v1[j] = gelu_tanh(v1[j]); }
                    u32x4 w; w.x = cvt_pk_bf16(v0[0], v0[1]); w.y = cvt_pk_bf16(v0[2], v0[3]); w.z = cvt_pk_bf16(v1[0], v1[1]); w.w = cvt_pk_bf16(v1[2], v1[3]);
                    *(u32x4*)(rowp + bj * HALF) = w; } }
    }
};
struct EpiSwiglu {
    static constexpr bool PERM = true;
    bf16_t* H; const float* bgu;
    __device__ __forceinline__ void init(f32x4 (&acc)[2][2][4][2], const Unit& u, int wc, int fq) const {
        const float* bg = bgu + (size_t)u.e * 2048 + u.pn * HALF + wc * 32 + 8 * fq;
#pragma unroll
        for (int n = 0; n < 2; ++n) { const f32x4 g = *(const f32x4*)(bg + 4 * n), up = *(const f32x4*)(bg + 1024 + 4 * n);
#pragma unroll
            for (int a = 0; a < 2; ++a)
#pragma unroll
                for (int m = 0; m < 4; ++m) { acc[a][0][m][n] = g; acc[a][1][m][n] = up; } }
    }
    __device__ __forceinline__ void operator()(const f32x4 (&acc)[2][2][4][2], const Unit& u, int wr, int wc, int fr, int fq) const {
        const int row0 = u.pm * BM + wr * 64 + fr, col0 = u.pn * HALF + wc * 32 + 8 * fq;
#pragma unroll
        for (int ai = 0; ai < 2; ++ai)
#pragma unroll
            for (int m = 0; m < 4; ++m) { bf16_t* rowp = H + (size_t)(row0 + ai * HALF + m * 16) * DFF + col0;
                unsigned wv[4];
#pragma unroll
                for (int n = 0; n < 2; ++n) { const f32x4 g = acc[ai][0][m][n], up = acc[ai][1][m][n];
#pragma unroll
                    for (int j = 0; j < 2; ++j) {
                        const f32x2 gg = {__builtin_amdgcn_fmed3f(g[2 * j], -3.0e38f, 7.0f), __builtin_amdgcn_fmed3f(g[2 * j + 1], -3.0e38f, 7.0f)};
                        const f32x2 uu = {__builtin_amdgcn_fmed3f(up[2 * j], -7.0f, 7.0f), __builtin_amdgcn_fmed3f(up[2 * j + 1], -7.0f, 7.0f)};
                        const f32x2 t = gg * -2.4554669595930156f;
                        f32x2 d = {__builtin_amdgcn_exp2f(t.x), __builtin_amdgcn_exp2f(t.y)}; d = d + 1.0f;
                        const f32x2 rr = {__builtin_amdgcn_rcpf(d.x), __builtin_amdgcn_rcpf(d.y)};
                        const f32x2 o = (uu + 1.0f) * gg * rr;
                        wv[2 * n + j] = cvt_pk_bf16(o.x, o.y); } }
                u32x4 w; w.x = wv[0]; w.y = wv[1]; w.z = wv[2]; w.w = wv[3];
                *(u32x4*)rowp = w; }
    }
};
struct EpiDown {
    static constexpr bool PERM = true;
    bf16_t* Y; const float* bd; const float* rgate;
    __device__ __forceinline__ void init(f32x4 (&acc)[2][2][4][2], const Unit& u, int wc, int fq) const {
        const float* b = bd + (size_t)u.e * 1024 + u.pn * BM + wc * 32 + 8 * fq;
#pragma unroll
        for (int bj = 0; bj < 2; ++bj)
#pragma unroll
            for (int n = 0; n < 2; ++n) { const f32x4 bv = *(const f32x4*)(b + bj * HALF + 4 * n);
#pragma unroll
                for (int a = 0; a < 2; ++a)
#pragma unroll
                    for (int m = 0; m < 4; ++m) acc[a][bj][m][n] = bv; }
    }
    __device__ __forceinline__ void operator()(const f32x4 (&acc)[2][2][4][2], const Unit& u, int wr, int wc, int fr, int fq) const {
        const int row0 = u.pm * BM + wr * 64 + fr, col0 = u.pn * BM + wc * 32 + 8 * fq;
#pragma unroll
        for (int ai = 0; ai < 2; ++ai)
#pragma unroll
            for (int m = 0; m < 4; ++m) { const int row = row0 + ai * HALF + m * 16; const float gt = rgate[row]; bf16_t* rowp = Y + (size_t)row * D + col0;
#pragma unroll
                for (int bj = 0; bj < 2; ++bj) { const f32x4 v0 = acc[ai][bj][m][0] * gt, v1 = acc[ai][bj][m][1] * gt;
                    u32x4 w; w.x = cvt_pk_bf16(v0[0], v0[1]); w.y = cvt_pk_bf16(v0[2], v0[3]); w.z = cvt_pk_bf16(v1[0], v1[1]); w.w = cvt_pk_bf16(v1[2], v1[3]);
                    *(u32x4*)(rowp + bj * HALF) = w; } }
    }
};
}
struct Frame {
    LAS unsigned char* lds;
    volatile LAS unsigned* LC;
    unsigned* ctl;
    unsigned char* ws;
    int tid, lane, wave, G, bx;
    float* out;
};
__device__ __forceinline__ size_t opaque_off(size_t o) { asm volatile("; ws offset" : "+s"(o)); return o; }
#define WSP(T_, off) ((T_*)(F.ws + opaque_off(off)))
__device__ __forceinline__ const float* inptr(const Frame& F, int i) {
    const unsigned lo = __builtin_amdgcn_readfirstlane(F.LC[128 + 2 * i]), hi = __builtin_amdgcn_readfirstlane(F.LC[129 + 2 * i]);
    const float* p = (const float*)(const GAS float*)(((unsigned long long)hi << 32) | (unsigned long long)lo);
    return p;
}
enum { I_X = 0, I_LN_G, I_LN_B, I_NSA_W_IN, I_NSA_CMP_POS, I_NSA_CMP_W1, I_NSA_CMP_B1, I_NSA_CMP_W2, I_NSA_CMP_B2, I_NSA_GATE_B, I_NSA_W_OUT,
       I_ML_W_IN, I_ML_CONV_W, I_ML_CONV_B, I_ML_GATE_B, I_ML_NORM_G, I_ML_W_OUT, I_HG_W_IN, I_HG_LOWER, I_HG_NORM_G, I_HG_W_OUT,
       I_ROUTER_W, I_ROUTER_B, I_MOE_W_GU, I_MOE_B_GU, I_MOE_W_DOWN, I_MOE_B_DOWN };

__device__ __forceinline__ void tr_load(f32x4 (&v)[16], const float* W, int N, int nvalid, int k0, int n0, int lane) {
    const int nn = n0 + 4 * (lane & 15); const bool ok = nn < nvalid; const int kr = lane >> 4;
#pragma unroll
    for (int i = 0; i < 16; ++i) v[i] = ok ? *(const f32x4*)(W + (size_t)(k0 + 4 * i + kr) * N + nn) : (f32x4){0.f, 0.f, 0.f, 0.f};
}
__device__ __forceinline__ void tr_store(const f32x4 (&v)[16], int K, bf16_t* WT, int drow, int k0, LAS float* scr, int lane) {
    const int kr = lane >> 4;
#pragma unroll
    for (int i = 0; i < 16; ++i) { LAS float* d = scr + (4 * i + kr) * 65 + 4 * (lane & 15); d[0] = v[i][0]; d[1] = v[i][1]; d[2] = v[i][2]; d[3] = v[i][3]; }
    LDS_WAIT();
    const int c = lane & 7;
#pragma unroll
    for (int j = 0; j < 8; ++j) { const int n = (lane >> 3) + 8 * j; const LAS float* s = scr + (8 * c) * 65 + n;
        u32x4 o; o.x = pk2(s[0 * 65], s[1 * 65]); o.y = pk2(s[2 * 65], s[3 * 65]); o.z = pk2(s[4 * 65], s[5 * 65]); o.w = pk2(s[6 * 65], s[7 * 65]);
        *(u32x4*)(WT + (size_t)(drow + n) * K + k0 + 8 * c) = o; }
    LDS_WAIT();
}
__device__ __forceinline__ void tr_class(Frame& F, const float* W, int nmat, int K, int N, int Npad, bf16_t* WT, bool gu, LAS float* scr, int gw, int NGW) {
    const int nblk = Npad / 64, per = (K / 64) * nblk; const long total = (long)nmat * per;
    f32x4 vbuf[16];
    long it = gw;
    if (it < total) { const int mat = (int)(it / per), r = (int)(it % per), kb = r / nblk, nb = r % nblk; tr_load(vbuf, W + (size_t)mat * K * N, N, N, kb * 64, nb * 64, F.lane); }
#pragma unroll 1
    for (; it < total; it += NGW) {
        const int mat = (int)(it / per), r = (int)(it % per), kb = r / nblk, nb = r % nblk, n0 = nb * 64;
        int drow = n0;
        if (gu) drow = (n0 < 1024) ? ((n0 >> 7) * 256 + (n0 & 127)) : ((((n0 - 1024) >> 7) * 256) + 128 + ((n0 - 1024) & 127));
        f32x4 cur[16];
#pragma unroll
        for (int i = 0; i < 16; ++i) cur[i] = vbuf[i];
        const long nx = it + NGW;
        if (nx < total) { const int mat2 = (int)(nx / per), r2 = (int)(nx % per), kb2 = r2 / nblk, nb2 = r2 % nblk; tr_load(vbuf, W + (size_t)mat2 * K * N, N, N, kb2 * 64, nb2 * 64, F.lane); }
        tr_store(cur, K, WT + (size_t)mat * Npad * K, drow, kb * 64, scr, F.lane);
    }
}
__device__ __forceinline__ void p0_prologue(Frame& F) {
    LAS float* scr = (LAS float*)(F.lds + F.wave * 16896);
    const int gw = F.bx * 8 + F.wave, NGW = F.G * 8;
    tr_class(F, inptr(F, I_MOE_W_GU), DEPTH * NEXP, D, 2 * DFF, 2 * DFF, WSP(bf16_t, OFF_W_GU), true, scr, gw, NGW);
    tr_class(F, inptr(F, I_MOE_W_DOWN), DEPTH * NEXP, DFF, D, D, WSP(bf16_t, OFF_W_DN), false, scr, gw, NGW);
    tr_class(F, inptr(F, I_NSA_W_IN), 2, D, NSA_IN, NSA_LD, WSP(bf16_t, OFF_W_NSAIN), false, scr, gw, NGW);
    tr_class(F, inptr(F, I_NSA_W_OUT), 2, D, D, D, WSP(bf16_t, OFF_W_NSAOUT), false, scr, gw, NGW);
    tr_class(F, inptr(F, I_ML_W_IN), 1, D, ML_IN, ML_LD, WSP(bf16_t, OFF_W_MLIN), false, scr, gw, NGW);
    tr_class(F, inptr(F, I_ML_W_OUT), 1, D, D, D, WSP(bf16_t, OFF_W_MLOUT), false, scr, gw, NGW);
    tr_class(F, inptr(F, I_HG_W_IN), 1, D, HG_LD, HG_LD, WSP(bf16_t, OFF_W_HGIN), false, scr, gw, NGW);
    tr_class(F, inptr(F, I_HG_W_OUT), 1, D, D, D, WSP(bf16_t, OFF_W_HGOUT), false, scr, gw, NGW);
    tr_class(F, inptr(F, I_NSA_CMP_W1), 4, 2048, 256, 256, WSP(bf16_t, OFF_W_CMP1), false, scr, gw, NGW);
    tr_class(F, inptr(F, I_NSA_CMP_W2), 4, 256, 64, 64, WSP(bf16_t, OFF_W_CMP2), false, scr, gw, NGW);
    const int gt = F.bx * 512 + F.tid;
    float* tab = WSP(float, OFF_TAB);
    if (gt < 1024) {
        const int lj = gt >> 8, n = gt & 255; const float* pos = inptr(F, I_NSA_CMP_POS) + (size_t)lj * 2048; const float* w1 = inptr(F, I_NSA_CMP_W1) + (size_t)lj * 2048 * 256;
        float a = inptr(F, I_NSA_CMP_B1)[lj * 256 + n];
        for (int k = 0; k < 2048; ++k) a += pos[k] * w1[(size_t)k * 256 + n];
        tab[TAB_CMPB + gt] = a;
    } else if (gt < 2048) {
        const int c = gt - 1024; float v[DEPTH], mx = -1e30f;
#pragma unroll
        for (int i = 0; i < DEPTH; ++i) { v[i] = inptr(F, I_HG_LOWER)[i * D + c]; mx = fmaxf(mx, v[i]); }
        float s = 0.f;
#pragma unroll
        for (int i = 0; i < DEPTH; ++i) { v[i] = __expf(v[i] - mx); s += v[i]; }
        tab[TAB_LB + c] = (v[1] + v[2]) / s;
    }
    { const float* rw = inptr(F, I_ROUTER_W); float* rwt = WSP(float, OFF_TAB) + TAB_RWT;
      for (int i = F.bx * 512 + F.tid; i < DEPTH * D * NEXP; i += F.G * 512) { const int l = i >> 15, r = i & 32767, k = r >> 5, e = r & 31; rwt[(l * NEXP + e) * D + k] = rw[i]; } }
    {
        const f32x4* xs = (const f32x4*)inptr(F, I_X); u32x2* xn = WSP(u32x2, OFF_XN);
        const size_t n4 = (size_t)NTOK * D / 4, stride = (size_t)F.G * 512;
        for (size_t i = (size_t)F.bx * 512 + F.tid; i < n4; i += stride) { const f32x4 v = xs[i]; u32x2 o; o.x = pk2(v[0], v[1]); o.y = pk2(v[2], v[3]); xn[i] = o; }
    }
}

__device__ __forceinline__ void phase_ln_router(Frame& F, int layer, bool dummy = false) {
    constexpr int SP = 1028;
    LAS float* LgL = (LAS float*)F.lds;
    LAS float* slab = LgL + 256 * 33;
    LAS float* part = slab + 16 * SP;
    if (F.tid < 32) F.LC[64 + F.tid] = 0u;
    __syncthreads();
    const float* g = inptr(F, I_LN_G) + (size_t)(layer * 2 + 0) * D; const float* bb = inptr(F, I_LN_B) + (size_t)(layer * 2 + 0) * D;
    const float* rb = inptr(F, I_ROUTER_B) + layer * NEXP;
    const float* rwt = WSP(float, OFF_TAB) + TAB_RWT + (size_t)layer * NEXP * D;
    const bf16_t* HM = WSP(bf16_t, OFF_HM); bf16_t* XN = dummy ? WSP(bf16_t, OFF_H + 256 * MiB) : WSP(bf16_t, OFF_XN);
    const bf16_t* XR = WSP(bf16_t, OFF_XN);
    int* toke = dummy ? WSP(int, OFF_H + 400 * MiB) : WSP(int, OFF_TOKE); float* tokg = dummy ? WSP(float, OFF_H + 402 * MiB) : WSP(float, OFF_TOKG);
    int lane = F.lane; asm volatile("; phase-local lane" : "+v"(lane));
    const int fr = lane & 15, fg = lane >> 4, wave = F.wave;
    f32x4 b0r[8], b1r[8];
    { const f32x4* B0p = (const f32x4*)(rwt + (size_t)fr * D + 128 * wave) + fg; const f32x4* B1p = (const f32x4*)(rwt + (size_t)(16 + fr) * D + 128 * wave) + fg;
#pragma unroll
      for (int t = 0; t < 8; ++t) { b0r[t] = B0p[4 * t]; b1r[t] = B1p[4 * t]; } }
    for (int blk = F.bx; blk < NTOK / 256; blk += F.G) {
        u32x2 xn_[2][4], hn_[2][4];
        { const int m0 = blk * 256 + 2 * wave;
#pragma unroll
          for (int q = 0; q < 2; ++q) { const u32x2* xr = (const u32x2*)(XR + (size_t)(m0 + q) * D) + lane; const u32x2* hr = (const u32x2*)(HM + (size_t)(m0 + q) * D) + lane;
#pragma unroll
            for (int j = 0; j < 4; ++j) { xn_[q][j] = xr[64 * j]; hn_[q][j] = hr[64 * j]; } } }
#pragma unroll 1
        for (int sub = 0; sub < 16; ++sub) {
            const int mb = blk * 256 + sub * 16 + 2 * wave;
            f32x4 v[2][4]; float s[2] = {0.f, 0.f};
#pragma unroll
            for (int q = 0; q < 2; ++q)
#pragma unroll
                for (int j = 0; j < 4; ++j) { const u32x2 xv = xn_[q][j]; const u32x2 hv = hn_[q][j];
                    v[q][j][0] = DN_ALPHA * __uint_as_float(xv.x << 16) + __uint_as_float(hv.x << 16); v[q][j][1] = DN_ALPHA * __uint_as_float(xv.x & 0xffff0000u) + __uint_as_float(hv.x & 0xffff0000u);
                    v[q][j][2] = DN_ALPHA * __uint_as_float(xv.y << 16) + __uint_as_float(hv.y << 16); v[q][j][3] = DN_ALPHA * __uint_as_float(xv.y & 0xffff0000u) + __uint_as_float(hv.y & 0xffff0000u);
                    s[q] += (v[q][j][0] + v[q][j][1]) + (v[q][j][2] + v[q][j][3]); }
            if (sub + 1 < 16) {
#pragma unroll
                for (int q = 0; q < 2; ++q) { const u32x2* xr = (const u32x2*)(XR + (size_t)(mb + 16 + q) * D) + lane; const u32x2* hr = (const u32x2*)(HM + (size_t)(mb + 16 + q) * D) + lane;
#pragma unroll
                    for (int j = 0; j < 4; ++j) { xn_[q][j] = xr[64 * j]; hn_[q][j] = hr[64 * j]; } } }
#pragma unroll
            for (int q = 0; q < 2; ++q) {
                const float mean = wave_sum(s[q]) * (1.f / D); float s2 = 0.f;
#pragma unroll
                for (int j = 0; j < 4; ++j) { v[q][j] = v[q][j] - mean; s2 += (v[q][j][0] * v[q][j][0] + v[q][j][1] * v[q][j][1]) + (v[q][j][2] * v[q][j][2] + v[q][j][3] * v[q][j][3]); }
                const float rstd = __builtin_amdgcn_rsqf(wave_sum(s2) * (1.f / D) + LN_EPS);
                u32x2* no = (u32x2*)(XN + (size_t)(mb + q) * D) + lane; LAS f32x4* so = (LAS f32x4*)(slab + (2 * wave + q) * SP) + lane;
#pragma unroll
                for (int j = 0; j < 4; ++j) { const f32x4 gv = *((const f32x4*)g + lane + 64 * j), bv = *((const f32x4*)bb + lane + 64 * j);
                    const f32x4 y = v[q][j] * rstd * gv + bv; so[64 * j] = y; u32x2 o; o.x = pk2(y[0], y[1]); o.y = pk2(y[2], y[3]); no[64 * j] = o; }
            }
            __syncthreads();
            {
                const LAS f32x4* Ap = (const LAS f32x4*)(slab + fr * SP + 128 * wave) + fg;
                f32x4 acc0 = (f32x4){0.f, 0.f, 0.f, 0.f}, acc1 = acc0;
#pragma unroll
                for (int t = 0; t < 8; ++t) { const f32x4 a = Ap[4 * t], b0 = b0r[t], b1 = b1r[t];
#pragma unroll
                    for (int j = 0; j < 4; ++j) { acc0 = __builtin_amdgcn_mfma_f32_16x16x4f32(a[j], b0[j], acc0, 0, 0, 0); acc1 = __builtin_amdgcn_mfma_f32_16x16x4f32(a[j], b1[j], acc1, 0, 0, 0); } }
#pragma unroll
                for (int e = 0; e < 4; ++e) { LAS float* pr = part + (wave * 16 + 4 * fg + e) * 33; pr[fr] = acc0[e]; pr[16 + fr] = acc1[e]; }
            }
            __syncthreads();
            { const int row = F.tid >> 5, e = F.tid & 31; float lg = rb[e];
#pragma unroll
              for (int w8 = 0; w8 < 8; ++w8) lg += part[(w8 * 16 + row) * 33 + e];
              LgL[(sub * 16 + row) * 33 + e] = lg; }
        }
        __syncthreads();
        if (F.tid < 256) {
            const int m = blk * 256 + F.tid; const LAS float* lr = LgL + F.tid * 33;
            unsigned taken = 0u; int se[TOPK]; float sv[TOPK];
#pragma unroll
            for (int k = 0; k < TOPK; ++k) { float best = -INFINITY; int bi = 0;
#pragma unroll 8
                for (int e = 0; e < NEXP; ++e) { const float c = ((taken >> e) & 1u) ? -INFINITY : lr[e]; if (c > best) { best = c; bi = e; } }
                se[k] = bi; sv[k] = best; taken |= 1u << bi; }
            float gs = 0.f, ge[TOPK];
#pragma unroll
            for (int k = 0; k < TOPK; ++k) { ge[k] = __expf(sv[k] - sv[0]); gs += ge[k]; }
            const float inv = __builtin_amdgcn_rcpf(gs);
#pragma unroll
            for (int k = 0; k < TOPK; ++k) { toke[m * 4 + k] = se[k]; tokg[m * 4 + k] = ge[k] * inv; __hip_atomic_fetch_add((LAS unsigned*)&F.LC[64 + se[k]], 1u, __ATOMIC_RELAXED, __HIP_MEMORY_SCOPE_WORKGROUP); }
        }
        __syncthreads();
    }
    if (F.tid < 32) { const unsigned c = F.LC[64 + F.tid]; if (c) __hip_atomic_fetch_add(F.ctl + (dummy ? 12288 : CW_CNT) + layer * 64 + F.tid, c, RLX_AGENT); }
    __syncthreads();
}

__device__ __forceinline__ void moe_tile_table(Frame& F, int layer) {
    if (F.tid < 64) {
        const int e = F.tid & 31;
        const unsigned c = __hip_atomic_load(F.ctl + CW_CNT + layer * 64 + e, RLX_AGENT);
        int acc = (int)((c + 255u) >> 8);
#pragma unroll
        for (int o = 1; o < 32; o <<= 1) { const int u = __shfl_up(acc, o); if (e >= o) acc += u; }
        if (F.tid < 32) { F.LC[8 + e] = (unsigned)acc; if (e == 31) F.LC[40] = (unsigned)acc; }
    }
    __syncthreads();
}
__device__ __forceinline__ void phase_moe_slots(Frame& F, int layer) {
    moe_tile_table(F, layer);
    const int* toke = WSP(int, OFF_TOKE); const float* tokg = WSP(float, OFF_TOKG);
    int* tokp = WSP(int, OFF_TOKP); int* rowt = WSP(int, OFF_ROWT); float* rowg = WSP(float, OFF_ROWG);
    for (int blk = F.bx; blk < NTOK / 256; blk += F.G) {
        if (F.tid < 32) F.LC[64 + F.tid] = 0u;
        __syncthreads();
        int e[2], rank[2];
#pragma unroll
        for (int q = 0; q < 2; ++q) { const int a = blk * 1024 + q * 512 + F.tid; e[q] = toke[a]; rank[q] = (int)__hip_atomic_fetch_add((LAS unsigned*)&F.LC[64 + e[q]], 1u, __ATOMIC_RELAXED, __HIP_MEMORY_SCOPE_WORKGROUP); }
        __syncthreads();
        if (F.tid < 32) { const unsigned c = F.LC[64 + F.tid]; const unsigned pstart = (F.tid ? F.LC[8 + F.tid - 1] : 0u) * 256u;
            F.LC[96 + F.tid] = pstart + (c ? __hip_atomic_fetch_add(F.ctl + CW_CUR + layer * 64 + F.tid, c, RLX_AGENT) : 0u); }
        __syncthreads();
#pragma unroll
        for (int q = 0; q < 2; ++q) { const int a = blk * 1024 + q * 512 + F.tid; const int pos = (int)F.LC[96 + e[q]] + rank[q];
            rowt[pos] = a >> 2; rowg[pos] = tokg[a]; tokp[a] = pos; }
        __syncthreads();
    }
    for (int e2 = F.bx; e2 < NEXP; e2 += F.G) {
        const unsigned c = __hip_atomic_load(F.ctl + CW_CNT + layer * 64 + e2, RLX_AGENT); const unsigned pstart = (e2 ? F.LC[8 + e2 - 1] : 0u) * 256u, pend = F.LC[8 + e2] * 256u;
        for (unsigned r = pstart + c + F.tid; r < pend; r += 512) { rowt[r] = 0; rowg[r] = 0.f; }
    }
}
__device__ __forceinline__ void phase_combine_ln(Frame& F, int layer, float* xo_base  , bool dummy = false) {
    const float* g = inptr(F, I_LN_G) + (size_t)(layer * 2 + 1) * D; const float* bb = inptr(F, I_LN_B) + (size_t)(layer * 2 + 1) * D;
    const bf16_t* XR = WSP(bf16_t, OFF_XN); bf16_t* XN = dummy ? WSP(bf16_t, OFF_H + 256 * MiB) : WSP(bf16_t, OFF_XN); const bf16_t* Y = WSP(bf16_t, OFF_Y); const int* tokp = WSP(int, OFF_TOKP);
    int lane = F.lane; asm volatile("; phase-local lane" : "+v"(lane)); const int gw = F.bx * 8 + F.wave, NGW = F.G * 8;
    u32x2 xq[4]; u32x2 yq[TOPK][4]; int posn[TOPK];
    {
        int p0[TOPK];
#pragma unroll
        for (int k = 0; k < TOPK; ++k) p0[k] = (gw < NTOK) ? tokp[gw * 4 + k] : 0;
        if (gw < NTOK) { const u32x2* xr = (const u32x2*)(XR + (size_t)gw * D) + lane;
#pragma unroll
            for (int j = 0; j < 4; ++j) xq[j] = xr[64 * j];
#pragma unroll
            for (int k = 0; k < TOPK; ++k) { const u32x2* yr = (const u32x2*)(Y + (size_t)p0[k] * D) + lane;
#pragma unroll
                for (int j = 0; j < 4; ++j) yq[k][j] = __builtin_nontemporal_load(yr + 64 * j); } }
#pragma unroll
        for (int k = 0; k < TOPK; ++k) posn[k] = (gw + NGW < NTOK) ? tokp[(gw + NGW) * 4 + k] : 0;
    }
#pragma unroll 1
    for (int m = gw; m < NTOK; m += NGW) {
        f32x4 v[4]; float s = 0.f;
#pragma unroll
        for (int j = 0; j < 4; ++j) { const u32x2 xv = xq[j]; v[j][0] = DN_ALPHA * __uint_as_float(xv.x << 16); v[j][1] = DN_ALPHA * __uint_as_float(xv.x & 0xffff0000u); v[j][2] = DN_ALPHA * __uint_as_float(xv.y << 16); v[j][3] = DN_ALPHA * __uint_as_float(xv.y & 0xffff0000u); }
#pragma unroll
        for (int k = 0; k < TOPK; ++k) {
#pragma unroll
            for (int j = 0; j < 4; ++j) { const u32x2 hv = yq[k][j];
                v[j][0] += __uint_as_float(hv.x << 16); v[j][1] += __uint_as_float(hv.x & 0xffff0000u); v[j][2] += __uint_as_float(hv.y << 16); v[j][3] += __uint_as_float(hv.y & 0xffff0000u); } }
        if (m + NGW < NTOK) {
            const u32x2* xr = (const u32x2*)(XR + (size_t)(m + NGW) * D) + lane;
#pragma unroll
            for (int j = 0; j < 4; ++j) xq[j] = xr[64 * j];
#pragma unroll
            for (int k = 0; k < TOPK; ++k) { const u32x2* yr = (const u32x2*)(Y + (size_t)posn[k] * D) + lane;
#pragma unroll
                for (int j = 0; j < 4; ++j) yq[k][j] = __builtin_nontemporal_load(yr + 64 * j); }
#pragma unroll
            for (int k = 0; k < TOPK; ++k) posn[k] = (m + 2 * NGW < NTOK) ? tokp[(m + 2 * NGW) * 4 + k] : 0;
        }
#pragma unroll
        for (int j = 0; j < 4; ++j) s += (v[j][0] + v[j][1]) + (v[j][2] + v[j][3]);
        const float mean = wave_sum(s) * (1.f / D); float s2 = 0.f;
#pragma unroll
        for (int j = 0; j < 4; ++j) { v[j] = v[j] - mean; s2 += (v[j][0] * v[j][0] + v[j][1] * v[j][1]) + (v[j][2] * v[j][2] + v[j][3] * v[j][3]); }
        const float rstd = __builtin_amdgcn_rsqf(wave_sum(s2) * (1.f / D) + LN_EPS);
        u32x2* no = (u32x2*)(XN + (size_t)m * D) + lane;
#pragma unroll
        for (int j = 0; j < 4; ++j) { const f32x4 gv = *((const f32x4*)g + lane + 64 * j), bv = *((const f32x4*)bb + lane + 64 * j);
            v[j] = v[j] * rstd * gv + bv;
            if (xo_base) *((f32x4*)(xo_base + (size_t)m * D) + lane + 64 * j) = v[j];
            else { u32x2 o; o.x = pk2(v[j][0], v[j][1]); o.y = pk2(v[j][2], v[j][3]); no[64 * j] = o; } }
    }
}
__device__ __forceinline__ void phase_nsa_cmp2(Frame& F, int slot) {
    const bf16_t* HC = WSP(bf16_t, OFF_HC); bf16_t* KC = WSP(bf16_t, OFF_KC);
    const bf16_t* W2t = WSP(bf16_t, OFF_W_CMP2) + (size_t)slot * 2 * 64 * 256;
    const float* b2 = inptr(F, I_NSA_CMP_B2) + (size_t)slot * 2 * 64;
    int lane = F.lane; asm volatile("; phase-local lane" : "+v"(lane));
    const int fr = lane & 15, fg = lane >> 4, gw = F.bx * 8 + F.wave, NGW = F.G * 8;
    for (int blk = gw; blk < 2 * 1024; blk += NGW) {
        const int j = blk >> 10, r0 = (blk & 1023) * 16;
        const bf16_t* A = HC + ((size_t)j * 16384 + r0 + fr) * 256 + 8 * fg;
        const bf16_t* B = W2t + ((size_t)j * 64 + fr) * 256 + 8 * fg;
        f32x4 acc[4];
#pragma unroll
        for (int t = 0; t < 4; ++t) acc[t] = (f32x4){0.f, 0.f, 0.f, 0.f};
#pragma unroll
        for (int ks = 0; ks < 8; ++ks) { const bf16x8 a = *(const bf16x8*)(A + 32 * ks);
#pragma unroll
            for (int t = 0; t < 4; ++t) acc[t] = __builtin_amdgcn_mfma_f32_16x16x32_bf16(*(const bf16x8*)(B + (size_t)t * 16 * 256 + 32 * ks), a, acc[t], 0, 0, 0); }
        const int row = r0 + fr;
#pragma unroll
        for (int t = 0; t < 4; ++t) { const int d0 = 16 * t + 4 * fg; const f32x4 bv = *(const f32x4*)(b2 + j * 64 + d0);
            f32x4 v = acc[t] + bv; if ((row & 127) == 127) v = (f32x4){0.f, 0.f, 0.f, 0.f};
            u32x2 w; w.x = pg8::cvt_pk_bf16(v[0], v[1]); w.y = pg8::cvt_pk_bf16(v[2], v[3]);
            *(u32x2*)(KC + ((size_t)j * 16384 + row) * 64 + d0) = w; }
    }
}
typedef float f32x16 __attribute__((ext_vector_type(16)));
#define PP_SYNC() do { __builtin_amdgcn_sched_barrier(0); __syncthreads(); __builtin_amdgcn_sched_barrier(0); } while (0)
#ifndef SP_SCALAR
#define SP_SCALAR 0
#endif
#ifndef SP_FILL
#define SP_FILL 12
#endif
#ifndef XCMP
#define XCMP 0
#endif
#ifndef XSELN
#define XSELN 0
#endif
#ifndef XOUT
#define XOUT 0
#endif
namespace na {
constexpr int KP = 144;
constexpr int VP = 144;
__device__ __forceinline__ int vcol(int key) { return (key & ~15) | (key & 3) | ((key & 8) >> 1) | ((key & 4) << 1); }
constexpr int TILEB = 64 * KP;
constexpr int L_K = 0, L_V = 2 * TILEB, L_PQ = 4 * TILEB, SLB = 64 * 33, L_SEL = L_PQ + 4 * SLB * 4, L_OA = L_SEL + 4864;
constexpr float NEG = -1e30f;
constexpr float C1 = 0.125f * 1.4426950408889634f;
__device__ __forceinline__ int crow(int r, int hi) { return (r & 3) + 8 * (r >> 2) + 4 * hi; }
__device__ __forceinline__ bf16x8 pack8(const f32x16& p, int s1) {
    u32x4 w; w.x = pg8::cvt_pk_bf16(p[8 * s1 + 0], p[8 * s1 + 1]); w.y = pg8::cvt_pk_bf16(p[8 * s1 + 2], p[8 * s1 + 3]);
    w.z = pg8::cvt_pk_bf16(p[8 * s1 + 4], p[8 * s1 + 5]); w.w = pg8::cvt_pk_bf16(p[8 * s1 + 6], p[8 * s1 + 7]);
    return __builtin_bit_cast(bf16x8, w);
}
__device__ __forceinline__ void qk(f32x16& p0, f32x16& p1, const LAS unsigned char* Kt, const bf16x8 (&qf)[4], int r, int h) {
    const f32x16 z = {0.f, 0.f, 0.f, 0.f, 0.f, 0.f, 0.f, 0.f, 0.f, 0.f, 0.f, 0.f, 0.f, 0.f, 0.f, 0.f};
    bf16x8 a0[4], a1[4];
#pragma unroll
    for (int s = 0; s < 4; ++s) { a0[s] = *(const LAS bf16x8*)(Kt + r * KP + (16 * s + 8 * h) * 2); a1[s] = *(const LAS bf16x8*)(Kt + (32 + r) * KP + (16 * s + 8 * h) * 2); }
    __builtin_amdgcn_sched_barrier(0);
#pragma unroll
    for (int s = 0; s < 4; ++s) {
        p0 = __builtin_amdgcn_mfma_f32_32x32x16_bf16(a0[s], qf[s], s == 0 ? z : p0, 0, 0, 0);
        p1 = __builtin_amdgcn_mfma_f32_32x32x16_bf16(a1[s], qf[s], s == 0 ? z : p1, 0, 0, 0);
    }
}
__device__ __forceinline__ void pv(f32x16& o0, f32x16& o1, const LAS unsigned char* Vt, const f32x16& p0, const f32x16& p1, int r, int h) {
#pragma unroll
    for (int s = 0; s < 4; ++s) {
        const int s1 = s & 1;
        const bf16x8 bfrag = (s < 2) ? pack8(p0, s1) : pack8(p1, s1);
        const int key0 = 32 * (s >> 1) + 16 * s1 + 4 * h;
#pragma unroll
        for (int dh = 0; dh < 2; ++dh) {
            const bf16x8 a = *(const LAS bf16x8*)(Vt + (32 * dh + r) * VP + (key0 - 4 * h + 8 * h) * 2);
            if (dh == 0) o0 = __builtin_amdgcn_mfma_f32_32x32x16_bf16(a, bfrag, o0, 0, 0, 0);
            else o1 = __builtin_amdgcn_mfma_f32_32x32x16_bf16(a, bfrag, o1, 0, 0, 0);
        }
    }
}
__device__ __forceinline__ void pack_p(bf16x8 (&pb)[4], const f32x16& p0, const f32x16& p1) { pb[0] = pack8(p0, 0); pb[1] = pack8(p0, 1); pb[2] = pack8(p1, 0); pb[3] = pack8(p1, 1); }
__device__ __forceinline__ void pv2(f32x16& o0, f32x16& o1, const LAS unsigned char* Vt, const bf16x8 (&pb)[4], int r, int h) {
    bf16x8 a[4][2];
#pragma unroll
    for (int s = 0; s < 4; ++s) {
        const int key0 = 32 * (s >> 1) + 16 * (s & 1) + 4 * h;
#pragma unroll
        for (int dh = 0; dh < 2; ++dh) {
            a[s][dh] = *(const LAS bf16x8*)(Vt + (32 * dh + r) * VP + (key0 - 4 * h + 8 * h) * 2);
        }
    }
    __builtin_amdgcn_sched_barrier(0);
#pragma unroll
    for (int s = 0; s < 4; ++s) {
        o0 = __builtin_amdgcn_mfma_f32_32x32x16_bf16(a[s][0], pb[s], o0, 0, 0, 0);
        o1 = __builtin_amdgcn_mfma_f32_32x32x16_bf16(a[s][1], pb[s], o1, 0, 0, 0);
    }
}
__device__ __forceinline__ void softmax_step(f32x16& p0, f32x16& p1, float& m, float& l, f32x16& o0, f32x16& o1, bool lane_on = true) {
    constexpr float THR = 8.0f / C1;
    float mx = fmaxf(fmaxf(fmaxf(p0[0], p1[5]), fmaxf(p0[10], p1[15])), fmaxf(fmaxf(p1[0], p0[5]), fmaxf(p1[10], p0[15])));
    mx = lane_on ? mx : NEG;
    mx = fmaxf(mx, __shfl_xor(mx, 32));
    const float mn = (mx > m + THR) ? mx : m;
    const float muse = (mn < -1e29f) ? 0.f : mn;
    const bool grow = mn != m;
    const float mc = lane_on ? muse * C1 : 3.0e38f;
    f32x2 lsa = {0.f, 0.f}, lsb = {0.f, 0.f}; const f32x2 c1v = {C1, C1}, nmc = {-mc, -mc};
#pragma unroll
    for (int i = 0; i < 8; ++i) {
        f32x2 a = {p0[2 * i], p0[2 * i + 1]}, b = {p1[2 * i], p1[2 * i + 1]};
        a = __builtin_elementwise_fma(a, c1v, nmc); b = __builtin_elementwise_fma(b, c1v, nmc);
        a.x = __builtin_amdgcn_exp2f(a.x); a.y = __builtin_amdgcn_exp2f(a.y); b.x = __builtin_amdgcn_exp2f(b.x); b.y = __builtin_amdgcn_exp2f(b.y);
        p0[2 * i] = a.x; p0[2 * i + 1] = a.y; p1[2 * i] = b.x; p1[2 * i + 1] = b.y; lsa += a; lsb += b; }
    const float ls = (lsa.x + lsa.y) + (lsb.x + lsb.y);
    if (__builtin_amdgcn_ballot_w64(grow) != 0ull) {
        const float alpha = __builtin_amdgcn_exp2f((((m < -1e29f) ? 0.f : m) - muse) * C1);
        l = l * alpha;
#pragma unroll
        for (int i = 0; i < 16; ++i) { o0[i] *= alpha; o1[i] *= alpha; }
        m = mn;
    }
    l += ls;
}
__device__ __forceinline__ void softmax_heavy(f32x16& p0, f32x16& p1, const float m, float& l, float& mxraw, bool lane_on) {
    const float mx = fmaxf(fmaxf(fmaxf(p0[0], p1[5]), fmaxf(p0[10], p1[15])), fmaxf(fmaxf(p1[0], p0[5]), fmaxf(p1[10], p0[15])));
    mxraw = lane_on ? mx : NEG;
    const float muse = (m < -1e29f) ? 0.f : m;
    const float mc = lane_on ? muse * C1 : 3.0e38f;
#if SP_SCALAR
    float ls0 = 0.f, ls1 = 0.f;
#pragma unroll
    for (int i = 0; i < 16; ++i) { p0[i] = __builtin_amdgcn_exp2f(p0[i] * C1 - mc); p1[i] = __builtin_amdgcn_exp2f(p1[i] * C1 - mc); ls0 += p0[i]; ls1 += p1[i]; }
    l += ls0 + ls1;
#else
    f32x2 lsa = {0.f, 0.f}, lsb = {0.f, 0.f}; const f32x2 c1v = {C1, C1}, nmc = {-mc, -mc};
#pragma unroll
    for (int i = 0; i < 8; ++i) {
        f32x2 a = {p0[2 * i], p0[2 * i + 1]}, b = {p1[2 * i], p1[2 * i + 1]};
        a = __builtin_elementwise_fma(a, c1v, nmc); b = __builtin_elementwise_fma(b, c1v, nmc);
        a.x = __builtin_amdgcn_exp2f(a.x); a.y = __builtin_amdgcn_exp2f(a.y); b.x = __builtin_amdgcn_exp2f(b.x); b.y = __builtin_amdgcn_exp2f(b.y);
        p0[2 * i] = a.x; p0[2 * i + 1] = a.y; p1[2 * i] = b.x; p1[2 * i + 1] = b.y; lsa += a; lsb += b; }
    l += (lsa.x + lsa.y) + (lsb.x + lsb.y);
#endif
}
__device__ __forceinline__ void softmax_light(float mxraw, float& m, float& l, f32x16& o0, f32x16& o1) {
    constexpr float THR = 8.0f / C1;
    const float mx = fmaxf(mxraw, __shfl_xor(mxraw, 32));
    const float mn = (mx > m + THR) ? mx : m;
    if (__builtin_amdgcn_ballot_w64(mn != m) != 0ull) {
        const float alpha = __builtin_amdgcn_exp2f((((m < -1e29f) ? 0.f : m) - ((mn < -1e29f) ? 0.f : mn)) * C1);
        l = l * alpha;
#pragma unroll
        for (int i = 0; i < 16; ++i) { o0[i] *= alpha; o1[i] *= alpha; }
        m = mn;
    }
}
struct Stage { u32x4 k, v; };
__device__ __forceinline__ void stage_load(Stage& st, const bf16_t* ksrc, const bf16_t* vsrc, long stride, int tid) {
    const int key = tid >> 3, dc = tid & 7, vkey = tid & 63, vdc = tid >> 6;
    st.k = *(const u32x4*)(ksrc + (long)key * stride + dc * 8); st.v = *(const u32x4*)(vsrc + (long)vkey * stride + vdc * 8);
}
__device__ __forceinline__ void stage_store(const Stage& st, LAS unsigned char* Kt, LAS unsigned char* Vt, int tid) {
    const int key = tid >> 3, dc = tid & 7, vkey = tid & 63, vdc = tid >> 6;
    *(LAS u32x4*)(Kt + key * KP + dc * 16) = st.k;
    const unsigned w[4] = {st.v.x, st.v.y, st.v.z, st.v.w};
#pragma unroll
    for (int e = 0; e < 4; ++e) { *(LAS unsigned short*)(Vt + (vdc * 8 + 2 * e) * VP + vcol(vkey) * 2) = (unsigned short)(w[e] & 0xffffu); *(LAS unsigned short*)(Vt + (vdc * 8 + 2 * e + 1) * VP + vcol(vkey) * 2) = (unsigned short)(w[e] >> 16); }
}
__device__ __forceinline__ void pp_load(u32x4 (&sg)[2], const bf16_t* src, long stride, int t256, int kind) {
    if (kind == 0) {
#pragma unroll
        for (int j = 0; j < 2; ++j) { const int c = t256 + 256 * j; sg[j] = *(const u32x4*)(src + (long)(c >> 3) * stride + (c & 7) * 8); }
    } else {
#pragma unroll
        for (int j = 0; j < 2; ++j) { const int c = t256 + 256 * j; sg[j] = *(const u32x4*)(src + (long)(c & 63) * stride + (c >> 6) * 8); }
    }
}
__device__ __forceinline__ void pp_store(const u32x4 (&sg)[2], LAS unsigned char* Kt, LAS unsigned char* Vt, int t256, int kind) {
    if (kind == 0) {
#pragma unroll
        for (int j = 0; j < 2; ++j) { const int c = t256 + 256 * j; *(LAS u32x4*)(Kt + (c >> 3) * KP + (c & 7) * 16) = sg[j]; }
    } else {
#pragma unroll
        for (int j = 0; j < 2; ++j) { const int c = t256 + 256 * j, vkey = c & 63, vdc = c >> 6; const unsigned w[4] = {sg[j].x, sg[j].y, sg[j].z, sg[j].w};
#pragma unroll
            for (int e = 0; e < 4; ++e) { *(LAS unsigned short*)(Vt + (vdc * 8 + 2 * e) * VP + vcol(vkey) * 2) = (unsigned short)(w[e] & 0xffffu); *(LAS unsigned short*)(Vt + (vdc * 8 + 2 * e + 1) * VP + vcol(vkey) * 2) = (unsigned short)(w[e] >> 16); } }
    }
}
template <int BR> __device__ __forceinline__ int pp_next(int kb, unsigned live) {
    if (BR == 1) return kb + 1;
    const unsigned rem = live & ~((2u << kb) - 1u);
    return rem ? __builtin_ctz(rem) : 32;
}
template <int BR>
__device__ __forceinline__ void pp_soft(f32x16& p0, f32x16& p1, int h, int kb, int qb, int qq, const LAS unsigned* selm, const float m, float& l, float& mxraw) {
    bool mine = true;
    if (BR == 0) mine = (selm[qq] >> kb) & 1u;
    if (kb == qb) {
#pragma unroll
        for (int e = 0; e < 16; ++e) { const int kk = crow(e, h); if (kk > qq) p0[e] = NEG; if (kk + 32 > qq) p1[e] = NEG; }
    } else if (BR == 1 && kb == qb - 8) {
#pragma unroll
        for (int e = 0; e < 16; ++e) { const int kk = crow(e, h); if (kk <= qq) p0[e] = NEG; if (kk + 32 <= qq) p1[e] = NEG; }
    }
    softmax_heavy(p0, p1, m, l, mxraw, mine);
}
template <int BR, bool PRE>
__device__ __forceinline__ void pp_stream(LAS unsigned char* lds, const bf16_t* Pb, int ld, int g, int qb, int qq, int qh, int t256, int r, int h, unsigned live, const LAS unsigned* selm,
                                          const bf16x8 (&qf)[4], u32x4 (&sg)[2], f32x16& o0, f32x16& o1, float& m, float& l) {
    const int kind = qh ^ 1;
    const int soff = (BR == 0 ? (kind == 0 ? 1536 : 1792) : (kind == 0 ? 2048 : 2304)) + g * 64;
    const int first = BR == 0 ? 0 : (qb > 8 ? qb - 8 : 0);
    const int n = BR == 0 ? __builtin_popcount(live) : (qb - first + 1);
    int kb_load = first;
    if (!PRE) pp_load(sg, Pb + (size_t)(kb_load * 64) * ld + soff, ld, t256, kind);
    kb_load = pp_next<BR>(kb_load, live);
    pp_store(sg, lds + L_K, lds + L_V, t256, kind);
    { const int kc = kb_load < qb ? kb_load : qb; pp_load(sg, Pb + (size_t)(kc * 64) * ld + soff, ld, t256, kind); kb_load = pp_next<BR>(kb_load, live); }
    __syncthreads();
    int kb = first;
    f32x16 p0, p1; float mxraw = NEG; bf16x8 pb[4];
    if (qh == 0) {
        qk(p0, p1, lds + L_K, qf, r, h);
#pragma unroll 1
        for (int i = 0; i < n; ++i) {
            pp_soft<BR>(p0, p1, h, kb, qb, qq, selm, m, l, mxraw);
            pack_p(pb, p0, p1);
            kb = pp_next<BR>(kb, live);
            PP_SYNC();
            if (i + 1 < n) pp_store(sg, lds + L_K + ((i + 1) & 1) * TILEB, lds + L_V + ((i + 1) & 1) * TILEB, t256, kind);
            { const int kc = kb_load < qb ? kb_load : qb; pp_load(sg, Pb + (size_t)(kc * 64) * ld + soff, ld, t256, kind); kb_load = pp_next<BR>(kb_load, live); }
            if (i + 1 < n) qk(p0, p1, lds + L_K + ((i + 1) & 1) * TILEB, qf, r, h);
            pv2(o0, o1, lds + L_V + (i & 1) * TILEB, pb, r, h);
            softmax_light(mxraw, m, l, o0, o1);
            PP_SYNC();
        }
    } else {
#pragma unroll 1
        for (int i = 0; i < n; ++i) {
            qk(p0, p1, lds + L_K + (i & 1) * TILEB, qf, r, h);
            if (i > 0) { pv2(o0, o1, lds + L_V + ((i - 1) & 1) * TILEB, pb, r, h); softmax_light(mxraw, m, l, o0, o1); }
            if (i + 1 < n) pp_store(sg, lds + L_K + ((i + 1) & 1) * TILEB, lds + L_V + ((i + 1) & 1) * TILEB, t256, kind);
            { const int kc = kb_load < qb ? kb_load : qb; pp_load(sg, Pb + (size_t)(kc * 64) * ld + soff, ld, t256, kind); kb_load = pp_next<BR>(kb_load, live); }
            PP_SYNC();
            pp_soft<BR>(p0, p1, h, kb, qb, qq, selm, m, l, mxraw);
            pack_p(pb, p0, p1);
            kb = pp_next<BR>(kb, live);
            PP_SYNC();
        }
        pv2(o0, o1, lds + L_V + ((n - 1) & 1) * TILEB, pb, r, h);
    }
}
__device__ __forceinline__ void st_store_k(const u32x4& k, LAS unsigned char* Kt, int tid) { const int key = tid >> 3, dc = tid & 7; *(LAS u32x4*)(Kt + key * KP + dc * 16) = k; }
__device__ __forceinline__ void st_store_v(const u32x4& v, LAS unsigned char* Vt, int tid) {
    const int vkey = tid & 63, vdc = tid >> 6; const unsigned w[4] = {v.x, v.y, v.z, v.w};
#pragma unroll
    for (int e = 0; e < 4; ++e) { *(LAS unsigned short*)(Vt + (vdc * 8 + 2 * e) * VP + vcol(vkey) * 2) = (unsigned short)(w[e] & 0xffffu); *(LAS unsigned short*)(Vt + (vdc * 8 + 2 * e + 1) * VP + vcol(vkey) * 2) = (unsigned short)(w[e] >> 16); }
}
__device__ __forceinline__ u32x4 st_load_k(const bf16_t* ksrc, long stride, int tid) { return *(const u32x4*)(ksrc + (long)(tid >> 3) * stride + (tid & 7) * 8); }
__device__ __forceinline__ u32x4 st_load_v(const bf16_t* vsrc, long stride, int tid) { return *(const u32x4*)(vsrc + (long)(tid & 63) * stride + (tid >> 6) * 8); }
template <int BR>
__device__ __forceinline__ void sp_mask(f32x16& p0, f32x16& p1, int h, int kb, int qb, int qq) {
    if (kb == qb) {
#pragma unroll
        for (int e = 0; e < 16; ++e) { const int kk = crow(e, h); if (kk > qq) p0[e] = NEG; if (kk + 32 > qq) p1[e] = NEG; }
    } else if (BR == 1 && kb == qb - 8) {
#pragma unroll
        for (int e = 0; e < 16; ++e) { const int kk = crow(e, h); if (kk <= qq) p0[e] = NEG; if (kk + 32 <= qq) p1[e] = NEG; }
    }
}
template <int BR, bool PRE>
__device__ __forceinline__ void sp_stream(LAS unsigned char* lds, const bf16_t* Pb, int ld, int g, int qb, int qq, int tid, int r, int h, unsigned live, const LAS unsigned* selm,
                                          const bf16x8 (&qf)[4], Stage& st, f32x16& o0, f32x16& o1, float& m, float& l) {
    const int koff = (BR == 0 ? 1536 : 2048) + g * 64, voff = (BR == 0 ? 1792 : 2304) + g * 64;
    const int first = BR == 0 ? 0 : (qb > 8 ? qb - 8 : 0);
    const int n = BR == 0 ? __builtin_popcount(live) : (qb - first + 1);
    int kbK = first, kbV = first;
    if (!PRE) stage_load(st, Pb + (size_t)(first * 64) * ld + koff, Pb + (size_t)(first * 64) * ld + voff, ld, tid);
    kbK = pp_next<BR>(kbK, live); kbV = kbK;
    Stage s1; { const int kc = kbK < qb ? kbK : qb; stage_load(s1, Pb + (size_t)(kc * 64) * ld + koff, Pb + (size_t)(kc * 64) * ld + voff, ld, tid); }
    kbK = pp_next<BR>(kbK, live); kbV = kbK;
    stage_store(st, lds + L_K, lds + L_V, tid);
    st_store_k(s1.k, lds + L_K + TILEB, tid); st.v = s1.v;
    { const int kc = kbK < qb ? kbK : qb; st.k = st_load_k(Pb + (size_t)(kc * 64) * ld + koff, ld, tid); kbK = pp_next<BR>(kbK, live); }
    __syncthreads();
    f32x16 p0, p1; float mxraw = NEG; bf16x8 pb[4];
    qk(p0, p1, lds + L_K, qf, r, h);
    int kb = first, rk1 = 1, rk2 = 2;
#pragma unroll 1
    for (int i = 0; i < n; ++i) {
        if (i + 2 < n) st_store_k(st.k, lds + (rk2 == 2 ? L_PQ : L_K + rk2 * TILEB), tid);
        if (i + 1 < n) st_store_v(st.v, lds + L_V + ((i + 1) & 1) * TILEB, tid);
        { const int kc = kbK < qb ? kbK : qb, vc = kbV < qb ? kbV : qb;
          st.k = st_load_k(Pb + (size_t)(kc * 64) * ld + koff, ld, tid); st.v = st_load_v(Pb + (size_t)(vc * 64) * ld + voff, ld, tid); kbK = pp_next<BR>(kbK, live); kbV = pp_next<BR>(kbV, live); }
        bool mine = true;
        if (BR == 0) mine = (selm[qq] >> kb) & 1u;
        sp_mask<BR>(p0, p1, h, kb, qb, qq);
        f32x16 n0, n1;
        {
            const LAS unsigned char* Kt = lds + (rk1 == 2 ? L_PQ : L_K + rk1 * TILEB);
            const f32x16 z = {0.f, 0.f, 0.f, 0.f, 0.f, 0.f, 0.f, 0.f, 0.f, 0.f, 0.f, 0.f, 0.f, 0.f, 0.f, 0.f};
            bf16x8 a0[4], a1[4];
#pragma unroll
            for (int s = 0; s < 4; ++s) { a0[s] = *(const LAS bf16x8*)(Kt + r * KP + (16 * s + 8 * h) * 2); a1[s] = *(const LAS bf16x8*)(Kt + (32 + r) * KP + (16 * s + 8 * h) * 2); }
            __builtin_amdgcn_sched_barrier(0);
#pragma unroll
            for (int s = 0; s < 4; ++s) {
                n0 = __builtin_amdgcn_mfma_f32_32x32x16_bf16(a0[s], qf[s], s == 0 ? z : n0, 0, 0, 0);
                n1 = __builtin_amdgcn_mfma_f32_32x32x16_bf16(a1[s], qf[s], s == 0 ? z : n1, 0, 0, 0);
            }
            softmax_heavy(p0, p1, m, l, mxraw, mine);
            pack_p(pb, p0, p1);
#pragma unroll
            for (int j = 0; j < 8; ++j) { __builtin_amdgcn_sched_group_barrier(0x008, 1, 0); __builtin_amdgcn_sched_group_barrier(0x002, SP_FILL, 0); }
            __builtin_amdgcn_sched_barrier(0);
        }
        pv2(o0, o1, lds + L_V + (i & 1) * TILEB, pb, r, h);
        softmax_light(mxraw, m, l, o0, o1);
        p0 = n0; p1 = n1; kb = pp_next<BR>(kb, live); rk1 = rk2; rk2 = rk2 == 2 ? 0 : rk2 + 1;
        __syncthreads();
    }
}
}

__device__ __forceinline__ void phase_nsa_attn_mfma(Frame& F, int slot) {
    using namespace na;
    const bf16_t* P = WSP(bf16_t, OFF_PROJ); bf16_t* ATT = WSP(bf16_t, OFF_ATT);
    const bf16_t* KCb = WSP(bf16_t, OFF_KC); const bf16_t* VCb = KCb + (size_t)128 * 128 * 64;
    const float* gb = inptr(F, I_NSA_GATE_B) + slot * 48;
    int tid = F.tid; asm volatile("; phase-local tid" : "+v"(tid));
    const int wave = __builtin_amdgcn_readfirstlane(tid >> 6), lane = tid & 63, r = lane & 31, h = lane >> 5, hh = wave & 3, qh = wave >> 2;
    const int t256 = tid & 255;
    LAS unsigned char* lds = F.lds;
    LAS float* Pq = (LAS float*)(lds + L_PQ); LAS unsigned* selm = (LAS unsigned*)(lds + L_SEL);
    const int ld = NSA_LD;
    const int qq = qh * 32 + r;
#pragma unroll 1
    for (int it = F.bx; it < 4096; it += F.G) {
        const int sl = it & 255, rnd = it >> 8, bg = sl >> 1, par = sl & 1, qb = (rnd & 1) ? (31 - 2 * (rnd >> 1) - par) : (2 * (rnd >> 1) + par);
        const int b = bg >> 2, g = bg & 3, t = qb * 64 + qq;
        const bf16_t* Pb = P + (size_t)b * T * ld;
        const bf16_t* prow = Pb + (size_t)t * ld;
        bf16x8 qf[4];
#pragma unroll
        for (int s = 0; s < 4; ++s) qf[s] = *(const bf16x8*)(prow + g * 256 + hh * 64 + 16 * s + 8 * h);
        float gt[3];
#pragma unroll
        for (int j = 0; j < 3; ++j) gt[j] = sigmoidf_(bf2f(prow[2560 + g * 12 + hh * 3 + j]) + gb[g * 12 + hh * 3 + j]);
        LAS float* gsave = (LAS float*)(lds + L_SEL + 512) + tid * 2; gsave[0] = gt[1]; gsave[1] = gt[2];
        if (tid == 0) selm[64] = 0u;
        Stage st0, st1;
        stage_load(st0, KCb + (size_t)bg * 128 * 64, VCb + (size_t)bg * 128 * 64, 64, tid);
        stage_load(st1, KCb + (size_t)bg * 128 * 64 + 64 * 64, VCb + (size_t)bg * 128 * 64 + 64 * 64, 64, tid);
        stage_store(st0, lds + L_K, lds + L_V, tid);
        stage_store(st1, lds + L_K + TILEB, lds + L_V + TILEB, tid);
        __syncthreads();
        LAS float* oaL = (LAS float*)(lds + L_OA) + tid;
#pragma unroll 1
        for (int xr_ = 0; xr_ <= XCMP; ++xr_)
        {
            const int cmax = (t >= 31) ? (((t - 31) >> 4) < 126 ? ((t - 31) >> 4) : 126) : -1;
            f32x16 o0, o1; float m = NEG, l = 0.f;
#pragma unroll
            for (int i = 0; i < 16; ++i) { o0[i] = 0.f; o1[i] = 0.f; }
#pragma unroll 1
            for (int tl = 0; tl < 2; ++tl) {
                f32x16 p0, p1;
                qk(p0, p1, lds + L_K + tl * TILEB, qf, r, h);
#pragma unroll
                for (int i = 0; i < 16; ++i) { const int c = 64 * tl + crow(i, h); if (c > cmax) p0[i] = NEG; if (c + 32 > cmax) p1[i] = NEG; }
                softmax_step(p0, p1, m, l, o0, o1);
                pv(o0, o1, lds + L_V + tl * TILEB, p0, p1, r, h);
            }
            l += __shfl_xor(l, 32);
            const float inv = l > 0.f ? 1.0f / l : 0.f;
            const float cf = gt[0] * inv;
#pragma unroll
            for (int i = 0; i < 16; ++i) { oaL[512 * i] = cf * o0[i]; oaL[512 * (16 + i)] = cf * o1[i]; }
            const float mc = ((m < -1e29f) ? 0.f : m) * C1;
            LAS float* slab = Pq + hh * SLB + qq * 33;
#pragma unroll 1
            for (int tl = 1; tl >= 0; --tl) {
                f32x16 p0, p1;
                qk(p0, p1, lds + L_K + tl * TILEB, qf, r, h);
#pragma unroll
                for (int i = 0; i < 16; ++i) { const int c = 64 * tl + crow(i, h);
                    p0[i] = (c > cmax) ? 0.f : __builtin_amdgcn_exp2f(p0[i] * C1 - mc) * inv; p1[i] = (c + 32 > cmax) ? 0.f : __builtin_amdgcn_exp2f(p1[i] * C1 - mc) * inv; }
#pragma unroll
                for (int k = 0; k < 4; ++k) {
                    slab[16 * tl + 2 * k + h] = 2.0f * (p0[4 * k] + p0[4 * k + 1] + p0[4 * k + 2]) + p0[4 * k + 3];
                    slab[16 * tl + 8 + 2 * k + h] = 2.0f * (p1[4 * k] + p1[4 * k + 1] + p1[4 * k + 2]) + p1[4 * k + 3]; }
                LDS_WAIT();
#pragma unroll
                for (int k = 0; k < 4; ++k) { const int s0 = 16 * tl + 2 * k + h + 1, s1 = 16 * tl + 8 + 2 * k + h + 1;
                    slab[s0] += p0[4 * k + 3]; if (s1 < 32) slab[s1] += p1[4 * k + 3]; }
                LDS_WAIT();
            }
        }
        __syncthreads();
        Stage st;
        stage_load(st, Pb + 1536 + g * 64, Pb + 1792 + g * 64, ld, tid);
#pragma unroll 1
        for (int xr_ = 0; xr_ <= XSELN; ++xr_)
        {
            const int cur = qb, q = tid >> 3, sub = tid & 7;
            float scv[4];
#pragma unroll
            for (int j = 0; j < 4; ++j) { const int s_ = 4 * sub + j; const LAS float* pr = Pq + q * 33 + s_;
                const float imp = (pr[0] + pr[SLB]) + (pr[2 * SLB] + pr[3 * SLB]);
                const bool forced = (s_ == 0) || (s_ == cur) || (s_ == cur - 1);
                scv[j] = forced ? 1e30f : (s_ <= cur ? imp : NEG); }
            unsigned mask = 0u;
#pragma unroll 1
            for (int rd = 0; rd < 8; ++rd) {
                float bv = scv[0]; int bi = 4 * sub;
#pragma unroll
                for (int j = 1; j < 4; ++j) if (scv[j] > bv) { bv = scv[j]; bi = 4 * sub + j; }
#define SEL_STEP(CTRL) { const float ov = dppf<CTRL>(bv); const int oi = __float_as_int(dppf<CTRL>(__int_as_float(bi))); if (ov > bv || (ov == bv && oi < bi)) { bv = ov; bi = oi; } }
                SEL_STEP(0xB1) SEL_STEP(0x4E) SEL_STEP(0x141)
#undef SEL_STEP
                if (bv > -0.5e30f) mask |= 1u << bi;
#pragma unroll
                for (int j = 0; j < 4; ++j) if (bi == 4 * sub + j) scv[j] = -INFINITY;
            }
            if (sub == 0) selm[q] = mask;
            unsigned any = mask;
#pragma unroll
            for (int o = 8; o < 64; o <<= 1) any |= __shfl_xor(any, o);
            if (lane == 0) __hip_atomic_fetch_or(selm + 64, any, __ATOMIC_RELAXED, __HIP_MEMORY_SCOPE_WORKGROUP);
            __syncthreads();
        }
        const unsigned anymask = __builtin_amdgcn_readfirstlane(selm[64]);
        {
            f32x16 o0, o1; float m = NEG, l = 0.f;
#pragma unroll
            for (int i = 0; i < 16; ++i) { o0[i] = 0.f; o1[i] = 0.f; }
            const unsigned live = anymask & (qb == 31 ? 0xffffffffu : ((2u << qb) - 1u));
            sp_stream<0, true>(lds, Pb, ld, g, qb, qq, tid, r, h, live, selm, qf, st, o0, o1, m, l);
            l += __shfl_xor(l, 32);
            const float cf = l > 0.f ? gsave[0] / l : 0.f;
#pragma unroll
            for (int i = 0; i < 16; ++i) { oaL[512 * i] += cf * o0[i]; oaL[512 * (16 + i)] += cf * o1[i]; }
        }
        __syncthreads();
        {
            f32x16 o0, o1; float m = NEG, l = 0.f;
#pragma unroll
            for (int i = 0; i < 16; ++i) { o0[i] = 0.f; o1[i] = 0.f; }
            sp_stream<1, false>(lds, Pb, ld, g, qb, qq, tid, r, h, 0u, selm, qf, st, o0, o1, m, l);
            l += __shfl_xor(l, 32);
            const float cf = l > 0.f ? gsave[1] / l : 0.f;
#pragma unroll
            for (int i = 0; i < 16; ++i) { o0[i] = oaL[512 * i] + cf * o0[i]; o1[i] = oaL[512 * (16 + i)] + cf * o1[i]; }
            bf16_t* orow = ATT + (size_t)(b * T + t) * D + (g * 4 + hh) * 64 + 4 * h;
#pragma unroll 1
            for (int xr_ = 0; xr_ <= XOUT; ++xr_)
#pragma unroll
            for (int k = 0; k < 4; ++k) {
                u32x2 w0, w1; w0.x = pg8::cvt_pk_bf16(o0[4 * k], o0[4 * k + 1]); w0.y = pg8::cvt_pk_bf16(o0[4 * k + 2], o0[4 * k + 3]);
                w1.x = pg8::cvt_pk_bf16(o1[4 * k], o1[4 * k + 1]); w1.y = pg8::cvt_pk_bf16(o1[4 * k + 2], o1[4 * k + 3]);
                *(u32x2*)(orow + 8 * k) = w0; *(u32x2*)(orow + 32 + 8 * k) = w1;
            }
        }
        __syncthreads();
    }
}
__device__ __forceinline__ float logsigmoidf_(float x) { return fminf(x, 0.f) - log1pf(__expf(-fabsf(x))); }
__device__ __forceinline__ void phase_mlstm_scan(Frame& F) {
    constexpr int QP = 132;
    LAS float* qL = (LAS float*)F.lds;
    LAS float* kL = qL + 64 * QP;
    LAS float* vL = kL + 64 * QP;
    LAS float* SL = vL + 64 * 128;
    LAS float* vec = SL + 64 * 68;
    LAS float* bL = vec;
    LAS float* liL = vec + 64;
    LAS float* mtL = vec + 128;
    LAS float* wiL = vec + 192;
    LAS float* dnL = vec + 256;
    LAS float* wkL = vec + 320;
    LAS float* nL = vec + 384;
    LAS float* scl = vec + 512;
    LAS float* rsL = vec + 576;
    LAS float* qnL = vec + 640;
    const bf16_t* P = WSP(bf16_t, OFF_PROJ); bf16_t* HO = WSP(bf16_t, OFF_HM);
    int tid = F.tid; asm volatile("; phase-local tid" : "+v"(tid));
    const int lane = tid & 63, ld = ML_LD;
    int v_ = tid >> 2, kq = tid & 3;
    for (int item = F.bx; item < BATCH * 4 * 2; item += F.G) {
        const int vh = item & 1, h = (item >> 1) & 3, b = item >> 3;
        float C[32];
#pragma unroll
        for (int j = 0; j < 32; ++j) C[j] = 0.f;
        if (tid < 128) nL[tid] = 0.f;
        if (tid == 0) scl[0] = 0.f;
        __syncthreads();
#pragma unroll 1
        for (int ch = 0; ch < T / 64; ++ch) {
            asm volatile("; chunk-local" : "+v"(v_), "+v"(kq), "+v"(tid));
            const int t0 = ch * 64; const bf16_t* Pc = P + (size_t)(b * T + t0) * ld;
            {
                const int c2 = tid & 255, part = tid >> 8;
                const int col = (c2 < 128) ? (h * 128 + c2) : (512 + h * 128 + (c2 - 128));
                const float w0 = inptr(F, I_ML_CONV_W)[0 * 1024 + col], w1 = inptr(F, I_ML_CONV_W)[1 * 1024 + col], w2 = inptr(F, I_ML_CONV_W)[2 * 1024 + col], w3 = inptr(F, I_ML_CONV_W)[3 * 1024 + col], cb = inptr(F, I_ML_CONV_B)[col];
                const float scale = (c2 < 128) ? 1.0f : 0.08838834764831845f;
                const int r0 = part * 32;
                float x0 = (t0 + r0 - 3 >= 0) ? bf2f(Pc[(long)(r0 - 3) * ld + col]) : 0.f;
                float x1 = (t0 + r0 - 2 >= 0) ? bf2f(Pc[(long)(r0 - 2) * ld + col]) : 0.f;
                float x2 = (t0 + r0 - 1 >= 0) ? bf2f(Pc[(long)(r0 - 1) * ld + col]) : 0.f;
                LAS float* dst = (c2 < 128) ? (qL + c2) : (kL + (c2 - 128));
                for (int r = r0; r < r0 + 32; ++r) { const float x3 = bf2f(Pc[(long)r * ld + col]);
                    const float y = w0 * x0 + w1 * x1 + w2 * x2 + w3 * x3 + cb; dst[r * QP] = y * sigmoidf_(y) * scale; x0 = x1; x1 = x2; x2 = x3; }
                const int vc = tid & 127, vp = tid >> 7;
                for (int r = vp * 16; r < vp * 16 + 16; ++r) vL[r * 128 + vc] = bf2f(Pc[(long)r * ld + 1024 + h * 256 + vh * 128 + vc]);
                if (tid < 64) { liL[tid] = bf2f(Pc[(long)tid * ld + 3072 + h]) + inptr(F, I_ML_GATE_B)[h];
                    bL[tid] = logsigmoidf_(bf2f(Pc[(long)tid * ld + 3076 + h]) + inptr(F, I_ML_GATE_B)[4 + h]); }
            }
            __syncthreads();
            if (tid < 64) {
                float bb = bL[lane];
#pragma unroll
                for (int o = 1; o < 64; o <<= 1) { const float u = __shfl_up(bb, o); if (lane >= o) bb += u; }
                const float li = liL[lane]; float pm = li - bb;
#pragma unroll
                for (int o = 1; o < 64; o <<= 1) { const float u = __shfl_up(pm, o); if (lane >= o) pm = fmaxf(pm, u); }
                const float mprev = scl[0];
                const float mt = fmaxf(bb + mprev, bb + pm);
                const float bend = __shfl(bb, 63);
                const float decay = bend - bb + li;
                const float mnew = fmaxf(bend + mprev, wave_max(decay));
                bL[lane] = bb; mtL[lane] = mt; wiL[lane] = __expf(bb + mprev - mt); wkL[lane] = __expf(decay - mnew);
                if (lane == 0) { scl[1] = __expf(bend + mprev - mnew); scl[2] = mnew; }
            }
            __syncthreads();
            {
                const int t = tid >> 3, sg = tid & 7;
                float a[8];
#pragma unroll
                for (int j = 0; j < 8; ++j) a[j] = 0.f;
#pragma unroll 1
                for (int k4 = 0; k4 < 32; ++k4) { const f32x4 qv = *(const LAS f32x4*)(qL + t * QP + k4 * 4);
#pragma unroll
                    for (int j = 0; j < 8; ++j) { const f32x4 kv = *(const LAS f32x4*)(kL + (sg + 8 * j) * QP + k4 * 4); a[j] += (qv[0] * kv[0] + qv[1] * kv[1]) + (qv[2] * kv[2] + qv[3] * kv[3]); } }
                const float bt = bL[t], mt = mtL[t];
#pragma unroll
                for (int j = 0; j < 8; ++j) { const int s = sg + 8 * j; SL[t * 68 + s] = (s <= t) ? a[j] * __expf(bt - bL[s] + liL[s] - mt) : 0.f; }
            }
            __syncthreads();
            if (tid < 64) { float rs = 0.f; for (int s = 0; s < 64; ++s) rs += SL[tid * 68 + s]; rsL[tid] = rs; }
            else if (tid < 128) { const int t = tid - 64; float qn = 0.f; for (int k = 0; k < 128; ++k) qn += qL[t * QP + k] * nL[k]; qnL[t] = qn; }
            __syncthreads();
            if (tid < 64) { const float den = rsL[tid] + wiL[tid] * qnL[tid]; dnL[tid] = 1.0f / fmaxf(fabsf(den), __expf(-mtL[tid])); }
            __syncthreads();
            {
                float vr[16];
#pragma unroll
                for (int j = 0; j < 16; ++j) vr[j] = vL[(kq * 16 + j) * 128 + v_];
#pragma unroll 1
                for (int tg = 0; tg < 4; ++tg) {
                    float res[4];
#pragma unroll
                    for (int ti = 0; ti < 16; ++ti) { const int t = tg * 16 + ti;
                        float aC = 0.f, aS = 0.f;
#pragma unroll
                        for (int j4 = 0; j4 < 8; ++j4) { const f32x4 qv = *(const LAS f32x4*)(qL + t * QP + kq * 32 + j4 * 4);
                            aC += (qv[0] * C[j4 * 4] + qv[1] * C[j4 * 4 + 1]) + (qv[2] * C[j4 * 4 + 2] + qv[3] * C[j4 * 4 + 3]); }
#pragma unroll
                        for (int j4 = 0; j4 < 4; ++j4) { const f32x4 sv = *(const LAS f32x4*)(SL + t * 68 + kq * 16 + j4 * 4);
                            aS += (sv[0] * vr[j4 * 4] + sv[1] * vr[j4 * 4 + 1]) + (sv[2] * vr[j4 * 4 + 2] + sv[3] * vr[j4 * 4 + 3]); }
                        float tot = aS + wiL[t] * aC;
                        tot += __shfl_xor(tot, 1); tot += __shfl_xor(tot, 2);
                        tot *= dnL[t];
                        if ((ti & 3) == kq) res[ti >> 2] = tot;
                        asm volatile("" ::: "memory");
                    }
#pragma unroll
                    for (int q = 0; q < 4; ++q) { const int t = tg * 16 + q * 4 + kq; HO[(size_t)(b * T + t0 + t) * D + h * 256 + vh * 128 + v_] = (bf16_t)f2bf(res[q]); }
                }
            }
            __syncthreads();
            {
                const float cs = scl[1];
#pragma unroll
                for (int j = 0; j < 32; ++j) C[j] *= cs;
#pragma unroll 2
                for (int s = 0; s < 64; ++s) { const float a = vL[s * 128 + v_] * wkL[s];
#pragma unroll
                    for (int j4 = 0; j4 < 8; ++j4) { const f32x4 kv = *(const LAS f32x4*)(kL + s * QP + kq * 32 + j4 * 4);
                        C[j4 * 4] += a * kv[0]; C[j4 * 4 + 1] += a * kv[1]; C[j4 * 4 + 2] += a * kv[2]; C[j4 * 4 + 3] += a * kv[3]; } }
                if (tid < 128) { float nn = nL[tid] * cs; for (int s = 0; s < 64; ++s) nn += wkL[s] * kL[s * QP + tid]; nL[tid] = nn; }
                if (tid == 0) scl[0] = scl[2];
            }
            __syncthreads();
        }
    }
}
template <int HD>
__device__ __forceinline__ void phase_norm_gate(Frame& F, const float* norm_g, int ld, int gate_col0) {
    const bf16_t* HI = WSP(bf16_t, OFF_HM); const bf16_t* P = WSP(bf16_t, OFF_PROJ); bf16_t* ATT = WSP(bf16_t, OFF_ATT);
    int lane = F.lane; asm volatile("; phase-local lane" : "+v"(lane)); const int gw = F.bx * 8 + F.wave, NGW = F.G * 8;
    u32x2 hq[4], gq[4];
    if (gw < NTOK) { const u32x2* hr = (const u32x2*)(HI + (size_t)gw * D) + lane; const u32x2* gr = (const u32x2*)(P + (size_t)gw * ld + gate_col0) + lane;
#pragma unroll
        for (int j = 0; j < 4; ++j) { hq[j] = hr[64 * j]; gq[j] = gr[64 * j]; } }
#pragma unroll 1
    for (int m = gw; m < NTOK; m += NGW) {
        u32x2 hc[4], gc[4];
#pragma unroll
        for (int j = 0; j < 4; ++j) { hc[j] = hq[j]; gc[j] = gq[j]; }
        if (m + NGW < NTOK) { const u32x2* hr = (const u32x2*)(HI + (size_t)(m + NGW) * D) + lane; const u32x2* gr = (const u32x2*)(P + (size_t)(m + NGW) * ld + gate_col0) + lane;
#pragma unroll
            for (int j = 0; j < 4; ++j) { hq[j] = hr[64 * j]; gq[j] = gr[64 * j]; } }
        u32x2* orow = (u32x2*)(ATT + (size_t)m * D) + lane;
#pragma unroll
        for (int j = 0; j < 4; ++j) {
            const u32x2 hv = hc[j], gv = gc[j];
            float x[4] = {__uint_as_float(hv.x << 16), __uint_as_float(hv.x & 0xffff0000u), __uint_as_float(hv.y << 16), __uint_as_float(hv.y & 0xffff0000u)};
            const float gt[4] = {__uint_as_float(gv.x << 16), __uint_as_float(gv.x & 0xffff0000u), __uint_as_float(gv.y << 16), __uint_as_float(gv.y & 0xffff0000u)};
            float ss = (x[0] * x[0] + x[1] * x[1]) + (x[2] * x[2] + x[3] * x[3]);
#pragma unroll
            for (int o = 1; o < (HD == 256 ? 64 : 32); o <<= 1) ss += __shfl_xor(ss, o);
            const float r = __builtin_amdgcn_rsqf(ss * (1.0f / HD) + RMS_EPS);
            const f32x4 ng = *((const f32x4*)norm_g + lane + 64 * j);
            float o4[4];
#pragma unroll
            for (int q = 0; q < 4; ++q) o4[q] = x[q] * r * ng[q] * sigmoidf_(gt[q]);
            u32x2 o; o.x = pk2(o4[0], o4[1]); o.y = pk2(o4[2], o4[3]); orow[64 * j] = o;
        }
    }
}

__device__ __forceinline__ void phase_hgrn_scan(Frame& F) {
    constexpr int QP = 132;
    LAS float* qL = (LAS float*)F.lds;
    LAS float* kL = qL + 32 * QP;
    LAS float* vL = kL + 32 * QP;
    LAS float* AL = vL + 32 * 128;
    LAS float* geL = AL + 32 * 36;
    const bf16_t* P = WSP(bf16_t, OFF_PROJ); bf16_t* HO = WSP(bf16_t, OFF_HM);
    const float* lbt = WSP(float, OFF_TAB) + TAB_LB;
    int tid = F.tid; asm volatile("; phase-local tid" : "+v"(tid));
    const int ld = HG_LD;
    int v_ = tid >> 2, kq = tid & 3;
    for (int item = F.bx; item < BATCH * 8; item += F.G) {
        const int h = item & 7, b = item >> 3;
        float S[32];
#pragma unroll
        for (int j = 0; j < 32; ++j) S[j] = 0.f;
#pragma unroll 1
        for (int ch = 0; ch < T / 32; ++ch) {
            asm volatile("; chunk-local" : "+v"(v_), "+v"(kq), "+v"(tid));
            const int t0 = ch * 32; const bf16_t* Pc = P + (size_t)(b * T + t0) * ld;
            { const int c = tid & 127, p4 = tid >> 7;
#pragma unroll 2
              for (int r = p4 * 8; r < p4 * 8 + 8; ++r) { qL[r * QP + c] = bf2f(Pc[(long)r * ld + h * 128 + c]); kL[r * QP + c] = bf2f(Pc[(long)r * ld + 1024 + h * 128 + c]); vL[r * 128 + c] = bf2f(Pc[(long)r * ld + 2048 + h * 128 + c]); } }
            __syncthreads();
            if (tid < 128) { const float lb = lbt[h * 128 + tid]; float G = 0.f;
#pragma unroll 2
                for (int r = 0; r < 32; ++r) { const float qr = qL[r * QP + tid], fr = kL[r * QP + tid];
                    const float f = lb + (1.0f - lb) * sigmoidf_(fr); G += __logf(f);
                    qL[r * QP + tid] = qr * sigmoidf_(qr) * __expf(G); kL[r * QP + tid] = (1.0f - f) * __expf(-G); }
                geL[tid] = __expf(G); }
            __syncthreads();
            { const int t = tid >> 4, sg = tid & 15;
              float a0 = 0.f, a1 = 0.f;
#pragma unroll 2
              for (int k4 = 0; k4 < 32; ++k4) { const f32x4 qv = *(const LAS f32x4*)(qL + t * QP + k4 * 4);
                  const f32x4 k0 = *(const LAS f32x4*)(kL + sg * QP + k4 * 4), k1 = *(const LAS f32x4*)(kL + (sg + 16) * QP + k4 * 4);
                  a0 += (qv[0] * k0[0] + qv[1] * k0[1]) + (qv[2] * k0[2] + qv[3] * k0[3]); a1 += (qv[0] * k1[0] + qv[1] * k1[1]) + (qv[2] * k1[2] + qv[3] * k1[3]); }
              AL[t * 36 + sg] = (sg <= t) ? a0 : 0.f; AL[t * 36 + sg + 16] = (sg + 16 <= t) ? a1 : 0.f; }
            __syncthreads();
            {
                float vr[8];
#pragma unroll
                for (int j = 0; j < 8; ++j) vr[j] = vL[(kq * 8 + j) * 128 + v_];
#pragma unroll 2
                for (int t = 0; t < 32; ++t) {
                    float a = 0.f;
#pragma unroll
                    for (int j4 = 0; j4 < 8; ++j4) { const f32x4 qv = *(const LAS f32x4*)(qL + t * QP + kq * 32 + j4 * 4);
                        a += (qv[0] * S[j4 * 4] + qv[1] * S[j4 * 4 + 1]) + (qv[2] * S[j4 * 4 + 2] + qv[3] * S[j4 * 4 + 3]); }
#pragma unroll
                    for (int j4 = 0; j4 < 2; ++j4) { const f32x4 sv = *(const LAS f32x4*)(AL + t * 36 + kq * 8 + j4 * 4);
                        a += (sv[0] * vr[j4 * 4] + sv[1] * vr[j4 * 4 + 1]) + (sv[2] * vr[j4 * 4 + 2] + sv[3] * vr[j4 * 4 + 3]); }
                    a += __shfl_xor(a, 1); a += __shfl_xor(a, 2);
                    if ((t & 3) == kq) HO[(size_t)(b * T + t0 + t) * D + h * 128 + v_] = (bf16_t)f2bf(a);
                    asm volatile("" ::: "memory");
                }
            }
            {
#pragma unroll 2
                for (int s = 0; s < 32; ++s) { const float a = vL[s * 128 + v_];
#pragma unroll
                    for (int j4 = 0; j4 < 8; ++j4) { const f32x4 kv = *(const LAS f32x4*)(kL + s * QP + kq * 32 + j4 * 4);
                        S[j4 * 4] += a * kv[0]; S[j4 * 4 + 1] += a * kv[1]; S[j4 * 4 + 2] += a * kv[2]; S[j4 * 4 + 3] += a * kv[3]; } }
#pragma unroll
                for (int j4 = 0; j4 < 8; ++j4) { const f32x4 ge = *(const LAS f32x4*)(geL + kq * 32 + j4 * 4);
                    S[j4 * 4] *= ge[0]; S[j4 * 4 + 1] *= ge[1]; S[j4 * 4 + 2] *= ge[2]; S[j4 * 4 + 3] *= ge[3]; }
            }
            __syncthreads();
        }
    }
}
namespace ml {
constexpr int PK = 272, PS = 144;
constexpr int L_Q = 0, L_KK = L_Q + 64 * PK, L_KWT = L_KK + 64 * PK, L_VT = L_KWT + 128 * PS, L_S = L_VT + 144 * PS, L_C = L_S + 64 * PS, L_VEC = L_C + 144 * PK;
typedef float f32x4_ __attribute__((ext_vector_type(4)));
__device__ __forceinline__ bf16x8 frag(const LAS unsigned char* base, int row, int pitch, int kelem) { return *(const LAS bf16x8*)(base + row * pitch + kelem * 2); }
}
__device__ __forceinline__ void phase_mlstm_scan_mfma(Frame& F) {
    using namespace ml;
    LAS unsigned char* lds = F.lds;
    LAS float* vec = (LAS float*)(lds + L_VEC);
    LAS float* bL = vec; LAS float* liL = vec + 64; LAS float* mtL = vec + 128; LAS float* wiL = vec + 192; LAS float* wkL = vec + 256; LAS float* scl = vec + 320;
    const bf16_t* P = WSP(bf16_t, OFF_PROJ); bf16_t* HO = WSP(bf16_t, OFF_HM);
    int tid = F.tid; asm volatile("; phase-local tid" : "+v"(tid));
    const int lane = tid & 63, wave = __builtin_amdgcn_readfirstlane(tid >> 6), ld = ML_LD;
    const int fr = lane & 15, fg = lane >> 4;
#pragma unroll 1
    for (int item = F.bx; item < BATCH * 4 * 2; item += F.G) {
        const int vh = item & 1, h = (item >> 1) & 3, b = item >> 3;
        f32x4 Cacc[9];
#pragma unroll
        for (int j = 0; j < 9; ++j) Cacc[j] = (f32x4){0.f, 0.f, 0.f, 0.f};
        for (int i = tid; i < 16 * 64; i += 512) { const int rr = i >> 6, s = i & 63; *(LAS unsigned short*)(lds + L_VT + (128 + rr) * PS + s * 2) = (rr == 0) ? (unsigned short)0x3F80 : (unsigned short)0; }
        for (int i = tid; i < 144 * PK / 4; i += 512) ((LAS unsigned*)(lds + L_C))[i] = 0u;
        if (tid == 0) scl[0] = 0.f;
        const int c2 = tid & 255, part = __builtin_amdgcn_readfirstlane(tid >> 8);
        const int col = (c2 < 128) ? (h * 128 + c2) : (512 + h * 128 + (c2 - 128));
        const float* cw = inptr(F, I_ML_CONV_W); const float* cbp = inptr(F, I_ML_CONV_B); const float* gbp = inptr(F, I_ML_GATE_B);
        const float w0 = cw[0 * 1024 + col], w1 = cw[1 * 1024 + col], w2 = cw[2 * 1024 + col], w3 = cw[3 * 1024 + col], cb = cbp[col];
        const float gbi = gbp[h], gbf = gbp[4 + h];
        const float qscale = (c2 < 128) ? 1.0f : 0.08838834764831845f;
        unsigned short xn[35]; u32x4 vn[2]; unsigned short gin = 0, gfn = 0;
        { const bf16_t* Pc = P + (size_t)(b * T) * ld; const int r0 = part * 32;
          const bf16_t* rp = Pc + (long)(r0 - 3) * ld;
#pragma unroll
          for (int i = 0; i < 35; ++i) { xn[i] = (r0 - 3 + i >= 0) ? rp[col] : (unsigned short)0; rp += ld; asm volatile("" : "+s"(rp)); }
          const int key = tid >> 3, dc = tid & 7;
#pragma unroll
          for (int q = 0; q < 2; ++q) vn[q] = *(const u32x4*)(Pc + (long)key * ld + 1024 + h * 256 + vh * 128 + (dc + 8 * q) * 8);
          if (wave == 0) { gin = Pc[(long)lane * ld + 3072 + h]; gfn = Pc[(long)lane * ld + 3076 + h]; } }
        __syncthreads();
#pragma unroll 1
        for (int ch = 0; ch < T / 64; ++ch) {
            const int t0 = ch * 64; const bf16_t* Pc = P + (size_t)(b * T + t0) * ld;
            if (wave == 0) {
                const float li = bf2f(gin) + gbi;
                float bb = logsigmoidf_(bf2f(gfn) + gbf);
#pragma unroll
                for (int o = 1; o < 64; o <<= 1) { const float u = __shfl_up(bb, o); if (lane >= o) bb += u; }
                float pm = li - bb;
#pragma unroll
                for (int o = 1; o < 64; o <<= 1) { const float u = __shfl_up(pm, o); if (lane >= o) pm = fmaxf(pm, u); }
                const float mprev = scl[0];
                const float mt = fmaxf(bb + mprev, bb + pm);
                const float bend = __shfl(bb, 63);
                const float decay = bend - bb + li;
                const float mnew = fmaxf(bend + mprev, wave_max(decay));
                bL[lane] = bb; liL[lane] = li; mtL[lane] = mt; wiL[lane] = __expf(bb + mprev - mt); wkL[lane] = __expf(decay - mnew);
                if (lane == 0) { scl[1] = __expf(bend + mprev - mnew); scl[2] = mnew; }
            }
            __syncthreads();
            {
                const int r0 = part * 32;
                LAS unsigned char* rowbase = lds + ((c2 < 128) ? L_Q : L_KK) + (c2 & 127) * 2;
#pragma unroll
                for (int i = 0; i < 32; ++i) { const int rr = r0 + i;
                    const float y = w0 * bf2f(xn[i]) + w1 * bf2f(xn[i + 1]) + w2 * bf2f(xn[i + 2]) + w3 * bf2f(xn[i + 3]) + cb; const float o = y * sigmoidf_(y) * qscale;
                    *(LAS unsigned short*)(rowbase + rr * PK) = (unsigned short)f2bf(o);
                    if (c2 >= 128) *(LAS unsigned short*)(lds + L_KWT + (c2 - 128) * PS + rr * 2) = (unsigned short)f2bf(o * wkL[rr]);
                    if ((i & 3) == 3) asm volatile("" ::: "memory"); }
                const int key = tid >> 3, dc = tid & 7;
#pragma unroll
                for (int q = 0; q < 2; ++q) { const unsigned w[4] = {vn[q].x, vn[q].y, vn[q].z, vn[q].w};
#pragma unroll
                    for (int e = 0; e < 4; ++e) { const int vrow = (dc + 8 * q) * 8 + 2 * e;
                        *(LAS unsigned short*)(lds + L_VT + vrow * PS + key * 2) = (unsigned short)(w[e] & 0xffffu); *(LAS unsigned short*)(lds + L_VT + (vrow + 1) * PS + key * 2) = (unsigned short)(w[e] >> 16); } }
            }
            if (ch + 1 < T / 64) {
                const bf16_t* Pn = Pc + (size_t)64 * ld; const int r0 = part * 32;
                const bf16_t* rp = Pn + (long)(r0 - 3) * ld;
#pragma unroll
                for (int i = 0; i < 35; ++i) { xn[i] = rp[col]; rp += ld; asm volatile("" : "+s"(rp)); }
                const int key = tid >> 3, dc = tid & 7;
#pragma unroll
                for (int q = 0; q < 2; ++q) vn[q] = *(const u32x4*)(Pn + (long)key * ld + 1024 + h * 256 + vh * 128 + (dc + 8 * q) * 8);
                if (wave == 0) { gin = Pn[(long)lane * ld + 3072 + h]; gfn = Pn[(long)lane * ld + 3076 + h]; }
            }
            __syncthreads();
#pragma unroll
            for (int q = 0; q < 2; ++q) {
                const int idx = 2 * wave + q, ti = idx >> 2, tj = idx & 3;
                f32x4 a = (f32x4){0.f, 0.f, 0.f, 0.f};
                if (ti <= tj) {
#pragma unroll
                    for (int ks = 0; ks < 4; ++ks) a = __builtin_amdgcn_mfma_f32_16x16x32_bf16(frag(lds + L_KK, 16 * ti + fr, PK, 32 * ks + 8 * fg), frag(lds + L_Q, 16 * tj + fr, PK, 32 * ks + 8 * fg), a, 0, 0, 0);
                    const int t = 16 * tj + fr; const float bt = bL[t], mt = mtL[t];
#pragma unroll
                    for (int e = 0; e < 4; ++e) { const int s = 16 * ti + 4 * fg + e; a[e] = (s <= t) ? a[e] * __expf(bt - bL[s] + liL[s] - mt) : 0.f; }
                }
                u32x2 w; w.x = pg8::cvt_pk_bf16(a[0], a[1]); w.y = pg8::cvt_pk_bf16(a[2], a[3]);
                *(LAS u32x2*)(lds + L_S + (16 * tj + fr) * PS + (16 * ti + 4 * fg) * 2) = w;
            }
            __syncthreads();
            {
#pragma unroll 1
                for (int tj = 0; tj < 4; ++tj) {
                    f32x4 a1 = (f32x4){0.f, 0.f, 0.f, 0.f}, a2 = a1, d1 = a1, d2 = a1;
#pragma unroll
                    for (int ks = 0; ks < 2; ++ks) { const bf16x8 bs = frag(lds + L_S, 16 * tj + fr, PS, 32 * ks + 8 * fg);
                        a1 = __builtin_amdgcn_mfma_f32_16x16x32_bf16(frag(lds + L_VT, 16 * wave + fr, PS, 32 * ks + 8 * fg), bs, a1, 0, 0, 0);
                        d1 = __builtin_amdgcn_mfma_f32_16x16x32_bf16(frag(lds + L_VT, 128 + fr, PS, 32 * ks + 8 * fg), bs, d1, 0, 0, 0); }
#pragma unroll
                    for (int ks = 0; ks < 4; ++ks) { const bf16x8 bq = frag(lds + L_Q, 16 * tj + fr, PK, 32 * ks + 8 * fg);
                        a2 = __builtin_amdgcn_mfma_f32_16x16x32_bf16(frag(lds + L_C, 16 * wave + fr, PK, 32 * ks + 8 * fg), bq, a2, 0, 0, 0);
                        d2 = __builtin_amdgcn_mfma_f32_16x16x32_bf16(frag(lds + L_C, 128 + fr, PK, 32 * ks + 8 * fg), bq, d2, 0, 0, 0); }
                    const int t = 16 * tj + fr; const float wi = wiL[t];
                    float den = d1[0] + wi * d2[0];
                    den = __shfl(den, fr);
                    const float inv = __builtin_amdgcn_rcpf(fmaxf(fabsf(den), __expf(-mtL[t])));
                    u32x2 w; w.x = pg8::cvt_pk_bf16((a1[0] + wi * a2[0]) * inv, (a1[1] + wi * a2[1]) * inv); w.y = pg8::cvt_pk_bf16((a1[2] + wi * a2[2]) * inv, (a1[3] + wi * a2[3]) * inv);
                    *(u32x2*)(HO + (size_t)(b * T + t0 + t) * D + h * 256 + vh * 128 + 16 * wave + 4 * fg) = w;
                }
            }
            __syncthreads();
            {
                const float cs = scl[1];
                const bf16x8 ka0 = frag(lds + L_KWT, 16 * wave + fr, PS, 8 * fg), ka1 = frag(lds + L_KWT, 16 * wave + fr, PS, 32 + 8 * fg);
#pragma unroll
                for (int j = 0; j < 9; ++j) {
                    Cacc[j] = Cacc[j] * cs;
                    Cacc[j] = __builtin_amdgcn_mfma_f32_16x16x32_bf16(ka0, frag(lds + L_VT, 16 * j + fr, PS, 8 * fg), Cacc[j], 0, 0, 0);
                    Cacc[j] = __builtin_amdgcn_mfma_f32_16x16x32_bf16(ka1, frag(lds + L_VT, 16 * j + fr, PS, 32 + 8 * fg), Cacc[j], 0, 0, 0);
                    u32x2 w; w.x = pg8::cvt_pk_bf16(Cacc[j][0], Cacc[j][1]); w.y = pg8::cvt_pk_bf16(Cacc[j][2], Cacc[j][3]);
                    *(LAS u32x2*)(lds + L_C + (16 * j + fr) * PK + (16 * wave + 4 * fg) * 2) = w;
                }
                if (tid == 0) scl[0] = scl[2];
            }
            __syncthreads();
        }
    }
}
namespace hg {
constexpr int PK = 272, PS = 144;
constexpr int L_QD = 0, L_KD = L_QD + 64 * PK, L_KDT = L_KD + 64 * PK, L_VT = L_KDT + 128 * PS, L_A = L_VT + 128 * PS, L_ST = L_A + 64 * PS, L_TOT = L_ST + 128 * PK, L_GE = L_TOT + 4 * 128 * 4, L_SSQ = L_GE + 128 * 4;
__device__ __forceinline__ bf16x8 frag(const LAS unsigned char* base, int row, int pitch, int kelem) { return *(const LAS bf16x8*)(base + row * pitch + kelem * 2); }
}
__device__ __forceinline__ void phase_hgrn_scan_mfma(Frame& F) {
    using namespace hg;
    LAS unsigned char* lds = F.lds;
    LAS float* totL = (LAS float*)(lds + L_TOT); LAS float* geL = (LAS float*)(lds + L_GE);
    const bf16_t* P = WSP(bf16_t, OFF_PROJ); bf16_t* ATT = WSP(bf16_t, OFF_ATT);
    const float* lbt = WSP(float, OFF_TAB) + TAB_LB; const float* norm_g = inptr(F, I_HG_NORM_G);
    LAS float* ssqL = (LAS float*)(F.lds + hg::L_SSQ);
    int tid = F.tid; asm volatile("; phase-local tid" : "+v"(tid));
    const int lane = tid & 63, wave = __builtin_amdgcn_readfirstlane(tid >> 6), ld = HG_LD;
    const int fr = lane & 15, fg = lane >> 4;
    const int kc = tid & 127, part = __builtin_amdgcn_readfirstlane(tid >> 7);
    const int vkey = tid >> 3, vdc = tid & 7;
#pragma unroll 1
    for (int item = F.bx; item < BATCH * 8; item += F.G) {
        const int h = item & 7, b = item >> 3;
        f32x4 Sacc[8];
#pragma unroll
        for (int j = 0; j < 8; ++j) Sacc[j] = (f32x4){0.f, 0.f, 0.f, 0.f};
        for (int i = tid; i < 128 * PK / 4; i += 512) ((LAS unsigned*)(lds + L_ST))[i] = 0u;
        const float lb = lbt[h * 128 + kc];
        const f32x4 ngv = *(const f32x4*)(norm_g + h * 128 + 16 * wave + 4 * fg);
        unsigned short qn[16], fn[16]; u32x4 vn[2];
        { const bf16_t* Pc = P + (size_t)(b * T) * ld;
          const bf16_t* rp = Pc + (long)(16 * part) * ld + h * 128;
#pragma unroll
          for (int i = 0; i < 16; ++i) { qn[i] = rp[kc]; fn[i] = rp[1024 + kc]; rp += ld; asm volatile("" : "+s"(rp)); }
#pragma unroll
          for (int q = 0; q < 2; ++q) vn[q] = *(const u32x4*)(Pc + (long)vkey * ld + 2048 + h * 128 + (vdc + 8 * q) * 8); }
        __syncthreads();
#pragma unroll 1
        for (int ch = 0; ch < T / 64; ++ch) {
            const int t0 = ch * 64;
            float qs[16], kk[16], G[16]; u32x4 vv[2];
            {
                float run = 0.f;
#pragma unroll
                for (int i = 0; i < 16; ++i) { const float qr = bf2f(qn[i]), fraw = bf2f(fn[i]);
                    const float f = lb + (1.0f - lb) * sigmoidf_(fraw);
                    run += __logf(f); G[i] = run; qs[i] = qr * sigmoidf_(qr); kk[i] = 1.0f - f; }
                totL[part * 128 + kc] = run; vv[0] = vn[0]; vv[1] = vn[1];
            }
            __syncthreads();
            if (ch + 1 < T / 64) {
                const bf16_t* Pn = P + (size_t)(b * T + t0 + 64) * ld;
                const bf16_t* rp = Pn + (long)(16 * part) * ld + h * 128;
#pragma unroll
                for (int i = 0; i < 16; ++i) { qn[i] = rp[kc]; fn[i] = rp[1024 + kc]; rp += ld; asm volatile("" : "+s"(rp)); }
#pragma unroll
                for (int q = 0; q < 2; ++q) vn[q] = *(const u32x4*)(Pn + (long)vkey * ld + 2048 + h * 128 + (vdc + 8 * q) * 8);
            }
            {
                float off = 0.f, tot = 0.f;
#pragma unroll
                for (int p = 0; p < 4; ++p) { const float tp = totL[p * 128 + kc]; if (p < part) off += tp; tot += tp; }
                if (part == 3) geL[kc] = __expf(tot);
#pragma unroll
                for (int i = 0; i < 16; ++i) { const int r = 16 * part + i; const float g = G[i] + off;
                    const unsigned short qd = (unsigned short)f2bf(qs[i] * __expf(g)), kd = (unsigned short)f2bf(kk[i] * __expf(-g));
                    *(LAS unsigned short*)(lds + L_QD + r * PK + kc * 2) = qd; *(LAS unsigned short*)(lds + L_KD + r * PK + kc * 2) = kd; *(LAS unsigned short*)(lds + L_KDT + kc * PS + r * 2) = kd; }
#pragma unroll
                for (int q = 0; q < 2; ++q) { const unsigned w[4] = {vv[q].x, vv[q].y, vv[q].z, vv[q].w};
#pragma unroll
                    for (int e = 0; e < 4; ++e) { const int vrow = (vdc + 8 * q) * 8 + 2 * e;
                        *(LAS unsigned short*)(lds + L_VT + vrow * PS + vkey * 2) = (unsigned short)(w[e] & 0xffffu); *(LAS unsigned short*)(lds + L_VT + (vrow + 1) * PS + vkey * 2) = (unsigned short)(w[e] >> 16); } }
            }
            __syncthreads();
#pragma unroll
            for (int q = 0; q < 2; ++q) {
                const int idx = 2 * wave + q, ti = idx >> 2, tj = idx & 3;
                f32x4 a = (f32x4){0.f, 0.f, 0.f, 0.f};
                if (ti <= tj) {
#pragma unroll
                    for (int ks = 0; ks < 4; ++ks) a = __builtin_amdgcn_mfma_f32_16x16x32_bf16(frag(lds + L_KD, 16 * ti + fr, PK, 32 * ks + 8 * fg), frag(lds + L_QD, 16 * tj + fr, PK, 32 * ks + 8 * fg), a, 0, 0, 0);
                    const int t = 16 * tj + fr;
#pragma unroll
                    for (int e = 0; e < 4; ++e) { const int s = 16 * ti + 4 * fg + e; a[e] = (s <= t) ? a[e] : 0.f; }
                }
                u32x2 w; w.x = pg8::cvt_pk_bf16(a[0], a[1]); w.y = pg8::cvt_pk_bf16(a[2], a[3]);
                *(LAS u32x2*)(lds + L_A + (16 * tj + fr) * PS + (16 * ti + 4 * fg) * 2) = w;
            }
            __syncthreads();
            f32x4 ot[4]; u32x2 gq[4];
            const bf16_t* Pg = P + (size_t)(b * T + t0) * ld + 3072 + h * 128 + 16 * wave + 4 * fg;
#pragma unroll
            for (int tj = 0; tj < 4; ++tj) {
                f32x4 a = (f32x4){0.f, 0.f, 0.f, 0.f};
                gq[tj] = *(const u32x2*)(Pg + (size_t)(16 * tj + fr) * ld);
#pragma unroll
                for (int ks = 0; ks < 2; ++ks) a = __builtin_amdgcn_mfma_f32_16x16x32_bf16(frag(lds + L_VT, 16 * wave + fr, PS, 32 * ks + 8 * fg), frag(lds + L_A, 16 * tj + fr, PS, 32 * ks + 8 * fg), a, 0, 0, 0);
#pragma unroll
                for (int ks = 0; ks < 4; ++ks) a = __builtin_amdgcn_mfma_f32_16x16x32_bf16(frag(lds + L_ST, 16 * wave + fr, PK, 32 * ks + 8 * fg), frag(lds + L_QD, 16 * tj + fr, PK, 32 * ks + 8 * fg), a, 0, 0, 0);
                ot[tj] = a;
                float ss = (a[0] * a[0] + a[1] * a[1]) + (a[2] * a[2] + a[3] * a[3]);
                ss += __shfl_xor(ss, 16); ss += __shfl_xor(ss, 32);
                if (fg == 0) ssqL[wave * 64 + 16 * tj + fr] = ss;
            }
            __syncthreads();
#pragma unroll
            for (int tj = 0; tj < 4; ++tj) {
                const int t = 16 * tj + fr; float tot = 0.f;
#pragma unroll
                for (int w8 = 0; w8 < 8; ++w8) tot += ssqL[w8 * 64 + t];
                const float rr = __builtin_amdgcn_rsqf(tot * (1.0f / 128.0f) + RMS_EPS);
                const float g0 = __uint_as_float(gq[tj].x << 16), g1 = __uint_as_float(gq[tj].x & 0xffff0000u), g2 = __uint_as_float(gq[tj].y << 16), g3 = __uint_as_float(gq[tj].y & 0xffff0000u);
                u32x2 w; w.x = pg8::cvt_pk_bf16(ot[tj][0] * rr * ngv[0] * sigmoidf_(g0), ot[tj][1] * rr * ngv[1] * sigmoidf_(g1));
                w.y = pg8::cvt_pk_bf16(ot[tj][2] * rr * ngv[2] * sigmoidf_(g2), ot[tj][3] * rr * ngv[3] * sigmoidf_(g3));
                *(u32x2*)(ATT + (size_t)(b * T + t0 + t) * D + h * 128 + 16 * wave + 4 * fg) = w;
            }
            {
                const bf16x8 ka0 = frag(lds + L_KDT, 16 * wave + fr, PS, 8 * fg), ka1 = frag(lds + L_KDT, 16 * wave + fr, PS, 32 + 8 * fg);
                const f32x4 ge = *(const LAS f32x4*)(geL + 16 * wave + 4 * fg);
#pragma unroll
                for (int j = 0; j < 8; ++j) {
                    Sacc[j] = __builtin_amdgcn_mfma_f32_16x16x32_bf16(ka0, frag(lds + L_VT, 16 * j + fr, PS, 8 * fg), Sacc[j], 0, 0, 0);
                    Sacc[j] = __builtin_amdgcn_mfma_f32_16x16x32_bf16(ka1, frag(lds + L_VT, 16 * j + fr, PS, 32 + 8 * fg), Sacc[j], 0, 0, 0);
                    Sacc[j] = Sacc[j] * ge;
                    u32x2 w; w.x = pg8::cvt_pk_bf16(Sacc[j][0], Sacc[j][1]); w.y = pg8::cvt_pk_bf16(Sacc[j][2], Sacc[j][3]);
                    *(LAS u32x2*)(lds + L_ST + (16 * j + fr) * PK + (16 * wave + 4 * fg) * 2) = w;
                }
            }
            __syncthreads();
        }
    }
}
constexpr int PH_PER_LAYER = 10, N_PHASES = 1 + PH_PER_LAYER * DEPTH;
struct Args { const float* in[27]; float* out; unsigned char* ws; int ph_lo, ph_hi; };
__global__ void __launch_bounds__(512, 2) mk_fwd(Args args) {
    extern __shared__ __attribute__((aligned(16))) unsigned char lds[];
    Frame F;
    F.lds = (LAS unsigned char*)lds;
    F.LC = (volatile LAS unsigned*)(F.lds + LDSCTL_OFF);
    F.tid = threadIdx.x; F.lane = F.tid & 63; F.wave = __builtin_amdgcn_readfirstlane(F.tid >> 6); F.G = gridDim.x; F.bx = blockIdx.x;
    F.ws = (unsigned char*)(GAS unsigned char*)args.ws; F.ctl = (unsigned*)(F.ws + OFF_CTL); F.out = (float*)(GAS float*)args.out;
    for (int u = F.tid; u < (LDS_BYTES - LDSCTL_OFF) / 4; u += 512) F.LC[u] = 0u;
    __syncthreads();
    if (F.tid < 27) { const unsigned long long pv = (unsigned long long)args.in[F.tid]; F.LC[128 + 2 * F.tid] = (unsigned)pv; F.LC[129 + 2 * F.tid] = (unsigned)(pv >> 32); }
    __syncthreads();
    XcdBarrier bar; bar.bar = F.ctl + CW_BAR; bar.x = 0; bar.st = nullptr;
    if (!MK_PER_PHASE) bar = xcd_barrier_post(F.ctl + CW_BAR, F.LC);
    const int lo = args.ph_lo, hi = args.ph_hi;
#define IN(k) (lo <= (k) && (k) < hi)
#ifndef DBL_LNR
#define DBL_LNR 1
#endif
#ifndef DBL_COMB
#define DBL_COMB 1
#endif
#ifndef DBL_NG
#define DBL_NG 1
#endif
#ifndef DBL_GIN
#define DBL_GIN 1
#endif
#ifndef DBL_GOUT
#define DBL_GOUT 1
#endif
#ifndef DBL_GCMP
#define DBL_GCMP 1
#endif
#ifndef DBL_GUP
#define DBL_GUP 1
#endif
#ifndef DBL_GDN
#define DBL_GDN 1
#endif
#ifndef DBL_SCAN
#define DBL_SCAN 1
#endif
#ifndef DBL_P0
#define DBL_P0 1
#endif
#ifndef DBL_ATT
#define DBL_ATT 1
#endif
#define REP(n) _Pragma("unroll 1") for (int rep_ = 0; rep_ < (n); ++rep_)
#ifdef PROBE_A
#define STAMP(k) do { if (blockIdx.x == 0 && F.tid == 0) ((unsigned long long*)(F.ws + OFF_TAB + 65536))[(k)] = wall_clock64(); } while (0)
#else
#define STAMP(k) do {} while (0)
#endif
#define SEAM(k) do { if (!MK_PER_PHASE && (k) + 1 < hi) xcd_barrier(bar); else __syncthreads(); } while (0)

    STAMP(0);
    if (IN(0)) {
#ifndef NO_P0
 REP(DBL_P0) p0_prologue(F);
#endif
 SEAM(0); }

    for (int L = 0; L < DEPTH; ++L) {
        int Lo = L; asm volatile("; layer-local" : "+s"(Lo));
        const int kind = Lo % 3, slot = Lo / 3, pb = 1 + PH_PER_LAYER * Lo;
#define PHL Frame Fp = F; asm volatile("; phase-local" : "+v"(Fp.tid), "+s"(Fp.bx)); Fp.lane = Fp.tid & 63;
        const int ldp = kind == 0 ? NSA_LD : (kind == 1 ? ML_LD : HG_LD);
        if (IN(pb + 0)) { PHL STAMP(pb + 0);
            const bf16_t* Wt = kind == 0 ? WSP(bf16_t, OFF_W_NSAIN) + (size_t)slot * NSA_LD * D : (kind == 1 ? WSP(bf16_t, OFF_W_MLIN) : WSP(bf16_t, OFF_W_HGIN));
            pg8::APlain AS{WSP(bf16_t, OFF_XN), D}; pg8::BPlain BS{Wt, D}; pg8::StaticOrder S; S.init(NTOK / 256, ldp / 256, Fp.G, Fp.bx);
            pg8::EpiStore E{WSP(bf16_t, OFF_PROJ), ldp};
            #ifndef NO_GIN
            REP(DBL_GIN) pg8::gemm_phase<pg8::EpiStore, pg8::StaticOrder, pg8::APlain, pg8::BPlain>(Fp.lds, D, AS, BS, S, E);
#endif
            SEAM(pb + 0);
        }
        if (kind == 0) {
            if (IN(pb + 1)) { PHL STAMP(pb + 1);
                pg8::ACmp AS{WSP(bf16_t, OFF_PROJ), NSA_LD, 1024}; pg8::BGroup BS{WSP(bf16_t, OFF_W_CMP1) + (size_t)slot * 2 * 256 * 2048, 2048, (size_t)256 * 2048};
                pg8::CmpOrder S{Fp.G, Fp.bx};
                pg8::EpiCmpGelu E{WSP(bf16_t, OFF_HC), WSP(float, OFF_TAB) + TAB_CMPB + slot * 512};
                #ifndef NO_GCMP
                REP(DBL_GCMP) pg8::gemm_phase<pg8::EpiCmpGelu, pg8::CmpOrder, pg8::ACmp, pg8::BGroup>(Fp.lds, 2048, AS, BS, S, E);
#endif
                SEAM(pb + 1);
            }
            if (IN(pb + 2)) { PHL STAMP(pb + 2);
#ifndef NO_CMP2
 REP(DBL_GCMP) phase_nsa_cmp2(Fp, slot);
#endif
 SEAM(pb + 2); }
            if (IN(pb + 3)) { PHL STAMP(pb + 3);
#ifndef NO_ATTN
 REP(DBL_ATT) phase_nsa_attn_mfma(Fp, slot);
#endif
 SEAM(pb + 3); }
        } else if (kind == 1) {
            if (IN(pb + 1)) { PHL STAMP(pb + 1);
#ifdef MLS_CHECK
                {
                    const size_t n16 = (size_t)NTOK * D * 2 / 16; u32x4* HMv = WSP(u32x4, OFF_HM); u32x4* Y1 = WSP(u32x4, OFF_Y); u32x4* Y2 = WSP(u32x4, OFF_Y + 160 * MiB);
#pragma unroll 1
                    for (int rep_ = 0; rep_ < 3; ++rep_) {
                        phase_mlstm_scan_mfma(Fp);
                        xcd_barrier(bar);
                        if (rep_ < 2) { u32x4* dst = rep_ == 0 ? Y1 : Y2;
                            for (size_t i = (size_t)blockIdx.x * 512 + Fp.tid; i < n16; i += (size_t)Fp.G * 512) dst[i] = HMv[i];
                            xcd_barrier(bar); }
                    }
                    unsigned bad_bits = 0u; float md = 0.f, mr = 0.f;
                    for (size_t i = (size_t)blockIdx.x * 512 + Fp.tid; i < n16; i += (size_t)Fp.G * 512) { const u32x4 a = HMv[i], b2 = Y2[i], c1 = Y1[i];
                        if (a.x != b2.x || a.y != b2.y || a.z != b2.z || a.w != b2.w) bad_bits = 1u;
                        const unsigned aw[4] = {a.x, a.y, a.z, a.w}, cw[4] = {c1.x, c1.y, c1.z, c1.w};
#pragma unroll
                        for (int q = 0; q < 4; ++q) { const float a0 = __uint_as_float(aw[q] << 16), a1 = __uint_as_float(aw[q] & 0xffff0000u), r0 = __uint_as_float(cw[q] << 16), r1 = __uint_as_float(cw[q] & 0xffff0000u);
                            md = fmaxf(md, fmaxf(fabsf(a0 - r0), fabsf(a1 - r1))); mr = fmaxf(mr, fmaxf(fabsf(r0), fabsf(r1))); if (!(a0 == a0) || !(a1 == a1)) bad_bits |= 4u; } }
                    md = wave_max(md); mr = wave_max(mr);
                    if (Fp.lane == 0) { atomicMax(F.ctl + 9000, __float_as_uint(md)); atomicMax(F.ctl + 9001, __float_as_uint(mr)); }
                    if (bad_bits) atomicOr(F.ctl + 9002, bad_bits);
                }
#else
#ifndef NO_MLS
 REP(DBL_SCAN) phase_mlstm_scan_mfma(Fp);
#endif
#endif
 SEAM(pb + 1); }
            if (IN(pb + 2)) { PHL STAMP(pb + 2);
#ifndef NO_NG
 REP(DBL_NG) phase_norm_gate<256>(Fp, inptr(Fp, I_ML_NORM_G), ML_LD, 2048);
#endif
 SEAM(pb + 2); }
        } else {
            if (IN(pb + 1)) { PHL STAMP(pb + 1);
#ifndef NO_HGS
 REP(DBL_SCAN) phase_hgrn_scan_mfma(Fp);
#endif
 SEAM(pb + 1); }
        }
        if (IN(pb + 4)) { PHL STAMP(pb + 4);
            const bf16_t* Wt = kind == 0 ? WSP(bf16_t, OFF_W_NSAOUT) + (size_t)slot * D * D : (kind == 1 ? WSP(bf16_t, OFF_W_MLOUT) : WSP(bf16_t, OFF_W_HGOUT));
            pg8::APlain AS{WSP(bf16_t, OFF_ATT), D}; pg8::BPlain BS{Wt, D}; pg8::StaticOrder S; S.init(NTOK / 256, D / 256, Fp.G, Fp.bx);
            pg8::EpiStore E{WSP(bf16_t, OFF_HM), D};
            #ifndef NO_GOUT
            REP(DBL_GOUT) pg8::gemm_phase<pg8::EpiStore, pg8::StaticOrder, pg8::APlain, pg8::BPlain>(Fp.lds, D, AS, BS, S, E);
#endif
            SEAM(pb + 4);
        }
        if (IN(pb + 5)) { PHL STAMP(pb + 5);
#ifndef NO_LNR
 if (DBL_LNR > 1) phase_ln_router(Fp, Lo, true);
 phase_ln_router(Fp, Lo);
#endif
 SEAM(pb + 5); }
        if (IN(pb + 6)) { PHL STAMP(pb + 6);
#ifndef NO_SLOT
 phase_moe_slots(Fp, Lo);
#endif
 SEAM(pb + 6); }
        if (IN(pb + 7)) { PHL STAMP(pb + 7);
            moe_tile_table(Fp, Lo);
            pg8::AGather AS{WSP(bf16_t, OFF_XN), D, WSP(int, OFF_ROWT)}; pg8::BGroup BS{WSP(bf16_t, OFF_W_GU) + (size_t)Lo * NEXP * 2048 * D, D, (size_t)2048 * D};
            pg8::MoeOrder S; S.init(__builtin_amdgcn_readfirstlane((int)Fp.LC[40]), 8, Fp.G, Fp.bx); S.pend = (const LAS int*)(Fp.lds + LDSCTL_OFF + 32);
            pg8::EpiSwiglu E{WSP(bf16_t, OFF_H), inptr(Fp, I_MOE_B_GU) + (size_t)Lo * NEXP * 2048};
            #ifndef NO_GUP
            REP(DBL_GUP) pg8::gemm_phase<pg8::EpiSwiglu, pg8::MoeOrder, pg8::AGather, pg8::BGroup>(Fp.lds, D, AS, BS, S, E);
#endif
            SEAM(pb + 7);
        }
        if (IN(pb + 8)) { PHL STAMP(pb + 8);
            moe_tile_table(Fp, Lo);
            pg8::APlain AS{WSP(bf16_t, OFF_H), DFF}; pg8::BGroup BS{WSP(bf16_t, OFF_W_DN) + (size_t)Lo * NEXP * D * DFF, DFF, (size_t)D * DFF};
            pg8::MoeOrder S; S.init(__builtin_amdgcn_readfirstlane((int)Fp.LC[40]), 4, Fp.G, Fp.bx); S.pend = (const LAS int*)(Fp.lds + LDSCTL_OFF + 32);
            pg8::EpiDown E{WSP(bf16_t, OFF_Y), inptr(Fp, I_MOE_B_DOWN) + (size_t)Lo * NEXP * D, WSP(float, OFF_ROWG)};
            #ifndef NO_GDN
            REP(DBL_GDN) pg8::gemm_phase<pg8::EpiDown, pg8::MoeOrder, pg8::APlain, pg8::BGroup>(Fp.lds, DFF, AS, BS, S, E);
#endif
            SEAM(pb + 8);
        }
        if (IN(pb + 9)) { PHL STAMP(pb + 9);
#ifndef NO_COMB
 if (DBL_COMB > 1) phase_combine_ln(Fp, Lo, (float*)nullptr, true);
 phase_combine_ln(Fp, Lo, Lo == DEPTH - 1 ? Fp.out : (float*)nullptr);
#endif
 SEAM(pb + 9); }
    }
#ifdef MLS_CHECK
    xcd_barrier(bar);
    { const float md = __uint_as_float(__hip_atomic_load(F.ctl + 9000, RLX_AGENT)), mr = __uint_as_float(__hip_atomic_load(F.ctl + 9001, RLX_AGENT)); const unsigned bb = __hip_atomic_load(F.ctl + 9002, RLX_AGENT);
      float code = 10.f; if (md > 0.02f * mr) code = 100.f; if (md > 0.2f * mr) code = 300.f; if (bb & 1u) code *= 10.f; if (bb & 4u) code *= 100.f;
      for (size_t i = (size_t)blockIdx.x * 512 + F.tid; i < (size_t)NTOK * D; i += (size_t)F.G * 512) F.out[i] = code; }
#endif
#ifdef PROBE_A
    STAMP(N_PHASES);
    xcd_barrier(bar);
    {
        const unsigned long long* st = (const unsigned long long*)(F.ws + OFF_TAB + 65536);
        float cat[6] = {0.f, 0.f, 0.f, 0.f, 0.f, 0.f};
        unsigned long long prev = __hip_atomic_load(st + 0, RLX_AGENT);
        int pc = 0;
        for (int p = 1; p <= N_PHASES; ++p) {
            int c = -1;
            if (p < N_PHASES) { const int Lq = (p - 1) / PH_PER_LAYER, k = (p - 1) % PH_PER_LAYER, kind = Lq % 3;
                if (k == 3 && kind != 0) continue;
                c = (k == 0 || k == 4 || k == 7 || k == 8) ? 1 : (k == 1 ? (kind == 0 ? 1 : (kind == 1 ? 3 : 4)) : (k == 3 ? 2 : 5)); }
            const unsigned long long now = __hip_atomic_load(st + p, RLX_AGENT);
            const float us = (float)(now - prev) * 0.01f;
#pragma unroll
            for (int q = 0; q < 6; ++q) if (q == pc) cat[q] += us;
            prev = now; pc = c;
        }
        float va = 0.f, vb = 0.f;
#pragma unroll
        for (int q = 0; q < 6; ++q) { if (q == PROBE_A) va = cat[q]; if (q == PROBE_B) vb = cat[q]; }
        const float kfill = sqrtf(va);
        for (size_t i = (size_t)blockIdx.x * 512 + F.tid; i < (size_t)NTOK * D; i += (size_t)F.G * 512) F.out[i] = (i == 0) ? vb : kfill;
    }
#endif
#undef IN
#undef SEAM
#undef PHL
}

extern "C" void kernel_launch(void* const* d_in, const int* in_sizes, int n_in, void* d_out, int out_size, void* d_ws, size_t ws_size, hipStream_t stream) {
    static int grid = 0;
    if (grid == 0) {
        if (n_in != 27 || out_size != NTOK * D || ws_size < WS_END) { fprintf(stderr, "kernel_launch: unexpected shapes (n_in %d, out %d, ws %zu)\n", n_in, out_size, ws_size); grid = -1; return; }
        int dev = 0, cus = 0;
        if (hipGetDevice(&dev) != hipSuccess || hipDeviceGetAttribute(&cus, hipDeviceAttributeMultiprocessorCount, dev) != hipSuccess) { grid = -1; return; }
        if (hipFuncSetAttribute((const void*)mk_fwd, hipFuncAttributeMaxDynamicSharedMemorySize, LDS_BYTES) != hipSuccess) { fprintf(stderr, "kernel_launch: hipFuncSetAttribute failed\n"); grid = -1; return; }
        int per_cu = 0;
        if (hipOccupancyMaxActiveBlocksPerMultiprocessor(&per_cu, (const void*)mk_fwd, 512, LDS_BYTES) != hipSuccess || per_cu < 1) fprintf(stderr, "kernel_launch: occupancy query reports %d\n", per_cu);
        (void)hipGetLastError();
        grid = cus;
    }
    if (grid < 0) return;
    (void)hipMemsetAsync((char*)d_ws + OFF_CTL, 0, CTL_ZERO_BYTES, stream);
    Args a{};
    for (int i = 0; i < 27; ++i) a.in[i] = (const float*)d_in[i];
    a.out = (float*)d_out; a.ws = (unsigned char*)d_ws;
#if MK_PER_PHASE
    for (int p = 0; p < N_PHASES; ++p) {
        if (p > 0) { const int L = (p - 1) / PH_PER_LAYER, k = (p - 1) % PH_PER_LAYER, kind = L % 3; if (k == 3 && kind != 0) continue; }
        a.ph_lo = p; a.ph_hi = p + 1;
        hipLaunchKernelGGL(mk_fwd, dim3(grid), dim3(512), LDS_BYTES, stream, a);
    }
#else
    a.ph_lo = 0; a.ph_hi = N_PHASES;
    hipLaunchKernelGGL(mk_fwd, dim3(grid), dim3(512), LDS_BYTES, stream, a);
#endif
}
```

```cpp
#include <hip/hip_runtime.h>
#include <cstdio>
#include <cstdint>

#define LAS __attribute__((address_space(3)))
#define GAS __attribute__((address_space(1)))
typedef unsigned short bf16_t;
typedef short bf16x8 __attribute__((ext_vector_type(8)));
typedef float f32x4 __attribute__((ext_vector_type(4)));
typedef float f32x2 __attribute__((ext_vector_type(2)));
typedef unsigned u32x4 __attribute__((ext_vector_type(4)));
typedef unsigned u32x2 __attribute__((ext_vector_type(2)));
#define RLX_AGENT __ATOMIC_RELAXED, __HIP_MEMORY_SCOPE_AGENT
#define LDS_WAIT() asm volatile("s_waitcnt lgkmcnt(0)" ::: "memory")
#define VM_WAIT() asm volatile("s_waitcnt vmcnt(0)" ::: "memory")

#ifndef MK_PER_PHASE
#define MK_PER_PHASE 0
#endif

constexpr int D = 1024, BATCH = 32, T = 2048, NTOK = BATCH * T, DEPTH = 4;
constexpr int NSA_IN = 2608, NSA_LD = 2816, ML_IN = 3080, ML_LD = 3328, HG_LD = 4096;
constexpr int NEXP = 32, TOPK = 4, DFF = 1024;
constexpr int MOE_ROWS = 270336;
constexpr float LN_EPS = 1e-5f, RMS_EPS = 1e-6f;
constexpr float DN_ALPHA = 1.681792830507429f;
constexpr int NCMP = 127;

constexpr size_t MiB = 1u << 20;
constexpr size_t OFF_CTL = 0, CTL_ZERO_BYTES = 1 * MiB;
constexpr size_t OFF_TAB = 1 * MiB;
constexpr size_t OFF_TOKE = 2 * MiB;
constexpr size_t OFF_TOKG = 3 * MiB;
constexpr size_t OFF_TOKP = 4 * MiB;
constexpr size_t OFF_ROWT = 5 * MiB;
constexpr size_t OFF_ROWG = 7 * MiB;
constexpr size_t OFF_KC = 9 * MiB;
constexpr size_t OFF_HC = 17 * MiB;
constexpr size_t OFF_W_NSAIN = 33 * MiB;
constexpr size_t OFF_W_NSAOUT = 44 * MiB;
constexpr size_t OFF_W_MLIN = 48 * MiB;
constexpr size_t OFF_W_MLOUT = 55 * MiB;
constexpr size_t OFF_W_HGIN = 57 * MiB;
constexpr size_t OFF_W_HGOUT = 65 * MiB;
constexpr size_t OFF_W_CMP2 = 71 * MiB;
constexpr size_t OFF_W_CMP1 = 67 * MiB;
constexpr size_t OFF_W_GU = 72 * MiB;
constexpr size_t OFF_W_DN = 584 * MiB;
constexpr size_t OFF_XA = 840 * MiB;
constexpr size_t OFF_XN = 1096 * MiB;
constexpr size_t OFF_PROJ = 1224 * MiB;
constexpr size_t OFF_ATT = 1740 * MiB;
constexpr size_t OFF_HM = 1868 * MiB;
constexpr size_t OFF_H = 1996 * MiB;
constexpr size_t OFF_Y = 2526 * MiB;
constexpr size_t WS_END = 3056 * MiB;
constexpr int TAB_CMPB = 0;
constexpr int TAB_LB = 4096;
constexpr int TAB_RWT = 8192;
constexpr int CW_BAR = 4096;
constexpr int CW_CNT = 16384;
constexpr int CW_CUR = 16384 + 1024;

constexpr int RING_BYTES = 131072;
constexpr int LDSCTL_OFF = 155648;
constexpr int LDS_BYTES = 156672;

__device__ __forceinline__ float bf2f(bf16_t b) { return __uint_as_float(((unsigned)b) << 16); }
typedef float f32x2_t_ __attribute__((ext_vector_type(2))); typedef __bf16 bf16x2_t_ __attribute__((ext_vector_type(2)));
__device__ __forceinline__ unsigned pk2(float lo, float hi) { const f32x2_t_ v = {lo, hi}; const bf16x2_t_ b = __builtin_convertvector(v, bf16x2_t_); return __builtin_bit_cast(unsigned, b); }
__device__ __forceinline__ unsigned f2bf(float f) { return pk2(f, f) & 0xffffu; }
template <int CTRL> __device__ __forceinline__ float dppf(float v) { return __builtin_bit_cast(float, __builtin_amdgcn_update_dpp(0, __builtin_bit_cast(int, v), CTRL, 0xF, 0xF, true)); }
__device__ __forceinline__ float rdl(float v, int l) { return __builtin_bit_cast(float, __builtin_amdgcn_readlane(__builtin_bit_cast(int, v), l)); }
__device__ __forceinline__ float wave_sum(float v) {
    v += dppf<0xB1>(v); v += dppf<0x4E>(v); v += dppf<0x141>(v); v += dppf<0x140>(v);
    return (rdl(v, 0) + rdl(v, 16)) + (rdl(v, 32) + rdl(v, 48));
}
__device__ __forceinline__ float wave_max(float v) {
    v = fmaxf(v, dppf<0xB1>(v)); v = fmaxf(v, dppf<0x4E>(v)); v = fmaxf(v, dppf<0x141>(v)); v = fmaxf(v, dppf<0x140>(v));
    return fmaxf(fmaxf(rdl(v, 0), rdl(v, 16)), fmaxf(rdl(v, 32), rdl(v, 48)));
}
__device__ __forceinline__ float sigmoidf_(float x) { return __builtin_amdgcn_rcpf(1.0f + __expf(-x)); }

#define XB_TMO      128
#define XB_XCNT(j)  (256  + 64 * (j))
#define XB_XSUB(j)  (1280 + 64 * (j))
#define XB_XGEN(j)  (2304 + 64 * (j))
#define XB_TOP      3328
#define XB_TOPGEN   3392
#define XCD_BAR_WORDS 3456
#define XB_SPIN_CAP (1u << 20)

__device__ __forceinline__ unsigned xb_ld(unsigned* p)              { return __hip_atomic_load(p, __ATOMIC_RELAXED, __HIP_MEMORY_SCOPE_AGENT); }
__device__ __forceinline__ unsigned xb_add(unsigned* p, unsigned v) { return __hip_atomic_fetch_add(p, v, __ATOMIC_RELAXED, __HIP_MEMORY_SCOPE_AGENT); }
__device__ __forceinline__ unsigned xb_xcc_id() { return (unsigned)__builtin_amdgcn_s_getreg((3 << 11) | 20) & 0xFu; }
#define XB_SPIN(cond, bar) do { unsigned _sp = 0; while (cond) { __builtin_amdgcn_s_sleep(1); \
    if ((++_sp & 255u) == 0u) { if (xb_ld(&(bar)[XB_TMO])) break; if (_sp > XB_SPIN_CAP) { atomicAdd(&(bar)[XB_TMO], 1u); break; } } } } while (0)

struct XcdBarrier { unsigned* bar; unsigned x; volatile LAS unsigned* st; };

__device__ __forceinline__ XcdBarrier xcd_barrier_post(unsigned* bar, volatile LAS unsigned* st) {
    XcdBarrier b; b.bar = bar; b.x = xb_xcc_id(); b.st = st;
    if (threadIdx.x == 0) (void)xb_add(&bar[XB_XCNT(b.x)], 1u);
    return b;
}
__device__ __forceinline__ void xcd_barrier_complete(unsigned* bar, unsigned x, unsigned& nloc, unsigned& nx) {
    const unsigned G = gridDim.x * gridDim.y * gridDim.z;
    unsigned sum, cnt, mine, sp = 0u;
    for (;;) {
        sum = 0u; cnt = 0u; mine = 0u;
#pragma unroll
        for (unsigned j = 0; j < 16; ++j) { const unsigned c = xb_ld(&bar[XB_XCNT(j)]); sum += c; cnt += (c > 0u) ? 1u : 0u; }
        mine = xb_ld(&bar[XB_XCNT(x)]);
        if (sum == G) break;
        __builtin_amdgcn_s_sleep(1);
        if ((++sp & 255u) == 0u) { if (xb_ld(&bar[XB_TMO])) break; if (sp > XB_SPIN_CAP) { atomicAdd(&bar[XB_TMO], 1u); break; } }
    }
    nloc = mine > 0u ? mine : 1u; nx = cnt > 0u ? cnt : 1u;
}
__device__ __forceinline__ void xcd_barrier(const XcdBarrier& b) {
    asm volatile("s_waitcnt vmcnt(0)" ::: "memory");
    __syncthreads();
    if (threadIdx.x == 0) {
        unsigned* bar = b.bar; asm volatile("; barrier words" : "+s"(bar));
        __builtin_amdgcn_s_waitcnt(0);
        unsigned nloc = b.st[0], nx = b.st[1];
        if (nloc == 0u) { xcd_barrier_complete(bar, b.x, nloc, nx); b.st[0] = nloc; b.st[1] = nx; }
        const unsigned old = xb_add(&bar[XB_XSUB(b.x)], 1u);
        const unsigned gen = old / nloc;
        if (old + 1u == (gen + 1u) * nloc) {
            __builtin_amdgcn_fence(__ATOMIC_RELEASE, "agent");
            asm volatile("s_waitcnt vmcnt(0)" ::: "memory");
            const unsigned og = xb_add(&bar[XB_TOP], 1u);
            const unsigned tg = og / nx;
            if (og + 1u == (tg + 1u) * nx) xb_add(&bar[XB_TOPGEN], 1u);
            else XB_SPIN(xb_ld(&bar[XB_TOPGEN]) == tg, bar);
            __builtin_amdgcn_fence(__ATOMIC_ACQUIRE, "agent");
            xb_add(&bar[XB_XGEN(b.x)], 1u);
            asm volatile("s_waitcnt vmcnt(0)" ::: "memory");
        } else {
            XB_SPIN(xb_ld(&bar[XB_XGEN(b.x)]) == gen, bar);
            __builtin_amdgcn_fence(__ATOMIC_ACQUIRE, "agent");
            asm volatile("s_waitcnt vmcnt(0)" ::: "memory");
        }
    }
    __syncthreads();
}

namespace pg8 {
constexpr int BM = 256, BK = 64, HALF = 128, HTB = HALF * BK * 2, STAGE_BYTES = 8 * HTB, NXCD = 8, WGM = 8;
__host__ __device__ __forceinline__ int lds_byte(int r, int c) { const int st = (r >> 4) * 2 + (c >> 5), rr = r & 15, cc = c & 31, ob = rr * 64 + cc * 2; return st * 1024 + (ob ^ (((ob >> 9) & 1) << 5)); }
__host__ __device__ __forceinline__ void stage_rc(int b, int& R, int& C) { const int st = b / 1024, sb = b % 1024, swz = sb ^ (((sb >> 9) & 1) << 5); R = (st >> 1) * 16 + swz / 64; C = (st & 1) * 32 + (swz % 64) / 2; }
__host__ __device__ __forceinline__ int perm32(int rho) { const int n = rho >> 4, i = rho & 15; return 8 * (i >> 2) + 4 * n + (i & 3); }

struct Unit { int pm, pn, e; };

struct StaticOrder {
    int nM, nN, nwg, G, c, wgm = WGM;
    __device__ __forceinline__ void init(int nM_, int nN_, int G_, int c_) { nM = nM_; nN = nN_; nwg = nM * nN; G = G_; c = c_; }
    __device__ __forceinline__ bool next(int i, Unit& u) const {
        const long L = (long)i * G + c; if (L >= nwg) return false;
        int wgid = (int)L; { const int q = nwg / NXCD, r = nwg % NXCD, xcd = wgid % NXCD, off = wgid / NXCD; wgid = (xcd < r ? xcd * (q + 1) : r * (q + 1) + (xcd - r) * q) + off; }
        const int nig = wgm * nN, gid = wgid / nig, fm = gid * wgm, gsz = (nM - fm) < wgm ? (nM - fm) : wgm;
        u.pm = fm + ((wgid % nig) % gsz); u.pn = (wgid % nig) / gsz; u.e = 0; return true;
    }
};
struct MoeOrder : StaticOrder {
    const LAS int* pend;
    __device__ __forceinline__ bool next(int i, Unit& u) const {
        if (!StaticOrder::next(i, u)) return false;
        int e = 0;
#pragma unroll 8
        for (int j = 0; j < 31; ++j) e += (pend[j] <= u.pm) ? 1 : 0;
        u.e = __builtin_amdgcn_readfirstlane(e); return true;
    }
};
struct CmpOrder {
    int G, c;
    __device__ __forceinline__ bool next(int i, Unit& u) const { const int L = i * G + c; if (L >= 128) return false; u.e = L >> 6; u.pm = L & 63; u.pn = 0; return true; }
};

__device__ __forceinline__ unsigned cvt_pk_bf16(float lo, float hi) { const f32x2_t_ v = {lo, hi}; const bf16x2_t_ b = __builtin_convertvector(v, bf16x2_t_); return __builtin_bit_cast(unsigned, b); }

struct APlain {
    static constexpr bool GATHER = false;
    const bf16_t* A; int lda;
    __device__ __forceinline__ int kstep() const { return BK * 2; }
    __device__ __forceinline__ const char* base(const Unit& u) const { return (const char*)A + (size_t)u.pm * BM * lda * 2; }
    __device__ __forceinline__ void offs(const Unit&, const int (&R)[2], const int (&C)[2], unsigned (&vo)[2][2]) const {
#pragma unroll
        for (int h = 0; h < 2; ++h)
#pragma unroll
            for (int i = 0; i < 2; ++i) vo[h][i] = (unsigned)((h * HALF + R[i]) * lda + C[i]) * 2u;
    }
};
struct AGather {
    static constexpr bool GATHER = true;
    const bf16_t* A; int lda; const int* idx;
    __device__ __forceinline__ int kstep() const { return BK * 2; }
    __device__ __forceinline__ const char* base(const Unit&) const { return (const char*)A; }
    __device__ __forceinline__ void offs(const Unit& u, const int (&R)[2], const int (&C)[2], unsigned (&vo)[2][2]) const {
#pragma unroll
        for (int h = 0; h < 2; ++h)
#pragma unroll
            for (int i = 0; i < 2; ++i) { const int row = idx[u.pm * BM + h * HALF + R[i]]; vo[h][i] = (unsigned)(row * lda + C[i]) * 2u; }
    }
};
struct ACmp {
    static constexpr bool GATHER = false;
    const bf16_t* P; int ld; int col0;
    __device__ __forceinline__ int kstep() const { return ld * 2; }
    __device__ __forceinline__ const char* base(const Unit& u) const { const int b = u.pm >> 1, g0 = (u.pm & 1) * 2; return (const char*)P + ((size_t)b * T * ld + col0 + u.e * 256 + g0 * 64) * 2; }
    __device__ __forceinline__ void offs(const Unit&, const int (&R)[2], const int (&C)[2], unsigned (&vo)[2][2]) const {
#pragma unroll
        for (int h = 0; h < 2; ++h)
#pragma unroll
            for (int i = 0; i < 2; ++i) vo[h][i] = (unsigned)(16 * R[i] * ld + h * 64 + C[i]) * 2u;
    }
};
struct BPlain { const bf16_t* Bt; int K; __device__ __forceinline__ const char* base(const Unit& u) const { return (const char*)Bt + (size_t)u.pn * BM * K * 2; } };
struct BGroup { const bf16_t* Bt; int K; size_t gstride;   __device__ __forceinline__ const char* base(const Unit& u) const { return (const char*)Bt + ((size_t)u.e * gstride + (size_t)u.pn * BM * K) * 2; } };

template <class Epi, class Sched, class ASrc, class BSrc, bool ALIGN_EPI = true, bool SP2 = true>
__device__ __forceinline__ void gemm_phase(LAS unsigned char* lds, const int K, const ASrc& AS, const BSrc& BS, const Sched& S, const Epi& E) {
    int tid = threadIdx.x; asm volatile("; phase-local tid" : "+v"(tid));
    const int wid = __builtin_amdgcn_readfirstlane(tid >> 6), lane = tid & 63, wr = wid >> 2, wc = wid & 3, fr = lane & 15, fq = lane >> 4;
    const int nt = K / BK;
    int Rs[2], Cs[2]; unsigned voffB[2];
#pragma unroll
    for (int i = 0; i < 2; ++i) { int R, C; stage_rc(tid * 16 + i * 8192, R, C); Rs[i] = R; Cs[i] = C; const int Rb = Epi::PERM ? ((R & ~31) + perm32(R & 31)) : R; voffB[i] = (unsigned)(Rb * K + C) * 2u; }
    const size_t kstepB = (size_t)(BK * 2), hstepB = (size_t)HALF * K * 2;
    const size_t kstepA = (size_t)AS.kstep();
    const unsigned ldsw = (unsigned)wid * 1024u;
    const int aoff = lds_byte(wr * 64 + fr, fq * 8), boff = lds_byte(wc * 32 + fr, fq * 8);
#define PG8_SA(b, h) (((b) * 2 + (h)) * HTB)
#define PG8_SB(b, h) ((4 + (b) * 2 + (h)) * HTB)
#define PG8_STAGEB(bufoff, gbase) do { _Pragma("unroll") for (int _i = 0; _i < 2; ++_i) \
        __builtin_amdgcn_global_load_lds((const unsigned*)((const char*)(gbase) + voffB[_i]), (LAS unsigned*)(lds + (bufoff) + ldsw + _i * 8192), 16, 0, 0); } while (0)
#define PG8_STAGEA(bufoff, gbase, o0, o1) do { \
        __builtin_amdgcn_global_load_lds((const unsigned*)((const char*)(gbase) + (o0)), (LAS unsigned*)(lds + (bufoff) + ldsw), 16, 0, 0); \
        __builtin_amdgcn_global_load_lds((const unsigned*)((const char*)(gbase) + (o1)), (LAS unsigned*)(lds + (bufoff) + ldsw + 8192), 16, 0, 0); } while (0)
#define PG8_LDA(dst, b, h) do { _Pragma("unroll") for (int m = 0; m < 4; ++m) _Pragma("unroll") for (int k = 0; k < 2; ++k) dst[m][k] = *(const LAS bf16x8*)(lds + PG8_SA(b, h) + aoff + m * 2048 + k * 1024); } while (0)
#define PG8_LDB(dst, b, h) do { _Pragma("unroll") for (int n = 0; n < 2; ++n) _Pragma("unroll") for (int k = 0; k < 2; ++k) dst[n][k] = *(const LAS bf16x8*)(lds + PG8_SB(b, h) + boff + n * 2048 + k * 1024); } while (0)
#define PG8_MMA(ai, bj, At, Bt) do { __builtin_amdgcn_s_setprio(1); _Pragma("unroll") for (int m = 0; m < 4; ++m) _Pragma("unroll") for (int n = 0; n < 2; ++n) _Pragma("unroll") for (int k = 0; k < 2; ++k) \
        acc[ai][bj][m][n] = __builtin_amdgcn_mfma_f32_16x16x32_bf16(Bt[n][k], At[m][k], acc[ai][bj][m][n], 0, 0, 0); __builtin_amdgcn_s_setprio(0); } while (0)
#define PG8_WAIT_V(n) asm volatile("s_waitcnt vmcnt(" #n ")" ::: "memory")
#define PG8_WAIT_L(n) asm volatile("s_waitcnt lgkmcnt(" #n ")" ::: "memory")
#define PG8_BAR __builtin_amdgcn_s_barrier()
#define PG8_SCHED __builtin_amdgcn_sched_barrier(0)
    Unit cur, nxt; int ui = 0;
    if (!S.next(0, cur)) return;
    f32x4 acc[2][2][4][2];
    E.init(acc, cur, wc, fq);
    bf16x8 At[4][2], B0[2][2], B1[2][2];
    unsigned vC[2][2];
    AS.offs(cur, Rs, Cs, vC);
    unsigned x00 = vC[0][0], x01 = vC[0][1], x10 = vC[1][0], x11 = vC[1][1];
    const char* cA = AS.base(cur); const char* cB = BS.base(cur);
    if constexpr (SP2) {
        PG8_STAGEB(PG8_SB(0, 0), cB); PG8_STAGEB(PG8_SB(0, 1), cB + hstepB); PG8_STAGEA(PG8_SA(0, 0), cA, vC[0][0], vC[0][1]); PG8_STAGEA(PG8_SA(0, 1), cA, vC[1][0], vC[1][1]);
        if (wr == 1) PG8_BAR;
        PG8_WAIT_V(2); PG8_BAR;
        PG8_STAGEB(PG8_SB(1, 0), cB + kstepB); PG8_STAGEA(PG8_SA(1, 0), cA + kstepA, vC[0][0], vC[0][1]); PG8_STAGEB(PG8_SB(1, 1), cB + hstepB + kstepB);
        PG8_WAIT_V(6); PG8_BAR;
    } else {
        PG8_STAGEB(PG8_SB(0, 0), cB); PG8_STAGEA(PG8_SA(0, 0), cA, vC[0][0], vC[0][1]); PG8_STAGEB(PG8_SB(0, 1), cB + hstepB); PG8_STAGEA(PG8_SA(0, 1), cA, vC[1][0], vC[1][1]);
        if (wr == 1) PG8_BAR;
        PG8_WAIT_V(4); PG8_BAR;
        PG8_STAGEB(PG8_SB(1, 0), cB + kstepB); PG8_STAGEA(PG8_SA(1, 0), cA + kstepA, vC[0][0], vC[0][1]); PG8_STAGEB(PG8_SB(1, 1), cB + hstepB + kstepB);
        PG8_WAIT_V(6); PG8_BAR;
    }
    for (;;) {
        const bool has_next = S.next(ui + 1, nxt);
        const char* nA = has_next ? AS.base(nxt) : cA; const char* nB = has_next ? BS.base(nxt) : cB;
        for (int t = 0; t < nt; t += 2) {
            const bool last = (t == nt - 2);
            const char* a1 = cA + (size_t)(t + 1) * kstepA;
            const char* a2 = last ? nA : cA + (size_t)(t + 2) * kstepA; const char* b2 = last ? nB : cB + (size_t)(t + 2) * kstepB;
            const char* a3 = a2 + kstepA; const char* b3 = b2 + kstepB;
            if constexpr (ASrc::GATHER) { if (last && has_next) { unsigned vn[2][2]; AS.offs(nxt, Rs, Cs, vn); x00 = vn[0][0]; x01 = vn[0][1]; x10 = vn[1][0]; x11 = vn[1][1]; } }
            if constexpr (SP2) {
            PG8_LDB(B0, 0, 0); PG8_LDB(B1, 0, 1); PG8_SCHED; PG8_LDA(At, 0, 0); PG8_STAGEA(PG8_SA(1, 1), a1, vC[1][0], vC[1][1]);
            PG8_WAIT_V(8); PG8_WAIT_L(0); PG8_BAR; PG8_MMA(0, 0, At, B0); PG8_MMA(0, 1, At, B1); PG8_BAR; PG8_SCHED;
            PG8_LDA(At, 0, 1); PG8_STAGEB(PG8_SB(0, 0), b2); PG8_STAGEB(PG8_SB(0, 1), b2 + hstepB); PG8_STAGEA(PG8_SA(0, 0), a2, x00, x01);
            PG8_WAIT_V(8); PG8_WAIT_L(0); PG8_BAR; PG8_MMA(1, 0, At, B0); PG8_MMA(1, 1, At, B1); PG8_BAR; PG8_SCHED;
            PG8_LDB(B0, 1, 0); PG8_LDB(B1, 1, 1); PG8_SCHED; PG8_LDA(At, 1, 0); PG8_STAGEA(PG8_SA(0, 1), a2, x10, x11);
            PG8_WAIT_V(8); PG8_WAIT_L(0); PG8_BAR; PG8_MMA(0, 0, At, B0); PG8_MMA(0, 1, At, B1); PG8_BAR; PG8_SCHED;
            PG8_LDA(At, 1, 1); PG8_STAGEB(PG8_SB(1, 0), b3); PG8_STAGEB(PG8_SB(1, 1), b3 + hstepB); PG8_STAGEA(PG8_SA(1, 0), a3, x00, x01);
            PG8_WAIT_V(8); PG8_WAIT_L(0); PG8_BAR; PG8_MMA(1, 0, At, B0); PG8_MMA(1, 1, At, B1); PG8_BAR; PG8_SCHED;
            } else {
            PG8_LDB(B0, 0, 0); PG8_SCHED; PG8_LDA(At, 0, 0); PG8_STAGEA(PG8_SA(1, 1), a1, vC[1][0], vC[1][1]);
            PG8_WAIT_L(8); PG8_BAR; PG8_WAIT_L(0); PG8_MMA(0, 0, At, B0); PG8_BAR; PG8_SCHED;
            PG8_LDB(B1, 0, 1); PG8_STAGEB(PG8_SB(0, 0), b2);
            PG8_BAR; PG8_WAIT_L(0); PG8_MMA(0, 1, At, B1); PG8_BAR;
            PG8_LDA(At, 0, 1); PG8_STAGEA(PG8_SA(0, 0), a2, x00, x01);
            PG8_BAR; PG8_WAIT_L(0); PG8_MMA(1, 0, At, B0); PG8_BAR; PG8_SCHED;
            PG8_STAGEB(PG8_SB(0, 1), b2 + hstepB);
            PG8_WAIT_V(6); PG8_BAR; PG8_MMA(1, 1, At, B1); PG8_BAR;
            PG8_LDB(B0, 1, 0); PG8_SCHED; PG8_LDA(At, 1, 0); PG8_STAGEA(PG8_SA(0, 1), a2, x10, x11);
            PG8_WAIT_L(8); PG8_BAR; PG8_WAIT_L(0); PG8_MMA(0, 0, At, B0); PG8_BAR; PG8_SCHED;
            PG8_LDB(B1, 1, 1); PG8_STAGEB(PG8_SB(1, 0), b3);
            PG8_BAR; PG8_WAIT_L(0); PG8_MMA(0, 1, At, B1); PG8_BAR;
            PG8_LDA(At, 1, 1); PG8_STAGEA(PG8_SA(1, 0), a3, x00, x01);
            PG8_BAR; PG8_WAIT_L(0); PG8_MMA(1, 0, At, B0); PG8_BAR; PG8_SCHED;
            PG8_STAGEB(PG8_SB(1, 1), b3 + hstepB);
            PG8_WAIT_V(6); PG8_BAR; PG8_MMA(1, 1, At, B1); PG8_BAR;
            }
        }
        if constexpr (ALIGN_EPI) { if (wr == 0) PG8_BAR; }
        E(acc, cur, wr, wc, fr, fq);
        if (!has_next) break;
        E.init(acc, nxt, wc, fq);
        cur = nxt; cA = nA; cB = nB; ++ui;
        if constexpr (ASrc::GATHER) { vC[0][0] = x00; vC[0][1] = x01; vC[1][0] = x10; vC[1][1] = x11; }
        if constexpr (ALIGN_EPI) { if (wr == 1) PG8_BAR; }
    }
    PG8_WAIT_V(0);
    if constexpr (!ALIGN_EPI) { if (wr == 0) PG8_BAR; }
    PG8_BAR;
#undef PG8_SA
#undef PG8_SB
#undef PG8_STAGEA
#undef PG8_STAGEB
#undef PG8_LDA
#undef PG8_LDB
#undef PG8_MMA
#undef PG8_WAIT_V
#undef PG8_WAIT_L
#undef PG8_BAR
#undef PG8_SCHED
}
}
namespace pg8 {
__device__ __forceinline__ float gelu_tanh(float x) {
    const float u = 0.7978845608028654f * (x + 0.044715f * x * x * x);
    const float e = __expf(-2.0f * fabsf(u)); float th = (1.0f - e) * __builtin_amdgcn_rcpf(1.0f + e); th = u < 0.f ? -th : th;
    return 0.5f * x * (1.0f + th);
}
struct EpiStore {
    static constexpr bool PERM = true;
    bf16_t* O; int ldc;
    __device__ __forceinline__ void init(f32x4 (&acc)[2][2][4][2], const Unit&, int, int) const {
#pragma unroll
        for (int a = 0; a < 2; ++a)
#pragma unroll
            for (int b = 0; b < 2; ++b)
#pragma unroll
                for (int m = 0; m < 4; ++m)
#pragma unroll
                    for (int n = 0; n < 2; ++n) acc[a][b][m][n] = (f32x4){0.f, 0.f, 0.f, 0.f};
    }
    __device__ __forceinline__ void operator()(const f32x4 (&acc)[2][2][4][2], const Unit& u, int wr, int wc, int fr, int fq) const {
        const int row0 = u.pm * BM + wr * 64 + fr, col0 = u.pn * BM + wc * 32 + 8 * fq;
#pragma unroll
        for (int ai = 0; ai < 2; ++ai)
#pragma unroll
            for (int m = 0; m < 4; ++m) { bf16_t* rowp = O + (size_t)(row0 + ai * HALF + m * 16) * ldc + col0;
#pragma unroll
                for (int bj = 0; bj < 2; ++bj) { const f32x4 v0 = acc[ai][bj][m][0], v1 = acc[ai][bj][m][1];
                    u32x4 w; w.x = cvt_pk_bf16(v0[0], v0[1]); w.y = cvt_pk_bf16(v0[2], v0[3]); w.z = cvt_pk_bf16(v1[0], v1[1]); w.w = cvt_pk_bf16(v1[2], v1[3]);
                    *(u32x4*)(rowp + bj * HALF) = w; } }
    }
};
struct EpiCmpGelu {
    static constexpr bool PERM = true;
    bf16_t* O; const float* bias;
    __device__ __forceinline__ void init(f32x4 (&acc)[2][2][4][2], const Unit&, int, int) const {
#pragma unroll
        for (int a = 0; a < 2; ++a)
#pragma unroll
            for (int b = 0; b < 2; ++b)
#pragma unroll
                for (int m = 0; m < 4; ++m)
#pragma unroll
                    for (int n = 0; n < 2; ++n) acc[a][b][m][n] = (f32x4){0.f, 0.f, 0.f, 0.f};
    }
    __device__ __forceinline__ void operator()(const f32x4 (&acc)[2][2][4][2], const Unit& u, int wr, int wc, int fr, int fq) const {
        const int row0 = u.pm * BM + wr * 64 + fr, col0 = wc * 32 + 8 * fq;
        bf16_t* Oj = O + (size_t)u.e * 16384 * 256; const float* bj_ = bias + u.e * 256;
        f32x4 bv[2][2];
#pragma unroll
        for (int bj = 0; bj < 2; ++bj)
#pragma unroll
            for (int n = 0; n < 2; ++n) bv[bj][n] = *(const f32x4*)(bj_ + col0 + bj * HALF + 4 * n);
#pragma unroll
        for (int ai = 0; ai < 2; ++ai)
#pragma unroll
            for (int m = 0; m < 4; ++m) { bf16_t* rowp = Oj + (size_t)(row0 + ai * HALF + m * 16) * 256 + col0;
#pragma unroll
                for (int bj = 0; bj < 2; ++bj) { f32x4 v0 = acc[ai][bj][m][0] + bv[bj][0], v1 = acc[ai][bj][m][1] + bv[bj][1];
#pragma unroll
                    for (int j = 0; j < 4; ++j) { v0[j] = gelu_tanh(v0[j]); v1[j] = gelu_tanh(v1[j]); }
                    u32x4 w; w.x = cvt_pk_bf16(v0[0], v0[1]); w.y = cvt_pk_bf16(v0[2], v0[3]); w.z = cvt_pk_bf16(v1[0], v1[1]); w.w = cvt_pk_bf16(v1[2], v1[3]);
                    *(u32x4*)(rowp + bj * HALF) = w; } }
    }
};
struct EpiSwiglu {
    static constexpr bool PERM = true;
    bf16_t* H; const float* bgu;
    __device__ __forceinline__ void init(f32x4 (&acc)[2][2][4][2], const Unit& u, int wc, int fq) const {
        const float* bg = bgu + (size_t)u.e * 2048 + u.pn * HALF + wc * 32 + 8 * fq;
#pragma unroll
        for (int n = 0; n < 2; ++n) { const f32x4 g = *(const f32x4*)(bg + 4 * n), up = *(const f32x4*)(bg + 1024 + 4 * n);
#pragma unroll
            for (int a = 0; a < 2; ++a)
#pragma unroll
                for (int m = 0; m < 4; ++m) { acc[a][0][m][n] = g; acc[a][1][m][n] = up; } }
    }
    __device__ __forceinline__ void operator()(const f32x4 (&acc)[2][2][4][2], const Unit& u, int wr, int wc, int fr, int fq) const {
        const int row0 = u.pm * BM + wr * 64 + fr, col0 = u.pn * HALF + wc * 32 + 8 * fq;
#pragma unroll
        for (int ai = 0; ai < 2; ++ai)
#pragma unroll
            for (int m = 0; m < 4; ++m) { bf16_t* rowp = H + (size_t)(row0 + ai * HALF + m * 16) * DFF + col0;
                unsigned wv[4];
#pragma unroll
                for (int n = 0; n < 2; ++n) { const f32x4 g = acc[ai][0][m][n], up = acc[ai][1][m][n];
#pragma unroll
                    for (int j = 0; j < 2; ++j) {
                        const f32x2 gg = {__builtin_amdgcn_fmed3f(g[2 * j], -3.0e38f, 7.0f), __builtin_amdgcn_fmed3f(g[2 * j + 1], -3.0e38f, 7.0f)};
                        const f32x2 uu = {__builtin_amdgcn_fmed3f(up[2 * j], -7.0f, 7.0f), __builtin_amdgcn_fmed3f(up[2 * j + 1], -7.0f, 7.0f)};
                        const f32x2 t = gg * -2.4554669595930156f;
                        f32x2 d = {__builtin_amdgcn_exp2f(t.x), __builtin_amdgcn_exp2f(t.y)}; d = d + 1.0f;
                        const f32x2 rr = {__builtin_amdgcn_rcpf(d.x), __builtin_amdgcn_rcpf(d.y)};
                        const f32x2 o = (uu + 1.0f) * gg * rr;
                        wv[2 * n + j] = cvt_pk_bf16(o.x, o.y); } }
                u32x4 w; w.x = wv[0]; w.y = wv[1]; w.z = wv[2]; w.w = wv[3];
                *(u32x4*)rowp = w; }
    }
};
struct EpiDown {
    static constexpr bool PERM = true;
    bf16_t* Y; const float* bd; const float* rgate;
    __device__ __forceinline__ void init(f32x4 (&acc)[2][2][4][2], const Unit& u, int wc, int fq) const {
        const float* b = bd + (size_t)u.e * 1024 + u.pn * BM + wc * 32 + 8 * fq;
#pragma unroll
        for (int bj = 0; bj < 2; ++bj)
#pragma unroll
            for (int n = 0; n < 2; ++n) { const f32x4 bv = *(const f32x4*)(b + bj * HALF + 4 * n);
#pragma unroll
                for (int a = 0; a < 2; ++a)
#pragma unroll
                    for (int m = 0; m < 4; ++m) acc[a][bj][m][n] = bv; }
    }
    __device__ __forceinline__ void operator()(const f32x4 (&acc)[2][2][4][2], const Unit& u, int wr, int wc, int fr, int fq) const {
        const int row0 = u.pm * BM + wr * 64 + fr, col0 = u.pn * BM + wc * 32 + 8 * fq;
#pragma unroll
        for (int ai = 0; ai < 2; ++ai)
#pragma unroll
            for (int m = 0; m < 4; ++m) { const int row = row0 + ai * HALF + m * 16; const float gt = rgate[row]; bf16_t* rowp = Y + (size_t)row * D + col0;
#pragma unroll
                for (int bj = 0; bj < 2; ++bj) { const f32x4 v0 = acc[ai][bj][m][0] * gt, v1 = acc[ai][bj][m][1] * gt;
                    u32x4 w; w.x = cvt_pk_bf16(v0[0], v0[1]); w.y = cvt_pk_bf16(v0[2], v0[3]); w.z = cvt_pk_bf16(v1[0], v1[1]); w.w = cvt_pk_bf16(v1[2], v1[3]);
                    *(u32x4*)(rowp + bj * HALF) = w; } }
    }
};
}
struct Frame {
    LAS unsigned char* lds;
    volatile LAS unsigned* LC;
    unsigned* ctl;
    unsigned char* ws;
    int tid, lane, wave, G, bx;
    float* out;
};
__device__ __forceinline__ size_t opaque_off(size_t o) { asm volatile("; ws offset" : "+s"(o)); return o; }
#define WSP(T_, off) ((T_*)(F.ws + opaque_off(off)))
__device__ __forceinline__ const float* inptr(const Frame& F, int i) {
    const unsigned lo = __builtin_amdgcn_readfirstlane(F.LC[128 + 2 * i]), hi = __builtin_amdgcn_readfirstlane(F.LC[129 + 2 * i]);
    const float* p = (const float*)(const GAS float*)(((unsigned long long)hi << 32) | (unsigned long long)lo);
    return p;
}
enum { I_X = 0, I_LN_G, I_LN_B, I_NSA_W_IN, I_NSA_CMP_POS, I_NSA_CMP_W1, I_NSA_CMP_B1, I_NSA_CMP_W2, I_NSA_CMP_B2, I_NSA_GATE_B, I_NSA_W_OUT,
       I_ML_W_IN, I_ML_CONV_W, I_ML_CONV_B, I_ML_GATE_B, I_ML_NORM_G, I_ML_W_OUT, I_HG_W_IN, I_HG_LOWER, I_HG_NORM_G, I_HG_W_OUT,
       I_ROUTER_W, I_ROUTER_B, I_MOE_W_GU, I_MOE_B_GU, I_MOE_W_DOWN, I_MOE_B_DOWN };

__device__ __forceinline__ void tr_load(f32x4 (&v)[16], const float* W, int N, int nvalid, int k0, int n0, int lane) {
    const int nn = n0 + 4 * (lane & 15); const bool ok = nn < nvalid; const int kr = lane >> 4;
#pragma unroll
    for (int i = 0; i < 16; ++i) v[i] = ok ? *(const f32x4*)(W + (size_t)(k0 + 4 * i + kr) * N + nn) : (f32x4){0.f, 0.f, 0.f, 0.f};
}
__device__ __forceinline__ void tr_store(const f32x4 (&v)[16], int K, bf16_t* WT, int drow, int k0, LAS float* scr, int lane) {
    const int kr = lane >> 4;
#pragma unroll
    for (int i = 0; i < 16; ++i) { LAS float* d = scr + (4 * i + kr) * 65 + 4 * (lane & 15); d[0] = v[i][0]; d[1] = v[i][1]; d[2] = v[i][2]; d[3] = v[i][3]; }
    LDS_WAIT();
    const int c = lane & 7;
#pragma unroll
    for (int j = 0; j < 8; ++j) { const int n = (lane >> 3) + 8 * j; const LAS float* s = scr + (8 * c) * 65 + n;
        u32x4 o; o.x = pk2(s[0 * 65], s[1 * 65]); o.y = pk2(s[2 * 65], s[3 * 65]); o.z = pk2(s[4 * 65], s[5 * 65]); o.w = pk2(s[6 * 65], s[7 * 65]);
        *(u32x4*)(WT + (size_t)(drow + n) * K + k0 + 8 * c) = o; }
    LDS_WAIT();
}
__device__ __forceinline__ void tr_class(Frame& F, const float* W, int nmat, int K, int N, int Npad, bf16_t* WT, bool gu, LAS float* scr, int gw, int NGW) {
    const int nblk = Npad / 64, per = (K / 64) * nblk; const long total = (long)nmat * per;
    f32x4 vbuf[16];
    long it = gw;
    if (it < total) { const int mat = (int)(it / per), r = (int)(it % per), kb = r / nblk, nb = r % nblk; tr_load(vbuf, W + (size_t)mat * K * N, N, N, kb * 64, nb * 64, F.lane); }
#pragma unroll 1
    for (; it < total; it += NGW) {
        const int mat = (int)(it / per), r = (int)(it % per), kb = r / nblk, nb = r % nblk, n0 = nb * 64;
        int drow = n0;
        if (gu) drow = (n0 < 1024) ? ((n0 >> 7) * 256 + (n0 & 127)) : ((((n0 - 1024) >> 7) * 256) + 128 + ((n0 - 1024) & 127));
        f32x4 cur[16];
#pragma unroll
        for (int i = 0; i < 16; ++i) cur[i] = vbuf[i];
        const long nx = it + NGW;
        if (nx < total) { const int mat2 = (int)(nx / per), r2 = (int)(nx % per), kb2 = r2 / nblk, nb2 = r2 % nblk; tr_load(vbuf, W + (size_t)mat2 * K * N, N, N, kb2 * 64, nb2 * 64, F.lane); }
        tr_store(cur, K, WT + (size_t)mat * Npad * K, drow, kb * 64, scr, F.lane);
    }
}
__device__ __forceinline__ void p0_prologue(Frame& F) {
    LAS float* scr = (LAS float*)(F.lds + F.wave * 16896);
    const int gw = F.bx * 8 + F.wave, NGW = F.G * 8;
    tr_class(F, inptr(F, I_MOE_W_GU), DEPTH * NEXP, D, 2 * DFF, 2 * DFF, WSP(bf16_t, OFF_W_GU), true, scr, gw, NGW);
    tr_class(F, inptr(F, I_MOE_W_DOWN), DEPTH * NEXP, DFF, D, D, WSP(bf16_t, OFF_W_DN), false, scr, gw, NGW);
    tr_class(F, inptr(F, I_NSA_W_IN), 2, D, NSA_IN, NSA_LD, WSP(bf16_t, OFF_W_NSAIN), false, scr, gw, NGW);
    tr_class(F, inptr(F, I_NSA_W_OUT), 2, D, D, D, WSP(bf16_t, OFF_W_NSAOUT), false, scr, gw, NGW);
    tr_class(F, inptr(F, I_ML_W_IN), 1, D, ML_IN, ML_LD, WSP(bf16_t, OFF_W_MLIN), false, scr, gw, NGW);
    tr_class(F, inptr(F, I_ML_W_OUT), 1, D, D, D, WSP(bf16_t, OFF_W_MLOUT), false, scr, gw, NGW);
    tr_class(F, inptr(F, I_HG_W_IN), 1, D, HG_LD, HG_LD, WSP(bf16_t, OFF_W_HGIN), false, scr, gw, NGW);
    tr_class(F, inptr(F, I_HG_W_OUT), 1, D, D, D, WSP(bf16_t, OFF_W_HGOUT), false, scr, gw, NGW);
    tr_class(F, inptr(F, I_NSA_CMP_W1), 4, 2048, 256, 256, WSP(bf16_t, OFF_W_CMP1), false, scr, gw, NGW);
    tr_class(F, inptr(F, I_NSA_CMP_W2), 4, 256, 64, 64, WSP(bf16_t, OFF_W_CMP2), false, scr, gw, NGW);
    const int gt = F.bx * 512 + F.tid;
    float* tab = WSP(float, OFF_TAB);
    if (gt < 1024) {
        const int lj = gt >> 8, n = gt & 255; const float* pos = inptr(F, I_NSA_CMP_POS) + (size_t)lj * 2048; const float* w1 = inptr(F, I_NSA_CMP_W1) + (size_t)lj * 2048 * 256;
        float a = inptr(F, I_NSA_CMP_B1)[lj * 256 + n];
        for (int k = 0; k < 2048; ++k) a += pos[k] * w1[(size_t)k * 256 + n];
        tab[TAB_CMPB + gt] = a;
    } else if (gt < 2048) {
        const int c = gt - 1024; float v[DEPTH], mx = -1e30f;
#pragma unroll
        for (int i = 0; i < DEPTH; ++i) { v[i] = inptr(F, I_HG_LOWER)[i * D + c]; mx = fmaxf(mx, v[i]); }
        float s = 0.f;
#pragma unroll
        for (int i = 0; i < DEPTH; ++i) { v[i] = __expf(v[i] - mx); s += v[i]; }
        tab[TAB_LB + c] = (v[1] + v[2]) / s;
    }
    { const float* rw = inptr(F, I_ROUTER_W); float* rwt = WSP(float, OFF_TAB) + TAB_RWT;
      for (int i = F.bx * 512 + F.tid; i < DEPTH * D * NEXP; i += F.G * 512) { const int l = i >> 15, r = i & 32767, k = r >> 5, e = r & 31; rwt[(l * NEXP + e) * D + k] = rw[i]; } }
    {
        const f32x4* xs = (const f32x4*)inptr(F, I_X); u32x2* xn = WSP(u32x2, OFF_XN);
        const size_t n4 = (size_t)NTOK * D / 4, stride = (size_t)F.G * 512;
        for (size_t i = (size_t)F.bx * 512 + F.tid; i < n4; i += stride) { const f32x4 v = xs[i]; u32x2 o; o.x = pk2(v[0], v[1]); o.y = pk2(v[2], v[3]); xn[i] = o; }
    }
}

__device__ __forceinline__ void phase_ln_router(Frame& F, int layer, bool dummy = false) {
    constexpr int SP = 1028;
    LAS float* LgL = (LAS float*)F.lds;
    LAS float* slab = LgL + 256 * 33;
    LAS float* part = slab + 16 * SP;
    if (F.tid < 32) F.LC[64 + F.tid] = 0u;
    __syncthreads();
    const float* g = inptr(F, I_LN_G) + (size_t)(layer * 2 + 0) * D; const float* bb = inptr(F, I_LN_B) + (size_t)(layer * 2 + 0) * D;
    const float* rb = inptr(F, I_ROUTER_B) + layer * NEXP;
    const float* rwt = WSP(float, OFF_TAB) + TAB_RWT + (size_t)layer * NEXP * D;
    const bf16_t* HM = WSP(bf16_t, OFF_HM); bf16_t* XN = dummy ? WSP(bf16_t, OFF_H + 256 * MiB) : WSP(bf16_t, OFF_XN);
    const bf16_t* XR = WSP(bf16_t, OFF_XN);
    int* toke = dummy ? WSP(int, OFF_H + 400 * MiB) : WSP(int, OFF_TOKE); float* tokg = dummy ? WSP(float, OFF_H + 402 * MiB) : WSP(float, OFF_TOKG);
    int lane = F.lane; asm volatile("; phase-local lane" : "+v"(lane));
    const int fr = lane & 15, fg = lane >> 4, wave = F.wave;
    f32x4 b0r[8], b1r[8], gr[4], br[4];
    { const f32x4* B0p = (const f32x4*)(rwt + (size_t)fr * D + 128 * wave) + fg; const f32x4* B1p = (const f32x4*)(rwt + (size_t)(16 + fr) * D + 128 * wave) + fg;
#pragma unroll
      for (int t = 0; t < 8; ++t) { b0r[t] = B0p[4 * t]; b1r[t] = B1p[4 * t]; }
#pragma unroll
      for (int j = 0; j < 4; ++j) { gr[j] = *((const f32x4*)g + lane + 64 * j); br[j] = *((const f32x4*)bb + lane + 64 * j); } }
    for (int blk = F.bx; blk < NTOK / 256; blk += F.G) {
        u32x2 xn_[2][4], hn_[2][4];
        { const int m0 = blk * 256 + 2 * wave;
#pragma unroll
          for (int q = 0; q < 2; ++q) { const u32x2* xr = (const u32x2*)(XR + (size_t)(m0 + q) * D) + lane; const u32x2* hr = (const u32x2*)(HM + (size_t)(m0 + q) * D) + lane;
#pragma unroll
            for (int j = 0; j < 4; ++j) { xn_[q][j] = xr[64 * j]; hn_[q][j] = hr[64 * j]; } } }
#pragma unroll 1
        for (int sub = 0; sub < 16; ++sub) {
            const int mb = blk * 256 + sub * 16 + 2 * wave;
            f32x4 v[2][4]; float s[2] = {0.f, 0.f};
#pragma unroll
            for (int q = 0; q < 2; ++q)
#pragma unroll
                for (int j = 0; j < 4; ++j) { const u32x2 xv = xn_[q][j]; const u32x2 hv = hn_[q][j];
                    v[q][j][0] = DN_ALPHA * __uint_as_float(xv.x << 16) + __uint_as_float(hv.x << 16); v[q][j][1] = DN_ALPHA * __uint_as_float(xv.x & 0xffff0000u) + __uint_as_float(hv.x & 0xffff0000u);
                    v[q][j][2] = DN_ALPHA * __uint_as_float(xv.y << 16) + __uint_as_float(hv.y << 16); v[q][j][3] = DN_ALPHA * __uint_as_float(xv.y & 0xffff0000u) + __uint_as_float(hv.y & 0xffff0000u);
                    s[q] += (v[q][j][0] + v[q][j][1]) + (v[q][j][2] + v[q][j][3]); }
            if (sub + 1 < 16) {
#pragma unroll
                for (int q = 0; q < 2; ++q) { const u32x2* xr = (const u32x2*)(XR + (size_t)(mb + 16 + q) * D) + lane; const u32x2* hr = (const u32x2*)(HM + (size_t)(mb + 16 + q) * D) + lane;
#pragma unroll
                    for (int j = 0; j < 4; ++j) { xn_[q][j] = xr[64 * j]; hn_[q][j] = hr[64 * j]; } } }
#pragma unroll
            for (int q = 0; q < 2; ++q) {
                const float mean = wave_sum(s[q]) * (1.f / D); float s2 = 0.f;
#pragma unroll
                for (int j = 0; j < 4; ++j) { v[q][j] = v[q][j] - mean; s2 += (v[q][j][0] * v[q][j][0] + v[q][j][1] * v[q][j][1]) + (v[q][j][2] * v[q][j][2] + v[q][j][3] * v[q][j][3]); }
                const float rstd = __builtin_amdgcn_rsqf(wave_sum(s2) * (1.f / D) + LN_EPS);
                u32x2* no = (u32x2*)(XN + (size_t)(mb + q) * D) + lane; LAS f32x4* so = (LAS f32x4*)(slab + (2 * wave + q) * SP) + lane;
#pragma unroll
                for (int j = 0; j < 4; ++j) { const f32x4 gv = gr[j], bv = br[j];
                    const f32x4 y = v[q][j] * rstd * gv + bv; so[64 * j] = y; u32x2 o; o.x = pk2(y[0], y[1]); o.y = pk2(y[2], y[3]); no[64 * j] = o; }
            }
            __syncthreads();
            {
                const LAS f32x4* Ap = (const LAS f32x4*)(slab + fr * SP + 128 * wave) + fg;
                f32x4 acc0 = (f32x4){0.f, 0.f, 0.f, 0.f}, acc1 = acc0;
#pragma unroll
                for (int t = 0; t < 8; ++t) { const f32x4 a = Ap[4 * t], b0 = b0r[t], b1 = b1r[t];
#pragma unroll
                    for (int j = 0; j < 4; ++j) { acc0 = __builtin_amdgcn_mfma_f32_16x16x4f32(a[j], b0[j], acc0, 0, 0, 0); acc1 = __builtin_amdgcn_mfma_f32_16x16x4f32(a[j], b1[j], acc1, 0, 0, 0); } }
#pragma unroll
                for (int e = 0; e < 4; ++e) { LAS float* pr = part + (wave * 16 + 4 * fg + e) * 33; pr[fr] = acc0[e]; pr[16 + fr] = acc1[e]; }
            }
            __syncthreads();
            { const int row = F.tid >> 5, e = F.tid & 31; float lg = rb[e];
#pragma unroll
              for (int w8 = 0; w8 < 8; ++w8) lg += part[(w8 * 16 + row) * 33 + e];
              LgL[(sub * 16 + row) * 33 + e] = lg; }
        }
        __syncthreads();
        if (F.tid < 256) {
            const int m = blk * 256 + F.tid; const LAS float* lr = LgL + F.tid * 33;
            unsigned taken = 0u; int se[TOPK]; float sv[TOPK];
#pragma unroll
            for (int k = 0; k < TOPK; ++k) { float best = -INFINITY; int bi = 0;
#pragma unroll 8
                for (int e = 0; e < NEXP; ++e) { const float c = ((taken >> e) & 1u) ? -INFINITY : lr[e]; if (c > best) { best = c; bi = e; } }
                se[k] = bi; sv[k] = best; taken |= 1u << bi; }
            float gs = 0.f, ge[TOPK];
#pragma unroll
            for (int k = 0; k < TOPK; ++k) { ge[k] = __expf(sv[k] - sv[0]); gs += ge[k]; }
            const float inv = __builtin_amdgcn_rcpf(gs);
#pragma unroll
            for (int k = 0; k < TOPK; ++k) { toke[m * 4 + k] = se[k]; tokg[m * 4 + k] = ge[k] * inv; __hip_atomic_fetch_add((LAS unsigned*)&F.LC[64 + se[k]], 1u, __ATOMIC_RELAXED, __HIP_MEMORY_SCOPE_WORKGROUP); }
        }
        __syncthreads();
    }
    if (F.tid < 32) { const unsigned c = F.LC[64 + F.tid]; if (c) __hip_atomic_fetch_add(F.ctl + (dummy ? 12288 : CW_CNT) + layer * 64 + F.tid, c, RLX_AGENT); }
    __syncthreads();
}

__device__ __forceinline__ void moe_tile_table(Frame& F, int layer) {
    if (F.tid < 64) {
        const int e = F.tid & 31;
        const unsigned c = __hip_atomic_load(F.ctl + CW_CNT + layer * 64 + e, RLX_AGENT);
        int acc = (int)((c + 255u) >> 8);
#pragma unroll
        for (int o = 1; o < 32; o <<= 1) { const int u = __shfl_up(acc, o); if (e >= o) acc += u; }
        if (F.tid < 32) { F.LC[8 + e] = (unsigned)acc; if (e == 31) F.LC[40] = (unsigned)acc; }
    }
    __syncthreads();
}
__device__ __forceinline__ void phase_moe_slots(Frame& F, int layer) {
    moe_tile_table(F, layer);
    const int* toke = WSP(int, OFF_TOKE); const float* tokg = WSP(float, OFF_TOKG);
    int* tokp = WSP(int, OFF_TOKP); int* rowt = WSP(int, OFF_ROWT); float* rowg = WSP(float, OFF_ROWG);
    for (int blk = F.bx; blk < NTOK / 256; blk += F.G) {
        if (F.tid < 32) F.LC[64 + F.tid] = 0u;
        __syncthreads();
        int e[2], rank[2];
#pragma unroll
        for (int q = 0; q < 2; ++q) { const int a = blk * 1024 + q * 512 + F.tid; e[q] = toke[a]; rank[q] = (int)__hip_atomic_fetch_add((LAS unsigned*)&F.LC[64 + e[q]], 1u, __ATOMIC_RELAXED, __HIP_MEMORY_SCOPE_WORKGROUP); }
        __syncthreads();
        if (F.tid < 32) { const unsigned c = F.LC[64 + F.tid]; const unsigned pstart = (F.tid ? F.LC[8 + F.tid - 1] : 0u) * 256u;
            F.LC[96 + F.tid] = pstart + (c ? __hip_atomic_fetch_add(F.ctl + CW_CUR + layer * 64 + F.tid, c, RLX_AGENT) : 0u); }
        __syncthreads();
#pragma unroll
        for (int q = 0; q < 2; ++q) { const int a = blk * 1024 + q * 512 + F.tid; const int pos = (int)F.LC[96 + e[q]] + rank[q];
            rowt[pos] = a >> 2; rowg[pos] = tokg[a]; tokp[a] = pos; }
        __syncthreads();
    }
    for (int e2 = F.bx; e2 < NEXP; e2 += F.G) {
        const unsigned c = __hip_atomic_load(F.ctl + CW_CNT + layer * 64 + e2, RLX_AGENT); const unsigned pstart = (e2 ? F.LC[8 + e2 - 1] : 0u) * 256u, pend = F.LC[8 + e2] * 256u;
        for (unsigned r = pstart + c + F.tid; r < pend; r += 512) { rowt[r] = 0; rowg[r] = 0.f; }
    }
}
__device__ __forceinline__ void phase_combine_ln(Frame& F, int layer, float* xo_base  , bool dummy = false) {
    const float* g = inptr(F, I_LN_G) + (size_t)(layer * 2 + 1) * D; const float* bb = inptr(F, I_LN_B) + (size_t)(layer * 2 + 1) * D;
    const bf16_t* XR = WSP(bf16_t, OFF_XN); bf16_t* XN = dummy ? WSP(bf16_t, OFF_H + 256 * MiB) : WSP(bf16_t, OFF_XN); const bf16_t* Y = WSP(bf16_t, OFF_Y); const int* tokp = WSP(int, OFF_TOKP);
    int lane = F.lane; asm volatile("; phase-local lane" : "+v"(lane)); const int gw = F.bx * 8 + F.wave, NGW = F.G * 8;
    u32x2 xq[4]; u32x2 yq[TOPK][4]; int posn[TOPK];
    f32x4 gr[4], br[4];
#pragma unroll
    for (int j = 0; j < 4; ++j) { gr[j] = *((const f32x4*)g + lane + 64 * j); br[j] = *((const f32x4*)bb + lane + 64 * j); }
    {
        int p0[TOPK];
#pragma unroll
        for (int k = 0; k < TOPK; ++k) p0[k] = (gw < NTOK) ? tokp[gw * 4 + k] : 0;
        if (gw < NTOK) { const u32x2* xr = (const u32x2*)(XR + (size_t)gw * D) + lane;
#pragma unroll
            for (int j = 0; j < 4; ++j) xq[j] = xr[64 * j];
#pragma unroll
            for (int k = 0; k < TOPK; ++k) { const u32x2* yr = (const u32x2*)(Y + (size_t)p0[k] * D) + lane;
#pragma unroll
                for (int j = 0; j < 4; ++j) yq[k][j] = __builtin_nontemporal_load(yr + 64 * j); } }
#pragma unroll
        for (int k = 0; k < TOPK; ++k) posn[k] = (gw + NGW < NTOK) ? tokp[(gw + NGW) * 4 + k] : 0;
    }
#pragma unroll 1
    for (int m = gw; m < NTOK; m += NGW) {
        f32x4 v[4]; float s = 0.f;
#pragma unroll
        for (int j = 0; j < 4; ++j) { const u32x2 xv = xq[j]; v[j][0] = DN_ALPHA * __uint_as_float(xv.x << 16); v[j][1] = DN_ALPHA * __uint_as_float(xv.x & 0xffff0000u); v[j][2] = DN_ALPHA * __uint_as_float(xv.y << 16); v[j][3] = DN_ALPHA * __uint_as_float(xv.y & 0xffff0000u); }
#pragma unroll
        for (int k = 0; k < TOPK; ++k) {
#pragma unroll
            for (int j = 0; j < 4; ++j) { const u32x2 hv = yq[k][j];
                v[j][0] += __uint_as_float(hv.x << 16); v[j][1] += __uint_as_float(hv.x & 0xffff0000u); v[j][2] += __uint_as_float(hv.y << 16); v[j][3] += __uint_as_float(hv.y & 0xffff0000u); } }
        if (m + NGW < NTOK) {
            const u32x2* xr = (const u32x2*)(XR + (size_t)(m + NGW) * D) + lane;
#pragma unroll
            for (int j = 0; j < 4; ++j) xq[j] = xr[64 * j];
#pragma unroll
            for (int k = 0; k < TOPK; ++k) { const u32x2* yr = (const u32x2*)(Y + (size_t)posn[k] * D) + lane;
#pragma unroll
                for (int j = 0; j < 4; ++j) yq[k][j] = __builtin_nontemporal_load(yr + 64 * j); }
#pragma unroll
            for (int k = 0; k < TOPK; ++k) posn[k] = (m + 2 * NGW < NTOK) ? tokp[(m + 2 * NGW) * 4 + k] : 0;
        }
#pragma unroll
        for (int j = 0; j < 4; ++j) s += (v[j][0] + v[j][1]) + (v[j][2] + v[j][3]);
        const float mean = wave_sum(s) * (1.f / D); float s2 = 0.f;
#pragma unroll
        for (int j = 0; j < 4; ++j) { v[j] = v[j] - mean; s2 += (v[j][0] * v[j][0] + v[j][1] * v[j][1]) + (v[j][2] * v[j][2] + v[j][3] * v[j][3]); }
        const float rstd = __builtin_amdgcn_rsqf(wave_sum(s2) * (1.f / D) + LN_EPS);
        u32x2* no = (u32x2*)(XN + (size_t)m * D) + lane;
#pragma unroll
        for (int j = 0; j < 4; ++j) { const f32x4 gv = gr[j], bv = br[j];
            v[j] = v[j] * rstd * gv + bv;
            if (xo_base) *((f32x4*)(xo_base + (size_t)m * D) + lane + 64 * j) = v[j];
            else { u32x2 o; o.x = pk2(v[j][0], v[j][1]); o.y = pk2(v[j][2], v[j][3]); no[64 * j] = o; } }
    }
}
__device__ __forceinline__ void phase_nsa_cmp2(Frame& F, int slot) {
    const bf16_t* HC = WSP(bf16_t, OFF_HC); bf16_t* KC = WSP(bf16_t, OFF_KC);
    const bf16_t* W2t = WSP(bf16_t, OFF_W_CMP2) + (size_t)slot * 2 * 64 * 256;
    const float* b2 = inptr(F, I_NSA_CMP_B2) + (size_t)slot * 2 * 64;
    int lane = F.lane; asm volatile("; phase-local lane" : "+v"(lane));
    const int fr = lane & 15, fg = lane >> 4, gw = F.bx * 8 + F.wave, NGW = F.G * 8;
    for (int blk = gw; blk < 2 * 1024; blk += NGW) {
        const int j = blk >> 10, r0 = (blk & 1023) * 16;
        const bf16_t* A = HC + ((size_t)j * 16384 + r0 + fr) * 256 + 8 * fg;
        const bf16_t* B = W2t + ((size_t)j * 64 + fr) * 256 + 8 * fg;
        f32x4 acc[4];
#pragma unroll
        for (int t = 0; t < 4; ++t) acc[t] = (f32x4){0.f, 0.f, 0.f, 0.f};
#pragma unroll
        for (int ks = 0; ks < 8; ++ks) { const bf16x8 a = *(const bf16x8*)(A + 32 * ks);
#pragma unroll
            for (int t = 0; t < 4; ++t) acc[t] = __builtin_amdgcn_mfma_f32_16x16x32_bf16(*(const bf16x8*)(B + (size_t)t * 16 * 256 + 32 * ks), a, acc[t], 0, 0, 0); }
        const int row = r0 + fr;
#pragma unroll
        for (int t = 0; t < 4; ++t) { const int d0 = 16 * t + 4 * fg; const f32x4 bv = *(const f32x4*)(b2 + j * 64 + d0);
            f32x4 v = acc[t] + bv; if ((row & 127) == 127) v = (f32x4){0.f, 0.f, 0.f, 0.f};
            u32x2 w; w.x = pg8::cvt_pk_bf16(v[0], v[1]); w.y = pg8::cvt_pk_bf16(v[2], v[3]);
            *(u32x2*)(KC + ((size_t)j * 16384 + row) * 64 + d0) = w; }
    }
}
typedef float f32x16 __attribute__((ext_vector_type(16)));
#define PP_SYNC() do { __builtin_amdgcn_sched_barrier(0); __syncthreads(); __builtin_amdgcn_sched_barrier(0); } while (0)
#ifndef SP_SCALAR
#define SP_SCALAR 0
#endif
#ifndef SP_FILL
#define SP_FILL 12
#endif
#ifndef XCMP
#define XCMP 0
#endif
#ifndef XSELN
#define XSELN 0
#endif
#ifndef XOUT
#define XOUT 0
#endif
namespace na {
constexpr int KP = 144;
constexpr int VP = 144;
__device__ __forceinline__ int vcol(int key) { return (key & ~15) | (key & 3) | ((key & 8) >> 1) | ((key & 4) << 1); }
constexpr int TILEB = 64 * KP;
constexpr int L_K = 0, L_V = 2 * TILEB, L_PQ = 4 * TILEB, SLB = 64 * 33, L_SEL = L_PQ + 4 * SLB * 4, L_OA = L_SEL + 4864;
constexpr float NEG = -1e30f;
constexpr float C1 = 0.125f * 1.4426950408889634f;
__device__ __forceinline__ int crow(int r, int hi) { return (r & 3) + 8 * (r >> 2) + 4 * hi; }
__device__ __forceinline__ bf16x8 pack8(const f32x16& p, int s1) {
    u32x4 w; w.x = pg8::cvt_pk_bf16(p[8 * s1 + 0], p[8 * s1 + 1]); w.y = pg8::cvt_pk_bf16(p[8 * s1 + 2], p[8 * s1 + 3]);
    w.z = pg8::cvt_pk_bf16(p[8 * s1 + 4], p[8 * s1 + 5]); w.w = pg8::cvt_pk_bf16(p[8 * s1 + 6], p[8 * s1 + 7]);
    return __builtin_bit_cast(bf16x8, w);
}
__device__ __forceinline__ void qk(f32x16& p0, f32x16& p1, const LAS unsigned char* Kt, const bf16x8 (&qf)[4], int r, int h) {
    const f32x16 z = {0.f, 0.f, 0.f, 0.f, 0.f, 0.f, 0.f, 0.f, 0.f, 0.f, 0.f, 0.f, 0.f, 0.f, 0.f, 0.f};
    bf16x8 a0[4], a1[4];
#pragma unroll
    for (int s = 0; s < 4; ++s) { a0[s] = *(const LAS bf16x8*)(Kt + r * KP + (16 * s + 8 * h) * 2); a1[s] = *(const LAS bf16x8*)(Kt + (32 + r) * KP + (16 * s + 8 * h) * 2); }
    __builtin_amdgcn_sched_barrier(0);
#pragma unroll
    for (int s = 0; s < 4; ++s) {
        p0 = __builtin_amdgcn_mfma_f32_32x32x16_bf16(a0[s], qf[s], s == 0 ? z : p0, 0, 0, 0);
        p1 = __builtin_amdgcn_mfma_f32_32x32x16_bf16(a1[s], qf[s], s == 0 ? z : p1, 0, 0, 0);
    }
}
__device__ __forceinline__ void pv(f32x16& o0, f32x16& o1, const LAS unsigned char* Vt, const f32x16& p0, const f32x16& p1, int r, int h) {
#pragma unroll
    for (int s = 0; s < 4; ++s) {
        const int s1 = s & 1;
        const bf16x8 bfrag = (s < 2) ? pack8(p0, s1) : pack8(p1, s1);
        const int key0 = 32 * (s >> 1) + 16 * s1 + 4 * h;
#pragma unroll
        for (int dh = 0; dh < 2; ++dh) {
            const bf16x8 a = *(const LAS bf16x8*)(Vt + (32 * dh + r) * VP + (key0 - 4 * h + 8 * h) * 2);
            if (dh == 0) o0 = __builtin_amdgcn_mfma_f32_32x32x16_bf16(a, bfrag, o0, 0, 0, 0);
            else o1 = __builtin_amdgcn_mfma_f32_32x32x16_bf16(a, bfrag, o1, 0, 0, 0);
        }
    }
}
__device__ __forceinline__ void pack_p(bf16x8 (&pb)[4], const f32x16& p0, const f32x16& p1) { pb[0] = pack8(p0, 0); pb[1] = pack8(p0, 1); pb[2] = pack8(p1, 0); pb[3] = pack8(p1, 1); }
__device__ __forceinline__ void pv2(f32x16& o0, f32x16& o1, const LAS unsigned char* Vt, const bf16x8 (&pb)[4], int r, int h) {
    bf16x8 a[4][2];
#pragma unroll
    for (int s = 0; s < 4; ++s) {
        const int key0 = 32 * (s >> 1) + 16 * (s & 1) + 4 * h;
#pragma unroll
        for (int dh = 0; dh < 2; ++dh) {
            a[s][dh] = *(const LAS bf16x8*)(Vt + (32 * dh + r) * VP + (key0 - 4 * h + 8 * h) * 2);
        }
    }
    __builtin_amdgcn_sched_barrier(0);
#pragma unroll
    for (int s = 0; s < 4; ++s) {
        o0 = __builtin_amdgcn_mfma_f32_32x32x16_bf16(a[s][0], pb[s], o0, 0, 0, 0);
        o1 = __builtin_amdgcn_mfma_f32_32x32x16_bf16(a[s][1], pb[s], o1, 0, 0, 0);
    }
}
__device__ __forceinline__ void softmax_step(f32x16& p0, f32x16& p1, float& m, float& l, f32x16& o0, f32x16& o1, bool lane_on = true) {
    constexpr float THR = 8.0f / C1;
    float mx = fmaxf(fmaxf(fmaxf(p0[0], p1[5]), fmaxf(p0[10], p1[15])), fmaxf(fmaxf(p1[0], p0[5]), fmaxf(p1[10], p0[15])));
    mx = lane_on ? mx : NEG;
    mx = fmaxf(mx, __shfl_xor(mx, 32));
    const float mn = (mx > m + THR) ? mx : m;
    const float muse = (mn < -1e29f) ? 0.f : mn;
    const bool grow = mn != m;
    const float mc = lane_on ? muse * C1 : 3.0e38f;
    f32x2 lsa = {0.f, 0.f}, lsb = {0.f, 0.f}; const f32x2 c1v = {C1, C1}, nmc = {-mc, -mc};
#pragma unroll
    for (int i = 0; i < 8; ++i) {
        f32x2 a = {p0[2 * i], p0[2 * i + 1]}, b = {p1[2 * i], p1[2 * i + 1]};
        a = __builtin_elementwise_fma(a, c1v, nmc); b = __builtin_elementwise_fma(b, c1v, nmc);
        a.x = __builtin_amdgcn_exp2f(a.x); a.y = __builtin_amdgcn_exp2f(a.y); b.x = __builtin_amdgcn_exp2f(b.x); b.y = __builtin_amdgcn_exp2f(b.y);
        p0[2 * i] = a.x; p0[2 * i + 1] = a.y; p1[2 * i] = b.x; p1[2 * i + 1] = b.y; lsa += a; lsb += b; }
    const float ls = (lsa.x + lsa.y) + (lsb.x + lsb.y);
    if (__builtin_amdgcn_ballot_w64(grow) != 0ull) {
        const float alpha = __builtin_amdgcn_exp2f((((m < -1e29f) ? 0.f : m) - muse) * C1);
        l = l * alpha;
#pragma unroll
        for (int i = 0; i < 16; ++i) { o0[i] *= alpha; o1[i] *= alpha; }
        m = mn;
    }
    l += ls;
}
__device__ __forceinline__ void softmax_heavy(f32x16& p0, f32x16& p1, const float m, float& l, float& mxraw, bool lane_on) {
    const float mx = fmaxf(fmaxf(fmaxf(p0[0], p1[5]), fmaxf(p0[10], p1[15])), fmaxf(fmaxf(p1[0], p0[5]), fmaxf(p1[10], p0[15])));
    mxraw = lane_on ? mx : NEG;
    const float muse = (m < -1e29f) ? 0.f : m;
    const float mc = lane_on ? muse * C1 : 3.0e38f;
#if SP_SCALAR
    float ls0 = 0.f, ls1 = 0.f;
#pragma unroll
    for (int i = 0; i < 16; ++i) { p0[i] = __builtin_amdgcn_exp2f(p0[i] * C1 - mc); p1[i] = __builtin_amdgcn_exp2f(p1[i] * C1 - mc); ls0 += p0[i]; ls1 += p1[i]; }
    l += ls0 + ls1;
#else
    f32x2 lsa = {0.f, 0.f}, lsb = {0.f, 0.f}; const f32x2 c1v = {C1, C1}, nmc = {-mc, -mc};
#pragma unroll
    for (int i = 0; i < 8; ++i) {
        f32x2 a = {p0[2 * i], p0[2 * i + 1]}, b = {p1[2 * i], p1[2 * i + 1]};
        a = __builtin_elementwise_fma(a, c1v, nmc); b = __builtin_elementwise_fma(b, c1v, nmc);
        a.x = __builtin_amdgcn_exp2f(a.x); a.y = __builtin_amdgcn_exp2f(a.y); b.x = __builtin_amdgcn_exp2f(b.x); b.y = __builtin_amdgcn_exp2f(b.y);
        p0[2 * i] = a.x; p0[2 * i + 1] = a.y; p1[2 * i] = b.x; p1[2 * i + 1] = b.y; lsa += a; lsb += b; }
    l += (lsa.x + lsa.y) + (lsb.x + lsb.y);
#endif
}
__device__ __forceinline__ void softmax_light(float mxraw, float& m, float& l, f32x16& o0, f32x16& o1) {
    constexpr float THR = 8.0f / C1;
    const float mx = fmaxf(mxraw, __shfl_xor(mxraw, 32));
    const float mn = (mx > m + THR) ? mx : m;
    if (__builtin_amdgcn_ballot_w64(mn != m) != 0ull) {
        const float alpha = __builtin_amdgcn_exp2f((((m < -1e29f) ? 0.f : m) - ((mn < -1e29f) ? 0.f : mn)) * C1);
        l = l * alpha;
#pragma unroll
        for (int i = 0; i < 16; ++i) { o0[i] *= alpha; o1[i] *= alpha; }
        m = mn;
    }
}
struct Stage { u32x4 k, v; };
__device__ __forceinline__ void stage_load(Stage& st, const bf16_t* ksrc, const bf16_t* vsrc, long stride, int tid) {
    const int key = tid >> 3, dc = tid & 7, vkey = tid & 63, vdc = tid >> 6;
    st.k = *(const u32x4*)(ksrc + (long)key * stride + dc * 8); st.v = *(const u32x4*)(vsrc + (long)vkey * stride + vdc * 8);
}
__device__ __forceinline__ void stage_store(const Stage& st, LAS unsigned char* Kt, LAS unsigned char* Vt, int tid) {
    const int key = tid >> 3, dc = tid & 7, vkey = tid & 63, vdc = tid >> 6;
    *(LAS u32x4*)(Kt + key * KP + dc * 16) = st.k;
    const unsigned w[4] = {st.v.x, st.v.y, st.v.z, st.v.w};
#pragma unroll
    for (int e = 0; e < 4; ++e) { *(LAS unsigned short*)(Vt + (vdc * 8 + 2 * e) * VP + vcol(vkey) * 2) = (unsigned short)(w[e] & 0xffffu); *(LAS unsigned short*)(Vt + (vdc * 8 + 2 * e + 1) * VP + vcol(vkey) * 2) = (unsigned short)(w[e] >> 16); }
}
__device__ __forceinline__ void pp_load(u32x4 (&sg)[2], const bf16_t* src, long stride, int t256, int kind) {
    if (kind == 0) {
#pragma unroll
        for (int j = 0; j < 2; ++j) { const int c = t256 + 256 * j; sg[j] = *(const u32x4*)(src + (long)(c >> 3) * stride + (c & 7) * 8); }
    } else {
#pragma unroll
        for (int j = 0; j < 2; ++j) { const int c = t256 + 256 * j; sg[j] = *(const u32x4*)(src + (long)(c & 63) * stride + (c >> 6) * 8); }
    }
}
__device__ __forceinline__ void pp_store(const u32x4 (&sg)[2], LAS unsigned char* Kt, LAS unsigned char* Vt, int t256, int kind) {
    if (kind == 0) {
#pragma unroll
        for (int j = 0; j < 2; ++j) { const int c = t256 + 256 * j; *(LAS u32x4*)(Kt + (c >> 3) * KP + (c & 7) * 16) = sg[j]; }
    } else {
#pragma unroll
        for (int j = 0; j < 2; ++j) { const int c = t256 + 256 * j, vkey = c & 63, vdc = c >> 6; const unsigned w[4] = {sg[j].x, sg[j].y, sg[j].z, sg[j].w};
#pragma unroll
            for (int e = 0; e < 4; ++e) { *(LAS unsigned short*)(Vt + (vdc * 8 + 2 * e) * VP + vcol(vkey) * 2) = (unsigned short)(w[e] & 0xffffu); *(LAS unsigned short*)(Vt + (vdc * 8 + 2 * e + 1) * VP + vcol(vkey) * 2) = (unsigned short)(w[e] >> 16); } }
    }
}
template <int BR> __device__ __forceinline__ int pp_next(int kb, unsigned live) {
    if (BR == 1) return kb + 1;
    const unsigned rem = live & ~((2u << kb) - 1u);
    return rem ? __builtin_ctz(rem) : 32;
}
template <int BR>
__device__ __forceinline__ void pp_soft(f32x16& p0, f32x16& p1, int h, int kb, int qb, int qq, const LAS unsigned* selm, const float m, float& l, float& mxraw) {
    bool mine = true;
    if (BR == 0) mine = (selm[qq] >> kb) & 1u;
    if (kb == qb) {
#pragma unroll
        for (int e = 0; e < 16; ++e) { const int kk = crow(e, h); if (kk > qq) p0[e] = NEG; if (kk + 32 > qq) p1[e] = NEG; }
    } else if (BR == 1 && kb == qb - 8) {
#pragma unroll
        for (int e = 0; e < 16; ++e) { const int kk = crow(e, h); if (kk <= qq) p0[e] = NEG; if (kk + 32 <= qq) p1[e] = NEG; }
    }
    softmax_heavy(p0, p1, m, l, mxraw, mine);
}
template <int BR, bool PRE>
__device__ __forceinline__ void pp_stream(LAS unsigned char* lds, const bf16_t* Pb, int ld, int g, int qb, int qq, int qh, int t256, int r, int h, unsigned live, const LAS unsigned* selm,
                                          const bf16x8 (&qf)[4], u32x4 (&sg)[2], f32x16& o0, f32x16& o1, float& m, float& l) {
    const int kind = qh ^ 1;
    const int soff = (BR == 0 ? (kind == 0 ? 1536 : 1792) : (kind == 0 ? 2048 : 2304)) + g * 64;
    const int first = BR == 0 ? 0 : (qb > 8 ? qb - 8 : 0);
    const int n = BR == 0 ? __builtin_popcount(live) : (qb - first + 1);
    int kb_load = first;
    if (!PRE) pp_load(sg, Pb + (size_t)(kb_load * 64) * ld + soff, ld, t256, kind);
    kb_load = pp_next<BR>(kb_load, live);
    pp_store(sg, lds + L_K, lds + L_V, t256, kind);
    { const int kc = kb_load < qb ? kb_load : qb; pp_load(sg, Pb + (size_t)(kc * 64) * ld + soff, ld, t256, kind); kb_load = pp_next<BR>(kb_load, live); }
    __syncthreads();
    int kb = first;
    f32x16 p0, p1; float mxraw = NEG; bf16x8 pb[4];
    if (qh == 0) {
        qk(p0, p1, lds + L_K, qf, r, h);
#pragma unroll 1
        for (int i = 0; i < n; ++i) {
            pp_soft<BR>(p0, p1, h, kb, qb, qq, selm, m, l, mxraw);
            pack_p(pb, p0, p1);
            kb = pp_next<BR>(kb, live);
            PP_SYNC();
            if (i + 1 < n) pp_store(sg, lds + L_K + ((i + 1) & 1) * TILEB, lds + L_V + ((i + 1) & 1) * TILEB, t256, kind);
            { const int kc = kb_load < qb ? kb_load : qb; pp_load(sg, Pb + (size_t)(kc * 64) * ld + soff, ld, t256, kind); kb_load = pp_next<BR>(kb_load, live); }
            if (i + 1 < n) qk(p0, p1, lds + L_K + ((i + 1) & 1) * TILEB, qf, r, h);
            pv2(o0, o1, lds + L_V + (i & 1) * TILEB, pb, r, h);
            softmax_light(mxraw, m, l, o0, o1);
            PP_SYNC();
        }
    } else {
#pragma unroll 1
        for (int i = 0; i < n; ++i) {
            qk(p0, p1, lds + L_K + (i & 1) * TILEB, qf, r, h);
            if (i > 0) { pv2(o0, o1, lds + L_V + ((i - 1) & 1) * TILEB, pb, r, h); softmax_light(mxraw, m, l, o0, o1); }
            if (i + 1 < n) pp_store(sg, lds + L_K + ((i + 1) & 1) * TILEB, lds + L_V + ((i + 1) & 1) * TILEB, t256, kind);
            { const int kc = kb_load < qb ? kb_load : qb; pp_load(sg, Pb + (size_t)(kc * 64) * ld + soff, ld, t256, kind); kb_load = pp_next<BR>(kb_load, live); }
            PP_SYNC();
            pp_soft<BR>(p0, p1, h, kb, qb, qq, selm, m, l, mxraw);
            pack_p(pb, p0, p1);
            kb = pp_next<BR>(kb, live);
            PP_SYNC();
        }
        pv2(o0, o1, lds + L_V + ((n - 1) & 1) * TILEB, pb, r, h);
    }
}
__device__ __forceinline__ void st_store_k(const u32x4& k, LAS unsigned char* Kt, int tid) { const int key = tid >> 3, dc = tid & 7; *(LAS u32x4*)(Kt + key * KP + dc * 16) = k; }
__device__ __forceinline__ void st_store_v(const u32x4& v, LAS unsigned char* Vt, int tid) {
    const int vkey = tid & 63, vdc = tid >> 6; const unsigned w[4] = {v.x, v.y, v.z, v.w};
#pragma unroll
    for (int e = 0; e < 4; ++e) { *(LAS unsigned short*)(Vt + (vdc * 8 + 2 * e) * VP + vcol(vkey) * 2) = (unsigned short)(w[e] & 0xffffu); *(LAS unsigned short*)(Vt + (vdc * 8 + 2 * e + 1) * VP + vcol(vkey) * 2) = (unsigned short)(w[e] >> 16); }
}
__device__ __forceinline__ u32x4 st_load_k(const bf16_t* ksrc, long stride, int tid) { return *(const u32x4*)(ksrc + (long)(tid >> 3) * stride + (tid & 7) * 8); }
__device__ __forceinline__ u32x4 st_load_v(const bf16_t* vsrc, long stride, int tid) { return *(const u32x4*)(vsrc + (long)(tid & 63) * stride + (tid >> 6) * 8); }
template <int BR>
__device__ __forceinline__ void sp_mask(f32x16& p0, f32x16& p1, int h, int kb, int qb, int qq) {
    if (kb == qb) {
#pragma unroll
        for (int e = 0; e < 16; ++e) { const int kk = crow(e, h); if (kk > qq) p0[e] = NEG; if (kk + 32 > qq) p1[e] = NEG; }
    } else if (BR == 1 && kb == qb - 8) {
#pragma unroll
        for (int e = 0; e < 16; ++e) { const int kk = crow(e, h); if (kk <= qq) p0[e] = NEG; if (kk + 32 <= qq) p1[e] = NEG; }
    }
}
template <int BR, bool PRE>
__device__ __forceinline__ void sp_stream(LAS unsigned char* lds, const bf16_t* Pb, int ld, int g, int qb, int qq, int tid, int r, int h, unsigned live, const LAS unsigned* selm,
                                          const bf16x8 (&qf)[4], Stage& st, f32x16& o0, f32x16& o1, float& m, float& l) {
    const int koff = (BR == 0 ? 1536 : 2048) + g * 64, voff = (BR == 0 ? 1792 : 2304) + g * 64;
    const int first = BR == 0 ? 0 : (qb > 8 ? qb - 8 : 0);
    const int n = BR == 0 ? __builtin_popcount(live) : (qb - first + 1);
    int kbK = first, kbV = first;
    if (!PRE) stage_load(st, Pb + (size_t)(first * 64) * ld + koff, Pb + (size_t)(first * 64) * ld + voff, ld, tid);
    kbK = pp_next<BR>(kbK, live); kbV = kbK;
    Stage s1; { const int kc = kbK < qb ? kbK : qb; stage_load(s1, Pb + (size_t)(kc * 64) * ld + koff, Pb + (size_t)(kc * 64) * ld + voff, ld, tid); }
    kbK = pp_next<BR>(kbK, live); kbV = kbK;
    stage_store(st, lds + L_K, lds + L_V, tid);
    st_store_k(s1.k, lds + L_K + TILEB, tid); st.v = s1.v;
    { const int kc = kbK < qb ? kbK : qb; st.k = st_load_k(Pb + (size_t)(kc * 64) * ld + koff, ld, tid); kbK = pp_next<BR>(kbK, live); }
    __syncthreads();
    f32x16 p0, p1; float mxraw = NEG; bf16x8 pb[4];
    qk(p0, p1, lds + L_K, qf, r, h);
    int kb = first, rk1 = 1, rk2 = 2;
#pragma unroll 1
    for (int i = 0; i < n; ++i) {
        if (i + 2 < n) st_store_k(st.k, lds + (rk2 == 2 ? L_PQ : L_K + rk2 * TILEB), tid);
        if (i + 1 < n) st_store_v(st.v, lds + L_V + ((i + 1) & 1) * TILEB, tid);
        { const int kc = kbK < qb ? kbK : qb, vc = kbV < qb ? kbV : qb;
          st.k = st_load_k(Pb + (size_t)(kc * 64) * ld + koff, ld, tid); st.v = st_load_v(Pb + (size_t)(vc * 64) * ld + voff, ld, tid); kbK = pp_next<BR>(kbK, live); kbV = pp_next<BR>(kbV, live); }
        bool mine = true;
        if (BR == 0) mine = (selm[qq] >> kb) & 1u;
        sp_mask<BR>(p0, p1, h, kb, qb, qq);
        f32x16 n0, n1;
        {
            const LAS unsigned char* Kt = lds + (rk1 == 2 ? L_PQ : L_K + rk1 * TILEB);
            const f32x16 z = {0.f, 0.f, 0.f, 0.f, 0.f, 0.f, 0.f, 0.f, 0.f, 0.f, 0.f, 0.f, 0.f, 0.f, 0.f, 0.f};
            bf16x8 a0[4], a1[4];
#pragma unroll
            for (int s = 0; s < 4; ++s) { a0[s] = *(const LAS bf16x8*)(Kt + r * KP + (16 * s + 8 * h) * 2); a1[s] = *(const LAS bf16x8*)(Kt + (32 + r) * KP + (16 * s + 8 * h) * 2); }
            __builtin_amdgcn_sched_barrier(0);
#pragma unroll
            for (int s = 0; s < 4; ++s) {
                n0 = __builtin_amdgcn_mfma_f32_32x32x16_bf16(a0[s], qf[s], s == 0 ? z : n0, 0, 0, 0);
                n1 = __builtin_amdgcn_mfma_f32_32x32x16_bf16(a1[s], qf[s], s == 0 ? z : n1, 0, 0, 0);
            }
            softmax_heavy(p0, p1, m, l, mxraw, mine);
            pack_p(pb, p0, p1);
#pragma unroll
            for (int j = 0; j < 8; ++j) { __builtin_amdgcn_sched_group_barrier(0x008, 1, 0); __builtin_amdgcn_sched_group_barrier(0x002, SP_FILL, 0); }
            __builtin_amdgcn_sched_barrier(0);
        }
        pv2(o0, o1, lds + L_V + (i & 1) * TILEB, pb, r, h);
        softmax_light(mxraw, m, l, o0, o1);
        p0 = n0; p1 = n1; kb = pp_next<BR>(kb, live); rk1 = rk2; rk2 = rk2 == 2 ? 0 : rk2 + 1;
        __syncthreads();
    }
}
}

__device__ __forceinline__ void phase_nsa_attn_mfma(Frame& F, int slot) {
    using namespace na;
    const bf16_t* P = WSP(bf16_t, OFF_PROJ); bf16_t* ATT = WSP(bf16_t, OFF_ATT);
    const bf16_t* KCb = WSP(bf16_t, OFF_KC); const bf16_t* VCb = KCb + (size_t)128 * 128 * 64;
    const float* gb = inptr(F, I_NSA_GATE_B) + slot * 48;
    int tid = F.tid; asm volatile("; phase-local tid" : "+v"(tid));
    const int wave = __builtin_amdgcn_readfirstlane(tid >> 6), lane = tid & 63, r = lane & 31, h = lane >> 5, hh = wave & 3, qh = wave >> 2;
    const int t256 = tid & 255;
    LAS unsigned char* lds = F.lds;
    LAS float* Pq = (LAS float*)(lds + L_PQ); LAS unsigned* selm = (LAS unsigned*)(lds + L_SEL);
    const int ld = NSA_LD;
    const int qq = qh * 32 + r;
#pragma unroll 1
    for (int it = F.bx; it < 4096; it += F.G) {
        const int sl = it & 255, rnd = it >> 8, bg = sl >> 1, par = sl & 1, qb = (rnd & 1) ? (31 - 2 * (rnd >> 1) - par) : (2 * (rnd >> 1) + par);
        const int b = bg >> 2, g = bg & 3, t = qb * 64 + qq;
        const bf16_t* Pb = P + (size_t)b * T * ld;
        const bf16_t* prow = Pb + (size_t)t * ld;
        bf16x8 qf[4];
#pragma unroll
        for (int s = 0; s < 4; ++s) qf[s] = *(const bf16x8*)(prow + g * 256 + hh * 64 + 16 * s + 8 * h);
        float gt[3];
#pragma unroll
        for (int j = 0; j < 3; ++j) gt[j] = sigmoidf_(bf2f(prow[2560 + g * 12 + hh * 3 + j]) + gb[g * 12 + hh * 3 + j]);
        LAS float* gsave = (LAS float*)(lds + L_SEL + 512) + tid * 2; gsave[0] = gt[1]; gsave[1] = gt[2];
        if (tid == 0) selm[64] = 0u;
        Stage st0, st1;
        stage_load(st0, KCb + (size_t)bg * 128 * 64, VCb + (size_t)bg * 128 * 64, 64, tid);
        stage_load(st1, KCb + (size_t)bg * 128 * 64 + 64 * 64, VCb + (size_t)bg * 128 * 64 + 64 * 64, 64, tid);
        stage_store(st0, lds + L_K, lds + L_V, tid);
        stage_store(st1, lds + L_K + TILEB, lds + L_V + TILEB, tid);
        __syncthreads();
        LAS float* oaL = (LAS float*)(lds + L_OA) + tid;
#pragma unroll 1
        for (int xr_ = 0; xr_ <= XCMP; ++xr_)
        {
            const int cmax = (t >= 31) ? (((t - 31) >> 4) < 126 ? ((t - 31) >> 4) : 126) : -1;
            f32x16 o0, o1; float m = NEG, l = 0.f;
#pragma unroll
            for (int i = 0; i < 16; ++i) { o0[i] = 0.f; o1[i] = 0.f; }
#pragma unroll 1
            for (int tl = 0; tl < 2; ++tl) {
                f32x16 p0, p1;
                qk(p0, p1, lds + L_K + tl * TILEB, qf, r, h);
#pragma unroll
                for (int i = 0; i < 16; ++i) { const int c = 64 * tl + crow(i, h); if (c > cmax) p0[i] = NEG; if (c + 32 > cmax) p1[i] = NEG; }
                softmax_step(p0, p1, m, l, o0, o1);
                pv(o0, o1, lds + L_V + tl * TILEB, p0, p1, r, h);
            }
            l += __shfl_xor(l, 32);
            const float inv = l > 0.f ? 1.0f / l : 0.f;
            const float cf = gt[0] * inv;
#pragma unroll
            for (int i = 0; i < 16; ++i) { oaL[512 * i] = cf * o0[i]; oaL[512 * (16 + i)] = cf * o1[i]; }
            const float mc = ((m < -1e29f) ? 0.f : m) * C1;
            LAS float* slab = Pq + hh * SLB + qq * 33;
#pragma unroll 1
            for (int tl = 1; tl >= 0; --tl) {
                f32x16 p0, p1;
                qk(p0, p1, lds + L_K + tl * TILEB, qf, r, h);
#pragma unroll
                for (int i = 0; i < 16; ++i) { const int c = 64 * tl + crow(i, h);
                    p0[i] = (c > cmax) ? 0.f : __builtin_amdgcn_exp2f(p0[i] * C1 - mc) * inv; p1[i] = (c + 32 > cmax) ? 0.f : __builtin_amdgcn_exp2f(p1[i] * C1 - mc) * inv; }
#pragma unroll
                for (int k = 0; k < 4; ++k) {
                    slab[16 * tl + 2 * k + h] = 2.0f * (p0[4 * k] + p0[4 * k + 1] + p0[4 * k + 2]) + p0[4 * k + 3];
                    slab[16 * tl + 8 + 2 * k + h] = 2.0f * (p1[4 * k] + p1[4 * k + 1] + p1[4 * k + 2]) + p1[4 * k + 3]; }
                LDS_WAIT();
#pragma unroll
                for (int k = 0; k < 4; ++k) { const int s0 = 16 * tl + 2 * k + h + 1, s1 = 16 * tl + 8 + 2 * k + h + 1;
                    slab[s0] += p0[4 * k + 3]; if (s1 < 32) slab[s1] += p1[4 * k + 3]; }
                LDS_WAIT();
            }
        }
        __syncthreads();
        Stage st;
        stage_load(st, Pb + 1536 + g * 64, Pb + 1792 + g * 64, ld, tid);
#pragma unroll 1
        for (int xr_ = 0; xr_ <= XSELN; ++xr_)
        {
            const int cur = qb, q = tid >> 3, sub = tid & 7;
            float scv[4];
#pragma unroll
            for (int j = 0; j < 4; ++j) { const int s_ = 4 * sub + j; const LAS float* pr = Pq + q * 33 + s_;
                const float imp = (pr[0] + pr[SLB]) + (pr[2 * SLB] + pr[3 * SLB]);
                const bool forced = (s_ == 0) || (s_ == cur) || (s_ == cur - 1);
                scv[j] = forced ? 1e30f : (s_ <= cur ? imp : NEG); }
            unsigned mask = 0u;
#pragma unroll 1
            for (int rd = 0; rd < 8; ++rd) {
                float bv = scv[0]; int bi = 4 * sub;
#pragma unroll
                for (int j = 1; j < 4; ++j) if (scv[j] > bv) { bv = scv[j]; bi = 4 * sub + j; }
#define SEL_STEP(CTRL) { const float ov = dppf<CTRL>(bv); const int oi = __float_as_int(dppf<CTRL>(__int_as_float(bi))); if (ov > bv || (ov == bv && oi < bi)) { bv = ov; bi = oi; } }
                SEL_STEP(0xB1) SEL_STEP(0x4E) SEL_STEP(0x141)
#undef SEL_STEP
                if (bv > -0.5e30f) mask |= 1u << bi;
#pragma unroll
                for (int j = 0; j < 4; ++j) if (bi == 4 * sub + j) scv[j] = -INFINITY;
            }
            if (sub == 0) selm[q] = mask;
            unsigned any = mask;
#pragma unroll
            for (int o = 8; o < 64; o <<= 1) any |= __shfl_xor(any, o);
            if (lane == 0) __hip_atomic_fetch_or(selm + 64, any, __ATOMIC_RELAXED, __HIP_MEMORY_SCOPE_WORKGROUP);
            __syncthreads();
        }
        const unsigned anymask = __builtin_amdgcn_readfirstlane(selm[64]);
        {
            f32x16 o0, o1; float m = NEG, l = 0.f;
#pragma unroll
            for (int i = 0; i < 16; ++i) { o0[i] = 0.f; o1[i] = 0.f; }
            const unsigned live = anymask & (qb == 31 ? 0xffffffffu : ((2u << qb) - 1u));
            sp_stream<0, true>(lds, Pb, ld, g, qb, qq, tid, r, h, live, selm, qf, st, o0, o1, m, l);
            l += __shfl_xor(l, 32);
            const float cf = l > 0.f ? gsave[0] / l : 0.f;
#pragma unroll
            for (int i = 0; i < 16; ++i) { oaL[512 * i] += cf * o0[i]; oaL[512 * (16 + i)] += cf * o1[i]; }
        }
        __syncthreads();
        {
            f32x16 o0, o1; float m = NEG, l = 0.f;
#pragma unroll
            for (int i = 0; i < 16; ++i) { o0[i] = 0.f; o1[i] = 0.f; }
            sp_stream<1, false>(lds, Pb, ld, g, qb, qq, tid, r, h, 0u, selm, qf, st, o0, o1, m, l);
            l += __shfl_xor(l, 32);
            const float cf = l > 0.f ? gsave[1] / l : 0.f;
#pragma unroll
            for (int i = 0; i < 16; ++i) { o0[i] = oaL[512 * i] + cf * o0[i]; o1[i] = oaL[512 * (16 + i)] + cf * o1[i]; }
            bf16_t* orow = ATT + (size_t)(b * T + t) * D + (g * 4 + hh) * 64 + 4 * h;
#pragma unroll 1
            for (int xr_ = 0; xr_ <= XOUT; ++xr_)
#pragma unroll
            for (int k = 0; k < 4; ++k) {
                u32x2 w0, w1; w0.x = pg8::cvt_pk_bf16(o0[4 * k], o0[4 * k + 1]); w0.y = pg8::cvt_pk_bf16(o0[4 * k + 2], o0[4 * k + 3]);
                w1.x = pg8::cvt_pk_bf16(o1[4 * k], o1[4 * k + 1]); w1.y = pg8::cvt_pk_bf16(o1[4 * k + 2], o1[4 * k + 3]);
                *(u32x2*)(orow + 8 * k) = w0; *(u32x2*)(orow + 32 + 8 * k) = w1;
            }
        }
        __syncthreads();
    }
}
__device__ __forceinline__ float logsigmoidf_(float x) { return fminf(x, 0.f) - log1pf(__expf(-fabsf(x))); }
__device__ __forceinline__ void phase_mlstm_scan(Frame& F) {
    constexpr int QP = 132;
    LAS float* qL = (LAS float*)F.lds;
    LAS float* kL = qL + 64 * QP;
    LAS float* vL = kL + 64 * QP;
    LAS float* SL = vL + 64 * 128;
    LAS float* vec = SL + 64 * 68;
    LAS float* bL = vec;
    LAS float* liL = vec + 64;
    LAS float* mtL = vec + 128;
    LAS float* wiL = vec + 192;
    LAS float* dnL = vec + 256;
    LAS float* wkL = vec + 320;
    LAS float* nL = vec + 384;
    LAS float* scl = vec + 512;
    LAS float* rsL = vec + 576;
    LAS float* qnL = vec + 640;
    const bf16_t* P = WSP(bf16_t, OFF_PROJ); bf16_t* HO = WSP(bf16_t, OFF_HM);
    int tid = F.tid; asm volatile("; phase-local tid" : "+v"(tid));
    const int lane = tid & 63, ld = ML_LD;
    int v_ = tid >> 2, kq = tid & 3;
    for (int item = F.bx; item < BATCH * 4 * 2; item += F.G) {
        const int vh = item & 1, h = (item >> 1) & 3, b = item >> 3;
        float C[32];
#pragma unroll
        for (int j = 0; j < 32; ++j) C[j] = 0.f;
        if (tid < 128) nL[tid] = 0.f;
        if (tid == 0) scl[0] = 0.f;
        __syncthreads();
#pragma unroll 1
        for (int ch = 0; ch < T / 64; ++ch) {
            asm volatile("; chunk-local" : "+v"(v_), "+v"(kq), "+v"(tid));
            const int t0 = ch * 64; const bf16_t* Pc = P + (size_t)(b * T + t0) * ld;
            {
                const int c2 = tid & 255, part = tid >> 8;
                const int col = (c2 < 128) ? (h * 128 + c2) : (512 + h * 128 + (c2 - 128));
                const float w0 = inptr(F, I_ML_CONV_W)[0 * 1024 + col], w1 = inptr(F, I_ML_CONV_W)[1 * 1024 + col], w2 = inptr(F, I_ML_CONV_W)[2 * 1024 + col], w3 = inptr(F, I_ML_CONV_W)[3 * 1024 + col], cb = inptr(F, I_ML_CONV_B)[col];
                const float scale = (c2 < 128) ? 1.0f : 0.08838834764831845f;
                const int r0 = part * 32;
                float x0 = (t0 + r0 - 3 >= 0) ? bf2f(Pc[(long)(r0 - 3) * ld + col]) : 0.f;
                float x1 = (t0 + r0 - 2 >= 0) ? bf2f(Pc[(long)(r0 - 2) * ld + col]) : 0.f;
                float x2 = (t0 + r0 - 1 >= 0) ? bf2f(Pc[(long)(r0 - 1) * ld + col]) : 0.f;
                LAS float* dst = (c2 < 128) ? (qL + c2) : (kL + (c2 - 128));
                for (int r = r0; r < r0 + 32; ++r) { const float x3 = bf2f(Pc[(long)r * ld + col]);
                    const float y = w0 * x0 + w1 * x1 + w2 * x2 + w3 * x3 + cb; dst[r * QP] = y * sigmoidf_(y) * scale; x0 = x1; x1 = x2; x2 = x3; }
                const int vc = tid & 127, vp = tid >> 7;
                for (int r = vp * 16; r < vp * 16 + 16; ++r) vL[r * 128 + vc] = bf2f(Pc[(long)r * ld + 1024 + h * 256 + vh * 128 + vc]);
                if (tid < 64) { liL[tid] = bf2f(Pc[(long)tid * ld + 3072 + h]) + inptr(F, I_ML_GATE_B)[h];
                    bL[tid] = logsigmoidf_(bf2f(Pc[(long)tid * ld + 3076 + h]) + inptr(F, I_ML_GATE_B)[4 + h]); }
            }
            __syncthreads();
            if (tid < 64) {
                float bb = bL[lane];
#pragma unroll
                for (int o = 1; o < 64; o <<= 1) { const float u = __shfl_up(bb, o); if (lane >= o) bb += u; }
                const float li = liL[lane]; float pm = li - bb;
#pragma unroll
                for (int o = 1; o < 64; o <<= 1) { const float u = __shfl_up(pm, o); if (lane >= o) pm = fmaxf(pm, u); }
                const float mprev = scl[0];
                const float mt = fmaxf(bb + mprev, bb + pm);
                const float bend = __shfl(bb, 63);
                const float decay = bend - bb + li;
                const float mnew = fmaxf(bend + mprev, wave_max(decay));
                bL[lane] = bb; mtL[lane] = mt; wiL[lane] = __expf(bb + mprev - mt); wkL[lane] = __expf(decay - mnew);
                if (lane == 0) { scl[1] = __expf(bend + mprev - mnew); scl[2] = mnew; }
            }
            __syncthreads();
            {
                const int t = tid >> 3, sg = tid & 7;
                float a[8];
#pragma unroll
                for (int j = 0; j < 8; ++j) a[j] = 0.f;
#pragma unroll 1
                for (int k4 = 0; k4 < 32; ++k4) { const f32x4 qv = *(const LAS f32x4*)(qL + t * QP + k4 * 4);
#pragma unroll
                    for (int j = 0; j < 8; ++j) { const f32x4 kv = *(const LAS f32x4*)(kL + (sg + 8 * j) * QP + k4 * 4); a[j] += (qv[0] * kv[0] + qv[1] * kv[1]) + (qv[2] * kv[2] + qv[3] * kv[3]); } }
                const float bt = bL[t], mt = mtL[t];
#pragma unroll
                for (int j = 0; j < 8; ++j) { const int s = sg + 8 * j; SL[t * 68 + s] = (s <= t) ? a[j] * __expf(bt - bL[s] + liL[s] - mt) : 0.f; }
            }
            __syncthreads();
            if (tid < 64) { float rs = 0.f; for (int s = 0; s < 64; ++s) rs += SL[tid * 68 + s]; rsL[tid] = rs; }
            else if (tid < 128) { const int t = tid - 64; float qn = 0.f; for (int k = 0; k < 128; ++k) qn += qL[t * QP + k] * nL[k]; qnL[t] = qn; }
            __syncthreads();
            if (tid < 64) { const float den = rsL[tid] + wiL[tid] * qnL[tid]; dnL[tid] = 1.0f / fmaxf(fabsf(den), __expf(-mtL[tid])); }
            __syncthreads();
            {
                float vr[16];
#pragma unroll
                for (int j = 0; j < 16; ++j) vr[j] = vL[(kq * 16 + j) * 128 + v_];
#pragma unroll 1
                for (int tg = 0; tg < 4; ++tg) {
                    float res[4];
#pragma unroll
                    for (int ti = 0; ti < 16; ++ti) { const int t = tg * 16 + ti;
                        float aC = 0.f, aS = 0.f;
#pragma unroll
                        for (int j4 = 0; j4 < 8; ++j4) { const f32x4 qv = *(const LAS f32x4*)(qL + t * QP + kq * 32 + j4 * 4);
                            aC += (qv[0] * C[j4 * 4] + qv[1] * C[j4 * 4 + 1]) + (qv[2] * C[j4 * 4 + 2] + qv[3] * C[j4 * 4 + 3]); }
#pragma unroll
                        for (int j4 = 0; j4 < 4; ++j4) { const f32x4 sv = *(const LAS f32x4*)(SL + t * 68 + kq * 16 + j4 * 4);
                            aS += (sv[0] * vr[j4 * 4] + sv[1] * vr[j4 * 4 + 1]) + (sv[2] * vr[j4 * 4 + 2] + sv[3] * vr[j4 * 4 + 3]); }
                        float tot = aS + wiL[t] * aC;
                        tot += __shfl_xor(tot, 1); tot += __shfl_xor(tot, 2);
                        tot *= dnL[t];
                        if ((ti & 3) == kq) res[ti >> 2] = tot;
                        asm volatile("" ::: "memory");
                    }
#pragma unroll
                    for (int q = 0; q < 4; ++q) { const int t = tg * 16 + q * 4 + kq; HO[(size_t)(b * T + t0 + t) * D + h * 256 + vh * 128 + v_] = (bf16_t)f2bf(res[q]); }
                }
            }
            __syncthreads();
            {
                const float cs = scl[1];
#pragma unroll
                for (int j = 0; j < 32; ++j) C[j] *= cs;
#pragma unroll 2
                for (int s = 0; s < 64; ++s) { const float a = vL[s * 128 + v_] * wkL[s];
#pragma unroll
                    for (int j4 = 0; j4 < 8; ++j4) { const f32x4 kv = *(const LAS f32x4*)(kL + s * QP + kq * 32 + j4 * 4);
                        C[j4 * 4] += a * kv[0]; C[j4 * 4 + 1] += a * kv[1]; C[j4 * 4 + 2] += a * kv[2]; C[j4 * 4 + 3] += a * kv[3]; } }
                if (tid < 128) { float nn = nL[tid] * cs; for (int s = 0; s < 64; ++s) nn += wkL[s] * kL[s * QP + tid]; nL[tid] = nn; }
                if (tid == 0) scl[0] = scl[2];
            }
            __syncthreads();
        }
    }
}
template <int HD>
__device__ __forceinline__ void phase_norm_gate(Frame& F, const float* norm_g, int ld, int gate_col0) {
    const bf16_t* HI = WSP(bf16_t, OFF_HM); const bf16_t* P = WSP(bf16_t, OFF_PROJ); bf16_t* ATT = WSP(bf16_t, OFF_ATT);
    int lane = F.lane; asm volatile("; phase-local lane" : "+v"(lane)); const int gw = F.bx * 8 + F.wave, NGW = F.G * 8;
    u32x2 hq[4], gq[4];
    if (gw < NTOK) { const u32x2* hr = (const u32x2*)(HI + (size_t)gw * D) + lane; const u32x2* gr = (const u32x2*)(P + (size_t)gw * ld + gate_col0) + lane;
#pragma unroll
        for (int j = 0; j < 4; ++j) { hq[j] = hr[64 * j]; gq[j] = gr[64 * j]; } }
#pragma unroll 1
    for (int m = gw; m < NTOK; m += NGW) {
        u32x2 hc[4], gc[4];
#pragma unroll
        for (int j = 0; j < 4; ++j) { hc[j] = hq[j]; gc[j] = gq[j]; }
        if (m + NGW < NTOK) { const u32x2* hr = (const u32x2*)(HI + (size_t)(m + NGW) * D) + lane; const u32x2* gr = (const u32x2*)(P + (size_t)(m + NGW) * ld + gate_col0) + lane;
#pragma unroll
            for (int j = 0; j < 4; ++j) { hq[j] = hr[64 * j]; gq[j] = gr[64 * j]; } }
        u32x2* orow = (u32x2*)(ATT + (size_t)m * D) + lane;
#pragma unroll
        for (int j = 0; j < 4; ++j) {
            const u32x2 hv = hc[j], gv = gc[j];
            float x[4] = {__uint_as_float(hv.x << 16), __uint_as_float(hv.x & 0xffff0000u), __uint_as_float(hv.y << 16), __uint_as_float(hv.y & 0xffff0000u)};
            const float gt[4] = {__uint_as_float(gv.x << 16), __uint_as_float(gv.x & 0xffff0000u), __uint_as_float(gv.y << 16), __uint_as_float(gv.y & 0xffff0000u)};
            float ss = (x[0] * x[0] + x[1] * x[1]) + (x[2] * x[2] + x[3] * x[3]);
#pragma unroll
            for (int o = 1; o < (HD == 256 ? 64 : 32); o <<= 1) ss += __shfl_xor(ss, o);
            const float r = __builtin_amdgcn_rsqf(ss * (1.0f / HD) + RMS_EPS);
            const f32x4 ng = *((const f32x4*)norm_g + lane + 64 * j);
            float o4[4];
#pragma unroll
            for (int q = 0; q < 4; ++q) o4[q] = x[q] * r * ng[q] * sigmoidf_(gt[q]);
            u32x2 o; o.x = pk2(o4[0], o4[1]); o.y = pk2(o4[2], o4[3]); orow[64 * j] = o;
        }
    }
}

__device__ __forceinline__ void phase_hgrn_scan(Frame& F) {
    constexpr int QP = 132;
    LAS float* qL = (LAS float*)F.lds;
    LAS float* kL = qL + 32 * QP;
    LAS float* vL = kL + 32 * QP;
    LAS float* AL = vL + 32 * 128;
    LAS float* geL = AL + 32 * 36;
    const bf16_t* P = WSP(bf16_t, OFF_PROJ); bf16_t* HO = WSP(bf16_t, OFF_HM);
    const float* lbt = WSP(float, OFF_TAB) + TAB_LB;
    int tid = F.tid; asm volatile("; phase-local tid" : "+v"(tid));
    const int ld = HG_LD;
    int v_ = tid >> 2, kq = tid & 3;
    for (int item = F.bx; item < BATCH * 8; item += F.G) {
        const int h = item & 7, b = item >> 3;
        float S[32];
#pragma unroll
        for (int j = 0; j < 32; ++j) S[j] = 0.f;
#pragma unroll 1
        for (int ch = 0; ch < T / 32; ++ch) {
            asm volatile("; chunk-local" : "+v"(v_), "+v"(kq), "+v"(tid));
            const int t0 = ch * 32; const bf16_t* Pc = P + (size_t)(b * T + t0) * ld;
            { const int c = tid & 127, p4 = tid >> 7;
#pragma unroll 2
              for (int r = p4 * 8; r < p4 * 8 + 8; ++r) { qL[r * QP + c] = bf2f(Pc[(long)r * ld + h * 128 + c]); kL[r * QP + c] = bf2f(Pc[(long)r * ld + 1024 + h * 128 + c]); vL[r * 128 + c] = bf2f(Pc[(long)r * ld + 2048 + h * 128 + c]); } }
            __syncthreads();
            if (tid < 128) { const float lb = lbt[h * 128 + tid]; float G = 0.f;
#pragma unroll 2
                for (int r = 0; r < 32; ++r) { const float qr = qL[r * QP + tid], fr = kL[r * QP + tid];
                    const float f = lb + (1.0f - lb) * sigmoidf_(fr); G += __logf(f);
                    qL[r * QP + tid] = qr * sigmoidf_(qr) * __expf(G); kL[r * QP + tid] = (1.0f - f) * __expf(-G); }
                geL[tid] = __expf(G); }
            __syncthreads();
            { const int t = tid >> 4, sg = tid & 15;
              float a0 = 0.f, a1 = 0.f;
#pragma unroll 2
              for (int k4 = 0; k4 < 32; ++k4) { const f32x4 qv = *(const LAS f32x4*)(qL + t * QP + k4 * 4);
                  const f32x4 k0 = *(const LAS f32x4*)(kL + sg * QP + k4 * 4), k1 = *(const LAS f32x4*)(kL + (sg + 16) * QP + k4 * 4);
                  a0 += (qv[0] * k0[0] + qv[1] * k0[1]) + (qv[2] * k0[2] + qv[3] * k0[3]); a1 += (qv[0] * k1[0] + qv[1] * k1[1]) + (qv[2] * k1[2] + qv[3] * k1[3]); }
              AL[t * 36 + sg] = (sg <= t) ? a0 : 0.f; AL[t * 36 + sg + 16] = (sg + 16 <= t) ? a1 : 0.f; }
            __syncthreads();
            {
                float vr[8];
#pragma unroll
                for (int j = 0; j < 8; ++j) vr[j] = vL[(kq * 8 + j) * 128 + v_];
#pragma unroll 2
                for (int t = 0; t < 32; ++t) {
                    float a = 0.f;
#pragma unroll
                    for (int j4 = 0; j4 < 8; ++j4) { const f32x4 qv = *(const LAS f32x4*)(qL + t * QP + kq * 32 + j4 * 4);
                        a += (qv[0] * S[j4 * 4] + qv[1] * S[j4 * 4 + 1]) + (qv[2] * S[j4 * 4 + 2] + qv[3] * S[j4 * 4 + 3]); }
#pragma unroll
                    for (int j4 = 0; j4 < 2; ++j4) { const f32x4 sv = *(const LAS f32x4*)(AL + t * 36 + kq * 8 + j4 * 4);
                        a += (sv[0] * vr[j4 * 4] + sv[1] * vr[j4 * 4 + 1]) + (sv[2] * vr[j4 * 4 + 2] + sv[3] * vr[j4 * 4 + 3]); }
                    a += __shfl_xor(a, 1); a += __shfl_xor(a, 2);
                    if ((t & 3) == kq) HO[(size_t)(b * T + t0 + t) * D + h * 128 + v_] = (bf16_t)f2bf(a);
                    asm volatile("" ::: "memory");
                }
            }
            {
#pragma unroll 2
                for (int s = 0; s < 32; ++s) { const float a = vL[s * 128 + v_];
#pragma unroll
                    for (int j4 = 0; j4 < 8; ++j4) { const f32x4 kv = *(const LAS f32x4*)(kL + s * QP + kq * 32 + j4 * 4);
                        S[j4 * 4] += a * kv[0]; S[j4 * 4 + 1] += a * kv[1]; S[j4 * 4 + 2] += a * kv[2]; S[j4 * 4 + 3] += a * kv[3]; } }
#pragma unroll
                for (int j4 = 0; j4 < 8; ++j4) { const f32x4 ge = *(const LAS f32x4*)(geL + kq * 32 + j4 * 4);
                    S[j4 * 4] *= ge[0]; S[j4 * 4 + 1] *= ge[1]; S[j4 * 4 + 2] *= ge[2]; S[j4 * 4 + 3] *= ge[3]; }
            }
            __syncthreads();
        }
    }
}
namespace ml {
constexpr int PK = 272, PS = 144;
constexpr int L_Q = 0, L_KK = L_Q + 64 * PK, L_KWT = L_KK + 64 * PK, L_VT = L_KWT + 128 * PS, L_S = L_VT + 144 * PS, L_C = L_S + 64 * PS, L_VEC = L_C + 144 * PK;
typedef float f32x4_ __attribute__((ext_vector_type(4)));
__device__ __forceinline__ bf16x8 frag(const LAS unsigned char* base, int row, int pitch, int kelem) { return *(const LAS bf16x8*)(base + row * pitch + kelem * 2); }
}
__device__ __forceinline__ void phase_mlstm_scan_mfma(Frame& F) {
    using namespace ml;
    LAS unsigned char* lds = F.lds;
    LAS float* vec = (LAS float*)(lds + L_VEC);
    LAS float* bL = vec; LAS float* liL = vec + 64; LAS float* mtL = vec + 128; LAS float* wiL = vec + 192; LAS float* wkL = vec + 256; LAS float* scl = vec + 320;
    const bf16_t* P = WSP(bf16_t, OFF_PROJ); bf16_t* HO = WSP(bf16_t, OFF_HM);
    int tid = F.tid; asm volatile("; phase-local tid" : "+v"(tid));
    const int lane = tid & 63, wave = __builtin_amdgcn_readfirstlane(tid >> 6), ld = ML_LD;
    const int fr = lane & 15, fg = lane >> 4;
#pragma unroll 1
    for (int item = F.bx; item < BATCH * 4 * 2; item += F.G) {
        const int vh = item & 1, h = (item >> 1) & 3, b = item >> 3;
        f32x4 Cacc[9];
#pragma unroll
        for (int j = 0; j < 9; ++j) Cacc[j] = (f32x4){0.f, 0.f, 0.f, 0.f};
        for (int i = tid; i < 16 * 64; i += 512) { const int rr = i >> 6, s = i & 63; *(LAS unsigned short*)(lds + L_VT + (128 + rr) * PS + s * 2) = (rr == 0) ? (unsigned short)0x3F80 : (unsigned short)0; }
        for (int i = tid; i < 144 * PK / 4; i += 512) ((LAS unsigned*)(lds + L_C))[i] = 0u;
        if (tid == 0) scl[0] = 0.f;
        const int c2 = tid & 255, part = __builtin_amdgcn_readfirstlane(tid >> 8);
        const int col = (c2 < 128) ? (h * 128 + c2) : (512 + h * 128 + (c2 - 128));
        const float* cw = inptr(F, I_ML_CONV_W); const float* cbp = inptr(F, I_ML_CONV_B); const float* gbp = inptr(F, I_ML_GATE_B);
        const float w0 = cw[0 * 1024 + col], w1 = cw[1 * 1024 + col], w2 = cw[2 * 1024 + col], w3 = cw[3 * 1024 + col], cb = cbp[col];
        const float gbi = gbp[h], gbf = gbp[4 + h];
        const float qscale = (c2 < 128) ? 1.0f : 0.08838834764831845f;
        unsigned short xn[35]; u32x4 vn[2]; unsigned short gin = 0, gfn = 0;
        { const bf16_t* Pc = P + (size_t)(b * T) * ld; const int r0 = part * 32;
          const bf16_t* rp = Pc + (long)(r0 - 3) * ld;
#pragma unroll
          for (int i = 0; i < 35; ++i) { xn[i] = (r0 - 3 + i >= 0) ? rp[col] : (unsigned short)0; rp += ld; asm volatile("" : "+s"(rp)); }
          const int key = tid >> 3, dc = tid & 7;
#pragma unroll
          for (int q = 0; q < 2; ++q) vn[q] = *(const u32x4*)(Pc + (long)key * ld + 1024 + h * 256 + vh * 128 + (dc + 8 * q) * 8);
          if (wave == 0) { gin = Pc[(long)lane * ld + 3072 + h]; gfn = Pc[(long)lane * ld + 3076 + h]; } }
        __syncthreads();
#pragma unroll 1
        for (int ch = 0; ch < T / 64; ++ch) {
            const int t0 = ch * 64; const bf16_t* Pc = P + (size_t)(b * T + t0) * ld;
            if (wave == 0) {
                const float li = bf2f(gin) + gbi;
                float bb = logsigmoidf_(bf2f(gfn) + gbf);
#pragma unroll
                for (int o = 1; o < 64; o <<= 1) { const float u = __shfl_up(bb, o); if (lane >= o) bb += u; }
                float pm = li - bb;
#pragma unroll
                for (int o = 1; o < 64; o <<= 1) { const float u = __shfl_up(pm, o); if (lane >= o) pm = fmaxf(pm, u); }
                const float mprev = scl[0];
                const float mt = fmaxf(bb + mprev, bb + pm);
                const float bend = __shfl(bb, 63);
                const float decay = bend - bb + li;
                const float mnew = fmaxf(bend + mprev, wave_max(decay));
                bL[lane] = bb; liL[lane] = li; mtL[lane] = mt; wiL[lane] = __expf(bb + mprev - mt); wkL[lane] = __expf(decay - mnew);
                if (lane == 0) { scl[1] = __expf(bend + mprev - mnew); scl[2] = mnew; }
            }
            __syncthreads();
            {
                const int r0 = part * 32;
                LAS unsigned char* rowbase = lds + ((c2 < 128) ? L_Q : L_KK) + (c2 & 127) * 2;
#pragma unroll
                for (int i = 0; i < 32; ++i) { const int rr = r0 + i;
                    const float y = w0 * bf2f(xn[i]) + w1 * bf2f(xn[i + 1]) + w2 * bf2f(xn[i + 2]) + w3 * bf2f(xn[i + 3]) + cb; const float o = y * sigmoidf_(y) * qscale;
                    *(LAS unsigned short*)(rowbase + rr * PK) = (unsigned short)f2bf(o);
                    if (c2 >= 128) *(LAS unsigned short*)(lds + L_KWT + (c2 - 128) * PS + rr * 2) = (unsigned short)f2bf(o * wkL[rr]);
                    if ((i & 3) == 3) asm volatile("" ::: "memory"); }
                const int key = tid >> 3, dc = tid & 7;
#pragma unroll
                for (int q = 0; q < 2; ++q) { const unsigned w[4] = {vn[q].x, vn[q].y, vn[q].z, vn[q].w};
#pragma unroll
                    for (int e = 0; e < 4; ++e) { const int vrow = (dc + 8 * q) * 8 + 2 * e;
                        *(LAS unsigned short*)(lds + L_VT + vrow * PS + key * 2) = (unsigned short)(w[e] & 0xffffu); *(LAS unsigned short*)(lds + L_VT + (vrow + 1) * PS + key * 2) = (unsigned short)(w[e] >> 16); } }
            }
            if (ch + 1 < T / 64) {
                const bf16_t* Pn = Pc + (size_t)64 * ld; const int r0 = part * 32;
                const bf16_t* rp = Pn + (long)(r0 - 3) * ld;
#pragma unroll
                for (int i = 0; i < 35; ++i) { xn[i] = rp[col]; rp += ld; asm volatile("" : "+s"(rp)); }
                const int key = tid >> 3, dc = tid & 7;
#pragma unroll
                for (int q = 0; q < 2; ++q) vn[q] = *(const u32x4*)(Pn + (long)key * ld + 1024 + h * 256 + vh * 128 + (dc + 8 * q) * 8);
                if (wave == 0) { gin = Pn[(long)lane * ld + 3072 + h]; gfn = Pn[(long)lane * ld + 3076 + h]; }
            }
            __syncthreads();
#pragma unroll
            for (int q = 0; q < 2; ++q) {
                const int idx = 2 * wave + q, ti = idx >> 2, tj = idx & 3;
                f32x4 a = (f32x4){0.f, 0.f, 0.f, 0.f};
                if (ti <= tj) {
#pragma unroll
                    for (int ks = 0; ks < 4; ++ks) a = __builtin_amdgcn_mfma_f32_16x16x32_bf16(frag(lds + L_KK, 16 * ti + fr, PK, 32 * ks + 8 * fg), frag(lds + L_Q, 16 * tj + fr, PK, 32 * ks + 8 * fg), a, 0, 0, 0);
                    const int t = 16 * tj + fr; const float bt = bL[t], mt = mtL[t];
#pragma unroll
                    for (int e = 0; e < 4; ++e) { const int s = 16 * ti + 4 * fg + e; a[e] = (s <= t) ? a[e] * __expf(bt - bL[s] + liL[s] - mt) : 0.f; }
                }
                u32x2 w; w.x = pg8::cvt_pk_bf16(a[0], a[1]); w.y = pg8::cvt_pk_bf16(a[2], a[3]);
                *(LAS u32x2*)(lds + L_S + (16 * tj + fr) * PS + (16 * ti + 4 * fg) * 2) = w;
            }
            __syncthreads();
            {
#pragma unroll 1
                for (int tj = 0; tj < 4; ++tj) {
                    f32x4 a1 = (f32x4){0.f, 0.f, 0.f, 0.f}, a2 = a1, d1 = a1, d2 = a1;
#pragma unroll
                    for (int ks = 0; ks < 2; ++ks) { const bf16x8 bs = frag(lds + L_S, 16 * tj + fr, PS, 32 * ks + 8 * fg);
                        a1 = __builtin_amdgcn_mfma_f32_16x16x32_bf16(frag(lds + L_VT, 16 * wave + fr, PS, 32 * ks + 8 * fg), bs, a1, 0, 0, 0);
                        d1 = __builtin_amdgcn_mfma_f32_16x16x32_bf16(frag(lds + L_VT, 128 + fr, PS, 32 * ks + 8 * fg), bs, d1, 0, 0, 0); }
#pragma unroll
                    for (int ks = 0; ks < 4; ++ks) { const bf16x8 bq = frag(lds + L_Q, 16 * tj + fr, PK, 32 * ks + 8 * fg);
                        a2 = __builtin_amdgcn_mfma_f32_16x16x32_bf16(frag(lds + L_C, 16 * wave + fr, PK, 32 * ks + 8 * fg), bq, a2, 0, 0, 0);
                        d2 = __builtin_amdgcn_mfma_f32_16x16x32_bf16(frag(lds + L_C, 128 + fr, PK, 32 * ks + 8 * fg), bq, d2, 0, 0, 0); }
                    const int t = 16 * tj + fr; const float wi = wiL[t];
                    float den = d1[0] + wi * d2[0];
                    den = __shfl(den, fr);
                    const float inv = __builtin_amdgcn_rcpf(fmaxf(fabsf(den), __expf(-mtL[t])));
                    u32x2 w; w.x = pg8::cvt_pk_bf16((a1[0] + wi * a2[0]) * inv, (a1[1] + wi * a2[1]) * inv); w.y = pg8::cvt_pk_bf16((a1[2] + wi * a2[2]) * inv, (a1[3] + wi * a2[3]) * inv);
                    *(u32x2*)(HO + (size_t)(b * T + t0 + t) * D + h * 256 + vh * 128 + 16 * wave + 4 * fg) = w;
                }
            }
            __syncthreads();
            {
                const float cs = scl[1];
                const bf16x8 ka0 = frag(lds + L_KWT, 16 * wave + fr, PS, 8 * fg), ka1 = frag(lds + L_KWT, 16 * wave + fr, PS, 32 + 8 * fg);
#pragma unroll
                for (int j = 0; j < 9; ++j) {
                    Cacc[j] = Cacc[j] * cs;
                    Cacc[j] = __builtin_amdgcn_mfma_f32_16x16x32_bf16(ka0, frag(lds + L_VT, 16 * j + fr, PS, 8 * fg), Cacc[j], 0, 0, 0);
                    Cacc[j] = __builtin_amdgcn_mfma_f32_16x16x32_bf16(ka1, frag(lds + L_VT, 16 * j + fr, PS, 32 + 8 * fg), Cacc[j], 0, 0, 0);
                    u32x2 w; w.x = pg8::cvt_pk_bf16(Cacc[j][0], Cacc[j][1]); w.y = pg8::cvt_pk_bf16(Cacc[j][2], Cacc[j][3]);
                    *(LAS u32x2*)(lds + L_C + (16 * j + fr) * PK + (16 * wave + 4 * fg) * 2) = w;
                }
                if (tid == 0) scl[0] = scl[2];
            }
            __syncthreads();
        }
    }
}
namespace hg {
constexpr int PK = 272, PS = 144;
constexpr int L_QD = 0, L_KD = L_QD + 64 * PK, L_KDT = L_KD + 64 * PK, L_VT = L_KDT + 128 * PS, L_A = L_VT + 128 * PS, L_ST = L_A + 64 * PS, L_TOT = L_ST + 128 * PK, L_GE = L_TOT + 4 * 128 * 4, L_SSQ = L_GE + 128 * 4;
__device__ __forceinline__ bf16x8 frag(const LAS unsigned char* base, int row, int pitch, int kelem) { return *(const LAS bf16x8*)(base + row * pitch + kelem * 2); }
}
__device__ __forceinline__ void phase_hgrn_scan_mfma(Frame& F) {
    using namespace hg;
    LAS unsigned char* lds = F.lds;
    LAS float* totL = (LAS float*)(lds + L_TOT); LAS float* geL = (LAS float*)(lds + L_GE);
    const bf16_t* P = WSP(bf16_t, OFF_PROJ); bf16_t* ATT = WSP(bf16_t, OFF_ATT);
    const float* lbt = WSP(float, OFF_TAB) + TAB_LB; const float* norm_g = inptr(F, I_HG_NORM_G);
    LAS float* ssqL = (LAS float*)(F.lds + hg::L_SSQ);
    int tid = F.tid; asm volatile("; phase-local tid" : "+v"(tid));
    const int lane = tid & 63, wave = __builtin_amdgcn_readfirstlane(tid >> 6), ld = HG_LD;
    const int fr = lane & 15, fg = lane >> 4;
    const int kc = tid & 127, part = __builtin_amdgcn_readfirstlane(tid >> 7);
    const int vkey = tid >> 3, vdc = tid & 7;
#pragma unroll 1
    for (int item = F.bx; item < BATCH * 8; item += F.G) {
        const int h = item & 7, b = item >> 3;
        f32x4 Sacc[8];
#pragma unroll
        for (int j = 0; j < 8; ++j) Sacc[j] = (f32x4){0.f, 0.f, 0.f, 0.f};
        for (int i = tid; i < 128 * PK / 4; i += 512) ((LAS unsigned*)(lds + L_ST))[i] = 0u;
        const float lb = lbt[h * 128 + kc];
        const f32x4 ngv = *(const f32x4*)(norm_g + h * 128 + 16 * wave + 4 * fg);
        unsigned short qn[16], fn[16]; u32x4 vn[2];
        { const bf16_t* Pc = P + (size_t)(b * T) * ld;
          const bf16_t* rp = Pc + (long)(16 * part) * ld + h * 128;
#pragma unroll
          for (int i = 0; i < 16; ++i) { qn[i] = rp[kc]; fn[i] = rp[1024 + kc]; rp += ld; asm volatile("" : "+s"(rp)); }
#pragma unroll
          for (int q = 0; q < 2; ++q) vn[q] = *(const u32x4*)(Pc + (long)vkey * ld + 2048 + h * 128 + (vdc + 8 * q) * 8); }
        __syncthreads();
#pragma unroll 1
        for (int ch = 0; ch < T / 64; ++ch) {
            const int t0 = ch * 64;
            float qs[16], kk[16], G[16]; u32x4 vv[2];
            {
                float run = 0.f;
#pragma unroll
                for (int i = 0; i < 16; ++i) { const float qr = bf2f(qn[i]), fraw = bf2f(fn[i]);
                    const float f = lb + (1.0f - lb) * sigmoidf_(fraw);
                    run += __logf(f); G[i] = run; qs[i] = qr * sigmoidf_(qr); kk[i] = 1.0f - f; }
                totL[part * 128 + kc] = run; vv[0] = vn[0]; vv[1] = vn[1];
            }
            __syncthreads();
            if (ch + 1 < T / 64) {
                const bf16_t* Pn = P + (size_t)(b * T + t0 + 64) * ld;
                const bf16_t* rp = Pn + (long)(16 * part) * ld + h * 128;
#pragma unroll
                for (int i = 0; i < 16; ++i) { qn[i] = rp[kc]; fn[i] = rp[1024 + kc]; rp += ld; asm volatile("" : "+s"(rp)); }
#pragma unroll
                for (int q = 0; q < 2; ++q) vn[q] = *(const u32x4*)(Pn + (long)vkey * ld + 2048 + h * 128 + (vdc + 8 * q) * 8);
            }
            {
                float off = 0.f, tot = 0.f;
#pragma unroll
                for (int p = 0; p < 4; ++p) { const float tp = totL[p * 128 + kc]; if (p < part) off += tp; tot += tp; }
                if (part == 3) geL[kc] = __expf(tot);
#pragma unroll
                for (int i = 0; i < 16; ++i) { const int r = 16 * part + i; const float g = G[i] + off;
                    const unsigned short qd = (unsigned short)f2bf(qs[i] * __expf(g)), kd = (unsigned short)f2bf(kk[i] * __expf(-g));
                    *(LAS unsigned short*)(lds + L_QD + r * PK + kc * 2) = qd; *(LAS unsigned short*)(lds + L_KD + r * PK + kc * 2) = kd; *(LAS unsigned short*)(lds + L_KDT + kc * PS + r * 2) = kd; }
#pragma unroll
                for (int q = 0; q < 2; ++q) { const unsigned w[4] = {vv[q].x, vv[q].y, vv[q].z, vv[q].w};
#pragma unroll
                    for (int e = 0; e < 4; ++e) { const int vrow = (vdc + 8 * q) * 8 + 2 * e;
                        *(LAS unsigned short*)(lds + L_VT + vrow * PS + vkey * 2) = (unsigned short)(w[e] & 0xffffu); *(LAS unsigned short*)(lds + L_VT + (vrow + 1) * PS + vkey * 2) = (unsigned short)(w[e] >> 16); } }
            }
            __syncthreads();
#pragma unroll
            for (int q = 0; q < 2; ++q) {
                const int idx = 2 * wave + q, ti = idx >> 2, tj = idx & 3;
                f32x4 a = (f32x4){0.f, 0.f, 0.f, 0.f};
                if (ti <= tj) {
#pragma unroll
                    for (int ks = 0; ks < 4; ++ks) a = __builtin_amdgcn_mfma_f32_16x16x32_bf16(frag(lds + L_KD, 16 * ti + fr, PK, 32 * ks + 8 * fg), frag(lds + L_QD, 16 * tj + fr, PK, 32 * ks + 8 * fg), a, 0, 0, 0);
                    const int t = 16 * tj + fr;
#pragma unroll
                    for (int e = 0; e < 4; ++e) { const int s = 16 * ti + 4 * fg + e; a[e] = (s <= t) ? a[e] : 0.f; }
                }
                u32x2 w; w.x = pg8::cvt_pk_bf16(a[0], a[1]); w.y = pg8::cvt_pk_bf16(a[2], a[3]);
                *(LAS u32x2*)(lds + L_A + (16 * tj + fr) * PS + (16 * ti + 4 * fg) * 2) = w;
            }
            __syncthreads();
            f32x4 ot[4]; u32x2 gq[4];
            const bf16_t* Pg = P + (size_t)(b * T + t0) * ld + 3072 + h * 128 + 16 * wave + 4 * fg;
#pragma unroll
            for (int tj = 0; tj < 4; ++tj) {
                f32x4 a = (f32x4){0.f, 0.f, 0.f, 0.f};
                gq[tj] = *(const u32x2*)(Pg + (size_t)(16 * tj + fr) * ld);
#pragma unroll
                for (int ks = 0; ks < 2; ++ks) a = __builtin_amdgcn_mfma_f32_16x16x32_bf16(frag(lds + L_VT, 16 * wave + fr, PS, 32 * ks + 8 * fg), frag(lds + L_A, 16 * tj + fr, PS, 32 * ks + 8 * fg), a, 0, 0, 0);
#pragma unroll
                for (int ks = 0; ks < 4; ++ks) a = __builtin_amdgcn_mfma_f32_16x16x32_bf16(frag(lds + L_ST, 16 * wave + fr, PK, 32 * ks + 8 * fg), frag(lds + L_QD, 16 * tj + fr, PK, 32 * ks + 8 * fg), a, 0, 0, 0);
                ot[tj] = a;
                float ss = (a[0] * a[0] + a[1] * a[1]) + (a[2] * a[2] + a[3] * a[3]);
                ss += __shfl_xor(ss, 16); ss += __shfl_xor(ss, 32);
                if (fg == 0) ssqL[wave * 64 + 16 * tj + fr] = ss;
            }
            __syncthreads();
#pragma unroll
            for (int tj = 0; tj < 4; ++tj) {
                const int t = 16 * tj + fr; float tot = 0.f;
#pragma unroll
                for (int w8 = 0; w8 < 8; ++w8) tot += ssqL[w8 * 64 + t];
                const float rr = __builtin_amdgcn_rsqf(tot * (1.0f / 128.0f) + RMS_EPS);
                const float g0 = __uint_as_float(gq[tj].x << 16), g1 = __uint_as_float(gq[tj].x & 0xffff0000u), g2 = __uint_as_float(gq[tj].y << 16), g3 = __uint_as_float(gq[tj].y & 0xffff0000u);
                u32x2 w; w.x = pg8::cvt_pk_bf16(ot[tj][0] * rr * ngv[0] * sigmoidf_(g0), ot[tj][1] * rr * ngv[1] * sigmoidf_(g1));
                w.y = pg8::cvt_pk_bf16(ot[tj][2] * rr * ngv[2] * sigmoidf_(g2), ot[tj][3] * rr * ngv[3] * sigmoidf_(g3));
                *(u32x2*)(ATT + (size_t)(b * T + t0 + t) * D + h * 128 + 16 * wave + 4 * fg) = w;
            }
            {
                const bf16x8 ka0 = frag(lds + L_KDT, 16 * wave + fr, PS, 8 * fg), ka1 = frag(lds + L_KDT, 16 * wave + fr, PS, 32 + 8 * fg);
                const f32x4 ge = *(const LAS f32x4*)(geL + 16 * wave + 4 * fg);
#pragma unroll
                for (int j = 0; j < 8; ++j) {
                    Sacc[j] = __builtin_amdgcn_mfma_f32_16x16x32_bf16(ka0, frag(lds + L_VT, 16 * j + fr, PS, 8 * fg), Sacc[j], 0, 0, 0);
                    Sacc[j] = __builtin_amdgcn_mfma_f32_16x16x32_bf16(ka1, frag(lds + L_VT, 16 * j + fr, PS, 32 + 8 * fg), Sacc[j], 0, 0, 0);
                    Sacc[j] = Sacc[j] * ge;
                    u32x2 w; w.x = pg8::cvt_pk_bf16(Sacc[j][0], Sacc[j][1]); w.y = pg8::cvt_pk_bf16(Sacc[j][2], Sacc[j][3]);
                    *(LAS u32x2*)(lds + L_ST + (16 * j + fr) * PK + (16 * wave + 4 * fg) * 2) = w;
                }
            }
            __syncthreads();
        }
    }
}
constexpr int PH_PER_LAYER = 10, N_PHASES = 1 + PH_PER_LAYER * DEPTH;
struct Args { const float* in[27]; float* out; unsigned char* ws; int ph_lo, ph_hi; };
__global__ void __launch_bounds__(512, 2) mk_fwd(Args args) {
    extern __shared__ __attribute__((aligned(16))) unsigned char lds[];
    Frame F;
    F.lds = (LAS unsigned char*)lds;
    F.LC = (volatile LAS unsigned*)(F.lds + LDSCTL_OFF);
    F.tid = threadIdx.x; F.lane = F.tid & 63; F.wave = __builtin_amdgcn_readfirstlane(F.tid >> 6); F.G = gridDim.x; F.bx = blockIdx.x;
    F.ws = (unsigned char*)(GAS unsigned char*)args.ws; F.ctl = (unsigned*)(F.ws + OFF_CTL); F.out = (float*)(GAS float*)args.out;
    for (int u = F.tid; u < (LDS_BYTES - LDSCTL_OFF) / 4; u += 512) F.LC[u] = 0u;
    __syncthreads();
    if (F.tid < 27) { const unsigned long long pv = (unsigned long long)args.in[F.tid]; F.LC[128 + 2 * F.tid] = (unsigned)pv; F.LC[129 + 2 * F.tid] = (unsigned)(pv >> 32); }
    __syncthreads();
    XcdBarrier bar; bar.bar = F.ctl + CW_BAR; bar.x = 0; bar.st = nullptr;
    if (!MK_PER_PHASE) bar = xcd_barrier_post(F.ctl + CW_BAR, F.LC);
    const int lo = args.ph_lo, hi = args.ph_hi;
#define IN(k) (lo <= (k) && (k) < hi)
#ifndef DBL_LNR
#define DBL_LNR 1
#endif
#ifndef DBL_COMB
#define DBL_COMB 1
#endif
#ifndef DBL_NG
#define DBL_NG 1
#endif
#ifndef DBL_GIN
#define DBL_GIN 1
#endif
#ifndef DBL_GOUT
#define DBL_GOUT 1
#endif
#ifndef DBL_GCMP
#define DBL_GCMP 1
#endif
#ifndef DBL_GUP
#define DBL_GUP 1
#endif
#ifndef DBL_GDN
#define DBL_GDN 1
#endif
#ifndef DBL_SCAN
#define DBL_SCAN 1
#endif
#ifndef DBL_P0
#define DBL_P0 1
#endif
#ifndef DBL_ATT
#define DBL_ATT 1
#endif
#define REP(n) _Pragma("unroll 1") for (int rep_ = 0; rep_ < (n); ++rep_)
#ifdef PROBE_A
#define STAMP(k) do { if (blockIdx.x == 0 && F.tid == 0) ((unsigned long long*)(F.ws + OFF_TAB + 65536))[(k)] = wall_clock64(); } while (0)
#else
#define STAMP(k) do {} while (0)
#endif
#define SEAM(k) do { if (!MK_PER_PHASE && (k) + 1 < hi) xcd_barrier(bar); else __syncthreads(); } while (0)

    STAMP(0);
    if (IN(0)) {
#ifndef NO_P0
 REP(DBL_P0) p0_prologue(F);
#endif
 SEAM(0); }

    for (int L = 0; L < DEPTH; ++L) {
        int Lo = L; asm volatile("; layer-local" : "+s"(Lo));
        const int kind = Lo % 3, slot = Lo / 3, pb = 1 + PH_PER_LAYER * Lo;
#define PHL Frame Fp = F; asm volatile("; phase-local" : "+v"(Fp.tid), "+s"(Fp.bx)); Fp.lane = Fp.tid & 63;
        const int ldp = kind == 0 ? NSA_LD : (kind == 1 ? ML_LD : HG_LD);
        if (IN(pb + 0)) { PHL STAMP(pb + 0);
            const bf16_t* Wt = kind == 0 ? WSP(bf16_t, OFF_W_NSAIN) + (size_t)slot * NSA_LD * D : (kind == 1 ? WSP(bf16_t, OFF_W_MLIN) : WSP(bf16_t, OFF_W_HGIN));
            pg8::APlain AS{WSP(bf16_t, OFF_XN), D}; pg8::BPlain BS{Wt, D}; pg8::StaticOrder S; S.init(NTOK / 256, ldp / 256, Fp.G, Fp.bx);
            pg8::EpiStore E{WSP(bf16_t, OFF_PROJ), ldp};
            #ifndef NO_GIN
            REP(DBL_GIN) pg8::gemm_phase<pg8::EpiStore, pg8::StaticOrder, pg8::APlain, pg8::BPlain>(Fp.lds, D, AS, BS, S, E);
#endif
            SEAM(pb + 0);
        }
        if (kind == 0) {
            if (IN(pb + 1)) { PHL STAMP(pb + 1);
                pg8::ACmp AS{WSP(bf16_t, OFF_PROJ), NSA_LD, 1024}; pg8::BGroup BS{WSP(bf16_t, OFF_W_CMP1) + (size_t)slot * 2 * 256 * 2048, 2048, (size_t)256 * 2048};
                pg8::CmpOrder S{Fp.G, Fp.bx};
                pg8::EpiCmpGelu E{WSP(bf16_t, OFF_HC), WSP(float, OFF_TAB) + TAB_CMPB + slot * 512};
                #ifndef NO_GCMP
                REP(DBL_GCMP) pg8::gemm_phase<pg8::EpiCmpGelu, pg8::CmpOrder, pg8::ACmp, pg8::BGroup>(Fp.lds, 2048, AS, BS, S, E);
#endif
                SEAM(pb + 1);
            }
            if (IN(pb + 2)) { PHL STAMP(pb + 2);
#ifndef NO_CMP2
 REP(DBL_GCMP) phase_nsa_cmp2(Fp, slot);
#endif
 SEAM(pb + 2); }
            if (IN(pb + 3)) { PHL STAMP(pb + 3);
#ifndef NO_ATTN
 REP(DBL_ATT) phase_nsa_attn_mfma(Fp, slot);
#endif
 SEAM(pb + 3); }
        } else if (kind == 1) {
            if (IN(pb + 1)) { PHL STAMP(pb + 1);
#ifdef MLS_CHECK
                {
                    const size_t n16 = (size_t)NTOK * D * 2 / 16; u32x4* HMv = WSP(u32x4, OFF_HM); u32x4* Y1 = WSP(u32x4, OFF_Y); u32x4* Y2 = WSP(u32x4, OFF_Y + 160 * MiB);
#pragma unroll 1
                    for (int rep_ = 0; rep_ < 3; ++rep_) {
                        phase_mlstm_scan_mfma(Fp);
                        xcd_barrier(bar);
                        if (rep_ < 2) { u32x4* dst = rep_ == 0 ? Y1 : Y2;
                            for (size_t i = (size_t)blockIdx.x * 512 + Fp.tid; i < n16; i += (size_t)Fp.G * 512) dst[i] = HMv[i];
                            xcd_barrier(bar); }
                    }
                    unsigned bad_bits = 0u; float md = 0.f, mr = 0.f;
                    for (size_t i = (size_t)blockIdx.x * 512 + Fp.tid; i < n16; i += (size_t)Fp.G * 512) { const u32x4 a = HMv[i], b2 = Y2[i], c1 = Y1[i];
                        if (a.x != b2.x || a.y != b2.y || a.z != b2.z || a.w != b2.w) bad_bits = 1u;
                        const unsigned aw[4] = {a.x, a.y, a.z, a.w}, cw[4] = {c1.x, c1.y, c1.z, c1.w};
#pragma unroll
                        for (int q = 0; q < 4; ++q) { const float a0 = __uint_as_float(aw[q] << 16), a1 = __uint_as_float(aw[q] & 0xffff0000u), r0 = __uint_as_float(cw[q] << 16), r1 = __uint_as_float(cw[q] & 0xffff0000u);
                            md = fmaxf(md, fmaxf(fabsf(a0 - r0), fabsf(a1 - r1))); mr = fmaxf(mr, fmaxf(fabsf(r0), fabsf(r1))); if (!(a0 == a0) || !(a1 == a1)) bad_bits |= 4u; } }
                    md = wave_max(md); mr = wave_max(mr);
                    if (Fp.lane == 0) { atomicMax(F.ctl + 9000, __float_as_uint(md)); atomicMax(F.ctl + 9001, __float_as_uint(mr)); }
                    if (bad_bits) atomicOr(F.ctl + 9002, bad_bits);
                }
#else
#ifndef NO_MLS
 REP(DBL_SCAN) phase_mlstm_scan_mfma(Fp);
#endif
#endif
 SEAM(pb + 1); }
            if (IN(pb + 2)) { PHL STAMP(pb + 2);
#ifndef NO_NG
 REP(DBL_NG) phase_norm_gate<256>(Fp, inptr(Fp, I_ML_NORM_G), ML_LD, 2048);
#endif
 SEAM(pb + 2); }
        } else {
            if (IN(pb + 1)) { PHL STAMP(pb + 1);
#ifndef NO_HGS
 REP(DBL_SCAN) phase_hgrn_scan_mfma(Fp);
#endif
 SEAM(pb + 1); }
        }
        if (IN(pb + 4)) { PHL STAMP(pb + 4);
            const bf16_t* Wt = kind == 0 ? WSP(bf16_t, OFF_W_NSAOUT) + (size_t)slot * D * D : (kind == 1 ? WSP(bf16_t, OFF_W_MLOUT) : WSP(bf16_t, OFF_W_HGOUT));
            pg8::APlain AS{WSP(bf16_t, OFF_ATT), D}; pg8::BPlain BS{Wt, D}; pg8::StaticOrder S; S.init(NTOK / 256, D / 256, Fp.G, Fp.bx);
            pg8::EpiStore E{WSP(bf16_t, OFF_HM), D};
            #ifndef NO_GOUT
            REP(DBL_GOUT) pg8::gemm_phase<pg8::EpiStore, pg8::StaticOrder, pg8::APlain, pg8::BPlain>(Fp.lds, D, AS, BS, S, E);
#endif
            SEAM(pb + 4);
        }
        if (IN(pb + 5)) { PHL STAMP(pb + 5);
#ifndef NO_LNR
 if (DBL_LNR > 1) phase_ln_router(Fp, Lo, true);
 phase_ln_router(Fp, Lo);
#endif
 SEAM(pb + 5); }
        if (IN(pb + 6)) { PHL STAMP(pb + 6);
#ifndef NO_SLOT
 phase_moe_slots(Fp, Lo);
#endif
 SEAM(pb + 6); }
        if (IN(pb + 7)) { PHL STAMP(pb + 7);
            moe_tile_table(Fp, Lo);
            pg8::AGather AS{WSP(bf16_t, OFF_XN), D, WSP(int, OFF_ROWT)}; pg8::BGroup BS{WSP(bf16_t, OFF_W_GU) + (size_t)Lo * NEXP * 2048 * D, D, (size_t)2048 * D};
            pg8::MoeOrder S; S.init(__builtin_amdgcn_readfirstlane((int)Fp.LC[40]), 8, Fp.G, Fp.bx); S.pend = (const LAS int*)(Fp.lds + LDSCTL_OFF + 32);
            pg8::EpiSwiglu E{WSP(bf16_t, OFF_H), inptr(Fp, I_MOE_B_GU) + (size_t)Lo * NEXP * 2048};
            #ifndef NO_GUP
            REP(DBL_GUP) pg8::gemm_phase<pg8::EpiSwiglu, pg8::MoeOrder, pg8::AGather, pg8::BGroup>(Fp.lds, D, AS, BS, S, E);
#endif
            SEAM(pb + 7);
        }
        if (IN(pb + 8)) { PHL STAMP(pb + 8);
            moe_tile_table(Fp, Lo);
            pg8::APlain AS{WSP(bf16_t, OFF_H), DFF}; pg8::BGroup BS{WSP(bf16_t, OFF_W_DN) + (size_t)Lo * NEXP * D * DFF, DFF, (size_t)D * DFF};
            pg8::MoeOrder S; S.init(__builtin_amdgcn_readfirstlane((int)Fp.LC[40]), 4, Fp.G, Fp.bx); S.pend = (const LAS int*)(Fp.lds + LDSCTL_OFF + 32);
            pg8::EpiDown E{WSP(bf16_t, OFF_Y), inptr(Fp, I_MOE_B_DOWN) + (size_t)Lo * NEXP * D, WSP(float, OFF_ROWG)};
            #ifndef NO_GDN
            REP(DBL_GDN) pg8::gemm_phase<pg8::EpiDown, pg8::MoeOrder, pg8::APlain, pg8::BGroup>(Fp.lds, DFF, AS, BS, S, E);
#endif
            SEAM(pb + 8);
        }
        if (IN(pb + 9)) { PHL STAMP(pb + 9);
#ifndef NO_COMB
 if (DBL_COMB > 1) phase_combine_ln(Fp, Lo, (float*)nullptr, true);
 phase_combine_ln(Fp, Lo, Lo == DEPTH - 1 ? Fp.out : (float*)nullptr);
#endif
 SEAM(pb + 9); }
    }
#ifdef MLS_CHECK
    xcd_barrier(bar);
    { const float md = __uint_as_float(__hip_atomic_load(F.ctl + 9000, RLX_AGENT)), mr = __uint_as_float(__hip_atomic_load(F.ctl + 9001, RLX_AGENT)); const unsigned bb = __hip_atomic_load(F.ctl + 9002, RLX_AGENT);
      float code = 10.f; if (md > 0.02f * mr) code = 100.f; if (md > 0.2f * mr) code = 300.f; if (bb & 1u) code *= 10.f; if (bb & 4u) code *= 100.f;
      for (size_t i = (size_t)blockIdx.x * 512 + F.tid; i < (size_t)NTOK * D; i += (size_t)F.G * 512) F.out[i] = code; }
#endif
#ifdef PROBE_A
    STAMP(N_PHASES);
    xcd_barrier(bar);
    {
        const unsigned long long* st = (const unsigned long long*)(F.ws + OFF_TAB + 65536);
        float cat[6] = {0.f, 0.f, 0.f, 0.f, 0.f, 0.f};
        unsigned long long prev = __hip_atomic_load(st + 0, RLX_AGENT);
        int pc = 0;
        for (int p = 1; p <= N_PHASES; ++p) {
            int c = -1;
            if (p < N_PHASES) { const int Lq = (p - 1) / PH_PER_LAYER, k = (p - 1) % PH_PER_LAYER, kind = Lq % 3;
                if (k == 3 && kind != 0) continue;
                c = (k == 0 || k == 4 || k == 7 || k == 8) ? 1 : (k == 1 ? (kind == 0 ? 1 : (kind == 1 ? 3 : 4)) : (k == 3 ? 2 : 5)); }
            const unsigned long long now = __hip_atomic_load(st + p, RLX_AGENT);
            const float us = (float)(now - prev) * 0.01f;
#pragma unroll
            for (int q = 0; q < 6; ++q) if (q == pc) cat[q] += us;
            prev = now; pc = c;
        }
        float va = 0.f, vb = 0.f;
#pragma unroll
        for (int q = 0; q < 6; ++q) { if (q == PROBE_A) va = cat[q]; if (q == PROBE_B) vb = cat[q]; }
        const float kfill = sqrtf(va);
        for (size_t i = (size_t)blockIdx.x * 512 + F.tid; i < (size_t)NTOK * D; i += (size_t)F.G * 512) F.out[i] = (i == 0) ? vb : kfill;
    }
#endif
#undef IN
#undef SEAM
#undef PHL
}

extern "C" void kernel_launch(void* const* d_in, const int* in_sizes, int n_in, void* d_out, int out_size, void* d_ws, size_t ws_size, hipStream_t stream) {
    static int grid = 0;
    if (grid == 0) {
        if (n_in != 27 || out_size != NTOK * D || ws_size < WS_END) { fprintf(stderr, "kernel_launch: unexpected shapes (n_in %d, out %d, ws %zu)\n", n_in, out_size, ws_size); grid = -1; return; }
        int dev = 0, cus = 0;
        if (hipGetDevice(&dev) != hipSuccess || hipDeviceGetAttribute(&cus, hipDeviceAttributeMultiprocessorCount, dev) != hipSuccess) { grid = -1; return; }
        if (hipFuncSetAttribute((const void*)mk_fwd, hipFuncAttributeMaxDynamicSharedMemorySize, LDS_BYTES) != hipSuccess) { fprintf(stderr, "kernel_launch: hipFuncSetAttribute failed\n"); grid = -1; return; }
        int per_cu = 0;
        if (hipOccupancyMaxActiveBlocksPerMultiprocessor(&per_cu, (const void*)mk_fwd, 512, LDS_BYTES) != hipSuccess || per_cu < 1) fprintf(stderr, "kernel_launch: occupancy query reports %d\n", per_cu);
        (void)hipGetLastError();
        grid = cus;
    }
    if (grid < 0) return;
    (void)hipMemsetAsync((char*)d_ws + OFF_CTL, 0, CTL_ZERO_BYTES, stream);
    Args a{};
    for (int i = 0; i < 27; ++i) a.in[i] = (const float*)d_in[i];
    a.out = (float*)d_out; a.ws = (unsigned char*)d_ws;
#if MK_PER_PHASE
    for (int p = 0; p < N_PHASES; ++p) {
        if (p > 0) { const int L = (p - 1) / PH_PER_LAYER, k = (p - 1) % PH_PER_LAYER, kind = L % 3; if (k == 3 && kind != 0) continue; }
        a.ph_lo = p; a.ph_hi = p + 1;
        hipLaunchKernelGGL(mk_fwd, dim3(grid), dim3(512), LDS_BYTES, stream, a);
    }
#else
    a.ph_lo = 0; a.ph_hi = N_PHASES;
    hipLaunchKernelGGL(mk_fwd, dim3(grid), dim3(512), LDS_BYTES, stream, a);
#endif
}
```

```cpp
#include <hip/hip_runtime.h>
#include <cstdio>
#include <cstdint>

#define LAS __attribute__((address_space(3)))
#define GAS __attribute__((address_space(1)))
typedef unsigned short bf16_t;
typedef short bf16x8 __attribute__((ext_vector_type(8)));
typedef float f32x4 __attribute__((ext_vector_type(4)));
typedef float f32x2 __attribute__((ext_vector_type(2)));
typedef unsigned u32x4 __attribute__((ext_vector_type(4)));
typedef unsigned u32x2 __attribute__((ext_vector_type(2)));
#define RLX_AGENT __ATOMIC_RELAXED, __HIP_MEMORY_SCOPE_AGENT
#define LDS_WAIT() asm volatile("s_waitcnt lgkmcnt(0)" ::: "memory")
#define VM_WAIT() asm volatile("s_waitcnt vmcnt(0)" ::: "memory")

#ifndef MK_PER_PHASE
#define MK_PER_PHASE 0
#endif

constexpr int D = 1024, BATCH = 32, T = 2048, NTOK = BATCH * T, DEPTH = 4;
constexpr int NSA_IN = 2608, NSA_LD = 2816, ML_IN = 3080, ML_LD = 3328, HG_LD = 4096;
constexpr int NEXP = 32, TOPK = 4, DFF = 1024;
constexpr int MOE_ROWS = 270336;
constexpr float LN_EPS = 1e-5f, RMS_EPS = 1e-6f;
constexpr float DN_ALPHA = 1.681792830507429f;
constexpr int NCMP = 127;

constexpr size_t MiB = 1u << 20;
constexpr size_t OFF_CTL = 0, CTL_ZERO_BYTES = 1 * MiB;
constexpr size_t OFF_TAB = 1 * MiB;
constexpr size_t OFF_TOKE = 2 * MiB;
constexpr size_t OFF_TOKG = 3 * MiB;
constexpr size_t OFF_TOKP = 4 * MiB;
constexpr size_t OFF_ROWT = 5 * MiB;
constexpr size_t OFF_ROWG = 7 * MiB;
constexpr size_t OFF_KC = 9 * MiB;
constexpr size_t OFF_HC = 17 * MiB;
constexpr size_t OFF_W_NSAIN = 33 * MiB;
constexpr size_t OFF_W_NSAOUT = 44 * MiB;
constexpr size_t OFF_W_MLIN = 48 * MiB;
constexpr size_t OFF_W_MLOUT = 55 * MiB;
constexpr size_t OFF_W_HGIN = 57 * MiB;
constexpr size_t OFF_W_HGOUT = 65 * MiB;
constexpr size_t OFF_W_CMP2 = 71 * MiB;
constexpr size_t OFF_W_CMP1 = 67 * MiB;
constexpr size_t OFF_W_GU = 72 * MiB;
constexpr size_t OFF_W_DN = 584 * MiB;
constexpr size_t OFF_XA = 840 * MiB;
constexpr size_t OFF_XN = 1096 * MiB;
constexpr size_t OFF_PROJ = 1224 * MiB;
constexpr size_t OFF_ATT = 1740 * MiB;
constexpr size_t OFF_HM = 1868 * MiB;
constexpr size_t OFF_H = 1996 * MiB;
constexpr size_t OFF_Y = 2526 * MiB;
constexpr size_t WS_END = 3056 * MiB;
constexpr int TAB_CMPB = 0;
constexpr int TAB_LB = 4096;
constexpr int TAB_RWT = 8192;
constexpr int CW_BAR = 4096;
constexpr int CW_CNT = 16384;
constexpr int CW_CUR = 16384 + 1024;

constexpr int RING_BYTES = 131072;
constexpr int LDSCTL_OFF = 155648;
constexpr int LDS_BYTES = 156672;

__device__ __forceinline__ float bf2f(bf16_t b) { return __uint_as_float(((unsigned)b) << 16); }
typedef float f32x2_t_ __attribute__((ext_vector_type(2))); typedef __bf16 bf16x2_t_ __attribute__((ext_vector_type(2)));
__device__ __forceinline__ unsigned pk2(float lo, float hi) { const f32x2_t_ v = {lo, hi}; const bf16x2_t_ b = __builtin_convertvector(v, bf16x2_t_); return __builtin_bit_cast(unsigned, b); }
__device__ __forceinline__ unsigned f2bf(float f) { return pk2(f, f) & 0xffffu; }
template <int CTRL> __device__ __forceinline__ float dppf(float v) { return __builtin_bit_cast(float, __builtin_amdgcn_update_dpp(0, __builtin_bit_cast(int, v), CTRL, 0xF, 0xF, true)); }
__device__ __forceinline__ float rdl(float v, int l) { return __builtin_bit_cast(float, __builtin_amdgcn_readlane(__builtin_bit_cast(int, v), l)); }
__device__ __forceinline__ float wave_sum(float v) {
    v += dppf<0xB1>(v); v += dppf<0x4E>(v); v += dppf<0x141>(v); v += dppf<0x140>(v);
    return (rdl(v, 0) + rdl(v, 16)) + (rdl(v, 32) + rdl(v, 48));
}
__device__ __forceinline__ float wave_max(float v) {
    v = fmaxf(v, dppf<0xB1>(v)); v = fmaxf(v, dppf<0x4E>(v)); v = fmaxf(v, dppf<0x141>(v)); v = fmaxf(v, dppf<0x140>(v));
    return fmaxf(fmaxf(rdl(v, 0), rdl(v, 16)), fmaxf(rdl(v, 32), rdl(v, 48)));
}
__device__ __forceinline__ float sigmoidf_(float x) { return __builtin_amdgcn_rcpf(1.0f + __expf(-x)); }

#define XB_TMO      128
#define XB_XCNT(j)  (256  + 64 * (j))
#define XB_XSUB(j)  (1280 + 64 * (j))
#define XB_XGEN(j)  (2304 + 64 * (j))
#define XB_TOP      3328
#define XB_TOPGEN   3392
#define XCD_BAR_WORDS 3456
#define XB_SPIN_CAP (1u << 20)

__device__ __forceinline__ unsigned xb_ld(unsigned* p)              { return __hip_atomic_load(p, __ATOMIC_RELAXED, __HIP_MEMORY_SCOPE_AGENT); }
__device__ __forceinline__ unsigned xb_add(unsigned* p, unsigned v) { return __hip_atomic_fetch_add(p, v, __ATOMIC_RELAXED, __HIP_MEMORY_SCOPE_AGENT); }
__device__ __forceinline__ unsigned xb_xcc_id() { return (unsigned)__builtin_amdgcn_s_getreg((3 << 11) | 20) & 0xFu; }
#define XB_SPIN(cond, bar) do { unsigned _sp = 0; while (cond) { __builtin_amdgcn_s_sleep(1); \
    if ((++_sp & 255u) == 0u) { if (xb_ld(&(bar)[XB_TMO])) break; if (_sp > XB_SPIN_CAP) { atomicAdd(&(bar)[XB_TMO], 1u); break; } } } } while (0)

struct XcdBarrier { unsigned* bar; unsigned x; volatile LAS unsigned* st; };

__device__ __forceinline__ XcdBarrier xcd_barrier_post(unsigned* bar, volatile LAS unsigned* st) {
    XcdBarrier b; b.bar = bar; b.x = xb_xcc_id(); b.st = st;
    if (threadIdx.x == 0) (void)xb_add(&bar[XB_XCNT(b.x)], 1u);
    return b;
}
__device__ __forceinline__ void xcd_barrier_complete(unsigned* bar, unsigned x, unsigned& nloc, unsigned& nx) {
    const unsigned G = gridDim.x * gridDim.y * gridDim.z;
    unsigned sum, cnt, mine, sp = 0u;
    for (;;) {
        sum = 0u; cnt = 0u; mine = 0u;
#pragma unroll
        for (unsigned j = 0; j < 16; ++j) { const unsigned c = xb_ld(&bar[XB_XCNT(j)]); sum += c; cnt += (c > 0u) ? 1u : 0u; }
        mine = xb_ld(&bar[XB_XCNT(x)]);
        if (sum == G) break;
        __builtin_amdgcn_s_sleep(1);
        if ((++sp & 255u) == 0u) { if (xb_ld(&bar[XB_TMO])) break; if (sp > XB_SPIN_CAP) { atomicAdd(&bar[XB_TMO], 1u); break; } }
    }
    nloc = mine > 0u ? mine : 1u; nx = cnt > 0u ? cnt : 1u;
}
__device__ __forceinline__ void xcd_barrier(const XcdBarrier& b) {
    asm volatile("s_waitcnt vmcnt(0)" ::: "memory");
    __syncthreads();
    if (threadIdx.x == 0) {
        unsigned* bar = b.bar; asm volatile("; barrier words" : "+s"(bar));
        __builtin_amdgcn_s_waitcnt(0);
        unsigned nloc = b.st[0], nx = b.st[1];
        if (nloc == 0u) { xcd_barrier_complete(bar, b.x, nloc, nx); b.st[0] = nloc; b.st[1] = nx; }
        const unsigned old = xb_add(&bar[XB_XSUB(b.x)], 1u);
        const unsigned gen = old / nloc;
        if (old + 1u == (gen + 1u) * nloc) {
            __builtin_amdgcn_fence(__ATOMIC_RELEASE, "agent");
            asm volatile("s_waitcnt vmcnt(0)" ::: "memory");
            const unsigned og = xb_add(&bar[XB_TOP], 1u);
            const unsigned tg = og / nx;
            if (og + 1u == (tg + 1u) * nx) xb_add(&bar[XB_TOPGEN], 1u);
            else XB_SPIN(xb_ld(&bar[XB_TOPGEN]) == tg, bar);
            __builtin_amdgcn_fence(__ATOMIC_ACQUIRE, "agent");
            xb_add(&bar[XB_XGEN(b.x)], 1u);
            asm volatile("s_waitcnt vmcnt(0)" ::: "memory");
        } else {
            XB_SPIN(xb_ld(&bar[XB_XGEN(b.x)]) == gen, bar);
            __builtin_amdgcn_fence(__ATOMIC_ACQUIRE, "agent");
            asm volatile("s_waitcnt vmcnt(0)" ::: "memory");
        }
    }
    __syncthreads();
}

namespace pg8 {
constexpr int BM = 256, BK = 64, HALF = 128, HTB = HALF * BK * 2, STAGE_BYTES = 8 * HTB, NXCD = 8, WGM = 8;
__host__ __device__ __forceinline__ int lds_byte(int r, int c) { const int st = (r >> 4) * 2 + (c >> 5), rr = r & 15, cc = c & 31, ob = rr * 64 + cc * 2; return st * 1024 + (ob ^ (((ob >> 9) & 1) << 5)); }
__host__ __device__ __forceinline__ void stage_rc(int b, int& R, int& C) { const int st = b / 1024, sb = b % 1024, swz = sb ^ (((sb >> 9) & 1) << 5); R = (st >> 1) * 16 + swz / 64; C = (st & 1) * 32 + (swz % 64) / 2; }
__host__ __device__ __forceinline__ int perm32(int rho) { const int n = rho >> 4, i = rho & 15; return 8 * (i >> 2) + 4 * n + (i & 3); }

struct Unit { int pm, pn, e; };

struct StaticOrder {
    int nM, nN, nwg, G, c, wgm = WGM;
    __device__ __forceinline__ void init(int nM_, int nN_, int G_, int c_) { nM = nM_; nN = nN_; nwg = nM * nN; G = G_; c = c_; }
    __device__ __forceinline__ bool next(int i, Unit& u) const {
        const long L = (long)i * G + c; if (L >= nwg) return false;
        int wgid = (int)L; { const int q = nwg / NXCD, r = nwg % NXCD, xcd = wgid % NXCD, off = wgid / NXCD; wgid = (xcd < r ? xcd * (q + 1) : r * (q + 1) + (xcd - r) * q) + off; }
        const int nig = wgm * nN, gid = wgid / nig, fm = gid * wgm, gsz = (nM - fm) < wgm ? (nM - fm) : wgm;
        u.pm = fm + ((wgid % nig) % gsz); u.pn = (wgid % nig) / gsz; u.e = 0; return true;
    }
};
struct MoeOrder : StaticOrder {
    const LAS int* pend;
    __device__ __forceinline__ bool next(int i, Unit& u) const {
        if (!StaticOrder::next(i, u)) return false;
        int e = 0;
#pragma unroll 8
        for (int j = 0; j < 31; ++j) e += (pend[j] <= u.pm) ? 1 : 0;
        u.e = __builtin_amdgcn_readfirstlane(e); return true;
    }
};
struct CmpOrder {
    int G, c;
    __device__ __forceinline__ bool next(int i, Unit& u) const { const int L = i * G + c; if (L >= 128) return false; u.e = L >> 6; u.pm = L & 63; u.pn = 0; return true; }
};

__device__ __forceinline__ unsigned cvt_pk_bf16(float lo, float hi) { const f32x2_t_ v = {lo, hi}; const bf16x2_t_ b = __builtin_convertvector(v, bf16x2_t_); return __builtin_bit_cast(unsigned, b); }

struct APlain {
    static constexpr bool GATHER = false;
    const bf16_t* A; int lda;
    __device__ __forceinline__ int kstep() const { return BK * 2; }
    __device__ __forceinline__ const char* base(const Unit& u) const { return (const char*)A + (size_t)u.pm * BM * lda * 2; }
    __device__ __forceinline__ void offs(const Unit&, const int (&R)[2], const int (&C)[2], unsigned (&vo)[2][2]) const {
#pragma unroll
        for (int h = 0; h < 2; ++h)
#pragma unroll
            for (int i = 0; i < 2; ++i) vo[h][i] = (unsigned)((h * HALF + R[i]) * lda + C[i]) * 2u;
    }
};
struct AGather {
    static constexpr bool GATHER = true;
    const bf16_t* A; int lda; const int* idx;
    __device__ __forceinline__ int kstep() const { return BK * 2; }
    __device__ __forceinline__ const char* base(const Unit&) const { return (const char*)A; }
    __device__ __forceinline__ void offs(const Unit& u, const int (&R)[2], const int (&C)[2], unsigned (&vo)[2][2]) const {
#pragma unroll
        for (int h = 0; h < 2; ++h)
#pragma unroll
            for (int i = 0; i < 2; ++i) { const int row = idx[u.pm * BM + h * HALF + R[i]]; vo[h][i] = (unsigned)(row * lda + C[i]) * 2u; }
    }
};
struct ACmp {
    static constexpr bool GATHER = false;
    const bf16_t* P; int ld; int col0;
    __device__ __forceinline__ int kstep() const { return ld * 2; }
    __device__ __forceinline__ const char* base(const Unit& u) const { const int b = u.pm >> 1, g0 = (u.pm & 1) * 2; return (const char*)P + ((size_t)b * T * ld + col0 + u.e * 256 + g0 * 64) * 2; }
    __device__ __forceinline__ void offs(const Unit&, const int (&R)[2], const int (&C)[2], unsigned (&vo)[2][2]) const {
#pragma unroll
        for (int h = 0; h < 2; ++h)
#pragma unroll
            for (int i = 0; i < 2; ++i) vo[h][i] = (unsigned)(16 * R[i] * ld + h * 64 + C[i]) * 2u;
    }
};
struct BPlain { const bf16_t* Bt; int K; __device__ __forceinline__ const char* base(const Unit& u) const { return (const char*)Bt + (size_t)u.pn * BM * K * 2; } };
struct BGroup { const bf16_t* Bt; int K; size_t gstride;   __device__ __forceinline__ const char* base(const Unit& u) const { return (const char*)Bt + ((size_t)u.e * gstride + (size_t)u.pn * BM * K) * 2; } };

template <class Epi, class Sched, class ASrc, class BSrc, bool ALIGN_EPI = true, bool SP2 = true>
__device__ __forceinline__ void gemm_phase(LAS unsigned char* lds, const int K, const ASrc& AS, const BSrc& BS, const Sched& S, const Epi& E) {
    int tid = threadIdx.x; asm volatile("; phase-local tid" : "+v"(tid));
    const int wid = __builtin_amdgcn_readfirstlane(tid >> 6), lane = tid & 63, wr = wid >> 2, wc = wid & 3, fr = lane & 15, fq = lane >> 4;
    const int nt = K / BK;
    int Rs[2], Cs[2]; unsigned voffB[2];
#pragma unroll
    for (int i = 0; i < 2; ++i) { int R, C; stage_rc(tid * 16 + i * 8192, R, C); Rs[i] = R; Cs[i] = C; const int Rb = Epi::PERM ? ((R & ~31) + perm32(R & 31)) : R; voffB[i] = (unsigned)(Rb * K + C) * 2u; }
    const size_t kstepB = (size_t)(BK * 2), hstepB = (size_t)HALF * K * 2;
    const size_t kstepA = (size_t)AS.kstep();
    const unsigned ldsw = (unsigned)wid * 1024u;
    const int aoff = lds_byte(wr * 64 + fr, fq * 8), boff = lds_byte(wc * 32 + fr, fq * 8);
#define PG8_SA(b, h) (((b) * 2 + (h)) * HTB)
#define PG8_SB(b, h) ((4 + (b) * 2 + (h)) * HTB)
#define PG8_STAGEB(bufoff, gbase) do { _Pragma("unroll") for (int _i = 0; _i < 2; ++_i) \
        __builtin_amdgcn_global_load_lds((const unsigned*)((const char*)(gbase) + voffB[_i]), (LAS unsigned*)(lds + (bufoff) + ldsw + _i * 8192), 16, 0, 0); } while (0)
#define PG8_STAGEA(bufoff, gbase, o0, o1) do { \
        __builtin_amdgcn_global_load_lds((const unsigned*)((const char*)(gbase) + (o0)), (LAS unsigned*)(lds + (bufoff) + ldsw), 16, 0, 0); \
        __builtin_amdgcn_global_load_lds((const unsigned*)((const char*)(gbase) + (o1)), (LAS unsigned*)(lds + (bufoff) + ldsw + 8192), 16, 0, 0); } while (0)
#define PG8_LDA(dst, b, h) do { _Pragma("unroll") for (int m = 0; m < 4; ++m) _Pragma("unroll") for (int k = 0; k < 2; ++k) dst[m][k] = *(const LAS bf16x8*)(lds + PG8_SA(b, h) + aoff + m * 2048 + k * 1024); } while (0)
#define PG8_LDB(dst, b, h) do { _Pragma("unroll") for (int n = 0; n < 2; ++n) _Pragma("unroll") for (int k = 0; k < 2; ++k) dst[n][k] = *(const LAS bf16x8*)(lds + PG8_SB(b, h) + boff + n * 2048 + k * 1024); } while (0)
#define PG8_MMA(ai, bj, At, Bt) do { __builtin_amdgcn_s_setprio(1); _Pragma("unroll") for (int m = 0; m < 4; ++m) _Pragma("unroll") for (int n = 0; n < 2; ++n) _Pragma("unroll") for (int k = 0; k < 2; ++k) \
        acc[ai][bj][m][n] = __builtin_amdgcn_mfma_f32_16x16x32_bf16(Bt[n][k], At[m][k], acc[ai][bj][m][n], 0, 0, 0); __builtin_amdgcn_s_setprio(0); } while (0)
#define PG8_WAIT_V(n) asm volatile("s_waitcnt vmcnt(" #n ")" ::: "memory")
#define PG8_WAIT_L(n) asm volatile("s_waitcnt lgkmcnt(" #n ")" ::: "memory")
#define PG8_BAR __builtin_amdgcn_s_barrier()
#define PG8_SCHED __builtin_amdgcn_sched_barrier(0)
    Unit cur, nxt; int ui = 0;
    if (!S.next(0, cur)) return;
    f32x4 acc[2][2][4][2];
    E.init(acc, cur, wc, fq);
    bf16x8 At[4][2], B0[2][2], B1[2][2];
    unsigned vC[2][2];
    AS.offs(cur, Rs, Cs, vC);
    unsigned x00 = vC[0][0], x01 = vC[0][1], x10 = vC[1][0], x11 = vC[1][1];
    const char* cA = AS.base(cur); const char* cB = BS.base(cur);
    if constexpr (SP2) {
        PG8_STAGEB(PG8_SB(0, 0), cB); PG8_STAGEB(PG8_SB(0, 1), cB + hstepB); PG8_STAGEA(PG8_SA(0, 0), cA, vC[0][0], vC[0][1]); PG8_STAGEA(PG8_SA(0, 1), cA, vC[1][0], vC[1][1]);
        if (wr == 1) PG8_BAR;
        PG8_WAIT_V(2); PG8_BAR;
        PG8_STAGEB(PG8_SB(1, 0), cB + kstepB); PG8_STAGEA(PG8_SA(1, 0), cA + kstepA, vC[0][0], vC[0][1]); PG8_STAGEB(PG8_SB(1, 1), cB + hstepB + kstepB);
        PG8_WAIT_V(6); PG8_BAR;
    } else {
        PG8_STAGEB(PG8_SB(0, 0), cB); PG8_STAGEA(PG8_SA(0, 0), cA, vC[0][0], vC[0][1]); PG8_STAGEB(PG8_SB(0, 1), cB + hstepB); PG8_STAGEA(PG8_SA(0, 1), cA, vC[1][0], vC[1][1]);
        if (wr == 1) PG8_BAR;
        PG8_WAIT_V(4); PG8_BAR;
        PG8_STAGEB(PG8_SB(1, 0), cB + kstepB); PG8_STAGEA(PG8_SA(1, 0), cA + kstepA, vC[0][0], vC[0][1]); PG8_STAGEB(PG8_SB(1, 1), cB + hstepB + kstepB);
        PG8_WAIT_V(6); PG8_BAR;
    }
    for (;;) {
        const bool has_next = S.next(ui + 1, nxt);
        const char* nA = has_next ? AS.base(nxt) : cA; const char* nB = has_next ? BS.base(nxt) : cB;
        for (int t = 0; t < nt; t += 2) {
            const bool last = (t == nt - 2);
            const char* a1 = cA + (size_t)(t + 1) * kstepA;
            const char* a2 = last ? nA : cA + (size_t)(t + 2) * kstepA; const char* b2 = last ? nB : cB + (size_t)(t + 2) * kstepB;
            const char* a3 = a2 + kstepA; const char* b3 = b2 + kstepB;
            if constexpr (ASrc::GATHER) { if (last && has_next) { unsigned vn[2][2]; AS.offs(nxt, Rs, Cs, vn); x00 = vn[0][0]; x01 = vn[0][1]; x10 = vn[1][0]; x11 = vn[1][1]; } }
            if constexpr (SP2) {
            PG8_LDB(B0, 0, 0); PG8_LDB(B1, 0, 1); PG8_SCHED; PG8_LDA(At, 0, 0); PG8_STAGEA(PG8_SA(1, 1), a1, vC[1][0], vC[1][1]);
            PG8_WAIT_V(8); PG8_WAIT_L(0); PG8_BAR; PG8_MMA(0, 0, At, B0); PG8_MMA(0, 1, At, B1); PG8_BAR; PG8_SCHED;
            PG8_LDA(At, 0, 1); PG8_STAGEB(PG8_SB(0, 0), b2); PG8_STAGEB(PG8_SB(0, 1), b2 + hstepB); PG8_STAGEA(PG8_SA(0, 0), a2, x00, x01);
            PG8_WAIT_V(8); PG8_WAIT_L(0); PG8_BAR; PG8_MMA(1, 0, At, B0); PG8_MMA(1, 1, At, B1); PG8_BAR; PG8_SCHED;
            PG8_LDB(B0, 1, 0); PG8_LDB(B1, 1, 1); PG8_SCHED; PG8_LDA(At, 1, 0); PG8_STAGEA(PG8_SA(0, 1), a2, x10, x11);
            PG8_WAIT_V(8); PG8_WAIT_L(0); PG8_BAR; PG8_MMA(0, 0, At, B0); PG8_MMA(0, 1, At, B1); PG8_BAR; PG8_SCHED;
            PG8_LDA(At, 1, 1); PG8_STAGEB(PG8_SB(1, 0), b3); PG8_STAGEB(PG8_SB(1, 1), b3 + hstepB); PG8_STAGEA(PG8_SA(1, 0), a3, x00, x01);
            PG8_WAIT_V(8); PG8_WAIT_L(0); PG8_BAR; PG8_MMA(1, 0, At, B0); PG8_MMA(1, 1, At, B1); PG8_BAR; PG8_SCHED;
            } else {
            PG8_LDB(B0, 0, 0); PG8_SCHED; PG8_LDA(At, 0, 0); PG8_STAGEA(PG8_SA(1, 1), a1, vC[1][0], vC[1][1]);
            PG8_WAIT_L(8); PG8_BAR; PG8_WAIT_L(0); PG8_MMA(0, 0, At, B0); PG8_BAR; PG8_SCHED;
            PG8_LDB(B1, 0, 1); PG8_STAGEB(PG8_SB(0, 0), b2);
            PG8_BAR; PG8_WAIT_L(0); PG8_MMA(0, 1, At, B1); PG8_BAR;
            PG8_LDA(At, 0, 1); PG8_STAGEA(PG8_SA(0, 0), a2, x00, x01);
            PG8_BAR; PG8_WAIT_L(0); PG8_MMA(1, 0, At, B0); PG8_BAR; PG8_SCHED;
            PG8_STAGEB(PG8_SB(0, 1), b2 + hstepB);
            PG8_WAIT_V(6); PG8_BAR; PG8_MMA(1, 1, At, B1); PG8_BAR;
            PG8_LDB(B0, 1, 0); PG8_SCHED; PG8_LDA(At, 1, 0); PG8_STAGEA(PG8_SA(0, 1), a2, x10, x11);
            PG8_WAIT_L(8); PG8_BAR; PG8_WAIT_L(0); PG8_MMA(0, 0, At, B0); PG8_BAR; PG8_SCHED;
            PG8_LDB(B1, 1, 1); PG8_STAGEB(PG8_SB(1, 0), b3);
            PG8_BAR; PG8_WAIT_L(0); PG8_MMA(0, 1, At, B1); PG8_BAR;
            PG8_LDA(At, 1, 1); PG8_STAGEA(PG8_SA(1, 0), a3, x00, x01);
            PG8_BAR; PG8_WAIT_L(0); PG8_MMA(1, 0, At, B0); PG8_BAR; PG8_SCHED;
            PG8_STAGEB(PG8_SB(1, 1), b3 + hstepB);
            PG8_WAIT_V(6); PG8_BAR; PG8_MMA(1, 1, At, B1); PG8_BAR;
            }
        }
        if constexpr (ALIGN_EPI) { if (wr == 0) PG8_BAR; }
        E(acc, cur, wr, wc, fr, fq);
        if (!has_next) break;
        E.init(acc, nxt, wc, fq);
        cur = nxt; cA = nA; cB = nB; ++ui;
        if constexpr (ASrc::GATHER) { vC[0][0] = x00; vC[0][1] = x01; vC[1][0] = x10; vC[1][1] = x11; }
        if constexpr (ALIGN_EPI) { if (wr == 1) PG8_BAR; }
    }
    PG8_WAIT_V(0);
    if constexpr (!ALIGN_EPI) { if (wr == 0) PG8_BAR; }
    PG8_BAR;
#undef PG8_SA
#undef PG8_SB
#undef PG8_STAGEA
#undef PG8_STAGEB
#undef PG8_LDA
#undef PG8_LDB
#undef PG8_MMA
#undef PG8_WAIT_V
#undef PG8_WAIT_L
#undef PG8_BAR
#undef PG8_SCHED
}
}
namespace pg8 {
__device__ __forceinline__ float gelu_tanh(float x) {
    const float u = 0.7978845608028654f * (x + 0.044715f * x * x * x);
    const float e = __expf(-2.0f * fabsf(u)); float th = (1.0f - e) * __builtin_amdgcn_rcpf(1.0f + e); th = u < 0.f ? -th : th;
    return 0.5f * x * (1.0f + th);
}
struct EpiStore {
    static constexpr bool PERM = true;
    bf16_t* O; int ldc;
    __device__ __forceinline__ void init(f32x4 (&acc)[2][2][4][2], const Unit&, int, int) const {
#pragma unroll
        for (int a = 0; a < 2; ++a)
#pragma unroll
            for (int b = 0; b < 2; ++b)
#pragma unroll
                for (int m = 0; m < 4; ++m)
#pragma unroll
                    for (int n = 0; n < 2; ++n) acc[a][b][m][n] = (f32x4){0.f, 0.f, 0.f, 0.f};
    }
    __device__ __forceinline__ void operator()(const f32x4 (&acc)[2][2][4][2], const Unit& u, int wr, int wc, int fr, int fq) const {
        const int row0 = u.pm * BM + wr * 64 + fr, col0 = u.pn * BM + wc * 32 + 8 * fq;
#pragma unroll
        for (int ai = 0; ai < 2; ++ai)
#pragma unroll
            for (int m = 0; m < 4; ++m) { bf16_t* rowp = O + (size_t)(row0 + ai * HALF + m * 16) * ldc + col0;
#pragma unroll
                for (int bj = 0; bj < 2; ++bj) { const f32x4 v0 = acc[ai][bj][m][0], v1 = acc[ai][bj][m][1];
                    u32x4 w; w.x = cvt_pk_bf16(v0[0], v0[1]); w.y = cvt_pk_bf16(v0[2], v0[3]); w.z = cvt_pk_bf16(v1[0], v1[1]); w.w = cvt_pk_bf16(v1[2], v1[3]);
                    *(u32x4*)(rowp + bj * HALF) = w; } }
    }
};
struct EpiCmpGelu {
    static constexpr bool PERM = true;
    bf16_t* O; const float* bias;
    __device__ __forceinline__ void init(f32x4 (&acc)[2][2][4][2], const Unit&, int, int) const {
#pragma unroll
        for (int a = 0; a < 2; ++a)
#pragma unroll
            for (int b = 0; b < 2; ++b)
#pragma unroll
                for (int m = 0; m < 4; ++m)
#pragma unroll
                    for (int n = 0; n < 2; ++n) acc[a][b][m][n] = (f32x4){0.f, 0.f, 0.f, 0.f};
    }
    __device__ __forceinline__ void operator()(const f32x4 (&acc)[2][2][4][2], const Unit& u, int wr, int wc, int fr, int fq) const {
        const int row0 = u.pm * BM + wr * 64 + fr, col0 = wc * 32 + 8 * fq;
        bf16_t* Oj = O + (size_t)u.e * 16384 * 256; const float* bj_ = bias + u.e * 256;
        f32x4 bv[2][2];
#pragma unroll
        for (int bj = 0; bj < 2; ++bj)
#pragma unroll
            for (int n = 0; n < 2; ++n) bv[bj][n] = *(const f32x4*)(bj_ + col0 + bj * HALF + 4 * n);
#pragma unroll
        for (int ai = 0; ai < 2; ++ai)
#pragma unroll
            for (int m = 0; m < 4; ++m) { bf16_t* rowp = Oj + (size_t)(row0 + ai * HALF + m * 16) * 256 + col0;
#pragma unroll
                for (int bj = 0; bj < 2; ++bj) { f32x4 v0 = acc[ai][bj][m][0] + bv[bj][0], v1 = acc[ai][bj][m][1] + bv[bj][1];
#pragma unroll
                    for (int j = 0; j < 4; ++j) { v0[j] = gelu_tanh(v0[j]); v1[j] = gelu_tanh(v1[j]); }
                    u32x4 w; w.x = cvt_pk_bf16(v0[0], v0[1]); w.y = cvt_pk_bf16(v0[2], v0[3]); w.z = cvt_pk_bf16(v1[0], v1[1]); w.w = cvt_pk_bf16(v1[2], v1[3]);
                    *(u32x4*)(rowp + bj * HALF) = w; } }
    }
};
struct EpiSwiglu {
    static constexpr bool PERM = true;
    bf16_t* H; const float* bgu;
    __device__ __forceinline__ void init(f32x4 (&acc)[2][2][4][2], const Unit& u, int wc, int fq) const {
        const float* bg = bgu + (size_t)u.e * 2048 + u.pn * HALF + wc * 32 + 8 * fq;
#pragma unroll
        for (int n = 0; n < 2; ++n) { const f32x4 g = *(const f32x4*)(bg + 4 * n), up = *(const f32x4*)(bg + 1024 + 4 * n);
#pragma unroll
            for (int a = 0; a < 2; ++a)
#pragma unroll
                for (int m = 0; m < 4; ++m) { acc[a][0][m][n] = g; acc[a][1][m][n] = up; } }
    }
    __device__ __forceinline__ void operator()(const f32x4 (&acc)[2][2][4][2], const Unit& u, int wr, int wc, int fr, int fq) const {
        const int row0 = u.pm * BM + wr * 64 + fr, col0 = u.pn * HALF + wc * 32 + 8 * fq;
#pragma unroll
        for (int ai = 0; ai < 2; ++ai)
#pragma unroll
            for (int m = 0; m < 4; ++m) { bf16_t* rowp = H + (size_t)(row0 + ai * HALF + m * 16) * DFF + col0;
                unsigned wv[4];
#pragma unroll
                for (int n = 0; n < 2; ++n) { const f32x4 g = acc[ai][0][m][n], up = acc[ai][1][m][n];
#pragma unroll
                    for (int j = 0; j < 2; ++j) {
                        const f32x2 gg = {__builtin_amdgcn_fmed3f(g[2 * j], -3.0e38f, 7.0f), __builtin_amdgcn_fmed3f(g[2 * j + 1], -3.0e38f, 7.0f)};
                        const f32x2 uu = {__builtin_amdgcn_fmed3f(up[2 * j], -7.0f, 7.0f), __builtin_amdgcn_fmed3f(up[2 * j + 1], -7.0f, 7.0f)};
                        const f32x2 t = gg * -2.4554669595930156f;
                        f32x2 d = {__builtin_amdgcn_exp2f(t.x), __builtin_amdgcn_exp2f(t.y)}; d = d + 1.0f;
                        const f32x2 rr = {__builtin_amdgcn_rcpf(d.x), __builtin_amdgcn_rcpf(d.y)};
                        const f32x2 o = (uu + 1.0f) * gg * rr;
                        wv[2 * n + j] = cvt_pk_bf16(o.x, o.y); } }
                u32x4 w; w.x = wv[0]; w.y = wv[1]; w.z = wv[2]; w.w = wv[3];
                *(u32x4*)rowp = w; }
    }
};
struct EpiDown {
    static constexpr bool PERM = true;
    bf16_t* Y; const float* bd; const float* rgate;
    __device__ __forceinline__ void init(f32x4 (&acc)[2][2][4][2], const Unit& u, int wc, int fq) const {
        const float* b = bd + (size_t)u.e * 1024 + u.pn * BM + wc * 32 + 8 * fq;
#pragma unroll
        for (int bj = 0; bj < 2; ++bj)
#pragma unroll
            for (int n = 0; n < 2; ++n) { const f32x4 bv = *(const f32x4*)(b + bj * HALF + 4 * n);
#pragma unroll
                for (int a = 0; a < 2; ++a)
#pragma unroll
                    for (int m = 0; m < 4; ++m) acc[a][bj][m][n] = bv; }
    }
    __device__ __forceinline__ void operator()(const f32x4 (&acc)[2][2][4][2], const Unit& u, int wr, int wc, int fr, int fq) const {
        const int row0 = u.pm * BM + wr * 64 + fr, col0 = u.pn * BM + wc * 32 + 8 * fq;
#pragma unroll
        for (int ai = 0; ai < 2; ++ai)
#pragma unroll
            for (int m = 0; m < 4; ++m) { const int row = row0 + ai * HALF + m * 16; const float gt = rgate[row]; bf16_t* rowp = Y + (size_t)row * D + col0;
#pragma unroll
                for (int bj = 0; bj < 2; ++bj) { const f32x4 v0 = acc[ai][bj][m][0] * gt, v1 = acc[ai][bj][m][1] * gt;
                    u32x4 w; w.x = cvt_pk_bf16(v0[0], v0[1]); w.y = cvt_pk_bf16(v0[2], v0[3]); w.z = cvt_pk_bf16(v1[0], v1[1]); w.w = cvt_pk_bf16(v1[2], v1[3]);
                    *(u32x4*)(rowp + bj * HALF) = w; } }
    }
};
}
struct Frame {
    LAS unsigned char* lds;
    volatile LAS unsigned* LC;
    unsigned* ctl;
    unsigned char* ws;
    int tid, lane, wave, G, bx;
    float* out;
};
__device__ __forceinline__ size_t opaque_off(size_t o) { asm volatile("; ws offset" : "+s"(o)); return o; }
#define WSP(T_, off) ((T_*)(F.ws + opaque_off(off)))
__device__ __forceinline__ const float* inptr(const Frame& F, int i) {
    const unsigned lo = __builtin_amdgcn_readfirstlane(F.LC[128 + 2 * i]), hi = __builtin_amdgcn_readfirstlane(F.LC[129 + 2 * i]);
    const float* p = (const float*)(const GAS float*)(((unsigned long long)hi << 32) | (unsigned long long)lo);
    return p;
}
enum { I_X = 0, I_LN_G, I_LN_B, I_NSA_W_IN, I_NSA_CMP_POS, I_NSA_CMP_W1, I_NSA_CMP_B1, I_NSA_CMP_W2, I_NSA_CMP_B2, I_NSA_GATE_B, I_NSA_W_OUT,
       I_ML_W_IN, I_ML_CONV_W, I_ML_CONV_B, I_ML_GATE_B, I_ML_NORM_G, I_ML_W_OUT, I_HG_W_IN, I_HG_LOWER, I_HG_NORM_G, I_HG_W_OUT,
       I_ROUTER_W, I_ROUTER_B, I_MOE_W_GU, I_MOE_B_GU, I_MOE_W_DOWN, I_MOE_B_DOWN };

__device__ __forceinline__ void tr_load(f32x4 (&v)[16], const float* W, int N, int nvalid, int k0, int n0, int lane) {
    const int nn = n0 + 4 * (lane & 15); const bool ok = nn < nvalid; const int kr = lane >> 4;
#pragma unroll
    for (int i = 0; i < 16; ++i) v[i] = ok ? *(const f32x4*)(W + (size_t)(k0 + 4 * i + kr) * N + nn) : (f32x4){0.f, 0.f, 0.f, 0.f};
}
__device__ __forceinline__ void tr_store(const f32x4 (&v)[16], int K, bf16_t* WT, int drow, int k0, LAS float* scr, int lane) {
    const int kr = lane >> 4;
#pragma unroll
    for (int i = 0; i < 16; ++i) { LAS float* d = scr + (4 * i + kr) * 65 + 4 * (lane & 15); d[0] = v[i][0]; d[1] = v[i][1]; d[2] = v[i][2]; d[3] = v[i][3]; }
    LDS_WAIT();
    const int c = lane & 7;
#pragma unroll
    for (int j = 0; j < 8; ++j) { const int n = (lane >> 3) + 8 * j; const LAS float* s = scr + (8 * c) * 65 + n;
        u32x4 o; o.x = pk2(s[0 * 65], s[1 * 65]); o.y = pk2(s[2 * 65], s[3 * 65]); o.z = pk2(s[4 * 65], s[5 * 65]); o.w = pk2(s[6 * 65], s[7 * 65]);
        *(u32x4*)(WT + (size_t)(drow + n) * K + k0 + 8 * c) = o; }
    LDS_WAIT();
}
__device__ __forceinline__ void tr_class(Frame& F, const float* W, int nmat, int K, int N, int Npad, bf16_t* WT, bool gu, LAS float* scr, int gw, int NGW) {
    const int nblk = Npad / 64, per = (K / 64) * nblk; const long total = (long)nmat * per;
    f32x4 vbuf[16];
    long it = gw;
    if (it < total) { const int mat = (int)(it / per), r = (int)(it % per), kb = r / nblk, nb = r % nblk; tr_load(vbuf, W + (size_t)mat * K * N, N, N, kb * 64, nb * 64, F.lane); }
#pragma unroll 1
    for (; it < total; it += NGW) {
        const int mat = (int)(it / per), r = (int)(it % per), kb = r / nblk, nb = r % nblk, n0 = nb * 64;
        int drow = n0;
        if (gu) drow = (n0 < 1024) ? ((n0 >> 7) * 256 + (n0 & 127)) : ((((n0 - 1024) >> 7) * 256) + 128 + ((n0 - 1024) & 127));
        f32x4 cur[16];
#pragma unroll
        for (int i = 0; i < 16; ++i) cur[i] = vbuf[i];
        const long nx = it + NGW;
        if (nx < total) { const int mat2 = (int)(nx / per), r2 = (int)(nx % per), kb2 = r2 / nblk, nb2 = r2 % nblk; tr_load(vbuf, W + (size_t)mat2 * K * N, N, N, kb2 * 64, nb2 * 64, F.lane); }
        tr_store(cur, K, WT + (size_t)mat * Npad * K, drow, kb * 64, scr, F.lane);
    }
}
__device__ __forceinline__ void p0_prologue(Frame& F) {
    LAS float* scr = (LAS float*)(F.lds + F.wave * 16896);
    const int gw = F.bx * 8 + F.wave, NGW = F.G * 8;
    tr_class(F, inptr(F, I_MOE_W_GU), DEPTH * NEXP, D, 2 * DFF, 2 * DFF, WSP(bf16_t, OFF_W_GU), true, scr, gw, NGW);
    tr_class(F, inptr(F, I_MOE_W_DOWN), DEPTH * NEXP, DFF, D, D, WSP(bf16_t, OFF_W_DN), false, scr, gw, NGW);
    tr_class(F, inptr(F, I_NSA_W_IN), 2, D, NSA_IN, NSA_LD, WSP(bf16_t, OFF_W_NSAIN), false, scr, gw, NGW);
    tr_class(F, inptr(F, I_NSA_W_OUT), 2, D, D, D, WSP(bf16_t, OFF_W_NSAOUT), false, scr, gw, NGW);
    tr_class(F, inptr(F, I_ML_W_IN), 1, D, ML_IN, ML_LD, WSP(bf16_t, OFF_W_MLIN), false, scr, gw, NGW);
    tr_class(F, inptr(F, I_ML_W_OUT), 1, D, D, D, WSP(bf16_t, OFF_W_MLOUT), false, scr, gw, NGW);
    tr_class(F, inptr(F, I_HG_W_IN), 1, D, HG_LD, HG_LD, WSP(bf16_t, OFF_W_HGIN), false, scr, gw, NGW);
    tr_class(F, inptr(F, I_HG_W_OUT), 1, D, D, D, WSP(bf16_t, OFF_W_HGOUT), false, scr, gw, NGW);
    tr_class(F, inptr(F, I_NSA_CMP_W1), 4, 2048, 256, 256, WSP(bf16_t, OFF_W_CMP1), false, scr, gw, NGW);
    tr_class(F, inptr(F, I_NSA_CMP_W2), 4, 256, 64, 64, WSP(bf16_t, OFF_W_CMP2), false, scr, gw, NGW);
    const int gt = F.bx * 512 + F.tid;
    float* tab = WSP(float, OFF_TAB);
    if (gt < 1024) {
        const int lj = gt >> 8, n = gt & 255; const float* pos = inptr(F, I_NSA_CMP_POS) + (size_t)lj * 2048; const float* w1 = inptr(F, I_NSA_CMP_W1) + (size_t)lj * 2048 * 256;
        float a = inptr(F, I_NSA_CMP_B1)[lj * 256 + n];
        for (int k = 0; k < 2048; ++k) a += pos[k] * w1[(size_t)k * 256 + n];
        tab[TAB_CMPB + gt] = a;
    } else if (gt < 2048) {
        const int c = gt - 1024; float v[DEPTH], mx = -1e30f;
#pragma unroll
        for (int i = 0; i < DEPTH; ++i) { v[i] = inptr(F, I_HG_LOWER)[i * D + c]; mx = fmaxf(mx, v[i]); }
        float s = 0.f;
#pragma unroll
        for (int i = 0; i < DEPTH; ++i) { v[i] = __expf(v[i] - mx); s += v[i]; }
        tab[TAB_LB + c] = (v[1] + v[2]) / s;
    }
    { const float* rw = inptr(F, I_ROUTER_W); float* rwt = WSP(float, OFF_TAB) + TAB_RWT;
      for (int i = F.bx * 512 + F.tid; i < DEPTH * D * NEXP; i += F.G * 512) { const int l = i >> 15, r = i & 32767, k = r >> 5, e = r & 31; rwt[(l * NEXP + e) * D + k] = rw[i]; } }
    {
        const f32x4* xs = (const f32x4*)inptr(F, I_X); u32x2* xn = WSP(u32x2, OFF_XN);
        const size_t n4 = (size_t)NTOK * D / 4, stride = (size_t)F.G * 512;
        for (size_t i = (size_t)F.bx * 512 + F.tid; i < n4; i += stride) { const f32x4 v = xs[i]; u32x2 o; o.x = pk2(v[0], v[1]); o.y = pk2(v[2], v[3]); xn[i] = o; }
    }
}

__device__ __forceinline__ void phase_ln_router(Frame& F, int layer, bool dummy = false) {
    constexpr int SP = 1028;
    LAS float* LgL = (LAS float*)F.lds;
    LAS float* slab = LgL + 256 * 33;
    LAS float* part = slab + 16 * SP;
    if (F.tid < 32) F.LC[64 + F.tid] = 0u;
    __syncthreads();
    const float* g = inptr(F, I_LN_G) + (size_t)(layer * 2 + 0) * D; const float* bb = inptr(F, I_LN_B) + (size_t)(layer * 2 + 0) * D;
    const float* rb = inptr(F, I_ROUTER_B) + layer * NEXP;
    const float* rwt = WSP(float, OFF_TAB) + TAB_RWT + (size_t)layer * NEXP * D;
    const bf16_t* HM = WSP(bf16_t, OFF_HM); bf16_t* XN = dummy ? WSP(bf16_t, OFF_H + 256 * MiB) : WSP(bf16_t, OFF_XN);
    const bf16_t* XR = WSP(bf16_t, OFF_XN);
    int* toke = dummy ? WSP(int, OFF_H + 400 * MiB) : WSP(int, OFF_TOKE); float* tokg = dummy ? WSP(float, OFF_H + 402 * MiB) : WSP(float, OFF_TOKG);
    int lane = F.lane; asm volatile("; phase-local lane" : "+v"(lane));
    const int fr = lane & 15, fg = lane >> 4, wave = F.wave;
    const float rbv = rb[F.tid & 31];
    f32x4 b0r[8], b1r[8], gr[4], br[4];
    { const f32x4* B0p = (const f32x4*)(rwt + (size_t)fr * D + 128 * wave) + fg; const f32x4* B1p = (const f32x4*)(rwt + (size_t)(16 + fr) * D + 128 * wave) + fg;
#pragma unroll
      for (int t = 0; t < 8; ++t) { b0r[t] = B0p[4 * t]; b1r[t] = B1p[4 * t]; }
#pragma unroll
      for (int j = 0; j < 4; ++j) { gr[j] = *((const f32x4*)g + lane + 64 * j); br[j] = *((const f32x4*)bb + lane + 64 * j); } }
    for (int blk = F.bx; blk < NTOK / 256; blk += F.G) {
        u32x2 xn_[2][4], hn_[2][4];
        { const int m0 = blk * 256 + 2 * wave;
#pragma unroll
          for (int q = 0; q < 2; ++q) { const u32x2* xr = (const u32x2*)(XR + (size_t)(m0 + q) * D) + lane; const u32x2* hr = (const u32x2*)(HM + (size_t)(m0 + q) * D) + lane;
#pragma unroll
            for (int j = 0; j < 4; ++j) { xn_[q][j] = xr[64 * j]; hn_[q][j] = hr[64 * j]; } } }
#pragma unroll 1
        for (int sub = 0; sub < 16; ++sub) {
            const int mb = blk * 256 + sub * 16 + 2 * wave;
            f32x4 v[2][4]; float s[2] = {0.f, 0.f};
#pragma unroll
            for (int q = 0; q < 2; ++q)
#pragma unroll
                for (int j = 0; j < 4; ++j) { const u32x2 xv = xn_[q][j]; const u32x2 hv = hn_[q][j];
                    v[q][j][0] = DN_ALPHA * __uint_as_float(xv.x << 16) + __uint_as_float(hv.x << 16); v[q][j][1] = DN_ALPHA * __uint_as_float(xv.x & 0xffff0000u) + __uint_as_float(hv.x & 0xffff0000u);
                    v[q][j][2] = DN_ALPHA * __uint_as_float(xv.y << 16) + __uint_as_float(hv.y << 16); v[q][j][3] = DN_ALPHA * __uint_as_float(xv.y & 0xffff0000u) + __uint_as_float(hv.y & 0xffff0000u);
                    s[q] += (v[q][j][0] + v[q][j][1]) + (v[q][j][2] + v[q][j][3]); }
            if (sub + 1 < 16) {
#pragma unroll
                for (int q = 0; q < 2; ++q) { const u32x2* xr = (const u32x2*)(XR + (size_t)(mb + 16 + q) * D) + lane; const u32x2* hr = (const u32x2*)(HM + (size_t)(mb + 16 + q) * D) + lane;
#pragma unroll
                    for (int j = 0; j < 4; ++j) { xn_[q][j] = xr[64 * j]; hn_[q][j] = hr[64 * j]; } } }
#pragma unroll
            for (int q = 0; q < 2; ++q) {
                const float mean = wave_sum(s[q]) * (1.f / D); float s2 = 0.f;
#pragma unroll
                for (int j = 0; j < 4; ++j) { v[q][j] = v[q][j] - mean; s2 += (v[q][j][0] * v[q][j][0] + v[q][j][1] * v[q][j][1]) + (v[q][j][2] * v[q][j][2] + v[q][j][3] * v[q][j][3]); }
                const float rstd = __builtin_amdgcn_rsqf(wave_sum(s2) * (1.f / D) + LN_EPS);
                u32x2* no = (u32x2*)(XN + (size_t)(mb + q) * D) + lane; LAS f32x4* so = (LAS f32x4*)(slab + (2 * wave + q) * SP) + lane;
#pragma unroll
                for (int j = 0; j < 4; ++j) { const f32x4 gv = gr[j], bv = br[j];
                    const f32x4 y = v[q][j] * rstd * gv + bv; so[64 * j] = y; u32x2 o; o.x = pk2(y[0], y[1]); o.y = pk2(y[2], y[3]); no[64 * j] = o; }
            }
            __syncthreads();
            {
                const LAS f32x4* Ap = (const LAS f32x4*)(slab + fr * SP + 128 * wave) + fg;
                f32x4 acc0 = (f32x4){0.f, 0.f, 0.f, 0.f}, acc1 = acc0;
#pragma unroll
                for (int t = 0; t < 8; ++t) { const f32x4 a = Ap[4 * t], b0 = b0r[t], b1 = b1r[t];
#pragma unroll
                    for (int j = 0; j < 4; ++j) { acc0 = __builtin_amdgcn_mfma_f32_16x16x4f32(a[j], b0[j], acc0, 0, 0, 0); acc1 = __builtin_amdgcn_mfma_f32_16x16x4f32(a[j], b1[j], acc1, 0, 0, 0); } }
#pragma unroll
                for (int e = 0; e < 4; ++e) { LAS float* pr = part + (wave * 16 + 4 * fg + e) * 33; pr[fr] = acc0[e]; pr[16 + fr] = acc1[e]; }
            }
            __syncthreads();
            { const int row = F.tid >> 5, e = F.tid & 31; float lg = rbv;
#pragma unroll
              for (int w8 = 0; w8 < 8; ++w8) lg += part[(w8 * 16 + row) * 33 + e];
              LgL[(sub * 16 + row) * 33 + e] = lg; }
        }
        __syncthreads();
        if (F.tid < 256) {
            const int m = blk * 256 + F.tid; const LAS float* lr = LgL + F.tid * 33;
            unsigned taken = 0u; int se[TOPK]; float sv[TOPK];
#pragma unroll
            for (int k = 0; k < TOPK; ++k) { float best = -INFINITY; int bi = 0;
#pragma unroll 8
                for (int e = 0; e < NEXP; ++e) { const float c = ((taken >> e) & 1u) ? -INFINITY : lr[e]; if (c > best) { best = c; bi = e; } }
                se[k] = bi; sv[k] = best; taken |= 1u << bi; }
            float gs = 0.f, ge[TOPK];
#pragma unroll
            for (int k = 0; k < TOPK; ++k) { ge[k] = __expf(sv[k] - sv[0]); gs += ge[k]; }
            const float inv = __builtin_amdgcn_rcpf(gs);
#pragma unroll
            for (int k = 0; k < TOPK; ++k) { toke[m * 4 + k] = se[k]; tokg[m * 4 + k] = ge[k] * inv; __hip_atomic_fetch_add((LAS unsigned*)&F.LC[64 + se[k]], 1u, __ATOMIC_RELAXED, __HIP_MEMORY_SCOPE_WORKGROUP); }
        }
        __syncthreads();
    }
    if (F.tid < 32) { const unsigned c = F.LC[64 + F.tid]; if (c) __hip_atomic_fetch_add(F.ctl + (dummy ? 12288 : CW_CNT) + layer * 64 + F.tid, c, RLX_AGENT); }
    __syncthreads();
}

__device__ __forceinline__ void moe_tile_table(Frame& F, int layer) {
    if (F.tid < 64) {
        const int e = F.tid & 31;
        const unsigned c = __hip_atomic_load(F.ctl + CW_CNT + layer * 64 + e, RLX_AGENT);
        int acc = (int)((c + 255u) >> 8);
#pragma unroll
        for (int o = 1; o < 32; o <<= 1) { const int u = __shfl_up(acc, o); if (e >= o) acc += u; }
        if (F.tid < 32) { F.LC[8 + e] = (unsigned)acc; if (e == 31) F.LC[40] = (unsigned)acc; }
    }
    __syncthreads();
}
__device__ __forceinline__ void phase_moe_slots(Frame& F, int layer) {
    moe_tile_table(F, layer);
    const int* toke = WSP(int, OFF_TOKE); const float* tokg = WSP(float, OFF_TOKG);
    int* tokp = WSP(int, OFF_TOKP); int* rowt = WSP(int, OFF_ROWT); float* rowg = WSP(float, OFF_ROWG);
    for (int blk = F.bx; blk < NTOK / 256; blk += F.G) {
        if (F.tid < 32) F.LC[64 + F.tid] = 0u;
        __syncthreads();
        int e[2], rank[2];
#pragma unroll
        for (int q = 0; q < 2; ++q) { const int a = blk * 1024 + q * 512 + F.tid; e[q] = toke[a]; rank[q] = (int)__hip_atomic_fetch_add((LAS unsigned*)&F.LC[64 + e[q]], 1u, __ATOMIC_RELAXED, __HIP_MEMORY_SCOPE_WORKGROUP); }
        __syncthreads();
        if (F.tid < 32) { const unsigned c = F.LC[64 + F.tid]; const unsigned pstart = (F.tid ? F.LC[8 + F.tid - 1] : 0u) * 256u;
            F.LC[96 + F.tid] = pstart + (c ? __hip_atomic_fetch_add(F.ctl + CW_CUR + layer * 64 + F.tid, c, RLX_AGENT) : 0u); }
        __syncthreads();
#pragma unroll
        for (int q = 0; q < 2; ++q) { const int a = blk * 1024 + q * 512 + F.tid; const int pos = (int)F.LC[96 + e[q]] + rank[q];
            rowt[pos] = a >> 2; rowg[pos] = tokg[a]; tokp[a] = pos; }
        __syncthreads();
    }
    for (int e2 = F.bx; e2 < NEXP; e2 += F.G) {
        const unsigned c = __hip_atomic_load(F.ctl + CW_CNT + layer * 64 + e2, RLX_AGENT); const unsigned pstart = (e2 ? F.LC[8 + e2 - 1] : 0u) * 256u, pend = F.LC[8 + e2] * 256u;
        for (unsigned r = pstart + c + F.tid; r < pend; r += 512) { rowt[r] = 0; rowg[r] = 0.f; }
    }
}
__device__ __forceinline__ void phase_combine_ln(Frame& F, int layer, float* xo_base  , bool dummy = false) {
    const float* g = inptr(F, I_LN_G) + (size_t)(layer * 2 + 1) * D; const float* bb = inptr(F, I_LN_B) + (size_t)(layer * 2 + 1) * D;
    const bf16_t* XR = WSP(bf16_t, OFF_XN); bf16_t* XN = dummy ? WSP(bf16_t, OFF_H + 256 * MiB) : WSP(bf16_t, OFF_XN); const bf16_t* Y = WSP(bf16_t, OFF_Y); const int* tokp = WSP(int, OFF_TOKP);
    int lane = F.lane; asm volatile("; phase-local lane" : "+v"(lane)); const int gw = F.bx * 8 + F.wave, NGW = F.G * 8;
    u32x2 xq[4]; u32x2 yq[TOPK][4]; int posn[TOPK];
    f32x4 gr[4], br[4];
#pragma unroll
    for (int j = 0; j < 4; ++j) { gr[j] = *((const f32x4*)g + lane + 64 * j); br[j] = *((const f32x4*)bb + lane + 64 * j); }
    {
        int p0[TOPK];
#pragma unroll
        for (int k = 0; k < TOPK; ++k) p0[k] = (gw < NTOK) ? tokp[gw * 4 + k] : 0;
        if (gw < NTOK) { const u32x2* xr = (const u32x2*)(XR + (size_t)gw * D) + lane;
#pragma unroll
            for (int j = 0; j < 4; ++j) xq[j] = xr[64 * j];
#pragma unroll
            for (int k = 0; k < TOPK; ++k) { const u32x2* yr = (const u32x2*)(Y + (size_t)p0[k] * D) + lane;
#pragma unroll
                for (int j = 0; j < 4; ++j) yq[k][j] = __builtin_nontemporal_load(yr + 64 * j); } }
#pragma unroll
        for (int k = 0; k < TOPK; ++k) posn[k] = (gw + NGW < NTOK) ? tokp[(gw + NGW) * 4 + k] : 0;
    }
#pragma unroll 1
    for (int m = gw; m < NTOK; m += NGW) {
        f32x4 v[4]; float s = 0.f;
#pragma unroll
        for (int j = 0; j < 4; ++j) { const u32x2 xv = xq[j]; v[j][0] = DN_ALPHA * __uint_as_float(xv.x << 16); v[j][1] = DN_ALPHA * __uint_as_float(xv.x & 0xffff0000u); v[j][2] = DN_ALPHA * __uint_as_float(xv.y << 16); v[j][3] = DN_ALPHA * __uint_as_float(xv.y & 0xffff0000u); }
#pragma unroll
        for (int k = 0; k < TOPK; ++k) {
#pragma unroll
            for (int j = 0; j < 4; ++j) { const u32x2 hv = yq[k][j];
                v[j][0] += __uint_as_float(hv.x << 16); v[j][1] += __uint_as_float(hv.x & 0xffff0000u); v[j][2] += __uint_as_float(hv.y << 16); v[j][3] += __uint_as_float(hv.y & 0xffff0000u); } }
        if (m + NGW < NTOK) {
            const u32x2* xr = (const u32x2*)(XR + (size_t)(m + NGW) * D) + lane;
#pragma unroll
            for (int j = 0; j < 4; ++j) xq[j] = xr[64 * j];
#pragma unroll
            for (int k = 0; k < TOPK; ++k) { const u32x2* yr = (const u32x2*)(Y + (size_t)posn[k] * D) + lane;
#pragma unroll
                for (int j = 0; j < 4; ++j) yq[k][j] = __builtin_nontemporal_load(yr + 64 * j); }
#pragma unroll
            for (int k = 0; k < TOPK; ++k) posn[k] = (m + 2 * NGW < NTOK) ? tokp[(m + 2 * NGW) * 4 + k] : 0;
        }
#pragma unroll
        for (int j = 0; j < 4; ++j) s += (v[j][0] + v[j][1]) + (v[j][2] + v[j][3]);
        const float mean = wave_sum(s) * (1.f / D); float s2 = 0.f;
#pragma unroll
        for (int j = 0; j < 4; ++j) { v[j] = v[j] - mean; s2 += (v[j][0] * v[j][0] + v[j][1] * v[j][1]) + (v[j][2] * v[j][2] + v[j][3] * v[j][3]); }
        const float rstd = __builtin_amdgcn_rsqf(wave_sum(s2) * (1.f / D) + LN_EPS);
        u32x2* no = (u32x2*)(XN + (size_t)m * D) + lane;
#pragma unroll
        for (int j = 0; j < 4; ++j) { const f32x4 gv = gr[j], bv = br[j];
            v[j] = v[j] * rstd * gv + bv;
            if (xo_base) *((f32x4*)(xo_base + (size_t)m * D) + lane + 64 * j) = v[j];
            else { u32x2 o; o.x = pk2(v[j][0], v[j][1]); o.y = pk2(v[j][2], v[j][3]); no[64 * j] = o; } }
    }
}
__device__ __forceinline__ void phase_nsa_cmp2(Frame& F, int slot) {
    const bf16_t* HC = WSP(bf16_t, OFF_HC); bf16_t* KC = WSP(bf16_t, OFF_KC);
    const bf16_t* W2t = WSP(bf16_t, OFF_W_CMP2) + (size_t)slot * 2 * 64 * 256;
    const float* b2 = inptr(F, I_NSA_CMP_B2) + (size_t)slot * 2 * 64;
    int lane = F.lane; asm volatile("; phase-local lane" : "+v"(lane));
    const int fr = lane & 15, fg = lane >> 4, gw = F.bx * 8 + F.wave, NGW = F.G * 8;
    for (int blk = gw; blk < 2 * 1024; blk += NGW) {
        const int j = blk >> 10, r0 = (blk & 1023) * 16;
        const bf16_t* A = HC + ((size_t)j * 16384 + r0 + fr) * 256 + 8 * fg;
        const bf16_t* B = W2t + ((size_t)j * 64 + fr) * 256 + 8 * fg;
        f32x4 acc[4];
#pragma unroll
        for (int t = 0; t < 4; ++t) acc[t] = (f32x4){0.f, 0.f, 0.f, 0.f};
#pragma unroll
        for (int ks = 0; ks < 8; ++ks) { const bf16x8 a = *(const bf16x8*)(A + 32 * ks);
#pragma unroll
            for (int t = 0; t < 4; ++t) acc[t] = __builtin_amdgcn_mfma_f32_16x16x32_bf16(*(const bf16x8*)(B + (size_t)t * 16 * 256 + 32 * ks), a, acc[t], 0, 0, 0); }
        const int row = r0 + fr;
#pragma unroll
        for (int t = 0; t < 4; ++t) { const int d0 = 16 * t + 4 * fg; const f32x4 bv = *(const f32x4*)(b2 + j * 64 + d0);
            f32x4 v = acc[t] + bv; if ((row & 127) == 127) v = (f32x4){0.f, 0.f, 0.f, 0.f};
            u32x2 w; w.x = pg8::cvt_pk_bf16(v[0], v[1]); w.y = pg8::cvt_pk_bf16(v[2], v[3]);
            *(u32x2*)(KC + ((size_t)j * 16384 + row) * 64 + d0) = w; }
    }
}
typedef float f32x16 __attribute__((ext_vector_type(16)));
#define PP_SYNC() do { __builtin_amdgcn_sched_barrier(0); __syncthreads(); __builtin_amdgcn_sched_barrier(0); } while (0)
#ifndef SP_SCALAR
#define SP_SCALAR 0
#endif
#ifndef SP_FILL
#define SP_FILL 12
#endif
#ifndef XCMP
#define XCMP 0
#endif
#ifndef XSELN
#define XSELN 0
#endif
#ifndef XOUT
#define XOUT 0
#endif
namespace na {
constexpr int KP = 144;
constexpr int VP = 144;
__device__ __forceinline__ int vcol(int key) { return (key & ~15) | (key & 3) | ((key & 8) >> 1) | ((key & 4) << 1); }
constexpr int TILEB = 64 * KP;
constexpr int L_K = 0, L_V = 2 * TILEB, L_PQ = 4 * TILEB, SLB = 64 * 33, L_SEL = L_PQ + 4 * SLB * 4, L_OA = L_SEL + 4864;
constexpr float NEG = -1e30f;
constexpr float C1 = 0.125f * 1.4426950408889634f;
__device__ __forceinline__ int crow(int r, int hi) { return (r & 3) + 8 * (r >> 2) + 4 * hi; }
__device__ __forceinline__ bf16x8 pack8(const f32x16& p, int s1) {
    u32x4 w; w.x = pg8::cvt_pk_bf16(p[8 * s1 + 0], p[8 * s1 + 1]); w.y = pg8::cvt_pk_bf16(p[8 * s1 + 2], p[8 * s1 + 3]);
    w.z = pg8::cvt_pk_bf16(p[8 * s1 + 4], p[8 * s1 + 5]); w.w = pg8::cvt_pk_bf16(p[8 * s1 + 6], p[8 * s1 + 7]);
    return __builtin_bit_cast(bf16x8, w);
}
__device__ __forceinline__ void qk(f32x16& p0, f32x16& p1, const LAS unsigned char* Kt, const bf16x8 (&qf)[4], int r, int h) {
    const f32x16 z = {0.f, 0.f, 0.f, 0.f, 0.f, 0.f, 0.f, 0.f, 0.f, 0.f, 0.f, 0.f, 0.f, 0.f, 0.f, 0.f};
    bf16x8 a0[4], a1[4];
#pragma unroll
    for (int s = 0; s < 4; ++s) { a0[s] = *(const LAS bf16x8*)(Kt + r * KP + (16 * s + 8 * h) * 2); a1[s] = *(const LAS bf16x8*)(Kt + (32 + r) * KP + (16 * s + 8 * h) * 2); }
    __builtin_amdgcn_sched_barrier(0);
#pragma unroll
    for (int s = 0; s < 4; ++s) {
        p0 = __builtin_amdgcn_mfma_f32_32x32x16_bf16(a0[s], qf[s], s == 0 ? z : p0, 0, 0, 0);
        p1 = __builtin_amdgcn_mfma_f32_32x32x16_bf16(a1[s], qf[s], s == 0 ? z : p1, 0, 0, 0);
    }
}
__device__ __forceinline__ void pv(f32x16& o0, f32x16& o1, const LAS unsigned char* Vt, const f32x16& p0, const f32x16& p1, int r, int h) {
#pragma unroll
    for (int s = 0; s < 4; ++s) {
        const int s1 = s & 1;
        const bf16x8 bfrag = (s < 2) ? pack8(p0, s1) : pack8(p1, s1);
        const int key0 = 32 * (s >> 1) + 16 * s1 + 4 * h;
#pragma unroll
        for (int dh = 0; dh < 2; ++dh) {
            const bf16x8 a = *(const LAS bf16x8*)(Vt + (32 * dh + r) * VP + (key0 - 4 * h + 8 * h) * 2);
            if (dh == 0) o0 = __builtin_amdgcn_mfma_f32_32x32x16_bf16(a, bfrag, o0, 0, 0, 0);
            else o1 = __builtin_amdgcn_mfma_f32_32x32x16_bf16(a, bfrag, o1, 0, 0, 0);
        }
    }
}
__device__ __forceinline__ void pack_p(bf16x8 (&pb)[4], const f32x16& p0, const f32x16& p1) { pb[0] = pack8(p0, 0); pb[1] = pack8(p0, 1); pb[2] = pack8(p1, 0); pb[3] = pack8(p1, 1); }
__device__ __forceinline__ void pv2(f32x16& o0, f32x16& o1, const LAS unsigned char* Vt, const bf16x8 (&pb)[4], int r, int h) {
    bf16x8 a[4][2];
#pragma unroll
    for (int s = 0; s < 4; ++s) {
        const int key0 = 32 * (s >> 1) + 16 * (s & 1) + 4 * h;
#pragma unroll
        for (int dh = 0; dh < 2; ++dh) {
            a[s][dh] = *(const LAS bf16x8*)(Vt + (32 * dh + r) * VP + (key0 - 4 * h + 8 * h) * 2);
        }
    }
    __builtin_amdgcn_sched_barrier(0);
#pragma unroll
    for (int s = 0; s < 4; ++s) {
        o0 = __builtin_amdgcn_mfma_f32_32x32x16_bf16(a[s][0], pb[s], o0, 0, 0, 0);
        o1 = __builtin_amdgcn_mfma_f32_32x32x16_bf16(a[s][1], pb[s], o1, 0, 0, 0);
    }
}
__device__ __forceinline__ void softmax_step(f32x16& p0, f32x16& p1, float& m, float& l, f32x16& o0, f32x16& o1, bool lane_on = true) {
    constexpr float THR = 8.0f / C1;
    float mx = fmaxf(fmaxf(fmaxf(p0[0], p1[5]), fmaxf(p0[10], p1[15])), fmaxf(fmaxf(p1[0], p0[5]), fmaxf(p1[10], p0[15])));
    mx = lane_on ? mx : NEG;
    mx = fmaxf(mx, __shfl_xor(mx, 32));
    const float mn = (mx > m + THR) ? mx : m;
    const float muse = (mn < -1e29f) ? 0.f : mn;
    const bool grow = mn != m;
    const float mc = lane_on ? muse * C1 : 3.0e38f;
    f32x2 lsa = {0.f, 0.f}, lsb = {0.f, 0.f}; const f32x2 c1v = {C1, C1}, nmc = {-mc, -mc};
#pragma unroll
    for (int i = 0; i < 8; ++i) {
        f32x2 a = {p0[2 * i], p0[2 * i + 1]}, b = {p1[2 * i], p1[2 * i + 1]};
        a = __builtin_elementwise_fma(a, c1v, nmc); b = __builtin_elementwise_fma(b, c1v, nmc);
        a.x = __builtin_amdgcn_exp2f(a.x); a.y = __builtin_amdgcn_exp2f(a.y); b.x = __builtin_amdgcn_exp2f(b.x); b.y = __builtin_amdgcn_exp2f(b.y);
        p0[2 * i] = a.x; p0[2 * i + 1] = a.y; p1[2 * i] = b.x; p1[2 * i + 1] = b.y; lsa += a; lsb += b; }
    const float ls = (lsa.x + lsa.y) + (lsb.x + lsb.y);
    if (__builtin_amdgcn_ballot_w64(grow) != 0ull) {
        const float alpha = __builtin_amdgcn_exp2f((((m < -1e29f) ? 0.f : m) - muse) * C1);
        l = l * alpha;
#pragma unroll
        for (int i = 0; i < 16; ++i) { o0[i] *= alpha; o1[i] *= alpha; }
        m = mn;
    }
    l += ls;
}
__device__ __forceinline__ void softmax_heavy(f32x16& p0, f32x16& p1, const float m, float& l, float& mxraw, bool lane_on) {
    const float mx = fmaxf(fmaxf(fmaxf(p0[0], p1[5]), fmaxf(p0[10], p1[15])), fmaxf(fmaxf(p1[0], p0[5]), fmaxf(p1[10], p0[15])));
    mxraw = lane_on ? mx : NEG;
    const float muse = (m < -1e29f) ? 0.f : m;
    const float mc = lane_on ? muse * C1 : 3.0e38f;
#if SP_SCALAR
    float ls0 = 0.f, ls1 = 0.f;
#pragma unroll
    for (int i = 0; i < 16; ++i) { p0[i] = __builtin_amdgcn_exp2f(p0[i] * C1 - mc); p1[i] = __builtin_amdgcn_exp2f(p1[i] * C1 - mc); ls0 += p0[i]; ls1 += p1[i]; }
    l += ls0 + ls1;
#else
    f32x2 lsa = {0.f, 0.f}, lsb = {0.f, 0.f}; const f32x2 c1v = {C1, C1}, nmc = {-mc, -mc};
#pragma unroll
    for (int i = 0; i < 8; ++i) {
        f32x2 a = {p0[2 * i], p0[2 * i + 1]}, b = {p1[2 * i], p1[2 * i + 1]};
        a = __builtin_elementwise_fma(a, c1v, nmc); b = __builtin_elementwise_fma(b, c1v, nmc);
        a.x = __builtin_amdgcn_exp2f(a.x); a.y = __builtin_amdgcn_exp2f(a.y); b.x = __builtin_amdgcn_exp2f(b.x); b.y = __builtin_amdgcn_exp2f(b.y);
        p0[2 * i] = a.x; p0[2 * i + 1] = a.y; p1[2 * i] = b.x; p1[2 * i + 1] = b.y; lsa += a; lsb += b; }
    l += (lsa.x + lsa.y) + (lsb.x + lsb.y);
#endif
}
__device__ __forceinline__ void softmax_light(float mxraw, float& m, float& l, f32x16& o0, f32x16& o1) {
    constexpr float THR = 8.0f / C1;
    const float mx = fmaxf(mxraw, __shfl_xor(mxraw, 32));
    const float mn = (mx > m + THR) ? mx : m;
    if (__builtin_amdgcn_ballot_w64(mn != m) != 0ull) {
        const float alpha = __builtin_amdgcn_exp2f((((m < -1e29f) ? 0.f : m) - ((mn < -1e29f) ? 0.f : mn)) * C1);
        l = l * alpha;
#pragma unroll
        for (int i = 0; i < 16; ++i) { o0[i] *= alpha; o1[i] *= alpha; }
        m = mn;
    }
}
struct Stage { u32x4 k, v; };
__device__ __forceinline__ void stage_load(Stage& st, const bf16_t* ksrc, const bf16_t* vsrc, long stride, int tid) {
    const int key = tid >> 3, dc = tid & 7, vkey = tid & 63, vdc = tid >> 6;
    st.k = *(const u32x4*)(ksrc + (long)key * stride + dc * 8); st.v = *(const u32x4*)(vsrc + (long)vkey * stride + vdc * 8);
}
__device__ __forceinline__ void stage_store(const Stage& st, LAS unsigned char* Kt, LAS unsigned char* Vt, int tid) {
    const int key = tid >> 3, dc = tid & 7, vkey = tid & 63, vdc = tid >> 6;
    *(LAS u32x4*)(Kt + key * KP + dc * 16) = st.k;
    const unsigned w[4] = {st.v.x, st.v.y, st.v.z, st.v.w};
#pragma unroll
    for (int e = 0; e < 4; ++e) { *(LAS unsigned short*)(Vt + (vdc * 8 + 2 * e) * VP + vcol(vkey) * 2) = (unsigned short)(w[e] & 0xffffu); *(LAS unsigned short*)(Vt + (vdc * 8 + 2 * e + 1) * VP + vcol(vkey) * 2) = (unsigned short)(w[e] >> 16); }
}
__device__ __forceinline__ void pp_load(u32x4 (&sg)[2], const bf16_t* src, long stride, int t256, int kind) {
    if (kind == 0) {
#pragma unroll
        for (int j = 0; j < 2; ++j) { const int c = t256 + 256 * j; sg[j] = *(const u32x4*)(src + (long)(c >> 3) * stride + (c & 7) * 8); }
    } else {
#pragma unroll
        for (int j = 0; j < 2; ++j) { const int c = t256 + 256 * j; sg[j] = *(const u32x4*)(src + (long)(c & 63) * stride + (c >> 6) * 8); }
    }
}
__device__ __forceinline__ void pp_store(const u32x4 (&sg)[2], LAS unsigned char* Kt, LAS unsigned char* Vt, int t256, int kind) {
    if (kind == 0) {
#pragma unroll
        for (int j = 0; j < 2; ++j) { const int c = t256 + 256 * j; *(LAS u32x4*)(Kt + (c >> 3) * KP + (c & 7) * 16) = sg[j]; }
    } else {
#pragma unroll
        for (int j = 0; j < 2; ++j) { const int c = t256 + 256 * j, vkey = c & 63, vdc = c >> 6; const unsigned w[4] = {sg[j].x, sg[j].y, sg[j].z, sg[j].w};
#pragma unroll
            for (int e = 0; e < 4; ++e) { *(LAS unsigned short*)(Vt + (vdc * 8 + 2 * e) * VP + vcol(vkey) * 2) = (unsigned short)(w[e] & 0xffffu); *(LAS unsigned short*)(Vt + (vdc * 8 + 2 * e + 1) * VP + vcol(vkey) * 2) = (unsigned short)(w[e] >> 16); } }
    }
}
template <int BR> __device__ __forceinline__ int pp_next(int kb, unsigned live) {
    if (BR == 1) return kb + 1;
    const unsigned rem = live & ~((2u << kb) - 1u);
    return rem ? __builtin_ctz(rem) : 32;
}
template <int BR>
__device__ __forceinline__ void pp_soft(f32x16& p0, f32x16& p1, int h, int kb, int qb, int qq, const LAS unsigned* selm, const float m, float& l, float& mxraw) {
    bool mine = true;
    if (BR == 0) mine = (selm[qq] >> kb) & 1u;
    if (kb == qb) {
#pragma unroll
        for (int e = 0; e < 16; ++e) { const int kk = crow(e, h); if (kk > qq) p0[e] = NEG; if (kk + 32 > qq) p1[e] = NEG; }
    } else if (BR == 1 && kb == qb - 8) {
#pragma unroll
        for (int e = 0; e < 16; ++e) { const int kk = crow(e, h); if (kk <= qq) p0[e] = NEG; if (kk + 32 <= qq) p1[e] = NEG; }
    }
    softmax_heavy(p0, p1, m, l, mxraw, mine);
}
template <int BR, bool PRE>
__device__ __forceinline__ void pp_stream(LAS unsigned char* lds, const bf16_t* Pb, int ld, int g, int qb, int qq, int qh, int t256, int r, int h, unsigned live, const LAS unsigned* selm,
                                          const bf16x8 (&qf)[4], u32x4 (&sg)[2], f32x16& o0, f32x16& o1, float& m, float& l) {
    const int kind = qh ^ 1;
    const int soff = (BR == 0 ? (kind == 0 ? 1536 : 1792) : (kind == 0 ? 2048 : 2304)) + g * 64;
    const int first = BR == 0 ? 0 : (qb > 8 ? qb - 8 : 0);
    const int n = BR == 0 ? __builtin_popcount(live) : (qb - first + 1);
    int kb_load = first;
    if (!PRE) pp_load(sg, Pb + (size_t)(kb_load * 64) * ld + soff, ld, t256, kind);
    kb_load = pp_next<BR>(kb_load, live);
    pp_store(sg, lds + L_K, lds + L_V, t256, kind);
    { const int kc = kb_load < qb ? kb_load : qb; pp_load(sg, Pb + (size_t)(kc * 64) * ld + soff, ld, t256, kind); kb_load = pp_next<BR>(kb_load, live); }
    __syncthreads();
    int kb = first;
    f32x16 p0, p1; float mxraw = NEG; bf16x8 pb[4];
    if (qh == 0) {
        qk(p0, p1, lds + L_K, qf, r, h);
#pragma unroll 1
        for (int i = 0; i < n; ++i) {
            pp_soft<BR>(p0, p1, h, kb, qb, qq, selm, m, l, mxraw);
            pack_p(pb, p0, p1);
            kb = pp_next<BR>(kb, live);
            PP_SYNC();
            if (i + 1 < n) pp_store(sg, lds + L_K + ((i + 1) & 1) * TILEB, lds + L_V + ((i + 1) & 1) * TILEB, t256, kind);
            { const int kc = kb_load < qb ? kb_load : qb; pp_load(sg, Pb + (size_t)(kc * 64) * ld + soff, ld, t256, kind); kb_load = pp_next<BR>(kb_load, live); }
            if (i + 1 < n) qk(p0, p1, lds + L_K + ((i + 1) & 1) * TILEB, qf, r, h);
            pv2(o0, o1, lds + L_V + (i & 1) * TILEB, pb, r, h);
            softmax_light(mxraw, m, l, o0, o1);
            PP_SYNC();
        }
    } else {
#pragma unroll 1
        for (int i = 0; i < n; ++i) {
            qk(p0, p1, lds + L_K + (i & 1) * TILEB, qf, r, h);
            if (i > 0) { pv2(o0, o1, lds + L_V + ((i - 1) & 1) * TILEB, pb, r, h); softmax_light(mxraw, m, l, o0, o1); }
            if (i + 1 < n) pp_store(sg, lds + L_K + ((i + 1) & 1) * TILEB, lds + L_V + ((i + 1) & 1) * TILEB, t256, kind);
            { const int kc = kb_load < qb ? kb_load : qb; pp_load(sg, Pb + (size_t)(kc * 64) * ld + soff, ld, t256, kind); kb_load = pp_next<BR>(kb_load, live); }
            PP_SYNC();
            pp_soft<BR>(p0, p1, h, kb, qb, qq, selm, m, l, mxraw);
            pack_p(pb, p0, p1);
            kb = pp_next<BR>(kb, live);
            PP_SYNC();
        }
        pv2(o0, o1, lds + L_V + ((n - 1) & 1) * TILEB, pb, r, h);
    }
}
__device__ __forceinline__ void st_store_k(const u32x4& k, LAS unsigned char* Kt, int tid) { const int key = tid >> 3, dc = tid & 7; *(LAS u32x4*)(Kt + key * KP + dc * 16) = k; }
__device__ __forceinline__ void st_store_v(const u32x4& v, LAS unsigned char* Vt, int tid) {
    const int vkey = tid & 63, vdc = tid >> 6; const unsigned w[4] = {v.x, v.y, v.z, v.w};
#pragma unroll
    for (int e = 0; e < 4; ++e) { *(LAS unsigned short*)(Vt + (vdc * 8 + 2 * e) * VP + vcol(vkey) * 2) = (unsigned short)(w[e] & 0xffffu); *(LAS unsigned short*)(Vt + (vdc * 8 + 2 * e + 1) * VP + vcol(vkey) * 2) = (unsigned short)(w[e] >> 16); }
}
__device__ __forceinline__ u32x4 st_load_k(const bf16_t* ksrc, long stride, int tid) { return *(const u32x4*)(ksrc + (long)(tid >> 3) * stride + (tid & 7) * 8); }
__device__ __forceinline__ u32x4 st_load_v(const bf16_t* vsrc, long stride, int tid) { return *(const u32x4*)(vsrc + (long)(tid & 63) * stride + (tid >> 6) * 8); }
template <int BR>
__device__ __forceinline__ void sp_mask(f32x16& p0, f32x16& p1, int h, int kb, int qb, int qq) {
    if (kb == qb) {
#pragma unroll
        for (int e = 0; e < 16; ++e) { const int kk = crow(e, h); if (kk > qq) p0[e] = NEG; if (kk + 32 > qq) p1[e] = NEG; }
    } else if (BR == 1 && kb == qb - 8) {
#pragma unroll
        for (int e = 0; e < 16; ++e) { const int kk = crow(e, h); if (kk <= qq) p0[e] = NEG; if (kk + 32 <= qq) p1[e] = NEG; }
    }
}
template <int BR, bool PRE>
__device__ __forceinline__ void sp_stream(LAS unsigned char* lds, const bf16_t* Pb, int ld, int g, int qb, int qq, int tid, int r, int h, unsigned live, const LAS unsigned* selm,
                                          const bf16x8 (&qf)[4], Stage& st, f32x16& o0, f32x16& o1, float& m, float& l) {
    const int koff = (BR == 0 ? 1536 : 2048) + g * 64, voff = (BR == 0 ? 1792 : 2304) + g * 64;
    const int first = BR == 0 ? 0 : (qb > 8 ? qb - 8 : 0);
    const int n = BR == 0 ? __builtin_popcount(live) : (qb - first + 1);
    int kbK = first, kbV = first;
    if (!PRE) stage_load(st, Pb + (size_t)(first * 64) * ld + koff, Pb + (size_t)(first * 64) * ld + voff, ld, tid);
    kbK = pp_next<BR>(kbK, live); kbV = kbK;
    Stage s1; { const int kc = kbK < qb ? kbK : qb; stage_load(s1, Pb + (size_t)(kc * 64) * ld + koff, Pb + (size_t)(kc * 64) * ld + voff, ld, tid); }
    kbK = pp_next<BR>(kbK, live); kbV = kbK;
    stage_store(st, lds + L_K, lds + L_V, tid);
    st_store_k(s1.k, lds + L_K + TILEB, tid); st.v = s1.v;
    { const int kc = kbK < qb ? kbK : qb; st.k = st_load_k(Pb + (size_t)(kc * 64) * ld + koff, ld, tid); kbK = pp_next<BR>(kbK, live); }
    __syncthreads();
    f32x16 p0, p1; float mxraw = NEG; bf16x8 pb[4];
    qk(p0, p1, lds + L_K, qf, r, h);
    int kb = first, rk1 = 1, rk2 = 2;
#pragma unroll 1
    for (int i = 0; i < n; ++i) {
        if (i + 2 < n) st_store_k(st.k, lds + (rk2 == 2 ? L_PQ : L_K + rk2 * TILEB), tid);
        if (i + 1 < n) st_store_v(st.v, lds + L_V + ((i + 1) & 1) * TILEB, tid);
        { const int kc = kbK < qb ? kbK : qb, vc = kbV < qb ? kbV : qb;
          st.k = st_load_k(Pb + (size_t)(kc * 64) * ld + koff, ld, tid); st.v = st_load_v(Pb + (size_t)(vc * 64) * ld + voff, ld, tid); kbK = pp_next<BR>(kbK, live); kbV = pp_next<BR>(kbV, live); }
        bool mine = true;
        if (BR == 0) mine = (selm[qq] >> kb) & 1u;
        sp_mask<BR>(p0, p1, h, kb, qb, qq);
        f32x16 n0, n1;
        {
            const LAS unsigned char* Kt = lds + (rk1 == 2 ? L_PQ : L_K + rk1 * TILEB);
            const f32x16 z = {0.f, 0.f, 0.f, 0.f, 0.f, 0.f, 0.f, 0.f, 0.f, 0.f, 0.f, 0.f, 0.f, 0.f, 0.f, 0.f};
            bf16x8 a0[4], a1[4];
#pragma unroll
            for (int s = 0; s < 4; ++s) { a0[s] = *(const LAS bf16x8*)(Kt + r * KP + (16 * s + 8 * h) * 2); a1[s] = *(const LAS bf16x8*)(Kt + (32 + r) * KP + (16 * s + 8 * h) * 2); }
            __builtin_amdgcn_sched_barrier(0);
#pragma unroll
            for (int s = 0; s < 4; ++s) {
                n0 = __builtin_amdgcn_mfma_f32_32x32x16_bf16(a0[s], qf[s], s == 0 ? z : n0, 0, 0, 0);
                n1 = __builtin_amdgcn_mfma_f32_32x32x16_bf16(a1[s], qf[s], s == 0 ? z : n1, 0, 0, 0);
            }
            softmax_heavy(p0, p1, m, l, mxraw, mine);
            pack_p(pb, p0, p1);
#pragma unroll
            for (int j = 0; j < 8; ++j) { __builtin_amdgcn_sched_group_barrier(0x008, 1, 0); __builtin_amdgcn_sched_group_barrier(0x002, SP_FILL, 0); }
            __builtin_amdgcn_sched_barrier(0);
        }
        pv2(o0, o1, lds + L_V + (i & 1) * TILEB, pb, r, h);
        softmax_light(mxraw, m, l, o0, o1);
        p0 = n0; p1 = n1; kb = pp_next<BR>(kb, live); rk1 = rk2; rk2 = rk2 == 2 ? 0 : rk2 + 1;
        __syncthreads();
    }
}
}

__device__ __forceinline__ void phase_nsa_attn_mfma(Frame& F, int slot) {
    using namespace na;
    const bf16_t* P = WSP(bf16_t, OFF_PROJ); bf16_t* ATT = WSP(bf16_t, OFF_ATT);
    const bf16_t* KCb = WSP(bf16_t, OFF_KC); const bf16_t* VCb = KCb + (size_t)128 * 128 * 64;
    const float* gb = inptr(F, I_NSA_GATE_B) + slot * 48;
    int tid = F.tid; asm volatile("; phase-local tid" : "+v"(tid));
    const int wave = __builtin_amdgcn_readfirstlane(tid >> 6), lane = tid & 63, r = lane & 31, h = lane >> 5, hh = wave & 3, qh = wave >> 2;
    const int t256 = tid & 255;
    LAS unsigned char* lds = F.lds;
    LAS float* Pq = (LAS float*)(lds + L_PQ); LAS unsigned* selm = (LAS unsigned*)(lds + L_SEL);
    const int ld = NSA_LD;
    const int qq = qh * 32 + r;
#pragma unroll 1
    for (int it = F.bx; it < 4096; it += F.G) {
        const int sl = it & 255, rnd = it >> 8, bg = sl >> 1, par = sl & 1, qb = (rnd & 1) ? (31 - 2 * (rnd >> 1) - par) : (2 * (rnd >> 1) + par);
        const int b = bg >> 2, g = bg & 3, t = qb * 64 + qq;
        const bf16_t* Pb = P + (size_t)b * T * ld;
        const bf16_t* prow = Pb + (size_t)t * ld;
        bf16x8 qf[4];
#pragma unroll
        for (int s = 0; s < 4; ++s) qf[s] = *(const bf16x8*)(prow + g * 256 + hh * 64 + 16 * s + 8 * h);
        float gt[3];
#pragma unroll
        for (int j = 0; j < 3; ++j) gt[j] = sigmoidf_(bf2f(prow[2560 + g * 12 + hh * 3 + j]) + gb[g * 12 + hh * 3 + j]);
        LAS float* gsave = (LAS float*)(lds + L_SEL + 512) + tid * 2; gsave[0] = gt[1]; gsave[1] = gt[2];
        if (tid == 0) selm[64] = 0u;
        Stage st0, st1;
        stage_load(st0, KCb + (size_t)bg * 128 * 64, VCb + (size_t)bg * 128 * 64, 64, tid);
        stage_load(st1, KCb + (size_t)bg * 128 * 64 + 64 * 64, VCb + (size_t)bg * 128 * 64 + 64 * 64, 64, tid);
        stage_store(st0, lds + L_K, lds + L_V, tid);
        stage_store(st1, lds + L_K + TILEB, lds + L_V + TILEB, tid);
        __syncthreads();
        LAS float* oaL = (LAS float*)(lds + L_OA) + tid;
#pragma unroll 1
        for (int xr_ = 0; xr_ <= XCMP; ++xr_)
        {
            const int cmax = (t >= 31) ? (((t - 31) >> 4) < 126 ? ((t - 31) >> 4) : 126) : -1;
            f32x16 o0, o1; float m = NEG, l = 0.f;
#pragma unroll
            for (int i = 0; i < 16; ++i) { o0[i] = 0.f; o1[i] = 0.f; }
#pragma unroll 1
            for (int tl = 0; tl < 2; ++tl) {
                f32x16 p0, p1;
                qk(p0, p1, lds + L_K + tl * TILEB, qf, r, h);
#pragma unroll
                for (int i = 0; i < 16; ++i) { const int c = 64 * tl + crow(i, h); if (c > cmax) p0[i] = NEG; if (c + 32 > cmax) p1[i] = NEG; }
                softmax_step(p0, p1, m, l, o0, o1);
                pv(o0, o1, lds + L_V + tl * TILEB, p0, p1, r, h);
            }
            l += __shfl_xor(l, 32);
            const float inv = l > 0.f ? 1.0f / l : 0.f;
            const float cf = gt[0] * inv;
#pragma unroll
            for (int i = 0; i < 16; ++i) { oaL[512 * i] = cf * o0[i]; oaL[512 * (16 + i)] = cf * o1[i]; }
            const float mc = ((m < -1e29f) ? 0.f : m) * C1;
            LAS float* slab = Pq + hh * SLB + qq * 33;
#pragma unroll 1
            for (int tl = 1; tl >= 0; --tl) {
                f32x16 p0, p1;
                qk(p0, p1, lds + L_K + tl * TILEB, qf, r, h);
#pragma unroll
                for (int i = 0; i < 16; ++i) { const int c = 64 * tl + crow(i, h);
                    p0[i] = (c > cmax) ? 0.f : __builtin_amdgcn_exp2f(p0[i] * C1 - mc) * inv; p1[i] = (c + 32 > cmax) ? 0.f : __builtin_amdgcn_exp2f(p1[i] * C1 - mc) * inv; }
#pragma unroll
                for (int k = 0; k < 4; ++k) {
                    slab[16 * tl + 2 * k + h] = 2.0f * (p0[4 * k] + p0[4 * k + 1] + p0[4 * k + 2]) + p0[4 * k + 3];
                    slab[16 * tl + 8 + 2 * k + h] = 2.0f * (p1[4 * k] + p1[4 * k + 1] + p1[4 * k + 2]) + p1[4 * k + 3]; }
                LDS_WAIT();
#pragma unroll
                for (int k = 0; k < 4; ++k) { const int s0 = 16 * tl + 2 * k + h + 1, s1 = 16 * tl + 8 + 2 * k + h + 1;
                    slab[s0] += p0[4 * k + 3]; if (s1 < 32) slab[s1] += p1[4 * k + 3]; }
                LDS_WAIT();
            }
        }
        __syncthreads();
        Stage st;
        stage_load(st, Pb + 1536 + g * 64, Pb + 1792 + g * 64, ld, tid);
#pragma unroll 1
        for (int xr_ = 0; xr_ <= XSELN; ++xr_)
        {
            const int cur = qb, q = tid >> 3, sub = tid & 7;
            float scv[4];
#pragma unroll
            for (int j = 0; j < 4; ++j) { const int s_ = 4 * sub + j; const LAS float* pr = Pq + q * 33 + s_;
                const float imp = (pr[0] + pr[SLB]) + (pr[2 * SLB] + pr[3 * SLB]);
                const bool forced = (s_ == 0) || (s_ == cur) || (s_ == cur - 1);
                scv[j] = forced ? 1e30f : (s_ <= cur ? imp : NEG); }
            unsigned mask = 0u;
#pragma unroll 1
            for (int rd = 0; rd < 8; ++rd) {
                float bv = scv[0]; int bi = 4 * sub;
#pragma unroll
                for (int j = 1; j < 4; ++j) if (scv[j] > bv) { bv = scv[j]; bi = 4 * sub + j; }
#define SEL_STEP(CTRL) { const float ov = dppf<CTRL>(bv); const int oi = __float_as_int(dppf<CTRL>(__int_as_float(bi))); if (ov > bv || (ov == bv && oi < bi)) { bv = ov; bi = oi; } }
                SEL_STEP(0xB1) SEL_STEP(0x4E) SEL_STEP(0x141)
#undef SEL_STEP
                if (bv > -0.5e30f) mask |= 1u << bi;
#pragma unroll
                for (int j = 0; j < 4; ++j) if (bi == 4 * sub + j) scv[j] = -INFINITY;
            }
            if (sub == 0) selm[q] = mask;
            unsigned any = mask;
#pragma unroll
            for (int o = 8; o < 64; o <<= 1) any |= __shfl_xor(any, o);
            if (lane == 0) __hip_atomic_fetch_or(selm + 64, any, __ATOMIC_RELAXED, __HIP_MEMORY_SCOPE_WORKGROUP);
            __syncthreads();
        }
        const unsigned anymask = __builtin_amdgcn_readfirstlane(selm[64]);
        {
            f32x16 o0, o1; float m = NEG, l = 0.f;
#pragma unroll
            for (int i = 0; i < 16; ++i) { o0[i] = 0.f; o1[i] = 0.f; }
            const unsigned live = anymask & (qb == 31 ? 0xffffffffu : ((2u << qb) - 1u));
            sp_stream<0, true>(lds, Pb, ld, g, qb, qq, tid, r, h, live, selm, qf, st, o0, o1, m, l);
            l += __shfl_xor(l, 32);
            const float cf = l > 0.f ? gsave[0] / l : 0.f;
#pragma unroll
            for (int i = 0; i < 16; ++i) { oaL[512 * i] += cf * o0[i]; oaL[512 * (16 + i)] += cf * o1[i]; }
        }
        __syncthreads();
        {
            f32x16 o0, o1; float m = NEG, l = 0.f;
#pragma unroll
            for (int i = 0; i < 16; ++i) { o0[i] = 0.f; o1[i] = 0.f; }
            sp_stream<1, false>(lds, Pb, ld, g, qb, qq, tid, r, h, 0u, selm, qf, st, o0, o1, m, l);
            l += __shfl_xor(l, 32);
            const float cf = l > 0.f ? gsave[1] / l : 0.f;
#pragma unroll
            for (int i = 0; i < 16; ++i) { o0[i] = oaL[512 * i] + cf * o0[i]; o1[i] = oaL[512 * (16 + i)] + cf * o1[i]; }
            bf16_t* orow = ATT + (size_t)(b * T + t) * D + (g * 4 + hh) * 64 + 4 * h;
#pragma unroll 1
            for (int xr_ = 0; xr_ <= XOUT; ++xr_)
#pragma unroll
            for (int k = 0; k < 4; ++k) {
                u32x2 w0, w1; w0.x = pg8::cvt_pk_bf16(o0[4 * k], o0[4 * k + 1]); w0.y = pg8::cvt_pk_bf16(o0[4 * k + 2], o0[4 * k + 3]);
                w1.x = pg8::cvt_pk_bf16(o1[4 * k], o1[4 * k + 1]); w1.y = pg8::cvt_pk_bf16(o1[4 * k + 2], o1[4 * k + 3]);
                *(u32x2*)(orow + 8 * k) = w0; *(u32x2*)(orow + 32 + 8 * k) = w1;
            }
        }
        __syncthreads();
    }
}
__device__ __forceinline__ float logsigmoidf_(float x) { return fminf(x, 0.f) - log1pf(__expf(-fabsf(x))); }
__device__ __forceinline__ void phase_mlstm_scan(Frame& F) {
    constexpr int QP = 132;
    LAS float* qL = (LAS float*)F.lds;
    LAS float* kL = qL + 64 * QP;
    LAS float* vL = kL + 64 * QP;
    LAS float* SL = vL + 64 * 128;
    LAS float* vec = SL + 64 * 68;
    LAS float* bL = vec;
    LAS float* liL = vec + 64;
    LAS float* mtL = vec + 128;
    LAS float* wiL = vec + 192;
    LAS float* dnL = vec + 256;
    LAS float* wkL = vec + 320;
    LAS float* nL = vec + 384;
    LAS float* scl = vec + 512;
    LAS float* rsL = vec + 576;
    LAS float* qnL = vec + 640;
    const bf16_t* P = WSP(bf16_t, OFF_PROJ); bf16_t* HO = WSP(bf16_t, OFF_HM);
    int tid = F.tid; asm volatile("; phase-local tid" : "+v"(tid));
    const int lane = tid & 63, ld = ML_LD;
    int v_ = tid >> 2, kq = tid & 3;
    for (int item = F.bx; item < BATCH * 4 * 2; item += F.G) {
        const int vh = item & 1, h = (item >> 1) & 3, b = item >> 3;
        float C[32];
#pragma unroll
        for (int j = 0; j < 32; ++j) C[j] = 0.f;
        if (tid < 128) nL[tid] = 0.f;
        if (tid == 0) scl[0] = 0.f;
        __syncthreads();
#pragma unroll 1
        for (int ch = 0; ch < T / 64; ++ch) {
            asm volatile("; chunk-local" : "+v"(v_), "+v"(kq), "+v"(tid));
            const int t0 = ch * 64; const bf16_t* Pc = P + (size_t)(b * T + t0) * ld;
            {
                const int c2 = tid & 255, part = tid >> 8;
                const int col = (c2 < 128) ? (h * 128 + c2) : (512 + h * 128 + (c2 - 128));
                const float w0 = inptr(F, I_ML_CONV_W)[0 * 1024 + col], w1 = inptr(F, I_ML_CONV_W)[1 * 1024 + col], w2 = inptr(F, I_ML_CONV_W)[2 * 1024 + col], w3 = inptr(F, I_ML_CONV_W)[3 * 1024 + col], cb = inptr(F, I_ML_CONV_B)[col];
                const float scale = (c2 < 128) ? 1.0f : 0.08838834764831845f;
                const int r0 = part * 32;
                float x0 = (t0 + r0 - 3 >= 0) ? bf2f(Pc[(long)(r0 - 3) * ld + col]) : 0.f;
                float x1 = (t0 + r0 - 2 >= 0) ? bf2f(Pc[(long)(r0 - 2) * ld + col]) : 0.f;
                float x2 = (t0 + r0 - 1 >= 0) ? bf2f(Pc[(long)(r0 - 1) * ld + col]) : 0.f;
                LAS float* dst = (c2 < 128) ? (qL + c2) : (kL + (c2 - 128));
                for (int r = r0; r < r0 + 32; ++r) { const float x3 = bf2f(Pc[(long)r * ld + col]);
                    const float y = w0 * x0 + w1 * x1 + w2 * x2 + w3 * x3 + cb; dst[r * QP] = y * sigmoidf_(y) * scale; x0 = x1; x1 = x2; x2 = x3; }
                const int vc = tid & 127, vp = tid >> 7;
                for (int r = vp * 16; r < vp * 16 + 16; ++r) vL[r * 128 + vc] = bf2f(Pc[(long)r * ld + 1024 + h * 256 + vh * 128 + vc]);
                if (tid < 64) { liL[tid] = bf2f(Pc[(long)tid * ld + 3072 + h]) + inptr(F, I_ML_GATE_B)[h];
                    bL[tid] = logsigmoidf_(bf2f(Pc[(long)tid * ld + 3076 + h]) + inptr(F, I_ML_GATE_B)[4 + h]); }
            }
            __syncthreads();
            if (tid < 64) {
                float bb = bL[lane];
#pragma unroll
                for (int o = 1; o < 64; o <<= 1) { const float u = __shfl_up(bb, o); if (lane >= o) bb += u; }
                const float li = liL[lane]; float pm = li - bb;
#pragma unroll
                for (int o = 1; o < 64; o <<= 1) { const float u = __shfl_up(pm, o); if (lane >= o) pm = fmaxf(pm, u); }
                const float mprev = scl[0];
                const float mt = fmaxf(bb + mprev, bb + pm);
                const float bend = __shfl(bb, 63);
                const float decay = bend - bb + li;
                const float mnew = fmaxf(bend + mprev, wave_max(decay));
                bL[lane] = bb; mtL[lane] = mt; wiL[lane] = __expf(bb + mprev - mt); wkL[lane] = __expf(decay - mnew);
                if (lane == 0) { scl[1] = __expf(bend + mprev - mnew); scl[2] = mnew; }
            }
            __syncthreads();
            {
                const int t = tid >> 3, sg = tid & 7;
                float a[8];
#pragma unroll
                for (int j = 0; j < 8; ++j) a[j] = 0.f;
#pragma unroll 1
                for (int k4 = 0; k4 < 32; ++k4) { const f32x4 qv = *(const LAS f32x4*)(qL + t * QP + k4 * 4);
#pragma unroll
                    for (int j = 0; j < 8; ++j) { const f32x4 kv = *(const LAS f32x4*)(kL + (sg + 8 * j) * QP + k4 * 4); a[j] += (qv[0] * kv[0] + qv[1] * kv[1]) + (qv[2] * kv[2] + qv[3] * kv[3]); } }
                const float bt = bL[t], mt = mtL[t];
#pragma unroll
                for (int j = 0; j < 8; ++j) { const int s = sg + 8 * j; SL[t * 68 + s] = (s <= t) ? a[j] * __expf(bt - bL[s] + liL[s] - mt) : 0.f; }
            }
            __syncthreads();
            if (tid < 64) { float rs = 0.f; for (int s = 0; s < 64; ++s) rs += SL[tid * 68 + s]; rsL[tid] = rs; }
            else if (tid < 128) { const int t = tid - 64; float qn = 0.f; for (int k = 0; k < 128; ++k) qn += qL[t * QP + k] * nL[k]; qnL[t] = qn; }
            __syncthreads();
            if (tid < 64) { const float den = rsL[tid] + wiL[tid] * qnL[tid]; dnL[tid] = 1.0f / fmaxf(fabsf(den), __expf(-mtL[tid])); }
            __syncthreads();
            {
                float vr[16];
#pragma unroll
                for (int j = 0; j < 16; ++j) vr[j] = vL[(kq * 16 + j) * 128 + v_];
#pragma unroll 1
                for (int tg = 0; tg < 4; ++tg) {
                    float res[4];
#pragma unroll
                    for (int ti = 0; ti < 16; ++ti) { const int t = tg * 16 + ti;
                        float aC = 0.f, aS = 0.f;
#pragma unroll
                        for (int j4 = 0; j4 < 8; ++j4) { const f32x4 qv = *(const LAS f32x4*)(qL + t * QP + kq * 32 + j4 * 4);
                            aC += (qv[0] * C[j4 * 4] + qv[1] * C[j4 * 4 + 1]) + (qv[2] * C[j4 * 4 + 2] + qv[3] * C[j4 * 4 + 3]); }
#pragma unroll
                        for (int j4 = 0; j4 < 4; ++j4) { const f32x4 sv = *(const LAS f32x4*)(SL + t * 68 + kq * 16 + j4 * 4);
                            aS += (sv[0] * vr[j4 * 4] + sv[1] * vr[j4 * 4 + 1]) + (sv[2] * vr[j4 * 4 + 2] + sv[3] * vr[j4 * 4 + 3]); }
                        float tot = aS + wiL[t] * aC;
                        tot += __shfl_xor(tot, 1); tot += __shfl_xor(tot, 2);
                        tot *= dnL[t];
                        if ((ti & 3) == kq) res[ti >> 2] = tot;
                        asm volatile("" ::: "memory");
                    }
#pragma unroll
                    for (int q = 0; q < 4; ++q) { const int t = tg * 16 + q * 4 + kq; HO[(size_t)(b * T + t0 + t) * D + h * 256 + vh * 128 + v_] = (bf16_t)f2bf(res[q]); }
                }
            }
            __syncthreads();
            {
                const float cs = scl[1];
#pragma unroll
                for (int j = 0; j < 32; ++j) C[j] *= cs;
#pragma unroll 2
                for (int s = 0; s < 64; ++s) { const float a = vL[s * 128 + v_] * wkL[s];
#pragma unroll
                    for (int j4 = 0; j4 < 8; ++j4) { const f32x4 kv = *(const LAS f32x4*)(kL + s * QP + kq * 32 + j4 * 4);
                        C[j4 * 4] += a * kv[0]; C[j4 * 4 + 1] += a * kv[1]; C[j4 * 4 + 2] += a * kv[2]; C[j4 * 4 + 3] += a * kv[3]; } }
                if (tid < 128) { float nn = nL[tid] * cs; for (int s = 0; s < 64; ++s) nn += wkL[s] * kL[s * QP + tid]; nL[tid] = nn; }
                if (tid == 0) scl[0] = scl[2];
            }
            __syncthreads();
        }
    }
}
template <int HD>
__device__ __forceinline__ void phase_norm_gate(Frame& F, const float* norm_g, int ld, int gate_col0) {
    const bf16_t* HI = WSP(bf16_t, OFF_HM); const bf16_t* P = WSP(bf16_t, OFF_PROJ); bf16_t* ATT = WSP(bf16_t, OFF_ATT);
    int lane = F.lane; asm volatile("; phase-local lane" : "+v"(lane)); const int gw = F.bx * 8 + F.wave, NGW = F.G * 8;
    u32x2 hq[4], gq[4];
    f32x4 ngr[4];
#pragma unroll
    for (int j = 0; j < 4; ++j) ngr[j] = *((const f32x4*)norm_g + lane + 64 * j);
    if (gw < NTOK) { const u32x2* hr = (const u32x2*)(HI + (size_t)gw * D) + lane; const u32x2* gr = (const u32x2*)(P + (size_t)gw * ld + gate_col0) + lane;
#pragma unroll
        for (int j = 0; j < 4; ++j) { hq[j] = hr[64 * j]; gq[j] = gr[64 * j]; } }
#pragma unroll 1
    for (int m = gw; m < NTOK; m += NGW) {
        u32x2 hc[4], gc[4];
#pragma unroll
        for (int j = 0; j < 4; ++j) { hc[j] = hq[j]; gc[j] = gq[j]; }
        if (m + NGW < NTOK) { const u32x2* hr = (const u32x2*)(HI + (size_t)(m + NGW) * D) + lane; const u32x2* gr = (const u32x2*)(P + (size_t)(m + NGW) * ld + gate_col0) + lane;
#pragma unroll
            for (int j = 0; j < 4; ++j) { hq[j] = hr[64 * j]; gq[j] = gr[64 * j]; } }
        u32x2* orow = (u32x2*)(ATT + (size_t)m * D) + lane;
#pragma unroll
        for (int j = 0; j < 4; ++j) {
            const u32x2 hv = hc[j], gv = gc[j];
            float x[4] = {__uint_as_float(hv.x << 16), __uint_as_float(hv.x & 0xffff0000u), __uint_as_float(hv.y << 16), __uint_as_float(hv.y & 0xffff0000u)};
            const float gt[4] = {__uint_as_float(gv.x << 16), __uint_as_float(gv.x & 0xffff0000u), __uint_as_float(gv.y << 16), __uint_as_float(gv.y & 0xffff0000u)};
            float ss = (x[0] * x[0] + x[1] * x[1]) + (x[2] * x[2] + x[3] * x[3]);
#pragma unroll
            for (int o = 1; o < (HD == 256 ? 64 : 32); o <<= 1) ss += __shfl_xor(ss, o);
            const float r = __builtin_amdgcn_rsqf(ss * (1.0f / HD) + RMS_EPS);
            const f32x4 ng = ngr[j];
            float o4[4];
#pragma unroll
            for (int q = 0; q < 4; ++q) o4[q] = x[q] * r * ng[q] * sigmoidf_(gt[q]);
            u32x2 o; o.x = pk2(o4[0], o4[1]); o.y = pk2(o4[2], o4[3]); orow[64 * j] = o;
        }
    }
}

__device__ __forceinline__ void phase_hgrn_scan(Frame& F) {
    constexpr int QP = 132;
    LAS float* qL = (LAS float*)F.lds;
    LAS float* kL = qL + 32 * QP;
    LAS float* vL = kL + 32 * QP;
    LAS float* AL = vL + 32 * 128;
    LAS float* geL = AL + 32 * 36;
    const bf16_t* P = WSP(bf16_t, OFF_PROJ); bf16_t* HO = WSP(bf16_t, OFF_HM);
    const float* lbt = WSP(float, OFF_TAB) + TAB_LB;
    int tid = F.tid; asm volatile("; phase-local tid" : "+v"(tid));
    const int ld = HG_LD;
    int v_ = tid >> 2, kq = tid & 3;
    for (int item = F.bx; item < BATCH * 8; item += F.G) {
        const int h = item & 7, b = item >> 3;
        float S[32];
#pragma unroll
        for (int j = 0; j < 32; ++j) S[j] = 0.f;
#pragma unroll 1
        for (int ch = 0; ch < T / 32; ++ch) {
            asm volatile("; chunk-local" : "+v"(v_), "+v"(kq), "+v"(tid));
            const int t0 = ch * 32; const bf16_t* Pc = P + (size_t)(b * T + t0) * ld;
            { const int c = tid & 127, p4 = tid >> 7;
#pragma unroll 2
              for (int r = p4 * 8; r < p4 * 8 + 8; ++r) { qL[r * QP + c] = bf2f(Pc[(long)r * ld + h * 128 + c]); kL[r * QP + c] = bf2f(Pc[(long)r * ld + 1024 + h * 128 + c]); vL[r * 128 + c] = bf2f(Pc[(long)r * ld + 2048 + h * 128 + c]); } }
            __syncthreads();
            if (tid < 128) { const float lb = lbt[h * 128 + tid]; float G = 0.f;
#pragma unroll 2
                for (int r = 0; r < 32; ++r) { const float qr = qL[r * QP + tid], fr = kL[r * QP + tid];
                    const float f = lb + (1.0f - lb) * sigmoidf_(fr); G += __logf(f);
                    qL[r * QP + tid] = qr * sigmoidf_(qr) * __expf(G); kL[r * QP + tid] = (1.0f - f) * __expf(-G); }
                geL[tid] = __expf(G); }
            __syncthreads();
            { const int t = tid >> 4, sg = tid & 15;
              float a0 = 0.f, a1 = 0.f;
#pragma unroll 2
              for (int k4 = 0; k4 < 32; ++k4) { const f32x4 qv = *(const LAS f32x4*)(qL + t * QP + k4 * 4);
                  const f32x4 k0 = *(const LAS f32x4*)(kL + sg * QP + k4 * 4), k1 = *(const LAS f32x4*)(kL + (sg + 16) * QP + k4 * 4);
                  a0 += (qv[0] * k0[0] + qv[1] * k0[1]) + (qv[2] * k0[2] + qv[3] * k0[3]); a1 += (qv[0] * k1[0] + qv[1] * k1[1]) + (qv[2] * k1[2] + qv[3] * k1[3]); }
              AL[t * 36 + sg] = (sg <= t) ? a0 : 0.f; AL[t * 36 + sg + 16] = (sg + 16 <= t) ? a1 : 0.f; }
            __syncthreads();
            {
                float vr[8];
#pragma unroll
                for (int j = 0; j < 8; ++j) vr[j] = vL[(kq * 8 + j) * 128 + v_];
#pragma unroll 2
                for (int t = 0; t < 32; ++t) {
                    float a = 0.f;
#pragma unroll
                    for (int j4 = 0; j4 < 8; ++j4) { const f32x4 qv = *(const LAS f32x4*)(qL + t * QP + kq * 32 + j4 * 4);
                        a += (qv[0] * S[j4 * 4] + qv[1] * S[j4 * 4 + 1]) + (qv[2] * S[j4 * 4 + 2] + qv[3] * S[j4 * 4 + 3]); }
#pragma unroll
                    for (int j4 = 0; j4 < 2; ++j4) { const f32x4 sv = *(const LAS f32x4*)(AL + t * 36 + kq * 8 + j4 * 4);
                        a += (sv[0] * vr[j4 * 4] + sv[1] * vr[j4 * 4 + 1]) + (sv[2] * vr[j4 * 4 + 2] + sv[3] * vr[j4 * 4 + 3]); }
                    a += __shfl_xor(a, 1); a += __shfl_xor(a, 2);
                    if ((t & 3) == kq) HO[(size_t)(b * T + t0 + t) * D + h * 128 + v_] = (bf16_t)f2bf(a);
                    asm volatile("" ::: "memory");
                }
            }
            {
#pragma unroll 2
                for (int s = 0; s < 32; ++s) { const float a = vL[s * 128 + v_];
#pragma unroll
                    for (int j4 = 0; j4 < 8; ++j4) { const f32x4 kv = *(const LAS f32x4*)(kL + s * QP + kq * 32 + j4 * 4);
                        S[j4 * 4] += a * kv[0]; S[j4 * 4 + 1] += a * kv[1]; S[j4 * 4 + 2] += a * kv[2]; S[j4 * 4 + 3] += a * kv[3]; } }
#pragma unroll
                for (int j4 = 0; j4 < 8; ++j4) { const f32x4 ge = *(const LAS f32x4*)(geL + kq * 32 + j4 * 4);
                    S[j4 * 4] *= ge[0]; S[j4 * 4 + 1] *= ge[1]; S[j4 * 4 + 2] *= ge[2]; S[j4 * 4 + 3] *= ge[3]; }
            }
            __syncthreads();
        }
    }
}
namespace ml {
constexpr int PK = 272, PS = 144;
constexpr int L_Q = 0, L_KK = L_Q + 64 * PK, L_KWT = L_KK + 64 * PK, L_VT = L_KWT + 128 * PS, L_S = L_VT + 144 * PS, L_C = L_S + 64 * PS, L_VEC = L_C + 144 * PK;
typedef float f32x4_ __attribute__((ext_vector_type(4)));
__device__ __forceinline__ bf16x8 frag(const LAS unsigned char* base, int row, int pitch, int kelem) { return *(const LAS bf16x8*)(base + row * pitch + kelem * 2); }
}
__device__ __forceinline__ void phase_mlstm_scan_mfma(Frame& F) {
    using namespace ml;
    LAS unsigned char* lds = F.lds;
    LAS float* vec = (LAS float*)(lds + L_VEC);
    LAS float* bL = vec; LAS float* liL = vec + 64; LAS float* mtL = vec + 128; LAS float* wiL = vec + 192; LAS float* wkL = vec + 256; LAS float* scl = vec + 320;
    const bf16_t* P = WSP(bf16_t, OFF_PROJ); bf16_t* HO = WSP(bf16_t, OFF_HM);
    int tid = F.tid; asm volatile("; phase-local tid" : "+v"(tid));
    const int lane = tid & 63, wave = __builtin_amdgcn_readfirstlane(tid >> 6), ld = ML_LD;
    const int fr = lane & 15, fg = lane >> 4;
#pragma unroll 1
    for (int item = F.bx; item < BATCH * 4 * 2; item += F.G) {
        const int vh = item & 1, h = (item >> 1) & 3, b = item >> 3;
        f32x4 Cacc[9];
#pragma unroll
        for (int j = 0; j < 9; ++j) Cacc[j] = (f32x4){0.f, 0.f, 0.f, 0.f};
        for (int i = tid; i < 16 * 64; i += 512) { const int rr = i >> 6, s = i & 63; *(LAS unsigned short*)(lds + L_VT + (128 + rr) * PS + s * 2) = (rr == 0) ? (unsigned short)0x3F80 : (unsigned short)0; }
        for (int i = tid; i < 144 * PK / 4; i += 512) ((LAS unsigned*)(lds + L_C))[i] = 0u;
        if (tid == 0) scl[0] = 0.f;
        const int c2 = tid & 255, part = __builtin_amdgcn_readfirstlane(tid >> 8);
        const int col = (c2 < 128) ? (h * 128 + c2) : (512 + h * 128 + (c2 - 128));
        const float* cw = inptr(F, I_ML_CONV_W); const float* cbp = inptr(F, I_ML_CONV_B); const float* gbp = inptr(F, I_ML_GATE_B);
        const float w0 = cw[0 * 1024 + col], w1 = cw[1 * 1024 + col], w2 = cw[2 * 1024 + col], w3 = cw[3 * 1024 + col], cb = cbp[col];
        const float gbi = gbp[h], gbf = gbp[4 + h];
        const float qscale = (c2 < 128) ? 1.0f : 0.08838834764831845f;
        unsigned short xn[35]; u32x4 vn[2]; unsigned short gin = 0, gfn = 0;
        { const bf16_t* Pc = P + (size_t)(b * T) * ld; const int r0 = part * 32;
          const bf16_t* rp = Pc + (long)(r0 - 3) * ld;
#pragma unroll
          for (int i = 0; i < 35; ++i) { xn[i] = (r0 - 3 + i >= 0) ? rp[col] : (unsigned short)0; rp += ld; asm volatile("" : "+s"(rp)); }
          const int key = tid >> 3, dc = tid & 7;
#pragma unroll
          for (int q = 0; q < 2; ++q) vn[q] = *(const u32x4*)(Pc + (long)key * ld + 1024 + h * 256 + vh * 128 + (dc + 8 * q) * 8);
          if (wave == 0) { gin = Pc[(long)lane * ld + 3072 + h]; gfn = Pc[(long)lane * ld + 3076 + h]; } }
        __syncthreads();
#pragma unroll 1
        for (int ch = 0; ch < T / 64; ++ch) {
            const int t0 = ch * 64; const bf16_t* Pc = P + (size_t)(b * T + t0) * ld;
            if (wave == 0) {
                const float li = bf2f(gin) + gbi;
                float bb = logsigmoidf_(bf2f(gfn) + gbf);
#pragma unroll
                for (int o = 1; o < 64; o <<= 1) { const float u = __shfl_up(bb, o); if (lane >= o) bb += u; }
                float pm = li - bb;
#pragma unroll
                for (int o = 1; o < 64; o <<= 1) { const float u = __shfl_up(pm, o); if (lane >= o) pm = fmaxf(pm, u); }
                const float mprev = scl[0];
                const float mt = fmaxf(bb + mprev, bb + pm);
                const float bend = __shfl(bb, 63);
                const float decay = bend - bb + li;
                const float mnew = fmaxf(bend + mprev, wave_max(decay));
                bL[lane] = bb; liL[lane] = li; mtL[lane] = mt; wiL[lane] = __expf(bb + mprev - mt); wkL[lane] = __expf(decay - mnew);
                if (lane == 0) { scl[1] = __expf(bend + mprev - mnew); scl[2] = mnew; }
            }
            __syncthreads();
            {
                const int r0 = part * 32;
                LAS unsigned char* rowbase = lds + ((c2 < 128) ? L_Q : L_KK) + (c2 & 127) * 2;
#pragma unroll
                for (int i = 0; i < 32; ++i) { const int rr = r0 + i;
                    const float y = w0 * bf2f(xn[i]) + w1 * bf2f(xn[i + 1]) + w2 * bf2f(xn[i + 2]) + w3 * bf2f(xn[i + 3]) + cb; const float o = y * sigmoidf_(y) * qscale;
                    *(LAS unsigned short*)(rowbase + rr * PK) = (unsigned short)f2bf(o);
                    if (c2 >= 128) *(LAS unsigned short*)(lds + L_KWT + (c2 - 128) * PS + rr * 2) = (unsigned short)f2bf(o * wkL[rr]);
                    if ((i & 3) == 3) asm volatile("" ::: "memory"); }
                const int key = tid >> 3, dc = tid & 7;
#pragma unroll
                for (int q = 0; q < 2; ++q) { const unsigned w[4] = {vn[q].x, vn[q].y, vn[q].z, vn[q].w};
#pragma unroll
                    for (int e = 0; e < 4; ++e) { const int vrow = (dc + 8 * q) * 8 + 2 * e;
                        *(LAS unsigned short*)(lds + L_VT + vrow * PS + key * 2) = (unsigned short)(w[e] & 0xffffu); *(LAS unsigned short*)(lds + L_VT + (vrow + 1) * PS + key * 2) = (unsigned short)(w[e] >> 16); } }
            }
            if (ch + 1 < T / 64) {
                const bf16_t* Pn = Pc + (size_t)64 * ld; const int r0 = part * 32;
                const bf16_t* rp = Pn + (long)(r0 - 3) * ld;
#pragma unroll
                for (int i = 0; i < 35; ++i) { xn[i] = rp[col]; rp += ld; asm volatile("" : "+s"(rp)); }
                const int key = tid >> 3, dc = tid & 7;
#pragma unroll
                for (int q = 0; q < 2; ++q) vn[q] = *(const u32x4*)(Pn + (long)key * ld + 1024 + h * 256 + vh * 128 + (dc + 8 * q) * 8);
                if (wave == 0) { gin = Pn[(long)lane * ld + 3072 + h]; gfn = Pn[(long)lane * ld + 3076 + h]; }
            }
            __syncthreads();
#pragma unroll
            for (int q = 0; q < 2; ++q) {
                const int idx = 2 * wave + q, ti = idx >> 2, tj = idx & 3;
                f32x4 a = (f32x4){0.f, 0.f, 0.f, 0.f};
                if (ti <= tj) {
#pragma unroll
                    for (int ks = 0; ks < 4; ++ks) a = __builtin_amdgcn_mfma_f32_16x16x32_bf16(frag(lds + L_KK, 16 * ti + fr, PK, 32 * ks + 8 * fg), frag(lds + L_Q, 16 * tj + fr, PK, 32 * ks + 8 * fg), a, 0, 0, 0);
                    const int t = 16 * tj + fr; const float bt = bL[t], mt = mtL[t];
#pragma unroll
                    for (int e = 0; e < 4; ++e) { const int s = 16 * ti + 4 * fg + e; a[e] = (s <= t) ? a[e] * __expf(bt - bL[s] + liL[s] - mt) : 0.f; }
                }
                u32x2 w; w.x = pg8::cvt_pk_bf16(a[0], a[1]); w.y = pg8::cvt_pk_bf16(a[2], a[3]);
                *(LAS u32x2*)(lds + L_S + (16 * tj + fr) * PS + (16 * ti + 4 * fg) * 2) = w;
            }
            __syncthreads();
            {
#pragma unroll 1
                for (int tj = 0; tj < 4; ++tj) {
                    f32x4 a1 = (f32x4){0.f, 0.f, 0.f, 0.f}, a2 = a1, d1 = a1, d2 = a1;
#pragma unroll
                    for (int ks = 0; ks < 2; ++ks) { const bf16x8 bs = frag(lds + L_S, 16 * tj + fr, PS, 32 * ks + 8 * fg);
                        a1 = __builtin_amdgcn_mfma_f32_16x16x32_bf16(frag(lds + L_VT, 16 * wave + fr, PS, 32 * ks + 8 * fg), bs, a1, 0, 0, 0);
                        d1 = __builtin_amdgcn_mfma_f32_16x16x32_bf16(frag(lds + L_VT, 128 + fr, PS, 32 * ks + 8 * fg), bs, d1, 0, 0, 0); }
#pragma unroll
                    for (int ks = 0; ks < 4; ++ks) { const bf16x8 bq = frag(lds + L_Q, 16 * tj + fr, PK, 32 * ks + 8 * fg);
                        a2 = __builtin_amdgcn_mfma_f32_16x16x32_bf16(frag(lds + L_C, 16 * wave + fr, PK, 32 * ks + 8 * fg), bq, a2, 0, 0, 0);
                        d2 = __builtin_amdgcn_mfma_f32_16x16x32_bf16(frag(lds + L_C, 128 + fr, PK, 32 * ks + 8 * fg), bq, d2, 0, 0, 0); }
                    const int t = 16 * tj + fr; const float wi = wiL[t];
                    float den = d1[0] + wi * d2[0];
                    den = __shfl(den, fr);
                    const float inv = __builtin_amdgcn_rcpf(fmaxf(fabsf(den), __expf(-mtL[t])));
                    u32x2 w; w.x = pg8::cvt_pk_bf16((a1[0] + wi * a2[0]) * inv, (a1[1] + wi * a2[1]) * inv); w.y = pg8::cvt_pk_bf16((a1[2] + wi * a2[2]) * inv, (a1[3] + wi * a2[3]) * inv);
                    *(u32x2*)(HO + (size_t)(b * T + t0 + t) * D + h * 256 + vh * 128 + 16 * wave + 4 * fg) = w;
                }
            }
            __syncthreads();
            {
                const float cs = scl[1];
                const bf16x8 ka0 = frag(lds + L_KWT, 16 * wave + fr, PS, 8 * fg), ka1 = frag(lds + L_KWT, 16 * wave + fr, PS, 32 + 8 * fg);
#pragma unroll
                for (int j = 0; j < 9; ++j) {
                    Cacc[j] = Cacc[j] * cs;
                    Cacc[j] = __builtin_amdgcn_mfma_f32_16x16x32_bf16(ka0, frag(lds + L_VT, 16 * j + fr, PS, 8 * fg), Cacc[j], 0, 0, 0);
                    Cacc[j] = __builtin_amdgcn_mfma_f32_16x16x32_bf16(ka1, frag(lds + L_VT, 16 * j + fr, PS, 32 + 8 * fg), Cacc[j], 0, 0, 0);
                    u32x2 w; w.x = pg8::cvt_pk_bf16(Cacc[j][0], Cacc[j][1]); w.y = pg8::cvt_pk_bf16(Cacc[j][2], Cacc[j][3]);
                    *(LAS u32x2*)(lds + L_C + (16 * j + fr) * PK + (16 * wave + 4 * fg) * 2) = w;
                }
                if (tid == 0) scl[0] = scl[2];
            }
            __syncthreads();
        }
    }
}
namespace hg {
constexpr int PK = 272, PS = 144;
constexpr int L_QD = 0, L_KD = L_QD + 64 * PK, L_KDT = L_KD + 64 * PK, L_VT = L_KDT + 128 * PS, L_A = L_VT + 128 * PS, L_ST = L_A + 64 * PS, L_TOT = L_ST + 128 * PK, L_GE = L_TOT + 4 * 128 * 4, L_SSQ = L_GE + 128 * 4;
__device__ __forceinline__ bf16x8 frag(const LAS unsigned char* base, int row, int pitch, int kelem) { return *(const LAS bf16x8*)(base + row * pitch + kelem * 2); }
}
__device__ __forceinline__ void phase_hgrn_scan_mfma(Frame& F) {
    using namespace hg;
    LAS unsigned char* lds = F.lds;
    LAS float* totL = (LAS float*)(lds + L_TOT); LAS float* geL = (LAS float*)(lds + L_GE);
    const bf16_t* P = WSP(bf16_t, OFF_PROJ); bf16_t* ATT = WSP(bf16_t, OFF_ATT);
    const float* lbt = WSP(float, OFF_TAB) + TAB_LB; const float* norm_g = inptr(F, I_HG_NORM_G);
    LAS float* ssqL = (LAS float*)(F.lds + hg::L_SSQ);
    int tid = F.tid; asm volatile("; phase-local tid" : "+v"(tid));
    const int lane = tid & 63, wave = __builtin_amdgcn_readfirstlane(tid >> 6), ld = HG_LD;
    const int fr = lane & 15, fg = lane >> 4;
    const int kc = tid & 127, part = __builtin_amdgcn_readfirstlane(tid >> 7);
    const int vkey = tid >> 3, vdc = tid & 7;
#pragma unroll 1
    for (int item = F.bx; item < BATCH * 8; item += F.G) {
        const int h = item & 7, b = item >> 3;
        f32x4 Sacc[8];
#pragma unroll
        for (int j = 0; j < 8; ++j) Sacc[j] = (f32x4){0.f, 0.f, 0.f, 0.f};
        for (int i = tid; i < 128 * PK / 4; i += 512) ((LAS unsigned*)(lds + L_ST))[i] = 0u;
        const float lb = lbt[h * 128 + kc];
        const f32x4 ngv = *(const f32x4*)(norm_g + h * 128 + 16 * wave + 4 * fg);
        unsigned short qn[16], fn[16]; u32x4 vn[2];
        { const bf16_t* Pc = P + (size_t)(b * T) * ld;
          const bf16_t* rp = Pc + (long)(16 * part) * ld + h * 128;
#pragma unroll
          for (int i = 0; i < 16; ++i) { qn[i] = rp[kc]; fn[i] = rp[1024 + kc]; rp += ld; asm volatile("" : "+s"(rp)); }
#pragma unroll
          for (int q = 0; q < 2; ++q) vn[q] = *(const u32x4*)(Pc + (long)vkey * ld + 2048 + h * 128 + (vdc + 8 * q) * 8); }
        __syncthreads();
#pragma unroll 1
        for (int ch = 0; ch < T / 64; ++ch) {
            const int t0 = ch * 64;
            float qs[16], kk[16], G[16]; u32x4 vv[2];
            {
                float run = 0.f;
#pragma unroll
                for (int i = 0; i < 16; ++i) { const float qr = bf2f(qn[i]), fraw = bf2f(fn[i]);
                    const float f = lb + (1.0f - lb) * sigmoidf_(fraw);
                    run += __logf(f); G[i] = run; qs[i] = qr * sigmoidf_(qr); kk[i] = 1.0f - f; }
                totL[part * 128 + kc] = run; vv[0] = vn[0]; vv[1] = vn[1];
            }
            __syncthreads();
            if (ch + 1 < T / 64) {
                const bf16_t* Pn = P + (size_t)(b * T + t0 + 64) * ld;
                const bf16_t* rp = Pn + (long)(16 * part) * ld + h * 128;
#pragma unroll
                for (int i = 0; i < 16; ++i) { qn[i] = rp[kc]; fn[i] = rp[1024 + kc]; rp += ld; asm volatile("" : "+s"(rp)); }
#pragma unroll
                for (int q = 0; q < 2; ++q) vn[q] = *(const u32x4*)(Pn + (long)vkey * ld + 2048 + h * 128 + (vdc + 8 * q) * 8);
            }
            {
                float off = 0.f, tot = 0.f;
#pragma unroll
                for (int p = 0; p < 4; ++p) { const float tp = totL[p * 128 + kc]; if (p < part) off += tp; tot += tp; }
                if (part == 3) geL[kc] = __expf(tot);
#pragma unroll
                for (int i = 0; i < 16; ++i) { const int r = 16 * part + i; const float g = G[i] + off;
                    const unsigned short qd = (unsigned short)f2bf(qs[i] * __expf(g)), kd = (unsigned short)f2bf(kk[i] * __expf(-g));
                    *(LAS unsigned short*)(lds + L_QD + r * PK + kc * 2) = qd; *(LAS unsigned short*)(lds + L_KD + r * PK + kc * 2) = kd; *(LAS unsigned short*)(lds + L_KDT + kc * PS + r * 2) = kd; }
#pragma unroll
                for (int q = 0; q < 2; ++q) { const unsigned w[4] = {vv[q].x, vv[q].y, vv[q].z, vv[q].w};
#pragma unroll
                    for (int e = 0; e < 4; ++e) { const int vrow = (vdc + 8 * q) * 8 + 2 * e;
                        *(LAS unsigned short*)(lds + L_VT + vrow * PS + vkey * 2) = (unsigned short)(w[e] & 0xffffu); *(LAS unsigned short*)(lds + L_VT + (vrow + 1) * PS + vkey * 2) = (unsigned short)(w[e] >> 16); } }
            }
            __syncthreads();
#pragma unroll
            for (int q = 0; q < 2; ++q) {
                const int idx = 2 * wave + q, ti = idx >> 2, tj = idx & 3;
                f32x4 a = (f32x4){0.f, 0.f, 0.f, 0.f};
                if (ti <= tj) {
#pragma unroll
                    for (int ks = 0; ks < 4; ++ks) a = __builtin_amdgcn_mfma_f32_16x16x32_bf16(frag(lds + L_KD, 16 * ti + fr, PK, 32 * ks + 8 * fg), frag(lds + L_QD, 16 * tj + fr, PK, 32 * ks + 8 * fg), a, 0, 0, 0);
                    const int t = 16 * tj + fr;
#pragma unroll
                    for (int e = 0; e < 4; ++e) { const int s = 16 * ti + 4 * fg + e; a[e] = (s <= t) ? a[e] : 0.f; }
                }
                u32x2 w; w.x = pg8::cvt_pk_bf16(a[0], a[1]); w.y = pg8::cvt_pk_bf16(a[2], a[3]);
                *(LAS u32x2*)(lds + L_A + (16 * tj + fr) * PS + (16 * ti + 4 * fg) * 2) = w;
            }
            __syncthreads();
            f32x4 ot[4]; u32x2 gq[4];
            const bf16_t* Pg = P + (size_t)(b * T + t0) * ld + 3072 + h * 128 + 16 * wave + 4 * fg;
#pragma unroll
            for (int tj = 0; tj < 4; ++tj) {
                f32x4 a = (f32x4){0.f, 0.f, 0.f, 0.f};
                gq[tj] = *(const u32x2*)(Pg + (size_t)(16 * tj + fr) * ld);
#pragma unroll
                for (int ks = 0; ks < 2; ++ks) a = __builtin_amdgcn_mfma_f32_16x16x32_bf16(frag(lds + L_VT, 16 * wave + fr, PS, 32 * ks + 8 * fg), frag(lds + L_A, 16 * tj + fr, PS, 32 * ks + 8 * fg), a, 0, 0, 0);
#pragma unroll
                for (int ks = 0; ks < 4; ++ks) a = __builtin_amdgcn_mfma_f32_16x16x32_bf16(frag(lds + L_ST, 16 * wave + fr, PK, 32 * ks + 8 * fg), frag(lds + L_QD, 16 * tj + fr, PK, 32 * ks + 8 * fg), a, 0, 0, 0);
                ot[tj] = a;
                float ss = (a[0] * a[0] + a[1] * a[1]) + (a[2] * a[2] + a[3] * a[3]);
                ss += __shfl_xor(ss, 16); ss += __shfl_xor(ss, 32);
                if (fg == 0) ssqL[wave * 64 + 16 * tj + fr] = ss;
            }
            __syncthreads();
#pragma unroll
            for (int tj = 0; tj < 4; ++tj) {
                const int t = 16 * tj + fr; float tot = 0.f;
#pragma unroll
                for (int w8 = 0; w8 < 8; ++w8) tot += ssqL[w8 * 64 + t];
                const float rr = __builtin_amdgcn_rsqf(tot * (1.0f / 128.0f) + RMS_EPS);
                const float g0 = __uint_as_float(gq[tj].x << 16), g1 = __uint_as_float(gq[tj].x & 0xffff0000u), g2 = __uint_as_float(gq[tj].y << 16), g3 = __uint_as_float(gq[tj].y & 0xffff0000u);
                u32x2 w; w.x = pg8::cvt_pk_bf16(ot[tj][0] * rr * ngv[0] * sigmoidf_(g0), ot[tj][1] * rr * ngv[1] * sigmoidf_(g1));
                w.y = pg8::cvt_pk_bf16(ot[tj][2] * rr * ngv[2] * sigmoidf_(g2), ot[tj][3] * rr * ngv[3] * sigmoidf_(g3));
                *(u32x2*)(ATT + (size_t)(b * T + t0 + t) * D + h * 128 + 16 * wave + 4 * fg) = w;
            }
            {
                const bf16x8 ka0 = frag(lds + L_KDT, 16 * wave + fr, PS, 8 * fg), ka1 = frag(lds + L_KDT, 16 * wave + fr, PS, 32 + 8 * fg);
                const f32x4 ge = *(const LAS f32x4*)(geL + 16 * wave + 4 * fg);
#pragma unroll
                for (int j = 0; j < 8; ++j) {
                    Sacc[j] = __builtin_amdgcn_mfma_f32_16x16x32_bf16(ka0, frag(lds + L_VT, 16 * j + fr, PS, 8 * fg), Sacc[j], 0, 0, 0);
                    Sacc[j] = __builtin_amdgcn_mfma_f32_16x16x32_bf16(ka1, frag(lds + L_VT, 16 * j + fr, PS, 32 + 8 * fg), Sacc[j], 0, 0, 0);
                    Sacc[j] = Sacc[j] * ge;
                    u32x2 w; w.x = pg8::cvt_pk_bf16(Sacc[j][0], Sacc[j][1]); w.y = pg8::cvt_pk_bf16(Sacc[j][2], Sacc[j][3]);
                    *(LAS u32x2*)(lds + L_ST + (16 * j + fr) * PK + (16 * wave + 4 * fg) * 2) = w;
                }
            }
            __syncthreads();
        }
    }
}
constexpr int PH_PER_LAYER = 10, N_PHASES = 1 + PH_PER_LAYER * DEPTH;
struct Args { const float* in[27]; float* out; unsigned char* ws; int ph_lo, ph_hi; };
__global__ void __launch_bounds__(512, 2) mk_fwd(Args args) {
    extern __shared__ __attribute__((aligned(16))) unsigned char lds[];
    Frame F;
    F.lds = (LAS unsigned char*)lds;
    F.LC = (volatile LAS unsigned*)(F.lds + LDSCTL_OFF);
    F.tid = threadIdx.x; F.lane = F.tid & 63; F.wave = __builtin_amdgcn_readfirstlane(F.tid >> 6); F.G = gridDim.x; F.bx = blockIdx.x;
    F.ws = (unsigned char*)(GAS unsigned char*)args.ws; F.ctl = (unsigned*)(F.ws + OFF_CTL); F.out = (float*)(GAS float*)args.out;
    for (int u = F.tid; u < (LDS_BYTES - LDSCTL_OFF) / 4; u += 512) F.LC[u] = 0u;
    __syncthreads();
    if (F.tid < 27) { const unsigned long long pv = (unsigned long long)args.in[F.tid]; F.LC[128 + 2 * F.tid] = (unsigned)pv; F.LC[129 + 2 * F.tid] = (unsigned)(pv >> 32); }
    __syncthreads();
    XcdBarrier bar; bar.bar = F.ctl + CW_BAR; bar.x = 0; bar.st = nullptr;
    if (!MK_PER_PHASE) bar = xcd_barrier_post(F.ctl + CW_BAR, F.LC);
    const int lo = args.ph_lo, hi = args.ph_hi;
#define IN(k) (lo <= (k) && (k) < hi)
#ifndef DBL_LNR
#define DBL_LNR 1
#endif
#ifndef DBL_COMB
#define DBL_COMB 1
#endif
#ifndef DBL_NG
#define DBL_NG 1
#endif
#ifndef DBL_GIN
#define DBL_GIN 1
#endif
#ifndef DBL_GOUT
#define DBL_GOUT 1
#endif
#ifndef DBL_GCMP
#define DBL_GCMP 1
#endif
#ifndef DBL_GUP
#define DBL_GUP 1
#endif
#ifndef DBL_GDN
#define DBL_GDN 1
#endif
#ifndef DBL_SCAN
#define DBL_SCAN 1
#endif
#ifndef DBL_P0
#define DBL_P0 1
#endif
#ifndef DBL_ATT
#define DBL_ATT 1
#endif
#define REP(n) _Pragma("unroll 1") for (int rep_ = 0; rep_ < (n); ++rep_)
#ifdef PROBE_A
#define STAMP(k) do { if (blockIdx.x == 0 && F.tid == 0) ((unsigned long long*)(F.ws + OFF_TAB + 65536))[(k)] = wall_clock64(); } while (0)
#else
#define STAMP(k) do {} while (0)
#endif
#define SEAM(k) do { if (!MK_PER_PHASE && (k) + 1 < hi) xcd_barrier(bar); else __syncthreads(); } while (0)

    STAMP(0);
    if (IN(0)) {
#ifndef NO_P0
 REP(DBL_P0) p0_prologue(F);
#endif
 SEAM(0); }

    for (int L = 0; L < DEPTH; ++L) {
        int Lo = L; asm volatile("; layer-local" : "+s"(Lo));
        const int kind = Lo % 3, slot = Lo / 3, pb = 1 + PH_PER_LAYER * Lo;
#define PHL Frame Fp = F; asm volatile("; phase-local" : "+v"(Fp.tid), "+s"(Fp.bx)); Fp.lane = Fp.tid & 63;
        const int ldp = kind == 0 ? NSA_LD : (kind == 1 ? ML_LD : HG_LD);
        if (IN(pb + 0)) { PHL STAMP(pb + 0);
            const bf16_t* Wt = kind == 0 ? WSP(bf16_t, OFF_W_NSAIN) + (size_t)slot * NSA_LD * D : (kind == 1 ? WSP(bf16_t, OFF_W_MLIN) : WSP(bf16_t, OFF_W_HGIN));
            pg8::APlain AS{WSP(bf16_t, OFF_XN), D}; pg8::BPlain BS{Wt, D}; pg8::StaticOrder S; S.init(NTOK / 256, ldp / 256, Fp.G, Fp.bx);
            pg8::EpiStore E{WSP(bf16_t, OFF_PROJ), ldp};
            #ifndef NO_GIN
            REP(DBL_GIN) pg8::gemm_phase<pg8::EpiStore, pg8::StaticOrder, pg8::APlain, pg8::BPlain>(Fp.lds, D, AS, BS, S, E);
#endif
            SEAM(pb + 0);
        }
        if (kind == 0) {
            if (IN(pb + 1)) { PHL STAMP(pb + 1);
                pg8::ACmp AS{WSP(bf16_t, OFF_PROJ), NSA_LD, 1024}; pg8::BGroup BS{WSP(bf16_t, OFF_W_CMP1) + (size_t)slot * 2 * 256 * 2048, 2048, (size_t)256 * 2048};
                pg8::CmpOrder S{Fp.G, Fp.bx};
                pg8::EpiCmpGelu E{WSP(bf16_t, OFF_HC), WSP(float, OFF_TAB) + TAB_CMPB + slot * 512};
                #ifndef NO_GCMP
                REP(DBL_GCMP) pg8::gemm_phase<pg8::EpiCmpGelu, pg8::CmpOrder, pg8::ACmp, pg8::BGroup>(Fp.lds, 2048, AS, BS, S, E);
#endif
                SEAM(pb + 1);
            }
            if (IN(pb + 2)) { PHL STAMP(pb + 2);
#ifndef NO_CMP2
 REP(DBL_GCMP) phase_nsa_cmp2(Fp, slot);
#endif
 SEAM(pb + 2); }
            if (IN(pb + 3)) { PHL STAMP(pb + 3);
#ifndef NO_ATTN
 REP(DBL_ATT) phase_nsa_attn_mfma(Fp, slot);
#endif
 SEAM(pb + 3); }
        } else if (kind == 1) {
            if (IN(pb + 1)) { PHL STAMP(pb + 1);
#ifdef MLS_CHECK
                {
                    const size_t n16 = (size_t)NTOK * D * 2 / 16; u32x4* HMv = WSP(u32x4, OFF_HM); u32x4* Y1 = WSP(u32x4, OFF_Y); u32x4* Y2 = WSP(u32x4, OFF_Y + 160 * MiB);
#pragma unroll 1
                    for (int rep_ = 0; rep_ < 3; ++rep_) {
                        phase_mlstm_scan_mfma(Fp);
                        xcd_barrier(bar);
                        if (rep_ < 2) { u32x4* dst = rep_ == 0 ? Y1 : Y2;
                            for (size_t i = (size_t)blockIdx.x * 512 + Fp.tid; i < n16; i += (size_t)Fp.G * 512) dst[i] = HMv[i];
                            xcd_barrier(bar); }
                    }
                    unsigned bad_bits = 0u; float md = 0.f, mr = 0.f;
                    for (size_t i = (size_t)blockIdx.x * 512 + Fp.tid; i < n16; i += (size_t)Fp.G * 512) { const u32x4 a = HMv[i], b2 = Y2[i], c1 = Y1[i];
                        if (a.x != b2.x || a.y != b2.y || a.z != b2.z || a.w != b2.w) bad_bits = 1u;
                        const unsigned aw[4] = {a.x, a.y, a.z, a.w}, cw[4] = {c1.x, c1.y, c1.z, c1.w};
#pragma unroll
                        for (int q = 0; q < 4; ++q) { const float a0 = __uint_as_float(aw[q] << 16), a1 = __uint_as_float(aw[q] & 0xffff0000u), r0 = __uint_as_float(cw[q] << 16), r1 = __uint_as_float(cw[q] & 0xffff0000u);
                            md = fmaxf(md, fmaxf(fabsf(a0 - r0), fabsf(a1 - r1))); mr = fmaxf(mr, fmaxf(fabsf(r0), fabsf(r1))); if (!(a0 == a0) || !(a1 == a1)) bad_bits |= 4u; } }
                    md = wave_max(md); mr = wave_max(mr);
                    if (Fp.lane == 0) { atomicMax(F.ctl + 9000, __float_as_uint(md)); atomicMax(F.ctl + 9001, __float_as_uint(mr)); }
                    if (bad_bits) atomicOr(F.ctl + 9002, bad_bits);
                }
#else
#ifndef NO_MLS
 REP(DBL_SCAN) phase_mlstm_scan_mfma(Fp);
#endif
#endif
 SEAM(pb + 1); }
            if (IN(pb + 2)) { PHL STAMP(pb + 2);
#ifndef NO_NG
 REP(DBL_NG) phase_norm_gate<256>(Fp, inptr(Fp, I_ML_NORM_G), ML_LD, 2048);
#endif
 SEAM(pb + 2); }
        } else {
            if (IN(pb + 1)) { PHL STAMP(pb + 1);
#ifndef NO_HGS
 REP(DBL_SCAN) phase_hgrn_scan_mfma(Fp);
#endif
 SEAM(pb + 1); }
        }
        if (IN(pb + 4)) { PHL STAMP(pb + 4);
            const bf16_t* Wt = kind == 0 ? WSP(bf16_t, OFF_W_NSAOUT) + (size_t)slot * D * D : (kind == 1 ? WSP(bf16_t, OFF_W_MLOUT) : WSP(bf16_t, OFF_W_HGOUT));
            pg8::APlain AS{WSP(bf16_t, OFF_ATT), D}; pg8::BPlain BS{Wt, D}; pg8::StaticOrder S; S.init(NTOK / 256, D / 256, Fp.G, Fp.bx);
            pg8::EpiStore E{WSP(bf16_t, OFF_HM), D};
            #ifndef NO_GOUT
            REP(DBL_GOUT) pg8::gemm_phase<pg8::EpiStore, pg8::StaticOrder, pg8::APlain, pg8::BPlain>(Fp.lds, D, AS, BS, S, E);
#endif
            SEAM(pb + 4);
        }
        if (IN(pb + 5)) { PHL STAMP(pb + 5);
#ifndef NO_LNR
 if (DBL_LNR > 1) phase_ln_router(Fp, Lo, true);
 phase_ln_router(Fp, Lo);
#endif
 SEAM(pb + 5); }
        if (IN(pb + 6)) { PHL STAMP(pb + 6);
#ifndef NO_SLOT
 phase_moe_slots(Fp, Lo);
#endif
 SEAM(pb + 6); }
        if (IN(pb + 7)) { PHL STAMP(pb + 7);
            moe_tile_table(Fp, Lo);
            pg8::AGather AS{WSP(bf16_t, OFF_XN), D, WSP(int, OFF_ROWT)}; pg8::BGroup BS{WSP(bf16_t, OFF_W_GU) + (size_t)Lo * NEXP * 2048 * D, D, (size_t)2048 * D};
            pg8::MoeOrder S; S.init(__builtin_amdgcn_readfirstlane((int)Fp.LC[40]), 8, Fp.G, Fp.bx); S.pend = (const LAS int*)(Fp.lds + LDSCTL_OFF + 32);
            pg8::EpiSwiglu E{WSP(bf16_t, OFF_H), inptr(Fp, I_MOE_B_GU) + (size_t)Lo * NEXP * 2048};
            #ifndef NO_GUP
            REP(DBL_GUP) pg8::gemm_phase<pg8::EpiSwiglu, pg8::MoeOrder, pg8::AGather, pg8::BGroup>(Fp.lds, D, AS, BS, S, E);
#endif
            SEAM(pb + 7);
        }
        if (IN(pb + 8)) { PHL STAMP(pb + 8);
            moe_tile_table(Fp, Lo);
            pg8::APlain AS{WSP(bf16_t, OFF_H), DFF}; pg8::BGroup BS{WSP(bf16_t, OFF_W_DN) + (size_t)Lo * NEXP * D * DFF, DFF, (size_t)D * DFF};
            pg8::MoeOrder S; S.init(__builtin_amdgcn_readfirstlane((int)Fp.LC[40]), 4, Fp.G, Fp.bx); S.pend = (const LAS int*)(Fp.lds + LDSCTL_OFF + 32);
            pg8::EpiDown E{WSP(bf16_t, OFF_Y), inptr(Fp, I_MOE_B_DOWN) + (size_t)Lo * NEXP * D, WSP(float, OFF_ROWG)};
            #ifndef NO_GDN
            REP(DBL_GDN) pg8::gemm_phase<pg8::EpiDown, pg8::MoeOrder, pg8::APlain, pg8::BGroup>(Fp.lds, DFF, AS, BS, S, E);
#endif
            SEAM(pb + 8);
        }
        if (IN(pb + 9)) { PHL STAMP(pb + 9);
#ifndef NO_COMB
 if (DBL_COMB > 1) phase_combine_ln(Fp, Lo, (float*)nullptr, true);
 phase_combine_ln(Fp, Lo, Lo == DEPTH - 1 ? Fp.out : (float*)nullptr);
#endif
 SEAM(pb + 9); }
    }
#ifdef MLS_CHECK
    xcd_barrier(bar);
    { const float md = __uint_as_float(__hip_atomic_load(F.ctl + 9000, RLX_AGENT)), mr = __uint_as_float(__hip_atomic_load(F.ctl + 9001, RLX_AGENT)); const unsigned bb = __hip_atomic_load(F.ctl + 9002, RLX_AGENT);
      float code = 10.f; if (md > 0.02f * mr) code = 100.f; if (md > 0.2f * mr) code = 300.f; if (bb & 1u) code *= 10.f; if (bb & 4u) code *= 100.f;
      for (size_t i = (size_t)blockIdx.x * 512 + F.tid; i < (size_t)NTOK * D; i += (size_t)F.G * 512) F.out[i] = code; }
#endif
#ifdef PROBE_A
    STAMP(N_PHASES);
    xcd_barrier(bar);
    {
        const unsigned long long* st = (const unsigned long long*)(F.ws + OFF_TAB + 65536);
        float cat[6] = {0.f, 0.f, 0.f, 0.f, 0.f, 0.f};
        unsigned long long prev = __hip_atomic_load(st + 0, RLX_AGENT);
        int pc = 0;
        for (int p = 1; p <= N_PHASES; ++p) {
            int c = -1;
            if (p < N_PHASES) { const int Lq = (p - 1) / PH_PER_LAYER, k = (p - 1) % PH_PER_LAYER, kind = Lq % 3;
                if (k == 3 && kind != 0) continue;
                c = (k == 0 || k == 4 || k == 7 || k == 8) ? 1 : (k == 1 ? (kind == 0 ? 1 : (kind == 1 ? 3 : 4)) : (k == 3 ? 2 : 5)); }
            const unsigned long long now = __hip_atomic_load(st + p, RLX_AGENT);
            const float us = (float)(now - prev) * 0.01f;
#pragma unroll
            for (int q = 0; q < 6; ++q) if (q == pc) cat[q] += us;
            prev = now; pc = c;
        }
        float va = 0.f, vb = 0.f;
#pragma unroll
        for (int q = 0; q < 6; ++q) { if (q == PROBE_A) va = cat[q]; if (q == PROBE_B) vb = cat[q]; }
        const float kfill = sqrtf(va);
        for (size_t i = (size_t)blockIdx.x * 512 + F.tid; i < (size_t)NTOK * D; i += (size_t)F.G * 512) F.out[i] = (i == 0) ? vb : kfill;
    }
#endif
#undef IN
#undef SEAM
#undef PHL
}

extern "C" void kernel_launch(void* const* d_in, const int* in_sizes, int n_in, void* d_out, int out_size, void* d_ws, size_t ws_size, hipStream_t stream) {
    static int grid = 0;
    if (grid == 0) {
        if (n_in != 27 || out_size != NTOK * D || ws_size < WS_END) { fprintf(stderr, "kernel_launch: unexpected shapes (n_in %d, out %d, ws %zu)\n", n_in, out_size, ws_size); grid = -1; return; }
        int dev = 0, cus = 0;
        if (hipGetDevice(&dev) != hipSuccess || hipDeviceGetAttribute(&cus, hipDeviceAttributeMultiprocessorCount, dev) != hipSuccess) { grid = -1; return; }
        if (hipFuncSetAttribute((const void*)mk_fwd, hipFuncAttributeMaxDynamicSharedMemorySize, LDS_BYTES) != hipSuccess) { fprintf(stderr, "kernel_launch: hipFuncSetAttribute failed\n"); grid = -1; return; }
        int per_cu = 0;
        if (hipOccupancyMaxActiveBlocksPerMultiprocessor(&per_cu, (const void*)mk_fwd, 512, LDS_BYTES) != hipSuccess || per_cu < 1) fprintf(stderr, "kernel_launch: occupancy query reports %d\n", per_cu);
        (void)hipGetLastError();
        grid = cus;
    }
    if (grid < 0) return;
    (void)hipMemsetAsync((char*)d_ws + OFF_CTL, 0, CTL_ZERO_BYTES, stream);
    Args a{};
    for (int i = 0; i < 27; ++i) a.in[i] = (const float*)d_in[i];
    a.out = (float*)d_out; a.ws = (unsigned char*)d_ws;
#if MK_PER_PHASE
    for (int p = 0; p < N_PHASES; ++p) {
        if (p > 0) { const int L = (p - 1) / PH_PER_LAYER, k = (p - 1) % PH_PER_LAYER, kind = L % 3; if (k == 3 && kind != 0) continue; }
        a.ph_lo = p; a.ph_hi = p + 1;
        hipLaunchKernelGGL(mk_fwd, dim3(grid), dim3(512), LDS_BYTES, stream, a);
    }
#else
    a.ph_lo = 0; a.ph_hi = N_PHASES;
    hipLaunchKernelGGL(mk_fwd, dim3(grid), dim3(512), LDS_BYTES, stream, a);
#endif
}
```

```cpp
#include <hip/hip_runtime.h>
#include <cstdio>
#include <cstdint>

#define LAS __attribute__((address_space(3)))
#define GAS __attribute__((address_space(1)))
typedef unsigned short bf16_t;
typedef short bf16x8 __attribute__((ext_vector_type(8)));
typedef float f32x4 __attribute__((ext_vector_type(4)));
typedef float f32x2 __attribute__((ext_vector_type(2)));
typedef unsigned u32x4 __attribute__((ext_vector_type(4)));
typedef unsigned u32x2 __attribute__((ext_vector_type(2)));
#define RLX_AGENT __ATOMIC_RELAXED, __HIP_MEMORY_SCOPE_AGENT
#define LDS_WAIT() asm volatile("s_waitcnt lgkmcnt(0)" ::: "memory")
#define VM_WAIT() asm volatile("s_waitcnt vmcnt(0)" ::: "memory")

#ifndef MK_PER_PHASE
#define MK_PER_PHASE 0
#endif

constexpr int D = 1024, BATCH = 32, T = 2048, NTOK = BATCH * T, DEPTH = 4;
constexpr int NSA_IN = 2608, NSA_LD = 2816, ML_IN = 3080, ML_LD = 3328, HG_LD = 4096;
constexpr int NEXP = 32, TOPK = 4, DFF = 1024;
constexpr int MOE_ROWS = 270336;
constexpr float LN_EPS = 1e-5f, RMS_EPS = 1e-6f;
constexpr float DN_ALPHA = 1.681792830507429f;
constexpr int NCMP = 127;

constexpr size_t MiB = 1u << 20;
constexpr size_t OFF_CTL = 0, CTL_ZERO_BYTES = 1 * MiB;
constexpr size_t OFF_TAB = 1 * MiB;
constexpr size_t OFF_TOKE = 2 * MiB;
constexpr size_t OFF_TOKG = 3 * MiB;
constexpr size_t OFF_TOKP = 4 * MiB;
constexpr size_t OFF_ROWT = 5 * MiB;
constexpr size_t OFF_ROWG = 7 * MiB;
constexpr size_t OFF_KC = 9 * MiB;
constexpr size_t OFF_HC = 17 * MiB;
constexpr size_t OFF_W_NSAIN = 33 * MiB;
constexpr size_t OFF_W_NSAOUT = 44 * MiB;
constexpr size_t OFF_W_MLIN = 48 * MiB;
constexpr size_t OFF_W_MLOUT = 55 * MiB;
constexpr size_t OFF_W_HGIN = 57 * MiB;
constexpr size_t OFF_W_HGOUT = 65 * MiB;
constexpr size_t OFF_W_CMP2 = 71 * MiB;
constexpr size_t OFF_W_CMP1 = 67 * MiB;
constexpr size_t OFF_W_GU = 72 * MiB;
constexpr size_t OFF_W_DN = 584 * MiB;
constexpr size_t OFF_XA = 840 * MiB;
constexpr size_t OFF_XN = 1096 * MiB;
constexpr size_t OFF_PROJ = 1224 * MiB;
constexpr size_t OFF_ATT = 1740 * MiB;
constexpr size_t OFF_HM = 1868 * MiB;
constexpr size_t OFF_H = 1996 * MiB;
constexpr size_t OFF_Y = 2526 * MiB;
constexpr size_t WS_END = 3056 * MiB;
constexpr int TAB_CMPB = 0;
constexpr int TAB_LB = 4096;
constexpr int TAB_RWT = 8192;
constexpr int CW_BAR = 4096;
constexpr int CW_CNT = 16384;
constexpr int CW_CUR = 16384 + 1024;

constexpr int RING_BYTES = 131072;
constexpr int LDSCTL_OFF = 155648;
constexpr int LDS_BYTES = 156672;

__device__ __forceinline__ float bf2f(bf16_t b) { return __uint_as_float(((unsigned)b) << 16); }
typedef float f32x2_t_ __attribute__((ext_vector_type(2))); typedef __bf16 bf16x2_t_ __attribute__((ext_vector_type(2)));
__device__ __forceinline__ unsigned pk2(float lo, float hi) { const f32x2_t_ v = {lo, hi}; const bf16x2_t_ b = __builtin_convertvector(v, bf16x2_t_); return __builtin_bit_cast(unsigned, b); }
__device__ __forceinline__ unsigned f2bf(float f) { return pk2(f, f) & 0xffffu; }
template <int CTRL> __device__ __forceinline__ float dppf(float v) { return __builtin_bit_cast(float, __builtin_amdgcn_update_dpp(0, __builtin_bit_cast(int, v), CTRL, 0xF, 0xF, true)); }
__device__ __forceinline__ float rdl(float v, int l) { return __builtin_bit_cast(float, __builtin_amdgcn_readlane(__builtin_bit_cast(int, v), l)); }
__device__ __forceinline__ float wave_sum(float v) {
    v += dppf<0xB1>(v); v += dppf<0x4E>(v); v += dppf<0x141>(v); v += dppf<0x140>(v);
    return (rdl(v, 0) + rdl(v, 16)) + (rdl(v, 32) + rdl(v, 48));
}
__device__ __forceinline__ float wave_max(float v) {
    v = fmaxf(v, dppf<0xB1>(v)); v = fmaxf(v, dppf<0x4E>(v)); v = fmaxf(v, dppf<0x141>(v)); v = fmaxf(v, dppf<0x140>(v));
    return fmaxf(fmaxf(rdl(v, 0), rdl(v, 16)), fmaxf(rdl(v, 32), rdl(v, 48)));
}
__device__ __forceinline__ float sigmoidf_(float x) { return __builtin_amdgcn_rcpf(1.0f + __expf(-x)); }

#define XB_TMO      128
#define XB_XCNT(j)  (256  + 64 * (j))
#define XB_XSUB(j)  (1280 + 64 * (j))
#define XB_XGEN(j)  (2304 + 64 * (j))
#define XB_TOP      3328
#define XB_TOPGEN   3392
#define XCD_BAR_WORDS 3456
#define XB_SPIN_CAP (1u << 20)

__device__ __forceinline__ unsigned xb_ld(unsigned* p)              { return __hip_atomic_load(p, __ATOMIC_RELAXED, __HIP_MEMORY_SCOPE_AGENT); }
__device__ __forceinline__ unsigned xb_add(unsigned* p, unsigned v) { return __hip_atomic_fetch_add(p, v, __ATOMIC_RELAXED, __HIP_MEMORY_SCOPE_AGENT); }
__device__ __forceinline__ unsigned xb_xcc_id() { return (unsigned)__builtin_amdgcn_s_getreg((3 << 11) | 20) & 0xFu; }
#define XB_SPIN(cond, bar) do { unsigned _sp = 0; while (cond) { __builtin_amdgcn_s_sleep(1); \
    if ((++_sp & 255u) == 0u) { if (xb_ld(&(bar)[XB_TMO])) break; if (_sp > XB_SPIN_CAP) { atomicAdd(&(bar)[XB_TMO], 1u); break; } } } } while (0)

struct XcdBarrier { unsigned* bar; unsigned x; volatile LAS unsigned* st; };

__device__ __forceinline__ XcdBarrier xcd_barrier_post(unsigned* bar, volatile LAS unsigned* st) {
    XcdBarrier b; b.bar = bar; b.x = xb_xcc_id(); b.st = st;
    if (threadIdx.x == 0) (void)xb_add(&bar[XB_XCNT(b.x)], 1u);
    return b;
}
__device__ __forceinline__ void xcd_barrier_complete(unsigned* bar, unsigned x, unsigned& nloc, unsigned& nx) {
    const unsigned G = gridDim.x * gridDim.y * gridDim.z;
    unsigned sum, cnt, mine, sp = 0u;
    for (;;) {
        sum = 0u; cnt = 0u; mine = 0u;
#pragma unroll
        for (unsigned j = 0; j < 16; ++j) { const unsigned c = xb_ld(&bar[XB_XCNT(j)]); sum += c; cnt += (c > 0u) ? 1u : 0u; }
        mine = xb_ld(&bar[XB_XCNT(x)]);
        if (sum == G) break;
        __builtin_amdgcn_s_sleep(1);
        if ((++sp & 255u) == 0u) { if (xb_ld(&bar[XB_TMO])) break; if (sp > XB_SPIN_CAP) { atomicAdd(&bar[XB_TMO], 1u); break; } }
    }
    nloc = mine > 0u ? mine : 1u; nx = cnt > 0u ? cnt : 1u;
}
__device__ __forceinline__ void xcd_barrier(const XcdBarrier& b) {
    asm volatile("s_waitcnt vmcnt(0)" ::: "memory");
    __syncthreads();
    if (threadIdx.x == 0) {
        unsigned* bar = b.bar; asm volatile("; barrier words" : "+s"(bar));
        __builtin_amdgcn_s_waitcnt(0);
        unsigned nloc = b.st[0], nx = b.st[1];
        if (nloc == 0u) { xcd_barrier_complete(bar, b.x, nloc, nx); b.st[0] = nloc; b.st[1] = nx; }
        const unsigned old = xb_add(&bar[XB_XSUB(b.x)], 1u);
        const unsigned gen = old / nloc;
        if (old + 1u == (gen + 1u) * nloc) {
            __builtin_amdgcn_fence(__ATOMIC_RELEASE, "agent");
            asm volatile("s_waitcnt vmcnt(0)" ::: "memory");
            const unsigned og = xb_add(&bar[XB_TOP], 1u);
            const unsigned tg = og / nx;
            if (og + 1u == (tg + 1u) * nx) xb_add(&bar[XB_TOPGEN], 1u);
            else XB_SPIN(xb_ld(&bar[XB_TOPGEN]) == tg, bar);
            __builtin_amdgcn_fence(__ATOMIC_ACQUIRE, "agent");
            xb_add(&bar[XB_XGEN(b.x)], 1u);
            asm volatile("s_waitcnt vmcnt(0)" ::: "memory");
        } else {
            XB_SPIN(xb_ld(&bar[XB_XGEN(b.x)]) == gen, bar);
            __builtin_amdgcn_fence(__ATOMIC_ACQUIRE, "agent");
            asm volatile("s_waitcnt vmcnt(0)" ::: "memory");
        }
    }
    __syncthreads();
}

namespace pg8 {
constexpr int BM = 256, BK = 64, HALF = 128, HTB = HALF * BK * 2, STAGE_BYTES = 8 * HTB, NXCD = 8, WGM = 8;
__host__ __device__ __forceinline__ int lds_byte(int r, int c) { const int st = (r >> 4) * 2 + (c >> 5), rr = r & 15, cc = c & 31, ob = rr * 64 + cc * 2; return st * 1024 + (ob ^ (((ob >> 9) & 1) << 5)); }
__host__ __device__ __forceinline__ void stage_rc(int b, int& R, int& C) { const int st = b / 1024, sb = b % 1024, swz = sb ^ (((sb >> 9) & 1) << 5); R = (st >> 1) * 16 + swz / 64; C = (st & 1) * 32 + (swz % 64) / 2; }
__host__ __device__ __forceinline__ int perm32(int rho) { const int n = rho >> 4, i = rho & 15; return 8 * (i >> 2) + 4 * n + (i & 3); }

struct Unit { int pm, pn, e; };

struct StaticOrder {
    int nM, nN, nwg, G, c, wgm = WGM;
    __device__ __forceinline__ void init(int nM_, int nN_, int G_, int c_) { nM = nM_; nN = nN_; nwg = nM * nN; G = G_; c = c_; }
    __device__ __forceinline__ bool next(int i, Unit& u) const {
        const long L = (long)i * G + c; if (L >= nwg) return false;
        int wgid = (int)L; { const int q = nwg / NXCD, r = nwg % NXCD, xcd = wgid % NXCD, off = wgid / NXCD; wgid = (xcd < r ? xcd * (q + 1) : r * (q + 1) + (xcd - r) * q) + off; }
        const int nig = wgm * nN, gid = wgid / nig, fm = gid * wgm, gsz = (nM - fm) < wgm ? (nM - fm) : wgm;
        u.pm = fm + ((wgid % nig) % gsz); u.pn = (wgid % nig) / gsz; u.e = 0; return true;
    }
};
struct MoeOrder : StaticOrder {
    const LAS int* pend;
    __device__ __forceinline__ bool next(int i, Unit& u) const {
        if (!StaticOrder::next(i, u)) return false;
        const int ln = __builtin_amdgcn_mbcnt_hi(~0u, __builtin_amdgcn_mbcnt_lo(~0u, 0u));
        const int pe = pend[ln & 31];
        const unsigned long long bal = __builtin_amdgcn_ballot_w64(ln < 31 && pe <= u.pm);
        u.e = __builtin_popcountll(bal); return true;
    }
};
struct CmpOrder {
    int G, c;
    __device__ __forceinline__ bool next(int i, Unit& u) const { const int L = i * G + c; if (L >= 128) return false; u.e = L >> 6; u.pm = L & 63; u.pn = 0; return true; }
};

__device__ __forceinline__ unsigned cvt_pk_bf16(float lo, float hi) { const f32x2_t_ v = {lo, hi}; const bf16x2_t_ b = __builtin_convertvector(v, bf16x2_t_); return __builtin_bit_cast(unsigned, b); }

struct APlain {
    static constexpr bool GATHER = false;
    const bf16_t* A; int lda;
    __device__ __forceinline__ int kstep() const { return BK * 2; }
    __device__ __forceinline__ const char* base(const Unit& u) const { return (const char*)A + (size_t)u.pm * BM * lda * 2; }
    __device__ __forceinline__ void offs(const Unit&, const int (&R)[2], const int (&C)[2], unsigned (&vo)[2][2]) const {
#pragma unroll
        for (int h = 0; h < 2; ++h)
#pragma unroll
            for (int i = 0; i < 2; ++i) vo[h][i] = (unsigned)((h * HALF + R[i]) * lda + C[i]) * 2u;
    }
};
struct AGather {
    static constexpr bool GATHER = true;
    const bf16_t* A; int lda; const int* idx;
    __device__ __forceinline__ int kstep() const { return BK * 2; }
    __device__ __forceinline__ const char* base(const Unit&) const { return (const char*)A; }
    __device__ __forceinline__ void offs(const Unit& u, const int (&R)[2], const int (&C)[2], unsigned (&vo)[2][2]) const {
#pragma unroll
        for (int h = 0; h < 2; ++h)
#pragma unroll
            for (int i = 0; i < 2; ++i) { const int row = idx[u.pm * BM + h * HALF + R[i]]; vo[h][i] = (unsigned)(row * lda + C[i]) * 2u; }
    }
};
struct ACmp {
    static constexpr bool GATHER = false;
    const bf16_t* P; int ld; int col0;
    __device__ __forceinline__ int kstep() const { return ld * 2; }
    __device__ __forceinline__ const char* base(const Unit& u) const { const int b = u.pm >> 1, g0 = (u.pm & 1) * 2; return (const char*)P + ((size_t)b * T * ld + col0 + u.e * 256 + g0 * 64) * 2; }
    __device__ __forceinline__ void offs(const Unit&, const int (&R)[2], const int (&C)[2], unsigned (&vo)[2][2]) const {
#pragma unroll
        for (int h = 0; h < 2; ++h)
#pragma unroll
            for (int i = 0; i < 2; ++i) vo[h][i] = (unsigned)(16 * R[i] * ld + h * 64 + C[i]) * 2u;
    }
};
struct BPlain { const bf16_t* Bt; int K; __device__ __forceinline__ const char* base(const Unit& u) const { return (const char*)Bt + (size_t)u.pn * BM * K * 2; } };
struct BGroup { const bf16_t* Bt; int K; size_t gstride;   __device__ __forceinline__ const char* base(const Unit& u) const { return (const char*)Bt + ((size_t)u.e * gstride + (size_t)u.pn * BM * K) * 2; } };

template <class Epi, class Sched, class ASrc, class BSrc, bool ALIGN_EPI = true, bool SP2 = true>
__device__ __forceinline__ void gemm_phase(LAS unsigned char* lds, const int K, const ASrc& AS, const BSrc& BS, const Sched& S, const Epi& E) {
    int tid = threadIdx.x; asm volatile("; phase-local tid" : "+v"(tid));
    const int wid = __builtin_amdgcn_readfirstlane(tid >> 6), lane = tid & 63, wr = wid >> 2, wc = wid & 3, fr = lane & 15, fq = lane >> 4;
    const int nt = K / BK;
    int Rs[2], Cs[2]; unsigned voffB[2];
#pragma unroll
    for (int i = 0; i < 2; ++i) { int R, C; stage_rc(tid * 16 + i * 8192, R, C); Rs[i] = R; Cs[i] = C; const int Rb = Epi::PERM ? ((R & ~31) + perm32(R & 31)) : R; voffB[i] = (unsigned)(Rb * K + C) * 2u; }
    const size_t kstepB = (size_t)(BK * 2), hstepB = (size_t)HALF * K * 2;
    const size_t kstepA = (size_t)AS.kstep();
    const unsigned ldsw = (unsigned)wid * 1024u;
    const int aoff = lds_byte(wr * 64 + fr, fq * 8), boff = lds_byte(wc * 32 + fr, fq * 8);
#define PG8_SA(b, h) (((b) * 2 + (h)) * HTB)
#define PG8_SB(b, h) ((4 + (b) * 2 + (h)) * HTB)
#define PG8_STAGEB(bufoff, gbase) do { _Pragma("unroll") for (int _i = 0; _i < 2; ++_i) \
        __builtin_amdgcn_global_load_lds((const unsigned*)((const char*)(gbase) + voffB[_i]), (LAS unsigned*)(lds + (bufoff) + ldsw + _i * 8192), 16, 0, 0); } while (0)
#define PG8_STAGEA(bufoff, gbase, o0, o1) do { \
        __builtin_amdgcn_global_load_lds((const unsigned*)((const char*)(gbase) + (o0)), (LAS unsigned*)(lds + (bufoff) + ldsw), 16, 0, 0); \
        __builtin_amdgcn_global_load_lds((const unsigned*)((const char*)(gbase) + (o1)), (LAS unsigned*)(lds + (bufoff) + ldsw + 8192), 16, 0, 0); } while (0)
#define PG8_LDA(dst, b, h) do { _Pragma("unroll") for (int m = 0; m < 4; ++m) _Pragma("unroll") for (int k = 0; k < 2; ++k) dst[m][k] = *(const LAS bf16x8*)(lds + PG8_SA(b, h) + aoff + m * 2048 + k * 1024); } while (0)
#define PG8_LDB(dst, b, h) do { _Pragma("unroll") for (int n = 0; n < 2; ++n) _Pragma("unroll") for (int k = 0; k < 2; ++k) dst[n][k] = *(const LAS bf16x8*)(lds + PG8_SB(b, h) + boff + n * 2048 + k * 1024); } while (0)
#define PG8_MMA(ai, bj, At, Bt) do { __builtin_amdgcn_s_setprio(1); _Pragma("unroll") for (int m = 0; m < 4; ++m) _Pragma("unroll") for (int n = 0; n < 2; ++n) _Pragma("unroll") for (int k = 0; k < 2; ++k) \
        acc[ai][bj][m][n] = __builtin_amdgcn_mfma_f32_16x16x32_bf16(Bt[n][k], At[m][k], acc[ai][bj][m][n], 0, 0, 0); __builtin_amdgcn_s_setprio(0); } while (0)
#define PG8_WAIT_V(n) asm volatile("s_waitcnt vmcnt(" #n ")" ::: "memory")
#define PG8_WAIT_L(n) asm volatile("s_waitcnt lgkmcnt(" #n ")" ::: "memory")
#define PG8_BAR __builtin_amdgcn_s_barrier()
#define PG8_SCHED __builtin_amdgcn_sched_barrier(0)
    Unit cur, nxt; int ui = 0;
    if (!S.next(0, cur)) return;
    f32x4 acc[2][2][4][2];
    E.init(acc, cur, wc, fq);
    bf16x8 At[4][2], B0[2][2], B1[2][2];
    unsigned vC[2][2];
    AS.offs(cur, Rs, Cs, vC);
    unsigned x00 = vC[0][0], x01 = vC[0][1], x10 = vC[1][0], x11 = vC[1][1];
    const char* cA = AS.base(cur); const char* cB = BS.base(cur);
    if constexpr (SP2) {
        PG8_STAGEB(PG8_SB(0, 0), cB); PG8_STAGEB(PG8_SB(0, 1), cB + hstepB); PG8_STAGEA(PG8_SA(0, 0), cA, vC[0][0], vC[0][1]); PG8_STAGEA(PG8_SA(0, 1), cA, vC[1][0], vC[1][1]);
        if (wr == 1) PG8_BAR;
        PG8_WAIT_V(2); PG8_BAR;
        PG8_STAGEB(PG8_SB(1, 0), cB + kstepB); PG8_STAGEA(PG8_SA(1, 0), cA + kstepA, vC[0][0], vC[0][1]); PG8_STAGEB(PG8_SB(1, 1), cB + hstepB + kstepB);
        PG8_WAIT_V(6); PG8_BAR;
    } else {
        PG8_STAGEB(PG8_SB(0, 0), cB); PG8_STAGEA(PG8_SA(0, 0), cA, vC[0][0], vC[0][1]); PG8_STAGEB(PG8_SB(0, 1), cB + hstepB); PG8_STAGEA(PG8_SA(0, 1), cA, vC[1][0], vC[1][1]);
        if (wr == 1) PG8_BAR;
        PG8_WAIT_V(4); PG8_BAR;
        PG8_STAGEB(PG8_SB(1, 0), cB + kstepB); PG8_STAGEA(PG8_SA(1, 0), cA + kstepA, vC[0][0], vC[0][1]); PG8_STAGEB(PG8_SB(1, 1), cB + hstepB + kstepB);
        PG8_WAIT_V(6); PG8_BAR;
    }
    for (;;) {
        const bool has_next = S.next(ui + 1, nxt);
        const char* nA = has_next ? AS.base(nxt) : cA; const char* nB = has_next ? BS.base(nxt) : cB;
        for (int t = 0; t < nt; t += 2) {
            const bool last = (t == nt - 2);
            const char* a1 = cA + (size_t)(t + 1) * kstepA;
            const char* a2 = last ? nA : cA + (size_t)(t + 2) * kstepA; const char* b2 = last ? nB : cB + (size_t)(t + 2) * kstepB;
            const char* a3 = a2 + kstepA; const char* b3 = b2 + kstepB;
            if constexpr (ASrc::GATHER) { if (last && has_next) { unsigned vn[2][2]; AS.offs(nxt, Rs, Cs, vn); x00 = vn[0][0]; x01 = vn[0][1]; x10 = vn[1][0]; x11 = vn[1][1]; } }
            if constexpr (SP2) {
            PG8_LDB(B0, 0, 0); PG8_LDB(B1, 0, 1); PG8_SCHED; PG8_LDA(At, 0, 0); PG8_STAGEA(PG8_SA(1, 1), a1, vC[1][0], vC[1][1]);
            PG8_WAIT_V(8); PG8_WAIT_L(0); PG8_BAR; PG8_MMA(0, 0, At, B0); PG8_MMA(0, 1, At, B1); PG8_BAR; PG8_SCHED;
            PG8_LDA(At, 0, 1); PG8_STAGEB(PG8_SB(0, 0), b2); PG8_STAGEB(PG8_SB(0, 1), b2 + hstepB); PG8_STAGEA(PG8_SA(0, 0), a2, x00, x01);
            PG8_WAIT_V(8); PG8_WAIT_L(0); PG8_BAR; PG8_MMA(1, 0, At, B0); PG8_MMA(1, 1, At, B1); PG8_BAR; PG8_SCHED;
            PG8_LDB(B0, 1, 0); PG8_LDB(B1, 1, 1); PG8_SCHED; PG8_LDA(At, 1, 0); PG8_STAGEA(PG8_SA(0, 1), a2, x10, x11);
            PG8_WAIT_V(8); PG8_WAIT_L(0); PG8_BAR; PG8_MMA(0, 0, At, B0); PG8_MMA(0, 1, At, B1); PG8_BAR; PG8_SCHED;
            PG8_LDA(At, 1, 1); PG8_STAGEB(PG8_SB(1, 0), b3); PG8_STAGEB(PG8_SB(1, 1), b3 + hstepB); PG8_STAGEA(PG8_SA(1, 0), a3, x00, x01);
            PG8_WAIT_V(8); PG8_WAIT_L(0); PG8_BAR; PG8_MMA(1, 0, At, B0); PG8_MMA(1, 1, At, B1); PG8_BAR; PG8_SCHED;
            } else {
            PG8_LDB(B0, 0, 0); PG8_SCHED; PG8_LDA(At, 0, 0); PG8_STAGEA(PG8_SA(1, 1), a1, vC[1][0], vC[1][1]);
            PG8_WAIT_L(8); PG8_BAR; PG8_WAIT_L(0); PG8_MMA(0, 0, At, B0); PG8_BAR; PG8_SCHED;
            PG8_LDB(B1, 0, 1); PG8_STAGEB(PG8_SB(0, 0), b2);
            PG8_BAR; PG8_WAIT_L(0); PG8_MMA(0, 1, At, B1); PG8_BAR;
            PG8_LDA(At, 0, 1); PG8_STAGEA(PG8_SA(0, 0), a2, x00, x01);
            PG8_BAR; PG8_WAIT_L(0); PG8_MMA(1, 0, At, B0); PG8_BAR; PG8_SCHED;
            PG8_STAGEB(PG8_SB(0, 1), b2 + hstepB);
            PG8_WAIT_V(6); PG8_BAR; PG8_MMA(1, 1, At, B1); PG8_BAR;
            PG8_LDB(B0, 1, 0); PG8_SCHED; PG8_LDA(At, 1, 0); PG8_STAGEA(PG8_SA(0, 1), a2, x10, x11);
            PG8_WAIT_L(8); PG8_BAR; PG8_WAIT_L(0); PG8_MMA(0, 0, At, B0); PG8_BAR; PG8_SCHED;
            PG8_LDB(B1, 1, 1); PG8_STAGEB(PG8_SB(1, 0), b3);
            PG8_BAR; PG8_WAIT_L(0); PG8_MMA(0, 1, At, B1); PG8_BAR;
            PG8_LDA(At, 1, 1); PG8_STAGEA(PG8_SA(1, 0), a3, x00, x01);
            PG8_BAR; PG8_WAIT_L(0); PG8_MMA(1, 0, At, B0); PG8_BAR; PG8_SCHED;
            PG8_STAGEB(PG8_SB(1, 1), b3 + hstepB);
            PG8_WAIT_V(6); PG8_BAR; PG8_MMA(1, 1, At, B1); PG8_BAR;
            }
        }
        if constexpr (ALIGN_EPI) { if (wr == 0) PG8_BAR; }
        E(acc, cur, wr, wc, fr, fq);
        if (!has_next) break;
        E.init(acc, nxt, wc, fq);
        cur = nxt; cA = nA; cB = nB; ++ui;
        if constexpr (ASrc::GATHER) { vC[0][0] = x00; vC[0][1] = x01; vC[1][0] = x10; vC[1][1] = x11; }
        if constexpr (ALIGN_EPI) { if (wr == 1) PG8_BAR; }
    }
    PG8_WAIT_V(0);
    if constexpr (!ALIGN_EPI) { if (wr == 0) PG8_BAR; }
    PG8_BAR;
#undef PG8_SA
#undef PG8_SB
#undef PG8_STAGEA
#undef PG8_STAGEB
#undef PG8_LDA
#undef PG8_LDB
#undef PG8_MMA
#undef PG8_WAIT_V
#undef PG8_WAIT_L
#undef PG8_BAR
#undef PG8_SCHED
}
}
namespace pg8 {
__device__ __forceinline__ float gelu_tanh(float x) {
    const float u = 0.7978845608028654f * (x + 0.044715f * x * x * x);
    const float e = __expf(-2.0f * fabsf(u)); float th = (1.0f - e) * __builtin_amdgcn_rcpf(1.0f + e); th = u < 0.f ? -th : th;
    return 0.5f * x * (1.0f + th);
}
struct EpiStore {
    static constexpr bool PERM = true;
    bf16_t* O; int ldc;
    __device__ __forceinline__ void init(f32x4 (&acc)[2][2][4][2], const Unit&, int, int) const {
#pragma unroll
        for (int a = 0; a < 2; ++a)
#pragma unroll
            for (int b = 0; b < 2; ++b)
#pragma unroll
                for (int m = 0; m < 4; ++m)
#pragma unroll
                    for (int n = 0; n < 2; ++n) acc[a][b][m][n] = (f32x4){0.f, 0.f, 0.f, 0.f};
    }
    __device__ __forceinline__ void operator()(const f32x4 (&acc)[2][2][4][2], const Unit& u, int wr, int wc, int fr, int fq) const {
        const int row0 = u.pm * BM + wr * 64 + fr, col0 = u.pn * BM + wc * 32 + 8 * fq;
#pragma unroll
        for (int ai = 0; ai < 2; ++ai)
#pragma unroll
            for (int m = 0; m < 4; ++m) { bf16_t* rowp = O + (size_t)(row0 + ai * HALF + m * 16) * ldc + col0;
#pragma unroll
                for (int bj = 0; bj < 2; ++bj) { const f32x4 v0 = acc[ai][bj][m][0], v1 = acc[ai][bj][m][1];
                    u32x4 w; w.x = cvt_pk_bf16(v0[0], v0[1]); w.y = cvt_pk_bf16(v0[2], v0[3]); w.z = cvt_pk_bf16(v1[0], v1[1]); w.w = cvt_pk_bf16(v1[2], v1[3]);
                    *(u32x4*)(rowp + bj * HALF) = w; } }
    }
};
struct EpiCmpGelu {
    static constexpr bool PERM = true;
    bf16_t* O; const float* bias;
    __device__ __forceinline__ void init(f32x4 (&acc)[2][2][4][2], const Unit&, int, int) const {
#pragma unroll
        for (int a = 0; a < 2; ++a)
#pragma unroll
            for (int b = 0; b < 2; ++b)
#pragma unroll
                for (int m = 0; m < 4; ++m)
#pragma unroll
                    for (int n = 0; n < 2; ++n) acc[a][b][m][n] = (f32x4){0.f, 0.f, 0.f, 0.f};
    }
    __device__ __forceinline__ void operator()(const f32x4 (&acc)[2][2][4][2], const Unit& u, int wr, int wc, int fr, int fq) const {
        const int row0 = u.pm * BM + wr * 64 + fr, col0 = wc * 32 + 8 * fq;
        bf16_t* Oj = O + (size_t)u.e * 16384 * 256; const float* bj_ = bias + u.e * 256;
        f32x4 bv[2][2];
#pragma unroll
        for (int bj = 0; bj < 2; ++bj)
#pragma unroll
            for (int n = 0; n < 2; ++n) bv[bj][n] = *(const f32x4*)(bj_ + col0 + bj * HALF + 4 * n);
#pragma unroll
        for (int ai = 0; ai < 2; ++ai)
#pragma unroll
            for (int m = 0; m < 4; ++m) { bf16_t* rowp = Oj + (size_t)(row0 + ai * HALF + m * 16) * 256 + col0;
#pragma unroll
                for (int bj = 0; bj < 2; ++bj) { f32x4 v0 = acc[ai][bj][m][0] + bv[bj][0], v1 = acc[ai][bj][m][1] + bv[bj][1];
#pragma unroll
                    for (int j = 0; j < 4; ++j) { v0[j] = gelu_tanh(v0[j]); v1[j] = gelu_tanh(v1[j]); }
                    u32x4 w; w.x = cvt_pk_bf16(v0[0], v0[1]); w.y = cvt_pk_bf16(v0[2], v0[3]); w.z = cvt_pk_bf16(v1[0], v1[1]); w.w = cvt_pk_bf16(v1[2], v1[3]);
                    *(u32x4*)(rowp + bj * HALF) = w; } }
    }
};
struct EpiSwiglu {
    static constexpr bool PERM = true;
    bf16_t* H; const float* bgu;
    __device__ __forceinline__ void init(f32x4 (&acc)[2][2][4][2], const Unit& u, int wc, int fq) const {
        const float* bg = bgu + (size_t)u.e * 2048 + u.pn * HALF + wc * 32 + 8 * fq;
#pragma unroll
        for (int n = 0; n < 2; ++n) { const f32x4 g = *(const f32x4*)(bg + 4 * n), up = *(const f32x4*)(bg + 1024 + 4 * n);
#pragma unroll
            for (int a = 0; a < 2; ++a)
#pragma unroll
                for (int m = 0; m < 4; ++m) { acc[a][0][m][n] = g; acc[a][1][m][n] = up; } }
    }
    __device__ __forceinline__ void operator()(const f32x4 (&acc)[2][2][4][2], const Unit& u, int wr, int wc, int fr, int fq) const {
        const int row0 = u.pm * BM + wr * 64 + fr, col0 = u.pn * HALF + wc * 32 + 8 * fq;
#pragma unroll
        for (int ai = 0; ai < 2; ++ai)
#pragma unroll
            for (int m = 0; m < 4; ++m) { bf16_t* rowp = H + (size_t)(row0 + ai * HALF + m * 16) * DFF + col0;
                unsigned wv[4];
#pragma unroll
                for (int n = 0; n < 2; ++n) { const f32x4 g = acc[ai][0][m][n], up = acc[ai][1][m][n];
#pragma unroll
                    for (int j = 0; j < 2; ++j) {
                        const f32x2 gg = {__builtin_amdgcn_fmed3f(g[2 * j], -3.0e38f, 7.0f), __builtin_amdgcn_fmed3f(g[2 * j + 1], -3.0e38f, 7.0f)};
                        const f32x2 uu = {__builtin_amdgcn_fmed3f(up[2 * j], -7.0f, 7.0f), __builtin_amdgcn_fmed3f(up[2 * j + 1], -7.0f, 7.0f)};
                        const f32x2 t = gg * -2.4554669595930156f;
                        f32x2 d = {__builtin_amdgcn_exp2f(t.x), __builtin_amdgcn_exp2f(t.y)}; d = d + 1.0f;
                        const f32x2 rr = {__builtin_amdgcn_rcpf(d.x), __builtin_amdgcn_rcpf(d.y)};
                        const f32x2 o = (uu + 1.0f) * gg * rr;
                        wv[2 * n + j] = cvt_pk_bf16(o.x, o.y); } }
                u32x4 w; w.x = wv[0]; w.y = wv[1]; w.z = wv[2]; w.w = wv[3];
                *(u32x4*)rowp = w; }
    }
};
struct EpiDown {
    static constexpr bool PERM = true;
    bf16_t* Y; const float* bd; const float* rgate;
    __device__ __forceinline__ void init(f32x4 (&acc)[2][2][4][2], const Unit& u, int wc, int fq) const {
        const float* b = bd + (size_t)u.e * 1024 + u.pn * BM + wc * 32 + 8 * fq;
#pragma unroll
        for (int bj = 0; bj < 2; ++bj)
#pragma unroll
            for (int n = 0; n < 2; ++n) { const f32x4 bv = *(const f32x4*)(b + bj * HALF + 4 * n);
#pragma unroll
                for (int a = 0; a < 2; ++a)
#pragma unroll
                    for (int m = 0; m < 4; ++m) acc[a][bj][m][n] = bv; }
    }
    __device__ __forceinline__ void operator()(const f32x4 (&acc)[2][2][4][2], const Unit& u, int wr, int wc, int fr, int fq) const {
        const int row0 = u.pm * BM + wr * 64 + fr, col0 = u.pn * BM + wc * 32 + 8 * fq;
#pragma unroll
        for (int ai = 0; ai < 2; ++ai)
#pragma unroll
            for (int m = 0; m < 4; ++m) { const int row = row0 + ai * HALF + m * 16; const float gt = rgate[row]; bf16_t* rowp = Y + (size_t)row * D + col0;
#pragma unroll
                for (int bj = 0; bj < 2; ++bj) { const f32x4 v0 = acc[ai][bj][m][0] * gt, v1 = acc[ai][bj][m][1] * gt;
                    u32x4 w; w.x = cvt_pk_bf16(v0[0], v0[1]); w.y = cvt_pk_bf16(v0[2], v0[3]); w.z = cvt_pk_bf16(v1[0], v1[1]); w.w = cvt_pk_bf16(v1[2], v1[3]);
                    *(u32x4*)(rowp + bj * HALF) = w; } }
    }
};
}
struct Frame {
    LAS unsigned char* lds;
    volatile LAS unsigned* LC;
    unsigned* ctl;
    unsigned char* ws;
    int tid, lane, wave, G, bx;
    float* out;
};
__device__ __forceinline__ size_t opaque_off(size_t o) { asm volatile("; ws offset" : "+s"(o)); return o; }
#define WSP(T_, off) ((T_*)(F.ws + opaque_off(off)))
__device__ __forceinline__ const float* inptr(const Frame& F, int i) {
    const unsigned lo = __builtin_amdgcn_readfirstlane(F.LC[128 + 2 * i]), hi = __builtin_amdgcn_readfirstlane(F.LC[129 + 2 * i]);
    const float* p = (const float*)(const GAS float*)(((unsigned long long)hi << 32) | (unsigned long long)lo);
    return p;
}
enum { I_X = 0, I_LN_G, I_LN_B, I_NSA_W_IN, I_NSA_CMP_POS, I_NSA_CMP_W1, I_NSA_CMP_B1, I_NSA_CMP_W2, I_NSA_CMP_B2, I_NSA_GATE_B, I_NSA_W_OUT,
       I_ML_W_IN, I_ML_CONV_W, I_ML_CONV_B, I_ML_GATE_B, I_ML_NORM_G, I_ML_W_OUT, I_HG_W_IN, I_HG_LOWER, I_HG_NORM_G, I_HG_W_OUT,
       I_ROUTER_W, I_ROUTER_B, I_MOE_W_GU, I_MOE_B_GU, I_MOE_W_DOWN, I_MOE_B_DOWN };

__device__ __forceinline__ void tr_load(f32x4 (&v)[16], const float* W, int N, int nvalid, int k0, int n0, int lane) {
    const int nn = n0 + 4 * (lane & 15); const bool ok = nn < nvalid; const int kr = lane >> 4;
#pragma unroll
    for (int i = 0; i < 16; ++i) v[i] = ok ? *(const f32x4*)(W + (size_t)(k0 + 4 * i + kr) * N + nn) : (f32x4){0.f, 0.f, 0.f, 0.f};
}
__device__ __forceinline__ void tr_store(const f32x4 (&v)[16], int K, bf16_t* WT, int drow, int k0, LAS float* scr, int lane) {
    const int kr = lane >> 4;
#pragma unroll
    for (int i = 0; i < 16; ++i) { LAS float* d = scr + (4 * i + kr) * 65 + 4 * (lane & 15); d[0] = v[i][0]; d[1] = v[i][1]; d[2] = v[i][2]; d[3] = v[i][3]; }
    LDS_WAIT();
    const int c = lane & 7;
#pragma unroll
    for (int j = 0; j < 8; ++j) { const int n = (lane >> 3) + 8 * j; const LAS float* s = scr + (8 * c) * 65 + n;
        u32x4 o; o.x = pk2(s[0 * 65], s[1 * 65]); o.y = pk2(s[2 * 65], s[3 * 65]); o.z = pk2(s[4 * 65], s[5 * 65]); o.w = pk2(s[6 * 65], s[7 * 65]);
        *(u32x4*)(WT + (size_t)(drow + n) * K + k0 + 8 * c) = o; }
    LDS_WAIT();
}
__device__ __forceinline__ void tr_class(Frame& F, const float* W, int nmat, int K, int N, int Npad, bf16_t* WT, bool gu, LAS float* scr, int gw, int NGW) {
    const int nblk = Npad / 64, per = (K / 64) * nblk; const long total = (long)nmat * per;
    f32x4 vbuf[16];
    long it = gw;
    if (it < total) { const int mat = (int)(it / per), r = (int)(it % per), kb = r / nblk, nb = r % nblk; tr_load(vbuf, W + (size_t)mat * K * N, N, N, kb * 64, nb * 64, F.lane); }
#pragma unroll 1
    for (; it < total; it += NGW) {
        const int mat = (int)(it / per), r = (int)(it % per), kb = r / nblk, nb = r % nblk, n0 = nb * 64;
        int drow = n0;
        if (gu) drow = (n0 < 1024) ? ((n0 >> 7) * 256 + (n0 & 127)) : ((((n0 - 1024) >> 7) * 256) + 128 + ((n0 - 1024) & 127));
        f32x4 cur[16];
#pragma unroll
        for (int i = 0; i < 16; ++i) cur[i] = vbuf[i];
        const long nx = it + NGW;
        if (nx < total) { const int mat2 = (int)(nx / per), r2 = (int)(nx % per), kb2 = r2 / nblk, nb2 = r2 % nblk; tr_load(vbuf, W + (size_t)mat2 * K * N, N, N, kb2 * 64, nb2 * 64, F.lane); }
        tr_store(cur, K, WT + (size_t)mat * Npad * K, drow, kb * 64, scr, F.lane);
    }
}
__device__ __forceinline__ void p0_prologue(Frame& F) {
    LAS float* scr = (LAS float*)(F.lds + F.wave * 16896);
    const int gw = F.bx * 8 + F.wave, NGW = F.G * 8;
    tr_class(F, inptr(F, I_MOE_W_GU), DEPTH * NEXP, D, 2 * DFF, 2 * DFF, WSP(bf16_t, OFF_W_GU), true, scr, gw, NGW);
    tr_class(F, inptr(F, I_MOE_W_DOWN), DEPTH * NEXP, DFF, D, D, WSP(bf16_t, OFF_W_DN), false, scr, gw, NGW);
    tr_class(F, inptr(F, I_NSA_W_IN), 2, D, NSA_IN, NSA_LD, WSP(bf16_t, OFF_W_NSAIN), false, scr, gw, NGW);
    tr_class(F, inptr(F, I_NSA_W_OUT), 2, D, D, D, WSP(bf16_t, OFF_W_NSAOUT), false, scr, gw, NGW);
    tr_class(F, inptr(F, I_ML_W_IN), 1, D, ML_IN, ML_LD, WSP(bf16_t, OFF_W_MLIN), false, scr, gw, NGW);
    tr_class(F, inptr(F, I_ML_W_OUT), 1, D, D, D, WSP(bf16_t, OFF_W_MLOUT), false, scr, gw, NGW);
    tr_class(F, inptr(F, I_HG_W_IN), 1, D, HG_LD, HG_LD, WSP(bf16_t, OFF_W_HGIN), false, scr, gw, NGW);
    tr_class(F, inptr(F, I_HG_W_OUT), 1, D, D, D, WSP(bf16_t, OFF_W_HGOUT), false, scr, gw, NGW);
    tr_class(F, inptr(F, I_NSA_CMP_W1), 4, 2048, 256, 256, WSP(bf16_t, OFF_W_CMP1), false, scr, gw, NGW);
    tr_class(F, inptr(F, I_NSA_CMP_W2), 4, 256, 64, 64, WSP(bf16_t, OFF_W_CMP2), false, scr, gw, NGW);
    const int gt = F.bx * 512 + F.tid;
    float* tab = WSP(float, OFF_TAB);
    if (gt < 1024) {
        const int lj = gt >> 8, n = gt & 255; const float* pos = inptr(F, I_NSA_CMP_POS) + (size_t)lj * 2048; const float* w1 = inptr(F, I_NSA_CMP_W1) + (size_t)lj * 2048 * 256;
        float a = inptr(F, I_NSA_CMP_B1)[lj * 256 + n];
        for (int k = 0; k < 2048; ++k) a += pos[k] * w1[(size_t)k * 256 + n];
        tab[TAB_CMPB + gt] = a;
    } else if (gt < 2048) {
        const int c = gt - 1024; float v[DEPTH], mx = -1e30f;
#pragma unroll
        for (int i = 0; i < DEPTH; ++i) { v[i] = inptr(F, I_HG_LOWER)[i * D + c]; mx = fmaxf(mx, v[i]); }
        float s = 0.f;
#pragma unroll
        for (int i = 0; i < DEPTH; ++i) { v[i] = __expf(v[i] - mx); s += v[i]; }
        tab[TAB_LB + c] = (v[1] + v[2]) / s;
    }
    { const float* rw = inptr(F, I_ROUTER_W); float* rwt = WSP(float, OFF_TAB) + TAB_RWT;
      for (int i = F.bx * 512 + F.tid; i < DEPTH * D * NEXP; i += F.G * 512) { const int l = i >> 15, r = i & 32767, k = r >> 5, e = r & 31; rwt[(l * NEXP + e) * D + k] = rw[i]; } }
    {
        const f32x4* xs = (const f32x4*)inptr(F, I_X); u32x2* xn = WSP(u32x2, OFF_XN);
        const size_t n4 = (size_t)NTOK * D / 4, stride = (size_t)F.G * 512;
        for (size_t i = (size_t)F.bx * 512 + F.tid; i < n4; i += stride) { const f32x4 v = xs[i]; u32x2 o; o.x = pk2(v[0], v[1]); o.y = pk2(v[2], v[3]); xn[i] = o; }
    }
}

__device__ __forceinline__ void phase_ln_router(Frame& F, int layer, bool dummy = false) {
    constexpr int SP = 1028;
    LAS float* LgL = (LAS float*)F.lds;
    LAS float* slab = LgL + 256 * 33;
    LAS float* part = slab + 16 * SP;
    if (F.tid < 32) F.LC[64 + F.tid] = 0u;
    __syncthreads();
    const float* g = inptr(F, I_LN_G) + (size_t)(layer * 2 + 0) * D; const float* bb = inptr(F, I_LN_B) + (size_t)(layer * 2 + 0) * D;
    const float* rb = inptr(F, I_ROUTER_B) + layer * NEXP;
    const float* rwt = WSP(float, OFF_TAB) + TAB_RWT + (size_t)layer * NEXP * D;
    const bf16_t* HM = WSP(bf16_t, OFF_HM); bf16_t* XN = dummy ? WSP(bf16_t, OFF_H + 256 * MiB) : WSP(bf16_t, OFF_XN);
    const bf16_t* XR = WSP(bf16_t, OFF_XN);
    int* toke = dummy ? WSP(int, OFF_H + 400 * MiB) : WSP(int, OFF_TOKE); float* tokg = dummy ? WSP(float, OFF_H + 402 * MiB) : WSP(float, OFF_TOKG);
    int lane = F.lane; asm volatile("; phase-local lane" : "+v"(lane));
    const int fr = lane & 15, fg = lane >> 4, wave = F.wave;
    const float rbv = rb[F.tid & 31];
    f32x4 b0r[8], b1r[8], gr[4], br[4];
    { const f32x4* B0p = (const f32x4*)(rwt + (size_t)fr * D + 128 * wave) + fg; const f32x4* B1p = (const f32x4*)(rwt + (size_t)(16 + fr) * D + 128 * wave) + fg;
#pragma unroll
      for (int t = 0; t < 8; ++t) { b0r[t] = B0p[4 * t]; b1r[t] = B1p[4 * t]; }
#pragma unroll
      for (int j = 0; j < 4; ++j) { gr[j] = *((const f32x4*)g + lane + 64 * j); br[j] = *((const f32x4*)bb + lane + 64 * j); } }
    for (int blk = F.bx; blk < NTOK / 256; blk += F.G) {
        u32x2 xn_[2][4], hn_[2][4];
        { const int m0 = blk * 256 + 2 * wave;
#pragma unroll
          for (int q = 0; q < 2; ++q) { const u32x2* xr = (const u32x2*)(XR + (size_t)(m0 + q) * D) + lane; const u32x2* hr = (const u32x2*)(HM + (size_t)(m0 + q) * D) + lane;
#pragma unroll
            for (int j = 0; j < 4; ++j) { xn_[q][j] = xr[64 * j]; hn_[q][j] = hr[64 * j]; } } }
#pragma unroll 1
        for (int sub = 0; sub < 16; ++sub) {
            const int mb = blk * 256 + sub * 16 + 2 * wave;
            f32x4 v[2][4]; float s[2] = {0.f, 0.f};
#pragma unroll
            for (int q = 0; q < 2; ++q)
#pragma unroll
                for (int j = 0; j < 4; ++j) { const u32x2 xv = xn_[q][j]; const u32x2 hv = hn_[q][j];
                    v[q][j][0] = DN_ALPHA * __uint_as_float(xv.x << 16) + __uint_as_float(hv.x << 16); v[q][j][1] = DN_ALPHA * __uint_as_float(xv.x & 0xffff0000u) + __uint_as_float(hv.x & 0xffff0000u);
                    v[q][j][2] = DN_ALPHA * __uint_as_float(xv.y << 16) + __uint_as_float(hv.y << 16); v[q][j][3] = DN_ALPHA * __uint_as_float(xv.y & 0xffff0000u) + __uint_as_float(hv.y & 0xffff0000u);
                    s[q] += (v[q][j][0] + v[q][j][1]) + (v[q][j][2] + v[q][j][3]); }
            if (sub + 1 < 16) {
#pragma unroll
                for (int q = 0; q < 2; ++q) { const u32x2* xr = (const u32x2*)(XR + (size_t)(mb + 16 + q) * D) + lane; const u32x2* hr = (const u32x2*)(HM + (size_t)(mb + 16 + q) * D) + lane;
#pragma unroll
                    for (int j = 0; j < 4; ++j) { xn_[q][j] = xr[64 * j]; hn_[q][j] = hr[64 * j]; } } }
#pragma unroll
            for (int q = 0; q < 2; ++q) {
                const float mean = wave_sum(s[q]) * (1.f / D); float s2 = 0.f;
#pragma unroll
                for (int j = 0; j < 4; ++j) { v[q][j] = v[q][j] - mean; s2 += (v[q][j][0] * v[q][j][0] + v[q][j][1] * v[q][j][1]) + (v[q][j][2] * v[q][j][2] + v[q][j][3] * v[q][j][3]); }
                const float rstd = __builtin_amdgcn_rsqf(wave_sum(s2) * (1.f / D) + LN_EPS);
                u32x2* no = (u32x2*)(XN + (size_t)(mb + q) * D) + lane; LAS f32x4* so = (LAS f32x4*)(slab + (2 * wave + q) * SP) + lane;
#pragma unroll
                for (int j = 0; j < 4; ++j) { const f32x4 gv = gr[j], bv = br[j];
                    const f32x4 y = v[q][j] * rstd * gv + bv; so[64 * j] = y; u32x2 o; o.x = pk2(y[0], y[1]); o.y = pk2(y[2], y[3]); no[64 * j] = o; }
            }
            __syncthreads();
            {
                const LAS f32x4* Ap = (const LAS f32x4*)(slab + fr * SP + 128 * wave) + fg;
                f32x4 acc0 = (f32x4){0.f, 0.f, 0.f, 0.f}, acc1 = acc0;
#pragma unroll
                for (int t = 0; t < 8; ++t) { const f32x4 a = Ap[4 * t], b0 = b0r[t], b1 = b1r[t];
#pragma unroll
                    for (int j = 0; j < 4; ++j) { acc0 = __builtin_amdgcn_mfma_f32_16x16x4f32(a[j], b0[j], acc0, 0, 0, 0); acc1 = __builtin_amdgcn_mfma_f32_16x16x4f32(a[j], b1[j], acc1, 0, 0, 0); } }
#pragma unroll
                for (int e = 0; e < 4; ++e) { LAS float* pr = part + (wave * 16 + 4 * fg + e) * 33; pr[fr] = acc0[e]; pr[16 + fr] = acc1[e]; }
            }
            __syncthreads();
            { const int row = F.tid >> 5, e = F.tid & 31; float lg = rbv;
#pragma unroll
              for (int w8 = 0; w8 < 8; ++w8) lg += part[(w8 * 16 + row) * 33 + e];
              LgL[(sub * 16 + row) * 33 + e] = lg; }
        }
        __syncthreads();
        if (F.tid < 256) {
            const int m = blk * 256 + F.tid; const LAS float* lr = LgL + F.tid * 33;
            unsigned taken = 0u; int se[TOPK]; float sv[TOPK];
#pragma unroll
            for (int k = 0; k < TOPK; ++k) { float best = -INFINITY; int bi = 0;
#pragma unroll 8
                for (int e = 0; e < NEXP; ++e) { const float c = ((taken >> e) & 1u) ? -INFINITY : lr[e]; if (c > best) { best = c; bi = e; } }
                se[k] = bi; sv[k] = best; taken |= 1u << bi; }
            float gs = 0.f, ge[TOPK];
#pragma unroll
            for (int k = 0; k < TOPK; ++k) { ge[k] = __expf(sv[k] - sv[0]); gs += ge[k]; }
            const float inv = __builtin_amdgcn_rcpf(gs);
#pragma unroll
            for (int k = 0; k < TOPK; ++k) { toke[m * 4 + k] = se[k]; tokg[m * 4 + k] = ge[k] * inv; __hip_atomic_fetch_add((LAS unsigned*)&F.LC[64 + se[k]], 1u, __ATOMIC_RELAXED, __HIP_MEMORY_SCOPE_WORKGROUP); }
        }
        __syncthreads();
    }
    if (F.tid < 32) { const unsigned c = F.LC[64 + F.tid]; if (c) __hip_atomic_fetch_add(F.ctl + (dummy ? 12288 : CW_CNT) + layer * 64 + F.tid, c, RLX_AGENT); }
    __syncthreads();
}

__device__ __forceinline__ void moe_tile_table(Frame& F, int layer) {
    if (F.tid < 64) {
        const int e = F.tid & 31;
        const unsigned c = __hip_atomic_load(F.ctl + CW_CNT + layer * 64 + e, RLX_AGENT);
        int acc = (int)((c + 255u) >> 8);
#pragma unroll
        for (int o = 1; o < 32; o <<= 1) { const int u = __shfl_up(acc, o); if (e >= o) acc += u; }
        if (F.tid < 32) { F.LC[8 + e] = (unsigned)acc; if (e == 31) F.LC[40] = (unsigned)acc; }
    }
    __syncthreads();
}
__device__ __forceinline__ void phase_moe_slots(Frame& F, int layer) {
    moe_tile_table(F, layer);
    const int* toke = WSP(int, OFF_TOKE); const float* tokg = WSP(float, OFF_TOKG);
    int* tokp = WSP(int, OFF_TOKP); int* rowt = WSP(int, OFF_ROWT); float* rowg = WSP(float, OFF_ROWG);
    for (int blk = F.bx; blk < NTOK / 256; blk += F.G) {
        if (F.tid < 32) F.LC[64 + F.tid] = 0u;
        __syncthreads();
        int e[2], rank[2];
#pragma unroll
        for (int q = 0; q < 2; ++q) { const int a = blk * 1024 + q * 512 + F.tid; e[q] = toke[a]; rank[q] = (int)__hip_atomic_fetch_add((LAS unsigned*)&F.LC[64 + e[q]], 1u, __ATOMIC_RELAXED, __HIP_MEMORY_SCOPE_WORKGROUP); }
        __syncthreads();
        if (F.tid < 32) { const unsigned c = F.LC[64 + F.tid]; const unsigned pstart = (F.tid ? F.LC[8 + F.tid - 1] : 0u) * 256u;
            F.LC[96 + F.tid] = pstart + (c ? __hip_atomic_fetch_add(F.ctl + CW_CUR + layer * 64 + F.tid, c, RLX_AGENT) : 0u); }
        __syncthreads();
#pragma unroll
        for (int q = 0; q < 2; ++q) { const int a = blk * 1024 + q * 512 + F.tid; const int pos = (int)F.LC[96 + e[q]] + rank[q];
            rowt[pos] = a >> 2; rowg[pos] = tokg[a]; tokp[a] = pos; }
        __syncthreads();
    }
    for (int e2 = F.bx; e2 < NEXP; e2 += F.G) {
        const unsigned c = __hip_atomic_load(F.ctl + CW_CNT + layer * 64 + e2, RLX_AGENT); const unsigned pstart = (e2 ? F.LC[8 + e2 - 1] : 0u) * 256u, pend = F.LC[8 + e2] * 256u;
        for (unsigned r = pstart + c + F.tid; r < pend; r += 512) { rowt[r] = 0; rowg[r] = 0.f; }
    }
}
__device__ __forceinline__ void phase_combine_ln(Frame& F, int layer, float* xo_base  , bool dummy = false) {
    const float* g = inptr(F, I_LN_G) + (size_t)(layer * 2 + 1) * D; const float* bb = inptr(F, I_LN_B) + (size_t)(layer * 2 + 1) * D;
    const bf16_t* XR = WSP(bf16_t, OFF_XN); bf16_t* XN = dummy ? WSP(bf16_t, OFF_H + 256 * MiB) : WSP(bf16_t, OFF_XN); const bf16_t* Y = WSP(bf16_t, OFF_Y); const int* tokp = WSP(int, OFF_TOKP);
    int lane = F.lane; asm volatile("; phase-local lane" : "+v"(lane)); const int gw = F.bx * 8 + F.wave, NGW = F.G * 8;
    u32x2 xq[4]; u32x2 yq[TOPK][4]; int posn[TOPK];
    f32x4 gr[4], br[4];
#pragma unroll
    for (int j = 0; j < 4; ++j) { gr[j] = *((const f32x4*)g + lane + 64 * j); br[j] = *((const f32x4*)bb + lane + 64 * j); }
    {
        int p0[TOPK];
#pragma unroll
        for (int k = 0; k < TOPK; ++k) p0[k] = (gw < NTOK) ? tokp[gw * 4 + k] : 0;
        if (gw < NTOK) { const u32x2* xr = (const u32x2*)(XR + (size_t)gw * D) + lane;
#pragma unroll
            for (int j = 0; j < 4; ++j) xq[j] = xr[64 * j];
#pragma unroll
            for (int k = 0; k < TOPK; ++k) { const u32x2* yr = (const u32x2*)(Y + (size_t)p0[k] * D) + lane;
#pragma unroll
                for (int j = 0; j < 4; ++j) yq[k][j] = __builtin_nontemporal_load(yr + 64 * j); } }
#pragma unroll
        for (int k = 0; k < TOPK; ++k) posn[k] = (gw + NGW < NTOK) ? tokp[(gw + NGW) * 4 + k] : 0;
    }
#pragma unroll 1
    for (int m = gw; m < NTOK; m += NGW) {
        f32x4 v[4]; float s = 0.f;
#pragma unroll
        for (int j = 0; j < 4; ++j) { const u32x2 xv = xq[j]; v[j][0] = DN_ALPHA * __uint_as_float(xv.x << 16); v[j][1] = DN_ALPHA * __uint_as_float(xv.x & 0xffff0000u); v[j][2] = DN_ALPHA * __uint_as_float(xv.y << 16); v[j][3] = DN_ALPHA * __uint_as_float(xv.y & 0xffff0000u); }
#pragma unroll
        for (int k = 0; k < TOPK; ++k) {
#pragma unroll
            for (int j = 0; j < 4; ++j) { const u32x2 hv = yq[k][j];
                v[j][0] += __uint_as_float(hv.x << 16); v[j][1] += __uint_as_float(hv.x & 0xffff0000u); v[j][2] += __uint_as_float(hv.y << 16); v[j][3] += __uint_as_float(hv.y & 0xffff0000u); } }
        if (m + NGW < NTOK) {
            const u32x2* xr = (const u32x2*)(XR + (size_t)(m + NGW) * D) + lane;
#pragma unroll
            for (int j = 0; j < 4; ++j) xq[j] = xr[64 * j];
#pragma unroll
            for (int k = 0; k < TOPK; ++k) { const u32x2* yr = (const u32x2*)(Y + (size_t)posn[k] * D) + lane;
#pragma unroll
                for (int j = 0; j < 4; ++j) yq[k][j] = __builtin_nontemporal_load(yr + 64 * j); }
#pragma unroll
            for (int k = 0; k < TOPK; ++k) posn[k] = (m + 2 * NGW < NTOK) ? tokp[(m + 2 * NGW) * 4 + k] : 0;
        }
#pragma unroll
        for (int j = 0; j < 4; ++j) s += (v[j][0] + v[j][1]) + (v[j][2] + v[j][3]);
        const float mean = wave_sum(s) * (1.f / D); float s2 = 0.f;
#pragma unroll
        for (int j = 0; j < 4; ++j) { v[j] = v[j] - mean; s2 += (v[j][0] * v[j][0] + v[j][1] * v[j][1]) + (v[j][2] * v[j][2] + v[j][3] * v[j][3]); }
        const float rstd = __builtin_amdgcn_rsqf(wave_sum(s2) * (1.f / D) + LN_EPS);
        u32x2* no = (u32x2*)(XN + (size_t)m * D) + lane;
#pragma unroll
        for (int j = 0; j < 4; ++j) { const f32x4 gv = gr[j], bv = br[j];
            v[j] = v[j] * rstd * gv + bv;
            if (xo_base) *((f32x4*)(xo_base + (size_t)m * D) + lane + 64 * j) = v[j];
            else { u32x2 o; o.x = pk2(v[j][0], v[j][1]); o.y = pk2(v[j][2], v[j][3]); no[64 * j] = o; } }
    }
}
__device__ __forceinline__ void phase_nsa_cmp2(Frame& F, int slot) {
    const bf16_t* HC = WSP(bf16_t, OFF_HC); bf16_t* KC = WSP(bf16_t, OFF_KC);
    const bf16_t* W2t = WSP(bf16_t, OFF_W_CMP2) + (size_t)slot * 2 * 64 * 256;
    const float* b2 = inptr(F, I_NSA_CMP_B2) + (size_t)slot * 2 * 64;
    int lane = F.lane; asm volatile("; phase-local lane" : "+v"(lane));
    const int fr = lane & 15, fg = lane >> 4, gw = F.bx * 8 + F.wave, NGW = F.G * 8;
    for (int blk = gw; blk < 2 * 1024; blk += NGW) {
        const int j = blk >> 10, r0 = (blk & 1023) * 16;
        const bf16_t* A = HC + ((size_t)j * 16384 + r0 + fr) * 256 + 8 * fg;
        const bf16_t* B = W2t + ((size_t)j * 64 + fr) * 256 + 8 * fg;
        f32x4 acc[4];
#pragma unroll
        for (int t = 0; t < 4; ++t) acc[t] = (f32x4){0.f, 0.f, 0.f, 0.f};
#pragma unroll
        for (int ks = 0; ks < 8; ++ks) { const bf16x8 a = *(const bf16x8*)(A + 32 * ks);
#pragma unroll
            for (int t = 0; t < 4; ++t) acc[t] = __builtin_amdgcn_mfma_f32_16x16x32_bf16(*(const bf16x8*)(B + (size_t)t * 16 * 256 + 32 * ks), a, acc[t], 0, 0, 0); }
        const int row = r0 + fr;
#pragma unroll
        for (int t = 0; t < 4; ++t) { const int d0 = 16 * t + 4 * fg; const f32x4 bv = *(const f32x4*)(b2 + j * 64 + d0);
            f32x4 v = acc[t] + bv; if ((row & 127) == 127) v = (f32x4){0.f, 0.f, 0.f, 0.f};
            u32x2 w; w.x = pg8::cvt_pk_bf16(v[0], v[1]); w.y = pg8::cvt_pk_bf16(v[2], v[3]);
            *(u32x2*)(KC + ((size_t)j * 16384 + row) * 64 + d0) = w; }
    }
}
typedef float f32x16 __attribute__((ext_vector_type(16)));
#define PP_SYNC() do { __builtin_amdgcn_sched_barrier(0); __syncthreads(); __builtin_amdgcn_sched_barrier(0); } while (0)
#ifndef SP_SCALAR
#define SP_SCALAR 0
#endif
#ifndef SP_FILL
#define SP_FILL 12
#endif
#ifndef XCMP
#define XCMP 0
#endif
#ifndef XSELN
#define XSELN 0
#endif
#ifndef XOUT
#define XOUT 0
#endif
namespace na {
constexpr int KP = 144;
constexpr int VP = 144;
__device__ __forceinline__ int vcol(int key) { return (key & ~15) | (key & 3) | ((key & 8) >> 1) | ((key & 4) << 1); }
constexpr int TILEB = 64 * KP;
constexpr int L_K = 0, L_V = 2 * TILEB, L_PQ = 4 * TILEB, SLB = 64 * 33, L_SEL = L_PQ + 4 * SLB * 4, L_OA = L_SEL + 4864;
constexpr float NEG = -1e30f;
constexpr float C1 = 0.125f * 1.4426950408889634f;
__device__ __forceinline__ int crow(int r, int hi) { return (r & 3) + 8 * (r >> 2) + 4 * hi; }
__device__ __forceinline__ bf16x8 pack8(const f32x16& p, int s1) {
    u32x4 w; w.x = pg8::cvt_pk_bf16(p[8 * s1 + 0], p[8 * s1 + 1]); w.y = pg8::cvt_pk_bf16(p[8 * s1 + 2], p[8 * s1 + 3]);
    w.z = pg8::cvt_pk_bf16(p[8 * s1 + 4], p[8 * s1 + 5]); w.w = pg8::cvt_pk_bf16(p[8 * s1 + 6], p[8 * s1 + 7]);
    return __builtin_bit_cast(bf16x8, w);
}
__device__ __forceinline__ void qk(f32x16& p0, f32x16& p1, const LAS unsigned char* Kt, const bf16x8 (&qf)[4], int r, int h) {
    const f32x16 z = {0.f, 0.f, 0.f, 0.f, 0.f, 0.f, 0.f, 0.f, 0.f, 0.f, 0.f, 0.f, 0.f, 0.f, 0.f, 0.f};
    bf16x8 a0[4], a1[4];
#pragma unroll
    for (int s = 0; s < 4; ++s) { a0[s] = *(const LAS bf16x8*)(Kt + r * KP + (16 * s + 8 * h) * 2); a1[s] = *(const LAS bf16x8*)(Kt + (32 + r) * KP + (16 * s + 8 * h) * 2); }
    __builtin_amdgcn_sched_barrier(0);
#pragma unroll
    for (int s = 0; s < 4; ++s) {
        p0 = __builtin_amdgcn_mfma_f32_32x32x16_bf16(a0[s], qf[s], s == 0 ? z : p0, 0, 0, 0);
        p1 = __builtin_amdgcn_mfma_f32_32x32x16_bf16(a1[s], qf[s], s == 0 ? z : p1, 0, 0, 0);
    }
}
__device__ __forceinline__ void pv(f32x16& o0, f32x16& o1, const LAS unsigned char* Vt, const f32x16& p0, const f32x16& p1, int r, int h) {
#pragma unroll
    for (int s = 0; s < 4; ++s) {
        const int s1 = s & 1;
        const bf16x8 bfrag = (s < 2) ? pack8(p0, s1) : pack8(p1, s1);
        const int key0 = 32 * (s >> 1) + 16 * s1 + 4 * h;
#pragma unroll
        for (int dh = 0; dh < 2; ++dh) {
            const bf16x8 a = *(const LAS bf16x8*)(Vt + (32 * dh + r) * VP + (key0 - 4 * h + 8 * h) * 2);
            if (dh == 0) o0 = __builtin_amdgcn_mfma_f32_32x32x16_bf16(a, bfrag, o0, 0, 0, 0);
            else o1 = __builtin_amdgcn_mfma_f32_32x32x16_bf16(a, bfrag, o1, 0, 0, 0);
        }
    }
}
__device__ __forceinline__ void pack_p(bf16x8 (&pb)[4], const f32x16& p0, const f32x16& p1) { pb[0] = pack8(p0, 0); pb[1] = pack8(p0, 1); pb[2] = pack8(p1, 0); pb[3] = pack8(p1, 1); }
__device__ __forceinline__ void pv2(f32x16& o0, f32x16& o1, const LAS unsigned char* Vt, const bf16x8 (&pb)[4], int r, int h) {
    bf16x8 a[4][2];
#pragma unroll
    for (int s = 0; s < 4; ++s) {
        const int key0 = 32 * (s >> 1) + 16 * (s & 1) + 4 * h;
#pragma unroll
        for (int dh = 0; dh < 2; ++dh) {
            a[s][dh] = *(const LAS bf16x8*)(Vt + (32 * dh + r) * VP + (key0 - 4 * h + 8 * h) * 2);
        }
    }
    __builtin_amdgcn_sched_barrier(0);
#pragma unroll
    for (int s = 0; s < 4; ++s) {
        o0 = __builtin_amdgcn_mfma_f32_32x32x16_bf16(a[s][0], pb[s], o0, 0, 0, 0);
        o1 = __builtin_amdgcn_mfma_f32_32x32x16_bf16(a[s][1], pb[s], o1, 0, 0, 0);
    }
}
__device__ __forceinline__ void softmax_step(f32x16& p0, f32x16& p1, float& m, float& l, f32x16& o0, f32x16& o1, bool lane_on = true) {
    constexpr float THR = 8.0f / C1;
    float mx = fmaxf(fmaxf(fmaxf(p0[0], p1[5]), fmaxf(p0[10], p1[15])), fmaxf(fmaxf(p1[0], p0[5]), fmaxf(p1[10], p0[15])));
    mx = lane_on ? mx : NEG;
    mx = fmaxf(mx, __shfl_xor(mx, 32));
    const float mn = (mx > m + THR) ? mx : m;
    const float muse = (mn < -1e29f) ? 0.f : mn;
    const bool grow = mn != m;
    const float mc = lane_on ? muse * C1 : 3.0e38f;
    f32x2 lsa = {0.f, 0.f}, lsb = {0.f, 0.f}; const f32x2 c1v = {C1, C1}, nmc = {-mc, -mc};
#pragma unroll
    for (int i = 0; i < 8; ++i) {
        f32x2 a = {p0[2 * i], p0[2 * i + 1]}, b = {p1[2 * i], p1[2 * i + 1]};
        a = __builtin_elementwise_fma(a, c1v, nmc); b = __builtin_elementwise_fma(b, c1v, nmc);
        a.x = __builtin_amdgcn_exp2f(a.x); a.y = __builtin_amdgcn_exp2f(a.y); b.x = __builtin_amdgcn_exp2f(b.x); b.y = __builtin_amdgcn_exp2f(b.y);
        p0[2 * i] = a.x; p0[2 * i + 1] = a.y; p1[2 * i] = b.x; p1[2 * i + 1] = b.y; lsa += a; lsb += b; }
    const float ls = (lsa.x + lsa.y) + (lsb.x + lsb.y);
    if (__builtin_amdgcn_ballot_w64(grow) != 0ull) {
        const float alpha = __builtin_amdgcn_exp2f((((m < -1e29f) ? 0.f : m) - muse) * C1);
        l = l * alpha;
#pragma unroll
        for (int i = 0; i < 16; ++i) { o0[i] *= alpha; o1[i] *= alpha; }
        m = mn;
    }
    l += ls;
}
__device__ __forceinline__ void softmax_heavy(f32x16& p0, f32x16& p1, const float m, float& l, float& mxraw, bool lane_on) {
    const float mx = fmaxf(fmaxf(fmaxf(p0[0], p1[5]), fmaxf(p0[10], p1[15])), fmaxf(fmaxf(p1[0], p0[5]), fmaxf(p1[10], p0[15])));
    mxraw = lane_on ? mx : NEG;
    const float muse = (m < -1e29f) ? 0.f : m;
    const float mc = lane_on ? muse * C1 : 3.0e38f;
#if SP_SCALAR
    float ls0 = 0.f, ls1 = 0.f;
#pragma unroll
    for (int i = 0; i < 16; ++i) { p0[i] = __builtin_amdgcn_exp2f(p0[i] * C1 - mc); p1[i] = __builtin_amdgcn_exp2f(p1[i] * C1 - mc); ls0 += p0[i]; ls1 += p1[i]; }
    l += ls0 + ls1;
#else
    f32x2 lsa = {0.f, 0.f}, lsb = {0.f, 0.f}; const f32x2 c1v = {C1, C1}, nmc = {-mc, -mc};
#pragma unroll
    for (int i = 0; i < 8; ++i) {
        f32x2 a = {p0[2 * i], p0[2 * i + 1]}, b = {p1[2 * i], p1[2 * i + 1]};
        a = __builtin_elementwise_fma(a, c1v, nmc); b = __builtin_elementwise_fma(b, c1v, nmc);
        a.x = __builtin_amdgcn_exp2f(a.x); a.y = __builtin_amdgcn_exp2f(a.y); b.x = __builtin_amdgcn_exp2f(b.x); b.y = __builtin_amdgcn_exp2f(b.y);
        p0[2 * i] = a.x; p0[2 * i + 1] = a.y; p1[2 * i] = b.x; p1[2 * i + 1] = b.y; lsa += a; lsb += b; }
    l += (lsa.x + lsa.y) + (lsb.x + lsb.y);
#endif
}
__device__ __forceinline__ void softmax_light(float mxraw, float& m, float& l, f32x16& o0, f32x16& o1) {
    constexpr float THR = 8.0f / C1;
    const float mx = fmaxf(mxraw, __shfl_xor(mxraw, 32));
    const float mn = (mx > m + THR) ? mx : m;
    if (__builtin_amdgcn_ballot_w64(mn != m) != 0ull) {
        const float alpha = __builtin_amdgcn_exp2f((((m < -1e29f) ? 0.f : m) - ((mn < -1e29f) ? 0.f : mn)) * C1);
        l = l * alpha;
#pragma unroll
        for (int i = 0; i < 16; ++i) { o0[i] *= alpha; o1[i] *= alpha; }
        m = mn;
    }
}
struct Stage { u32x4 k, v; };
__device__ __forceinline__ void stage_load(Stage& st, const bf16_t* ksrc, const bf16_t* vsrc, long stride, int tid) {
    const int key = tid >> 3, dc = tid & 7, vkey = tid & 63, vdc = tid >> 6;
    st.k = *(const u32x4*)(ksrc + (long)key * stride + dc * 8); st.v = *(const u32x4*)(vsrc + (long)vkey * stride + vdc * 8);
}
__device__ __forceinline__ void stage_store(const Stage& st, LAS unsigned char* Kt, LAS unsigned char* Vt, int tid) {
    const int key = tid >> 3, dc = tid & 7, vkey = tid & 63, vdc = tid >> 6;
    *(LAS u32x4*)(Kt + key * KP + dc * 16) = st.k;
    const unsigned w[4] = {st.v.x, st.v.y, st.v.z, st.v.w};
#pragma unroll
    for (int e = 0; e < 4; ++e) { *(LAS unsigned short*)(Vt + (vdc * 8 + 2 * e) * VP + vcol(vkey) * 2) = (unsigned short)(w[e] & 0xffffu); *(LAS unsigned short*)(Vt + (vdc * 8 + 2 * e + 1) * VP + vcol(vkey) * 2) = (unsigned short)(w[e] >> 16); }
}
__device__ __forceinline__ void pp_load(u32x4 (&sg)[2], const bf16_t* src, long stride, int t256, int kind) {
    if (kind == 0) {
#pragma unroll
        for (int j = 0; j < 2; ++j) { const int c = t256 + 256 * j; sg[j] = *(const u32x4*)(src + (long)(c >> 3) * stride + (c & 7) * 8); }
    } else {
#pragma unroll
        for (int j = 0; j < 2; ++j) { const int c = t256 + 256 * j; sg[j] = *(const u32x4*)(src + (long)(c & 63) * stride + (c >> 6) * 8); }
    }
}
__device__ __forceinline__ void pp_store(const u32x4 (&sg)[2], LAS unsigned char* Kt, LAS unsigned char* Vt, int t256, int kind) {
    if (kind == 0) {
#pragma unroll
        for (int j = 0; j < 2; ++j) { const int c = t256 + 256 * j; *(LAS u32x4*)(Kt + (c >> 3) * KP + (c & 7) * 16) = sg[j]; }
    } else {
#pragma unroll
        for (int j = 0; j < 2; ++j) { const int c = t256 + 256 * j, vkey = c & 63, vdc = c >> 6; const unsigned w[4] = {sg[j].x, sg[j].y, sg[j].z, sg[j].w};
#pragma unroll
            for (int e = 0; e < 4; ++e) { *(LAS unsigned short*)(Vt + (vdc * 8 + 2 * e) * VP + vcol(vkey) * 2) = (unsigned short)(w[e] & 0xffffu); *(LAS unsigned short*)(Vt + (vdc * 8 + 2 * e + 1) * VP + vcol(vkey) * 2) = (unsigned short)(w[e] >> 16); } }
    }
}
template <int BR> __device__ __forceinline__ int pp_next(int kb, unsigned live) {
    if (BR == 1) return kb + 1;
    const unsigned rem = live & ~((2u << kb) - 1u);
    return rem ? __builtin_ctz(rem) : 32;
}
template <int BR>
__device__ __forceinline__ void pp_soft(f32x16& p0, f32x16& p1, int h, int kb, int qb, int qq, const LAS unsigned* selm, const float m, float& l, float& mxraw) {
    bool mine = true;
    if (BR == 0) mine = (selm[qq] >> kb) & 1u;
    if (kb == qb) {
#pragma unroll
        for (int e = 0; e < 16; ++e) { const int kk = crow(e, h); if (kk > qq) p0[e] = NEG; if (kk + 32 > qq) p1[e] = NEG; }
    } else if (BR == 1 && kb == qb - 8) {
#pragma unroll
        for (int e = 0; e < 16; ++e) { const int kk = crow(e, h); if (kk <= qq) p0[e] = NEG; if (kk + 32 <= qq) p1[e] = NEG; }
    }
    softmax_heavy(p0, p1, m, l, mxraw, mine);
}
template <int BR, bool PRE>
__device__ __forceinline__ void pp_stream(LAS unsigned char* lds, const bf16_t* Pb, int ld, int g, int qb, int qq, int qh, int t256, int r, int h, unsigned live, const LAS unsigned* selm,
                                          const bf16x8 (&qf)[4], u32x4 (&sg)[2], f32x16& o0, f32x16& o1, float& m, float& l) {
    const int kind = qh ^ 1;
    const int soff = (BR == 0 ? (kind == 0 ? 1536 : 1792) : (kind == 0 ? 2048 : 2304)) + g * 64;
    const int first = BR == 0 ? 0 : (qb > 8 ? qb - 8 : 0);
    const int n = BR == 0 ? __builtin_popcount(live) : (qb - first + 1);
    int kb_load = first;
    if (!PRE) pp_load(sg, Pb + (size_t)(kb_load * 64) * ld + soff, ld, t256, kind);
    kb_load = pp_next<BR>(kb_load, live);
    pp_store(sg, lds + L_K, lds + L_V, t256, kind);
    { const int kc = kb_load < qb ? kb_load : qb; pp_load(sg, Pb + (size_t)(kc * 64) * ld + soff, ld, t256, kind); kb_load = pp_next<BR>(kb_load, live); }
    __syncthreads();
    int kb = first;
    f32x16 p0, p1; float mxraw = NEG; bf16x8 pb[4];
    if (qh == 0) {
        qk(p0, p1, lds + L_K, qf, r, h);
#pragma unroll 1
        for (int i = 0; i < n; ++i) {
            pp_soft<BR>(p0, p1, h, kb, qb, qq, selm, m, l, mxraw);
            pack_p(pb, p0, p1);
            kb = pp_next<BR>(kb, live);
            PP_SYNC();
            if (i + 1 < n) pp_store(sg, lds + L_K + ((i + 1) & 1) * TILEB, lds + L_V + ((i + 1) & 1) * TILEB, t256, kind);
            { const int kc = kb_load < qb ? kb_load : qb; pp_load(sg, Pb + (size_t)(kc * 64) * ld + soff, ld, t256, kind); kb_load = pp_next<BR>(kb_load, live); }
            if (i + 1 < n) qk(p0, p1, lds + L_K + ((i + 1) & 1) * TILEB, qf, r, h);
            pv2(o0, o1, lds + L_V + (i & 1) * TILEB, pb, r, h);
            softmax_light(mxraw, m, l, o0, o1);
            PP_SYNC();
        }
    } else {
#pragma unroll 1
        for (int i = 0; i < n; ++i) {
            qk(p0, p1, lds + L_K + (i & 1) * TILEB, qf, r, h);
            if (i > 0) { pv2(o0, o1, lds + L_V + ((i - 1) & 1) * TILEB, pb, r, h); softmax_light(mxraw, m, l, o0, o1); }
            if (i + 1 < n) pp_store(sg, lds + L_K + ((i + 1) & 1) * TILEB, lds + L_V + ((i + 1) & 1) * TILEB, t256, kind);
            { const int kc = kb_load < qb ? kb_load : qb; pp_load(sg, Pb + (size_t)(kc * 64) * ld + soff, ld, t256, kind); kb_load = pp_next<BR>(kb_load, live); }
            PP_SYNC();
            pp_soft<BR>(p0, p1, h, kb, qb, qq, selm, m, l, mxraw);
            pack_p(pb, p0, p1);
            kb = pp_next<BR>(kb, live);
            PP_SYNC();
        }
        pv2(o0, o1, lds + L_V + ((n - 1) & 1) * TILEB, pb, r, h);
    }
}
__device__ __forceinline__ void st_store_k(const u32x4& k, LAS unsigned char* Kt, int tid) { const int key = tid >> 3, dc = tid & 7; *(LAS u32x4*)(Kt + key * KP + dc * 16) = k; }
__device__ __forceinline__ void st_store_v(const u32x4& v, LAS unsigned char* Vt, int tid) {
    const int vkey = tid & 63, vdc = tid >> 6; const unsigned w[4] = {v.x, v.y, v.z, v.w};
#pragma unroll
    for (int e = 0; e < 4; ++e) { *(LAS unsigned short*)(Vt + (vdc * 8 + 2 * e) * VP + vcol(vkey) * 2) = (unsigned short)(w[e] & 0xffffu); *(LAS unsigned short*)(Vt + (vdc * 8 + 2 * e + 1) * VP + vcol(vkey) * 2) = (unsigned short)(w[e] >> 16); }
}
__device__ __forceinline__ u32x4 st_load_k(const bf16_t* ksrc, long stride, int tid) { return *(const u32x4*)(ksrc + (long)(tid >> 3) * stride + (tid & 7) * 8); }
__device__ __forceinline__ u32x4 st_load_v(const bf16_t* vsrc, long stride, int tid) { return *(const u32x4*)(vsrc + (long)(tid & 63) * stride + (tid >> 6) * 8); }
template <int BR>
__device__ __forceinline__ void sp_mask(f32x16& p0, f32x16& p1, int h, int kb, int qb, int qq) {
    if (kb == qb) {
#pragma unroll
        for (int e = 0; e < 16; ++e) { const int kk = crow(e, h); if (kk > qq) p0[e] = NEG; if (kk + 32 > qq) p1[e] = NEG; }
    } else if (BR == 1 && kb == qb - 8) {
#pragma unroll
        for (int e = 0; e < 16; ++e) { const int kk = crow(e, h); if (kk <= qq) p0[e] = NEG; if (kk + 32 <= qq) p1[e] = NEG; }
    }
}
template <int BR, bool PRE>
__device__ __forceinline__ void sp_stream(LAS unsigned char* lds, const bf16_t* Pb, int ld, int g, int qb, int qq, int tid, int r, int h, unsigned live, const LAS unsigned* selm,
                                          const bf16x8 (&qf)[4], Stage& st, f32x16& o0, f32x16& o1, float& m, float& l) {
    const int koff = (BR == 0 ? 1536 : 2048) + g * 64, voff = (BR == 0 ? 1792 : 2304) + g * 64;
    const int first = BR == 0 ? 0 : (qb > 8 ? qb - 8 : 0);
    const int n = BR == 0 ? __builtin_popcount(live) : (qb - first + 1);
    int kbK = first, kbV = first;
    if (!PRE) stage_load(st, Pb + (size_t)(first * 64) * ld + koff, Pb + (size_t)(first * 64) * ld + voff, ld, tid);
    kbK = pp_next<BR>(kbK, live); kbV = kbK;
    Stage s1; { const int kc = kbK < qb ? kbK : qb; stage_load(s1, Pb + (size_t)(kc * 64) * ld + koff, Pb + (size_t)(kc * 64) * ld + voff, ld, tid); }
    kbK = pp_next<BR>(kbK, live); kbV = kbK;
    stage_store(st, lds + L_K, lds + L_V, tid);
    st_store_k(s1.k, lds + L_K + TILEB, tid); st.v = s1.v;
    { const int kc = kbK < qb ? kbK : qb; st.k = st_load_k(Pb + (size_t)(kc * 64) * ld + koff, ld, tid); kbK = pp_next<BR>(kbK, live); }
    __syncthreads();
    f32x16 p0, p1; float mxraw = NEG; bf16x8 pb[4];
    qk(p0, p1, lds + L_K, qf, r, h);
    int kb = first, rk1 = 1, rk2 = 2;
#pragma unroll 1
    for (int i = 0; i < n; ++i) {
        if (i + 2 < n) st_store_k(st.k, lds + (rk2 == 2 ? L_PQ : L_K + rk2 * TILEB), tid);
        if (i + 1 < n) st_store_v(st.v, lds + L_V + ((i + 1) & 1) * TILEB, tid);
        { const int kc = kbK < qb ? kbK : qb, vc = kbV < qb ? kbV : qb;
          st.k = st_load_k(Pb + (size_t)(kc * 64) * ld + koff, ld, tid); st.v = st_load_v(Pb + (size_t)(vc * 64) * ld + voff, ld, tid); kbK = pp_next<BR>(kbK, live); kbV = pp_next<BR>(kbV, live); }
        bool mine = true;
        if (BR == 0) mine = (selm[qq] >> kb) & 1u;
        sp_mask<BR>(p0, p1, h, kb, qb, qq);
        f32x16 n0, n1;
        {
            const LAS unsigned char* Kt = lds + (rk1 == 2 ? L_PQ : L_K + rk1 * TILEB);
            const f32x16 z = {0.f, 0.f, 0.f, 0.f, 0.f, 0.f, 0.f, 0.f, 0.f, 0.f, 0.f, 0.f, 0.f, 0.f, 0.f, 0.f};
            bf16x8 a0[4], a1[4];
#pragma unroll
            for (int s = 0; s < 4; ++s) { a0[s] = *(const LAS bf16x8*)(Kt + r * KP + (16 * s + 8 * h) * 2); a1[s] = *(const LAS bf16x8*)(Kt + (32 + r) * KP + (16 * s + 8 * h) * 2); }
            __builtin_amdgcn_sched_barrier(0);
#pragma unroll
            for (int s = 0; s < 4; ++s) {
                n0 = __builtin_amdgcn_mfma_f32_32x32x16_bf16(a0[s], qf[s], s == 0 ? z : n0, 0, 0, 0);
                n1 = __builtin_amdgcn_mfma_f32_32x32x16_bf16(a1[s], qf[s], s == 0 ? z : n1, 0, 0, 0);
            }
            softmax_heavy(p0, p1, m, l, mxraw, mine);
            pack_p(pb, p0, p1);
#pragma unroll
            for (int j = 0; j < 8; ++j) { __builtin_amdgcn_sched_group_barrier(0x008, 1, 0); __builtin_amdgcn_sched_group_barrier(0x002, SP_FILL, 0); }
            __builtin_amdgcn_sched_barrier(0);
        }
        pv2(o0, o1, lds + L_V + (i & 1) * TILEB, pb, r, h);
        softmax_light(mxraw, m, l, o0, o1);
        p0 = n0; p1 = n1; kb = pp_next<BR>(kb, live); rk1 = rk2; rk2 = rk2 == 2 ? 0 : rk2 + 1;
        __syncthreads();
    }
}
}

__device__ __forceinline__ void phase_nsa_attn_mfma(Frame& F, int slot) {
    using namespace na;
    const bf16_t* P = WSP(bf16_t, OFF_PROJ); bf16_t* ATT = WSP(bf16_t, OFF_ATT);
    const bf16_t* KCb = WSP(bf16_t, OFF_KC); const bf16_t* VCb = KCb + (size_t)128 * 128 * 64;
    const float* gb = inptr(F, I_NSA_GATE_B) + slot * 48;
    int tid = F.tid; asm volatile("; phase-local tid" : "+v"(tid));
    const int wave = __builtin_amdgcn_readfirstlane(tid >> 6), lane = tid & 63, r = lane & 31, h = lane >> 5, hh = wave & 3, qh = wave >> 2;
    const int t256 = tid & 255;
    LAS unsigned char* lds = F.lds;
    LAS float* Pq = (LAS float*)(lds + L_PQ); LAS unsigned* selm = (LAS unsigned*)(lds + L_SEL);
    const int ld = NSA_LD;
    const int qq = qh * 32 + r;
#pragma unroll 1
    for (int it = F.bx; it < 4096; it += F.G) {
        const int sl = it & 255, rnd = it >> 8, bg = sl >> 1, par = sl & 1, qb = (rnd & 1) ? (31 - 2 * (rnd >> 1) - par) : (2 * (rnd >> 1) + par);
        const int b = bg >> 2, g = bg & 3, t = qb * 64 + qq;
        const bf16_t* Pb = P + (size_t)b * T * ld;
        const bf16_t* prow = Pb + (size_t)t * ld;
        bf16x8 qf[4];
#pragma unroll
        for (int s = 0; s < 4; ++s) qf[s] = *(const bf16x8*)(prow + g * 256 + hh * 64 + 16 * s + 8 * h);
        float gt[3];
#pragma unroll
        for (int j = 0; j < 3; ++j) gt[j] = sigmoidf_(bf2f(prow[2560 + g * 12 + hh * 3 + j]) + gb[g * 12 + hh * 3 + j]);
        LAS float* gsave = (LAS float*)(lds + L_SEL + 512) + tid * 2; gsave[0] = gt[1]; gsave[1] = gt[2];
        if (tid == 0) selm[64] = 0u;
        Stage st0, st1;
        stage_load(st0, KCb + (size_t)bg * 128 * 64, VCb + (size_t)bg * 128 * 64, 64, tid);
        stage_load(st1, KCb + (size_t)bg * 128 * 64 + 64 * 64, VCb + (size_t)bg * 128 * 64 + 64 * 64, 64, tid);
        stage_store(st0, lds + L_K, lds + L_V, tid);
        stage_store(st1, lds + L_K + TILEB, lds + L_V + TILEB, tid);
        __syncthreads();
        LAS float* oaL = (LAS float*)(lds + L_OA) + tid;
#pragma unroll 1
        for (int xr_ = 0; xr_ <= XCMP; ++xr_)
        {
            const int cmax = (t >= 31) ? (((t - 31) >> 4) < 126 ? ((t - 31) >> 4) : 126) : -1;
            f32x16 o0, o1; float m = NEG, l = 0.f;
#pragma unroll
            for (int i = 0; i < 16; ++i) { o0[i] = 0.f; o1[i] = 0.f; }
#pragma unroll 1
            for (int tl = 0; tl < 2; ++tl) {
                f32x16 p0, p1;
                qk(p0, p1, lds + L_K + tl * TILEB, qf, r, h);
#pragma unroll
                for (int i = 0; i < 16; ++i) { const int c = 64 * tl + crow(i, h); if (c > cmax) p0[i] = NEG; if (c + 32 > cmax) p1[i] = NEG; }
                softmax_step(p0, p1, m, l, o0, o1);
                pv(o0, o1, lds + L_V + tl * TILEB, p0, p1, r, h);
            }
            l += __shfl_xor(l, 32);
            const float inv = l > 0.f ? 1.0f / l : 0.f;
            const float cf = gt[0] * inv;
#pragma unroll
            for (int i = 0; i < 16; ++i) { oaL[512 * i] = cf * o0[i]; oaL[512 * (16 + i)] = cf * o1[i]; }
            const float mc = ((m < -1e29f) ? 0.f : m) * C1;
            LAS float* slab = Pq + hh * SLB + qq * 33;
#pragma unroll 1
            for (int tl = 1; tl >= 0; --tl) {
                f32x16 p0, p1;
                qk(p0, p1, lds + L_K + tl * TILEB, qf, r, h);
#pragma unroll
                for (int i = 0; i < 16; ++i) { const int c = 64 * tl + crow(i, h);
                    p0[i] = (c > cmax) ? 0.f : __builtin_amdgcn_exp2f(p0[i] * C1 - mc) * inv; p1[i] = (c + 32 > cmax) ? 0.f : __builtin_amdgcn_exp2f(p1[i] * C1 - mc) * inv; }
#pragma unroll
                for (int k = 0; k < 4; ++k) {
                    slab[16 * tl + 2 * k + h] = 2.0f * (p0[4 * k] + p0[4 * k + 1] + p0[4 * k + 2]) + p0[4 * k + 3];
                    slab[16 * tl + 8 + 2 * k + h] = 2.0f * (p1[4 * k] + p1[4 * k + 1] + p1[4 * k + 2]) + p1[4 * k + 3]; }
                LDS_WAIT();
#pragma unroll
                for (int k = 0; k < 4; ++k) { const int s0 = 16 * tl + 2 * k + h + 1, s1 = 16 * tl + 8 + 2 * k + h + 1;
                    slab[s0] += p0[4 * k + 3]; if (s1 < 32) slab[s1] += p1[4 * k + 3]; }
                LDS_WAIT();
            }
        }
        __syncthreads();
        Stage st;
        stage_load(st, Pb + 1536 + g * 64, Pb + 1792 + g * 64, ld, tid);
#pragma unroll 1
        for (int xr_ = 0; xr_ <= XSELN; ++xr_)
        {
            const int cur = qb, q = tid >> 3, sub = tid & 7;
            float scv[4];
#pragma unroll
            for (int j = 0; j < 4; ++j) { const int s_ = 4 * sub + j; const LAS float* pr = Pq + q * 33 + s_;
                const float imp = (pr[0] + pr[SLB]) + (pr[2 * SLB] + pr[3 * SLB]);
                const bool forced = (s_ == 0) || (s_ == cur) || (s_ == cur - 1);
                scv[j] = forced ? 1e30f : (s_ <= cur ? imp : NEG); }
            unsigned mask = 0u;
#pragma unroll 1
            for (int rd = 0; rd < 8; ++rd) {
                float bv = scv[0]; int bi = 4 * sub;
#pragma unroll
                for (int j = 1; j < 4; ++j) if (scv[j] > bv) { bv = scv[j]; bi = 4 * sub + j; }
#define SEL_STEP(CTRL) { const float ov = dppf<CTRL>(bv); const int oi = __float_as_int(dppf<CTRL>(__int_as_float(bi))); if (ov > bv || (ov == bv && oi < bi)) { bv = ov; bi = oi; } }
                SEL_STEP(0xB1) SEL_STEP(0x4E) SEL_STEP(0x141)
#undef SEL_STEP
                if (bv > -0.5e30f) mask |= 1u << bi;
#pragma unroll
                for (int j = 0; j < 4; ++j) if (bi == 4 * sub + j) scv[j] = -INFINITY;
            }
            if (sub == 0) selm[q] = mask;
            unsigned any = mask;
#pragma unroll
            for (int o = 8; o < 64; o <<= 1) any |= __shfl_xor(any, o);
            if (lane == 0) __hip_atomic_fetch_or(selm + 64, any, __ATOMIC_RELAXED, __HIP_MEMORY_SCOPE_WORKGROUP);
            __syncthreads();
        }
        const unsigned anymask = __builtin_amdgcn_readfirstlane(selm[64]);
        {
            f32x16 o0, o1; float m = NEG, l = 0.f;
#pragma unroll
            for (int i = 0; i < 16; ++i) { o0[i] = 0.f; o1[i] = 0.f; }
            const unsigned live = anymask & (qb == 31 ? 0xffffffffu : ((2u << qb) - 1u));
            sp_stream<0, true>(lds, Pb, ld, g, qb, qq, tid, r, h, live, selm, qf, st, o0, o1, m, l);
            l += __shfl_xor(l, 32);
            const float cf = l > 0.f ? gsave[0] / l : 0.f;
#pragma unroll
            for (int i = 0; i < 16; ++i) { oaL[512 * i] += cf * o0[i]; oaL[512 * (16 + i)] += cf * o1[i]; }
        }
        __syncthreads();
        {
            f32x16 o0, o1; float m = NEG, l = 0.f;
#pragma unroll
            for (int i = 0; i < 16; ++i) { o0[i] = 0.f; o1[i] = 0.f; }
            sp_stream<1, false>(lds, Pb, ld, g, qb, qq, tid, r, h, 0u, selm, qf, st, o0, o1, m, l);
            l += __shfl_xor(l, 32);
            const float cf = l > 0.f ? gsave[1] / l : 0.f;
#pragma unroll
            for (int i = 0; i < 16; ++i) { o0[i] = oaL[512 * i] + cf * o0[i]; o1[i] = oaL[512 * (16 + i)] + cf * o1[i]; }
            bf16_t* orow = ATT + (size_t)(b * T + t) * D + (g * 4 + hh) * 64 + 4 * h;
#pragma unroll 1
            for (int xr_ = 0; xr_ <= XOUT; ++xr_)
#pragma unroll
            for (int k = 0; k < 4; ++k) {
                u32x2 w0, w1; w0.x = pg8::cvt_pk_bf16(o0[4 * k], o0[4 * k + 1]); w0.y = pg8::cvt_pk_bf16(o0[4 * k + 2], o0[4 * k + 3]);
                w1.x = pg8::cvt_pk_bf16(o1[4 * k], o1[4 * k + 1]); w1.y = pg8::cvt_pk_bf16(o1[4 * k + 2], o1[4 * k + 3]);
                *(u32x2*)(orow + 8 * k) = w0; *(u32x2*)(orow + 32 + 8 * k) = w1;
            }
        }
        __syncthreads();
    }
}
__device__ __forceinline__ float logsigmoidf_(float x) { return fminf(x, 0.f) - log1pf(__expf(-fabsf(x))); }
__device__ __forceinline__ void phase_mlstm_scan(Frame& F) {
    constexpr int QP = 132;
    LAS float* qL = (LAS float*)F.lds;
    LAS float* kL = qL + 64 * QP;
    LAS float* vL = kL + 64 * QP;
    LAS float* SL = vL + 64 * 128;
    LAS float* vec = SL + 64 * 68;
    LAS float* bL = vec;
    LAS float* liL = vec + 64;
    LAS float* mtL = vec + 128;
    LAS float* wiL = vec + 192;
    LAS float* dnL = vec + 256;
    LAS float* wkL = vec + 320;
    LAS float* nL = vec + 384;
    LAS float* scl = vec + 512;
    LAS float* rsL = vec + 576;
    LAS float* qnL = vec + 640;
    const bf16_t* P = WSP(bf16_t, OFF_PROJ); bf16_t* HO = WSP(bf16_t, OFF_HM);
    int tid = F.tid; asm volatile("; phase-local tid" : "+v"(tid));
    const int lane = tid & 63, ld = ML_LD;
    int v_ = tid >> 2, kq = tid & 3;
    for (int item = F.bx; item < BATCH * 4 * 2; item += F.G) {
        const int vh = item & 1, h = (item >> 1) & 3, b = item >> 3;
        float C[32];
#pragma unroll
        for (int j = 0; j < 32; ++j) C[j] = 0.f;
        if (tid < 128) nL[tid] = 0.f;
        if (tid == 0) scl[0] = 0.f;
        __syncthreads();
#pragma unroll 1
        for (int ch = 0; ch < T / 64; ++ch) {
            asm volatile("; chunk-local" : "+v"(v_), "+v"(kq), "+v"(tid));
            const int t0 = ch * 64; const bf16_t* Pc = P + (size_t)(b * T + t0) * ld;
            {
                const int c2 = tid & 255, part = tid >> 8;
                const int col = (c2 < 128) ? (h * 128 + c2) : (512 + h * 128 + (c2 - 128));
                const float w0 = inptr(F, I_ML_CONV_W)[0 * 1024 + col], w1 = inptr(F, I_ML_CONV_W)[1 * 1024 + col], w2 = inptr(F, I_ML_CONV_W)[2 * 1024 + col], w3 = inptr(F, I_ML_CONV_W)[3 * 1024 + col], cb = inptr(F, I_ML_CONV_B)[col];
                const float scale = (c2 < 128) ? 1.0f : 0.08838834764831845f;
                const int r0 = part * 32;
                float x0 = (t0 + r0 - 3 >= 0) ? bf2f(Pc[(long)(r0 - 3) * ld + col]) : 0.f;
                float x1 = (t0 + r0 - 2 >= 0) ? bf2f(Pc[(long)(r0 - 2) * ld + col]) : 0.f;
                float x2 = (t0 + r0 - 1 >= 0) ? bf2f(Pc[(long)(r0 - 1) * ld + col]) : 0.f;
                LAS float* dst = (c2 < 128) ? (qL + c2) : (kL + (c2 - 128));
                for (int r = r0; r < r0 + 32; ++r) { const float x3 = bf2f(Pc[(long)r * ld + col]);
                    const float y = w0 * x0 + w1 * x1 + w2 * x2 + w3 * x3 + cb; dst[r * QP] = y * sigmoidf_(y) * scale; x0 = x1; x1 = x2; x2 = x3; }
                const int vc = tid & 127, vp = tid >> 7;
                for (int r = vp * 16; r < vp * 16 + 16; ++r) vL[r * 128 + vc] = bf2f(Pc[(long)r * ld + 1024 + h * 256 + vh * 128 + vc]);
                if (tid < 64) { liL[tid] = bf2f(Pc[(long)tid * ld + 3072 + h]) + inptr(F, I_ML_GATE_B)[h];
                    bL[tid] = logsigmoidf_(bf2f(Pc[(long)tid * ld + 3076 + h]) + inptr(F, I_ML_GATE_B)[4 + h]); }
            }
            __syncthreads();
            if (tid < 64) {
                float bb = bL[lane];
#pragma unroll
                for (int o = 1; o < 64; o <<= 1) { const float u = __shfl_up(bb, o); if (lane >= o) bb += u; }
                const float li = liL[lane]; float pm = li - bb;
#pragma unroll
                for (int o = 1; o < 64; o <<= 1) { const float u = __shfl_up(pm, o); if (lane >= o) pm = fmaxf(pm, u); }
                const float mprev = scl[0];
                const float mt = fmaxf(bb + mprev, bb + pm);
                const float bend = __shfl(bb, 63);
                const float decay = bend - bb + li;
                const float mnew = fmaxf(bend + mprev, wave_max(decay));
                bL[lane] = bb; mtL[lane] = mt; wiL[lane] = __expf(bb + mprev - mt); wkL[lane] = __expf(decay - mnew);
                if (lane == 0) { scl[1] = __expf(bend + mprev - mnew); scl[2] = mnew; }
            }
            __syncthreads();
            {
                const int t = tid >> 3, sg = tid & 7;
                float a[8];
#pragma unroll
                for (int j = 0; j < 8; ++j) a[j] = 0.f;
#pragma unroll 1
                for (int k4 = 0; k4 < 32; ++k4) { const f32x4 qv = *(const LAS f32x4*)(qL + t * QP + k4 * 4);
#pragma unroll
                    for (int j = 0; j < 8; ++j) { const f32x4 kv = *(const LAS f32x4*)(kL + (sg + 8 * j) * QP + k4 * 4); a[j] += (qv[0] * kv[0] + qv[1] * kv[1]) + (qv[2] * kv[2] + qv[3] * kv[3]); } }
                const float bt = bL[t], mt = mtL[t];
#pragma unroll
                for (int j = 0; j < 8; ++j) { const int s = sg + 8 * j; SL[t * 68 + s] = (s <= t) ? a[j] * __expf(bt - bL[s] + liL[s] - mt) : 0.f; }
            }
            __syncthreads();
            if (tid < 64) { float rs = 0.f; for (int s = 0; s < 64; ++s) rs += SL[tid * 68 + s]; rsL[tid] = rs; }
            else if (tid < 128) { const int t = tid - 64; float qn = 0.f; for (int k = 0; k < 128; ++k) qn += qL[t * QP + k] * nL[k]; qnL[t] = qn; }
            __syncthreads();
            if (tid < 64) { const float den = rsL[tid] + wiL[tid] * qnL[tid]; dnL[tid] = 1.0f / fmaxf(fabsf(den), __expf(-mtL[tid])); }
            __syncthreads();
            {
                float vr[16];
#pragma unroll
                for (int j = 0; j < 16; ++j) vr[j] = vL[(kq * 16 + j) * 128 + v_];
#pragma unroll 1
                for (int tg = 0; tg < 4; ++tg) {
                    float res[4];
#pragma unroll
                    for (int ti = 0; ti < 16; ++ti) { const int t = tg * 16 + ti;
                        float aC = 0.f, aS = 0.f;
#pragma unroll
                        for (int j4 = 0; j4 < 8; ++j4) { const f32x4 qv = *(const LAS f32x4*)(qL + t * QP + kq * 32 + j4 * 4);
                            aC += (qv[0] * C[j4 * 4] + qv[1] * C[j4 * 4 + 1]) + (qv[2] * C[j4 * 4 + 2] + qv[3] * C[j4 * 4 + 3]); }
#pragma unroll
                        for (int j4 = 0; j4 < 4; ++j4) { const f32x4 sv = *(const LAS f32x4*)(SL + t * 68 + kq * 16 + j4 * 4);
                            aS += (sv[0] * vr[j4 * 4] + sv[1] * vr[j4 * 4 + 1]) + (sv[2] * vr[j4 * 4 + 2] + sv[3] * vr[j4 * 4 + 3]); }
                        float tot = aS + wiL[t] * aC;
                        tot += __shfl_xor(tot, 1); tot += __shfl_xor(tot, 2);
                        tot *= dnL[t];
                        if ((ti & 3) == kq) res[ti >> 2] = tot;
                        asm volatile("" ::: "memory");
                    }
#pragma unroll
                    for (int q = 0; q < 4; ++q) { const int t = tg * 16 + q * 4 + kq; HO[(size_t)(b * T + t0 + t) * D + h * 256 + vh * 128 + v_] = (bf16_t)f2bf(res[q]); }
                }
            }
            __syncthreads();
            {
                const float cs = scl[1];
#pragma unroll
                for (int j = 0; j < 32; ++j) C[j] *= cs;
#pragma unroll 2
                for (int s = 0; s < 64; ++s) { const float a = vL[s * 128 + v_] * wkL[s];
#pragma unroll
                    for (int j4 = 0; j4 < 8; ++j4) { const f32x4 kv = *(const LAS f32x4*)(kL + s * QP + kq * 32 + j4 * 4);
                        C[j4 * 4] += a * kv[0]; C[j4 * 4 + 1] += a * kv[1]; C[j4 * 4 + 2] += a * kv[2]; C[j4 * 4 + 3] += a * kv[3]; } }
                if (tid < 128) { float nn = nL[tid] * cs; for (int s = 0; s < 64; ++s) nn += wkL[s] * kL[s * QP + tid]; nL[tid] = nn; }
                if (tid == 0) scl[0] = scl[2];
            }
            __syncthreads();
        }
    }
}
template <int HD>
__device__ __forceinline__ void phase_norm_gate(Frame& F, const float* norm_g, int ld, int gate_col0) {
    const bf16_t* HI = WSP(bf16_t, OFF_HM); const bf16_t* P = WSP(bf16_t, OFF_PROJ); bf16_t* ATT = WSP(bf16_t, OFF_ATT);
    int lane = F.lane; asm volatile("; phase-local lane" : "+v"(lane)); const int gw = F.bx * 8 + F.wave, NGW = F.G * 8;
    u32x2 hq[4], gq[4];
    f32x4 ngr[4];
#pragma unroll
    for (int j = 0; j < 4; ++j) ngr[j] = *((const f32x4*)norm_g + lane + 64 * j);
    if (gw < NTOK) { const u32x2* hr = (const u32x2*)(HI + (size_t)gw * D) + lane; const u32x2* gr = (const u32x2*)(P + (size_t)gw * ld + gate_col0) + lane;
#pragma unroll
        for (int j = 0; j < 4; ++j) { hq[j] = hr[64 * j]; gq[j] = gr[64 * j]; } }
#pragma unroll 1
    for (int m = gw; m < NTOK; m += NGW) {
        u32x2 hc[4], gc[4];
#pragma unroll
        for (int j = 0; j < 4; ++j) { hc[j] = hq[j]; gc[j] = gq[j]; }
        if (m + NGW < NTOK) { const u32x2* hr = (const u32x2*)(HI + (size_t)(m + NGW) * D) + lane; const u32x2* gr = (const u32x2*)(P + (size_t)(m + NGW) * ld + gate_col0) + lane;
#pragma unroll
            for (int j = 0; j < 4; ++j) { hq[j] = hr[64 * j]; gq[j] = gr[64 * j]; } }
        u32x2* orow = (u32x2*)(ATT + (size_t)m * D) + lane;
#pragma unroll
        for (int j = 0; j < 4; ++j) {
            const u32x2 hv = hc[j], gv = gc[j];
            float x[4] = {__uint_as_float(hv.x << 16), __uint_as_float(hv.x & 0xffff0000u), __uint_as_float(hv.y << 16), __uint_as_float(hv.y & 0xffff0000u)};
            const float gt[4] = {__uint_as_float(gv.x << 16), __uint_as_float(gv.x & 0xffff0000u), __uint_as_float(gv.y << 16), __uint_as_float(gv.y & 0xffff0000u)};
            float ss = (x[0] * x[0] + x[1] * x[1]) + (x[2] * x[2] + x[3] * x[3]);
#pragma unroll
            for (int o = 1; o < (HD == 256 ? 64 : 32); o <<= 1) ss += __shfl_xor(ss, o);
            const float r = __builtin_amdgcn_rsqf(ss * (1.0f / HD) + RMS_EPS);
            const f32x4 ng = ngr[j];
            float o4[4];
#pragma unroll
            for (int q = 0; q < 4; ++q) o4[q] = x[q] * r * ng[q] * sigmoidf_(gt[q]);
            u32x2 o; o.x = pk2(o4[0], o4[1]); o.y = pk2(o4[2], o4[3]); orow[64 * j] = o;
        }
    }
}

__device__ __forceinline__ void phase_hgrn_scan(Frame& F) {
    constexpr int QP = 132;
    LAS float* qL = (LAS float*)F.lds;
    LAS float* kL = qL + 32 * QP;
    LAS float* vL = kL + 32 * QP;
    LAS float* AL = vL + 32 * 128;
    LAS float* geL = AL + 32 * 36;
    const bf16_t* P = WSP(bf16_t, OFF_PROJ); bf16_t* HO = WSP(bf16_t, OFF_HM);
    const float* lbt = WSP(float, OFF_TAB) + TAB_LB;
    int tid = F.tid; asm volatile("; phase-local tid" : "+v"(tid));
    const int ld = HG_LD;
    int v_ = tid >> 2, kq = tid & 3;
    for (int item = F.bx; item < BATCH * 8; item += F.G) {
        const int h = item & 7, b = item >> 3;
        float S[32];
#pragma unroll
        for (int j = 0; j < 32; ++j) S[j] = 0.f;
#pragma unroll 1
        for (int ch = 0; ch < T / 32; ++ch) {
            asm volatile("; chunk-local" : "+v"(v_), "+v"(kq), "+v"(tid));
            const int t0 = ch * 32; const bf16_t* Pc = P + (size_t)(b * T + t0) * ld;
            { const int c = tid & 127, p4 = tid >> 7;
#pragma unroll 2
              for (int r = p4 * 8; r < p4 * 8 + 8; ++r) { qL[r * QP + c] = bf2f(Pc[(long)r * ld + h * 128 + c]); kL[r * QP + c] = bf2f(Pc[(long)r * ld + 1024 + h * 128 + c]); vL[r * 128 + c] = bf2f(Pc[(long)r * ld + 2048 + h * 128 + c]); } }
            __syncthreads();
            if (tid < 128) { const float lb = lbt[h * 128 + tid]; float G = 0.f;
#pragma unroll 2
                for (int r = 0; r < 32; ++r) { const float qr = qL[r * QP + tid], fr = kL[r * QP + tid];
                    const float f = lb + (1.0f - lb) * sigmoidf_(fr); G += __logf(f);
                    qL[r * QP + tid] = qr * sigmoidf_(qr) * __expf(G); kL[r * QP + tid] = (1.0f - f) * __expf(-G); }
                geL[tid] = __expf(G); }
            __syncthreads();
            { const int t = tid >> 4, sg = tid & 15;
              float a0 = 0.f, a1 = 0.f;
#pragma unroll 2
              for (int k4 = 0; k4 < 32; ++k4) { const f32x4 qv = *(const LAS f32x4*)(qL + t * QP + k4 * 4);
                  const f32x4 k0 = *(const LAS f32x4*)(kL + sg * QP + k4 * 4), k1 = *(const LAS f32x4*)(kL + (sg + 16) * QP + k4 * 4);
                  a0 += (qv[0] * k0[0] + qv[1] * k0[1]) + (qv[2] * k0[2] + qv[3] * k0[3]); a1 += (qv[0] * k1[0] + qv[1] * k1[1]) + (qv[2] * k1[2] + qv[3] * k1[3]); }
              AL[t * 36 + sg] = (sg <= t) ? a0 : 0.f; AL[t * 36 + sg + 16] = (sg + 16 <= t) ? a1 : 0.f; }
            __syncthreads();
            {
                float vr[8];
#pragma unroll
                for (int j = 0; j < 8; ++j) vr[j] = vL[(kq * 8 + j) * 128 + v_];
#pragma unroll 2
                for (int t = 0; t < 32; ++t) {
                    float a = 0.f;
#pragma unroll
                    for (int j4 = 0; j4 < 8; ++j4) { const f32x4 qv = *(const LAS f32x4*)(qL + t * QP + kq * 32 + j4 * 4);
                        a += (qv[0] * S[j4 * 4] + qv[1] * S[j4 * 4 + 1]) + (qv[2] * S[j4 * 4 + 2] + qv[3] * S[j4 * 4 + 3]); }
#pragma unroll
                    for (int j4 = 0; j4 < 2; ++j4) { const f32x4 sv = *(const LAS f32x4*)(AL + t * 36 + kq * 8 + j4 * 4);
                        a += (sv[0] * vr[j4 * 4] + sv[1] * vr[j4 * 4 + 1]) + (sv[2] * vr[j4 * 4 + 2] + sv[3] * vr[j4 * 4 + 3]); }
                    a += __shfl_xor(a, 1); a += __shfl_xor(a, 2);
                    if ((t & 3) == kq) HO[(size_t)(b * T + t0 + t) * D + h * 128 + v_] = (bf16_t)f2bf(a);
                    asm volatile("" ::: "memory");
                }
            }
            {
#pragma unroll 2
                for (int s = 0; s < 32; ++s) { const float a = vL[s * 128 + v_];
#pragma unroll
                    for (int j4 = 0; j4 < 8; ++j4) { const f32x4 kv = *(const LAS f32x4*)(kL + s * QP + kq * 32 + j4 * 4);
                        S[j4 * 4] += a * kv[0]; S[j4 * 4 + 1] += a * kv[1]; S[j4 * 4 + 2] += a * kv[2]; S[j4 * 4 + 3] += a * kv[3]; } }
#pragma unroll
                for (int j4 = 0; j4 < 8; ++j4) { const f32x4 ge = *(const LAS f32x4*)(geL + kq * 32 + j4 * 4);
                    S[j4 * 4] *= ge[0]; S[j4 * 4 + 1] *= ge[1]; S[j4 * 4 + 2] *= ge[2]; S[j4 * 4 + 3] *= ge[3]; }
            }
            __syncthreads();
        }
    }
}
namespace ml {
constexpr int PK = 272, PS = 144;
constexpr int L_Q = 0, L_KK = L_Q + 64 * PK, L_KWT = L_KK + 64 * PK, L_VT = L_KWT + 128 * PS, L_S = L_VT + 144 * PS, L_C = L_S + 64 * PS, L_VEC = L_C + 144 * PK;
typedef float f32x4_ __attribute__((ext_vector_type(4)));
__device__ __forceinline__ bf16x8 frag(const LAS unsigned char* base, int row, int pitch, int kelem) { return *(const LAS bf16x8*)(base + row * pitch + kelem * 2); }
}
__device__ __forceinline__ void phase_mlstm_scan_mfma(Frame& F) {
    using namespace ml;
    LAS unsigned char* lds = F.lds;
    LAS float* vec = (LAS float*)(lds + L_VEC);
    LAS float* bL = vec; LAS float* liL = vec + 64; LAS float* mtL = vec + 128; LAS float* wiL = vec + 192; LAS float* wkL = vec + 256; LAS float* scl = vec + 320;
    const bf16_t* P = WSP(bf16_t, OFF_PROJ); bf16_t* HO = WSP(bf16_t, OFF_HM);
    int tid = F.tid; asm volatile("; phase-local tid" : "+v"(tid));
    const int lane = tid & 63, wave = __builtin_amdgcn_readfirstlane(tid >> 6), ld = ML_LD;
    const int fr = lane & 15, fg = lane >> 4;
#pragma unroll 1
    for (int item = F.bx; item < BATCH * 4 * 2; item += F.G) {
        const int vh = item & 1, h = (item >> 1) & 3, b = item >> 3;
        f32x4 Cacc[9];
#pragma unroll
        for (int j = 0; j < 9; ++j) Cacc[j] = (f32x4){0.f, 0.f, 0.f, 0.f};
        for (int i = tid; i < 16 * 64; i += 512) { const int rr = i >> 6, s = i & 63; *(LAS unsigned short*)(lds + L_VT + (128 + rr) * PS + s * 2) = (rr == 0) ? (unsigned short)0x3F80 : (unsigned short)0; }
        for (int i = tid; i < 144 * PK / 4; i += 512) ((LAS unsigned*)(lds + L_C))[i] = 0u;
        if (tid == 0) scl[0] = 0.f;
        const int c2 = tid & 255, part = __builtin_amdgcn_readfirstlane(tid >> 8);
        const int col = (c2 < 128) ? (h * 128 + c2) : (512 + h * 128 + (c2 - 128));
        const float* cw = inptr(F, I_ML_CONV_W); const float* cbp = inptr(F, I_ML_CONV_B); const float* gbp = inptr(F, I_ML_GATE_B);
        const float w0 = cw[0 * 1024 + col], w1 = cw[1 * 1024 + col], w2 = cw[2 * 1024 + col], w3 = cw[3 * 1024 + col], cb = cbp[col];
        const float gbi = gbp[h], gbf = gbp[4 + h];
        const float qscale = (c2 < 128) ? 1.0f : 0.08838834764831845f;
        unsigned short xn[35]; u32x4 vn[2]; unsigned short gin = 0, gfn = 0;
        { const bf16_t* Pc = P + (size_t)(b * T) * ld; const int r0 = part * 32;
          const bf16_t* rp = Pc + (long)(r0 - 3) * ld;
#pragma unroll
          for (int i = 0; i < 35; ++i) { xn[i] = (r0 - 3 + i >= 0) ? rp[col] : (unsigned short)0; rp += ld; asm volatile("" : "+s"(rp)); }
          const int key = tid >> 3, dc = tid & 7;
#pragma unroll
          for (int q = 0; q < 2; ++q) vn[q] = *(const u32x4*)(Pc + (long)key * ld + 1024 + h * 256 + vh * 128 + (dc + 8 * q) * 8);
          if (wave == 0) { gin = Pc[(long)lane * ld + 3072 + h]; gfn = Pc[(long)lane * ld + 3076 + h]; } }
        __syncthreads();
#pragma unroll 1
        for (int ch = 0; ch < T / 64; ++ch) {
            const int t0 = ch * 64; const bf16_t* Pc = P + (size_t)(b * T + t0) * ld;
            if (wave == 0) {
                const float li = bf2f(gin) + gbi;
                float bb = logsigmoidf_(bf2f(gfn) + gbf);
#pragma unroll
                for (int o = 1; o < 64; o <<= 1) { const float u = __shfl_up(bb, o); if (lane >= o) bb += u; }
                float pm = li - bb;
#pragma unroll
                for (int o = 1; o < 64; o <<= 1) { const float u = __shfl_up(pm, o); if (lane >= o) pm = fmaxf(pm, u); }
                const float mprev = scl[0];
                const float mt = fmaxf(bb + mprev, bb + pm);
                const float bend = __shfl(bb, 63);
                const float decay = bend - bb + li;
                const float mnew = fmaxf(bend + mprev, wave_max(decay));
                bL[lane] = bb; liL[lane] = li; mtL[lane] = mt; wiL[lane] = __expf(bb + mprev - mt); wkL[lane] = __expf(decay - mnew);
                if (lane == 0) { scl[1] = __expf(bend + mprev - mnew); scl[2] = mnew; }
            }
            __syncthreads();
            {
                const int r0 = part * 32;
                LAS unsigned char* rowbase = lds + ((c2 < 128) ? L_Q : L_KK) + (c2 & 127) * 2;
#pragma unroll
                for (int i = 0; i < 32; ++i) { const int rr = r0 + i;
                    const float y = w0 * bf2f(xn[i]) + w1 * bf2f(xn[i + 1]) + w2 * bf2f(xn[i + 2]) + w3 * bf2f(xn[i + 3]) + cb; const float o = y * sigmoidf_(y) * qscale;
                    *(LAS unsigned short*)(rowbase + rr * PK) = (unsigned short)f2bf(o);
                    if (c2 >= 128) *(LAS unsigned short*)(lds + L_KWT + (c2 - 128) * PS + rr * 2) = (unsigned short)f2bf(o * wkL[rr]);
                    if ((i & 3) == 3) asm volatile("" ::: "memory"); }
                const int key = tid >> 3, dc = tid & 7;
#pragma unroll
                for (int q = 0; q < 2; ++q) { const unsigned w[4] = {vn[q].x, vn[q].y, vn[q].z, vn[q].w};
#pragma unroll
                    for (int e = 0; e < 4; ++e) { const int vrow = (dc + 8 * q) * 8 + 2 * e;
                        *(LAS unsigned short*)(lds + L_VT + vrow * PS + key * 2) = (unsigned short)(w[e] & 0xffffu); *(LAS unsigned short*)(lds + L_VT + (vrow + 1) * PS + key * 2) = (unsigned short)(w[e] >> 16); } }
            }
            if (ch + 1 < T / 64) {
                const bf16_t* Pn = Pc + (size_t)64 * ld; const int r0 = part * 32;
                const bf16_t* rp = Pn + (long)(r0 - 3) * ld;
#pragma unroll
                for (int i = 0; i < 35; ++i) { xn[i] = rp[col]; rp += ld; asm volatile("" : "+s"(rp)); }
                const int key = tid >> 3, dc = tid & 7;
#pragma unroll
                for (int q = 0; q < 2; ++q) vn[q] = *(const u32x4*)(Pn + (long)key * ld + 1024 + h * 256 + vh * 128 + (dc + 8 * q) * 8);
                if (wave == 0) { gin = Pn[(long)lane * ld + 3072 + h]; gfn = Pn[(long)lane * ld + 3076 + h]; }
            }
            __syncthreads();
#pragma unroll
            for (int q = 0; q < 2; ++q) {
                const int idx = 2 * wave + q, ti = idx >> 2, tj = idx & 3;
                f32x4 a = (f32x4){0.f, 0.f, 0.f, 0.f};
                if (ti <= tj) {
#pragma unroll
                    for (int ks = 0; ks < 4; ++ks) a = __builtin_amdgcn_mfma_f32_16x16x32_bf16(frag(lds + L_KK, 16 * ti + fr, PK, 32 * ks + 8 * fg), frag(lds + L_Q, 16 * tj + fr, PK, 32 * ks + 8 * fg), a, 0, 0, 0);
                    const int t = 16 * tj + fr; const float bt = bL[t], mt = mtL[t];
#pragma unroll
                    for (int e = 0; e < 4; ++e) { const int s = 16 * ti + 4 * fg + e; a[e] = (s <= t) ? a[e] * __expf(bt - bL[s] + liL[s] - mt) : 0.f; }
                }
                u32x2 w; w.x = pg8::cvt_pk_bf16(a[0], a[1]); w.y = pg8::cvt_pk_bf16(a[2], a[3]);
                *(LAS u32x2*)(lds + L_S + (16 * tj + fr) * PS + (16 * ti + 4 * fg) * 2) = w;
            }
            __syncthreads();
            {
#pragma unroll 1
                for (int tj = 0; tj < 4; ++tj) {
                    f32x4 a1 = (f32x4){0.f, 0.f, 0.f, 0.f}, a2 = a1, d1 = a1, d2 = a1;
#pragma unroll
                    for (int ks = 0; ks < 2; ++ks) { const bf16x8 bs = frag(lds + L_S, 16 * tj + fr, PS, 32 * ks + 8 * fg);
                        a1 = __builtin_amdgcn_mfma_f32_16x16x32_bf16(frag(lds + L_VT, 16 * wave + fr, PS, 32 * ks + 8 * fg), bs, a1, 0, 0, 0);
                        d1 = __builtin_amdgcn_mfma_f32_16x16x32_bf16(frag(lds + L_VT, 128 + fr, PS, 32 * ks + 8 * fg), bs, d1, 0, 0, 0); }
#pragma unroll
                    for (int ks = 0; ks < 4; ++ks) { const bf16x8 bq = frag(lds + L_Q, 16 * tj + fr, PK, 32 * ks + 8 * fg);
                        a2 = __builtin_amdgcn_mfma_f32_16x16x32_bf16(frag(lds + L_C, 16 * wave + fr, PK, 32 * ks + 8 * fg), bq, a2, 0, 0, 0);
                        d2 = __builtin_amdgcn_mfma_f32_16x16x32_bf16(frag(lds + L_C, 128 + fr, PK, 32 * ks + 8 * fg), bq, d2, 0, 0, 0); }
                    const int t = 16 * tj + fr; const float wi = wiL[t];
                    float den = d1[0] + wi * d2[0];
                    den = __shfl(den, fr);
                    const float inv = __builtin_amdgcn_rcpf(fmaxf(fabsf(den), __expf(-mtL[t])));
                    u32x2 w; w.x = pg8::cvt_pk_bf16((a1[0] + wi * a2[0]) * inv, (a1[1] + wi * a2[1]) * inv); w.y = pg8::cvt_pk_bf16((a1[2] + wi * a2[2]) * inv, (a1[3] + wi * a2[3]) * inv);
                    *(u32x2*)(HO + (size_t)(b * T + t0 + t) * D + h * 256 + vh * 128 + 16 * wave + 4 * fg) = w;
                }
            }
            __syncthreads();
            {
                const float cs = scl[1];
                const bf16x8 ka0 = frag(lds + L_KWT, 16 * wave + fr, PS, 8 * fg), ka1 = frag(lds + L_KWT, 16 * wave + fr, PS, 32 + 8 * fg);
#pragma unroll
                for (int j = 0; j < 9; ++j) {
                    Cacc[j] = Cacc[j] * cs;
                    Cacc[j] = __builtin_amdgcn_mfma_f32_16x16x32_bf16(ka0, frag(lds + L_VT, 16 * j + fr, PS, 8 * fg), Cacc[j], 0, 0, 0);
                    Cacc[j] = __builtin_amdgcn_mfma_f32_16x16x32_bf16(ka1, frag(lds + L_VT, 16 * j + fr, PS, 32 + 8 * fg), Cacc[j], 0, 0, 0);
                    u32x2 w; w.x = pg8::cvt_pk_bf16(Cacc[j][0], Cacc[j][1]); w.y = pg8::cvt_pk_bf16(Cacc[j][2], Cacc[j][3]);
                    *(LAS u32x2*)(lds + L_C + (16 * j + fr) * PK + (16 * wave + 4 * fg) * 2) = w;
                }
                if (tid == 0) scl[0] = scl[2];
            }
            __syncthreads();
        }
    }
}
namespace hg {
constexpr int PK = 272, PS = 144;
constexpr int L_QD = 0, L_KD = L_QD + 64 * PK, L_KDT = L_KD + 64 * PK, L_VT = L_KDT + 128 * PS, L_A = L_VT + 128 * PS, L_ST = L_A + 64 * PS, L_TOT = L_ST + 128 * PK, L_GE = L_TOT + 4 * 128 * 4, L_SSQ = L_GE + 128 * 4;
__device__ __forceinline__ bf16x8 frag(const LAS unsigned char* base, int row, int pitch, int kelem) { return *(const LAS bf16x8*)(base + row * pitch + kelem * 2); }
}
__device__ __forceinline__ void phase_hgrn_scan_mfma(Frame& F) {
    using namespace hg;
    LAS unsigned char* lds = F.lds;
    LAS float* totL = (LAS float*)(lds + L_TOT); LAS float* geL = (LAS float*)(lds + L_GE);
    const bf16_t* P = WSP(bf16_t, OFF_PROJ); bf16_t* ATT = WSP(bf16_t, OFF_ATT);
    const float* lbt = WSP(float, OFF_TAB) + TAB_LB; const float* norm_g = inptr(F, I_HG_NORM_G);
    LAS float* ssqL = (LAS float*)(F.lds + hg::L_SSQ);
    int tid = F.tid; asm volatile("; phase-local tid" : "+v"(tid));
    const int lane = tid & 63, wave = __builtin_amdgcn_readfirstlane(tid >> 6), ld = HG_LD;
    const int fr = lane & 15, fg = lane >> 4;
    const int kc = tid & 127, part = __builtin_amdgcn_readfirstlane(tid >> 7);
    const int vkey = tid >> 3, vdc = tid & 7;
#pragma unroll 1
    for (int item = F.bx; item < BATCH * 8; item += F.G) {
        const int h = item & 7, b = item >> 3;
        f32x4 Sacc[8];
#pragma unroll
        for (int j = 0; j < 8; ++j) Sacc[j] = (f32x4){0.f, 0.f, 0.f, 0.f};
        for (int i = tid; i < 128 * PK / 4; i += 512) ((LAS unsigned*)(lds + L_ST))[i] = 0u;
        const float lb = lbt[h * 128 + kc];
        const f32x4 ngv = *(const f32x4*)(norm_g + h * 128 + 16 * wave + 4 * fg);
        unsigned short qn[16], fn[16]; u32x4 vn[2];
        { const bf16_t* Pc = P + (size_t)(b * T) * ld;
          const bf16_t* rp = Pc + (long)(16 * part) * ld + h * 128;
#pragma unroll
          for (int i = 0; i < 16; ++i) { qn[i] = rp[kc]; fn[i] = rp[1024 + kc]; rp += ld; asm volatile("" : "+s"(rp)); }
#pragma unroll
          for (int q = 0; q < 2; ++q) vn[q] = *(const u32x4*)(Pc + (long)vkey * ld + 2048 + h * 128 + (vdc + 8 * q) * 8); }
        __syncthreads();
#pragma unroll 1
        for (int ch = 0; ch < T / 64; ++ch) {
            const int t0 = ch * 64;
            float qs[16], kk[16], G[16]; u32x4 vv[2];
            {
                float run = 0.f;
#pragma unroll
                for (int i = 0; i < 16; ++i) { const float qr = bf2f(qn[i]), fraw = bf2f(fn[i]);
                    const float f = lb + (1.0f - lb) * sigmoidf_(fraw);
                    run += __logf(f); G[i] = run; qs[i] = qr * sigmoidf_(qr); kk[i] = 1.0f - f; }
                totL[part * 128 + kc] = run; vv[0] = vn[0]; vv[1] = vn[1];
            }
            __syncthreads();
            if (ch + 1 < T / 64) {
                const bf16_t* Pn = P + (size_t)(b * T + t0 + 64) * ld;
                const bf16_t* rp = Pn + (long)(16 * part) * ld + h * 128;
#pragma unroll
                for (int i = 0; i < 16; ++i) { qn[i] = rp[kc]; fn[i] = rp[1024 + kc]; rp += ld; asm volatile("" : "+s"(rp)); }
#pragma unroll
                for (int q = 0; q < 2; ++q) vn[q] = *(const u32x4*)(Pn + (long)vkey * ld + 2048 + h * 128 + (vdc + 8 * q) * 8);
            }
            {
                float off = 0.f, tot = 0.f;
#pragma unroll
                for (int p = 0; p < 4; ++p) { const float tp = totL[p * 128 + kc]; if (p < part) off += tp; tot += tp; }
                if (part == 3) geL[kc] = __expf(tot);
#pragma unroll
                for (int i = 0; i < 16; ++i) { const int r = 16 * part + i; const float g = G[i] + off;
                    const unsigned short qd = (unsigned short)f2bf(qs[i] * __expf(g)), kd = (unsigned short)f2bf(kk[i] * __expf(-g));
                    *(LAS unsigned short*)(lds + L_QD + r * PK + kc * 2) = qd; *(LAS unsigned short*)(lds + L_KD + r * PK + kc * 2) = kd; *(LAS unsigned short*)(lds + L_KDT + kc * PS + r * 2) = kd; }
#pragma unroll
                for (int q = 0; q < 2; ++q) { const unsigned w[4] = {vv[q].x, vv[q].y, vv[q].z, vv[q].w};
#pragma unroll
                    for (int e = 0; e < 4; ++e) { const int vrow = (vdc + 8 * q) * 8 + 2 * e;
                        *(LAS unsigned short*)(lds + L_VT + vrow * PS + vkey * 2) = (unsigned short)(w[e] & 0xffffu); *(LAS unsigned short*)(lds + L_VT + (vrow + 1) * PS + vkey * 2) = (unsigned short)(w[e] >> 16); } }
            }
            __syncthreads();
#pragma unroll
            for (int q = 0; q < 2; ++q) {
                const int idx = 2 * wave + q, ti = idx >> 2, tj = idx & 3;
                f32x4 a = (f32x4){0.f, 0.f, 0.f, 0.f};
                if (ti <= tj) {
#pragma unroll
                    for (int ks = 0; ks < 4; ++ks) a = __builtin_amdgcn_mfma_f32_16x16x32_bf16(frag(lds + L_KD, 16 * ti + fr, PK, 32 * ks + 8 * fg), frag(lds + L_QD, 16 * tj + fr, PK, 32 * ks + 8 * fg), a, 0, 0, 0);
                    const int t = 16 * tj + fr;
#pragma unroll
                    for (int e = 0; e < 4; ++e) { const int s = 16 * ti + 4 * fg + e; a[e] = (s <= t) ? a[e] : 0.f; }
                }
                u32x2 w; w.x = pg8::cvt_pk_bf16(a[0], a[1]); w.y = pg8::cvt_pk_bf16(a[2], a[3]);
                *(LAS u32x2*)(lds + L_A + (16 * tj + fr) * PS + (16 * ti + 4 * fg) * 2) = w;
            }
            __syncthreads();
            f32x4 ot[4]; u32x2 gq[4];
            const bf16_t* Pg = P + (size_t)(b * T + t0) * ld + 3072 + h * 128 + 16 * wave + 4 * fg;
#pragma unroll
            for (int tj = 0; tj < 4; ++tj) {
                f32x4 a = (f32x4){0.f, 0.f, 0.f, 0.f};
                gq[tj] = *(const u32x2*)(Pg + (size_t)(16 * tj + fr) * ld);
#pragma unroll
                for (int ks = 0; ks < 2; ++ks) a = __builtin_amdgcn_mfma_f32_16x16x32_bf16(frag(lds + L_VT, 16 * wave + fr, PS, 32 * ks + 8 * fg), frag(lds + L_A, 16 * tj + fr, PS, 32 * ks + 8 * fg), a, 0, 0, 0);
#pragma unroll
                for (int ks = 0; ks < 4; ++ks) a = __builtin_amdgcn_mfma_f32_16x16x32_bf16(frag(lds + L_ST, 16 * wave + fr, PK, 32 * ks + 8 * fg), frag(lds + L_QD, 16 * tj + fr, PK, 32 * ks + 8 * fg), a, 0, 0, 0);
                ot[tj] = a;
                float ss = (a[0] * a[0] + a[1] * a[1]) + (a[2] * a[2] + a[3] * a[3]);
                ss += __shfl_xor(ss, 16); ss += __shfl_xor(ss, 32);
                if (fg == 0) ssqL[wave * 64 + 16 * tj + fr] = ss;
            }
            __syncthreads();
#pragma unroll
            for (int tj = 0; tj < 4; ++tj) {
                const int t = 16 * tj + fr; float tot = 0.f;
#pragma unroll
                for (int w8 = 0; w8 < 8; ++w8) tot += ssqL[w8 * 64 + t];
                const float rr = __builtin_amdgcn_rsqf(tot * (1.0f / 128.0f) + RMS_EPS);
                const float g0 = __uint_as_float(gq[tj].x << 16), g1 = __uint_as_float(gq[tj].x & 0xffff0000u), g2 = __uint_as_float(gq[tj].y << 16), g3 = __uint_as_float(gq[tj].y & 0xffff0000u);
                u32x2 w; w.x = pg8::cvt_pk_bf16(ot[tj][0] * rr * ngv[0] * sigmoidf_(g0), ot[tj][1] * rr * ngv[1] * sigmoidf_(g1));
                w.y = pg8::cvt_pk_bf16(ot[tj][2] * rr * ngv[2] * sigmoidf_(g2), ot[tj][3] * rr * ngv[3] * sigmoidf_(g3));
                *(u32x2*)(ATT + (size_t)(b * T + t0 + t) * D + h * 128 + 16 * wave + 4 * fg) = w;
            }
            {
                const bf16x8 ka0 = frag(lds + L_KDT, 16 * wave + fr, PS, 8 * fg), ka1 = frag(lds + L_KDT, 16 * wave + fr, PS, 32 + 8 * fg);
                const f32x4 ge = *(const LAS f32x4*)(geL + 16 * wave + 4 * fg);
#pragma unroll
                for (int j = 0; j < 8; ++j) {
                    Sacc[j] = __builtin_amdgcn_mfma_f32_16x16x32_bf16(ka0, frag(lds + L_VT, 16 * j + fr, PS, 8 * fg), Sacc[j], 0, 0, 0);
                    Sacc[j] = __builtin_amdgcn_mfma_f32_16x16x32_bf16(ka1, frag(lds + L_VT, 16 * j + fr, PS, 32 + 8 * fg), Sacc[j], 0, 0, 0);
                    Sacc[j] = Sacc[j] * ge;
                    u32x2 w; w.x = pg8::cvt_pk_bf16(Sacc[j][0], Sacc[j][1]); w.y = pg8::cvt_pk_bf16(Sacc[j][2], Sacc[j][3]);
                    *(LAS u32x2*)(lds + L_ST + (16 * j + fr) * PK + (16 * wave + 4 * fg) * 2) = w;
                }
            }
            __syncthreads();
        }
    }
}
constexpr int PH_PER_LAYER = 10, N_PHASES = 1 + PH_PER_LAYER * DEPTH;
struct Args { const float* in[27]; float* out; unsigned char* ws; int ph_lo, ph_hi; };
__global__ void __launch_bounds__(512, 2) mk_fwd(Args args) {
    extern __shared__ __attribute__((aligned(16))) unsigned char lds[];
    Frame F;
    F.lds = (LAS unsigned char*)lds;
    F.LC = (volatile LAS unsigned*)(F.lds + LDSCTL_OFF);
    F.tid = threadIdx.x; F.lane = F.tid & 63; F.wave = __builtin_amdgcn_readfirstlane(F.tid >> 6); F.G = gridDim.x; F.bx = blockIdx.x;
    F.ws = (unsigned char*)(GAS unsigned char*)args.ws; F.ctl = (unsigned*)(F.ws + OFF_CTL); F.out = (float*)(GAS float*)args.out;
    for (int u = F.tid; u < (LDS_BYTES - LDSCTL_OFF) / 4; u += 512) F.LC[u] = 0u;
    __syncthreads();
    if (F.tid < 27) { const unsigned long long pv = (unsigned long long)args.in[F.tid]; F.LC[128 + 2 * F.tid] = (unsigned)pv; F.LC[129 + 2 * F.tid] = (unsigned)(pv >> 32); }
    __syncthreads();
    XcdBarrier bar; bar.bar = F.ctl + CW_BAR; bar.x = 0; bar.st = nullptr;
    if (!MK_PER_PHASE) bar = xcd_barrier_post(F.ctl + CW_BAR, F.LC);
    const int lo = args.ph_lo, hi = args.ph_hi;
#define IN(k) (lo <= (k) && (k) < hi)
#ifndef DBL_LNR
#define DBL_LNR 1
#endif
#ifndef DBL_COMB
#define DBL_COMB 1
#endif
#ifndef DBL_NG
#define DBL_NG 1
#endif
#ifndef DBL_GIN
#define DBL_GIN 1
#endif
#ifndef DBL_GOUT
#define DBL_GOUT 1
#endif
#ifndef DBL_GCMP
#define DBL_GCMP 1
#endif
#ifndef DBL_GUP
#define DBL_GUP 1
#endif
#ifndef DBL_GDN
#define DBL_GDN 1
#endif
#ifndef DBL_SCAN
#define DBL_SCAN 1
#endif
#ifndef DBL_P0
#define DBL_P0 1
#endif
#ifndef DBL_ATT
#define DBL_ATT 1
#endif
#define REP(n) _Pragma("unroll 1") for (int rep_ = 0; rep_ < (n); ++rep_)
#ifdef PROBE_A
#define STAMP(k) do { if (blockIdx.x == 0 && F.tid == 0) ((unsigned long long*)(F.ws + OFF_TAB + 65536))[(k)] = wall_clock64(); } while (0)
#else
#define STAMP(k) do {} while (0)
#endif
#define SEAM(k) do { if (!MK_PER_PHASE && (k) + 1 < hi) xcd_barrier(bar); else __syncthreads(); } while (0)

    STAMP(0);
    if (IN(0)) {
#ifndef NO_P0
 REP(DBL_P0) p0_prologue(F);
#endif
 SEAM(0); }

    for (int L = 0; L < DEPTH; ++L) {
        int Lo = L; asm volatile("; layer-local" : "+s"(Lo));
        const int kind = Lo % 3, slot = Lo / 3, pb = 1 + PH_PER_LAYER * Lo;
#define PHL Frame Fp = F; asm volatile("; phase-local" : "+v"(Fp.tid), "+s"(Fp.bx)); Fp.lane = Fp.tid & 63;
        const int ldp = kind == 0 ? NSA_LD : (kind == 1 ? ML_LD : HG_LD);
        if (IN(pb + 0)) { PHL STAMP(pb + 0);
            const bf16_t* Wt = kind == 0 ? WSP(bf16_t, OFF_W_NSAIN) + (size_t)slot * NSA_LD * D : (kind == 1 ? WSP(bf16_t, OFF_W_MLIN) : WSP(bf16_t, OFF_W_HGIN));
            pg8::APlain AS{WSP(bf16_t, OFF_XN), D}; pg8::BPlain BS{Wt, D}; pg8::StaticOrder S; S.init(NTOK / 256, ldp / 256, Fp.G, Fp.bx);
            pg8::EpiStore E{WSP(bf16_t, OFF_PROJ), ldp};
            #ifndef NO_GIN
            REP(DBL_GIN) pg8::gemm_phase<pg8::EpiStore, pg8::StaticOrder, pg8::APlain, pg8::BPlain>(Fp.lds, D, AS, BS, S, E);
#endif
            SEAM(pb + 0);
        }
        if (kind == 0) {
            if (IN(pb + 1)) { PHL STAMP(pb + 1);
                pg8::ACmp AS{WSP(bf16_t, OFF_PROJ), NSA_LD, 1024}; pg8::BGroup BS{WSP(bf16_t, OFF_W_CMP1) + (size_t)slot * 2 * 256 * 2048, 2048, (size_t)256 * 2048};
                pg8::CmpOrder S{Fp.G, Fp.bx};
                pg8::EpiCmpGelu E{WSP(bf16_t, OFF_HC), WSP(float, OFF_TAB) + TAB_CMPB + slot * 512};
                #ifndef NO_GCMP
                REP(DBL_GCMP) pg8::gemm_phase<pg8::EpiCmpGelu, pg8::CmpOrder, pg8::ACmp, pg8::BGroup>(Fp.lds, 2048, AS, BS, S, E);
#endif
                SEAM(pb + 1);
            }
            if (IN(pb + 2)) { PHL STAMP(pb + 2);
#ifndef NO_CMP2
 REP(DBL_GCMP) phase_nsa_cmp2(Fp, slot);
#endif
 SEAM(pb + 2); }
            if (IN(pb + 3)) { PHL STAMP(pb + 3);
#ifndef NO_ATTN
 REP(DBL_ATT) phase_nsa_attn_mfma(Fp, slot);
#endif
 SEAM(pb + 3); }
        } else if (kind == 1) {
            if (IN(pb + 1)) { PHL STAMP(pb + 1);
#ifdef MLS_CHECK
                {
                    const size_t n16 = (size_t)NTOK * D * 2 / 16; u32x4* HMv = WSP(u32x4, OFF_HM); u32x4* Y1 = WSP(u32x4, OFF_Y); u32x4* Y2 = WSP(u32x4, OFF_Y + 160 * MiB);
#pragma unroll 1
                    for (int rep_ = 0; rep_ < 3; ++rep_) {
                        phase_mlstm_scan_mfma(Fp);
                        xcd_barrier(bar);
                        if (rep_ < 2) { u32x4* dst = rep_ == 0 ? Y1 : Y2;
                            for (size_t i = (size_t)blockIdx.x * 512 + Fp.tid; i < n16; i += (size_t)Fp.G * 512) dst[i] = HMv[i];
                            xcd_barrier(bar); }
                    }
                    unsigned bad_bits = 0u; float md = 0.f, mr = 0.f;
                    for (size_t i = (size_t)blockIdx.x * 512 + Fp.tid; i < n16; i += (size_t)Fp.G * 512) { const u32x4 a = HMv[i], b2 = Y2[i], c1 = Y1[i];
                        if (a.x != b2.x || a.y != b2.y || a.z != b2.z || a.w != b2.w) bad_bits = 1u;
                        const unsigned aw[4] = {a.x, a.y, a.z, a.w}, cw[4] = {c1.x, c1.y, c1.z, c1.w};
#pragma unroll
                        for (int q = 0; q < 4; ++q) { const float a0 = __uint_as_float(aw[q] << 16), a1 = __uint_as_float(aw[q] & 0xffff0000u), r0 = __uint_as_float(cw[q] << 16), r1 = __uint_as_float(cw[q] & 0xffff0000u);
                            md = fmaxf(md, fmaxf(fabsf(a0 - r0), fabsf(a1 - r1))); mr = fmaxf(mr, fmaxf(fabsf(r0), fabsf(r1))); if (!(a0 == a0) || !(a1 == a1)) bad_bits |= 4u; } }
                    md = wave_max(md); mr = wave_max(mr);
                    if (Fp.lane == 0) { atomicMax(F.ctl + 9000, __float_as_uint(md)); atomicMax(F.ctl + 9001, __float_as_uint(mr)); }
                    if (bad_bits) atomicOr(F.ctl + 9002, bad_bits);
                }
#else
#ifndef NO_MLS
 REP(DBL_SCAN) phase_mlstm_scan_mfma(Fp);
#endif
#endif
 SEAM(pb + 1); }
            if (IN(pb + 2)) { PHL STAMP(pb + 2);
#ifndef NO_NG
 REP(DBL_NG) phase_norm_gate<256>(Fp, inptr(Fp, I_ML_NORM_G), ML_LD, 2048);
#endif
 SEAM(pb + 2); }
        } else {
            if (IN(pb + 1)) { PHL STAMP(pb + 1);
#ifndef NO_HGS
 REP(DBL_SCAN) phase_hgrn_scan_mfma(Fp);
#endif
 SEAM(pb + 1); }
        }
        if (IN(pb + 4)) { PHL STAMP(pb + 4);
            const bf16_t* Wt = kind == 0 ? WSP(bf16_t, OFF_W_NSAOUT) + (size_t)slot * D * D : (kind == 1 ? WSP(bf16_t, OFF_W_MLOUT) : WSP(bf16_t, OFF_W_HGOUT));
            pg8::APlain AS{WSP(bf16_t, OFF_ATT), D}; pg8::BPlain BS{Wt, D}; pg8::StaticOrder S; S.init(NTOK / 256, D / 256, Fp.G, Fp.bx);
            pg8::EpiStore E{WSP(bf16_t, OFF_HM), D};
            #ifndef NO_GOUT
            REP(DBL_GOUT) pg8::gemm_phase<pg8::EpiStore, pg8::StaticOrder, pg8::APlain, pg8::BPlain>(Fp.lds, D, AS, BS, S, E);
#endif
            SEAM(pb + 4);
        }
        if (IN(pb + 5)) { PHL STAMP(pb + 5);
#ifndef NO_LNR
 if (DBL_LNR > 1) phase_ln_router(Fp, Lo, true);
 phase_ln_router(Fp, Lo);
#endif
 SEAM(pb + 5); }
        if (IN(pb + 6)) { PHL STAMP(pb + 6);
#ifndef NO_SLOT
 phase_moe_slots(Fp, Lo);
#endif
 SEAM(pb + 6); }
        if (IN(pb + 7)) { PHL STAMP(pb + 7);
            moe_tile_table(Fp, Lo);
            pg8::AGather AS{WSP(bf16_t, OFF_XN), D, WSP(int, OFF_ROWT)}; pg8::BGroup BS{WSP(bf16_t, OFF_W_GU) + (size_t)Lo * NEXP * 2048 * D, D, (size_t)2048 * D};
            pg8::MoeOrder S; S.init(__builtin_amdgcn_readfirstlane((int)Fp.LC[40]), 8, Fp.G, Fp.bx); S.pend = (const LAS int*)(Fp.lds + LDSCTL_OFF + 32);
            pg8::EpiSwiglu E{WSP(bf16_t, OFF_H), inptr(Fp, I_MOE_B_GU) + (size_t)Lo * NEXP * 2048};
            #ifndef NO_GUP
            REP(DBL_GUP) pg8::gemm_phase<pg8::EpiSwiglu, pg8::MoeOrder, pg8::AGather, pg8::BGroup>(Fp.lds, D, AS, BS, S, E);
#endif
            SEAM(pb + 7);
        }
        if (IN(pb + 8)) { PHL STAMP(pb + 8);
            moe_tile_table(Fp, Lo);
            pg8::APlain AS{WSP(bf16_t, OFF_H), DFF}; pg8::BGroup BS{WSP(bf16_t, OFF_W_DN) + (size_t)Lo * NEXP * D * DFF, DFF, (size_t)D * DFF};
            pg8::MoeOrder S; S.init(__builtin_amdgcn_readfirstlane((int)Fp.LC[40]), 4, Fp.G, Fp.bx); S.pend = (const LAS int*)(Fp.lds + LDSCTL_OFF + 32);
            pg8::EpiDown E{WSP(bf16_t, OFF_Y), inptr(Fp, I_MOE_B_DOWN) + (size_t)Lo * NEXP * D, WSP(float, OFF_ROWG)};
            #ifndef NO_GDN
            REP(DBL_GDN) pg8::gemm_phase<pg8::EpiDown, pg8::MoeOrder, pg8::APlain, pg8::BGroup>(Fp.lds, DFF, AS, BS, S, E);
#endif
            SEAM(pb + 8);
        }
        if (IN(pb + 9)) { PHL STAMP(pb + 9);
#ifndef NO_COMB
 if (DBL_COMB > 1) phase_combine_ln(Fp, Lo, (float*)nullptr, true);
 phase_combine_ln(Fp, Lo, Lo == DEPTH - 1 ? Fp.out : (float*)nullptr);
#endif
 SEAM(pb + 9); }
    }
#ifdef MLS_CHECK
    xcd_barrier(bar);
    { const float md = __uint_as_float(__hip_atomic_load(F.ctl + 9000, RLX_AGENT)), mr = __uint_as_float(__hip_atomic_load(F.ctl + 9001, RLX_AGENT)); const unsigned bb = __hip_atomic_load(F.ctl + 9002, RLX_AGENT);
      float code = 10.f; if (md > 0.02f * mr) code = 100.f; if (md > 0.2f * mr) code = 300.f; if (bb & 1u) code *= 10.f; if (bb & 4u) code *= 100.f;
      for (size_t i = (size_t)blockIdx.x * 512 + F.tid; i < (size_t)NTOK * D; i += (size_t)F.G * 512) F.out[i] = code; }
#endif
#ifdef PROBE_A
    STAMP(N_PHASES);
    xcd_barrier(bar);
    {
        const unsigned long long* st = (const unsigned long long*)(F.ws + OFF_TAB + 65536);
        float cat[6] = {0.f, 0.f, 0.f, 0.f, 0.f, 0.f};
        unsigned long long prev = __hip_atomic_load(st + 0, RLX_AGENT);
        int pc = 0;
        for (int p = 1; p <= N_PHASES; ++p) {
            int c = -1;
            if (p < N_PHASES) { const int Lq = (p - 1) / PH_PER_LAYER, k = (p - 1) % PH_PER_LAYER, kind = Lq % 3;
                if (k == 3 && kind != 0) continue;
                c = (k == 0 || k == 4 || k == 7 || k == 8) ? 1 : (k == 1 ? (kind == 0 ? 1 : (kind == 1 ? 3 : 4)) : (k == 3 ? 2 : 5)); }
            const unsigned long long now = __hip_atomic_load(st + p, RLX_AGENT);
            const float us = (float)(now - prev) * 0.01f;
#pragma unroll
            for (int q = 0; q < 6; ++q) if (q == pc) cat[q] += us;
            prev = now; pc = c;
        }
        float va = 0.f, vb = 0.f;
#pragma unroll
        for (int q = 0; q < 6; ++q) { if (q == PROBE_A) va = cat[q]; if (q == PROBE_B) vb = cat[q]; }
        const float kfill = sqrtf(va);
        for (size_t i = (size_t)blockIdx.x * 512 + F.tid; i < (size_t)NTOK * D; i += (size_t)F.G * 512) F.out[i] = (i == 0) ? vb : kfill;
    }
#endif
#undef IN
#undef SEAM
#undef PHL
}

extern "C" void kernel_launch(void* const* d_in, const int* in_sizes, int n_in, void* d_out, int out_size, void* d_ws, size_t ws_size, hipStream_t stream) {
    static int grid = 0;
    if (grid == 0) {
        if (n_in != 27 || out_size != NTOK * D || ws_size < WS_END) { fprintf(stderr, "kernel_launch: unexpected shapes (n_in %d, out %d, ws %zu)\n", n_in, out_size, ws_size); grid = -1; return; }
        int dev = 0, cus = 0;
        if (hipGetDevice(&dev) != hipSuccess || hipDeviceGetAttribute(&cus, hipDeviceAttributeMultiprocessorCount, dev) != hipSuccess) { grid = -1; return; }
        if (hipFuncSetAttribute((const void*)mk_fwd, hipFuncAttributeMaxDynamicSharedMemorySize, LDS_BYTES) != hipSuccess) { fprintf(stderr, "kernel_launch: hipFuncSetAttribute failed\n"); grid = -1; return; }
        int per_cu = 0;
        if (hipOccupancyMaxActiveBlocksPerMultiprocessor(&per_cu, (const void*)mk_fwd, 512, LDS_BYTES) != hipSuccess || per_cu < 1) fprintf(stderr, "kernel_launch: occupancy query reports %d\n", per_cu);
        (void)hipGetLastError();
        grid = cus;
    }
    if (grid < 0) return;
    (void)hipMemsetAsync((char*)d_ws + OFF_CTL, 0, CTL_ZERO_BYTES, stream);
    Args a{};
    for (int i = 0; i < 27; ++i) a.in[i] = (const float*)d_in[i];
    a.out = (float*)d_out; a.ws = (unsigned char*)d_ws;
#if MK_PER_PHASE
    for (int p = 0; p < N_PHASES; ++p) {
        if (p > 0) { const int L = (p - 1) / PH_PER_LAYER, k = (p - 1) % PH_PER_LAYER, kind = L % 3; if (k == 3 && kind != 0) continue; }
        a.ph_lo = p; a.ph_hi = p + 1;
        hipLaunchKernelGGL(mk_fwd, dim3(grid), dim3(512), LDS_BYTES, stream, a);
    }
#else
    a.ph_lo = 0; a.ph_hi = N_PHASES;
    hipLaunchKernelGGL(mk_fwd, dim3(grid), dim3(512), LDS_BYTES, stream, a);
#endif
}
```

```cpp
#include <hip/hip_runtime.h>
#include <cstdio>
#include <cstdint>

#define LAS __attribute__((address_space(3)))
#define GAS __attribute__((address_space(1)))
typedef unsigned short bf16_t;
typedef short bf16x8 __attribute__((ext_vector_type(8)));
typedef float f32x4 __attribute__((ext_vector_type(4)));
typedef float f32x2 __attribute__((ext_vector_type(2)));
typedef unsigned u32x4 __attribute__((ext_vector_type(4)));
typedef unsigned u32x2 __attribute__((ext_vector_type(2)));
#define RLX_AGENT __ATOMIC_RELAXED, __HIP_MEMORY_SCOPE_AGENT
#define LDS_WAIT() asm volatile("s_waitcnt lgkmcnt(0)" ::: "memory")
#define VM_WAIT() asm volatile("s_waitcnt vmcnt(0)" ::: "memory")

#ifndef MK_PER_PHASE
#define MK_PER_PHASE 0
#endif

constexpr int D = 1024, BATCH = 32, T = 2048, NTOK = BATCH * T, DEPTH = 4;
constexpr int NSA_IN = 2608, NSA_LD = 2816, ML_IN = 3080, ML_LD = 3328, HG_LD = 4096;
constexpr int NEXP = 32, TOPK = 4, DFF = 1024;
constexpr int MOE_ROWS = 270336;
constexpr float LN_EPS = 1e-5f, RMS_EPS = 1e-6f;
constexpr float DN_ALPHA = 1.681792830507429f;
constexpr int NCMP = 127;

constexpr size_t MiB = 1u << 20;
constexpr size_t OFF_CTL = 0, CTL_ZERO_BYTES = 1 * MiB;
constexpr size_t OFF_TAB = 1 * MiB;
constexpr size_t OFF_TOKE = 2 * MiB;
constexpr size_t OFF_TOKG = 3 * MiB;
constexpr size_t OFF_TOKP = 4 * MiB;
constexpr size_t OFF_ROWT = 5 * MiB;
constexpr size_t OFF_ROWG = 7 * MiB;
constexpr size_t OFF_KC = 9 * MiB;
constexpr size_t OFF_HC = 17 * MiB;
constexpr size_t OFF_W_NSAIN = 33 * MiB;
constexpr size_t OFF_W_NSAOUT = 44 * MiB;
constexpr size_t OFF_W_MLIN = 48 * MiB;
constexpr size_t OFF_W_MLOUT = 55 * MiB;
constexpr size_t OFF_W_HGIN = 57 * MiB;
constexpr size_t OFF_W_HGOUT = 65 * MiB;
constexpr size_t OFF_W_CMP2 = 71 * MiB;
constexpr size_t OFF_W_CMP1 = 67 * MiB;
constexpr size_t OFF_W_GU = 72 * MiB;
constexpr size_t OFF_W_DN = 584 * MiB;
constexpr size_t OFF_XA = 840 * MiB;
constexpr size_t OFF_XN = 1096 * MiB;
constexpr size_t OFF_PROJ = 1224 * MiB;
constexpr size_t OFF_ATT = 1740 * MiB;
constexpr size_t OFF_HM = 1868 * MiB;
constexpr size_t OFF_H = 1996 * MiB;
constexpr size_t OFF_Y = 2526 * MiB;
constexpr size_t WS_END = 3056 * MiB;
constexpr int TAB_CMPB = 0;
constexpr int TAB_LB = 4096;
constexpr int TAB_RWT = 8192;
constexpr int CW_BAR = 4096;
constexpr int CW_CNT = 16384;
constexpr int CW_CUR = 16384 + 1024;

constexpr int RING_BYTES = 131072;
constexpr int LDSCTL_OFF = 155648;
constexpr int LDS_BYTES = 156672;

__device__ __forceinline__ float bf2f(bf16_t b) { return __uint_as_float(((unsigned)b) << 16); }
typedef float f32x2_t_ __attribute__((ext_vector_type(2))); typedef __bf16 bf16x2_t_ __attribute__((ext_vector_type(2)));
__device__ __forceinline__ unsigned pk2(float lo, float hi) { const f32x2_t_ v = {lo, hi}; const bf16x2_t_ b = __builtin_convertvector(v, bf16x2_t_); return __builtin_bit_cast(unsigned, b); }
__device__ __forceinline__ unsigned f2bf(float f) { return pk2(f, f) & 0xffffu; }
template <int CTRL> __device__ __forceinline__ float dppf(float v) { return __builtin_bit_cast(float, __builtin_amdgcn_update_dpp(0, __builtin_bit_cast(int, v), CTRL, 0xF, 0xF, true)); }
__device__ __forceinline__ float rdl(float v, int l) { return __builtin_bit_cast(float, __builtin_amdgcn_readlane(__builtin_bit_cast(int, v), l)); }
__device__ __forceinline__ float wave_sum(float v) {
    v += dppf<0xB1>(v); v += dppf<0x4E>(v); v += dppf<0x141>(v); v += dppf<0x140>(v);
    return (rdl(v, 0) + rdl(v, 16)) + (rdl(v, 32) + rdl(v, 48));
}
__device__ __forceinline__ float wave_max(float v) {
    v = fmaxf(v, dppf<0xB1>(v)); v = fmaxf(v, dppf<0x4E>(v)); v = fmaxf(v, dppf<0x141>(v)); v = fmaxf(v, dppf<0x140>(v));
    return fmaxf(fmaxf(rdl(v, 0), rdl(v, 16)), fmaxf(rdl(v, 32), rdl(v, 48)));
}
__device__ __forceinline__ float sigmoidf_(float x) { return __builtin_amdgcn_rcpf(1.0f + __expf(-x)); }

#define XB_TMO      128
#define XB_XCNT(j)  (256  + 64 * (j))
#define XB_XSUB(j)  (1280 + 64 * (j))
#define XB_XGEN(j)  (2304 + 64 * (j))
#define XB_TOP      3328
#define XB_TOPGEN   3392
#define XCD_BAR_WORDS 3456
#define XB_SPIN_CAP (1u << 20)

__device__ __forceinline__ unsigned xb_ld(unsigned* p)              { return __hip_atomic_load(p, __ATOMIC_RELAXED, __HIP_MEMORY_SCOPE_AGENT); }
__device__ __forceinline__ unsigned xb_add(unsigned* p, unsigned v) { return __hip_atomic_fetch_add(p, v, __ATOMIC_RELAXED, __HIP_MEMORY_SCOPE_AGENT); }
__device__ __forceinline__ unsigned xb_xcc_id() { return (unsigned)__builtin_amdgcn_s_getreg((3 << 11) | 20) & 0xFu; }
#define XB_SPIN(cond, bar) do { unsigned _sp = 0; while (cond) { __builtin_amdgcn_s_sleep(1); \
    if ((++_sp & 255u) == 0u) { if (xb_ld(&(bar)[XB_TMO])) break; if (_sp > XB_SPIN_CAP) { atomicAdd(&(bar)[XB_TMO], 1u); break; } } } } while (0)

struct XcdBarrier { unsigned* bar; unsigned x; volatile LAS unsigned* st; };

__device__ __forceinline__ XcdBarrier xcd_barrier_post(unsigned* bar, volatile LAS unsigned* st) {
    XcdBarrier b; b.bar = bar; b.x = xb_xcc_id(); b.st = st;
    if (threadIdx.x == 0) (void)xb_add(&bar[XB_XCNT(b.x)], 1u);
    return b;
}
__device__ __forceinline__ void xcd_barrier_complete(unsigned* bar, unsigned x, unsigned& nloc, unsigned& nx) {
    const unsigned G = gridDim.x * gridDim.y * gridDim.z;
    unsigned sum, cnt, mine, sp = 0u;
    for (;;) {
        sum = 0u; cnt = 0u; mine = 0u;
#pragma unroll
        for (unsigned j = 0; j < 16; ++j) { const unsigned c = xb_ld(&bar[XB_XCNT(j)]); sum += c; cnt += (c > 0u) ? 1u : 0u; }
        mine = xb_ld(&bar[XB_XCNT(x)]);
        if (sum == G) break;
        __builtin_amdgcn_s_sleep(1);
        if ((++sp & 255u) == 0u) { if (xb_ld(&bar[XB_TMO])) break; if (sp > XB_SPIN_CAP) { atomicAdd(&bar[XB_TMO], 1u); break; } }
    }
    nloc = mine > 0u ? mine : 1u; nx = cnt > 0u ? cnt : 1u;
}
__device__ __forceinline__ void xcd_barrier(const XcdBarrier& b) {
    asm volatile("s_waitcnt vmcnt(0)" ::: "memory");
    __syncthreads();
    if (threadIdx.x == 0) {
        unsigned* bar = b.bar; asm volatile("; barrier words" : "+s"(bar));
        __builtin_amdgcn_s_waitcnt(0);
        unsigned nloc = b.st[0], nx = b.st[1];
        if (nloc == 0u) { xcd_barrier_complete(bar, b.x, nloc, nx); b.st[0] = nloc; b.st[1] = nx; }
        const unsigned old = xb_add(&bar[XB_XSUB(b.x)], 1u);
        const unsigned gen = old / nloc;
        if (old + 1u == (gen + 1u) * nloc) {
            __builtin_amdgcn_fence(__ATOMIC_RELEASE, "agent");
            asm volatile("s_waitcnt vmcnt(0)" ::: "memory");
            const unsigned og = xb_add(&bar[XB_TOP], 1u);
            const unsigned tg = og / nx;
            if (og + 1u == (tg + 1u) * nx) xb_add(&bar[XB_TOPGEN], 1u);
            else XB_SPIN(xb_ld(&bar[XB_TOPGEN]) == tg, bar);
            __builtin_amdgcn_fence(__ATOMIC_ACQUIRE, "agent");
            xb_add(&bar[XB_XGEN(b.x)], 1u);
            asm volatile("s_waitcnt vmcnt(0)" ::: "memory");
        } else {
            XB_SPIN(xb_ld(&bar[XB_XGEN(b.x)]) == gen, bar);
            __builtin_amdgcn_fence(__ATOMIC_ACQUIRE, "agent");
            asm volatile("s_waitcnt vmcnt(0)" ::: "memory");
        }
    }
    __syncthreads();
}

namespace pg8 {
constexpr int BM = 256, BK = 64, HALF = 128, HTB = HALF * BK * 2, STAGE_BYTES = 8 * HTB, NXCD = 8, WGM = 8;
__host__ __device__ __forceinline__ int lds_byte(int r, int c) { const int st = (r >> 4) * 2 + (c >> 5), rr = r & 15, cc = c & 31, ob = rr * 64 + cc * 2; return st * 1024 + (ob ^ (((ob >> 9) & 1) << 5)); }
__host__ __device__ __forceinline__ void stage_rc(int b, int& R, int& C) { const int st = b / 1024, sb = b % 1024, swz = sb ^ (((sb >> 9) & 1) << 5); R = (st >> 1) * 16 + swz / 64; C = (st & 1) * 32 + (swz % 64) / 2; }
__host__ __device__ __forceinline__ int perm32(int rho) { const int n = rho >> 4, i = rho & 15; return 8 * (i >> 2) + 4 * n + (i & 3); }

struct Unit { int pm, pn, e; };

struct StaticOrder {
    int nM, nN, nwg, G, c, wgm = WGM;
    __device__ __forceinline__ void init(int nM_, int nN_, int G_, int c_) { nM = nM_; nN = nN_; nwg = nM * nN; G = G_; c = c_; }
    __device__ __forceinline__ bool next(int i, Unit& u) const {
        const long L = (long)i * G + c; if (L >= nwg) return false;
        int wgid = (int)L; { const int q = nwg / NXCD, r = nwg % NXCD, xcd = wgid % NXCD, off = wgid / NXCD; wgid = (xcd < r ? xcd * (q + 1) : r * (q + 1) + (xcd - r) * q) + off; }
        const int nig = wgm * nN, gid = wgid / nig, fm = gid * wgm, gsz = (nM - fm) < wgm ? (nM - fm) : wgm;
        u.pm = fm + ((wgid % nig) % gsz); u.pn = (wgid % nig) / gsz; u.e = 0; return true;
    }
};
struct MoeOrder : StaticOrder {
    const LAS int* pend;
    __device__ __forceinline__ bool next(int i, Unit& u) const {
        if (!StaticOrder::next(i, u)) return false;
        const int ln = __builtin_amdgcn_mbcnt_hi(~0u, __builtin_amdgcn_mbcnt_lo(~0u, 0u));
        const int pe = pend[ln & 31];
        const unsigned long long bal = __builtin_amdgcn_ballot_w64(ln < 31 && pe <= u.pm);
        u.e = __builtin_popcountll(bal); return true;
    }
};
struct CmpOrder {
    int G, c;
    __device__ __forceinline__ bool next(int i, Unit& u) const { const int L = i * G + c; if (L >= 128) return false; u.e = L >> 6; u.pm = L & 63; u.pn = 0; return true; }
};

__device__ __forceinline__ unsigned cvt_pk_bf16(float lo, float hi) { const f32x2_t_ v = {lo, hi}; const bf16x2_t_ b = __builtin_convertvector(v, bf16x2_t_); return __builtin_bit_cast(unsigned, b); }

struct APlain {
    static constexpr bool GATHER = false;
    const bf16_t* A; int lda;
    __device__ __forceinline__ int kstep() const { return BK * 2; }
    __device__ __forceinline__ const char* base(const Unit& u) const { return (const char*)A + (size_t)u.pm * BM * lda * 2; }
    __device__ __forceinline__ void offs(const Unit&, const int (&R)[2], const int (&C)[2], unsigned (&vo)[2][2]) const {
#pragma unroll
        for (int h = 0; h < 2; ++h)
#pragma unroll
            for (int i = 0; i < 2; ++i) vo[h][i] = (unsigned)((h * HALF + R[i]) * lda + C[i]) * 2u;
    }
};
struct AGather {
    static constexpr bool GATHER = true;
    const bf16_t* A; int lda; const int* idx;
    __device__ __forceinline__ int kstep() const { return BK * 2; }
    __device__ __forceinline__ const char* base(const Unit&) const { return (const char*)A; }
    __device__ __forceinline__ void offs(const Unit& u, const int (&R)[2], const int (&C)[2], unsigned (&vo)[2][2]) const {
#pragma unroll
        for (int h = 0; h < 2; ++h)
#pragma unroll
            for (int i = 0; i < 2; ++i) { const int row = idx[u.pm * BM + h * HALF + R[i]]; vo[h][i] = (unsigned)(row * lda + C[i]) * 2u; }
    }
};
struct ACmp {
    static constexpr bool GATHER = false;
    const bf16_t* P; int ld; int col0;
    __device__ __forceinline__ int kstep() const { return ld * 2; }
    __device__ __forceinline__ const char* base(const Unit& u) const { const int b = u.pm >> 1, g0 = (u.pm & 1) * 2; return (const char*)P + ((size_t)b * T * ld + col0 + u.e * 256 + g0 * 64) * 2; }
    __device__ __forceinline__ void offs(const Unit&, const int (&R)[2], const int (&C)[2], unsigned (&vo)[2][2]) const {
#pragma unroll
        for (int h = 0; h < 2; ++h)
#pragma unroll
            for (int i = 0; i < 2; ++i) vo[h][i] = (unsigned)(16 * R[i] * ld + h * 64 + C[i]) * 2u;
    }
};
struct BPlain { const bf16_t* Bt; int K; __device__ __forceinline__ const char* base(const Unit& u) const { return (const char*)Bt + (size_t)u.pn * BM * K * 2; } };
struct BGroup { const bf16_t* Bt; int K; size_t gstride;   __device__ __forceinline__ const char* base(const Unit& u) const { return (const char*)Bt + ((size_t)u.e * gstride + (size_t)u.pn * BM * K) * 2; } };

template <class Epi, class Sched, class ASrc, class BSrc, bool ALIGN_EPI = true, bool SP2 = true>
__device__ __forceinline__ void gemm_phase(LAS unsigned char* lds, const int K, const ASrc& AS, const BSrc& BS, const Sched& S, const Epi& E) {
    int tid = threadIdx.x; asm volatile("; phase-local tid" : "+v"(tid));
    const int wid = __builtin_amdgcn_readfirstlane(tid >> 6), lane = tid & 63, wr = wid >> 2, wc = wid & 3, fr = lane & 15, fq = lane >> 4;
    const int nt = K / BK;
    int Rs[2], Cs[2]; unsigned voffB[2];
#pragma unroll
    for (int i = 0; i < 2; ++i) { int R, C; stage_rc(tid * 16 + i * 8192, R, C); Rs[i] = R; Cs[i] = C; const int Rb = Epi::PERM ? ((R & ~31) + perm32(R & 31)) : R; voffB[i] = (unsigned)(Rb * K + C) * 2u; }
    const size_t kstepB = (size_t)(BK * 2), hstepB = (size_t)HALF * K * 2;
    const size_t kstepA = (size_t)AS.kstep();
    const unsigned ldsw = (unsigned)wid * 1024u;
    const int aoff = lds_byte(wr * 64 + fr, fq * 8), boff = lds_byte(wc * 32 + fr, fq * 8);
#define PG8_SA(b, h) (((b) * 2 + (h)) * HTB)
#define PG8_SB(b, h) ((4 + (b) * 2 + (h)) * HTB)
#define PG8_STAGEB(bufoff, gbase) do { _Pragma("unroll") for (int _i = 0; _i < 2; ++_i) \
        __builtin_amdgcn_global_load_lds((const unsigned*)((const char*)(gbase) + voffB[_i]), (LAS unsigned*)(lds + (bufoff) + ldsw + _i * 8192), 16, 0, 0); } while (0)
#define PG8_STAGEA(bufoff, gbase, o0, o1) do { \
        __builtin_amdgcn_global_load_lds((const unsigned*)((const char*)(gbase) + (o0)), (LAS unsigned*)(lds + (bufoff) + ldsw), 16, 0, 0); \
        __builtin_amdgcn_global_load_lds((const unsigned*)((const char*)(gbase) + (o1)), (LAS unsigned*)(lds + (bufoff) + ldsw + 8192), 16, 0, 0); } while (0)
#define PG8_LDA(dst, b, h) do { _Pragma("unroll") for (int m = 0; m < 4; ++m) _Pragma("unroll") for (int k = 0; k < 2; ++k) dst[m][k] = *(const LAS bf16x8*)(lds + PG8_SA(b, h) + aoff + m * 2048 + k * 1024); } while (0)
#define PG8_LDB(dst, b, h) do { _Pragma("unroll") for (int n = 0; n < 2; ++n) _Pragma("unroll") for (int k = 0; k < 2; ++k) dst[n][k] = *(const LAS bf16x8*)(lds + PG8_SB(b, h) + boff + n * 2048 + k * 1024); } while (0)
#define PG8_MMA(ai, bj, At, Bt) do { __builtin_amdgcn_s_setprio(1); _Pragma("unroll") for (int m = 0; m < 4; ++m) _Pragma("unroll") for (int n = 0; n < 2; ++n) _Pragma("unroll") for (int k = 0; k < 2; ++k) \
        acc[ai][bj][m][n] = __builtin_amdgcn_mfma_f32_16x16x32_bf16(Bt[n][k], At[m][k], acc[ai][bj][m][n], 0, 0, 0); __builtin_amdgcn_s_setprio(0); } while (0)
#define PG8_WAIT_V(n) asm volatile("s_waitcnt vmcnt(" #n ")" ::: "memory")
#define PG8_WAIT_L(n) asm volatile("s_waitcnt lgkmcnt(" #n ")" ::: "memory")
#define PG8_BAR __builtin_amdgcn_s_barrier()
#define PG8_SCHED __builtin_amdgcn_sched_barrier(0)
    Unit cur, nxt; int ui = 0;
    if (!S.next(0, cur)) return;
    f32x4 acc[2][2][4][2];
    E.init(acc, cur, wc, fq);
    bf16x8 At[4][2], B0[2][2], B1[2][2];
    unsigned vC[2][2];
    AS.offs(cur, Rs, Cs, vC);
    unsigned x00 = vC[0][0], x01 = vC[0][1], x10 = vC[1][0], x11 = vC[1][1];
    const char* cA = AS.base(cur); const char* cB = BS.base(cur);
    if constexpr (SP2) {
        PG8_STAGEB(PG8_SB(0, 0), cB); PG8_STAGEB(PG8_SB(0, 1), cB + hstepB); PG8_STAGEA(PG8_SA(0, 0), cA, vC[0][0], vC[0][1]); PG8_STAGEA(PG8_SA(0, 1), cA, vC[1][0], vC[1][1]);
        if (wr == 1) PG8_BAR;
        PG8_WAIT_V(2); PG8_BAR;
        PG8_STAGEB(PG8_SB(1, 0), cB + kstepB); PG8_STAGEA(PG8_SA(1, 0), cA + kstepA, vC[0][0], vC[0][1]); PG8_STAGEB(PG8_SB(1, 1), cB + hstepB + kstepB);
        PG8_WAIT_V(6); PG8_BAR;
    } else {
        PG8_STAGEB(PG8_SB(0, 0), cB); PG8_STAGEA(PG8_SA(0, 0), cA, vC[0][0], vC[0][1]); PG8_STAGEB(PG8_SB(0, 1), cB + hstepB); PG8_STAGEA(PG8_SA(0, 1), cA, vC[1][0], vC[1][1]);
        if (wr == 1) PG8_BAR;
        PG8_WAIT_V(4); PG8_BAR;
        PG8_STAGEB(PG8_SB(1, 0), cB + kstepB); PG8_STAGEA(PG8_SA(1, 0), cA + kstepA, vC[0][0], vC[0][1]); PG8_STAGEB(PG8_SB(1, 1), cB + hstepB + kstepB);
        PG8_WAIT_V(6); PG8_BAR;
    }
    for (;;) {
        const bool has_next = S.next(ui + 1, nxt);
        const char* nA = has_next ? AS.base(nxt) : cA; const char* nB = has_next ? BS.base(nxt) : cB;
        for (int t = 0; t < nt; t += 2) {
            const bool last = (t == nt - 2);
            const char* a1 = cA + (size_t)(t + 1) * kstepA;
            const char* a2 = last ? nA : cA + (size_t)(t + 2) * kstepA; const char* b2 = last ? nB : cB + (size_t)(t + 2) * kstepB;
            const char* a3 = a2 + kstepA; const char* b3 = b2 + kstepB;
            if constexpr (ASrc::GATHER) { if (last && has_next) { unsigned vn[2][2]; AS.offs(nxt, Rs, Cs, vn); x00 = vn[0][0]; x01 = vn[0][1]; x10 = vn[1][0]; x11 = vn[1][1]; } }
            if constexpr (SP2) {
            PG8_LDB(B0, 0, 0); PG8_LDB(B1, 0, 1); PG8_SCHED; PG8_LDA(At, 0, 0); PG8_STAGEA(PG8_SA(1, 1), a1, vC[1][0], vC[1][1]);
            PG8_WAIT_V(8); PG8_WAIT_L(0); PG8_BAR; PG8_MMA(0, 0, At, B0); PG8_MMA(0, 1, At, B1); PG8_BAR; PG8_SCHED;
            PG8_LDA(At, 0, 1); PG8_STAGEB(PG8_SB(0, 0), b2); PG8_STAGEB(PG8_SB(0, 1), b2 + hstepB); PG8_STAGEA(PG8_SA(0, 0), a2, x00, x01);
            PG8_WAIT_V(8); PG8_WAIT_L(0); PG8_BAR; PG8_MMA(1, 0, At, B0); PG8_MMA(1, 1, At, B1); PG8_BAR; PG8_SCHED;
            PG8_LDB(B0, 1, 0); PG8_LDB(B1, 1, 1); PG8_SCHED; PG8_LDA(At, 1, 0); PG8_STAGEA(PG8_SA(0, 1), a2, x10, x11);
            PG8_WAIT_V(8); PG8_WAIT_L(0); PG8_BAR; PG8_MMA(0, 0, At, B0); PG8_MMA(0, 1, At, B1); PG8_BAR; PG8_SCHED;
            PG8_LDA(At, 1, 1); PG8_STAGEB(PG8_SB(1, 0), b3); PG8_STAGEB(PG8_SB(1, 1), b3 + hstepB); PG8_STAGEA(PG8_SA(1, 0), a3, x00, x01);
            PG8_WAIT_V(8); PG8_WAIT_L(0); PG8_BAR; PG8_MMA(1, 0, At, B0); PG8_MMA(1, 1, At, B1); PG8_BAR; PG8_SCHED;
            } else {
            PG8_LDB(B0, 0, 0); PG8_SCHED; PG8_LDA(At, 0, 0); PG8_STAGEA(PG8_SA(1, 1), a1, vC[1][0], vC[1][1]);
            PG8_WAIT_L(8); PG8_BAR; PG8_WAIT_L(0); PG8_MMA(0, 0, At, B0); PG8_BAR; PG8_SCHED;
            PG8_LDB(B1, 0, 1); PG8_STAGEB(PG8_SB(0, 0), b2);
            PG8_BAR; PG8_WAIT_L(0); PG8_MMA(0, 1, At, B1); PG8_BAR;
            PG8_LDA(At, 0, 1); PG8_STAGEA(PG8_SA(0, 0), a2, x00, x01);
            PG8_BAR; PG8_WAIT_L(0); PG8_MMA(1, 0, At, B0); PG8_BAR; PG8_SCHED;
            PG8_STAGEB(PG8_SB(0, 1), b2 + hstepB);
            PG8_WAIT_V(6); PG8_BAR; PG8_MMA(1, 1, At, B1); PG8_BAR;
            PG8_LDB(B0, 1, 0); PG8_SCHED; PG8_LDA(At, 1, 0); PG8_STAGEA(PG8_SA(0, 1), a2, x10, x11);
            PG8_WAIT_L(8); PG8_BAR; PG8_WAIT_L(0); PG8_MMA(0, 0, At, B0); PG8_BAR; PG8_SCHED;
            PG8_LDB(B1, 1, 1); PG8_STAGEB(PG8_SB(1, 0), b3);
            PG8_BAR; PG8_WAIT_L(0); PG8_MMA(0, 1, At, B1); PG8_BAR;
            PG8_LDA(At, 1, 1); PG8_STAGEA(PG8_SA(1, 0), a3, x00, x01);
            PG8_BAR; PG8_WAIT_L(0); PG8_MMA(1, 0, At, B0); PG8_BAR; PG8_SCHED;
            PG8_STAGEB(PG8_SB(1, 1), b3 + hstepB);
            PG8_WAIT_V(6); PG8_BAR; PG8_MMA(1, 1, At, B1); PG8_BAR;
            }
        }
        if constexpr (ALIGN_EPI) { if (wr == 0) PG8_BAR; }
        E(acc, cur, wr, wc, fr, fq);
        if (!has_next) break;
        E.init(acc, nxt, wc, fq);
        cur = nxt; cA = nA; cB = nB; ++ui;
        if constexpr (ASrc::GATHER) { vC[0][0] = x00; vC[0][1] = x01; vC[1][0] = x10; vC[1][1] = x11; }
        if constexpr (ALIGN_EPI) { if (wr == 1) PG8_BAR; }
    }
    PG8_WAIT_V(0);
    if constexpr (!ALIGN_EPI) { if (wr == 0) PG8_BAR; }
    PG8_BAR;
#undef PG8_SA
#undef PG8_SB
#undef PG8_STAGEA
#undef PG8_STAGEB
#undef PG8_LDA
#undef PG8_LDB
#undef PG8_MMA
#undef PG8_WAIT_V
#undef PG8_WAIT_L
#undef PG8_BAR
#undef PG8_SCHED
}
}
namespace pg8 {
__device__ __forceinline__ float gelu_tanh(float x) {
    const float u = 0.7978845608028654f * (x + 0.044715f * x * x * x);
    const float e = __expf(-2.0f * fabsf(u)); float th = (1.0f - e) * __builtin_amdgcn_rcpf(1.0f + e); th = u < 0.f ? -th : th;
    return 0.5f * x * (1.0f + th);
}
struct EpiStore {
    static constexpr bool PERM = true;
    bf16_t* O; int ldc;
    __device__ __forceinline__ void init(f32x4 (&acc)[2][2][4][2], const Unit&, int, int) const {
#pragma unroll
        for (int a = 0; a < 2; ++a)
#pragma unroll
            for (int b = 0; b < 2; ++b)
#pragma unroll
                for (int m = 0; m < 4; ++m)
#pragma unroll
                    for (int n = 0; n < 2; ++n) acc[a][b][m][n] = (f32x4){0.f, 0.f, 0.f, 0.f};
    }
    __device__ __forceinline__ void operator()(const f32x4 (&acc)[2][2][4][2], const Unit& u, int wr, int wc, int fr, int fq) const {
        const int row0 = u.pm * BM + wr * 64 + fr, col0 = u.pn * BM + wc * 32 + 8 * fq;
#pragma unroll
        for (int ai = 0; ai < 2; ++ai)
#pragma unroll
            for (int m = 0; m < 4; ++m) { bf16_t* rowp = O + (size_t)(row0 + ai * HALF + m * 16) * ldc + col0;
#pragma unroll
                for (int bj = 0; bj < 2; ++bj) { const f32x4 v0 = acc[ai][bj][m][0], v1 = acc[ai][bj][m][1];
                    u32x4 w; w.x = cvt_pk_bf16(v0[0], v0[1]); w.y = cvt_pk_bf16(v0[2], v0[3]); w.z = cvt_pk_bf16(v1[0], v1[1]); w.w = cvt_pk_bf16(v1[2], v1[3]);
                    *(u32x4*)(rowp + bj * HALF) = w; } }
    }
};
struct EpiCmpGelu {
    static constexpr bool PERM = true;
    bf16_t* O; const float* bias;
    __device__ __forceinline__ void init(f32x4 (&acc)[2][2][4][2], const Unit&, int, int) const {
#pragma unroll
        for (int a = 0; a < 2; ++a)
#pragma unroll
            for (int b = 0; b < 2; ++b)
#pragma unroll
                for (int m = 0; m < 4; ++m)
#pragma unroll
                    for (int n = 0; n < 2; ++n) acc[a][b][m][n] = (f32x4){0.f, 0.f, 0.f, 0.f};
    }
    __device__ __forceinline__ void operator()(const f32x4 (&acc)[2][2][4][2], const Unit& u, int wr, int wc, int fr, int fq) const {
        const int row0 = u.pm * BM + wr * 64 + fr, col0 = wc * 32 + 8 * fq;
        bf16_t* Oj = O + (size_t)u.e * 16384 * 256; const float* bj_ = bias + u.e * 256;
        f32x4 bv[2][2];
#pragma unroll
        for (int bj = 0; bj < 2; ++bj)
#pragma unroll
            for (int n = 0; n < 2; ++n) bv[bj][n] = *(const f32x4*)(bj_ + col0 + bj * HALF + 4 * n);
#pragma unroll
        for (int ai = 0; ai < 2; ++ai)
#pragma unroll
            for (int m = 0; m < 4; ++m) { bf16_t* rowp = Oj + (size_t)(row0 + ai * HALF + m * 16) * 256 + col0;
#pragma unroll
                for (int bj = 0; bj < 2; ++bj) { f32x4 v0 = acc[ai][bj][m][0] + bv[bj][0], v1 = acc[ai][bj][m][1] + bv[bj][1];
#pragma unroll
                    for (int j = 0; j < 4; ++j) { v0[j] = gelu_tanh(v0[j]); v1[j] = gelu_tanh(v1[j]); }
                    u32x4 w; w.x = cvt_pk_bf16(v0[0], v0[1]); w.y = cvt_pk_bf16(v0[2], v0[3]); w.z = cvt_pk_bf16(v1[0], v1[1]); w.w = cvt_pk_bf16(v1[2], v1[3]);
                    *(u32x4*)(rowp + bj * HALF) = w; } }
    }
};
struct EpiSwiglu {
    static constexpr bool PERM = true;
    bf16_t* H; const float* bgu;
    __device__ __forceinline__ void init(f32x4 (&acc)[2][2][4][2], const Unit& u, int wc, int fq) const {
        const float* bg = bgu + (size_t)u.e * 2048 + u.pn * HALF + wc * 32 + 8 * fq;
#pragma unroll
        for (int n = 0; n < 2; ++n) { const f32x4 g = *(const f32x4*)(bg + 4 * n), up = *(const f32x4*)(bg + 1024 + 4 * n);
#pragma unroll
            for (int a = 0; a < 2; ++a)
#pragma unroll
                for (int m = 0; m < 4; ++m) { acc[a][0][m][n] = g; acc[a][1][m][n] = up; } }
    }
    __device__ __forceinline__ void operator()(const f32x4 (&acc)[2][2][4][2], const Unit& u, int wr, int wc, int fr, int fq) const {
        const int row0 = u.pm * BM + wr * 64 + fr, col0 = u.pn * HALF + wc * 32 + 8 * fq;
#pragma unroll
        for (int ai = 0; ai < 2; ++ai)
#pragma unroll
            for (int m = 0; m < 4; ++m) { bf16_t* rowp = H + (size_t)(row0 + ai * HALF + m * 16) * DFF + col0;
                unsigned wv[4];
#pragma unroll
                for (int n = 0; n < 2; ++n) { const f32x4 g = acc[ai][0][m][n], up = acc[ai][1][m][n];
#pragma unroll
                    for (int j = 0; j < 2; ++j) {
                        const f32x2 gg = {__builtin_amdgcn_fmed3f(g[2 * j], -3.0e38f, 7.0f), __builtin_amdgcn_fmed3f(g[2 * j + 1], -3.0e38f, 7.0f)};
                        const f32x2 uu = {__builtin_amdgcn_fmed3f(up[2 * j], -7.0f, 7.0f), __builtin_amdgcn_fmed3f(up[2 * j + 1], -7.0f, 7.0f)};
                        const f32x2 t = gg * -2.4554669595930156f;
                        f32x2 d = {__builtin_amdgcn_exp2f(t.x), __builtin_amdgcn_exp2f(t.y)}; d = d + 1.0f;
                        const f32x2 rr = {__builtin_amdgcn_rcpf(d.x), __builtin_amdgcn_rcpf(d.y)};
                        const f32x2 o = (uu + 1.0f) * gg * rr;
                        wv[2 * n + j] = cvt_pk_bf16(o.x, o.y); } }
                u32x4 w; w.x = wv[0]; w.y = wv[1]; w.z = wv[2]; w.w = wv[3];
                *(u32x4*)rowp = w; }
    }
};
struct EpiDown {
    static constexpr bool PERM = true;
    bf16_t* Y; const float* bd; const float* rgate;
    __device__ __forceinline__ void init(f32x4 (&acc)[2][2][4][2], const Unit& u, int wc, int fq) const {
        const float* b = bd + (size_t)u.e * 1024 + u.pn * BM + wc * 32 + 8 * fq;
#pragma unroll
        for (int bj = 0; bj < 2; ++bj)
#pragma unroll
            for (int n = 0; n < 2; ++n) { const f32x4 bv = *(const f32x4*)(b + bj * HALF + 4 * n);
#pragma unroll
                for (int a = 0; a < 2; ++a)
#pragma unroll
                    for (int m = 0; m < 4; ++m) acc[a][bj][m][n] = bv; }
    }
    __device__ __forceinline__ void operator()(const f32x4 (&acc)[2][2][4][2], const Unit& u, int wr, int wc, int fr, int fq) const {
        const int row0 = u.pm * BM + wr * 64 + fr, col0 = u.pn * BM + wc * 32 + 8 * fq;
#pragma unroll
        for (int ai = 0; ai < 2; ++ai)
#pragma unroll
            for (int m = 0; m < 4; ++m) { const int row = row0 + ai * HALF + m * 16; const float gt = rgate[row]; bf16_t* rowp = Y + (size_t)row * D + col0;
#pragma unroll
                for (int bj = 0; bj < 2; ++bj) { const f32x4 v0 = acc[ai][bj][m][0] * gt, v1 = acc[ai][bj][m][1] * gt;
                    u32x4 w; w.x = cvt_pk_bf16(v0[0], v0[1]); w.y = cvt_pk_bf16(v0[2], v0[3]); w.z = cvt_pk_bf16(v1[0], v1[1]); w.w = cvt_pk_bf16(v1[2], v1[3]);
                    *(u32x4*)(rowp + bj * HALF) = w; } }
    }
};
}
struct Frame {
    LAS unsigned char* lds;
    volatile LAS unsigned* LC;
    unsigned* ctl;
    unsigned char* ws;
    int tid, lane, wave, G, bx;
    float* out;
};
__device__ __forceinline__ size_t opaque_off(size_t o) { asm volatile("; ws offset" : "+s"(o)); return o; }
#define WSP(T_, off) ((T_*)(F.ws + opaque_off(off)))
__device__ __forceinline__ const float* inptr(const Frame& F, int i) {
    const unsigned lo = __builtin_amdgcn_readfirstlane(F.LC[128 + 2 * i]), hi = __builtin_amdgcn_readfirstlane(F.LC[129 + 2 * i]);
    const float* p = (const float*)(const GAS float*)(((unsigned long long)hi << 32) | (unsigned long long)lo);
    return p;
}
enum { I_X = 0, I_LN_G, I_LN_B, I_NSA_W_IN, I_NSA_CMP_POS, I_NSA_CMP_W1, I_NSA_CMP_B1, I_NSA_CMP_W2, I_NSA_CMP_B2, I_NSA_GATE_B, I_NSA_W_OUT,
       I_ML_W_IN, I_ML_CONV_W, I_ML_CONV_B, I_ML_GATE_B, I_ML_NORM_G, I_ML_W_OUT, I_HG_W_IN, I_HG_LOWER, I_HG_NORM_G, I_HG_W_OUT,
       I_ROUTER_W, I_ROUTER_B, I_MOE_W_GU, I_MOE_B_GU, I_MOE_W_DOWN, I_MOE_B_DOWN };

__device__ __forceinline__ void tr_load(f32x4 (&v)[16], const float* W, int N, int nvalid, int k0, int n0, int lane) {
    const int nn = n0 + 4 * (lane & 15); const bool ok = nn < nvalid; const int kr = lane >> 4;
#pragma unroll
    for (int i = 0; i < 16; ++i) v[i] = ok ? *(const f32x4*)(W + (size_t)(k0 + 4 * i + kr) * N + nn) : (f32x4){0.f, 0.f, 0.f, 0.f};
}
__device__ __forceinline__ void tr_store(const f32x4 (&v)[16], int K, bf16_t* WT, int drow, int k0, LAS float* scr, int lane) {
    const int kr = lane >> 4;
#pragma unroll
    for (int i = 0; i < 16; ++i) { LAS float* d = scr + (4 * i + kr) * 65 + 4 * (lane & 15); d[0] = v[i][0]; d[1] = v[i][1]; d[2] = v[i][2]; d[3] = v[i][3]; }
    LDS_WAIT();
    const int c = lane & 7;
#pragma unroll
    for (int j = 0; j < 8; ++j) { const int n = (lane >> 3) + 8 * j; const LAS float* s = scr + (8 * c) * 65 + n;
        u32x4 o; o.x = pk2(s[0 * 65], s[1 * 65]); o.y = pk2(s[2 * 65], s[3 * 65]); o.z = pk2(s[4 * 65], s[5 * 65]); o.w = pk2(s[6 * 65], s[7 * 65]);
        *(u32x4*)(WT + (size_t)(drow + n) * K + k0 + 8 * c) = o; }
    LDS_WAIT();
}
__device__ __forceinline__ void tr_class(Frame& F, const float* W, int nmat, int K, int N, int Npad, bf16_t* WT, bool gu, LAS float* scr, int gw, int NGW) {
    const int nblk = Npad / 64, per = (K / 64) * nblk; const long total = (long)nmat * per;
    f32x4 vbuf[16];
    long it = gw;
    if (it < total) { const int mat = (int)(it / per), r = (int)(it % per), kb = r / nblk, nb = r % nblk; tr_load(vbuf, W + (size_t)mat * K * N, N, N, kb * 64, nb * 64, F.lane); }
#pragma unroll 1
    for (; it < total; it += NGW) {
        const int mat = (int)(it / per), r = (int)(it % per), kb = r / nblk, nb = r % nblk, n0 = nb * 64;
        int drow = n0;
        if (gu) drow = (n0 < 1024) ? ((n0 >> 7) * 256 + (n0 & 127)) : ((((n0 - 1024) >> 7) * 256) + 128 + ((n0 - 1024) & 127));
        f32x4 cur[16];
#pragma unroll
        for (int i = 0; i < 16; ++i) cur[i] = vbuf[i];
        const long nx = it + NGW;
        if (nx < total) { const int mat2 = (int)(nx / per), r2 = (int)(nx % per), kb2 = r2 / nblk, nb2 = r2 % nblk; tr_load(vbuf, W + (size_t)mat2 * K * N, N, N, kb2 * 64, nb2 * 64, F.lane); }
        tr_store(cur, K, WT + (size_t)mat * Npad * K, drow, kb * 64, scr, F.lane);
    }
}
__device__ __forceinline__ void p0_prologue(Frame& F) {
    LAS float* scr = (LAS float*)(F.lds + F.wave * 16896);
    const int gw = F.bx * 8 + F.wave, NGW = F.G * 8;
    tr_class(F, inptr(F, I_MOE_W_GU), DEPTH * NEXP, D, 2 * DFF, 2 * DFF, WSP(bf16_t, OFF_W_GU), true, scr, gw, NGW);
    tr_class(F, inptr(F, I_MOE_W_DOWN), DEPTH * NEXP, DFF, D, D, WSP(bf16_t, OFF_W_DN), false, scr, gw, NGW);
    tr_class(F, inptr(F, I_NSA_W_IN), 2, D, NSA_IN, NSA_LD, WSP(bf16_t, OFF_W_NSAIN), false, scr, gw, NGW);
    tr_class(F, inptr(F, I_NSA_W_OUT), 2, D, D, D, WSP(bf16_t, OFF_W_NSAOUT), false, scr, gw, NGW);
    tr_class(F, inptr(F, I_ML_W_IN), 1, D, ML_IN, ML_LD, WSP(bf16_t, OFF_W_MLIN), false, scr, gw, NGW);
    tr_class(F, inptr(F, I_ML_W_OUT), 1, D, D, D, WSP(bf16_t, OFF_W_MLOUT), false, scr, gw, NGW);
    tr_class(F, inptr(F, I_HG_W_IN), 1, D, HG_LD, HG_LD, WSP(bf16_t, OFF_W_HGIN), false, scr, gw, NGW);
    tr_class(F, inptr(F, I_HG_W_OUT), 1, D, D, D, WSP(bf16_t, OFF_W_HGOUT), false, scr, gw, NGW);
    tr_class(F, inptr(F, I_NSA_CMP_W1), 4, 2048, 256, 256, WSP(bf16_t, OFF_W_CMP1), false, scr, gw, NGW);
    tr_class(F, inptr(F, I_NSA_CMP_W2), 4, 256, 64, 64, WSP(bf16_t, OFF_W_CMP2), false, scr, gw, NGW);
    const int gt = F.bx * 512 + F.tid;
    float* tab = WSP(float, OFF_TAB);
    if (gt < 1024) {
        const int lj = gt >> 8, n = gt & 255; const float* pos = inptr(F, I_NSA_CMP_POS) + (size_t)lj * 2048; const float* w1 = inptr(F, I_NSA_CMP_W1) + (size_t)lj * 2048 * 256;
        float a = inptr(F, I_NSA_CMP_B1)[lj * 256 + n];
        for (int k = 0; k < 2048; ++k) a += pos[k] * w1[(size_t)k * 256 + n];
        tab[TAB_CMPB + gt] = a;
    } else if (gt < 2048) {
        const int c = gt - 1024; float v[DEPTH], mx = -1e30f;
#pragma unroll
        for (int i = 0; i < DEPTH; ++i) { v[i] = inptr(F, I_HG_LOWER)[i * D + c]; mx = fmaxf(mx, v[i]); }
        float s = 0.f;
#pragma unroll
        for (int i = 0; i < DEPTH; ++i) { v[i] = __expf(v[i] - mx); s += v[i]; }
        tab[TAB_LB + c] = (v[1] + v[2]) / s;
    }
    { const float* rw = inptr(F, I_ROUTER_W); float* rwt = WSP(float, OFF_TAB) + TAB_RWT;
      for (int i = F.bx * 512 + F.tid; i < DEPTH * D * NEXP; i += F.G * 512) { const int l = i >> 15, r = i & 32767, k = r >> 5, e = r & 31; rwt[(l * NEXP + e) * D + k] = rw[i]; } }
    {
        const f32x4* xs = (const f32x4*)inptr(F, I_X); u32x2* xn = WSP(u32x2, OFF_XN);
        const size_t n4 = (size_t)NTOK * D / 4, stride = (size_t)F.G * 512;
        for (size_t i = (size_t)F.bx * 512 + F.tid; i < n4; i += stride) { const f32x4 v = xs[i]; u32x2 o; o.x = pk2(v[0], v[1]); o.y = pk2(v[2], v[3]); xn[i] = o; }
    }
}

__device__ __forceinline__ void split8(const f32x4& x0, const f32x4& x1, bf16x8& hi, bf16x8& lo) {
    u32x4 h, l;
    h.x = pk2(x0[0], x0[1]); h.y = pk2(x0[2], x0[3]); h.z = pk2(x1[0], x1[1]); h.w = pk2(x1[2], x1[3]);
    l.x = pk2(x0[0] - __uint_as_float(h.x << 16), x0[1] - __uint_as_float(h.x & 0xffff0000u)); l.y = pk2(x0[2] - __uint_as_float(h.y << 16), x0[3] - __uint_as_float(h.y & 0xffff0000u));
    l.z = pk2(x1[0] - __uint_as_float(h.z << 16), x1[1] - __uint_as_float(h.z & 0xffff0000u)); l.w = pk2(x1[2] - __uint_as_float(h.w << 16), x1[3] - __uint_as_float(h.w & 0xffff0000u));
    hi = __builtin_bit_cast(bf16x8, h); lo = __builtin_bit_cast(bf16x8, l);
}
__device__ __forceinline__ void phase_ln_router(Frame& F, int layer, bool dummy = false) {
    constexpr int SP = 1028;
    LAS float* LgL = (LAS float*)F.lds;
    LAS float* slab = LgL + 256 * 33;
    LAS float* part = slab + 16 * SP;
    if (F.tid < 32) F.LC[64 + F.tid] = 0u;
    __syncthreads();
    const float* g = inptr(F, I_LN_G) + (size_t)(layer * 2 + 0) * D; const float* bb = inptr(F, I_LN_B) + (size_t)(layer * 2 + 0) * D;
    const float* rb = inptr(F, I_ROUTER_B) + layer * NEXP;
    const float* rwt = WSP(float, OFF_TAB) + TAB_RWT + (size_t)layer * NEXP * D;
    const bf16_t* HM = WSP(bf16_t, OFF_HM); bf16_t* XN = dummy ? WSP(bf16_t, OFF_H + 256 * MiB) : WSP(bf16_t, OFF_XN);
    const bf16_t* XR = WSP(bf16_t, OFF_XN);
    int* toke = dummy ? WSP(int, OFF_H + 400 * MiB) : WSP(int, OFF_TOKE); float* tokg = dummy ? WSP(float, OFF_H + 402 * MiB) : WSP(float, OFF_TOKG);
    int lane = F.lane; asm volatile("; phase-local lane" : "+v"(lane));
    const int fr = lane & 15, fg = lane >> 4, wave = F.wave;
    const float rbv = rb[F.tid & 31];
    f32x4 gr[4], br[4];
    bf16x8 bh0[4], bl0[4], bh1[4], bl1[4];
    {
#pragma unroll
      for (int ks = 0; ks < 4; ++ks) { const float* q0 = rwt + (size_t)fr * D + 128 * wave + 32 * ks + 8 * fg; const float* q1 = q0 + (size_t)16 * D;
          const f32x4 w0 = *(const f32x4*)q0, w1 = *(const f32x4*)(q0 + 4), w2 = *(const f32x4*)q1, w3 = *(const f32x4*)(q1 + 4);
          split8(w0, w1, bh0[ks], bl0[ks]); split8(w2, w3, bh1[ks], bl1[ks]); }
#pragma unroll
      for (int j = 0; j < 4; ++j) { gr[j] = *((const f32x4*)g + lane + 64 * j); br[j] = *((const f32x4*)bb + lane + 64 * j); } }
    for (int blk = F.bx; blk < NTOK / 256; blk += F.G) {
        u32x2 xn_[2][4], hn_[2][4];
        { const int m0 = blk * 256 + 2 * wave;
#pragma unroll
          for (int q = 0; q < 2; ++q) { const u32x2* xr = (const u32x2*)(XR + (size_t)(m0 + q) * D) + lane; const u32x2* hr = (const u32x2*)(HM + (size_t)(m0 + q) * D) + lane;
#pragma unroll
            for (int j = 0; j < 4; ++j) { xn_[q][j] = xr[64 * j]; hn_[q][j] = hr[64 * j]; } } }
#pragma unroll 1
        for (int sub = 0; sub < 16; ++sub) {
            const int mb = blk * 256 + sub * 16 + 2 * wave;
            f32x4 v[2][4]; float s[2] = {0.f, 0.f};
#pragma unroll
            for (int q = 0; q < 2; ++q)
#pragma unroll
                for (int j = 0; j < 4; ++j) { const u32x2 xv = xn_[q][j]; const u32x2 hv = hn_[q][j];
                    v[q][j][0] = DN_ALPHA * __uint_as_float(xv.x << 16) + __uint_as_float(hv.x << 16); v[q][j][1] = DN_ALPHA * __uint_as_float(xv.x & 0xffff0000u) + __uint_as_float(hv.x & 0xffff0000u);
                    v[q][j][2] = DN_ALPHA * __uint_as_float(xv.y << 16) + __uint_as_float(hv.y << 16); v[q][j][3] = DN_ALPHA * __uint_as_float(xv.y & 0xffff0000u) + __uint_as_float(hv.y & 0xffff0000u);
                    s[q] += (v[q][j][0] + v[q][j][1]) + (v[q][j][2] + v[q][j][3]); }
            if (sub + 1 < 16) {
#pragma unroll
                for (int q = 0; q < 2; ++q) { const u32x2* xr = (const u32x2*)(XR + (size_t)(mb + 16 + q) * D) + lane; const u32x2* hr = (const u32x2*)(HM + (size_t)(mb + 16 + q) * D) + lane;
#pragma unroll
                    for (int j = 0; j < 4; ++j) { xn_[q][j] = xr[64 * j]; hn_[q][j] = hr[64 * j]; } } }
#pragma unroll
            for (int q = 0; q < 2; ++q) {
                const float mean = wave_sum(s[q]) * (1.f / D); float s2 = 0.f;
#pragma unroll
                for (int j = 0; j < 4; ++j) { v[q][j] = v[q][j] - mean; s2 += (v[q][j][0] * v[q][j][0] + v[q][j][1] * v[q][j][1]) + (v[q][j][2] * v[q][j][2] + v[q][j][3] * v[q][j][3]); }
                const float rstd = __builtin_amdgcn_rsqf(wave_sum(s2) * (1.f / D) + LN_EPS);
                u32x2* no = (u32x2*)(XN + (size_t)(mb + q) * D) + lane; LAS f32x4* so = (LAS f32x4*)(slab + (2 * wave + q) * SP) + lane;
#pragma unroll
                for (int j = 0; j < 4; ++j) { const f32x4 gv = gr[j], bv = br[j];
                    const f32x4 y = v[q][j] * rstd * gv + bv; so[64 * j] = y; u32x2 o; o.x = pk2(y[0], y[1]); o.y = pk2(y[2], y[3]); no[64 * j] = o; }
            }
            __syncthreads();
            {
                const LAS float* Ap = slab + fr * SP + 128 * wave + 8 * fg;
                f32x4 acc0 = (f32x4){0.f, 0.f, 0.f, 0.f}, acc1 = acc0;
#pragma unroll
                for (int ks = 0; ks < 4; ++ks) { bf16x8 ah, al; const f32x4 xa = *(const LAS f32x4*)(Ap + 32 * ks), xb = *(const LAS f32x4*)(Ap + 32 * ks + 4); split8(xa, xb, ah, al);
                    acc0 = __builtin_amdgcn_mfma_f32_16x16x32_bf16(ah, bh0[ks], acc0, 0, 0, 0); acc1 = __builtin_amdgcn_mfma_f32_16x16x32_bf16(ah, bh1[ks], acc1, 0, 0, 0);
                    acc0 = __builtin_amdgcn_mfma_f32_16x16x32_bf16(al, bh0[ks], acc0, 0, 0, 0); acc1 = __builtin_amdgcn_mfma_f32_16x16x32_bf16(al, bh1[ks], acc1, 0, 0, 0);
                    acc0 = __builtin_amdgcn_mfma_f32_16x16x32_bf16(ah, bl0[ks], acc0, 0, 0, 0); acc1 = __builtin_amdgcn_mfma_f32_16x16x32_bf16(ah, bl1[ks], acc1, 0, 0, 0); }
#pragma unroll
                for (int e = 0; e < 4; ++e) { LAS float* pr = part + (wave * 16 + 4 * fg + e) * 33; pr[fr] = acc0[e]; pr[16 + fr] = acc1[e]; }
            }
            __syncthreads();
            { const int row = F.tid >> 5, e = F.tid & 31; float lg = rbv;
#pragma unroll
              for (int w8 = 0; w8 < 8; ++w8) lg += part[(w8 * 16 + row) * 33 + e];
              LgL[(sub * 16 + row) * 33 + e] = lg; }
        }
        __syncthreads();
        if (F.tid < 256) {
            const int m = blk * 256 + F.tid; const LAS float* lr = LgL + F.tid * 33;
            unsigned taken = 0u; int se[TOPK]; float sv[TOPK];
#pragma unroll
            for (int k = 0; k < TOPK; ++k) { float best = -INFINITY; int bi = 0;
#pragma unroll 8
                for (int e = 0; e < NEXP; ++e) { const float c = ((taken >> e) & 1u) ? -INFINITY : lr[e]; if (c > best) { best = c; bi = e; } }
                se[k] = bi; sv[k] = best; taken |= 1u << bi; }
            float gs = 0.f, ge[TOPK];
#pragma unroll
            for (int k = 0; k < TOPK; ++k) { ge[k] = __expf(sv[k] - sv[0]); gs += ge[k]; }
            const float inv = __builtin_amdgcn_rcpf(gs);
#pragma unroll
            for (int k = 0; k < TOPK; ++k) { toke[m * 4 + k] = se[k]; tokg[m * 4 + k] = ge[k] * inv; __hip_atomic_fetch_add((LAS unsigned*)&F.LC[64 + se[k]], 1u, __ATOMIC_RELAXED, __HIP_MEMORY_SCOPE_WORKGROUP); }
        }
        __syncthreads();
    }
    if (F.tid < 32) { const unsigned c = F.LC[64 + F.tid]; if (c) __hip_atomic_fetch_add(F.ctl + (dummy ? 12288 : CW_CNT) + layer * 64 + F.tid, c, RLX_AGENT); }
    __syncthreads();
}

__device__ __forceinline__ void moe_tile_table(Frame& F, int layer) {
    if (F.tid < 64) {
        const int e = F.tid & 31;
        const unsigned c = __hip_atomic_load(F.ctl + CW_CNT + layer * 64 + e, RLX_AGENT);
        int acc = (int)((c + 255u) >> 8);
#pragma unroll
        for (int o = 1; o < 32; o <<= 1) { const int u = __shfl_up(acc, o); if (e >= o) acc += u; }
        if (F.tid < 32) { F.LC[8 + e] = (unsigned)acc; if (e == 31) F.LC[40] = (unsigned)acc; }
    }
    __syncthreads();
}
__device__ __forceinline__ void phase_moe_slots(Frame& F, int layer) {
    moe_tile_table(F, layer);
    const int* toke = WSP(int, OFF_TOKE); const float* tokg = WSP(float, OFF_TOKG);
    int* tokp = WSP(int, OFF_TOKP); int* rowt = WSP(int, OFF_ROWT); float* rowg = WSP(float, OFF_ROWG);
    for (int blk = F.bx; blk < NTOK / 256; blk += F.G) {
        if (F.tid < 32) F.LC[64 + F.tid] = 0u;
        __syncthreads();
        int e[2], rank[2];
#pragma unroll
        for (int q = 0; q < 2; ++q) { const int a = blk * 1024 + q * 512 + F.tid; e[q] = toke[a]; rank[q] = (int)__hip_atomic_fetch_add((LAS unsigned*)&F.LC[64 + e[q]], 1u, __ATOMIC_RELAXED, __HIP_MEMORY_SCOPE_WORKGROUP); }
        __syncthreads();
        if (F.tid < 32) { const unsigned c = F.LC[64 + F.tid]; const unsigned pstart = (F.tid ? F.LC[8 + F.tid - 1] : 0u) * 256u;
            F.LC[96 + F.tid] = pstart + (c ? __hip_atomic_fetch_add(F.ctl + CW_CUR + layer * 64 + F.tid, c, RLX_AGENT) : 0u); }
        __syncthreads();
#pragma unroll
        for (int q = 0; q < 2; ++q) { const int a = blk * 1024 + q * 512 + F.tid; const int pos = (int)F.LC[96 + e[q]] + rank[q];
            rowt[pos] = a >> 2; rowg[pos] = tokg[a]; tokp[a] = pos; }
        __syncthreads();
    }
    for (int e2 = F.bx; e2 < NEXP; e2 += F.G) {
        const unsigned c = __hip_atomic_load(F.ctl + CW_CNT + layer * 64 + e2, RLX_AGENT); const unsigned pstart = (e2 ? F.LC[8 + e2 - 1] : 0u) * 256u, pend = F.LC[8 + e2] * 256u;
        for (unsigned r = pstart + c + F.tid; r < pend; r += 512) { rowt[r] = 0; rowg[r] = 0.f; }
    }
}
__device__ __forceinline__ void phase_combine_ln(Frame& F, int layer, float* xo_base  , bool dummy = false) {
    const float* g = inptr(F, I_LN_G) + (size_t)(layer * 2 + 1) * D; const float* bb = inptr(F, I_LN_B) + (size_t)(layer * 2 + 1) * D;
    const bf16_t* XR = WSP(bf16_t, OFF_XN); bf16_t* XN = dummy ? WSP(bf16_t, OFF_H + 256 * MiB) : WSP(bf16_t, OFF_XN); const bf16_t* Y = WSP(bf16_t, OFF_Y); const int* tokp = WSP(int, OFF_TOKP);
    int lane = F.lane; asm volatile("; phase-local lane" : "+v"(lane)); const int gw = F.bx * 8 + F.wave, NGW = F.G * 8;
    u32x2 xq[4]; u32x2 yq[TOPK][4]; int posn[TOPK];
    f32x4 gr[4], br[4];
#pragma unroll
    for (int j = 0; j < 4; ++j) { gr[j] = *((const f32x4*)g + lane + 64 * j); br[j] = *((const f32x4*)bb + lane + 64 * j); }
    {
        int p0[TOPK];
#pragma unroll
        for (int k = 0; k < TOPK; ++k) p0[k] = (gw < NTOK) ? tokp[gw * 4 + k] : 0;
        if (gw < NTOK) { const u32x2* xr = (const u32x2*)(XR + (size_t)gw * D) + lane;
#pragma unroll
            for (int j = 0; j < 4; ++j) xq[j] = xr[64 * j];
#pragma unroll
            for (int k = 0; k < TOPK; ++k) { const u32x2* yr = (const u32x2*)(Y + (size_t)p0[k] * D) + lane;
#pragma unroll
                for (int j = 0; j < 4; ++j) yq[k][j] = __builtin_nontemporal_load(yr + 64 * j); } }
#pragma unroll
        for (int k = 0; k < TOPK; ++k) posn[k] = (gw + NGW < NTOK) ? tokp[(gw + NGW) * 4 + k] : 0;
    }
#pragma unroll 1
    for (int m = gw; m < NTOK; m += NGW) {
        f32x4 v[4]; float s = 0.f;
#pragma unroll
        for (int j = 0; j < 4; ++j) { const u32x2 xv = xq[j]; v[j][0] = DN_ALPHA * __uint_as_float(xv.x << 16); v[j][1] = DN_ALPHA * __uint_as_float(xv.x & 0xffff0000u); v[j][2] = DN_ALPHA * __uint_as_float(xv.y << 16); v[j][3] = DN_ALPHA * __uint_as_float(xv.y & 0xffff0000u); }
#pragma unroll
        for (int k = 0; k < TOPK; ++k) {
#pragma unroll
            for (int j = 0; j < 4; ++j) { const u32x2 hv = yq[k][j];
                v[j][0] += __uint_as_float(hv.x << 16); v[j][1] += __uint_as_float(hv.x & 0xffff0000u); v[j][2] += __uint_as_float(hv.y << 16); v[j][3] += __uint_as_float(hv.y & 0xffff0000u); } }
        if (m + NGW < NTOK) {
            const u32x2* xr = (const u32x2*)(XR + (size_t)(m + NGW) * D) + lane;
#pragma unroll
            for (int j = 0; j < 4; ++j) xq[j] = xr[64 * j];
#pragma unroll
            for (int k = 0; k < TOPK; ++k) { const u32x2* yr = (const u32x2*)(Y + (size_t)posn[k] * D) + lane;
#pragma unroll
                for (int j = 0; j < 4; ++j) yq[k][j] = __builtin_nontemporal_load(yr + 64 * j); }
#pragma unroll
            for (int k = 0; k < TOPK; ++k) posn[k] = (m + 2 * NGW < NTOK) ? tokp[(m + 2 * NGW) * 4 + k] : 0;
        }
#pragma unroll
        for (int j = 0; j < 4; ++j) s += (v[j][0] + v[j][1]) + (v[j][2] + v[j][3]);
        const float mean = wave_sum(s) * (1.f / D); float s2 = 0.f;
#pragma unroll
        for (int j = 0; j < 4; ++j) { v[j] = v[j] - mean; s2 += (v[j][0] * v[j][0] + v[j][1] * v[j][1]) + (v[j][2] * v[j][2] + v[j][3] * v[j][3]); }
        const float rstd = __builtin_amdgcn_rsqf(wave_sum(s2) * (1.f / D) + LN_EPS);
        u32x2* no = (u32x2*)(XN + (size_t)m * D) + lane;
#pragma unroll
        for (int j = 0; j < 4; ++j) { const f32x4 gv = gr[j], bv = br[j];
            v[j] = v[j] * rstd * gv + bv;
            if (xo_base) *((f32x4*)(xo_base + (size_t)m * D) + lane + 64 * j) = v[j];
            else { u32x2 o; o.x = pk2(v[j][0], v[j][1]); o.y = pk2(v[j][2], v[j][3]); no[64 * j] = o; } }
    }
}
__device__ __forceinline__ void phase_nsa_cmp2(Frame& F, int slot) {
    const bf16_t* HC = WSP(bf16_t, OFF_HC); bf16_t* KC = WSP(bf16_t, OFF_KC);
    const bf16_t* W2t = WSP(bf16_t, OFF_W_CMP2) + (size_t)slot * 2 * 64 * 256;
    const float* b2 = inptr(F, I_NSA_CMP_B2) + (size_t)slot * 2 * 64;
    int lane = F.lane; asm volatile("; phase-local lane" : "+v"(lane));
    const int fr = lane & 15, fg = lane >> 4, gw = F.bx * 8 + F.wave, NGW = F.G * 8;
    for (int blk = gw; blk < 2 * 1024; blk += NGW) {
        const int j = blk >> 10, r0 = (blk & 1023) * 16;
        const bf16_t* A = HC + ((size_t)j * 16384 + r0 + fr) * 256 + 8 * fg;
        const bf16_t* B = W2t + ((size_t)j * 64 + fr) * 256 + 8 * fg;
        f32x4 acc[4];
#pragma unroll
        for (int t = 0; t < 4; ++t) acc[t] = (f32x4){0.f, 0.f, 0.f, 0.f};
#pragma unroll
        for (int ks = 0; ks < 8; ++ks) { const bf16x8 a = *(const bf16x8*)(A + 32 * ks);
#pragma unroll
            for (int t = 0; t < 4; ++t) acc[t] = __builtin_amdgcn_mfma_f32_16x16x32_bf16(*(const bf16x8*)(B + (size_t)t * 16 * 256 + 32 * ks), a, acc[t], 0, 0, 0); }
        const int row = r0 + fr;
#pragma unroll
        for (int t = 0; t < 4; ++t) { const int d0 = 16 * t + 4 * fg; const f32x4 bv = *(const f32x4*)(b2 + j * 64 + d0);
            f32x4 v = acc[t] + bv; if ((row & 127) == 127) v = (f32x4){0.f, 0.f, 0.f, 0.f};
            u32x2 w; w.x = pg8::cvt_pk_bf16(v[0], v[1]); w.y = pg8::cvt_pk_bf16(v[2], v[3]);
            *(u32x2*)(KC + ((size_t)j * 16384 + row) * 64 + d0) = w; }
    }
}
typedef float f32x16 __attribute__((ext_vector_type(16)));
#define PP_SYNC() do { __builtin_amdgcn_sched_barrier(0); __syncthreads(); __builtin_amdgcn_sched_barrier(0); } while (0)
#ifndef SP_SCALAR
#define SP_SCALAR 0
#endif
#ifndef SP_FILL
#define SP_FILL 12
#endif
#ifndef XCMP
#define XCMP 0
#endif
#ifndef XSELN
#define XSELN 0
#endif
#ifndef XOUT
#define XOUT 0
#endif
namespace na {
constexpr int KP = 144;
constexpr int VP = 144;
__device__ __forceinline__ int vcol(int key) { return (key & ~15) | (key & 3) | ((key & 8) >> 1) | ((key & 4) << 1); }
constexpr int TILEB = 64 * KP;
constexpr int L_K = 0, L_V = 2 * TILEB, L_PQ = 4 * TILEB, SLB = 64 * 33, L_SEL = L_PQ + 4 * SLB * 4, L_OA = L_SEL + 4864;
constexpr float NEG = -1e30f;
constexpr float C1 = 0.125f * 1.4426950408889634f;
__device__ __forceinline__ int crow(int r, int hi) { return (r & 3) + 8 * (r >> 2) + 4 * hi; }
__device__ __forceinline__ bf16x8 pack8(const f32x16& p, int s1) {
    u32x4 w; w.x = pg8::cvt_pk_bf16(p[8 * s1 + 0], p[8 * s1 + 1]); w.y = pg8::cvt_pk_bf16(p[8 * s1 + 2], p[8 * s1 + 3]);
    w.z = pg8::cvt_pk_bf16(p[8 * s1 + 4], p[8 * s1 + 5]); w.w = pg8::cvt_pk_bf16(p[8 * s1 + 6], p[8 * s1 + 7]);
    return __builtin_bit_cast(bf16x8, w);
}
__device__ __forceinline__ void qk(f32x16& p0, f32x16& p1, const LAS unsigned char* Kt, const bf16x8 (&qf)[4], int r, int h) {
    const f32x16 z = {0.f, 0.f, 0.f, 0.f, 0.f, 0.f, 0.f, 0.f, 0.f, 0.f, 0.f, 0.f, 0.f, 0.f, 0.f, 0.f};
    bf16x8 a0[4], a1[4];
#pragma unroll
    for (int s = 0; s < 4; ++s) { a0[s] = *(const LAS bf16x8*)(Kt + r * KP + (16 * s + 8 * h) * 2); a1[s] = *(const LAS bf16x8*)(Kt + (32 + r) * KP + (16 * s + 8 * h) * 2); }
    __builtin_amdgcn_sched_barrier(0);
#pragma unroll
    for (int s = 0; s < 4; ++s) {
        p0 = __builtin_amdgcn_mfma_f32_32x32x16_bf16(a0[s], qf[s], s == 0 ? z : p0, 0, 0, 0);
        p1 = __builtin_amdgcn_mfma_f32_32x32x16_bf16(a1[s], qf[s], s == 0 ? z : p1, 0, 0, 0);
    }
}
__device__ __forceinline__ void pv(f32x16& o0, f32x16& o1, const LAS unsigned char* Vt, const f32x16& p0, const f32x16& p1, int r, int h) {
#pragma unroll
    for (int s = 0; s < 4; ++s) {
        const int s1 = s & 1;
        const bf16x8 bfrag = (s < 2) ? pack8(p0, s1) : pack8(p1, s1);
        const int key0 = 32 * (s >> 1) + 16 * s1 + 4 * h;
#pragma unroll
        for (int dh = 0; dh < 2; ++dh) {
            const bf16x8 a = *(const LAS bf16x8*)(Vt + (32 * dh + r) * VP + (key0 - 4 * h + 8 * h) * 2);
            if (dh == 0) o0 = __builtin_amdgcn_mfma_f32_32x32x16_bf16(a, bfrag, o0, 0, 0, 0);
            else o1 = __builtin_amdgcn_mfma_f32_32x32x16_bf16(a, bfrag, o1, 0, 0, 0);
        }
    }
}
__device__ __forceinline__ void pack_p(bf16x8 (&pb)[4], const f32x16& p0, const f32x16& p1) { pb[0] = pack8(p0, 0); pb[1] = pack8(p0, 1); pb[2] = pack8(p1, 0); pb[3] = pack8(p1, 1); }
__device__ __forceinline__ void pv2(f32x16& o0, f32x16& o1, const LAS unsigned char* Vt, const bf16x8 (&pb)[4], int r, int h) {
    bf16x8 a[4][2];
#pragma unroll
    for (int s = 0; s < 4; ++s) {
        const int key0 = 32 * (s >> 1) + 16 * (s & 1) + 4 * h;
#pragma unroll
        for (int dh = 0; dh < 2; ++dh) {
            a[s][dh] = *(const LAS bf16x8*)(Vt + (32 * dh + r) * VP + (key0 - 4 * h + 8 * h) * 2);
        }
    }
    __builtin_amdgcn_sched_barrier(0);
#pragma unroll
    for (int s = 0; s < 4; ++s) {
        o0 = __builtin_amdgcn_mfma_f32_32x32x16_bf16(a[s][0], pb[s], o0, 0, 0, 0);
        o1 = __builtin_amdgcn_mfma_f32_32x32x16_bf16(a[s][1], pb[s], o1, 0, 0, 0);
    }
}
__device__ __forceinline__ void softmax_step(f32x16& p0, f32x16& p1, float& m, float& l, f32x16& o0, f32x16& o1, bool lane_on = true) {
    constexpr float THR = 8.0f / C1;
    float mx = fmaxf(fmaxf(fmaxf(p0[0], p1[5]), fmaxf(p0[10], p1[15])), fmaxf(fmaxf(p1[0], p0[5]), fmaxf(p1[10], p0[15])));
    mx = lane_on ? mx : NEG;
    mx = fmaxf(mx, __shfl_xor(mx, 32));
    const float mn = (mx > m + THR) ? mx : m;
    const float muse = (mn < -1e29f) ? 0.f : mn;
    const bool grow = mn != m;
    const float mc = lane_on ? muse * C1 : 3.0e38f;
    f32x2 lsa = {0.f, 0.f}, lsb = {0.f, 0.f}; const f32x2 c1v = {C1, C1}, nmc = {-mc, -mc};
#pragma unroll
    for (int i = 0; i < 8; ++i) {
        f32x2 a = {p0[2 * i], p0[2 * i + 1]}, b = {p1[2 * i], p1[2 * i + 1]};
        a = __builtin_elementwise_fma(a, c1v, nmc); b = __builtin_elementwise_fma(b, c1v, nmc);
        a.x = __builtin_amdgcn_exp2f(a.x); a.y = __builtin_amdgcn_exp2f(a.y); b.x = __builtin_amdgcn_exp2f(b.x); b.y = __builtin_amdgcn_exp2f(b.y);
        p0[2 * i] = a.x; p0[2 * i + 1] = a.y; p1[2 * i] = b.x; p1[2 * i + 1] = b.y; lsa += a; lsb += b; }
    const float ls = (lsa.x + lsa.y) + (lsb.x + lsb.y);
    if (__builtin_amdgcn_ballot_w64(grow) != 0ull) {
        const float alpha = __builtin_amdgcn_exp2f((((m < -1e29f) ? 0.f : m) - muse) * C1);
        l = l * alpha;
#pragma unroll
        for (int i = 0; i < 16; ++i) { o0[i] *= alpha; o1[i] *= alpha; }
        m = mn;
    }
    l += ls;
}
__device__ __forceinline__ void softmax_heavy(f32x16& p0, f32x16& p1, const float m, float& l, float& mxraw, bool lane_on) {
    const float mx = fmaxf(fmaxf(fmaxf(p0[0], p1[5]), fmaxf(p0[10], p1[15])), fmaxf(fmaxf(p1[0], p0[5]), fmaxf(p1[10], p0[15])));
    mxraw = lane_on ? mx : NEG;
    const float muse = (m < -1e29f) ? 0.f : m;
    const float mc = lane_on ? muse * C1 : 3.0e38f;
#if SP_SCALAR
    float ls0 = 0.f, ls1 = 0.f;
#pragma unroll
    for (int i = 0; i < 16; ++i) { p0[i] = __builtin_amdgcn_exp2f(p0[i] * C1 - mc); p1[i] = __builtin_amdgcn_exp2f(p1[i] * C1 - mc); ls0 += p0[i]; ls1 += p1[i]; }
    l += ls0 + ls1;
#else
    f32x2 lsa = {0.f, 0.f}, lsb = {0.f, 0.f}; const f32x2 c1v = {C1, C1}, nmc = {-mc, -mc};
#pragma unroll
    for (int i = 0; i < 8; ++i) {
        f32x2 a = {p0[2 * i], p0[2 * i + 1]}, b = {p1[2 * i], p1[2 * i + 1]};
        a = __builtin_elementwise_fma(a, c1v, nmc); b = __builtin_elementwise_fma(b, c1v, nmc);
        a.x = __builtin_amdgcn_exp2f(a.x); a.y = __builtin_amdgcn_exp2f(a.y); b.x = __builtin_amdgcn_exp2f(b.x); b.y = __builtin_amdgcn_exp2f(b.y);
        p0[2 * i] = a.x; p0[2 * i + 1] = a.y; p1[2 * i] = b.x; p1[2 * i + 1] = b.y; lsa += a; lsb += b; }
    l += (lsa.x + lsa.y) + (lsb.x + lsb.y);
#endif
}
__device__ __forceinline__ void softmax_light(float mxraw, float& m, float& l, f32x16& o0, f32x16& o1) {
    constexpr float THR = 8.0f / C1;
    const float mx = fmaxf(mxraw, __shfl_xor(mxraw, 32));
    const float mn = (mx > m + THR) ? mx : m;
    if (__builtin_amdgcn_ballot_w64(mn != m) != 0ull) {
        const float alpha = __builtin_amdgcn_exp2f((((m < -1e29f) ? 0.f : m) - ((mn < -1e29f) ? 0.f : mn)) * C1);
        l = l * alpha;
#pragma unroll
        for (int i = 0; i < 16; ++i) { o0[i] *= alpha; o1[i] *= alpha; }
        m = mn;
    }
}
struct Stage { u32x4 k, v; };
__device__ __forceinline__ void stage_load(Stage& st, const bf16_t* ksrc, const bf16_t* vsrc, long stride, int tid) {
    const int key = tid >> 3, dc = tid & 7, vkey = tid & 63, vdc = tid >> 6;
    st.k = *(const u32x4*)(ksrc + (long)key * stride + dc * 8); st.v = *(const u32x4*)(vsrc + (long)vkey * stride + vdc * 8);
}
__device__ __forceinline__ void stage_store(const Stage& st, LAS unsigned char* Kt, LAS unsigned char* Vt, int tid) {
    const int key = tid >> 3, dc = tid & 7, vkey = tid & 63, vdc = tid >> 6;
    *(LAS u32x4*)(Kt + key * KP + dc * 16) = st.k;
    const unsigned w[4] = {st.v.x, st.v.y, st.v.z, st.v.w};
#pragma unroll
    for (int e = 0; e < 4; ++e) { *(LAS unsigned short*)(Vt + (vdc * 8 + 2 * e) * VP + vcol(vkey) * 2) = (unsigned short)(w[e] & 0xffffu); *(LAS unsigned short*)(Vt + (vdc * 8 + 2 * e + 1) * VP + vcol(vkey) * 2) = (unsigned short)(w[e] >> 16); }
}
__device__ __forceinline__ void pp_load(u32x4 (&sg)[2], const bf16_t* src, long stride, int t256, int kind) {
    if (kind == 0) {
#pragma unroll
        for (int j = 0; j < 2; ++j) { const int c = t256 + 256 * j; sg[j] = *(const u32x4*)(src + (long)(c >> 3) * stride + (c & 7) * 8); }
    } else {
#pragma unroll
        for (int j = 0; j < 2; ++j) { const int c = t256 + 256 * j; sg[j] = *(const u32x4*)(src + (long)(c & 63) * stride + (c >> 6) * 8); }
    }
}
__device__ __forceinline__ void pp_store(const u32x4 (&sg)[2], LAS unsigned char* Kt, LAS unsigned char* Vt, int t256, int kind) {
    if (kind == 0) {
#pragma unroll
        for (int j = 0; j < 2; ++j) { const int c = t256 + 256 * j; *(LAS u32x4*)(Kt + (c >> 3) * KP + (c & 7) * 16) = sg[j]; }
    } else {
#pragma unroll
        for (int j = 0; j < 2; ++j) { const int c = t256 + 256 * j, vkey = c & 63, vdc = c >> 6; const unsigned w[4] = {sg[j].x, sg[j].y, sg[j].z, sg[j].w};
#pragma unroll
            for (int e = 0; e < 4; ++e) { *(LAS unsigned short*)(Vt + (vdc * 8 + 2 * e) * VP + vcol(vkey) * 2) = (unsigned short)(w[e] & 0xffffu); *(LAS unsigned short*)(Vt + (vdc * 8 + 2 * e + 1) * VP + vcol(vkey) * 2) = (unsigned short)(w[e] >> 16); } }
    }
}
template <int BR> __device__ __forceinline__ int pp_next(int kb, unsigned live) {
    if (BR == 1) return kb + 1;
    const unsigned rem = live & ~((2u << kb) - 1u);
    return rem ? __builtin_ctz(rem) : 32;
}
template <int BR>
__device__ __forceinline__ void pp_soft(f32x16& p0, f32x16& p1, int h, int kb, int qb, int qq, const LAS unsigned* selm, const float m, float& l, float& mxraw) {
    bool mine = true;
    if (BR == 0) mine = (selm[qq] >> kb) & 1u;
    if (kb == qb) {
#pragma unroll
        for (int e = 0; e < 16; ++e) { const int kk = crow(e, h); if (kk > qq) p0[e] = NEG; if (kk + 32 > qq) p1[e] = NEG; }
    } else if (BR == 1 && kb == qb - 8) {
#pragma unroll
        for (int e = 0; e < 16; ++e) { const int kk = crow(e, h); if (kk <= qq) p0[e] = NEG; if (kk + 32 <= qq) p1[e] = NEG; }
    }
    softmax_heavy(p0, p1, m, l, mxraw, mine);
}
template <int BR, bool PRE>
__device__ __forceinline__ void pp_stream(LAS unsigned char* lds, const bf16_t* Pb, int ld, int g, int qb, int qq, int qh, int t256, int r, int h, unsigned live, const LAS unsigned* selm,
                                          const bf16x8 (&qf)[4], u32x4 (&sg)[2], f32x16& o0, f32x16& o1, float& m, float& l) {
    const int kind = qh ^ 1;
    const int soff = (BR == 0 ? (kind == 0 ? 1536 : 1792) : (kind == 0 ? 2048 : 2304)) + g * 64;
    const int first = BR == 0 ? 0 : (qb > 8 ? qb - 8 : 0);
    const int n = BR == 0 ? __builtin_popcount(live) : (qb - first + 1);
    int kb_load = first;
    if (!PRE) pp_load(sg, Pb + (size_t)(kb_load * 64) * ld + soff, ld, t256, kind);
    kb_load = pp_next<BR>(kb_load, live);
    pp_store(sg, lds + L_K, lds + L_V, t256, kind);
    { const int kc = kb_load < qb ? kb_load : qb; pp_load(sg, Pb + (size_t)(kc * 64) * ld + soff, ld, t256, kind); kb_load = pp_next<BR>(kb_load, live); }
    __syncthreads();
    int kb = first;
    f32x16 p0, p1; float mxraw = NEG; bf16x8 pb[4];
    if (qh == 0) {
        qk(p0, p1, lds + L_K, qf, r, h);
#pragma unroll 1
        for (int i = 0; i < n; ++i) {
            pp_soft<BR>(p0, p1, h, kb, qb, qq, selm, m, l, mxraw);
            pack_p(pb, p0, p1);
            kb = pp_next<BR>(kb, live);
            PP_SYNC();
            if (i + 1 < n) pp_store(sg, lds + L_K + ((i + 1) & 1) * TILEB, lds + L_V + ((i + 1) & 1) * TILEB, t256, kind);
            { const int kc = kb_load < qb ? kb_load : qb; pp_load(sg, Pb + (size_t)(kc * 64) * ld + soff, ld, t256, kind); kb_load = pp_next<BR>(kb_load, live); }
            if (i + 1 < n) qk(p0, p1, lds + L_K + ((i + 1) & 1) * TILEB, qf, r, h);
            pv2(o0, o1, lds + L_V + (i & 1) * TILEB, pb, r, h);
            softmax_light(mxraw, m, l, o0, o1);
            PP_SYNC();
        }
    } else {
#pragma unroll 1
        for (int i = 0; i < n; ++i) {
            qk(p0, p1, lds + L_K + (i & 1) * TILEB, qf, r, h);
            if (i > 0) { pv2(o0, o1, lds + L_V + ((i - 1) & 1) * TILEB, pb, r, h); softmax_light(mxraw, m, l, o0, o1); }
            if (i + 1 < n) pp_store(sg, lds + L_K + ((i + 1) & 1) * TILEB, lds + L_V + ((i + 1) & 1) * TILEB, t256, kind);
            { const int kc = kb_load < qb ? kb_load : qb; pp_load(sg, Pb + (size_t)(kc * 64) * ld + soff, ld, t256, kind); kb_load = pp_next<BR>(kb_load, live); }
            PP_SYNC();
            pp_soft<BR>(p0, p1, h, kb, qb, qq, selm, m, l, mxraw);
            pack_p(pb, p0, p1);
            kb = pp_next<BR>(kb, live);
            PP_SYNC();
        }
        pv2(o0, o1, lds + L_V + ((n - 1) & 1) * TILEB, pb, r, h);
    }
}
__device__ __forceinline__ void st_store_k(const u32x4& k, LAS unsigned char* Kt, int tid) { const int key = tid >> 3, dc = tid & 7; *(LAS u32x4*)(Kt + key * KP + dc * 16) = k; }
__device__ __forceinline__ void st_store_v(const u32x4& v, LAS unsigned char* Vt, int tid) {
    const int vkey = tid & 63, vdc = tid >> 6; const unsigned w[4] = {v.x, v.y, v.z, v.w};
#pragma unroll
    for (int e = 0; e < 4; ++e) { *(LAS unsigned short*)(Vt + (vdc * 8 + 2 * e) * VP + vcol(vkey) * 2) = (unsigned short)(w[e] & 0xffffu); *(LAS unsigned short*)(Vt + (vdc * 8 + 2 * e + 1) * VP + vcol(vkey) * 2) = (unsigned short)(w[e] >> 16); }
}
__device__ __forceinline__ u32x4 st_load_k(const bf16_t* ksrc, long stride, int tid) { return *(const u32x4*)(ksrc + (long)(tid >> 3) * stride + (tid & 7) * 8); }
__device__ __forceinline__ u32x4 st_load_v(const bf16_t* vsrc, long stride, int tid) { return *(const u32x4*)(vsrc + (long)(tid & 63) * stride + (tid >> 6) * 8); }
template <int BR>
__device__ __forceinline__ void sp_mask(f32x16& p0, f32x16& p1, int h, int kb, int qb, int qq) {
    if (kb == qb) {
#pragma unroll
        for (int e = 0; e < 16; ++e) { const int kk = crow(e, h); if (kk > qq) p0[e] = NEG; if (kk + 32 > qq) p1[e] = NEG; }
    } else if (BR == 1 && kb == qb - 8) {
#pragma unroll
        for (int e = 0; e < 16; ++e) { const int kk = crow(e, h); if (kk <= qq) p0[e] = NEG; if (kk + 32 <= qq) p1[e] = NEG; }
    }
}
template <int BR, bool PRE>
__device__ __forceinline__ void sp_stream(LAS unsigned char* lds, const bf16_t* Pb, int ld, int g, int qb, int qq, int tid, int r, int h, unsigned live, const LAS unsigned* selm,
                                          const bf16x8 (&qf)[4], Stage& st, f32x16& o0, f32x16& o1, float& m, float& l) {
    const int koff = (BR == 0 ? 1536 : 2048) + g * 64, voff = (BR == 0 ? 1792 : 2304) + g * 64;
    const int first = BR == 0 ? 0 : (qb > 8 ? qb - 8 : 0);
    const int n = BR == 0 ? __builtin_popcount(live) : (qb - first + 1);
    int kbK = first, kbV = first;
    if (!PRE) stage_load(st, Pb + (size_t)(first * 64) * ld + koff, Pb + (size_t)(first * 64) * ld + voff, ld, tid);
    kbK = pp_next<BR>(kbK, live); kbV = kbK;
    Stage s1; { const int kc = kbK < qb ? kbK : qb; stage_load(s1, Pb + (size_t)(kc * 64) * ld + koff, Pb + (size_t)(kc * 64) * ld + voff, ld, tid); }
    kbK = pp_next<BR>(kbK, live); kbV = kbK;
    stage_store(st, lds + L_K, lds + L_V, tid);
    st_store_k(s1.k, lds + L_K + TILEB, tid); st.v = s1.v;
    { const int kc = kbK < qb ? kbK : qb; st.k = st_load_k(Pb + (size_t)(kc * 64) * ld + koff, ld, tid); kbK = pp_next<BR>(kbK, live); }
    __syncthreads();
    f32x16 p0, p1; float mxraw = NEG; bf16x8 pb[4];
    qk(p0, p1, lds + L_K, qf, r, h);
    int kb = first, rk1 = 1, rk2 = 2;
#pragma unroll 1
    for (int i = 0; i < n; ++i) {
        if (i + 2 < n) st_store_k(st.k, lds + (rk2 == 2 ? L_PQ : L_K + rk2 * TILEB), tid);
        if (i + 1 < n) st_store_v(st.v, lds + L_V + ((i + 1) & 1) * TILEB, tid);
        { const int kc = kbK < qb ? kbK : qb, vc = kbV < qb ? kbV : qb;
          st.k = st_load_k(Pb + (size_t)(kc * 64) * ld + koff, ld, tid); st.v = st_load_v(Pb + (size_t)(vc * 64) * ld + voff, ld, tid); kbK = pp_next<BR>(kbK, live); kbV = pp_next<BR>(kbV, live); }
        bool mine = true;
        if (BR == 0) mine = (selm[qq] >> kb) & 1u;
        sp_mask<BR>(p0, p1, h, kb, qb, qq);
        f32x16 n0, n1;
        {
            const LAS unsigned char* Kt = lds + (rk1 == 2 ? L_PQ : L_K + rk1 * TILEB);
            const f32x16 z = {0.f, 0.f, 0.f, 0.f, 0.f, 0.f, 0.f, 0.f, 0.f, 0.f, 0.f, 0.f, 0.f, 0.f, 0.f, 0.f};
            bf16x8 a0[4], a1[4];
#pragma unroll
            for (int s = 0; s < 4; ++s) { a0[s] = *(const LAS bf16x8*)(Kt + r * KP + (16 * s + 8 * h) * 2); a1[s] = *(const LAS bf16x8*)(Kt + (32 + r) * KP + (16 * s + 8 * h) * 2); }
            __builtin_amdgcn_sched_barrier(0);
#pragma unroll
            for (int s = 0; s < 4; ++s) {
                n0 = __builtin_amdgcn_mfma_f32_32x32x16_bf16(a0[s], qf[s], s == 0 ? z : n0, 0, 0, 0);
                n1 = __builtin_amdgcn_mfma_f32_32x32x16_bf16(a1[s], qf[s], s == 0 ? z : n1, 0, 0, 0);
            }
            softmax_heavy(p0, p1, m, l, mxraw, mine);
            pack_p(pb, p0, p1);
#pragma unroll
            for (int j = 0; j < 8; ++j) { __builtin_amdgcn_sched_group_barrier(0x008, 1, 0); __builtin_amdgcn_sched_group_barrier(0x002, SP_FILL, 0); }
            __builtin_amdgcn_sched_barrier(0);
        }
        pv2(o0, o1, lds + L_V + (i & 1) * TILEB, pb, r, h);
        softmax_light(mxraw, m, l, o0, o1);
        p0 = n0; p1 = n1; kb = pp_next<BR>(kb, live); rk1 = rk2; rk2 = rk2 == 2 ? 0 : rk2 + 1;
        __syncthreads();
    }
}
}

__device__ __forceinline__ void phase_nsa_attn_mfma(Frame& F, int slot) {
    using namespace na;
    const bf16_t* P = WSP(bf16_t, OFF_PROJ); bf16_t* ATT = WSP(bf16_t, OFF_ATT);
    const bf16_t* KCb = WSP(bf16_t, OFF_KC); const bf16_t* VCb = KCb + (size_t)128 * 128 * 64;
    const float* gb = inptr(F, I_NSA_GATE_B) + slot * 48;
    int tid = F.tid; asm volatile("; phase-local tid" : "+v"(tid));
    const int wave = __builtin_amdgcn_readfirstlane(tid >> 6), lane = tid & 63, r = lane & 31, h = lane >> 5, hh = wave & 3, qh = wave >> 2;
    const int t256 = tid & 255;
    LAS unsigned char* lds = F.lds;
    LAS float* Pq = (LAS float*)(lds + L_PQ); LAS unsigned* selm = (LAS unsigned*)(lds + L_SEL);
    const int ld = NSA_LD;
    const int qq = qh * 32 + r;
#pragma unroll 1
    for (int it = F.bx; it < 4096; it += F.G) {
        const int sl = it & 255, rnd = it >> 8, bg = sl >> 1, par = sl & 1, qb = (rnd & 1) ? (31 - 2 * (rnd >> 1) - par) : (2 * (rnd >> 1) + par);
        const int b = bg >> 2, g = bg & 3, t = qb * 64 + qq;
        const bf16_t* Pb = P + (size_t)b * T * ld;
        const bf16_t* prow = Pb + (size_t)t * ld;
        bf16x8 qf[4];
#pragma unroll
        for (int s = 0; s < 4; ++s) qf[s] = *(const bf16x8*)(prow + g * 256 + hh * 64 + 16 * s + 8 * h);
        float gt[3];
#pragma unroll
        for (int j = 0; j < 3; ++j) gt[j] = sigmoidf_(bf2f(prow[2560 + g * 12 + hh * 3 + j]) + gb[g * 12 + hh * 3 + j]);
        LAS float* gsave = (LAS float*)(lds + L_SEL + 512) + tid * 2; gsave[0] = gt[1]; gsave[1] = gt[2];
        if (tid == 0) selm[64] = 0u;
        Stage st0, st1;
        stage_load(st0, KCb + (size_t)bg * 128 * 64, VCb + (size_t)bg * 128 * 64, 64, tid);
        stage_load(st1, KCb + (size_t)bg * 128 * 64 + 64 * 64, VCb + (size_t)bg * 128 * 64 + 64 * 64, 64, tid);
        stage_store(st0, lds + L_K, lds + L_V, tid);
        stage_store(st1, lds + L_K + TILEB, lds + L_V + TILEB, tid);
        __syncthreads();
        LAS float* oaL = (LAS float*)(lds + L_OA) + tid;
#pragma unroll 1
        for (int xr_ = 0; xr_ <= XCMP; ++xr_)
        {
            const int cmax = (t >= 31) ? (((t - 31) >> 4) < 126 ? ((t - 31) >> 4) : 126) : -1;
            f32x16 o0, o1; float m = NEG, l = 0.f;
#pragma unroll
            for (int i = 0; i < 16; ++i) { o0[i] = 0.f; o1[i] = 0.f; }
#pragma unroll 1
            for (int tl = 0; tl < 2; ++tl) {
                f32x16 p0, p1;
                qk(p0, p1, lds + L_K + tl * TILEB, qf, r, h);
#pragma unroll
                for (int i = 0; i < 16; ++i) { const int c = 64 * tl + crow(i, h); if (c > cmax) p0[i] = NEG; if (c + 32 > cmax) p1[i] = NEG; }
                softmax_step(p0, p1, m, l, o0, o1);
                pv(o0, o1, lds + L_V + tl * TILEB, p0, p1, r, h);
            }
            l += __shfl_xor(l, 32);
            const float inv = l > 0.f ? 1.0f / l : 0.f;
            const float cf = gt[0] * inv;
#pragma unroll
            for (int i = 0; i < 16; ++i) { oaL[512 * i] = cf * o0[i]; oaL[512 * (16 + i)] = cf * o1[i]; }
            const float mc = ((m < -1e29f) ? 0.f : m) * C1;
            LAS float* slab = Pq + hh * SLB + qq * 33;
#pragma unroll 1
            for (int tl = 1; tl >= 0; --tl) {
                f32x16 p0, p1;
                qk(p0, p1, lds + L_K + tl * TILEB, qf, r, h);
#pragma unroll
                for (int i = 0; i < 16; ++i) { const int c = 64 * tl + crow(i, h);
                    p0[i] = (c > cmax) ? 0.f : __builtin_amdgcn_exp2f(p0[i] * C1 - mc) * inv; p1[i] = (c + 32 > cmax) ? 0.f : __builtin_amdgcn_exp2f(p1[i] * C1 - mc) * inv; }
#pragma unroll
                for (int k = 0; k < 4; ++k) {
                    slab[16 * tl + 2 * k + h] = 2.0f * (p0[4 * k] + p0[4 * k + 1] + p0[4 * k + 2]) + p0[4 * k + 3];
                    slab[16 * tl + 8 + 2 * k + h] = 2.0f * (p1[4 * k] + p1[4 * k + 1] + p1[4 * k + 2]) + p1[4 * k + 3]; }
                LDS_WAIT();
#pragma unroll
                for (int k = 0; k < 4; ++k) { const int s0 = 16 * tl + 2 * k + h + 1, s1 = 16 * tl + 8 + 2 * k + h + 1;
                    slab[s0] += p0[4 * k + 3]; if (s1 < 32) slab[s1] += p1[4 * k + 3]; }
                LDS_WAIT();
            }
        }
        __syncthreads();
        Stage st;
        stage_load(st, Pb + 1536 + g * 64, Pb + 1792 + g * 64, ld, tid);
#pragma unroll 1
        for (int xr_ = 0; xr_ <= XSELN; ++xr_)
        {
            const int cur = qb, q = tid >> 3, sub = tid & 7;
            float scv[4];
#pragma unroll
            for (int j = 0; j < 4; ++j) { const int s_ = 4 * sub + j; const LAS float* pr = Pq + q * 33 + s_;
                const float imp = (pr[0] + pr[SLB]) + (pr[2 * SLB] + pr[3 * SLB]);
                const bool forced = (s_ == 0) || (s_ == cur) || (s_ == cur - 1);
                scv[j] = forced ? 1e30f : (s_ <= cur ? imp : NEG); }
            unsigned mask = 0u;
#pragma unroll 1
            for (int rd = 0; rd < 8; ++rd) {
                float bv = scv[0]; int bi = 4 * sub;
#pragma unroll
                for (int j = 1; j < 4; ++j) if (scv[j] > bv) { bv = scv[j]; bi = 4 * sub + j; }
#define SEL_STEP(CTRL) { const float ov = dppf<CTRL>(bv); const int oi = __float_as_int(dppf<CTRL>(__int_as_float(bi))); if (ov > bv || (ov == bv && oi < bi)) { bv = ov; bi = oi; } }
                SEL_STEP(0xB1) SEL_STEP(0x4E) SEL_STEP(0x141)
#undef SEL_STEP
                if (bv > -0.5e30f) mask |= 1u << bi;
#pragma unroll
                for (int j = 0; j < 4; ++j) if (bi == 4 * sub + j) scv[j] = -INFINITY;
            }
            if (sub == 0) selm[q] = mask;
            unsigned any = mask;
#pragma unroll
            for (int o = 8; o < 64; o <<= 1) any |= __shfl_xor(any, o);
            if (lane == 0) __hip_atomic_fetch_or(selm + 64, any, __ATOMIC_RELAXED, __HIP_MEMORY_SCOPE_WORKGROUP);
            __syncthreads();
        }
        const unsigned anymask = __builtin_amdgcn_readfirstlane(selm[64]);
        {
            f32x16 o0, o1; float m = NEG, l = 0.f;
#pragma unroll
            for (int i = 0; i < 16; ++i) { o0[i] = 0.f; o1[i] = 0.f; }
            const unsigned live = anymask & (qb == 31 ? 0xffffffffu : ((2u << qb) - 1u));
            sp_stream<0, true>(lds, Pb, ld, g, qb, qq, tid, r, h, live, selm, qf, st, o0, o1, m, l);
            l += __shfl_xor(l, 32);
            const float cf = l > 0.f ? gsave[0] / l : 0.f;
#pragma unroll
            for (int i = 0; i < 16; ++i) { oaL[512 * i] += cf * o0[i]; oaL[512 * (16 + i)] += cf * o1[i]; }
        }
        __syncthreads();
        {
            f32x16 o0, o1; float m = NEG, l = 0.f;
#pragma unroll
            for (int i = 0; i < 16; ++i) { o0[i] = 0.f; o1[i] = 0.f; }
            sp_stream<1, false>(lds, Pb, ld, g, qb, qq, tid, r, h, 0u, selm, qf, st, o0, o1, m, l);
            l += __shfl_xor(l, 32);
            const float cf = l > 0.f ? gsave[1] / l : 0.f;
#pragma unroll
            for (int i = 0; i < 16; ++i) { o0[i] = oaL[512 * i] + cf * o0[i]; o1[i] = oaL[512 * (16 + i)] + cf * o1[i]; }
            bf16_t* orow = ATT + (size_t)(b * T + t) * D + (g * 4 + hh) * 64 + 4 * h;
#pragma unroll 1
            for (int xr_ = 0; xr_ <= XOUT; ++xr_)
#pragma unroll
            for (int k = 0; k < 4; ++k) {
                u32x2 w0, w1; w0.x = pg8::cvt_pk_bf16(o0[4 * k], o0[4 * k + 1]); w0.y = pg8::cvt_pk_bf16(o0[4 * k + 2], o0[4 * k + 3]);
                w1.x = pg8::cvt_pk_bf16(o1[4 * k], o1[4 * k + 1]); w1.y = pg8::cvt_pk_bf16(o1[4 * k + 2], o1[4 * k + 3]);
                *(u32x2*)(orow + 8 * k) = w0; *(u32x2*)(orow + 32 + 8 * k) = w1;
            }
        }
        __syncthreads();
    }
}
__device__ __forceinline__ float logsigmoidf_(float x) { return fminf(x, 0.f) - log1pf(__expf(-fabsf(x))); }
__device__ __forceinline__ void phase_mlstm_scan(Frame& F) {
    constexpr int QP = 132;
    LAS float* qL = (LAS float*)F.lds;
    LAS float* kL = qL + 64 * QP;
    LAS float* vL = kL + 64 * QP;
    LAS float* SL = vL + 64 * 128;
    LAS float* vec = SL + 64 * 68;
    LAS float* bL = vec;
    LAS float* liL = vec + 64;
    LAS float* mtL = vec + 128;
    LAS float* wiL = vec + 192;
    LAS float* dnL = vec + 256;
    LAS float* wkL = vec + 320;
    LAS float* nL = vec + 384;
    LAS float* scl = vec + 512;
    LAS float* rsL = vec + 576;
    LAS float* qnL = vec + 640;
    const bf16_t* P = WSP(bf16_t, OFF_PROJ); bf16_t* HO = WSP(bf16_t, OFF_HM);
    int tid = F.tid; asm volatile("; phase-local tid" : "+v"(tid));
    const int lane = tid & 63, ld = ML_LD;
    int v_ = tid >> 2, kq = tid & 3;
    for (int item = F.bx; item < BATCH * 4 * 2; item += F.G) {
        const int vh = item & 1, h = (item >> 1) & 3, b = item >> 3;
        float C[32];
#pragma unroll
        for (int j = 0; j < 32; ++j) C[j] = 0.f;
        if (tid < 128) nL[tid] = 0.f;
        if (tid == 0) scl[0] = 0.f;
        __syncthreads();
#pragma unroll 1
        for (int ch = 0; ch < T / 64; ++ch) {
            asm volatile("; chunk-local" : "+v"(v_), "+v"(kq), "+v"(tid));
            const int t0 = ch * 64; const bf16_t* Pc = P + (size_t)(b * T + t0) * ld;
            {
                const int c2 = tid & 255, part = tid >> 8;
                const int col = (c2 < 128) ? (h * 128 + c2) : (512 + h * 128 + (c2 - 128));
                const float w0 = inptr(F, I_ML_CONV_W)[0 * 1024 + col], w1 = inptr(F, I_ML_CONV_W)[1 * 1024 + col], w2 = inptr(F, I_ML_CONV_W)[2 * 1024 + col], w3 = inptr(F, I_ML_CONV_W)[3 * 1024 + col], cb = inptr(F, I_ML_CONV_B)[col];
                const float scale = (c2 < 128) ? 1.0f : 0.08838834764831845f;
                const int r0 = part * 32;
                float x0 = (t0 + r0 - 3 >= 0) ? bf2f(Pc[(long)(r0 - 3) * ld + col]) : 0.f;
                float x1 = (t0 + r0 - 2 >= 0) ? bf2f(Pc[(long)(r0 - 2) * ld + col]) : 0.f;
                float x2 = (t0 + r0 - 1 >= 0) ? bf2f(Pc[(long)(r0 - 1) * ld + col]) : 0.f;
                LAS float* dst = (c2 < 128) ? (qL + c2) : (kL + (c2 - 128));
                for (int r = r0; r < r0 + 32; ++r) { const float x3 = bf2f(Pc[(long)r * ld + col]);
                    const float y = w0 * x0 + w1 * x1 + w2 * x2 + w3 * x3 + cb; dst[r * QP] = y * sigmoidf_(y) * scale; x0 = x1; x1 = x2; x2 = x3; }
                const int vc = tid & 127, vp = tid >> 7;
                for (int r = vp * 16; r < vp * 16 + 16; ++r) vL[r * 128 + vc] = bf2f(Pc[(long)r * ld + 1024 + h * 256 + vh * 128 + vc]);
                if (tid < 64) { liL[tid] = bf2f(Pc[(long)tid * ld + 3072 + h]) + inptr(F, I_ML_GATE_B)[h];
                    bL[tid] = logsigmoidf_(bf2f(Pc[(long)tid * ld + 3076 + h]) + inptr(F, I_ML_GATE_B)[4 + h]); }
            }
            __syncthreads();
            if (tid < 64) {
                float bb = bL[lane];
#pragma unroll
                for (int o = 1; o < 64; o <<= 1) { const float u = __shfl_up(bb, o); if (lane >= o) bb += u; }
                const float li = liL[lane]; float pm = li - bb;
#pragma unroll
                for (int o = 1; o < 64; o <<= 1) { const float u = __shfl_up(pm, o); if (lane >= o) pm = fmaxf(pm, u); }
                const float mprev = scl[0];
                const float mt = fmaxf(bb + mprev, bb + pm);
                const float bend = __shfl(bb, 63);
                const float decay = bend - bb + li;
                const float mnew = fmaxf(bend + mprev, wave_max(decay));
                bL[lane] = bb; mtL[lane] = mt; wiL[lane] = __expf(bb + mprev - mt); wkL[lane] = __expf(decay - mnew);
                if (lane == 0) { scl[1] = __expf(bend + mprev - mnew); scl[2] = mnew; }
            }
            __syncthreads();
            {
                const int t = tid >> 3, sg = tid & 7;
                float a[8];
#pragma unroll
                for (int j = 0; j < 8; ++j) a[j] = 0.f;
#pragma unroll 1
                for (int k4 = 0; k4 < 32; ++k4) { const f32x4 qv = *(const LAS f32x4*)(qL + t * QP + k4 * 4);
#pragma unroll
                    for (int j = 0; j < 8; ++j) { const f32x4 kv = *(const LAS f32x4*)(kL + (sg + 8 * j) * QP + k4 * 4); a[j] += (qv[0] * kv[0] + qv[1] * kv[1]) + (qv[2] * kv[2] + qv[3] * kv[3]); } }
                const float bt = bL[t], mt = mtL[t];
#pragma unroll
                for (int j = 0; j < 8; ++j) { const int s = sg + 8 * j; SL[t * 68 + s] = (s <= t) ? a[j] * __expf(bt - bL[s] + liL[s] - mt) : 0.f; }
            }
            __syncthreads();
            if (tid < 64) { float rs = 0.f; for (int s = 0; s < 64; ++s) rs += SL[tid * 68 + s]; rsL[tid] = rs; }
            else if (tid < 128) { const int t = tid - 64; float qn = 0.f; for (int k = 0; k < 128; ++k) qn += qL[t * QP + k] * nL[k]; qnL[t] = qn; }
            __syncthreads();
            if (tid < 64) { const float den = rsL[tid] + wiL[tid] * qnL[tid]; dnL[tid] = 1.0f / fmaxf(fabsf(den), __expf(-mtL[tid])); }
            __syncthreads();
            {
                float vr[16];
#pragma unroll
                for (int j = 0; j < 16; ++j) vr[j] = vL[(kq * 16 + j) * 128 + v_];
#pragma unroll 1
                for (int tg = 0; tg < 4; ++tg) {
                    float res[4];
#pragma unroll
                    for (int ti = 0; ti < 16; ++ti) { const int t = tg * 16 + ti;
                        float aC = 0.f, aS = 0.f;
#pragma unroll
                        for (int j4 = 0; j4 < 8; ++j4) { const f32x4 qv = *(const LAS f32x4*)(qL + t * QP + kq * 32 + j4 * 4);
                            aC += (qv[0] * C[j4 * 4] + qv[1] * C[j4 * 4 + 1]) + (qv[2] * C[j4 * 4 + 2] + qv[3] * C[j4 * 4 + 3]); }
#pragma unroll
                        for (int j4 = 0; j4 < 4; ++j4) { const f32x4 sv = *(const LAS f32x4*)(SL + t * 68 + kq * 16 + j4 * 4);
                            aS += (sv[0] * vr[j4 * 4] + sv[1] * vr[j4 * 4 + 1]) + (sv[2] * vr[j4 * 4 + 2] + sv[3] * vr[j4 * 4 + 3]); }
                        float tot = aS + wiL[t] * aC;
                        tot += __shfl_xor(tot, 1); tot += __shfl_xor(tot, 2);
                        tot *= dnL[t];
                        if ((ti & 3) == kq) res[ti >> 2] = tot;
                        asm volatile("" ::: "memory");
                    }
#pragma unroll
                    for (int q = 0; q < 4; ++q) { const int t = tg * 16 + q * 4 + kq; HO[(size_t)(b * T + t0 + t) * D + h * 256 + vh * 128 + v_] = (bf16_t)f2bf(res[q]); }
                }
            }
            __syncthreads();
            {
                const float cs = scl[1];
#pragma unroll
                for (int j = 0; j < 32; ++j) C[j] *= cs;
#pragma unroll 2
                for (int s = 0; s < 64; ++s) { const float a = vL[s * 128 + v_] * wkL[s];
#pragma unroll
                    for (int j4 = 0; j4 < 8; ++j4) { const f32x4 kv = *(const LAS f32x4*)(kL + s * QP + kq * 32 + j4 * 4);
                        C[j4 * 4] += a * kv[0]; C[j4 * 4 + 1] += a * kv[1]; C[j4 * 4 + 2] += a * kv[2]; C[j4 * 4 + 3] += a * kv[3]; } }
                if (tid < 128) { float nn = nL[tid] * cs; for (int s = 0; s < 64; ++s) nn += wkL[s] * kL[s * QP + tid]; nL[tid] = nn; }
                if (tid == 0) scl[0] = scl[2];
            }
            __syncthreads();
        }
    }
}
template <int HD>
__device__ __forceinline__ void phase_norm_gate(Frame& F, const float* norm_g, int ld, int gate_col0) {
    const bf16_t* HI = WSP(bf16_t, OFF_HM); const bf16_t* P = WSP(bf16_t, OFF_PROJ); bf16_t* ATT = WSP(bf16_t, OFF_ATT);
    int lane = F.lane; asm volatile("; phase-local lane" : "+v"(lane)); const int gw = F.bx * 8 + F.wave, NGW = F.G * 8;
    u32x2 hq[4], gq[4];
    f32x4 ngr[4];
#pragma unroll
    for (int j = 0; j < 4; ++j) ngr[j] = *((const f32x4*)norm_g + lane + 64 * j);
    if (gw < NTOK) { const u32x2* hr = (const u32x2*)(HI + (size_t)gw * D) + lane; const u32x2* gr = (const u32x2*)(P + (size_t)gw * ld + gate_col0) + lane;
#pragma unroll
        for (int j = 0; j < 4; ++j) { hq[j] = hr[64 * j]; gq[j] = gr[64 * j]; } }
#pragma unroll 1
    for (int m = gw; m < NTOK; m += NGW) {
        u32x2 hc[4], gc[4];
#pragma unroll
        for (int j = 0; j < 4; ++j) { hc[j] = hq[j]; gc[j] = gq[j]; }
        if (m + NGW < NTOK) { const u32x2* hr = (const u32x2*)(HI + (size_t)(m + NGW) * D) + lane; const u32x2* gr = (const u32x2*)(P + (size_t)(m + NGW) * ld + gate_col0) + lane;
#pragma unroll
            for (int j = 0; j < 4; ++j) { hq[j] = hr[64 * j]; gq[j] = gr[64 * j]; } }
        u32x2* orow = (u32x2*)(ATT + (size_t)m * D) + lane;
#pragma unroll
        for (int j = 0; j < 4; ++j) {
            const u32x2 hv = hc[j], gv = gc[j];
            float x[4] = {__uint_as_float(hv.x << 16), __uint_as_float(hv.x & 0xffff0000u), __uint_as_float(hv.y << 16), __uint_as_float(hv.y & 0xffff0000u)};
            const float gt[4] = {__uint_as_float(gv.x << 16), __uint_as_float(gv.x & 0xffff0000u), __uint_as_float(gv.y << 16), __uint_as_float(gv.y & 0xffff0000u)};
            float ss = (x[0] * x[0] + x[1] * x[1]) + (x[2] * x[2] + x[3] * x[3]);
#pragma unroll
            for (int o = 1; o < (HD == 256 ? 64 : 32); o <<= 1) ss += __shfl_xor(ss, o);
            const float r = __builtin_amdgcn_rsqf(ss * (1.0f / HD) + RMS_EPS);
            const f32x4 ng = ngr[j];
            float o4[4];
#pragma unroll
            for (int q = 0; q < 4; ++q) o4[q] = x[q] * r * ng[q] * sigmoidf_(gt[q]);
            u32x2 o; o.x = pk2(o4[0], o4[1]); o.y = pk2(o4[2], o4[3]); orow[64 * j] = o;
        }
    }
}

__device__ __forceinline__ void phase_hgrn_scan(Frame& F) {
    constexpr int QP = 132;
    LAS float* qL = (LAS float*)F.lds;
    LAS float* kL = qL + 32 * QP;
    LAS float* vL = kL + 32 * QP;
    LAS float* AL = vL + 32 * 128;
    LAS float* geL = AL + 32 * 36;
    const bf16_t* P = WSP(bf16_t, OFF_PROJ); bf16_t* HO = WSP(bf16_t, OFF_HM);
    const float* lbt = WSP(float, OFF_TAB) + TAB_LB;
    int tid = F.tid; asm volatile("; phase-local tid" : "+v"(tid));
    const int ld = HG_LD;
    int v_ = tid >> 2, kq = tid & 3;
    for (int item = F.bx; item < BATCH * 8; item += F.G) {
        const int h = item & 7, b = item >> 3;
        float S[32];
#pragma unroll
        for (int j = 0; j < 32; ++j) S[j] = 0.f;
#pragma unroll 1
        for (int ch = 0; ch < T / 32; ++ch) {
            asm volatile("; chunk-local" : "+v"(v_), "+v"(kq), "+v"(tid));
            const int t0 = ch * 32; const bf16_t* Pc = P + (size_t)(b * T + t0) * ld;
            { const int c = tid & 127, p4 = tid >> 7;
#pragma unroll 2
              for (int r = p4 * 8; r < p4 * 8 + 8; ++r) { qL[r * QP + c] = bf2f(Pc[(long)r * ld + h * 128 + c]); kL[r * QP + c] = bf2f(Pc[(long)r * ld + 1024 + h * 128 + c]); vL[r * 128 + c] = bf2f(Pc[(long)r * ld + 2048 + h * 128 + c]); } }
            __syncthreads();
            if (tid < 128) { const float lb = lbt[h * 128 + tid]; float G = 0.f;
#pragma unroll 2
                for (int r = 0; r < 32; ++r) { const float qr = qL[r * QP + tid], fr = kL[r * QP + tid];
                    const float f = lb + (1.0f - lb) * sigmoidf_(fr); G += __logf(f);
                    qL[r * QP + tid] = qr * sigmoidf_(qr) * __expf(G); kL[r * QP + tid] = (1.0f - f) * __expf(-G); }
                geL[tid] = __expf(G); }
            __syncthreads();
            { const int t = tid >> 4, sg = tid & 15;
              float a0 = 0.f, a1 = 0.f;
#pragma unroll 2
              for (int k4 = 0; k4 < 32; ++k4) { const f32x4 qv = *(const LAS f32x4*)(qL + t * QP + k4 * 4);
                  const f32x4 k0 = *(const LAS f32x4*)(kL + sg * QP + k4 * 4), k1 = *(const LAS f32x4*)(kL + (sg + 16) * QP + k4 * 4);
                  a0 += (qv[0] * k0[0] + qv[1] * k0[1]) + (qv[2] * k0[2] + qv[3] * k0[3]); a1 += (qv[0] * k1[0] + qv[1] * k1[1]) + (qv[2] * k1[2] + qv[3] * k1[3]); }
              AL[t * 36 + sg] = (sg <= t) ? a0 : 0.f; AL[t * 36 + sg + 16] = (sg + 16 <= t) ? a1 : 0.f; }
            __syncthreads();
            {
                float vr[8];
#pragma unroll
                for (int j = 0; j < 8; ++j) vr[j] = vL[(kq * 8 + j) * 128 + v_];
#pragma unroll 2
                for (int t = 0; t < 32; ++t) {
                    float a = 0.f;
#pragma unroll
                    for (int j4 = 0; j4 < 8; ++j4) { const f32x4 qv = *(const LAS f32x4*)(qL + t * QP + kq * 32 + j4 * 4);
                        a += (qv[0] * S[j4 * 4] + qv[1] * S[j4 * 4 + 1]) + (qv[2] * S[j4 * 4 + 2] + qv[3] * S[j4 * 4 + 3]); }
#pragma unroll
                    for (int j4 = 0; j4 < 2; ++j4) { const f32x4 sv = *(const LAS f32x4*)(AL + t * 36 + kq * 8 + j4 * 4);
                        a += (sv[0] * vr[j4 * 4] + sv[1] * vr[j4 * 4 + 1]) + (sv[2] * vr[j4 * 4 + 2] + sv[3] * vr[j4 * 4 + 3]); }
                    a += __shfl_xor(a, 1); a += __shfl_xor(a, 2);
                    if ((t & 3) == kq) HO[(size_t)(b * T + t0 + t) * D + h * 128 + v_] = (bf16_t)f2bf(a);
                    asm volatile("" ::: "memory");
                }
            }
            {
#pragma unroll 2
                for (int s = 0; s < 32; ++s) { const float a = vL[s * 128 + v_];
#pragma unroll
                    for (int j4 = 0; j4 < 8; ++j4) { const f32x4 kv = *(const LAS f32x4*)(kL + s * QP + kq * 32 + j4 * 4);
                        S[j4 * 4] += a * kv[0]; S[j4 * 4 + 1] += a * kv[1]; S[j4 * 4 + 2] += a * kv[2]; S[j4 * 4 + 3] += a * kv[3]; } }
#pragma unroll
                for (int j4 = 0; j4 < 8; ++j4) { const f32x4 ge = *(const LAS f32x4*)(geL + kq * 32 + j4 * 4);
                    S[j4 * 4] *= ge[0]; S[j4 * 4 + 1] *= ge[1]; S[j4 * 4 + 2] *= ge[2]; S[j4 * 4 + 3] *= ge[3]; }
            }
            __syncthreads();
        }
    }
}
namespace ml {
constexpr int PK = 272, PS = 144;
constexpr int L_Q = 0, L_KK = L_Q + 64 * PK, L_KWT = L_KK + 64 * PK, L_VT = L_KWT + 128 * PS, L_S = L_VT + 144 * PS, L_C = L_S + 64 * PS, L_VEC = L_C + 144 * PK;
typedef float f32x4_ __attribute__((ext_vector_type(4)));
__device__ __forceinline__ bf16x8 frag(const LAS unsigned char* base, int row, int pitch, int kelem) { return *(const LAS bf16x8*)(base + row * pitch + kelem * 2); }
}
__device__ __forceinline__ void phase_mlstm_scan_mfma(Frame& F) {
    using namespace ml;
    LAS unsigned char* lds = F.lds;
    LAS float* vec = (LAS float*)(lds + L_VEC);
    LAS float* bL = vec; LAS float* liL = vec + 64; LAS float* mtL = vec + 128; LAS float* wiL = vec + 192; LAS float* wkL = vec + 256; LAS float* scl = vec + 320;
    const bf16_t* P = WSP(bf16_t, OFF_PROJ); bf16_t* HO = WSP(bf16_t, OFF_HM);
    int tid = F.tid; asm volatile("; phase-local tid" : "+v"(tid));
    const int lane = tid & 63, wave = __builtin_amdgcn_readfirstlane(tid >> 6), ld = ML_LD;
    const int fr = lane & 15, fg = lane >> 4;
#pragma unroll 1
    for (int item = F.bx; item < BATCH * 4 * 2; item += F.G) {
        const int vh = item & 1, h = (item >> 1) & 3, b = item >> 3;
        f32x4 Cacc[9];
#pragma unroll
        for (int j = 0; j < 9; ++j) Cacc[j] = (f32x4){0.f, 0.f, 0.f, 0.f};
        for (int i = tid; i < 16 * 64; i += 512) { const int rr = i >> 6, s = i & 63; *(LAS unsigned short*)(lds + L_VT + (128 + rr) * PS + s * 2) = (rr == 0) ? (unsigned short)0x3F80 : (unsigned short)0; }
        for (int i = tid; i < 144 * PK / 4; i += 512) ((LAS unsigned*)(lds + L_C))[i] = 0u;
        if (tid == 0) scl[0] = 0.f;
        const int c2 = tid & 255, part = __builtin_amdgcn_readfirstlane(tid >> 8);
        const int col = (c2 < 128) ? (h * 128 + c2) : (512 + h * 128 + (c2 - 128));
        const float* cw = inptr(F, I_ML_CONV_W); const float* cbp = inptr(F, I_ML_CONV_B); const float* gbp = inptr(F, I_ML_GATE_B);
        const float w0 = cw[0 * 1024 + col], w1 = cw[1 * 1024 + col], w2 = cw[2 * 1024 + col], w3 = cw[3 * 1024 + col], cb = cbp[col];
        const float gbi = gbp[h], gbf = gbp[4 + h];
        const float qscale = (c2 < 128) ? 1.0f : 0.08838834764831845f;
        unsigned short xn[35]; u32x4 vn[2]; unsigned short gin = 0, gfn = 0;
        { const bf16_t* Pc = P + (size_t)(b * T) * ld; const int r0 = part * 32;
          const bf16_t* rp = Pc + (long)(r0 - 3) * ld;
#pragma unroll
          for (int i = 0; i < 35; ++i) { xn[i] = (r0 - 3 + i >= 0) ? rp[col] : (unsigned short)0; rp += ld; asm volatile("" : "+s"(rp)); }
          const int key = tid >> 3, dc = tid & 7;
#pragma unroll
          for (int q = 0; q < 2; ++q) vn[q] = *(const u32x4*)(Pc + (long)key * ld + 1024 + h * 256 + vh * 128 + (dc + 8 * q) * 8);
          if (wave == 0) { gin = Pc[(long)lane * ld + 3072 + h]; gfn = Pc[(long)lane * ld + 3076 + h]; } }
        __syncthreads();
#pragma unroll 1
        for (int ch = 0; ch < T / 64; ++ch) {
            const int t0 = ch * 64; const bf16_t* Pc = P + (size_t)(b * T + t0) * ld;
            if (wave == 0) {
                const float li = bf2f(gin) + gbi;
                float bb = logsigmoidf_(bf2f(gfn) + gbf);
#pragma unroll
                for (int o = 1; o < 64; o <<= 1) { const float u = __shfl_up(bb, o); if (lane >= o) bb += u; }
                float pm = li - bb;
#pragma unroll
                for (int o = 1; o < 64; o <<= 1) { const float u = __shfl_up(pm, o); if (lane >= o) pm = fmaxf(pm, u); }
                const float mprev = scl[0];
                const float mt = fmaxf(bb + mprev, bb + pm);
                const float bend = __shfl(bb, 63);
                const float decay = bend - bb + li;
                const float mnew = fmaxf(bend + mprev, wave_max(decay));
                bL[lane] = bb; liL[lane] = li; mtL[lane] = mt; wiL[lane] = __expf(bb + mprev - mt); wkL[lane] = __expf(decay - mnew);
                if (lane == 0) { scl[1] = __expf(bend + mprev - mnew); scl[2] = mnew; }
            }
            __syncthreads();
            {
                const int r0 = part * 32;
                LAS unsigned char* rowbase = lds + ((c2 < 128) ? L_Q : L_KK) + (c2 & 127) * 2;
#pragma unroll
                for (int i = 0; i < 32; ++i) { const int rr = r0 + i;
                    const float y = w0 * bf2f(xn[i]) + w1 * bf2f(xn[i + 1]) + w2 * bf2f(xn[i + 2]) + w3 * bf2f(xn[i + 3]) + cb; const float o = y * sigmoidf_(y) * qscale;
                    *(LAS unsigned short*)(rowbase + rr * PK) = (unsigned short)f2bf(o);
                    if (c2 >= 128) *(LAS unsigned short*)(lds + L_KWT + (c2 - 128) * PS + rr * 2) = (unsigned short)f2bf(o * wkL[rr]);
                    if ((i & 3) == 3) asm volatile("" ::: "memory"); }
                const int key = tid >> 3, dc = tid & 7;
#pragma unroll
                for (int q = 0; q < 2; ++q) { const unsigned w[4] = {vn[q].x, vn[q].y, vn[q].z, vn[q].w};
#pragma unroll
                    for (int e = 0; e < 4; ++e) { const int vrow = (dc + 8 * q) * 8 + 2 * e;
                        *(LAS unsigned short*)(lds + L_VT + vrow * PS + key * 2) = (unsigned short)(w[e] & 0xffffu); *(LAS unsigned short*)(lds + L_VT + (vrow + 1) * PS + key * 2) = (unsigned short)(w[e] >> 16); } }
            }
            if (ch + 1 < T / 64) {
                const bf16_t* Pn = Pc + (size_t)64 * ld; const int r0 = part * 32;
                const bf16_t* rp = Pn + (long)(r0 - 3) * ld;
#pragma unroll
                for (int i = 0; i < 35; ++i) { xn[i] = rp[col]; rp += ld; asm volatile("" : "+s"(rp)); }
                const int key = tid >> 3, dc = tid & 7;
#pragma unroll
                for (int q = 0; q < 2; ++q) vn[q] = *(const u32x4*)(Pn + (long)key * ld + 1024 + h * 256 + vh * 128 + (dc + 8 * q) * 8);
                if (wave == 0) { gin = Pn[(long)lane * ld + 3072 + h]; gfn = Pn[(long)lane * ld + 3076 + h]; }
            }
            __syncthreads();
#pragma unroll
            for (int q = 0; q < 2; ++q) {
                const int idx = 2 * wave + q, ti = idx >> 2, tj = idx & 3;
                f32x4 a = (f32x4){0.f, 0.f, 0.f, 0.f};
                if (ti <= tj) {
#pragma unroll
                    for (int ks = 0; ks < 4; ++ks) a = __builtin_amdgcn_mfma_f32_16x16x32_bf16(frag(lds + L_KK, 16 * ti + fr, PK, 32 * ks + 8 * fg), frag(lds + L_Q, 16 * tj + fr, PK, 32 * ks + 8 * fg), a, 0, 0, 0);
                    const int t = 16 * tj + fr; const float bt = bL[t], mt = mtL[t];
#pragma unroll
                    for (int e = 0; e < 4; ++e) { const int s = 16 * ti + 4 * fg + e; a[e] = (s <= t) ? a[e] * __expf(bt - bL[s] + liL[s] - mt) : 0.f; }
                }
                u32x2 w; w.x = pg8::cvt_pk_bf16(a[0], a[1]); w.y = pg8::cvt_pk_bf16(a[2], a[3]);
                *(LAS u32x2*)(lds + L_S + (16 * tj + fr) * PS + (16 * ti + 4 * fg) * 2) = w;
            }
            __syncthreads();
            {
#pragma unroll 1
                for (int tj = 0; tj < 4; ++tj) {
                    f32x4 a1 = (f32x4){0.f, 0.f, 0.f, 0.f}, a2 = a1, d1 = a1, d2 = a1;
#pragma unroll
                    for (int ks = 0; ks < 2; ++ks) { const bf16x8 bs = frag(lds + L_S, 16 * tj + fr, PS, 32 * ks + 8 * fg);
                        a1 = __builtin_amdgcn_mfma_f32_16x16x32_bf16(frag(lds + L_VT, 16 * wave + fr, PS, 32 * ks + 8 * fg), bs, a1, 0, 0, 0);
                        d1 = __builtin_amdgcn_mfma_f32_16x16x32_bf16(frag(lds + L_VT, 128 + fr, PS, 32 * ks + 8 * fg), bs, d1, 0, 0, 0); }
#pragma unroll
                    for (int ks = 0; ks < 4; ++ks) { const bf16x8 bq = frag(lds + L_Q, 16 * tj + fr, PK, 32 * ks + 8 * fg);
                        a2 = __builtin_amdgcn_mfma_f32_16x16x32_bf16(frag(lds + L_C, 16 * wave + fr, PK, 32 * ks + 8 * fg), bq, a2, 0, 0, 0);
                        d2 = __builtin_amdgcn_mfma_f32_16x16x32_bf16(frag(lds + L_C, 128 + fr, PK, 32 * ks + 8 * fg), bq, d2, 0, 0, 0); }
                    const int t = 16 * tj + fr; const float wi = wiL[t];
                    float den = d1[0] + wi * d2[0];
                    den = __shfl(den, fr);
                    const float inv = __builtin_amdgcn_rcpf(fmaxf(fabsf(den), __expf(-mtL[t])));
                    u32x2 w; w.x = pg8::cvt_pk_bf16((a1[0] + wi * a2[0]) * inv, (a1[1] + wi * a2[1]) * inv); w.y = pg8::cvt_pk_bf16((a1[2] + wi * a2[2]) * inv, (a1[3] + wi * a2[3]) * inv);
                    *(u32x2*)(HO + (size_t)(b * T + t0 + t) * D + h * 256 + vh * 128 + 16 * wave + 4 * fg) = w;
                }
            }
            __syncthreads();
            {
                const float cs = scl[1];
                const bf16x8 ka0 = frag(lds + L_KWT, 16 * wave + fr, PS, 8 * fg), ka1 = frag(lds + L_KWT, 16 * wave + fr, PS, 32 + 8 * fg);
#pragma unroll
                for (int j = 0; j < 9; ++j) {
                    Cacc[j] = Cacc[j] * cs;
                    Cacc[j] = __builtin_amdgcn_mfma_f32_16x16x32_bf16(ka0, frag(lds + L_VT, 16 * j + fr, PS, 8 * fg), Cacc[j], 0, 0, 0);
                    Cacc[j] = __builtin_amdgcn_mfma_f32_16x16x32_bf16(ka1, frag(lds + L_VT, 16 * j + fr, PS, 32 + 8 * fg), Cacc[j], 0, 0, 0);
                    u32x2 w; w.x = pg8::cvt_pk_bf16(Cacc[j][0], Cacc[j][1]); w.y = pg8::cvt_pk_bf16(Cacc[j][2], Cacc[j][3]);
                    *(LAS u32x2*)(lds + L_C + (16 * j + fr) * PK + (16 * wave + 4 * fg) * 2) = w;
                }
                if (tid == 0) scl[0] = scl[2];
            }
            __syncthreads();
        }
    }
}
namespace hg {
constexpr int PK = 272, PS = 144;
constexpr int L_QD = 0, L_KD = L_QD + 64 * PK, L_KDT = L_KD + 64 * PK, L_VT = L_KDT + 128 * PS, L_A = L_VT + 128 * PS, L_ST = L_A + 64 * PS, L_TOT = L_ST + 128 * PK, L_GE = L_TOT + 4 * 128 * 4, L_SSQ = L_GE + 128 * 4;
__device__ __forceinline__ bf16x8 frag(const LAS unsigned char* base, int row, int pitch, int kelem) { return *(const LAS bf16x8*)(base + row * pitch + kelem * 2); }
}
__device__ __forceinline__ void phase_hgrn_scan_mfma(Frame& F) {
    using namespace hg;
    LAS unsigned char* lds = F.lds;
    LAS float* totL = (LAS float*)(lds + L_TOT); LAS float* geL = (LAS float*)(lds + L_GE);
    const bf16_t* P = WSP(bf16_t, OFF_PROJ); bf16_t* ATT = WSP(bf16_t, OFF_ATT);
    const float* lbt = WSP(float, OFF_TAB) + TAB_LB; const float* norm_g = inptr(F, I_HG_NORM_G);
    LAS float* ssqL = (LAS float*)(F.lds + hg::L_SSQ);
    int tid = F.tid; asm volatile("; phase-local tid" : "+v"(tid));
    const int lane = tid & 63, wave = __builtin_amdgcn_readfirstlane(tid >> 6), ld = HG_LD;
    const int fr = lane & 15, fg = lane >> 4;
    const int kc = tid & 127, part = __builtin_amdgcn_readfirstlane(tid >> 7);
    const int vkey = tid >> 3, vdc = tid & 7;
#pragma unroll 1
    for (int item = F.bx; item < BATCH * 8; item += F.G) {
        const int h = item & 7, b = item >> 3;
        f32x4 Sacc[8];
#pragma unroll
        for (int j = 0; j < 8; ++j) Sacc[j] = (f32x4){0.f, 0.f, 0.f, 0.f};
        for (int i = tid; i < 128 * PK / 4; i += 512) ((LAS unsigned*)(lds + L_ST))[i] = 0u;
        const float lb = lbt[h * 128 + kc];
        const f32x4 ngv = *(const f32x4*)(norm_g + h * 128 + 16 * wave + 4 * fg);
        unsigned short qn[16], fn[16]; u32x4 vn[2];
        { const bf16_t* Pc = P + (size_t)(b * T) * ld;
          const bf16_t* rp = Pc + (long)(16 * part) * ld + h * 128;
#pragma unroll
          for (int i = 0; i < 16; ++i) { qn[i] = rp[kc]; fn[i] = rp[1024 + kc]; rp += ld; asm volatile("" : "+s"(rp)); }
#pragma unroll
          for (int q = 0; q < 2; ++q) vn[q] = *(const u32x4*)(Pc + (long)vkey * ld + 2048 + h * 128 + (vdc + 8 * q) * 8); }
        __syncthreads();
#pragma unroll 1
        for (int ch = 0; ch < T / 64; ++ch) {
            const int t0 = ch * 64;
            float qs[16], kk[16], G[16]; u32x4 vv[2];
            {
                float run = 0.f;
#pragma unroll
                for (int i = 0; i < 16; ++i) { const float qr = bf2f(qn[i]), fraw = bf2f(fn[i]);
                    const float f = lb + (1.0f - lb) * sigmoidf_(fraw);
                    run += __logf(f); G[i] = run; qs[i] = qr * sigmoidf_(qr); kk[i] = 1.0f - f; }
                totL[part * 128 + kc] = run; vv[0] = vn[0]; vv[1] = vn[1];
            }
            __syncthreads();
            if (ch + 1 < T / 64) {
                const bf16_t* Pn = P + (size_t)(b * T + t0 + 64) * ld;
                const bf16_t* rp = Pn + (long)(16 * part) * ld + h * 128;
#pragma unroll
                for (int i = 0; i < 16; ++i) { qn[i] = rp[kc]; fn[i] = rp[1024 + kc]; rp += ld; asm volatile("" : "+s"(rp)); }
#pragma unroll
                for (int q = 0; q < 2; ++q) vn[q] = *(const u32x4*)(Pn + (long)vkey * ld + 2048 + h * 128 + (vdc + 8 * q) * 8);
            }
            {
                float off = 0.f, tot = 0.f;
#pragma unroll
                for (int p = 0; p < 4; ++p) { const float tp = totL[p * 128 + kc]; if (p < part) off += tp; tot += tp; }
                if (part == 3) geL[kc] = __expf(tot);
#pragma unroll
                for (int i = 0; i < 16; ++i) { const int r = 16 * part + i; const float g = G[i] + off;
                    const unsigned short qd = (unsigned short)f2bf(qs[i] * __expf(g)), kd = (unsigned short)f2bf(kk[i] * __expf(-g));
                    *(LAS unsigned short*)(lds + L_QD + r * PK + kc * 2) = qd; *(LAS unsigned short*)(lds + L_KD + r * PK + kc * 2) = kd; *(LAS unsigned short*)(lds + L_KDT + kc * PS + r * 2) = kd; }
#pragma unroll
                for (int q = 0; q < 2; ++q) { const unsigned w[4] = {vv[q].x, vv[q].y, vv[q].z, vv[q].w};
#pragma unroll
                    for (int e = 0; e < 4; ++e) { const int vrow = (vdc + 8 * q) * 8 + 2 * e;
                        *(LAS unsigned short*)(lds + L_VT + vrow * PS + vkey * 2) = (unsigned short)(w[e] & 0xffffu); *(LAS unsigned short*)(lds + L_VT + (vrow + 1) * PS + vkey * 2) = (unsigned short)(w[e] >> 16); } }
            }
            __syncthreads();
#pragma unroll
            for (int q = 0; q < 2; ++q) {
                const int idx = 2 * wave + q, ti = idx >> 2, tj = idx & 3;
                f32x4 a = (f32x4){0.f, 0.f, 0.f, 0.f};
                if (ti <= tj) {
#pragma unroll
                    for (int ks = 0; ks < 4; ++ks) a = __builtin_amdgcn_mfma_f32_16x16x32_bf16(frag(lds + L_KD, 16 * ti + fr, PK, 32 * ks + 8 * fg), frag(lds + L_QD, 16 * tj + fr, PK, 32 * ks + 8 * fg), a, 0, 0, 0);
                    const int t = 16 * tj + fr;
#pragma unroll
                    for (int e = 0; e < 4; ++e) { const int s = 16 * ti + 4 * fg + e; a[e] = (s <= t) ? a[e] : 0.f; }
                }
                u32x2 w; w.x = pg8::cvt_pk_bf16(a[0], a[1]); w.y = pg8::cvt_pk_bf16(a[2], a[3]);
                *(LAS u32x2*)(lds + L_A + (16 * tj + fr) * PS + (16 * ti + 4 * fg) * 2) = w;
            }
            __syncthreads();
            f32x4 ot[4]; u32x2 gq[4];
            const bf16_t* Pg = P + (size_t)(b * T + t0) * ld + 3072 + h * 128 + 16 * wave + 4 * fg;
#pragma unroll
            for (int tj = 0; tj < 4; ++tj) {
                f32x4 a = (f32x4){0.f, 0.f, 0.f, 0.f};
                gq[tj] = *(const u32x2*)(Pg + (size_t)(16 * tj + fr) * ld);
#pragma unroll
                for (int ks = 0; ks < 2; ++ks) a = __builtin_amdgcn_mfma_f32_16x16x32_bf16(frag(lds + L_VT, 16 * wave + fr, PS, 32 * ks + 8 * fg), frag(lds + L_A, 16 * tj + fr, PS, 32 * ks + 8 * fg), a, 0, 0, 0);
#pragma unroll
                for (int ks = 0; ks < 4; ++ks) a = __builtin_amdgcn_mfma_f32_16x16x32_bf16(frag(lds + L_ST, 16 * wave + fr, PK, 32 * ks + 8 * fg), frag(lds + L_QD, 16 * tj + fr, PK, 32 * ks + 8 * fg), a, 0, 0, 0);
                ot[tj] = a;
                float ss = (a[0] * a[0] + a[1] * a[1]) + (a[2] * a[2] + a[3] * a[3]);
                ss += __shfl_xor(ss, 16); ss += __shfl_xor(ss, 32);
                if (fg == 0) ssqL[wave * 64 + 16 * tj + fr] = ss;
            }
            __syncthreads();
#pragma unroll
            for (int tj = 0; tj < 4; ++tj) {
                const int t = 16 * tj + fr; float tot = 0.f;
#pragma unroll
                for (int w8 = 0; w8 < 8; ++w8) tot += ssqL[w8 * 64 + t];
                const float rr = __builtin_amdgcn_rsqf(tot * (1.0f / 128.0f) + RMS_EPS);
                const float g0 = __uint_as_float(gq[tj].x << 16), g1 = __uint_as_float(gq[tj].x & 0xffff0000u), g2 = __uint_as_float(gq[tj].y << 16), g3 = __uint_as_float(gq[tj].y & 0xffff0000u);
                u32x2 w; w.x = pg8::cvt_pk_bf16(ot[tj][0] * rr * ngv[0] * sigmoidf_(g0), ot[tj][1] * rr * ngv[1] * sigmoidf_(g1));
                w.y = pg8::cvt_pk_bf16(ot[tj][2] * rr * ngv[2] * sigmoidf_(g2), ot[tj][3] * rr * ngv[3] * sigmoidf_(g3));
                *(u32x2*)(ATT + (size_t)(b * T + t0 + t) * D + h * 128 + 16 * wave + 4 * fg) = w;
            }
            {
                const bf16x8 ka0 = frag(lds + L_KDT, 16 * wave + fr, PS, 8 * fg), ka1 = frag(lds + L_KDT, 16 * wave + fr, PS, 32 + 8 * fg);
                const f32x4 ge = *(const LAS f32x4*)(geL + 16 * wave + 4 * fg);
#pragma unroll
                for (int j = 0; j < 8; ++j) {
                    Sacc[j] = __builtin_amdgcn_mfma_f32_16x16x32_bf16(ka0, frag(lds + L_VT, 16 * j + fr, PS, 8 * fg), Sacc[j], 0, 0, 0);
                    Sacc[j] = __builtin_amdgcn_mfma_f32_16x16x32_bf16(ka1, frag(lds + L_VT, 16 * j + fr, PS, 32 + 8 * fg), Sacc[j], 0, 0, 0);
                    Sacc[j] = Sacc[j] * ge;
                    u32x2 w; w.x = pg8::cvt_pk_bf16(Sacc[j][0], Sacc[j][1]); w.y = pg8::cvt_pk_bf16(Sacc[j][2], Sacc[j][3]);
                    *(LAS u32x2*)(lds + L_ST + (16 * j + fr) * PK + (16 * wave + 4 * fg) * 2) = w;
                }
            }
            __syncthreads();
        }
    }
}
constexpr int PH_PER_LAYER = 10, N_PHASES = 1 + PH_PER_LAYER * DEPTH;
struct Args { const float* in[27]; float* out; unsigned char* ws; int ph_lo, ph_hi; };
__global__ void __launch_bounds__(512, 2) mk_fwd(Args args) {
    extern __shared__ __attribute__((aligned(16))) unsigned char lds[];
    Frame F;
    F.lds = (LAS unsigned char*)lds;
    F.LC = (volatile LAS unsigned*)(F.lds + LDSCTL_OFF);
    F.tid = threadIdx.x; F.lane = F.tid & 63; F.wave = __builtin_amdgcn_readfirstlane(F.tid >> 6); F.G = gridDim.x; F.bx = blockIdx.x;
    F.ws = (unsigned char*)(GAS unsigned char*)args.ws; F.ctl = (unsigned*)(F.ws + OFF_CTL); F.out = (float*)(GAS float*)args.out;
    for (int u = F.tid; u < (LDS_BYTES - LDSCTL_OFF) / 4; u += 512) F.LC[u] = 0u;
    __syncthreads();
    if (F.tid < 27) { const unsigned long long pv = (unsigned long long)args.in[F.tid]; F.LC[128 + 2 * F.tid] = (unsigned)pv; F.LC[129 + 2 * F.tid] = (unsigned)(pv >> 32); }
    __syncthreads();
    XcdBarrier bar; bar.bar = F.ctl + CW_BAR; bar.x = 0; bar.st = nullptr;
    if (!MK_PER_PHASE) bar = xcd_barrier_post(F.ctl + CW_BAR, F.LC);
    const int lo = args.ph_lo, hi = args.ph_hi;
#define IN(k) (lo <= (k) && (k) < hi)
#ifndef DBL_LNR
#define DBL_LNR 1
#endif
#ifndef DBL_COMB
#define DBL_COMB 1
#endif
#ifndef DBL_NG
#define DBL_NG 1
#endif
#ifndef DBL_GIN
#define DBL_GIN 1
#endif
#ifndef DBL_GOUT
#define DBL_GOUT 1
#endif
#ifndef DBL_GCMP
#define DBL_GCMP 1
#endif
#ifndef DBL_GUP
#define DBL_GUP 1
#endif
#ifndef DBL_GDN
#define DBL_GDN 1
#endif
#ifndef DBL_SCAN
#define DBL_SCAN 1
#endif
#ifndef DBL_P0
#define DBL_P0 1
#endif
#ifndef DBL_ATT
#define DBL_ATT 1
#endif
#define REP(n) _Pragma("unroll 1") for (int rep_ = 0; rep_ < (n); ++rep_)
#ifdef PROBE_A
#define STAMP(k) do { if (blockIdx.x == 0 && F.tid == 0) ((unsigned long long*)(F.ws + OFF_TAB + 65536))[(k)] = wall_clock64(); } while (0)
#else
#define STAMP(k) do {} while (0)
#endif
#define SEAM(k) do { if (!MK_PER_PHASE && (k) + 1 < hi) xcd_barrier(bar); else __syncthreads(); } while (0)

    STAMP(0);
    if (IN(0)) {
#ifndef NO_P0
 REP(DBL_P0) p0_prologue(F);
#endif
 SEAM(0); }

    for (int L = 0; L < DEPTH; ++L) {
        int Lo = L; asm volatile("; layer-local" : "+s"(Lo));
        const int kind = Lo % 3, slot = Lo / 3, pb = 1 + PH_PER_LAYER * Lo;
#define PHL Frame Fp = F; asm volatile("; phase-local" : "+v"(Fp.tid), "+s"(Fp.bx)); Fp.lane = Fp.tid & 63;
        const int ldp = kind == 0 ? NSA_LD : (kind == 1 ? ML_LD : HG_LD);
        if (IN(pb + 0)) { PHL STAMP(pb + 0);
            const bf16_t* Wt = kind == 0 ? WSP(bf16_t, OFF_W_NSAIN) + (size_t)slot * NSA_LD * D : (kind == 1 ? WSP(bf16_t, OFF_W_MLIN) : WSP(bf16_t, OFF_W_HGIN));
            pg8::APlain AS{WSP(bf16_t, OFF_XN), D}; pg8::BPlain BS{Wt, D}; pg8::StaticOrder S; S.init(NTOK / 256, ldp / 256, Fp.G, Fp.bx);
            pg8::EpiStore E{WSP(bf16_t, OFF_PROJ), ldp};
            #ifndef NO_GIN
            REP(DBL_GIN) pg8::gemm_phase<pg8::EpiStore, pg8::StaticOrder, pg8::APlain, pg8::BPlain>(Fp.lds, D, AS, BS, S, E);
#endif
            SEAM(pb + 0);
        }
        if (kind == 0) {
            if (IN(pb + 1)) { PHL STAMP(pb + 1);
                pg8::ACmp AS{WSP(bf16_t, OFF_PROJ), NSA_LD, 1024}; pg8::BGroup BS{WSP(bf16_t, OFF_W_CMP1) + (size_t)slot * 2 * 256 * 2048, 2048, (size_t)256 * 2048};
                pg8::CmpOrder S{Fp.G, Fp.bx};
                pg8::EpiCmpGelu E{WSP(bf16_t, OFF_HC), WSP(float, OFF_TAB) + TAB_CMPB + slot * 512};
                #ifndef NO_GCMP
                REP(DBL_GCMP) pg8::gemm_phase<pg8::EpiCmpGelu, pg8::CmpOrder, pg8::ACmp, pg8::BGroup>(Fp.lds, 2048, AS, BS, S, E);
#endif
                SEAM(pb + 1);
            }
            if (IN(pb + 2)) { PHL STAMP(pb + 2);
#ifndef NO_CMP2
 REP(DBL_GCMP) phase_nsa_cmp2(Fp, slot);
#endif
 SEAM(pb + 2); }
            if (IN(pb + 3)) { PHL STAMP(pb + 3);
#ifndef NO_ATTN
 REP(DBL_ATT) phase_nsa_attn_mfma(Fp, slot);
#endif
 SEAM(pb + 3); }
        } else if (kind == 1) {
            if (IN(pb + 1)) { PHL STAMP(pb + 1);
#ifdef MLS_CHECK
                {
                    const size_t n16 = (size_t)NTOK * D * 2 / 16; u32x4* HMv = WSP(u32x4, OFF_HM); u32x4* Y1 = WSP(u32x4, OFF_Y); u32x4* Y2 = WSP(u32x4, OFF_Y + 160 * MiB);
#pragma unroll 1
                    for (int rep_ = 0; rep_ < 3; ++rep_) {
                        phase_mlstm_scan_mfma(Fp);
                        xcd_barrier(bar);
                        if (rep_ < 2) { u32x4* dst = rep_ == 0 ? Y1 : Y2;
                            for (size_t i = (size_t)blockIdx.x * 512 + Fp.tid; i < n16; i += (size_t)Fp.G * 512) dst[i] = HMv[i];
                            xcd_barrier(bar); }
                    }
                    unsigned bad_bits = 0u; float md = 0.f, mr = 0.f;
                    for (size_t i = (size_t)blockIdx.x * 512 + Fp.tid; i < n16; i += (size_t)Fp.G * 512) { const u32x4 a = HMv[i], b2 = Y2[i], c1 = Y1[i];
                        if (a.x != b2.x || a.y != b2.y || a.z != b2.z || a.w != b2.w) bad_bits = 1u;
                        const unsigned aw[4] = {a.x, a.y, a.z, a.w}, cw[4] = {c1.x, c1.y, c1.z, c1.w};
#pragma unroll
                        for (int q = 0; q < 4; ++q) { const float a0 = __uint_as_float(aw[q] << 16), a1 = __uint_as_float(aw[q] & 0xffff0000u), r0 = __uint_as_float(cw[q] << 16), r1 = __uint_as_float(cw[q] & 0xffff0000u);
                            md = fmaxf(md, fmaxf(fabsf(a0 - r0), fabsf(a1 - r1))); mr = fmaxf(mr, fmaxf(fabsf(r0), fabsf(r1))); if (!(a0 == a0) || !(a1 == a1)) bad_bits |= 4u; } }
                    md = wave_max(md); mr = wave_max(mr);
                    if (Fp.lane == 0) { atomicMax(F.ctl + 9000, __float_as_uint(md)); atomicMax(F.ctl + 9001, __float_as_uint(mr)); }
                    if (bad_bits) atomicOr(F.ctl + 9002, bad_bits);
                }
#else
#ifndef NO_MLS
 REP(DBL_SCAN) phase_mlstm_scan_mfma(Fp);
#endif
#endif
 SEAM(pb + 1); }
            if (IN(pb + 2)) { PHL STAMP(pb + 2);
#ifndef NO_NG
 REP(DBL_NG) phase_norm_gate<256>(Fp, inptr(Fp, I_ML_NORM_G), ML_LD, 2048);
#endif
 SEAM(pb + 2); }
        } else {
            if (IN(pb + 1)) { PHL STAMP(pb + 1);
#ifndef NO_HGS
 REP(DBL_SCAN) phase_hgrn_scan_mfma(Fp);
#endif
 SEAM(pb + 1); }
        }
        if (IN(pb + 4)) { PHL STAMP(pb + 4);
            const bf16_t* Wt = kind == 0 ? WSP(bf16_t, OFF_W_NSAOUT) + (size_t)slot * D * D : (kind == 1 ? WSP(bf16_t, OFF_W_MLOUT) : WSP(bf16_t, OFF_W_HGOUT));
            pg8::APlain AS{WSP(bf16_t, OFF_ATT), D}; pg8::BPlain BS{Wt, D}; pg8::StaticOrder S; S.init(NTOK / 256, D / 256, Fp.G, Fp.bx);
            pg8::EpiStore E{WSP(bf16_t, OFF_HM), D};
            #ifndef NO_GOUT
            REP(DBL_GOUT) pg8::gemm_phase<pg8::EpiStore, pg8::StaticOrder, pg8::APlain, pg8::BPlain>(Fp.lds, D, AS, BS, S, E);
#endif
            SEAM(pb + 4);
        }
        if (IN(pb + 5)) { PHL STAMP(pb + 5);
#ifndef NO_LNR
 if (DBL_LNR > 1) phase_ln_router(Fp, Lo, true);
 phase_ln_router(Fp, Lo);
#endif
 SEAM(pb + 5); }
        if (IN(pb + 6)) { PHL STAMP(pb + 6);
#ifndef NO_SLOT
 phase_moe_slots(Fp, Lo);
#endif
 SEAM(pb + 6); }
        if (IN(pb + 7)) { PHL STAMP(pb + 7);
            moe_tile_table(Fp, Lo);
            pg8::AGather AS{WSP(bf16_t, OFF_XN), D, WSP(int, OFF_ROWT)}; pg8::BGroup BS{WSP(bf16_t, OFF_W_GU) + (size_t)Lo * NEXP * 2048 * D, D, (size_t)2048 * D};
            pg8::MoeOrder S; S.init(__builtin_amdgcn_readfirstlane((int)Fp.LC[40]), 8, Fp.G, Fp.bx); S.pend = (const LAS int*)(Fp.lds + LDSCTL_OFF + 32);
            pg8::EpiSwiglu E{WSP(bf16_t, OFF_H), inptr(Fp, I_MOE_B_GU) + (size_t)Lo * NEXP * 2048};
            #ifndef NO_GUP
            REP(DBL_GUP) pg8::gemm_phase<pg8::EpiSwiglu, pg8::MoeOrder, pg8::AGather, pg8::BGroup>(Fp.lds, D, AS, BS, S, E);
#endif
            SEAM(pb + 7);
        }
        if (IN(pb + 8)) { PHL STAMP(pb + 8);
            moe_tile_table(Fp, Lo);
            pg8::APlain AS{WSP(bf16_t, OFF_H), DFF}; pg8::BGroup BS{WSP(bf16_t, OFF_W_DN) + (size_t)Lo * NEXP * D * DFF, DFF, (size_t)D * DFF};
            pg8::MoeOrder S; S.init(__builtin_amdgcn_readfirstlane((int)Fp.LC[40]), 4, Fp.G, Fp.bx); S.pend = (const LAS int*)(Fp.lds + LDSCTL_OFF + 32);
            pg8::EpiDown E{WSP(bf16_t, OFF_Y), inptr(Fp, I_MOE_B_DOWN) + (size_t)Lo * NEXP * D, WSP(float, OFF_ROWG)};
            #ifndef NO_GDN
            REP(DBL_GDN) pg8::gemm_phase<pg8::EpiDown, pg8::MoeOrder, pg8::APlain, pg8::BGroup>(Fp.lds, DFF, AS, BS, S, E);
#endif
            SEAM(pb + 8);
        }
        if (IN(pb + 9)) { PHL STAMP(pb + 9);
#ifndef NO_COMB
 if (DBL_COMB > 1) phase_combine_ln(Fp, Lo, (float*)nullptr, true);
 phase_combine_ln(Fp, Lo, Lo == DEPTH - 1 ? Fp.out : (float*)nullptr);
#endif
 SEAM(pb + 9); }
    }
#ifdef MLS_CHECK
    xcd_barrier(bar);
    { const float md = __uint_as_float(__hip_atomic_load(F.ctl + 9000, RLX_AGENT)), mr = __uint_as_float(__hip_atomic_load(F.ctl + 9001, RLX_AGENT)); const unsigned bb = __hip_atomic_load(F.ctl + 9002, RLX_AGENT);
      float code = 10.f; if (md > 0.02f * mr) code = 100.f; if (md > 0.2f * mr) code = 300.f; if (bb & 1u) code *= 10.f; if (bb & 4u) code *= 100.f;
      for (size_t i = (size_t)blockIdx.x * 512 + F.tid; i < (size_t)NTOK * D; i += (size_t)F.G * 512) F.out[i] = code; }
#endif
#ifdef PROBE_A
    STAMP(N_PHASES);
    xcd_barrier(bar);
    {
        const unsigned long long* st = (const unsigned long long*)(F.ws + OFF_TAB + 65536);
        float cat[6] = {0.f, 0.f, 0.f, 0.f, 0.f, 0.f};
        unsigned long long prev = __hip_atomic_load(st + 0, RLX_AGENT);
        int pc = 0;
        for (int p = 1; p <= N_PHASES; ++p) {
            int c = -1;
            if (p < N_PHASES) { const int Lq = (p - 1) / PH_PER_LAYER, k = (p - 1) % PH_PER_LAYER, kind = Lq % 3;
                if (k == 3 && kind != 0) continue;
                c = (k == 0 || k == 4 || k == 7 || k == 8) ? 1 : (k == 1 ? (kind == 0 ? 1 : (kind == 1 ? 3 : 4)) : (k == 3 ? 2 : 5)); }
            const unsigned long long now = __hip_atomic_load(st + p, RLX_AGENT);
            const float us = (float)(now - prev) * 0.01f;
#pragma unroll
            for (int q = 0; q < 6; ++q) if (q == pc) cat[q] += us;
            prev = now; pc = c;
        }
        float va = 0.f, vb = 0.f;
#pragma unroll
        for (int q = 0; q < 6; ++q) { if (q == PROBE_A) va = cat[q]; if (q == PROBE_B) vb = cat[q]; }
        const float kfill = sqrtf(va);
        for (size_t i = (size_t)blockIdx.x * 512 + F.tid; i < (size_t)NTOK * D; i += (size_t)F.G * 512) F.out[i] = (i == 0) ? vb : kfill;
    }
#endif
#undef IN
#undef SEAM
#undef PHL
}

extern "C" void kernel_launch(void* const* d_in, const int* in_sizes, int n_in, void* d_out, int out_size, void* d_ws, size_t ws_size, hipStream_t stream) {
    static int grid = 0;
    if (grid == 0) {
        if (n_in != 27 || out_size != NTOK * D || ws_size < WS_END) { fprintf(stderr, "kernel_launch: unexpected shapes (n_in %d, out %d, ws %zu)\n", n_in, out_size, ws_size); grid = -1; return; }
        int dev = 0, cus = 0;
        if (hipGetDevice(&dev) != hipSuccess || hipDeviceGetAttribute(&cus, hipDeviceAttributeMultiprocessorCount, dev) != hipSuccess) { grid = -1; return; }
        if (hipFuncSetAttribute((const void*)mk_fwd, hipFuncAttributeMaxDynamicSharedMemorySize, LDS_BYTES) != hipSuccess) { fprintf(stderr, "kernel_launch: hipFuncSetAttribute failed\n"); grid = -1; return; }
        int per_cu = 0;
        if (hipOccupancyMaxActiveBlocksPerMultiprocessor(&per_cu, (const void*)mk_fwd, 512, LDS_BYTES) != hipSuccess || per_cu < 1) fprintf(stderr, "kernel_launch: occupancy query reports %d\n", per_cu);
        (void)hipGetLastError();
        grid = cus;
    }
    if (grid < 0) return;
    (void)hipMemsetAsync((char*)d_ws + OFF_CTL, 0, CTL_ZERO_BYTES, stream);
    Args a{};
    for (int i = 0; i < 27; ++i) a.in[i] = (const float*)d_in[i];
    a.out = (float*)d_out; a.ws = (unsigned char*)d_ws;
#if MK_PER_PHASE
    for (int p = 0; p < N_PHASES; ++p) {
        if (p > 0) { const int L = (p - 1) / PH_PER_LAYER, k = (p - 1) % PH_PER_LAYER, kind = L % 3; if (k == 3 && kind != 0) continue; }
        a.ph_lo = p; a.ph_hi = p + 1;
        hipLaunchKernelGGL(mk_fwd, dim3(grid), dim3(512), LDS_BYTES, stream, a);
    }
#else
    a.ph_lo = 0; a.ph_hi = N_PHASES;
    hipLaunchKernelGGL(mk_fwd, dim3(grid), dim3(512), LDS_BYTES, stream, a);
#endif
}
```

```cpp
#include <hip/hip_runtime.h>
#include <cstdio>
#include <cstdint>

#define LAS __attribute__((address_space(3)))
#define GAS __attribute__((address_space(1)))
typedef unsigned short bf16_t;
typedef short bf16x8 __attribute__((ext_vector_type(8)));
typedef float f32x4 __attribute__((ext_vector_type(4)));
typedef float f32x2 __attribute__((ext_vector_type(2)));
typedef unsigned u32x4 __attribute__((ext_vector_type(4)));
typedef unsigned u32x2 __attribute__((ext_vector_type(2)));
#define RLX_AGENT __ATOMIC_RELAXED, __HIP_MEMORY_SCOPE_AGENT
#define LDS_WAIT() asm volatile("s_waitcnt lgkmcnt(0)" ::: "memory")
#define VM_WAIT() asm volatile("s_waitcnt vmcnt(0)" ::: "memory")

#ifndef MK_PER_PHASE
#define MK_PER_PHASE 0
#endif

constexpr int D = 1024, BATCH = 32, T = 2048, NTOK = BATCH * T, DEPTH = 4;
constexpr int NSA_IN = 2608, NSA_LD = 2816, ML_IN = 3080, ML_LD = 3328, HG_LD = 4096;
constexpr int NEXP = 32, TOPK = 4, DFF = 1024;
constexpr int MOE_ROWS = 270336;
constexpr float LN_EPS = 1e-5f, RMS_EPS = 1e-6f;
constexpr float DN_ALPHA = 1.681792830507429f;
constexpr int NCMP = 127;

constexpr size_t MiB = 1u << 20;
constexpr size_t OFF_CTL = 0, CTL_ZERO_BYTES = 1 * MiB;
constexpr size_t OFF_TAB = 1 * MiB;
constexpr size_t OFF_TOKE = 2 * MiB;
constexpr size_t OFF_TOKG = 3 * MiB;
constexpr size_t OFF_TOKP = 4 * MiB;
constexpr size_t OFF_ROWT = 5 * MiB;
constexpr size_t OFF_ROWG = 7 * MiB;
constexpr size_t OFF_KC = 9 * MiB;
constexpr size_t OFF_HC = 17 * MiB;
constexpr size_t OFF_W_NSAIN = 33 * MiB;
constexpr size_t OFF_W_NSAOUT = 44 * MiB;
constexpr size_t OFF_W_MLIN = 48 * MiB;
constexpr size_t OFF_W_MLOUT = 55 * MiB;
constexpr size_t OFF_W_HGIN = 57 * MiB;
constexpr size_t OFF_W_HGOUT = 65 * MiB;
constexpr size_t OFF_W_CMP2 = 71 * MiB;
constexpr size_t OFF_W_CMP1 = 67 * MiB;
constexpr size_t OFF_W_GU = 72 * MiB;
constexpr size_t OFF_W_DN = 584 * MiB;
constexpr size_t OFF_XA = 840 * MiB;
constexpr size_t OFF_XN = 1096 * MiB;
constexpr size_t OFF_PROJ = 1224 * MiB;
constexpr size_t OFF_ATT = 1740 * MiB;
constexpr size_t OFF_HM = 1868 * MiB;
constexpr size_t OFF_H = 1996 * MiB;
constexpr size_t OFF_Y = 2526 * MiB;
constexpr size_t WS_END = 3056 * MiB;
constexpr int TAB_CMPB = 0;
constexpr int TAB_LB = 4096;
constexpr int TAB_RWT = 8192;
constexpr int CW_BAR = 4096;
constexpr int CW_CNT = 16384;
constexpr int CW_CUR = 16384 + 1024;

constexpr int RING_BYTES = 131072;
constexpr int LDSCTL_OFF = 155648;
constexpr int LDS_BYTES = 156672;

__device__ __forceinline__ float bf2f(bf16_t b) { return __uint_as_float(((unsigned)b) << 16); }
typedef float f32x2_t_ __attribute__((ext_vector_type(2))); typedef __bf16 bf16x2_t_ __attribute__((ext_vector_type(2)));
__device__ __forceinline__ unsigned pk2(float lo, float hi) { const f32x2_t_ v = {lo, hi}; const bf16x2_t_ b = __builtin_convertvector(v, bf16x2_t_); return __builtin_bit_cast(unsigned, b); }
__device__ __forceinline__ unsigned f2bf(float f) { return pk2(f, f) & 0xffffu; }
template <int CTRL> __device__ __forceinline__ float dppf(float v) { return __builtin_bit_cast(float, __builtin_amdgcn_update_dpp(0, __builtin_bit_cast(int, v), CTRL, 0xF, 0xF, true)); }
__device__ __forceinline__ float rdl(float v, int l) { return __builtin_bit_cast(float, __builtin_amdgcn_readlane(__builtin_bit_cast(int, v), l)); }
__device__ __forceinline__ float wave_sum(float v) {
    v += dppf<0xB1>(v); v += dppf<0x4E>(v); v += dppf<0x141>(v); v += dppf<0x140>(v);
    return (rdl(v, 0) + rdl(v, 16)) + (rdl(v, 32) + rdl(v, 48));
}
__device__ __forceinline__ float wave_max(float v) {
    v = fmaxf(v, dppf<0xB1>(v)); v = fmaxf(v, dppf<0x4E>(v)); v = fmaxf(v, dppf<0x141>(v)); v = fmaxf(v, dppf<0x140>(v));
    return fmaxf(fmaxf(rdl(v, 0), rdl(v, 16)), fmaxf(rdl(v, 32), rdl(v, 48)));
}
__device__ __forceinline__ float sigmoidf_(float x) { return __builtin_amdgcn_rcpf(1.0f + __expf(-x)); }

#define XB_TMO      128
#define XB_XCNT(j)  (256  + 64 * (j))
#define XB_XSUB(j)  (1280 + 64 * (j))
#define XB_XGEN(j)  (2304 + 64 * (j))
#define XB_TOP      3328
#define XB_TOPGEN   3392
#define XCD_BAR_WORDS 3456
#define XB_SPIN_CAP (1u << 20)

__device__ __forceinline__ unsigned xb_ld(unsigned* p)              { return __hip_atomic_load(p, __ATOMIC_RELAXED, __HIP_MEMORY_SCOPE_AGENT); }
__device__ __forceinline__ unsigned xb_add(unsigned* p, unsigned v) { return __hip_atomic_fetch_add(p, v, __ATOMIC_RELAXED, __HIP_MEMORY_SCOPE_AGENT); }
__device__ __forceinline__ unsigned xb_xcc_id() { return (unsigned)__builtin_amdgcn_s_getreg((3 << 11) | 20) & 0xFu; }
#define XB_SPIN(cond, bar) do { unsigned _sp = 0; while (cond) { __builtin_amdgcn_s_sleep(1); \
    if ((++_sp & 255u) == 0u) { if (xb_ld(&(bar)[XB_TMO])) break; if (_sp > XB_SPIN_CAP) { atomicAdd(&(bar)[XB_TMO], 1u); break; } } } } while (0)

struct XcdBarrier { unsigned* bar; unsigned x; volatile LAS unsigned* st; };

__device__ __forceinline__ XcdBarrier xcd_barrier_post(unsigned* bar, volatile LAS unsigned* st) {
    XcdBarrier b; b.bar = bar; b.x = xb_xcc_id(); b.st = st;
    if (threadIdx.x == 0) (void)xb_add(&bar[XB_XCNT(b.x)], 1u);
    return b;
}
__device__ __forceinline__ void xcd_barrier_complete(unsigned* bar, unsigned x, unsigned& nloc, unsigned& nx) {
    const unsigned G = gridDim.x * gridDim.y * gridDim.z;
    unsigned sum, cnt, mine, sp = 0u;
    for (;;) {
        sum = 0u; cnt = 0u; mine = 0u;
#pragma unroll
        for (unsigned j = 0; j < 16; ++j) { const unsigned c = xb_ld(&bar[XB_XCNT(j)]); sum += c; cnt += (c > 0u) ? 1u : 0u; }
        mine = xb_ld(&bar[XB_XCNT(x)]);
        if (sum == G) break;
        __builtin_amdgcn_s_sleep(1);
        if ((++sp & 255u) == 0u) { if (xb_ld(&bar[XB_TMO])) break; if (sp > XB_SPIN_CAP) { atomicAdd(&bar[XB_TMO], 1u); break; } }
    }
    nloc = mine > 0u ? mine : 1u; nx = cnt > 0u ? cnt : 1u;
}
__device__ __forceinline__ void xcd_barrier(const XcdBarrier& b) {
    asm volatile("s_waitcnt vmcnt(0)" ::: "memory");
    __syncthreads();
    if (threadIdx.x == 0) {
        unsigned* bar = b.bar; asm volatile("; barrier words" : "+s"(bar));
        __builtin_amdgcn_s_waitcnt(0);
        unsigned nloc = b.st[0], nx = b.st[1];
        if (nloc == 0u) { xcd_barrier_complete(bar, b.x, nloc, nx); b.st[0] = nloc; b.st[1] = nx; }
        const unsigned old = xb_add(&bar[XB_XSUB(b.x)], 1u);
        const unsigned gen = old / nloc;
        if (old + 1u == (gen + 1u) * nloc) {
            __builtin_amdgcn_fence(__ATOMIC_RELEASE, "agent");
            asm volatile("s_waitcnt vmcnt(0)" ::: "memory");
            const unsigned og = xb_add(&bar[XB_TOP], 1u);
            const unsigned tg = og / nx;
            if (og + 1u == (tg + 1u) * nx) xb_add(&bar[XB_TOPGEN], 1u);
            else XB_SPIN(xb_ld(&bar[XB_TOPGEN]) == tg, bar);
            __builtin_amdgcn_fence(__ATOMIC_ACQUIRE, "agent");
            xb_add(&bar[XB_XGEN(b.x)], 1u);
            asm volatile("s_waitcnt vmcnt(0)" ::: "memory");
        } else {
            XB_SPIN(xb_ld(&bar[XB_XGEN(b.x)]) == gen, bar);
            __builtin_amdgcn_fence(__ATOMIC_ACQUIRE, "agent");
            asm volatile("s_waitcnt vmcnt(0)" ::: "memory");
        }
    }
    __syncthreads();
}

namespace pg8 {
constexpr int BM = 256, BK = 64, HALF = 128, HTB = HALF * BK * 2, STAGE_BYTES = 8 * HTB, NXCD = 8, WGM = 8;
__host__ __device__ __forceinline__ int lds_byte(int r, int c) { const int st = (r >> 4) * 2 + (c >> 5), rr = r & 15, cc = c & 31, ob = rr * 64 + cc * 2; return st * 1024 + (ob ^ (((ob >> 9) & 1) << 5)); }
__host__ __device__ __forceinline__ void stage_rc(int b, int& R, int& C) { const int st = b / 1024, sb = b % 1024, swz = sb ^ (((sb >> 9) & 1) << 5); R = (st >> 1) * 16 + swz / 64; C = (st & 1) * 32 + (swz % 64) / 2; }
__host__ __device__ __forceinline__ int perm32(int rho) { const int n = rho >> 4, i = rho & 15; return 8 * (i >> 2) + 4 * n + (i & 3); }

struct Unit { int pm, pn, e; };

struct StaticOrder {
    int nM, nN, nwg, G, c, wgm = WGM;
    __device__ __forceinline__ void init(int nM_, int nN_, int G_, int c_) { nM = nM_; nN = nN_; nwg = nM * nN; G = G_; c = c_; }
    __device__ __forceinline__ bool next(int i, Unit& u) const {
        const long L = (long)i * G + c; if (L >= nwg) return false;
        int wgid = (int)L; { const int q = nwg / NXCD, r = nwg % NXCD, xcd = wgid % NXCD, off = wgid / NXCD; wgid = (xcd < r ? xcd * (q + 1) : r * (q + 1) + (xcd - r) * q) + off; }
        const int nig = wgm * nN, gid = wgid / nig, fm = gid * wgm, gsz = (nM - fm) < wgm ? (nM - fm) : wgm;
        u.pm = fm + ((wgid % nig) % gsz); u.pn = (wgid % nig) / gsz; u.e = 0; return true;
    }
};
struct MoeOrder : StaticOrder {
    const LAS int* pend;
    __device__ __forceinline__ bool next(int i, Unit& u) const {
        if (!StaticOrder::next(i, u)) return false;
        const int ln = __builtin_amdgcn_mbcnt_hi(~0u, __builtin_amdgcn_mbcnt_lo(~0u, 0u));
        const int pe = pend[ln & 31];
        const unsigned long long bal = __builtin_amdgcn_ballot_w64(ln < 31 && pe <= u.pm);
        u.e = __builtin_popcountll(bal); return true;
    }
};
struct CmpOrder {
    int G, c;
    __device__ __forceinline__ bool next(int i, Unit& u) const { const int L = i * G + c; if (L >= 128) return false; u.e = L >> 6; u.pm = L & 63; u.pn = 0; return true; }
};

__device__ __forceinline__ unsigned cvt_pk_bf16(float lo, float hi) { const f32x2_t_ v = {lo, hi}; const bf16x2_t_ b = __builtin_convertvector(v, bf16x2_t_); return __builtin_bit_cast(unsigned, b); }

struct APlain {
    static constexpr bool GATHER = false;
    const bf16_t* A; int lda;
    __device__ __forceinline__ int kstep() const { return BK * 2; }
    __device__ __forceinline__ const char* base(const Unit& u) const { return (const char*)A + (size_t)u.pm * BM * lda * 2; }
    __device__ __forceinline__ void offs(const Unit&, const int (&R)[2], const int (&C)[2], unsigned (&vo)[2][2]) const {
#pragma unroll
        for (int h = 0; h < 2; ++h)
#pragma unroll
            for (int i = 0; i < 2; ++i) vo[h][i] = (unsigned)((h * HALF + R[i]) * lda + C[i]) * 2u;
    }
};
struct AGather {
    static constexpr bool GATHER = true;
    const bf16_t* A; int lda; const int* idx;
    __device__ __forceinline__ int kstep() const { return BK * 2; }
    __device__ __forceinline__ const char* base(const Unit&) const { return (const char*)A; }
    __device__ __forceinline__ void offs(const Unit& u, const int (&R)[2], const int (&C)[2], unsigned (&vo)[2][2]) const {
#pragma unroll
        for (int h = 0; h < 2; ++h)
#pragma unroll
            for (int i = 0; i < 2; ++i) { const int row = idx[u.pm * BM + h * HALF + R[i]]; vo[h][i] = (unsigned)(row * lda + C[i]) * 2u; }
    }
};
struct ACmp {
    static constexpr bool GATHER = false;
    const bf16_t* P; int ld; int col0;
    __device__ __forceinline__ int kstep() const { return ld * 2; }
    __device__ __forceinline__ const char* base(const Unit& u) const { const int b = u.pm >> 1, g0 = (u.pm & 1) * 2; return (const char*)P + ((size_t)b * T * ld + col0 + u.e * 256 + g0 * 64) * 2; }
    __device__ __forceinline__ void offs(const Unit&, const int (&R)[2], const int (&C)[2], unsigned (&vo)[2][2]) const {
#pragma unroll
        for (int h = 0; h < 2; ++h)
#pragma unroll
            for (int i = 0; i < 2; ++i) vo[h][i] = (unsigned)(16 * R[i] * ld + h * 64 + C[i]) * 2u;
    }
};
struct BPlain { const bf16_t* Bt; int K; __device__ __forceinline__ const char* base(const Unit& u) const { return (const char*)Bt + (size_t)u.pn * BM * K * 2; } };
struct BGroup { const bf16_t* Bt; int K; size_t gstride;   __device__ __forceinline__ const char* base(const Unit& u) const { return (const char*)Bt + ((size_t)u.e * gstride + (size_t)u.pn * BM * K) * 2; } };

template <class Epi, class Sched, class ASrc, class BSrc, bool ALIGN_EPI = true, bool SP2 = true>
__device__ __forceinline__ void gemm_phase(LAS unsigned char* lds, const int K, const ASrc& AS, const BSrc& BS, const Sched& S, const Epi& E) {
    int tid = threadIdx.x; asm volatile("; phase-local tid" : "+v"(tid));
    const int wid = __builtin_amdgcn_readfirstlane(tid >> 6), lane = tid & 63, wr = wid >> 2, wc = wid & 3, fr = lane & 15, fq = lane >> 4;
    const int nt = K / BK;
    int Rs[2], Cs[2]; unsigned voffB[2];
#pragma unroll
    for (int i = 0; i < 2; ++i) { int R, C; stage_rc(tid * 16 + i * 8192, R, C); Rs[i] = R; Cs[i] = C; const int Rb = Epi::PERM ? ((R & ~31) + perm32(R & 31)) : R; voffB[i] = (unsigned)(Rb * K + C) * 2u; }
    const size_t kstepB = (size_t)(BK * 2), hstepB = (size_t)HALF * K * 2;
    const size_t kstepA = (size_t)AS.kstep();
    const unsigned ldsw = (unsigned)wid * 1024u;
    const int aoff = lds_byte(wr * 64 + fr, fq * 8), boff = lds_byte(wc * 32 + fr, fq * 8);
#define PG8_SA(b, h) (((b) * 2 + (h)) * HTB)
#define PG8_SB(b, h) ((4 + (b) * 2 + (h)) * HTB)
#define PG8_STAGEB(bufoff, gbase) do { _Pragma("unroll") for (int _i = 0; _i < 2; ++_i) \
        __builtin_amdgcn_global_load_lds((const unsigned*)((const char*)(gbase) + voffB[_i]), (LAS unsigned*)(lds + (bufoff) + ldsw + _i * 8192), 16, 0, 0); } while (0)
#define PG8_STAGEA(bufoff, gbase, o0, o1) do { \
        __builtin_amdgcn_global_load_lds((const unsigned*)((const char*)(gbase) + (o0)), (LAS unsigned*)(lds + (bufoff) + ldsw), 16, 0, 0); \
        __builtin_amdgcn_global_load_lds((const unsigned*)((const char*)(gbase) + (o1)), (LAS unsigned*)(lds + (bufoff) + ldsw + 8192), 16, 0, 0); } while (0)
#define PG8_LDA(dst, b, h) do { _Pragma("unroll") for (int m = 0; m < 4; ++m) _Pragma("unroll") for (int k = 0; k < 2; ++k) dst[m][k] = *(const LAS bf16x8*)(lds + PG8_SA(b, h) + aoff + m * 2048 + k * 1024); } while (0)
#define PG8_LDB(dst, b, h) do { _Pragma("unroll") for (int n = 0; n < 2; ++n) _Pragma("unroll") for (int k = 0; k < 2; ++k) dst[n][k] = *(const LAS bf16x8*)(lds + PG8_SB(b, h) + boff + n * 2048 + k * 1024); } while (0)
#define PG8_MMA(ai, bj, At, Bt) do { __builtin_amdgcn_s_setprio(1); _Pragma("unroll") for (int m = 0; m < 4; ++m) _Pragma("unroll") for (int n = 0; n < 2; ++n) _Pragma("unroll") for (int k = 0; k < 2; ++k) \
        acc[ai][bj][m][n] = __builtin_amdgcn_mfma_f32_16x16x32_bf16(Bt[n][k], At[m][k], acc[ai][bj][m][n], 0, 0, 0); __builtin_amdgcn_s_setprio(0); } while (0)
#define PG8_WAIT_V(n) asm volatile("s_waitcnt vmcnt(" #n ")" ::: "memory")
#define PG8_WAIT_L(n) asm volatile("s_waitcnt lgkmcnt(" #n ")" ::: "memory")
#define PG8_BAR __builtin_amdgcn_s_barrier()
#define PG8_SCHED __builtin_amdgcn_sched_barrier(0)
    Unit cur, nxt; int ui = 0;
    if (!S.next(0, cur)) return;
    f32x4 acc[2][2][4][2];
    E.init(acc, cur, wc, fq);
    bf16x8 At[4][2], B0[2][2], B1[2][2];
    unsigned vC[2][2];
    AS.offs(cur, Rs, Cs, vC);
    unsigned x00 = vC[0][0], x01 = vC[0][1], x10 = vC[1][0], x11 = vC[1][1];
    const char* cA = AS.base(cur); const char* cB = BS.base(cur);
    if constexpr (SP2) {
        PG8_STAGEB(PG8_SB(0, 0), cB); PG8_STAGEB(PG8_SB(0, 1), cB + hstepB); PG8_STAGEA(PG8_SA(0, 0), cA, vC[0][0], vC[0][1]); PG8_STAGEA(PG8_SA(0, 1), cA, vC[1][0], vC[1][1]);
        if (wr == 1) PG8_BAR;
        PG8_WAIT_V(2); PG8_BAR;
        PG8_STAGEB(PG8_SB(1, 0), cB + kstepB); PG8_STAGEA(PG8_SA(1, 0), cA + kstepA, vC[0][0], vC[0][1]); PG8_STAGEB(PG8_SB(1, 1), cB + hstepB + kstepB);
        PG8_WAIT_V(6); PG8_BAR;
    } else {
        PG8_STAGEB(PG8_SB(0, 0), cB); PG8_STAGEA(PG8_SA(0, 0), cA, vC[0][0], vC[0][1]); PG8_STAGEB(PG8_SB(0, 1), cB + hstepB); PG8_STAGEA(PG8_SA(0, 1), cA, vC[1][0], vC[1][1]);
        if (wr == 1) PG8_BAR;
        PG8_WAIT_V(4); PG8_BAR;
        PG8_STAGEB(PG8_SB(1, 0), cB + kstepB); PG8_STAGEA(PG8_SA(1, 0), cA + kstepA, vC[0][0], vC[0][1]); PG8_STAGEB(PG8_SB(1, 1), cB + hstepB + kstepB);
        PG8_WAIT_V(6); PG8_BAR;
    }
    for (;;) {
        const bool has_next = S.next(ui + 1, nxt);
        const char* nA = has_next ? AS.base(nxt) : cA; const char* nB = has_next ? BS.base(nxt) : cB;
        for (int t = 0; t < nt; t += 2) {
            const bool last = (t == nt - 2);
            const char* a1 = cA + (size_t)(t + 1) * kstepA;
            const char* a2 = last ? nA : cA + (size_t)(t + 2) * kstepA; const char* b2 = last ? nB : cB + (size_t)(t + 2) * kstepB;
            const char* a3 = a2 + kstepA; const char* b3 = b2 + kstepB;
            if constexpr (ASrc::GATHER) { if (last && has_next) { unsigned vn[2][2]; AS.offs(nxt, Rs, Cs, vn); x00 = vn[0][0]; x01 = vn[0][1]; x10 = vn[1][0]; x11 = vn[1][1]; } }
            if constexpr (SP2) {
            PG8_LDB(B0, 0, 0); PG8_LDB(B1, 0, 1); PG8_SCHED; PG8_LDA(At, 0, 0); PG8_STAGEA(PG8_SA(1, 1), a1, vC[1][0], vC[1][1]);
            PG8_WAIT_V(8); PG8_WAIT_L(0); PG8_BAR; PG8_MMA(0, 0, At, B0); PG8_MMA(0, 1, At, B1); PG8_BAR; PG8_SCHED;
            PG8_LDA(At, 0, 1); PG8_STAGEB(PG8_SB(0, 0), b2); PG8_STAGEB(PG8_SB(0, 1), b2 + hstepB); PG8_STAGEA(PG8_SA(0, 0), a2, x00, x01);
            PG8_WAIT_V(8); PG8_WAIT_L(0); PG8_BAR; PG8_MMA(1, 0, At, B0); PG8_MMA(1, 1, At, B1); PG8_BAR; PG8_SCHED;
            PG8_LDB(B0, 1, 0); PG8_LDB(B1, 1, 1); PG8_SCHED; PG8_LDA(At, 1, 0); PG8_STAGEA(PG8_SA(0, 1), a2, x10, x11);
            PG8_WAIT_V(8); PG8_WAIT_L(0); PG8_BAR; PG8_MMA(0, 0, At, B0); PG8_MMA(0, 1, At, B1); PG8_BAR; PG8_SCHED;
            PG8_LDA(At, 1, 1); PG8_STAGEB(PG8_SB(1, 0), b3); PG8_STAGEB(PG8_SB(1, 1), b3 + hstepB); PG8_STAGEA(PG8_SA(1, 0), a3, x00, x01);
            PG8_WAIT_V(8); PG8_WAIT_L(0); PG8_BAR; PG8_MMA(1, 0, At, B0); PG8_MMA(1, 1, At, B1); PG8_BAR; PG8_SCHED;
            } else {
            PG8_LDB(B0, 0, 0); PG8_SCHED; PG8_LDA(At, 0, 0); PG8_STAGEA(PG8_SA(1, 1), a1, vC[1][0], vC[1][1]);
            PG8_WAIT_L(8); PG8_BAR; PG8_WAIT_L(0); PG8_MMA(0, 0, At, B0); PG8_BAR; PG8_SCHED;
            PG8_LDB(B1, 0, 1); PG8_STAGEB(PG8_SB(0, 0), b2);
            PG8_BAR; PG8_WAIT_L(0); PG8_MMA(0, 1, At, B1); PG8_BAR;
            PG8_LDA(At, 0, 1); PG8_STAGEA(PG8_SA(0, 0), a2, x00, x01);
            PG8_BAR; PG8_WAIT_L(0); PG8_MMA(1, 0, At, B0); PG8_BAR; PG8_SCHED;
            PG8_STAGEB(PG8_SB(0, 1), b2 + hstepB);
            PG8_WAIT_V(6); PG8_BAR; PG8_MMA(1, 1, At, B1); PG8_BAR;
            PG8_LDB(B0, 1, 0); PG8_SCHED; PG8_LDA(At, 1, 0); PG8_STAGEA(PG8_SA(0, 1), a2, x10, x11);
            PG8_WAIT_L(8); PG8_BAR; PG8_WAIT_L(0); PG8_MMA(0, 0, At, B0); PG8_BAR; PG8_SCHED;
            PG8_LDB(B1, 1, 1); PG8_STAGEB(PG8_SB(1, 0), b3);
            PG8_BAR; PG8_WAIT_L(0); PG8_MMA(0, 1, At, B1); PG8_BAR;
            PG8_LDA(At, 1, 1); PG8_STAGEA(PG8_SA(1, 0), a3, x00, x01);
            PG8_BAR; PG8_WAIT_L(0); PG8_MMA(1, 0, At, B0); PG8_BAR; PG8_SCHED;
            PG8_STAGEB(PG8_SB(1, 1), b3 + hstepB);
            PG8_WAIT_V(6); PG8_BAR; PG8_MMA(1, 1, At, B1); PG8_BAR;
            }
        }
        if constexpr (ALIGN_EPI) { if (wr == 0) PG8_BAR; }
        E(acc, cur, wr, wc, fr, fq);
        if (!has_next) break;
        E.init(acc, nxt, wc, fq);
        cur = nxt; cA = nA; cB = nB; ++ui;
        if constexpr (ASrc::GATHER) { vC[0][0] = x00; vC[0][1] = x01; vC[1][0] = x10; vC[1][1] = x11; }
        if constexpr (ALIGN_EPI) { if (wr == 1) PG8_BAR; }
    }
    PG8_WAIT_V(0);
    if constexpr (!ALIGN_EPI) { if (wr == 0) PG8_BAR; }
    PG8_BAR;
#undef PG8_SA
#undef PG8_SB
#undef PG8_STAGEA
#undef PG8_STAGEB
#undef PG8_LDA
#undef PG8_LDB
#undef PG8_MMA
#undef PG8_WAIT_V
#undef PG8_WAIT_L
#undef PG8_BAR
#undef PG8_SCHED
}
}
namespace pg8 {
__device__ __forceinline__ float gelu_tanh(float x) {
    const float u = 0.7978845608028654f * (x + 0.044715f * x * x * x);
    const float e = __expf(-2.0f * fabsf(u)); float th = (1.0f - e) * __builtin_amdgcn_rcpf(1.0f + e); th = u < 0.f ? -th : th;
    return 0.5f * x * (1.0f + th);
}
struct EpiStore {
    static constexpr bool PERM = true;
    bf16_t* O; int ldc;
    __device__ __forceinline__ void init(f32x4 (&acc)[2][2][4][2], const Unit&, int, int) const {
#pragma unroll
        for (int a = 0; a < 2; ++a)
#pragma unroll
            for (int b = 0; b < 2; ++b)
#pragma unroll
                for (int m = 0; m < 4; ++m)
#pragma unroll
                    for (int n = 0; n < 2; ++n) acc[a][b][m][n] = (f32x4){0.f, 0.f, 0.f, 0.f};
    }
    __device__ __forceinline__ void operator()(const f32x4 (&acc)[2][2][4][2], const Unit& u, int wr, int wc, int fr, int fq) const {
        const int row0 = u.pm * BM + wr * 64 + fr, col0 = u.pn * BM + wc * 32 + 8 * fq;
#pragma unroll
        for (int ai = 0; ai < 2; ++ai)
#pragma unroll
            for (int m = 0; m < 4; ++m) { bf16_t* rowp = O + (size_t)(row0 + ai * HALF + m * 16) * ldc + col0;
#pragma unroll
                for (int bj = 0; bj < 2; ++bj) { const f32x4 v0 = acc[ai][bj][m][0], v1 = acc[ai][bj][m][1];
                    u32x4 w; w.x = cvt_pk_bf16(v0[0], v0[1]); w.y = cvt_pk_bf16(v0[2], v0[3]); w.z = cvt_pk_bf16(v1[0], v1[1]); w.w = cvt_pk_bf16(v1[2], v1[3]);
                    *(u32x4*)(rowp + bj * HALF) = w; } }
    }
};
struct EpiCmpGelu {
    static constexpr bool PERM = true;
    bf16_t* O; const float* bias;
    __device__ __forceinline__ void init(f32x4 (&acc)[2][2][4][2], const Unit&, int, int) const {
#pragma unroll
        for (int a = 0; a < 2; ++a)
#pragma unroll
            for (int b = 0; b < 2; ++b)
#pragma unroll
                for (int m = 0; m < 4; ++m)
#pragma unroll
                    for (int n = 0; n < 2; ++n) acc[a][b][m][n] = (f32x4){0.f, 0.f, 0.f, 0.f};
    }
    __device__ __forceinline__ void operator()(const f32x4 (&acc)[2][2][4][2], const Unit& u, int wr, int wc, int fr, int fq) const {
        const int row0 = u.pm * BM + wr * 64 + fr, col0 = wc * 32 + 8 * fq;
        bf16_t* Oj = O + (size_t)u.e * 16384 * 256; const float* bj_ = bias + u.e * 256;
        f32x4 bv[2][2];
#pragma unroll
        for (int bj = 0; bj < 2; ++bj)
#pragma unroll
            for (int n = 0; n < 2; ++n) bv[bj][n] = *(const f32x4*)(bj_ + col0 + bj * HALF + 4 * n);
#pragma unroll
        for (int ai = 0; ai < 2; ++ai)
#pragma unroll
            for (int m = 0; m < 4; ++m) { bf16_t* rowp = Oj + (size_t)(row0 + ai * HALF + m * 16) * 256 + col0;
#pragma unroll
                for (int bj = 0; bj < 2; ++bj) { f32x4 v0 = acc[ai][bj][m][0] + bv[bj][0], v1 = acc[ai][bj][m][1] + bv[bj][1];
#pragma unroll
                    for (int j = 0; j < 4; ++j) { v0[j] = gelu_tanh(v0[j]); v1[j] = gelu_tanh(v1[j]); }
                    u32x4 w; w.x = cvt_pk_bf16(v0[0], v0[1]); w.y = cvt_pk_bf16(v0[2], v0[3]); w.z = cvt_pk_bf16(v1[0], v1[1]); w.w = cvt_pk_bf16(v1[2], v1[3]);
                    *(u32x4*)(rowp + bj * HALF) = w; } }
    }
};
struct EpiSwiglu {
    static constexpr bool PERM = true;
    bf16_t* H; const float* bgu;
    __device__ __forceinline__ void init(f32x4 (&acc)[2][2][4][2], const Unit& u, int wc, int fq) const {
        const float* bg = bgu + (size_t)u.e * 2048 + u.pn * HALF + wc * 32 + 8 * fq;
#pragma unroll
        for (int n = 0; n < 2; ++n) { const f32x4 g = *(const f32x4*)(bg + 4 * n), up = *(const f32x4*)(bg + 1024 + 4 * n);
#pragma unroll
            for (int a = 0; a < 2; ++a)
#pragma unroll
                for (int m = 0; m < 4; ++m) { acc[a][0][m][n] = g; acc[a][1][m][n] = up; } }
    }
    __device__ __forceinline__ void operator()(const f32x4 (&acc)[2][2][4][2], const Unit& u, int wr, int wc, int fr, int fq) const {
        const int row0 = u.pm * BM + wr * 64 + fr, col0 = u.pn * HALF + wc * 32 + 8 * fq;
#pragma unroll
        for (int ai = 0; ai < 2; ++ai)
#pragma unroll
            for (int m = 0; m < 4; ++m) { bf16_t* rowp = H + (size_t)(row0 + ai * HALF + m * 16) * DFF + col0;
                unsigned wv[4];
#pragma unroll
                for (int n = 0; n < 2; ++n) { const f32x4 g = acc[ai][0][m][n], up = acc[ai][1][m][n];
#pragma unroll
                    for (int j = 0; j < 2; ++j) {
                        const f32x2 gg = {__builtin_amdgcn_fmed3f(g[2 * j], -3.0e38f, 7.0f), __builtin_amdgcn_fmed3f(g[2 * j + 1], -3.0e38f, 7.0f)};
                        const f32x2 uu = {__builtin_amdgcn_fmed3f(up[2 * j], -7.0f, 7.0f), __builtin_amdgcn_fmed3f(up[2 * j + 1], -7.0f, 7.0f)};
                        const f32x2 t = gg * -2.4554669595930156f;
                        f32x2 d = {__builtin_amdgcn_exp2f(t.x), __builtin_amdgcn_exp2f(t.y)}; d = d + 1.0f;
                        const f32x2 rr = {__builtin_amdgcn_rcpf(d.x), __builtin_amdgcn_rcpf(d.y)};
                        const f32x2 o = (uu + 1.0f) * gg * rr;
                        wv[2 * n + j] = cvt_pk_bf16(o.x, o.y); } }
                u32x4 w; w.x = wv[0]; w.y = wv[1]; w.z = wv[2]; w.w = wv[3];
                *(u32x4*)rowp = w; }
    }
};
struct EpiDown {
    static constexpr bool PERM = true;
    bf16_t* Y; const float* bd; const float* rgate;
    __device__ __forceinline__ void init(f32x4 (&acc)[2][2][4][2], const Unit& u, int wc, int fq) const {
        const float* b = bd + (size_t)u.e * 1024 + u.pn * BM + wc * 32 + 8 * fq;
#pragma unroll
        for (int bj = 0; bj < 2; ++bj)
#pragma unroll
            for (int n = 0; n < 2; ++n) { const f32x4 bv = *(const f32x4*)(b + bj * HALF + 4 * n);
#pragma unroll
                for (int a = 0; a < 2; ++a)
#pragma unroll
                    for (int m = 0; m < 4; ++m) acc[a][bj][m][n] = bv; }
    }
    __device__ __forceinline__ void operator()(const f32x4 (&acc)[2][2][4][2], const Unit& u, int wr, int wc, int fr, int fq) const {
        const int row0 = u.pm * BM + wr * 64 + fr, col0 = u.pn * BM + wc * 32 + 8 * fq;
#pragma unroll
        for (int ai = 0; ai < 2; ++ai)
#pragma unroll
            for (int m = 0; m < 4; ++m) { const int row = row0 + ai * HALF + m * 16; const float gt = rgate[row]; bf16_t* rowp = Y + (size_t)row * D + col0;
#pragma unroll
                for (int bj = 0; bj < 2; ++bj) { const f32x4 v0 = acc[ai][bj][m][0] * gt, v1 = acc[ai][bj][m][1] * gt;
                    u32x4 w; w.x = cvt_pk_bf16(v0[0], v0[1]); w.y = cvt_pk_bf16(v0[2], v0[3]); w.z = cvt_pk_bf16(v1[0], v1[1]); w.w = cvt_pk_bf16(v1[2], v1[3]);
                    *(u32x4*)(rowp + bj * HALF) = w; } }
    }
};
}
struct Frame {
    LAS unsigned char* lds;
    volatile LAS unsigned* LC;
    unsigned* ctl;
    unsigned char* ws;
    int tid, lane, wave, G, bx;
    float* out;
};
__device__ __forceinline__ size_t opaque_off(size_t o) { asm volatile("; ws offset" : "+s"(o)); return o; }
#define WSP(T_, off) ((T_*)(F.ws + opaque_off(off)))
__device__ __forceinline__ const float* inptr(const Frame& F, int i) {
    const unsigned lo = __builtin_amdgcn_readfirstlane(F.LC[128 + 2 * i]), hi = __builtin_amdgcn_readfirstlane(F.LC[129 + 2 * i]);
    const float* p = (const float*)(const GAS float*)(((unsigned long long)hi << 32) | (unsigned long long)lo);
    return p;
}
enum { I_X = 0, I_LN_G, I_LN_B, I_NSA_W_IN, I_NSA_CMP_POS, I_NSA_CMP_W1, I_NSA_CMP_B1, I_NSA_CMP_W2, I_NSA_CMP_B2, I_NSA_GATE_B, I_NSA_W_OUT,
       I_ML_W_IN, I_ML_CONV_W, I_ML_CONV_B, I_ML_GATE_B, I_ML_NORM_G, I_ML_W_OUT, I_HG_W_IN, I_HG_LOWER, I_HG_NORM_G, I_HG_W_OUT,
       I_ROUTER_W, I_ROUTER_B, I_MOE_W_GU, I_MOE_B_GU, I_MOE_W_DOWN, I_MOE_B_DOWN };

__device__ __forceinline__ void tr_load(f32x4 (&v)[16], const float* W, int N, int nvalid, int k0, int n0, int lane) {
    const int nn = n0 + 4 * (lane & 15); const bool ok = nn < nvalid; const int kr = lane >> 4;
#pragma unroll
    for (int i = 0; i < 16; ++i) v[i] = ok ? *(const f32x4*)(W + (size_t)(k0 + 4 * i + kr) * N + nn) : (f32x4){0.f, 0.f, 0.f, 0.f};
}
__device__ __forceinline__ void tr_store(const f32x4 (&v)[16], int K, bf16_t* WT, int drow, int k0, LAS float* scr, int lane) {
    const int kr = lane >> 4;
#pragma unroll
    for (int i = 0; i < 16; ++i) { LAS float* d = scr + (4 * i + kr) * 65 + 4 * (lane & 15); d[0] = v[i][0]; d[1] = v[i][1]; d[2] = v[i][2]; d[3] = v[i][3]; }
    LDS_WAIT();
    const int c = lane & 7;
#pragma unroll
    for (int j = 0; j < 8; ++j) { const int n = (lane >> 3) + 8 * j; const LAS float* s = scr + (8 * c) * 65 + n;
        u32x4 o; o.x = pk2(s[0 * 65], s[1 * 65]); o.y = pk2(s[2 * 65], s[3 * 65]); o.z = pk2(s[4 * 65], s[5 * 65]); o.w = pk2(s[6 * 65], s[7 * 65]);
        *(u32x4*)(WT + (size_t)(drow + n) * K + k0 + 8 * c) = o; }
    LDS_WAIT();
}
__device__ __forceinline__ void tr_class(Frame& F, const float* W, int nmat, int K, int N, int Npad, bf16_t* WT, bool gu, LAS float* scr, int gw, int NGW) {
    const int nblk = Npad / 64, per = (K / 64) * nblk; const long total = (long)nmat * per;
    f32x4 vbuf[16];
    long it = gw;
    if (it < total) { const int mat = (int)(it / per), r = (int)(it % per), kb = r / nblk, nb = r % nblk; tr_load(vbuf, W + (size_t)mat * K * N, N, N, kb * 64, nb * 64, F.lane); }
#pragma unroll 1
    for (; it < total; it += NGW) {
        const int mat = (int)(it / per), r = (int)(it % per), kb = r / nblk, nb = r % nblk, n0 = nb * 64;
        int drow = n0;
        if (gu) drow = (n0 < 1024) ? ((n0 >> 7) * 256 + (n0 & 127)) : ((((n0 - 1024) >> 7) * 256) + 128 + ((n0 - 1024) & 127));
        f32x4 cur[16];
#pragma unroll
        for (int i = 0; i < 16; ++i) cur[i] = vbuf[i];
        const long nx = it + NGW;
        if (nx < total) { const int mat2 = (int)(nx / per), r2 = (int)(nx % per), kb2 = r2 / nblk, nb2 = r2 % nblk; tr_load(vbuf, W + (size_t)mat2 * K * N, N, N, kb2 * 64, nb2 * 64, F.lane); }
        tr_store(cur, K, WT + (size_t)mat * Npad * K, drow, kb * 64, scr, F.lane);
    }
}
__device__ __forceinline__ void p0_prologue(Frame& F) {
    LAS float* scr = (LAS float*)(F.lds + F.wave * 16896);
    const int gw = F.bx * 8 + F.wave, NGW = F.G * 8;
    tr_class(F, inptr(F, I_MOE_W_GU), DEPTH * NEXP, D, 2 * DFF, 2 * DFF, WSP(bf16_t, OFF_W_GU), true, scr, gw, NGW);
    tr_class(F, inptr(F, I_MOE_W_DOWN), DEPTH * NEXP, DFF, D, D, WSP(bf16_t, OFF_W_DN), false, scr, gw, NGW);
    tr_class(F, inptr(F, I_NSA_W_IN), 2, D, NSA_IN, NSA_LD, WSP(bf16_t, OFF_W_NSAIN), false, scr, gw, NGW);
    tr_class(F, inptr(F, I_NSA_W_OUT), 2, D, D, D, WSP(bf16_t, OFF_W_NSAOUT), false, scr, gw, NGW);
    tr_class(F, inptr(F, I_ML_W_IN), 1, D, ML_IN, ML_LD, WSP(bf16_t, OFF_W_MLIN), false, scr, gw, NGW);
    tr_class(F, inptr(F, I_ML_W_OUT), 1, D, D, D, WSP(bf16_t, OFF_W_MLOUT), false, scr, gw, NGW);
    tr_class(F, inptr(F, I_HG_W_IN), 1, D, HG_LD, HG_LD, WSP(bf16_t, OFF_W_HGIN), false, scr, gw, NGW);
    tr_class(F, inptr(F, I_HG_W_OUT), 1, D, D, D, WSP(bf16_t, OFF_W_HGOUT), false, scr, gw, NGW);
    tr_class(F, inptr(F, I_NSA_CMP_W1), 4, 2048, 256, 256, WSP(bf16_t, OFF_W_CMP1), false, scr, gw, NGW);
    tr_class(F, inptr(F, I_NSA_CMP_W2), 4, 256, 64, 64, WSP(bf16_t, OFF_W_CMP2), false, scr, gw, NGW);
    const int gt = F.bx * 512 + F.tid;
    float* tab = WSP(float, OFF_TAB);
    if (gt < 1024) {
        const int lj = gt >> 8, n = gt & 255; const float* pos = inptr(F, I_NSA_CMP_POS) + (size_t)lj * 2048; const float* w1 = inptr(F, I_NSA_CMP_W1) + (size_t)lj * 2048 * 256;
        float a = inptr(F, I_NSA_CMP_B1)[lj * 256 + n];
        for (int k = 0; k < 2048; ++k) a += pos[k] * w1[(size_t)k * 256 + n];
        tab[TAB_CMPB + gt] = a;
    } else if (gt < 2048) {
        const int c = gt - 1024; float v[DEPTH], mx = -1e30f;
#pragma unroll
        for (int i = 0; i < DEPTH; ++i) { v[i] = inptr(F, I_HG_LOWER)[i * D + c]; mx = fmaxf(mx, v[i]); }
        float s = 0.f;
#pragma unroll
        for (int i = 0; i < DEPTH; ++i) { v[i] = __expf(v[i] - mx); s += v[i]; }
        tab[TAB_LB + c] = (v[1] + v[2]) / s;
    }
    { const float* rw = inptr(F, I_ROUTER_W); float* rwt = WSP(float, OFF_TAB) + TAB_RWT;
      for (int i = F.bx * 512 + F.tid; i < DEPTH * D * NEXP; i += F.G * 512) { const int l = i >> 15, r = i & 32767, k = r >> 5, e = r & 31; rwt[(l * NEXP + e) * D + k] = rw[i]; } }
    {
        const f32x4* xs = (const f32x4*)inptr(F, I_X); u32x2* xn = WSP(u32x2, OFF_XN);
        const size_t n4 = (size_t)NTOK * D / 4, stride = (size_t)F.G * 512;
        for (size_t i = (size_t)F.bx * 512 + F.tid; i < n4; i += stride) { const f32x4 v = xs[i]; u32x2 o; o.x = pk2(v[0], v[1]); o.y = pk2(v[2], v[3]); xn[i] = o; }
    }
}

__device__ __forceinline__ void split8(const f32x4& x0, const f32x4& x1, bf16x8& hi, bf16x8& lo) {
    u32x4 h, l;
    h.x = pk2(x0[0], x0[1]); h.y = pk2(x0[2], x0[3]); h.z = pk2(x1[0], x1[1]); h.w = pk2(x1[2], x1[3]);
    l.x = pk2(x0[0] - __uint_as_float(h.x << 16), x0[1] - __uint_as_float(h.x & 0xffff0000u)); l.y = pk2(x0[2] - __uint_as_float(h.y << 16), x0[3] - __uint_as_float(h.y & 0xffff0000u));
    l.z = pk2(x1[0] - __uint_as_float(h.z << 16), x1[1] - __uint_as_float(h.z & 0xffff0000u)); l.w = pk2(x1[2] - __uint_as_float(h.w << 16), x1[3] - __uint_as_float(h.w & 0xffff0000u));
    hi = __builtin_bit_cast(bf16x8, h); lo = __builtin_bit_cast(bf16x8, l);
}
__device__ __forceinline__ void phase_ln_router(Frame& F, int layer, bool dummy = false) {
    constexpr int SP = 1028;
    LAS float* LgL = (LAS float*)F.lds;
    LAS float* slab = LgL + 256 * 33;
    LAS float* part = slab + 16 * SP;
    if (F.tid < 32) F.LC[64 + F.tid] = 0u;
    __syncthreads();
    const float* g = inptr(F, I_LN_G) + (size_t)(layer * 2 + 0) * D; const float* bb = inptr(F, I_LN_B) + (size_t)(layer * 2 + 0) * D;
    const float* rb = inptr(F, I_ROUTER_B) + layer * NEXP;
    const float* rwt = WSP(float, OFF_TAB) + TAB_RWT + (size_t)layer * NEXP * D;
    const bf16_t* HM = WSP(bf16_t, OFF_HM); bf16_t* XN = dummy ? WSP(bf16_t, OFF_H + 256 * MiB) : WSP(bf16_t, OFF_XN);
    const bf16_t* XR = WSP(bf16_t, OFF_XN);
    int* toke = dummy ? WSP(int, OFF_H + 400 * MiB) : WSP(int, OFF_TOKE); float* tokg = dummy ? WSP(float, OFF_H + 402 * MiB) : WSP(float, OFF_TOKG);
    int lane = F.lane; asm volatile("; phase-local lane" : "+v"(lane));
    const int fr = lane & 15, fg = lane >> 4, wave = F.wave;
    const float rbv = rb[F.tid & 31];
    f32x4 gr[4], br[4];
    bf16x8 bh0[4], bl0[4], bh1[4], bl1[4];
    {
#pragma unroll
      for (int ks = 0; ks < 4; ++ks) { const float* q0 = rwt + (size_t)fr * D + 128 * wave + 32 * ks + 8 * fg; const float* q1 = q0 + (size_t)16 * D;
          const f32x4 w0 = *(const f32x4*)q0, w1 = *(const f32x4*)(q0 + 4), w2 = *(const f32x4*)q1, w3 = *(const f32x4*)(q1 + 4);
          split8(w0, w1, bh0[ks], bl0[ks]); split8(w2, w3, bh1[ks], bl1[ks]); }
#pragma unroll
      for (int j = 0; j < 4; ++j) { gr[j] = *((const f32x4*)g + lane + 64 * j); br[j] = *((const f32x4*)bb + lane + 64 * j); } }
    for (int blk = F.bx; blk < NTOK / 256; blk += F.G) {
        u32x2 xn_[2][4], hn_[2][4];
        { const int m0 = blk * 256 + 2 * wave;
#pragma unroll
          for (int q = 0; q < 2; ++q) { const u32x2* xr = (const u32x2*)(XR + (size_t)(m0 + q) * D) + lane; const u32x2* hr = (const u32x2*)(HM + (size_t)(m0 + q) * D) + lane;
#pragma unroll
            for (int j = 0; j < 4; ++j) { xn_[q][j] = xr[64 * j]; hn_[q][j] = hr[64 * j]; } } }
#pragma unroll 1
        for (int sub = 0; sub < 16; ++sub) {
            const int mb = blk * 256 + sub * 16 + 2 * wave;
            f32x4 v[2][4]; float s[2] = {0.f, 0.f};
#pragma unroll
            for (int q = 0; q < 2; ++q)
#pragma unroll
                for (int j = 0; j < 4; ++j) { const u32x2 xv = xn_[q][j]; const u32x2 hv = hn_[q][j];
                    v[q][j][0] = DN_ALPHA * __uint_as_float(xv.x << 16) + __uint_as_float(hv.x << 16); v[q][j][1] = DN_ALPHA * __uint_as_float(xv.x & 0xffff0000u) + __uint_as_float(hv.x & 0xffff0000u);
                    v[q][j][2] = DN_ALPHA * __uint_as_float(xv.y << 16) + __uint_as_float(hv.y << 16); v[q][j][3] = DN_ALPHA * __uint_as_float(xv.y & 0xffff0000u) + __uint_as_float(hv.y & 0xffff0000u);
                    s[q] += (v[q][j][0] + v[q][j][1]) + (v[q][j][2] + v[q][j][3]); }
            if (sub + 1 < 16) {
#pragma unroll
                for (int q = 0; q < 2; ++q) { const u32x2* xr = (const u32x2*)(XR + (size_t)(mb + 16 + q) * D) + lane; const u32x2* hr = (const u32x2*)(HM + (size_t)(mb + 16 + q) * D) + lane;
#pragma unroll
                    for (int j = 0; j < 4; ++j) { xn_[q][j] = xr[64 * j]; hn_[q][j] = hr[64 * j]; } } }
#pragma unroll
            for (int q = 0; q < 2; ++q) {
                const float mean = wave_sum(s[q]) * (1.f / D); float s2 = 0.f;
#pragma unroll
                for (int j = 0; j < 4; ++j) { v[q][j] = v[q][j] - mean; s2 += (v[q][j][0] * v[q][j][0] + v[q][j][1] * v[q][j][1]) + (v[q][j][2] * v[q][j][2] + v[q][j][3] * v[q][j][3]); }
                const float rstd = __builtin_amdgcn_rsqf(wave_sum(s2) * (1.f / D) + LN_EPS);
                u32x2* no = (u32x2*)(XN + (size_t)(mb + q) * D) + lane; LAS f32x4* so = (LAS f32x4*)(slab + (2 * wave + q) * SP) + lane;
#pragma unroll
                for (int j = 0; j < 4; ++j) { const f32x4 gv = gr[j], bv = br[j];
                    const f32x4 y = v[q][j] * rstd * gv + bv; so[64 * j] = y; u32x2 o; o.x = pk2(y[0], y[1]); o.y = pk2(y[2], y[3]); no[64 * j] = o; }
            }
            __syncthreads();
            {
                const LAS float* Ap = slab + fr * SP + 128 * wave + 8 * fg;
                f32x4 acc0 = (f32x4){0.f, 0.f, 0.f, 0.f}, acc1 = acc0;
#pragma unroll
                for (int ks = 0; ks < 4; ++ks) { bf16x8 ah, al; const f32x4 xa = *(const LAS f32x4*)(Ap + 32 * ks), xb = *(const LAS f32x4*)(Ap + 32 * ks + 4); split8(xa, xb, ah, al);
                    acc0 = __builtin_amdgcn_mfma_f32_16x16x32_bf16(ah, bh0[ks], acc0, 0, 0, 0); acc1 = __builtin_amdgcn_mfma_f32_16x16x32_bf16(ah, bh1[ks], acc1, 0, 0, 0);
                    acc0 = __builtin_amdgcn_mfma_f32_16x16x32_bf16(al, bh0[ks], acc0, 0, 0, 0); acc1 = __builtin_amdgcn_mfma_f32_16x16x32_bf16(al, bh1[ks], acc1, 0, 0, 0);
                    acc0 = __builtin_amdgcn_mfma_f32_16x16x32_bf16(ah, bl0[ks], acc0, 0, 0, 0); acc1 = __builtin_amdgcn_mfma_f32_16x16x32_bf16(ah, bl1[ks], acc1, 0, 0, 0); }
#pragma unroll
                for (int e = 0; e < 4; ++e) { LAS float* pr = part + (wave * 16 + 4 * fg + e) * 33; pr[fr] = acc0[e]; pr[16 + fr] = acc1[e]; }
            }
            __syncthreads();
            { const int row = F.tid >> 5, e = F.tid & 31; float lg = rbv;
#pragma unroll
              for (int w8 = 0; w8 < 8; ++w8) lg += part[(w8 * 16 + row) * 33 + e];
              LgL[(sub * 16 + row) * 33 + e] = lg; }
        }
        __syncthreads();
        if (F.tid < 256) {
            const int m = blk * 256 + F.tid; const LAS float* lr = LgL + F.tid * 33;
            unsigned taken = 0u; int se[TOPK]; float sv[TOPK];
#pragma unroll
            for (int k = 0; k < TOPK; ++k) { float best = -INFINITY; int bi = 0;
#pragma unroll 8
                for (int e = 0; e < NEXP; ++e) { const float c = ((taken >> e) & 1u) ? -INFINITY : lr[e]; if (c > best) { best = c; bi = e; } }
                se[k] = bi; sv[k] = best; taken |= 1u << bi; }
            float gs = 0.f, ge[TOPK];
#pragma unroll
            for (int k = 0; k < TOPK; ++k) { ge[k] = __expf(sv[k] - sv[0]); gs += ge[k]; }
            const float inv = __builtin_amdgcn_rcpf(gs);
#pragma unroll
            for (int k = 0; k < TOPK; ++k) { toke[m * 4 + k] = se[k]; tokg[m * 4 + k] = ge[k] * inv; __hip_atomic_fetch_add((LAS unsigned*)&F.LC[64 + se[k]], 1u, __ATOMIC_RELAXED, __HIP_MEMORY_SCOPE_WORKGROUP); }
        }
        __syncthreads();
    }
    if (F.tid < 32) { const unsigned c = F.LC[64 + F.tid]; if (c) __hip_atomic_fetch_add(F.ctl + (dummy ? 12288 : CW_CNT) + layer * 64 + F.tid, c, RLX_AGENT); }
    __syncthreads();
}

__device__ __forceinline__ void moe_tile_table(Frame& F, int layer) {
    if (F.tid < 64) {
        const int e = F.tid & 31;
        const unsigned c = __hip_atomic_load(F.ctl + CW_CNT + layer * 64 + e, RLX_AGENT);
        int acc = (int)((c + 255u) >> 8);
#pragma unroll
        for (int o = 1; o < 32; o <<= 1) { const int u = __shfl_up(acc, o); if (e >= o) acc += u; }
        if (F.tid < 32) { F.LC[8 + e] = (unsigned)acc; if (e == 31) F.LC[40] = (unsigned)acc; }
    }
    __syncthreads();
}
__device__ __forceinline__ void phase_moe_slots(Frame& F, int layer) {
    moe_tile_table(F, layer);
    const int* toke = WSP(int, OFF_TOKE); const float* tokg = WSP(float, OFF_TOKG);
    int* tokp = WSP(int, OFF_TOKP); int* rowt = WSP(int, OFF_ROWT); float* rowg = WSP(float, OFF_ROWG);
    for (int blk = F.bx; blk < NTOK / 256; blk += F.G) {
        if (F.tid < 32) F.LC[64 + F.tid] = 0u;
        __syncthreads();
        int e[2], rank[2];
#pragma unroll
        for (int q = 0; q < 2; ++q) { const int a = blk * 1024 + q * 512 + F.tid; e[q] = toke[a]; rank[q] = (int)__hip_atomic_fetch_add((LAS unsigned*)&F.LC[64 + e[q]], 1u, __ATOMIC_RELAXED, __HIP_MEMORY_SCOPE_WORKGROUP); }
        __syncthreads();
        if (F.tid < 32) { const unsigned c = F.LC[64 + F.tid]; const unsigned pstart = (F.tid ? F.LC[8 + F.tid - 1] : 0u) * 256u;
            F.LC[96 + F.tid] = pstart + (c ? __hip_atomic_fetch_add(F.ctl + CW_CUR + layer * 64 + F.tid, c, RLX_AGENT) : 0u); }
        __syncthreads();
#pragma unroll
        for (int q = 0; q < 2; ++q) { const int a = blk * 1024 + q * 512 + F.tid; const int pos = (int)F.LC[96 + e[q]] + rank[q];
            rowt[pos] = a >> 2; rowg[pos] = tokg[a]; tokp[a] = pos; }
        __syncthreads();
    }
    for (int e2 = F.bx; e2 < NEXP; e2 += F.G) {
        const unsigned c = __hip_atomic_load(F.ctl + CW_CNT + layer * 64 + e2, RLX_AGENT); const unsigned pstart = (e2 ? F.LC[8 + e2 - 1] : 0u) * 256u, pend = F.LC[8 + e2] * 256u;
        for (unsigned r = pstart + c + F.tid; r < pend; r += 512) { rowt[r] = 0; rowg[r] = 0.f; }
    }
}
__device__ __forceinline__ void phase_combine_ln(Frame& F, int layer, float* xo_base  , bool dummy = false) {
    const float* g = inptr(F, I_LN_G) + (size_t)(layer * 2 + 1) * D; const float* bb = inptr(F, I_LN_B) + (size_t)(layer * 2 + 1) * D;
    const bf16_t* XR = WSP(bf16_t, OFF_XN); bf16_t* XN = dummy ? WSP(bf16_t, OFF_H + 256 * MiB) : WSP(bf16_t, OFF_XN); const bf16_t* Y = WSP(bf16_t, OFF_Y); const int* tokp = WSP(int, OFF_TOKP);
    int lane = F.lane; asm volatile("; phase-local lane" : "+v"(lane)); const int gw = F.bx * 8 + F.wave, NGW = F.G * 8;
    u32x2 xq[4]; u32x2 yq[TOPK][4]; int posn[TOPK];
    f32x4 gr[4], br[4];
#pragma unroll
    for (int j = 0; j < 4; ++j) { gr[j] = *((const f32x4*)g + lane + 64 * j); br[j] = *((const f32x4*)bb + lane + 64 * j); }
    {
        int p0[TOPK];
#pragma unroll
        for (int k = 0; k < TOPK; ++k) p0[k] = (gw < NTOK) ? tokp[gw * 4 + k] : 0;
        if (gw < NTOK) { const u32x2* xr = (const u32x2*)(XR + (size_t)gw * D) + lane;
#pragma unroll
            for (int j = 0; j < 4; ++j) xq[j] = xr[64 * j];
#pragma unroll
            for (int k = 0; k < TOPK; ++k) { const u32x2* yr = (const u32x2*)(Y + (size_t)p0[k] * D) + lane;
#pragma unroll
                for (int j = 0; j < 4; ++j) yq[k][j] = __builtin_nontemporal_load(yr + 64 * j); } }
#pragma unroll
        for (int k = 0; k < TOPK; ++k) posn[k] = (gw + NGW < NTOK) ? tokp[(gw + NGW) * 4 + k] : 0;
    }
#pragma unroll 1
    for (int m = gw; m < NTOK; m += NGW) {
        f32x4 v[4]; float s = 0.f;
#pragma unroll
        for (int j = 0; j < 4; ++j) { const u32x2 xv = xq[j]; v[j][0] = DN_ALPHA * __uint_as_float(xv.x << 16); v[j][1] = DN_ALPHA * __uint_as_float(xv.x & 0xffff0000u); v[j][2] = DN_ALPHA * __uint_as_float(xv.y << 16); v[j][3] = DN_ALPHA * __uint_as_float(xv.y & 0xffff0000u); }
#pragma unroll
        for (int k = 0; k < TOPK; ++k) {
#pragma unroll
            for (int j = 0; j < 4; ++j) { const u32x2 hv = yq[k][j];
                v[j][0] += __uint_as_float(hv.x << 16); v[j][1] += __uint_as_float(hv.x & 0xffff0000u); v[j][2] += __uint_as_float(hv.y << 16); v[j][3] += __uint_as_float(hv.y & 0xffff0000u); } }
        if (m + NGW < NTOK) {
            const u32x2* xr = (const u32x2*)(XR + (size_t)(m + NGW) * D) + lane;
#pragma unroll
            for (int j = 0; j < 4; ++j) xq[j] = xr[64 * j];
#pragma unroll
            for (int k = 0; k < TOPK; ++k) { const u32x2* yr = (const u32x2*)(Y + (size_t)posn[k] * D) + lane;
#pragma unroll
                for (int j = 0; j < 4; ++j) yq[k][j] = __builtin_nontemporal_load(yr + 64 * j); }
#pragma unroll
            for (int k = 0; k < TOPK; ++k) posn[k] = (m + 2 * NGW < NTOK) ? tokp[(m + 2 * NGW) * 4 + k] : 0;
        }
#pragma unroll
        for (int j = 0; j < 4; ++j) s += (v[j][0] + v[j][1]) + (v[j][2] + v[j][3]);
        const float mean = wave_sum(s) * (1.f / D); float s2 = 0.f;
#pragma unroll
        for (int j = 0; j < 4; ++j) { v[j] = v[j] - mean; s2 += (v[j][0] * v[j][0] + v[j][1] * v[j][1]) + (v[j][2] * v[j][2] + v[j][3] * v[j][3]); }
        const float rstd = __builtin_amdgcn_rsqf(wave_sum(s2) * (1.f / D) + LN_EPS);
        u32x2* no = (u32x2*)(XN + (size_t)m * D) + lane;
#pragma unroll
        for (int j = 0; j < 4; ++j) { const f32x4 gv = gr[j], bv = br[j];
            v[j] = v[j] * rstd * gv + bv;
            if (xo_base) *((f32x4*)(xo_base + (size_t)m * D) + lane + 64 * j) = v[j];
            else { u32x2 o; o.x = pk2(v[j][0], v[j][1]); o.y = pk2(v[j][2], v[j][3]); no[64 * j] = o; } }
    }
}
__device__ __forceinline__ void phase_nsa_cmp2(Frame& F, int slot) {
    const bf16_t* HC = WSP(bf16_t, OFF_HC); bf16_t* KC = WSP(bf16_t, OFF_KC);
    const bf16_t* W2t = WSP(bf16_t, OFF_W_CMP2) + (size_t)slot * 2 * 64 * 256;
    const float* b2 = inptr(F, I_NSA_CMP_B2) + (size_t)slot * 2 * 64;
    int lane = F.lane; asm volatile("; phase-local lane" : "+v"(lane));
    const int fr = lane & 15, fg = lane >> 4, gw = F.bx * 8 + F.wave, NGW = F.G * 8;
    for (int blk = gw; blk < 2 * 1024; blk += NGW) {
        const int j = blk >> 10, r0 = (blk & 1023) * 16;
        const bf16_t* A = HC + ((size_t)j * 16384 + r0 + fr) * 256 + 8 * fg;
        const bf16_t* B = W2t + ((size_t)j * 64 + fr) * 256 + 8 * fg;
        f32x4 acc[4];
#pragma unroll
        for (int t = 0; t < 4; ++t) acc[t] = (f32x4){0.f, 0.f, 0.f, 0.f};
#pragma unroll
        for (int ks = 0; ks < 8; ++ks) { const bf16x8 a = *(const bf16x8*)(A + 32 * ks);
#pragma unroll
            for (int t = 0; t < 4; ++t) acc[t] = __builtin_amdgcn_mfma_f32_16x16x32_bf16(*(const bf16x8*)(B + (size_t)t * 16 * 256 + 32 * ks), a, acc[t], 0, 0, 0); }
        const int row = r0 + fr;
#pragma unroll
        for (int t = 0; t < 4; ++t) { const int d0 = 16 * t + 4 * fg; const f32x4 bv = *(const f32x4*)(b2 + j * 64 + d0);
            f32x4 v = acc[t] + bv; if ((row & 127) == 127) v = (f32x4){0.f, 0.f, 0.f, 0.f};
            u32x2 w; w.x = pg8::cvt_pk_bf16(v[0], v[1]); w.y = pg8::cvt_pk_bf16(v[2], v[3]);
            *(u32x2*)(KC + ((size_t)j * 16384 + row) * 64 + d0) = w; }
    }
}
typedef float f32x16 __attribute__((ext_vector_type(16)));
#define PP_SYNC() do { __builtin_amdgcn_sched_barrier(0); __syncthreads(); __builtin_amdgcn_sched_barrier(0); } while (0)
#ifndef SP_SCALAR
#define SP_SCALAR 0
#endif
#ifndef SP_FILL
#define SP_FILL 12
#endif
#ifndef XCMP
#define XCMP 0
#endif
#ifndef XSELN
#define XSELN 0
#endif
#ifndef XOUT
#define XOUT 0
#endif
namespace na {
constexpr int KP = 144;
constexpr int VP = 144;
__device__ __forceinline__ int vcol(int key) { return (key & ~15) | (key & 3) | ((key & 8) >> 1) | ((key & 4) << 1); }
constexpr int TILEB = 64 * KP;
constexpr int L_K = 0, L_V = 2 * TILEB, L_PQ = 4 * TILEB, SLB = 64 * 33, L_SEL = L_PQ + 4 * SLB * 4, L_OA = L_SEL + 4864;
constexpr float NEG = -1e30f;
constexpr float C1 = 0.125f * 1.4426950408889634f;
__device__ __forceinline__ int crow(int r, int hi) { return (r & 3) + 8 * (r >> 2) + 4 * hi; }
__device__ __forceinline__ bf16x8 pack8(const f32x16& p, int s1) {
    u32x4 w; w.x = pg8::cvt_pk_bf16(p[8 * s1 + 0], p[8 * s1 + 1]); w.y = pg8::cvt_pk_bf16(p[8 * s1 + 2], p[8 * s1 + 3]);
    w.z = pg8::cvt_pk_bf16(p[8 * s1 + 4], p[8 * s1 + 5]); w.w = pg8::cvt_pk_bf16(p[8 * s1 + 6], p[8 * s1 + 7]);
    return __builtin_bit_cast(bf16x8, w);
}
__device__ __forceinline__ void qk(f32x16& p0, f32x16& p1, const LAS unsigned char* Kt, const bf16x8 (&qf)[4], int r, int h) {
    const f32x16 z = {0.f, 0.f, 0.f, 0.f, 0.f, 0.f, 0.f, 0.f, 0.f, 0.f, 0.f, 0.f, 0.f, 0.f, 0.f, 0.f};
    bf16x8 a0[4], a1[4];
#pragma unroll
    for (int s = 0; s < 4; ++s) { a0[s] = *(const LAS bf16x8*)(Kt + r * KP + (16 * s + 8 * h) * 2); a1[s] = *(const LAS bf16x8*)(Kt + (32 + r) * KP + (16 * s + 8 * h) * 2); }
    __builtin_amdgcn_sched_barrier(0);
#pragma unroll
    for (int s = 0; s < 4; ++s) {
        p0 = __builtin_amdgcn_mfma_f32_32x32x16_bf16(a0[s], qf[s], s == 0 ? z : p0, 0, 0, 0);
        p1 = __builtin_amdgcn_mfma_f32_32x32x16_bf16(a1[s], qf[s], s == 0 ? z : p1, 0, 0, 0);
    }
}
__device__ __forceinline__ void pv(f32x16& o0, f32x16& o1, const LAS unsigned char* Vt, const f32x16& p0, const f32x16& p1, int r, int h) {
#pragma unroll
    for (int s = 0; s < 4; ++s) {
        const int s1 = s & 1;
        const bf16x8 bfrag = (s < 2) ? pack8(p0, s1) : pack8(p1, s1);
        const int key0 = 32 * (s >> 1) + 16 * s1 + 4 * h;
#pragma unroll
        for (int dh = 0; dh < 2; ++dh) {
            const bf16x8 a = *(const LAS bf16x8*)(Vt + (32 * dh + r) * VP + (key0 - 4 * h + 8 * h) * 2);
            if (dh == 0) o0 = __builtin_amdgcn_mfma_f32_32x32x16_bf16(a, bfrag, o0, 0, 0, 0);
            else o1 = __builtin_amdgcn_mfma_f32_32x32x16_bf16(a, bfrag, o1, 0, 0, 0);
        }
    }
}
__device__ __forceinline__ void pack_p(bf16x8 (&pb)[4], const f32x16& p0, const f32x16& p1) { pb[0] = pack8(p0, 0); pb[1] = pack8(p0, 1); pb[2] = pack8(p1, 0); pb[3] = pack8(p1, 1); }
__device__ __forceinline__ void pv2(f32x16& o0, f32x16& o1, const LAS unsigned char* Vt, const bf16x8 (&pb)[4], int r, int h) {
    bf16x8 a[4][2];
#pragma unroll
    for (int s = 0; s < 4; ++s) {
        const int key0 = 32 * (s >> 1) + 16 * (s & 1) + 4 * h;
#pragma unroll
        for (int dh = 0; dh < 2; ++dh) {
            a[s][dh] = *(const LAS bf16x8*)(Vt + (32 * dh + r) * VP + (key0 - 4 * h + 8 * h) * 2);
        }
    }
    __builtin_amdgcn_sched_barrier(0);
#pragma unroll
    for (int s = 0; s < 4; ++s) {
        o0 = __builtin_amdgcn_mfma_f32_32x32x16_bf16(a[s][0], pb[s], o0, 0, 0, 0);
        o1 = __builtin_amdgcn_mfma_f32_32x32x16_bf16(a[s][1], pb[s], o1, 0, 0, 0);
    }
}
__device__ __forceinline__ void softmax_step(f32x16& p0, f32x16& p1, float& m, float& l, f32x16& o0, f32x16& o1, bool lane_on = true) {
    constexpr float THR = 8.0f / C1;
    float mx = fmaxf(fmaxf(fmaxf(p0[0], p1[5]), fmaxf(p0[10], p1[15])), fmaxf(fmaxf(p1[0], p0[5]), fmaxf(p1[10], p0[15])));
    mx = lane_on ? mx : NEG;
    mx = fmaxf(mx, __shfl_xor(mx, 32));
    const float mn = (mx > m + THR) ? mx : m;
    const float muse = (mn < -1e29f) ? 0.f : mn;
    const bool grow = mn != m;
    const float mc = lane_on ? muse * C1 : 3.0e38f;
    f32x2 lsa = {0.f, 0.f}, lsb = {0.f, 0.f}; const f32x2 c1v = {C1, C1}, nmc = {-mc, -mc};
#pragma unroll
    for (int i = 0; i < 8; ++i) {
        f32x2 a = {p0[2 * i], p0[2 * i + 1]}, b = {p1[2 * i], p1[2 * i + 1]};
        a = __builtin_elementwise_fma(a, c1v, nmc); b = __builtin_elementwise_fma(b, c1v, nmc);
        a.x = __builtin_amdgcn_exp2f(a.x); a.y = __builtin_amdgcn_exp2f(a.y); b.x = __builtin_amdgcn_exp2f(b.x); b.y = __builtin_amdgcn_exp2f(b.y);
        p0[2 * i] = a.x; p0[2 * i + 1] = a.y; p1[2 * i] = b.x; p1[2 * i + 1] = b.y; lsa += a; lsb += b; }
    const float ls = (lsa.x + lsa.y) + (lsb.x + lsb.y);
    if (__builtin_amdgcn_ballot_w64(grow) != 0ull) {
        const float alpha = __builtin_amdgcn_exp2f((((m < -1e29f) ? 0.f : m) - muse) * C1);
        l = l * alpha;
#pragma unroll
        for (int i = 0; i < 16; ++i) { o0[i] *= alpha; o1[i] *= alpha; }
        m = mn;
    }
    l += ls;
}
__device__ __forceinline__ void softmax_heavy(f32x16& p0, f32x16& p1, const float m, float& l, float& mxraw, bool lane_on) {
    const float mx = fmaxf(fmaxf(fmaxf(p0[0], p1[5]), fmaxf(p0[10], p1[15])), fmaxf(fmaxf(p1[0], p0[5]), fmaxf(p1[10], p0[15])));
    mxraw = lane_on ? mx : NEG;
    const float muse = (m < -1e29f) ? 0.f : m;
    const float mc = lane_on ? muse * C1 : 3.0e38f;
#if SP_SCALAR
    float ls0 = 0.f, ls1 = 0.f;
#pragma unroll
    for (int i = 0; i < 16; ++i) { p0[i] = __builtin_amdgcn_exp2f(p0[i] * C1 - mc); p1[i] = __builtin_amdgcn_exp2f(p1[i] * C1 - mc); ls0 += p0[i]; ls1 += p1[i]; }
    l += ls0 + ls1;
#else
    f32x2 lsa = {0.f, 0.f}, lsb = {0.f, 0.f}; const f32x2 c1v = {C1, C1}, nmc = {-mc, -mc};
#pragma unroll
    for (int i = 0; i < 8; ++i) {
        f32x2 a = {p0[2 * i], p0[2 * i + 1]}, b = {p1[2 * i], p1[2 * i + 1]};
        a = __builtin_elementwise_fma(a, c1v, nmc); b = __builtin_elementwise_fma(b, c1v, nmc);
        a.x = __builtin_amdgcn_exp2f(a.x); a.y = __builtin_amdgcn_exp2f(a.y); b.x = __builtin_amdgcn_exp2f(b.x); b.y = __builtin_amdgcn_exp2f(b.y);
        p0[2 * i] = a.x; p0[2 * i + 1] = a.y; p1[2 * i] = b.x; p1[2 * i + 1] = b.y; lsa += a; lsb += b; }
    l += (lsa.x + lsa.y) + (lsb.x + lsb.y);
#endif
}
__device__ __forceinline__ void softmax_light(float mxraw, float& m, float& l, f32x16& o0, f32x16& o1) {
    constexpr float THR = 8.0f / C1;
    const float mx = fmaxf(mxraw, __shfl_xor(mxraw, 32));
    const float mn = (mx > m + THR) ? mx : m;
    if (__builtin_amdgcn_ballot_w64(mn != m) != 0ull) {
        const float alpha = __builtin_amdgcn_exp2f((((m < -1e29f) ? 0.f : m) - ((mn < -1e29f) ? 0.f : mn)) * C1);
        l = l * alpha;
#pragma unroll
        for (int i = 0; i < 16; ++i) { o0[i] *= alpha; o1[i] *= alpha; }
        m = mn;
    }
}
struct Stage { u32x4 k, v; };
__device__ __forceinline__ void stage_load(Stage& st, const bf16_t* ksrc, const bf16_t* vsrc, long stride, int tid) {
    const int key = tid >> 3, dc = tid & 7, vkey = tid & 63, vdc = tid >> 6;
    st.k = *(const u32x4*)(ksrc + (long)key * stride + dc * 8); st.v = *(const u32x4*)(vsrc + (long)vkey * stride + vdc * 8);
}
__device__ __forceinline__ void stage_store(const Stage& st, LAS unsigned char* Kt, LAS unsigned char* Vt, int tid) {
    const int key = tid >> 3, dc = tid & 7, vkey = tid & 63, vdc = tid >> 6;
    *(LAS u32x4*)(Kt + key * KP + dc * 16) = st.k;
    const unsigned w[4] = {st.v.x, st.v.y, st.v.z, st.v.w};
#pragma unroll
    for (int e = 0; e < 4; ++e) { *(LAS unsigned short*)(Vt + (vdc * 8 + 2 * e) * VP + vcol(vkey) * 2) = (unsigned short)(w[e] & 0xffffu); *(LAS unsigned short*)(Vt + (vdc * 8 + 2 * e + 1) * VP + vcol(vkey) * 2) = (unsigned short)(w[e] >> 16); }
}
__device__ __forceinline__ void pp_load(u32x4 (&sg)[2], const bf16_t* src, long stride, int t256, int kind) {
    if (kind == 0) {
#pragma unroll
        for (int j = 0; j < 2; ++j) { const int c = t256 + 256 * j; sg[j] = *(const u32x4*)(src + (long)(c >> 3) * stride + (c & 7) * 8); }
    } else {
#pragma unroll
        for (int j = 0; j < 2; ++j) { const int c = t256 + 256 * j; sg[j] = *(const u32x4*)(src + (long)(c & 63) * stride + (c >> 6) * 8); }
    }
}
__device__ __forceinline__ void pp_store(const u32x4 (&sg)[2], LAS unsigned char* Kt, LAS unsigned char* Vt, int t256, int kind) {
    if (kind == 0) {
#pragma unroll
        for (int j = 0; j < 2; ++j) { const int c = t256 + 256 * j; *(LAS u32x4*)(Kt + (c >> 3) * KP + (c & 7) * 16) = sg[j]; }
    } else {
#pragma unroll
        for (int j = 0; j < 2; ++j) { const int c = t256 + 256 * j, vkey = c & 63, vdc = c >> 6; const unsigned w[4] = {sg[j].x, sg[j].y, sg[j].z, sg[j].w};
#pragma unroll
            for (int e = 0; e < 4; ++e) { *(LAS unsigned short*)(Vt + (vdc * 8 + 2 * e) * VP + vcol(vkey) * 2) = (unsigned short)(w[e] & 0xffffu); *(LAS unsigned short*)(Vt + (vdc * 8 + 2 * e + 1) * VP + vcol(vkey) * 2) = (unsigned short)(w[e] >> 16); } }
    }
}
template <int BR> __device__ __forceinline__ int pp_next(int kb, unsigned live) {
    if (BR == 1) return kb + 1;
    const unsigned rem = live & ~((2u << kb) - 1u);
    return rem ? __builtin_ctz(rem) : 32;
}
template <int BR>
__device__ __forceinline__ void pp_soft(f32x16& p0, f32x16& p1, int h, int kb, int qb, int qq, const LAS unsigned* selm, const float m, float& l, float& mxraw) {
    bool mine = true;
    if (BR == 0) mine = (selm[qq] >> kb) & 1u;
    if (kb == qb) {
#pragma unroll
        for (int e = 0; e < 16; ++e) { const int kk = crow(e, h); if (kk > qq) p0[e] = NEG; if (kk + 32 > qq) p1[e] = NEG; }
    } else if (BR == 1 && kb == qb - 8) {
#pragma unroll
        for (int e = 0; e < 16; ++e) { const int kk = crow(e, h); if (kk <= qq) p0[e] = NEG; if (kk + 32 <= qq) p1[e] = NEG; }
    }
    softmax_heavy(p0, p1, m, l, mxraw, mine);
}
template <int BR, bool PRE>
__device__ __forceinline__ void pp_stream(LAS unsigned char* lds, const bf16_t* Pb, int ld, int g, int qb, int qq, int qh, int t256, int r, int h, unsigned live, const LAS unsigned* selm,
                                          const bf16x8 (&qf)[4], u32x4 (&sg)[2], f32x16& o0, f32x16& o1, float& m, float& l) {
    const int kind = qh ^ 1;
    const int soff = (BR == 0 ? (kind == 0 ? 1536 : 1792) : (kind == 0 ? 2048 : 2304)) + g * 64;
    const int first = BR == 0 ? 0 : (qb > 8 ? qb - 8 : 0);
    const int n = BR == 0 ? __builtin_popcount(live) : (qb - first + 1);
    int kb_load = first;
    if (!PRE) pp_load(sg, Pb + (size_t)(kb_load * 64) * ld + soff, ld, t256, kind);
    kb_load = pp_next<BR>(kb_load, live);
    pp_store(sg, lds + L_K, lds + L_V, t256, kind);
    { const int kc = kb_load < qb ? kb_load : qb; pp_load(sg, Pb + (size_t)(kc * 64) * ld + soff, ld, t256, kind); kb_load = pp_next<BR>(kb_load, live); }
    __syncthreads();
    int kb = first;
    f32x16 p0, p1; float mxraw = NEG; bf16x8 pb[4];
    if (qh == 0) {
        qk(p0, p1, lds + L_K, qf, r, h);
#pragma unroll 1
        for (int i = 0; i < n; ++i) {
            pp_soft<BR>(p0, p1, h, kb, qb, qq, selm, m, l, mxraw);
            pack_p(pb, p0, p1);
            kb = pp_next<BR>(kb, live);
            PP_SYNC();
            if (i + 1 < n) pp_store(sg, lds + L_K + ((i + 1) & 1) * TILEB, lds + L_V + ((i + 1) & 1) * TILEB, t256, kind);
            { const int kc = kb_load < qb ? kb_load : qb; pp_load(sg, Pb + (size_t)(kc * 64) * ld + soff, ld, t256, kind); kb_load = pp_next<BR>(kb_load, live); }
            if (i + 1 < n) qk(p0, p1, lds + L_K + ((i + 1) & 1) * TILEB, qf, r, h);
            pv2(o0, o1, lds + L_V + (i & 1) * TILEB, pb, r, h);
            softmax_light(mxraw, m, l, o0, o1);
            PP_SYNC();
        }
    } else {
#pragma unroll 1
        for (int i = 0; i < n; ++i) {
            qk(p0, p1, lds + L_K + (i & 1) * TILEB, qf, r, h);
            if (i > 0) { pv2(o0, o1, lds + L_V + ((i - 1) & 1) * TILEB, pb, r, h); softmax_light(mxraw, m, l, o0, o1); }
            if (i + 1 < n) pp_store(sg, lds + L_K + ((i + 1) & 1) * TILEB, lds + L_V + ((i + 1) & 1) * TILEB, t256, kind);
            { const int kc = kb_load < qb ? kb_load : qb; pp_load(sg, Pb + (size_t)(kc * 64) * ld + soff, ld, t256, kind); kb_load = pp_next<BR>(kb_load, live); }
            PP_SYNC();
            pp_soft<BR>(p0, p1, h, kb, qb, qq, selm, m, l, mxraw);
            pack_p(pb, p0, p1);
            kb = pp_next<BR>(kb, live);
            PP_SYNC();
        }
        pv2(o0, o1, lds + L_V + ((n - 1) & 1) * TILEB, pb, r, h);
    }
}
__device__ __forceinline__ void st_store_k(const u32x4& k, LAS unsigned char* Kt, int tid) { const int key = tid >> 3, dc = tid & 7; *(LAS u32x4*)(Kt + key * KP + dc * 16) = k; }
__device__ __forceinline__ void st_store_v(const u32x4& v, LAS unsigned char* Vt, int tid) {
    const int vkey = tid & 63, vdc = tid >> 6; const unsigned w[4] = {v.x, v.y, v.z, v.w};
#pragma unroll
    for (int e = 0; e < 4; ++e) { *(LAS unsigned short*)(Vt + (vdc * 8 + 2 * e) * VP + vcol(vkey) * 2) = (unsigned short)(w[e] & 0xffffu); *(LAS unsigned short*)(Vt + (vdc * 8 + 2 * e + 1) * VP + vcol(vkey) * 2) = (unsigned short)(w[e] >> 16); }
}
__device__ __forceinline__ u32x4 st_load_k(const bf16_t* ksrc, long stride, int tid) { return *(const u32x4*)(ksrc + (long)(tid >> 3) * stride + (tid & 7) * 8); }
__device__ __forceinline__ u32x4 st_load_v(const bf16_t* vsrc, long stride, int tid) { return *(const u32x4*)(vsrc + (long)(tid & 63) * stride + (tid >> 6) * 8); }
template <int BR>
__device__ __forceinline__ void sp_mask(f32x16& p0, f32x16& p1, int h, int kb, int qb, int qq) {
    if (kb == qb) {
#pragma unroll
        for (int e = 0; e < 16; ++e) { const int kk = crow(e, h); if (kk > qq) p0[e] = NEG; if (kk + 32 > qq) p1[e] = NEG; }
    } else if (BR == 1 && kb == qb - 8) {
#pragma unroll
        for (int e = 0; e < 16; ++e) { const int kk = crow(e, h); if (kk <= qq) p0[e] = NEG; if (kk + 32 <= qq) p1[e] = NEG; }
    }
}
template <int BR, bool PRE>
__device__ __forceinline__ void sp_stream(LAS unsigned char* lds, const bf16_t* Pb, int ld, int g, int qb, int qq, int tid, int r, int h, unsigned live, const LAS unsigned* selm,
                                          const bf16x8 (&qf)[4], Stage& st, f32x16& o0, f32x16& o1, float& m, float& l) {
    const int koff = (BR == 0 ? 1536 : 2048) + g * 64, voff = (BR == 0 ? 1792 : 2304) + g * 64;
    const int first = BR == 0 ? 0 : (qb > 8 ? qb - 8 : 0);
    const int n = BR == 0 ? __builtin_popcount(live) : (qb - first + 1);
    int kbK = first, kbV = first;
    if (!PRE) stage_load(st, Pb + (size_t)(first * 64) * ld + koff, Pb + (size_t)(first * 64) * ld + voff, ld, tid);
    kbK = pp_next<BR>(kbK, live); kbV = kbK;
    Stage s1; { const int kc = kbK < qb ? kbK : qb; stage_load(s1, Pb + (size_t)(kc * 64) * ld + koff, Pb + (size_t)(kc * 64) * ld + voff, ld, tid); }
    kbK = pp_next<BR>(kbK, live); kbV = kbK;
    stage_store(st, lds + L_K, lds + L_V, tid);
    st_store_k(s1.k, lds + L_K + TILEB, tid); st.v = s1.v;
    { const int kc = kbK < qb ? kbK : qb; st.k = st_load_k(Pb + (size_t)(kc * 64) * ld + koff, ld, tid); kbK = pp_next<BR>(kbK, live); }
    __syncthreads();
    f32x16 p0, p1; float mxraw = NEG; bf16x8 pb[4];
    qk(p0, p1, lds + L_K, qf, r, h);
    int kb = first, rk1 = 1, rk2 = 2;
#pragma unroll 1
    for (int i = 0; i < n; ++i) {
        if (i + 2 < n) st_store_k(st.k, lds + (rk2 == 2 ? L_PQ : L_K + rk2 * TILEB), tid);
        if (i + 1 < n) st_store_v(st.v, lds + L_V + ((i + 1) & 1) * TILEB, tid);
        { const int kc = kbK < qb ? kbK : qb, vc = kbV < qb ? kbV : qb;
          st.k = st_load_k(Pb + (size_t)(kc * 64) * ld + koff, ld, tid); st.v = st_load_v(Pb + (size_t)(vc * 64) * ld + voff, ld, tid); kbK = pp_next<BR>(kbK, live); kbV = pp_next<BR>(kbV, live); }
        bool mine = true;
        if (BR == 0) mine = (selm[qq] >> kb) & 1u;
        sp_mask<BR>(p0, p1, h, kb, qb, qq);
        f32x16 n0, n1;
        {
            const LAS unsigned char* Kt = lds + (rk1 == 2 ? L_PQ : L_K + rk1 * TILEB);
            const f32x16 z = {0.f, 0.f, 0.f, 0.f, 0.f, 0.f, 0.f, 0.f, 0.f, 0.f, 0.f, 0.f, 0.f, 0.f, 0.f, 0.f};
            bf16x8 a0[4], a1[4];
#pragma unroll
            for (int s = 0; s < 4; ++s) { a0[s] = *(const LAS bf16x8*)(Kt + r * KP + (16 * s + 8 * h) * 2); a1[s] = *(const LAS bf16x8*)(Kt + (32 + r) * KP + (16 * s + 8 * h) * 2); }
            __builtin_amdgcn_sched_barrier(0);
#pragma unroll
            for (int s = 0; s < 4; ++s) {
                n0 = __builtin_amdgcn_mfma_f32_32x32x16_bf16(a0[s], qf[s], s == 0 ? z : n0, 0, 0, 0);
                n1 = __builtin_amdgcn_mfma_f32_32x32x16_bf16(a1[s], qf[s], s == 0 ? z : n1, 0, 0, 0);
            }
            softmax_heavy(p0, p1, m, l, mxraw, mine);
            pack_p(pb, p0, p1);
#pragma unroll
            for (int j = 0; j < 8; ++j) { __builtin_amdgcn_sched_group_barrier(0x008, 1, 0); __builtin_amdgcn_sched_group_barrier(0x002, SP_FILL, 0); }
            __builtin_amdgcn_sched_barrier(0);
        }
        pv2(o0, o1, lds + L_V + (i & 1) * TILEB, pb, r, h);
        softmax_light(mxraw, m, l, o0, o1);
        p0 = n0; p1 = n1; kb = pp_next<BR>(kb, live); rk1 = rk2; rk2 = rk2 == 2 ? 0 : rk2 + 1;
        __syncthreads();
    }
}
}

__device__ __forceinline__ void phase_nsa_attn_mfma(Frame& F, int slot) {
    using namespace na;
    const bf16_t* P = WSP(bf16_t, OFF_PROJ); bf16_t* ATT = WSP(bf16_t, OFF_ATT);
    const bf16_t* KCb = WSP(bf16_t, OFF_KC); const bf16_t* VCb = KCb + (size_t)128 * 128 * 64;
    const float* gb = inptr(F, I_NSA_GATE_B) + slot * 48;
    int tid = F.tid; asm volatile("; phase-local tid" : "+v"(tid));
    const int wave = __builtin_amdgcn_readfirstlane(tid >> 6), lane = tid & 63, r = lane & 31, h = lane >> 5, hh = wave & 3, qh = wave >> 2;
    const int t256 = tid & 255;
    LAS unsigned char* lds = F.lds;
    LAS float* Pq = (LAS float*)(lds + L_PQ); LAS unsigned* selm = (LAS unsigned*)(lds + L_SEL);
    const int ld = NSA_LD;
    const int qq = qh * 32 + r;
#pragma unroll 1
    for (int it = F.bx; it < 4096; it += F.G) {
        const int sl = it & 255, rnd = it >> 8, bg = sl >> 1, par = sl & 1, qb = (rnd & 1) ? (31 - 2 * (rnd >> 1) - par) : (2 * (rnd >> 1) + par);
        const int b = bg >> 2, g = bg & 3, t = qb * 64 + qq;
        const bf16_t* Pb = P + (size_t)b * T * ld;
        const bf16_t* prow = Pb + (size_t)t * ld;
        bf16x8 qf[4];
#pragma unroll
        for (int s = 0; s < 4; ++s) qf[s] = *(const bf16x8*)(prow + g * 256 + hh * 64 + 16 * s + 8 * h);
        float gt[3];
#pragma unroll
        for (int j = 0; j < 3; ++j) gt[j] = sigmoidf_(bf2f(prow[2560 + g * 12 + hh * 3 + j]) + gb[g * 12 + hh * 3 + j]);
        LAS float* gsave = (LAS float*)(lds + L_SEL + 512) + tid * 2; gsave[0] = gt[1]; gsave[1] = gt[2];
        if (tid == 0) selm[64] = 0u;
        Stage st0, st1;
        stage_load(st0, KCb + (size_t)bg * 128 * 64, VCb + (size_t)bg * 128 * 64, 64, tid);
        stage_load(st1, KCb + (size_t)bg * 128 * 64 + 64 * 64, VCb + (size_t)bg * 128 * 64 + 64 * 64, 64, tid);
        stage_store(st0, lds + L_K, lds + L_V, tid);
        stage_store(st1, lds + L_K + TILEB, lds + L_V + TILEB, tid);
        __syncthreads();
        LAS float* oaL = (LAS float*)(lds + L_OA) + tid;
#pragma unroll 1
        for (int xr_ = 0; xr_ <= XCMP; ++xr_)
        {
            const int cmax = (t >= 31) ? (((t - 31) >> 4) < 126 ? ((t - 31) >> 4) : 126) : -1;
            f32x16 o0, o1; float m = NEG, l = 0.f;
#pragma unroll
            for (int i = 0; i < 16; ++i) { o0[i] = 0.f; o1[i] = 0.f; }
#pragma unroll 1
            for (int tl = 0; tl < 2; ++tl) {
                f32x16 p0, p1;
                qk(p0, p1, lds + L_K + tl * TILEB, qf, r, h);
#pragma unroll
                for (int i = 0; i < 16; ++i) { const int c = 64 * tl + crow(i, h); if (c > cmax) p0[i] = NEG; if (c + 32 > cmax) p1[i] = NEG; }
                softmax_step(p0, p1, m, l, o0, o1);
                pv(o0, o1, lds + L_V + tl * TILEB, p0, p1, r, h);
            }
            l += __shfl_xor(l, 32);
            const float inv = l > 0.f ? 1.0f / l : 0.f;
            const float cf = gt[0] * inv;
#pragma unroll
            for (int i = 0; i < 16; ++i) { oaL[512 * i] = cf * o0[i]; oaL[512 * (16 + i)] = cf * o1[i]; }
            const float mc = ((m < -1e29f) ? 0.f : m) * C1;
            LAS float* slab = Pq + hh * SLB + qq * 33;
#pragma unroll 1
            for (int tl = 1; tl >= 0; --tl) {
                f32x16 p0, p1;
                qk(p0, p1, lds + L_K + tl * TILEB, qf, r, h);
#pragma unroll
                for (int i = 0; i < 16; ++i) { const int c = 64 * tl + crow(i, h);
                    p0[i] = (c > cmax) ? 0.f : __builtin_amdgcn_exp2f(p0[i] * C1 - mc) * inv; p1[i] = (c + 32 > cmax) ? 0.f : __builtin_amdgcn_exp2f(p1[i] * C1 - mc) * inv; }
#pragma unroll
                for (int k = 0; k < 4; ++k) {
                    slab[16 * tl + 2 * k + h] = 2.0f * (p0[4 * k] + p0[4 * k + 1] + p0[4 * k + 2]) + p0[4 * k + 3];
                    slab[16 * tl + 8 + 2 * k + h] = 2.0f * (p1[4 * k] + p1[4 * k + 1] + p1[4 * k + 2]) + p1[4 * k + 3]; }
                LDS_WAIT();
#pragma unroll
                for (int k = 0; k < 4; ++k) { const int s0 = 16 * tl + 2 * k + h + 1, s1 = 16 * tl + 8 + 2 * k + h + 1;
                    slab[s0] += p0[4 * k + 3]; if (s1 < 32) slab[s1] += p1[4 * k + 3]; }
                LDS_WAIT();
            }
        }
        __syncthreads();
        Stage st;
        stage_load(st, Pb + 1536 + g * 64, Pb + 1792 + g * 64, ld, tid);
#pragma unroll 1
        for (int xr_ = 0; xr_ <= XSELN; ++xr_)
        {
            const int cur = qb, q = tid >> 3, sub = tid & 7;
            float scv[4];
#pragma unroll
            for (int j = 0; j < 4; ++j) { const int s_ = 4 * sub + j; const LAS float* pr = Pq + q * 33 + s_;
                const float imp = (pr[0] + pr[SLB]) + (pr[2 * SLB] + pr[3 * SLB]);
                const bool forced = (s_ == 0) || (s_ == cur) || (s_ == cur - 1);
                scv[j] = forced ? 1e30f : (s_ <= cur ? imp : NEG); }
            unsigned mask = 0u;
#pragma unroll 1
            for (int rd = 0; rd < 8; ++rd) {
                float bv = scv[0]; int bi = 4 * sub;
#pragma unroll
                for (int j = 1; j < 4; ++j) if (scv[j] > bv) { bv = scv[j]; bi = 4 * sub + j; }
#define SEL_STEP(CTRL) { const float ov = dppf<CTRL>(bv); const int oi = __float_as_int(dppf<CTRL>(__int_as_float(bi))); if (ov > bv || (ov == bv && oi < bi)) { bv = ov; bi = oi; } }
                SEL_STEP(0xB1) SEL_STEP(0x4E) SEL_STEP(0x141)
#undef SEL_STEP
                if (bv > -0.5e30f) mask |= 1u << bi;
#pragma unroll
                for (int j = 0; j < 4; ++j) if (bi == 4 * sub + j) scv[j] = -INFINITY;
            }
            if (sub == 0) selm[q] = mask;
            unsigned any = mask;
#pragma unroll
            for (int o = 8; o < 64; o <<= 1) any |= __shfl_xor(any, o);
            if (lane == 0) __hip_atomic_fetch_or(selm + 64, any, __ATOMIC_RELAXED, __HIP_MEMORY_SCOPE_WORKGROUP);
            __syncthreads();
        }
        const unsigned anymask = __builtin_amdgcn_readfirstlane(selm[64]);
        {
            f32x16 o0, o1; float m = NEG, l = 0.f;
#pragma unroll
            for (int i = 0; i < 16; ++i) { o0[i] = 0.f; o1[i] = 0.f; }
            const unsigned live = anymask & (qb == 31 ? 0xffffffffu : ((2u << qb) - 1u));
            sp_stream<0, true>(lds, Pb, ld, g, qb, qq, tid, r, h, live, selm, qf, st, o0, o1, m, l);
            l += __shfl_xor(l, 32);
            const float cf = l > 0.f ? gsave[0] / l : 0.f;
#pragma unroll
            for (int i = 0; i < 16; ++i) { oaL[512 * i] += cf * o0[i]; oaL[512 * (16 + i)] += cf * o1[i]; }
        }
        __syncthreads();
        {
            f32x16 o0, o1; float m = NEG, l = 0.f;
#pragma unroll
            for (int i = 0; i < 16; ++i) { o0[i] = 0.f; o1[i] = 0.f; }
            sp_stream<1, false>(lds, Pb, ld, g, qb, qq, tid, r, h, 0u, selm, qf, st, o0, o1, m, l);
            l += __shfl_xor(l, 32);
            const float cf = l > 0.f ? gsave[1] / l : 0.f;
#pragma unroll
            for (int i = 0; i < 16; ++i) { o0[i] = oaL[512 * i] + cf * o0[i]; o1[i] = oaL[512 * (16 + i)] + cf * o1[i]; }
            bf16_t* orow = ATT + (size_t)(b * T + t) * D + (g * 4 + hh) * 64 + 4 * h;
#pragma unroll 1
            for (int xr_ = 0; xr_ <= XOUT; ++xr_)
#pragma unroll
            for (int k = 0; k < 4; ++k) {
                u32x2 w0, w1; w0.x = pg8::cvt_pk_bf16(o0[4 * k], o0[4 * k + 1]); w0.y = pg8::cvt_pk_bf16(o0[4 * k + 2], o0[4 * k + 3]);
                w1.x = pg8::cvt_pk_bf16(o1[4 * k], o1[4 * k + 1]); w1.y = pg8::cvt_pk_bf16(o1[4 * k + 2], o1[4 * k + 3]);
                *(u32x2*)(orow + 8 * k) = w0; *(u32x2*)(orow + 32 + 8 * k) = w1;
            }
        }
        __syncthreads();
    }
}
__device__ __forceinline__ float logsigmoidf_(float x) { return fminf(x, 0.f) - log1pf(__expf(-fabsf(x))); }
__device__ __forceinline__ void phase_mlstm_scan(Frame& F) {
    constexpr int QP = 132;
    LAS float* qL = (LAS float*)F.lds;
    LAS float* kL = qL + 64 * QP;
    LAS float* vL = kL + 64 * QP;
    LAS float* SL = vL + 64 * 128;
    LAS float* vec = SL + 64 * 68;
    LAS float* bL = vec;
    LAS float* liL = vec + 64;
    LAS float* mtL = vec + 128;
    LAS float* wiL = vec + 192;
    LAS float* dnL = vec + 256;
    LAS float* wkL = vec + 320;
    LAS float* nL = vec + 384;
    LAS float* scl = vec + 512;
    LAS float* rsL = vec + 576;
    LAS float* qnL = vec + 640;
    const bf16_t* P = WSP(bf16_t, OFF_PROJ); bf16_t* HO = WSP(bf16_t, OFF_HM);
    int tid = F.tid; asm volatile("; phase-local tid" : "+v"(tid));
    const int lane = tid & 63, ld = ML_LD;
    int v_ = tid >> 2, kq = tid & 3;
    for (int item = F.bx; item < BATCH * 4 * 2; item += F.G) {
        const int vh = item & 1, h = (item >> 1) & 3, b = item >> 3;
        float C[32];
#pragma unroll
        for (int j = 0; j < 32; ++j) C[j] = 0.f;
        if (tid < 128) nL[tid] = 0.f;
        if (tid == 0) scl[0] = 0.f;
        __syncthreads();
#pragma unroll 1
        for (int ch = 0; ch < T / 64; ++ch) {
            asm volatile("; chunk-local" : "+v"(v_), "+v"(kq), "+v"(tid));
            const int t0 = ch * 64; const bf16_t* Pc = P + (size_t)(b * T + t0) * ld;
            {
                const int c2 = tid & 255, part = tid >> 8;
                const int col = (c2 < 128) ? (h * 128 + c2) : (512 + h * 128 + (c2 - 128));
                const float w0 = inptr(F, I_ML_CONV_W)[0 * 1024 + col], w1 = inptr(F, I_ML_CONV_W)[1 * 1024 + col], w2 = inptr(F, I_ML_CONV_W)[2 * 1024 + col], w3 = inptr(F, I_ML_CONV_W)[3 * 1024 + col], cb = inptr(F, I_ML_CONV_B)[col];
                const float scale = (c2 < 128) ? 1.0f : 0.08838834764831845f;
                const int r0 = part * 32;
                float x0 = (t0 + r0 - 3 >= 0) ? bf2f(Pc[(long)(r0 - 3) * ld + col]) : 0.f;
                float x1 = (t0 + r0 - 2 >= 0) ? bf2f(Pc[(long)(r0 - 2) * ld + col]) : 0.f;
                float x2 = (t0 + r0 - 1 >= 0) ? bf2f(Pc[(long)(r0 - 1) * ld + col]) : 0.f;
                LAS float* dst = (c2 < 128) ? (qL + c2) : (kL + (c2 - 128));
                for (int r = r0; r < r0 + 32; ++r) { const float x3 = bf2f(Pc[(long)r * ld + col]);
                    const float y = w0 * x0 + w1 * x1 + w2 * x2 + w3 * x3 + cb; dst[r * QP] = y * sigmoidf_(y) * scale; x0 = x1; x1 = x2; x2 = x3; }
                const int vc = tid & 127, vp = tid >> 7;
                for (int r = vp * 16; r < vp * 16 + 16; ++r) vL[r * 128 + vc] = bf2f(Pc[(long)r * ld + 1024 + h * 256 + vh * 128 + vc]);
                if (tid < 64) { liL[tid] = bf2f(Pc[(long)tid * ld + 3072 + h]) + inptr(F, I_ML_GATE_B)[h];
                    bL[tid] = logsigmoidf_(bf2f(Pc[(long)tid * ld + 3076 + h]) + inptr(F, I_ML_GATE_B)[4 + h]); }
            }
            __syncthreads();
            if (tid < 64) {
                float bb = bL[lane];
#pragma unroll
                for (int o = 1; o < 64; o <<= 1) { const float u = __shfl_up(bb, o); if (lane >= o) bb += u; }
                const float li = liL[lane]; float pm = li - bb;
#pragma unroll
                for (int o = 1; o < 64; o <<= 1) { const float u = __shfl_up(pm, o); if (lane >= o) pm = fmaxf(pm, u); }
                const float mprev = scl[0];
                const float mt = fmaxf(bb + mprev, bb + pm);
                const float bend = __shfl(bb, 63);
                const float decay = bend - bb + li;
                const float mnew = fmaxf(bend + mprev, wave_max(decay));
                bL[lane] = bb; mtL[lane] = mt; wiL[lane] = __expf(bb + mprev - mt); wkL[lane] = __expf(decay - mnew);
                if (lane == 0) { scl[1] = __expf(bend + mprev - mnew); scl[2] = mnew; }
            }
            __syncthreads();
            {
                const int t = tid >> 3, sg = tid & 7;
                float a[8];
#pragma unroll
                for (int j = 0; j < 8; ++j) a[j] = 0.f;
#pragma unroll 1
                for (int k4 = 0; k4 < 32; ++k4) { const f32x4 qv = *(const LAS f32x4*)(qL + t * QP + k4 * 4);
#pragma unroll
                    for (int j = 0; j < 8; ++j) { const f32x4 kv = *(const LAS f32x4*)(kL + (sg + 8 * j) * QP + k4 * 4); a[j] += (qv[0] * kv[0] + qv[1] * kv[1]) + (qv[2] * kv[2] + qv[3] * kv[3]); } }
                const float bt = bL[t], mt = mtL[t];
#pragma unroll
                for (int j = 0; j < 8; ++j) { const int s = sg + 8 * j; SL[t * 68 + s] = (s <= t) ? a[j] * __expf(bt - bL[s] + liL[s] - mt) : 0.f; }
            }
            __syncthreads();
            if (tid < 64) { float rs = 0.f; for (int s = 0; s < 64; ++s) rs += SL[tid * 68 + s]; rsL[tid] = rs; }
            else if (tid < 128) { const int t = tid - 64; float qn = 0.f; for (int k = 0; k < 128; ++k) qn += qL[t * QP + k] * nL[k]; qnL[t] = qn; }
            __syncthreads();
            if (tid < 64) { const float den = rsL[tid] + wiL[tid] * qnL[tid]; dnL[tid] = 1.0f / fmaxf(fabsf(den), __expf(-mtL[tid])); }
            __syncthreads();
            {
                float vr[16];
#pragma unroll
                for (int j = 0; j < 16; ++j) vr[j] = vL[(kq * 16 + j) * 128 + v_];
#pragma unroll 1
                for (int tg = 0; tg < 4; ++tg) {
                    float res[4];
#pragma unroll
                    for (int ti = 0; ti < 16; ++ti) { const int t = tg * 16 + ti;
                        float aC = 0.f, aS = 0.f;
#pragma unroll
                        for (int j4 = 0; j4 < 8; ++j4) { const f32x4 qv = *(const LAS f32x4*)(qL + t * QP + kq * 32 + j4 * 4);
                            aC += (qv[0] * C[j4 * 4] + qv[1] * C[j4 * 4 + 1]) + (qv[2] * C[j4 * 4 + 2] + qv[3] * C[j4 * 4 + 3]); }
#pragma unroll
                        for (int j4 = 0; j4 < 4; ++j4) { const f32x4 sv = *(const LAS f32x4*)(SL + t * 68 + kq * 16 + j4 * 4);
                            aS += (sv[0] * vr[j4 * 4] + sv[1] * vr[j4 * 4 + 1]) + (sv[2] * vr[j4 * 4 + 2] + sv[3] * vr[j4 * 4 + 3]); }
                        float tot = aS + wiL[t] * aC;
                        tot += __shfl_xor(tot, 1); tot += __shfl_xor(tot, 2);
                        tot *= dnL[t];
                        if ((ti & 3) == kq) res[ti >> 2] = tot;
                        asm volatile("" ::: "memory");
                    }
#pragma unroll
                    for (int q = 0; q < 4; ++q) { const int t = tg * 16 + q * 4 + kq; HO[(size_t)(b * T + t0 + t) * D + h * 256 + vh * 128 + v_] = (bf16_t)f2bf(res[q]); }
                }
            }
            __syncthreads();
            {
                const float cs = scl[1];
#pragma unroll
                for (int j = 0; j < 32; ++j) C[j] *= cs;
#pragma unroll 2
                for (int s = 0; s < 64; ++s) { const float a = vL[s * 128 + v_] * wkL[s];
#pragma unroll
                    for (int j4 = 0; j4 < 8; ++j4) { const f32x4 kv = *(const LAS f32x4*)(kL + s * QP + kq * 32 + j4 * 4);
                        C[j4 * 4] += a * kv[0]; C[j4 * 4 + 1] += a * kv[1]; C[j4 * 4 + 2] += a * kv[2]; C[j4 * 4 + 3] += a * kv[3]; } }
                if (tid < 128) { float nn = nL[tid] * cs; for (int s = 0; s < 64; ++s) nn += wkL[s] * kL[s * QP + tid]; nL[tid] = nn; }
                if (tid == 0) scl[0] = scl[2];
            }
            __syncthreads();
        }
    }
}
template <int HD>
__device__ __forceinline__ void phase_norm_gate(Frame& F, const float* norm_g, int ld, int gate_col0) {
    const bf16_t* HI = WSP(bf16_t, OFF_HM); const bf16_t* P = WSP(bf16_t, OFF_PROJ); bf16_t* ATT = WSP(bf16_t, OFF_ATT);
    int lane = F.lane; asm volatile("; phase-local lane" : "+v"(lane)); const int gw = F.bx * 8 + F.wave, NGW = F.G * 8;
    u32x2 hq[4], gq[4];
    f32x4 ngr[4];
#pragma unroll
    for (int j = 0; j < 4; ++j) ngr[j] = *((const f32x4*)norm_g + lane + 64 * j);
    if (gw < NTOK) { const u32x2* hr = (const u32x2*)(HI + (size_t)gw * D) + lane; const u32x2* gr = (const u32x2*)(P + (size_t)gw * ld + gate_col0) + lane;
#pragma unroll
        for (int j = 0; j < 4; ++j) { hq[j] = hr[64 * j]; gq[j] = gr[64 * j]; } }
#pragma unroll 1
    for (int m = gw; m < NTOK; m += NGW) {
        u32x2 hc[4], gc[4];
#pragma unroll
        for (int j = 0; j < 4; ++j) { hc[j] = hq[j]; gc[j] = gq[j]; }
        if (m + NGW < NTOK) { const u32x2* hr = (const u32x2*)(HI + (size_t)(m + NGW) * D) + lane; const u32x2* gr = (const u32x2*)(P + (size_t)(m + NGW) * ld + gate_col0) + lane;
#pragma unroll
            for (int j = 0; j < 4; ++j) { hq[j] = hr[64 * j]; gq[j] = gr[64 * j]; } }
        u32x2* orow = (u32x2*)(ATT + (size_t)m * D) + lane;
#pragma unroll
        for (int j = 0; j < 4; ++j) {
            const u32x2 hv = hc[j], gv = gc[j];
            float x[4] = {__uint_as_float(hv.x << 16), __uint_as_float(hv.x & 0xffff0000u), __uint_as_float(hv.y << 16), __uint_as_float(hv.y & 0xffff0000u)};
            const float gt[4] = {__uint_as_float(gv.x << 16), __uint_as_float(gv.x & 0xffff0000u), __uint_as_float(gv.y << 16), __uint_as_float(gv.y & 0xffff0000u)};
            float ss = (x[0] * x[0] + x[1] * x[1]) + (x[2] * x[2] + x[3] * x[3]);
#pragma unroll
            for (int o = 1; o < (HD == 256 ? 64 : 32); o <<= 1) ss += __shfl_xor(ss, o);
            const float r = __builtin_amdgcn_rsqf(ss * (1.0f / HD) + RMS_EPS);
            const f32x4 ng = ngr[j];
            float o4[4];
#pragma unroll
            for (int q = 0; q < 4; ++q) o4[q] = x[q] * r * ng[q] * sigmoidf_(gt[q]);
            u32x2 o; o.x = pk2(o4[0], o4[1]); o.y = pk2(o4[2], o4[3]); orow[64 * j] = o;
        }
    }
}

__device__ __forceinline__ void phase_hgrn_scan(Frame& F) {
    constexpr int QP = 132;
    LAS float* qL = (LAS float*)F.lds;
    LAS float* kL = qL + 32 * QP;
    LAS float* vL = kL + 32 * QP;
    LAS float* AL = vL + 32 * 128;
    LAS float* geL = AL + 32 * 36;
    const bf16_t* P = WSP(bf16_t, OFF_PROJ); bf16_t* HO = WSP(bf16_t, OFF_HM);
    const float* lbt = WSP(float, OFF_TAB) + TAB_LB;
    int tid = F.tid; asm volatile("; phase-local tid" : "+v"(tid));
    const int ld = HG_LD;
    int v_ = tid >> 2, kq = tid & 3;
    for (int item = F.bx; item < BATCH * 8; item += F.G) {
        const int h = item & 7, b = item >> 3;
        float S[32];
#pragma unroll
        for (int j = 0; j < 32; ++j) S[j] = 0.f;
#pragma unroll 1
        for (int ch = 0; ch < T / 32; ++ch) {
            asm volatile("; chunk-local" : "+v"(v_), "+v"(kq), "+v"(tid));
            const int t0 = ch * 32; const bf16_t* Pc = P + (size_t)(b * T + t0) * ld;
            { const int c = tid & 127, p4 = tid >> 7;
#pragma unroll 2
              for (int r = p4 * 8; r < p4 * 8 + 8; ++r) { qL[r * QP + c] = bf2f(Pc[(long)r * ld + h * 128 + c]); kL[r * QP + c] = bf2f(Pc[(long)r * ld + 1024 + h * 128 + c]); vL[r * 128 + c] = bf2f(Pc[(long)r * ld + 2048 + h * 128 + c]); } }
            __syncthreads();
            if (tid < 128) { const float lb = lbt[h * 128 + tid]; float G = 0.f;
#pragma unroll 2
                for (int r = 0; r < 32; ++r) { const float qr = qL[r * QP + tid], fr = kL[r * QP + tid];
                    const float f = lb + (1.0f - lb) * sigmoidf_(fr); G += __logf(f);
                    qL[r * QP + tid] = qr * sigmoidf_(qr) * __expf(G); kL[r * QP + tid] = (1.0f - f) * __expf(-G); }
                geL[tid] = __expf(G); }
            __syncthreads();
            { const int t = tid >> 4, sg = tid & 15;
              float a0 = 0.f, a1 = 0.f;
#pragma unroll 2
              for (int k4 = 0; k4 < 32; ++k4) { const f32x4 qv = *(const LAS f32x4*)(qL + t * QP + k4 * 4);
                  const f32x4 k0 = *(const LAS f32x4*)(kL + sg * QP + k4 * 4), k1 = *(const LAS f32x4*)(kL + (sg + 16) * QP + k4 * 4);
                  a0 += (qv[0] * k0[0] + qv[1] * k0[1]) + (qv[2] * k0[2] + qv[3] * k0[3]); a1 += (qv[0] * k1[0] + qv[1] * k1[1]) + (qv[2] * k1[2] + qv[3] * k1[3]); }
              AL[t * 36 + sg] = (sg <= t) ? a0 : 0.f; AL[t * 36 + sg + 16] = (sg + 16 <= t) ? a1 : 0.f; }
            __syncthreads();
            {
                float vr[8];
#pragma unroll
                for (int j = 0; j < 8; ++j) vr[j] = vL[(kq * 8 + j) * 128 + v_];
#pragma unroll 2
                for (int t = 0; t < 32; ++t) {
                    float a = 0.f;
#pragma unroll
                    for (int j4 = 0; j4 < 8; ++j4) { const f32x4 qv = *(const LAS f32x4*)(qL + t * QP + kq * 32 + j4 * 4);
                        a += (qv[0] * S[j4 * 4] + qv[1] * S[j4 * 4 + 1]) + (qv[2] * S[j4 * 4 + 2] + qv[3] * S[j4 * 4 + 3]); }
#pragma unroll
                    for (int j4 = 0; j4 < 2; ++j4) { const f32x4 sv = *(const LAS f32x4*)(AL + t * 36 + kq * 8 + j4 * 4);
                        a += (sv[0] * vr[j4 * 4] + sv[1] * vr[j4 * 4 + 1]) + (sv[2] * vr[j4 * 4 + 2] + sv[3] * vr[j4 * 4 + 3]); }
                    a += __shfl_xor(a, 1); a += __shfl_xor(a, 2);
                    if ((t & 3) == kq) HO[(size_t)(b * T + t0 + t) * D + h * 128 + v_] = (bf16_t)f2bf(a);
                    asm volatile("" ::: "memory");
                }
            }
            {
#pragma unroll 2
                for (int s = 0; s < 32; ++s) { const float a = vL[s * 128 + v_];
#pragma unroll
                    for (int j4 = 0; j4 < 8; ++j4) { const f32x4 kv = *(const LAS f32x4*)(kL + s * QP + kq * 32 + j4 * 4);
                        S[j4 * 4] += a * kv[0]; S[j4 * 4 + 1] += a * kv[1]; S[j4 * 4 + 2] += a * kv[2]; S[j4 * 4 + 3] += a * kv[3]; } }
#pragma unroll
                for (int j4 = 0; j4 < 8; ++j4) { const f32x4 ge = *(const LAS f32x4*)(geL + kq * 32 + j4 * 4);
                    S[j4 * 4] *= ge[0]; S[j4 * 4 + 1] *= ge[1]; S[j4 * 4 + 2] *= ge[2]; S[j4 * 4 + 3] *= ge[3]; }
            }
            __syncthreads();
        }
    }
}
namespace ml {
constexpr int PK = 272, PS = 144;
constexpr int L_Q = 0, L_KK = L_Q + 64 * PK, L_KWT = L_KK + 64 * PK, L_VT = L_KWT + 128 * PS, L_S = L_VT + 144 * PS, L_C = L_S + 64 * PS, L_VEC = L_C + 144 * PK;
typedef float f32x4_ __attribute__((ext_vector_type(4)));
__device__ __forceinline__ bf16x8 frag(const LAS unsigned char* base, int row, int pitch, int kelem) { return *(const LAS bf16x8*)(base + row * pitch + kelem * 2); }
}
__device__ __forceinline__ void phase_mlstm_scan_mfma(Frame& F) {
    using namespace ml;
    LAS unsigned char* lds = F.lds;
    LAS float* vec = (LAS float*)(lds + L_VEC);
    LAS float* bL = vec; LAS float* liL = vec + 64; LAS float* mtL = vec + 128; LAS float* wiL = vec + 192; LAS float* wkL = vec + 256; LAS float* scl = vec + 320;
    const bf16_t* P = WSP(bf16_t, OFF_PROJ); bf16_t* HO = WSP(bf16_t, OFF_HM);
    int tid = F.tid; asm volatile("; phase-local tid" : "+v"(tid));
    const int lane = tid & 63, wave = __builtin_amdgcn_readfirstlane(tid >> 6), ld = ML_LD;
    const int fr = lane & 15, fg = lane >> 4;
#pragma unroll 1
    for (int item = F.bx; item < BATCH * 4 * 2; item += F.G) {
        const int vh = item & 1, h = (item >> 1) & 3, b = item >> 3;
        f32x4 Cacc[9];
#pragma unroll
        for (int j = 0; j < 9; ++j) Cacc[j] = (f32x4){0.f, 0.f, 0.f, 0.f};
        for (int i = tid; i < 16 * 64; i += 512) { const int rr = i >> 6, s = i & 63; *(LAS unsigned short*)(lds + L_VT + (128 + rr) * PS + s * 2) = (rr == 0) ? (unsigned short)0x3F80 : (unsigned short)0; }
        for (int i = tid; i < 144 * PK / 4; i += 512) ((LAS unsigned*)(lds + L_C))[i] = 0u;
        if (tid == 0) scl[0] = 0.f;
        const int c2 = tid & 255, part = __builtin_amdgcn_readfirstlane(tid >> 8);
        const int col = (c2 < 128) ? (h * 128 + c2) : (512 + h * 128 + (c2 - 128));
        const float* cw = inptr(F, I_ML_CONV_W); const float* cbp = inptr(F, I_ML_CONV_B); const float* gbp = inptr(F, I_ML_GATE_B);
        const float w0 = cw[0 * 1024 + col], w1 = cw[1 * 1024 + col], w2 = cw[2 * 1024 + col], w3 = cw[3 * 1024 + col], cb = cbp[col];
        const float gbi = gbp[h], gbf = gbp[4 + h];
        const float qscale = (c2 < 128) ? 1.0f : 0.08838834764831845f;
        unsigned short xn[35]; u32x4 vn[2]; unsigned short gin = 0, gfn = 0;
        { const bf16_t* Pc = P + (size_t)(b * T) * ld; const int r0 = part * 32;
          const bf16_t* rp = Pc + (long)(r0 - 3) * ld;
#pragma unroll
          for (int i = 0; i < 35; ++i) { xn[i] = (r0 - 3 + i >= 0) ? rp[col] : (unsigned short)0; rp += ld; asm volatile("" : "+s"(rp)); }
          const int key = tid >> 3, dc = tid & 7;
#pragma unroll
          for (int q = 0; q < 2; ++q) vn[q] = *(const u32x4*)(Pc + (long)key * ld + 1024 + h * 256 + vh * 128 + (dc + 8 * q) * 8);
          if (wave == 0) { gin = Pc[(long)lane * ld + 3072 + h]; gfn = Pc[(long)lane * ld + 3076 + h]; } }
        __syncthreads();
#pragma unroll 1
        for (int ch = 0; ch < T / 64; ++ch) {
            const int t0 = ch * 64; const bf16_t* Pc = P + (size_t)(b * T + t0) * ld;
            if (wave == 0) {
                const float li = bf2f(gin) + gbi;
                float bb = logsigmoidf_(bf2f(gfn) + gbf);
#pragma unroll
                for (int o = 1; o < 64; o <<= 1) { const float u = __shfl_up(bb, o); if (lane >= o) bb += u; }
                float pm = li - bb;
#pragma unroll
                for (int o = 1; o < 64; o <<= 1) { const float u = __shfl_up(pm, o); if (lane >= o) pm = fmaxf(pm, u); }
                const float mprev = scl[0];
                const float mt = fmaxf(bb + mprev, bb + pm);
                const float bend = __shfl(bb, 63);
                const float decay = bend - bb + li;
                const float mnew = fmaxf(bend + mprev, wave_max(decay));
                bL[lane] = bb; liL[lane] = li; mtL[lane] = mt; wiL[lane] = __expf(bb + mprev - mt); wkL[lane] = __expf(decay - mnew);
                if (lane == 0) { scl[1] = __expf(bend + mprev - mnew); scl[2] = mnew; }
            }
            __syncthreads();
            {
                const int r0 = part * 32;
                LAS unsigned char* rowbase = lds + ((c2 < 128) ? L_Q : L_KK) + (c2 & 127) * 2;
#pragma unroll
                for (int i = 0; i < 32; ++i) { const int rr = r0 + i;
                    const float y = w0 * bf2f(xn[i]) + w1 * bf2f(xn[i + 1]) + w2 * bf2f(xn[i + 2]) + w3 * bf2f(xn[i + 3]) + cb; const float o = y * sigmoidf_(y) * qscale;
                    *(LAS unsigned short*)(rowbase + rr * PK) = (unsigned short)f2bf(o);
                    if (c2 >= 128) *(LAS unsigned short*)(lds + L_KWT + (c2 - 128) * PS + rr * 2) = (unsigned short)f2bf(o * wkL[rr]);
                    if ((i & 3) == 3) asm volatile("" ::: "memory"); }
                const int key = tid >> 3, dc = tid & 7;
#pragma unroll
                for (int q = 0; q < 2; ++q) { const unsigned w[4] = {vn[q].x, vn[q].y, vn[q].z, vn[q].w};
#pragma unroll
                    for (int e = 0; e < 4; ++e) { const int vrow = (dc + 8 * q) * 8 + 2 * e;
                        *(LAS unsigned short*)(lds + L_VT + vrow * PS + key * 2) = (unsigned short)(w[e] & 0xffffu); *(LAS unsigned short*)(lds + L_VT + (vrow + 1) * PS + key * 2) = (unsigned short)(w[e] >> 16); } }
            }
            if (ch + 1 < T / 64) {
                const bf16_t* Pn = Pc + (size_t)64 * ld; const int r0 = part * 32;
                const bf16_t* rp = Pn + (long)(r0 - 3) * ld;
#pragma unroll
                for (int i = 0; i < 35; ++i) { xn[i] = rp[col]; rp += ld; asm volatile("" : "+s"(rp)); }
                const int key = tid >> 3, dc = tid & 7;
#pragma unroll
                for (int q = 0; q < 2; ++q) vn[q] = *(const u32x4*)(Pn + (long)key * ld + 1024 + h * 256 + vh * 128 + (dc + 8 * q) * 8);
                if (wave == 0) { gin = Pn[(long)lane * ld + 3072 + h]; gfn = Pn[(long)lane * ld + 3076 + h]; }
            }
            __syncthreads();
#pragma unroll
            for (int q = 0; q < 2; ++q) {
                const int idx = 2 * wave + q, ti = idx >> 2, tj = idx & 3;
                f32x4 a = (f32x4){0.f, 0.f, 0.f, 0.f};
                if (ti <= tj) {
#pragma unroll
                    for (int ks = 0; ks < 4; ++ks) a = __builtin_amdgcn_mfma_f32_16x16x32_bf16(frag(lds + L_KK, 16 * ti + fr, PK, 32 * ks + 8 * fg), frag(lds + L_Q, 16 * tj + fr, PK, 32 * ks + 8 * fg), a, 0, 0, 0);
                    const int t = 16 * tj + fr; const float bt = bL[t], mt = mtL[t];
#pragma unroll
                    for (int e = 0; e < 4; ++e) { const int s = 16 * ti + 4 * fg + e; a[e] = (s <= t) ? a[e] * __expf(bt - bL[s] + liL[s] - mt) : 0.f; }
                }
                u32x2 w; w.x = pg8::cvt_pk_bf16(a[0], a[1]); w.y = pg8::cvt_pk_bf16(a[2], a[3]);
                *(LAS u32x2*)(lds + L_S + (16 * tj + fr) * PS + (16 * ti + 4 * fg) * 2) = w;
            }
            __syncthreads();
            {
#pragma unroll 1
                for (int tj = 0; tj < 4; ++tj) {
                    f32x4 a1 = (f32x4){0.f, 0.f, 0.f, 0.f}, a2 = a1, d1 = a1, d2 = a1;
#pragma unroll
                    for (int ks = 0; ks < 2; ++ks) { const bf16x8 bs = frag(lds + L_S, 16 * tj + fr, PS, 32 * ks + 8 * fg);
                        a1 = __builtin_amdgcn_mfma_f32_16x16x32_bf16(frag(lds + L_VT, 16 * wave + fr, PS, 32 * ks + 8 * fg), bs, a1, 0, 0, 0);
                        d1 = __builtin_amdgcn_mfma_f32_16x16x32_bf16(frag(lds + L_VT, 128 + fr, PS, 32 * ks + 8 * fg), bs, d1, 0, 0, 0); }
#pragma unroll
                    for (int ks = 0; ks < 4; ++ks) { const bf16x8 bq = frag(lds + L_Q, 16 * tj + fr, PK, 32 * ks + 8 * fg);
                        a2 = __builtin_amdgcn_mfma_f32_16x16x32_bf16(frag(lds + L_C, 16 * wave + fr, PK, 32 * ks + 8 * fg), bq, a2, 0, 0, 0);
                        d2 = __builtin_amdgcn_mfma_f32_16x16x32_bf16(frag(lds + L_C, 128 + fr, PK, 32 * ks + 8 * fg), bq, d2, 0, 0, 0); }
                    const int t = 16 * tj + fr; const float wi = wiL[t];
                    float den = d1[0] + wi * d2[0];
                    den = __shfl(den, fr);
                    const float inv = __builtin_amdgcn_rcpf(fmaxf(fabsf(den), __expf(-mtL[t])));
                    u32x2 w; w.x = pg8::cvt_pk_bf16((a1[0] + wi * a2[0]) * inv, (a1[1] + wi * a2[1]) * inv); w.y = pg8::cvt_pk_bf16((a1[2] + wi * a2[2]) * inv, (a1[3] + wi * a2[3]) * inv);
                    *(u32x2*)(HO + (size_t)(b * T + t0 + t) * D + h * 256 + vh * 128 + 16 * wave + 4 * fg) = w;
                }
            }
            __syncthreads();
            {
                const float cs = scl[1];
                const bf16x8 ka0 = frag(lds + L_KWT, 16 * wave + fr, PS, 8 * fg), ka1 = frag(lds + L_KWT, 16 * wave + fr, PS, 32 + 8 * fg);
#pragma unroll
                for (int j = 0; j < 9; ++j) {
                    Cacc[j] = Cacc[j] * cs;
                    Cacc[j] = __builtin_amdgcn_mfma_f32_16x16x32_bf16(ka0, frag(lds + L_VT, 16 * j + fr, PS, 8 * fg), Cacc[j], 0, 0, 0);
                    Cacc[j] = __builtin_amdgcn_mfma_f32_16x16x32_bf16(ka1, frag(lds + L_VT, 16 * j + fr, PS, 32 + 8 * fg), Cacc[j], 0, 0, 0);
                    u32x2 w; w.x = pg8::cvt_pk_bf16(Cacc[j][0], Cacc[j][1]); w.y = pg8::cvt_pk_bf16(Cacc[j][2], Cacc[j][3]);
                    *(LAS u32x2*)(lds + L_C + (16 * j + fr) * PK + (16 * wave + 4 * fg) * 2) = w;
                }
                if (tid == 0) scl[0] = scl[2];
            }
            __syncthreads();
        }
    }
}
namespace hg {
constexpr int PK = 272, PS = 144;
constexpr int L_QD = 0, L_KD = L_QD + 64 * PK, L_KDT = L_KD + 64 * PK, L_VT = L_KDT + 128 * PS, L_A = L_VT + 128 * PS, L_ST = L_A + 64 * PS, L_TOT = L_ST + 128 * PK, L_GE = L_TOT + 4 * 128 * 4, L_SSQ = L_GE + 128 * 4;
__device__ __forceinline__ bf16x8 frag(const LAS unsigned char* base, int row, int pitch, int kelem) { return *(const LAS bf16x8*)(base + row * pitch + kelem * 2); }
}
__device__ __forceinline__ void phase_hgrn_scan_mfma(Frame& F) {
    using namespace hg;
    LAS unsigned char* lds = F.lds;
    LAS float* totL = (LAS float*)(lds + L_TOT); LAS float* geL = (LAS float*)(lds + L_GE);
    const bf16_t* P = WSP(bf16_t, OFF_PROJ); bf16_t* ATT = WSP(bf16_t, OFF_ATT);
    const float* lbt = WSP(float, OFF_TAB) + TAB_LB; const float* norm_g = inptr(F, I_HG_NORM_G);
    LAS float* ssqL = (LAS float*)(F.lds + hg::L_SSQ);
    int tid = F.tid; asm volatile("; phase-local tid" : "+v"(tid));
    const int lane = tid & 63, wave = __builtin_amdgcn_readfirstlane(tid >> 6), ld = HG_LD;
    const int fr = lane & 15, fg = lane >> 4;
    const int kc = tid & 127, part = __builtin_amdgcn_readfirstlane(tid >> 7);
    const int vkey = lane, vdc2 = 2 * wave;
#pragma unroll 1
    for (int item = F.bx; item < BATCH * 8; item += F.G) {
        const int h = item & 7, b = item >> 3;
        f32x4 Sacc[8];
#pragma unroll
        for (int j = 0; j < 8; ++j) Sacc[j] = (f32x4){0.f, 0.f, 0.f, 0.f};
        for (int i = tid; i < 128 * PK / 4; i += 512) ((LAS unsigned*)(lds + L_ST))[i] = 0u;
        const float lb = lbt[h * 128 + kc];
        const f32x4 ngv = *(const f32x4*)(norm_g + h * 128 + 16 * wave + 4 * fg);
        unsigned short qn[16], fn[16]; u32x4 vn[2];
        { const bf16_t* Pc = P + (size_t)(b * T) * ld;
          const bf16_t* rp = Pc + (long)(16 * part) * ld + h * 128;
#pragma unroll
          for (int i = 0; i < 16; ++i) { qn[i] = rp[kc]; fn[i] = rp[1024 + kc]; rp += ld; asm volatile("" : "+s"(rp)); }
#pragma unroll
          for (int q = 0; q < 2; ++q) vn[q] = *(const u32x4*)(Pc + (long)vkey * ld + 2048 + h * 128 + (vdc2 + q) * 8); }
        __syncthreads();
#pragma unroll 1
        for (int ch = 0; ch < T / 64; ++ch) {
            const int t0 = ch * 64;
            float qs[16], kk[16], G[16]; u32x4 vv[2];
            {
                float run = 0.f;
#pragma unroll
                for (int i = 0; i < 16; ++i) { const float qr = bf2f(qn[i]), fraw = bf2f(fn[i]);
                    const float f = lb + (1.0f - lb) * sigmoidf_(fraw);
                    run += __logf(f); G[i] = run; qs[i] = qr * sigmoidf_(qr); kk[i] = 1.0f - f; }
                totL[part * 128 + kc] = run; vv[0] = vn[0]; vv[1] = vn[1];
            }
            __syncthreads();
            if (ch + 1 < T / 64) {
                const bf16_t* Pn = P + (size_t)(b * T + t0 + 64) * ld;
                const bf16_t* rp = Pn + (long)(16 * part) * ld + h * 128;
#pragma unroll
                for (int i = 0; i < 16; ++i) { qn[i] = rp[kc]; fn[i] = rp[1024 + kc]; rp += ld; asm volatile("" : "+s"(rp)); }
#pragma unroll
                for (int q = 0; q < 2; ++q) vn[q] = *(const u32x4*)(Pn + (long)vkey * ld + 2048 + h * 128 + (vdc2 + q) * 8);
            }
            {
                float off = 0.f, tot = 0.f;
#pragma unroll
                for (int p = 0; p < 4; ++p) { const float tp = totL[p * 128 + kc]; if (p < part) off += tp; tot += tp; }
                if (part == 3) geL[kc] = __expf(tot);
                unsigned kdw[8];
#pragma unroll
                for (int i = 0; i < 16; ++i) { const int r = 16 * part + i; const float g = G[i] + off;
                    const unsigned short qd = (unsigned short)f2bf(qs[i] * __expf(g)), kd = (unsigned short)f2bf(kk[i] * __expf(-g));
                    *(LAS unsigned short*)(lds + L_QD + r * PK + kc * 2) = qd; *(LAS unsigned short*)(lds + L_KD + r * PK + kc * 2) = kd;
                    if (i & 1) kdw[i >> 1] |= (unsigned)kd << 16; else kdw[i >> 1] = (unsigned)kd; }
                { u32x4 w0, w1; w0.x = kdw[0]; w0.y = kdw[1]; w0.z = kdw[2]; w0.w = kdw[3]; w1.x = kdw[4]; w1.y = kdw[5]; w1.z = kdw[6]; w1.w = kdw[7];
                  LAS u32x4* kp = (LAS u32x4*)(lds + L_KDT + kc * PS + (16 * part) * 2); kp[0] = w0; kp[1] = w1; }
#pragma unroll
                for (int q = 0; q < 2; ++q) { const unsigned w[4] = {vv[q].x, vv[q].y, vv[q].z, vv[q].w};
#pragma unroll
                    for (int e = 0; e < 4; ++e) { const int vrow = (vdc2 + q) * 8 + 2 * e;
                        *(LAS unsigned short*)(lds + L_VT + vrow * PS + vkey * 2) = (unsigned short)(w[e] & 0xffffu); *(LAS unsigned short*)(lds + L_VT + (vrow + 1) * PS + vkey * 2) = (unsigned short)(w[e] >> 16); } }
            }
            __syncthreads();
#pragma unroll
            for (int q = 0; q < 2; ++q) {
                const int idx = 2 * wave + q, ti = idx >> 2, tj = idx & 3;
                f32x4 a = (f32x4){0.f, 0.f, 0.f, 0.f};
                if (ti <= tj) {
#pragma unroll
                    for (int ks = 0; ks < 4; ++ks) a = __builtin_amdgcn_mfma_f32_16x16x32_bf16(frag(lds + L_KD, 16 * ti + fr, PK, 32 * ks + 8 * fg), frag(lds + L_QD, 16 * tj + fr, PK, 32 * ks + 8 * fg), a, 0, 0, 0);
                    const int t = 16 * tj + fr;
#pragma unroll
                    for (int e = 0; e < 4; ++e) { const int s = 16 * ti + 4 * fg + e; a[e] = (s <= t) ? a[e] : 0.f; }
                }
                u32x2 w; w.x = pg8::cvt_pk_bf16(a[0], a[1]); w.y = pg8::cvt_pk_bf16(a[2], a[3]);
                *(LAS u32x2*)(lds + L_A + (16 * tj + fr) * PS + (16 * ti + 4 * fg) * 2) = w;
            }
            __syncthreads();
            f32x4 ot[4]; u32x2 gq[4];
            const bf16_t* Pg = P + (size_t)(b * T + t0) * ld + 3072 + h * 128 + 16 * wave + 4 * fg;
#pragma unroll
            for (int tj = 0; tj < 4; ++tj) {
                f32x4 a = (f32x4){0.f, 0.f, 0.f, 0.f};
                gq[tj] = *(const u32x2*)(Pg + (size_t)(16 * tj + fr) * ld);
#pragma unroll
                for (int ks = 0; ks < 2; ++ks) a = __builtin_amdgcn_mfma_f32_16x16x32_bf16(frag(lds + L_VT, 16 * wave + fr, PS, 32 * ks + 8 * fg), frag(lds + L_A, 16 * tj + fr, PS, 32 * ks + 8 * fg), a, 0, 0, 0);
#pragma unroll
                for (int ks = 0; ks < 4; ++ks) a = __builtin_amdgcn_mfma_f32_16x16x32_bf16(frag(lds + L_ST, 16 * wave + fr, PK, 32 * ks + 8 * fg), frag(lds + L_QD, 16 * tj + fr, PK, 32 * ks + 8 * fg), a, 0, 0, 0);
                ot[tj] = a;
                float ss = (a[0] * a[0] + a[1] * a[1]) + (a[2] * a[2] + a[3] * a[3]);
                ss += __shfl_xor(ss, 16); ss += __shfl_xor(ss, 32);
                if (fg == 0) ssqL[wave * 64 + 16 * tj + fr] = ss;
            }
            __syncthreads();
#pragma unroll
            for (int tj = 0; tj < 4; ++tj) {
                const int t = 16 * tj + fr; float tot = 0.f;
#pragma unroll
                for (int w8 = 0; w8 < 8; ++w8) tot += ssqL[w8 * 64 + t];
                const float rr = __builtin_amdgcn_rsqf(tot * (1.0f / 128.0f) + RMS_EPS);
                const float g0 = __uint_as_float(gq[tj].x << 16), g1 = __uint_as_float(gq[tj].x & 0xffff0000u), g2 = __uint_as_float(gq[tj].y << 16), g3 = __uint_as_float(gq[tj].y & 0xffff0000u);
                u32x2 w; w.x = pg8::cvt_pk_bf16(ot[tj][0] * rr * ngv[0] * sigmoidf_(g0), ot[tj][1] * rr * ngv[1] * sigmoidf_(g1));
                w.y = pg8::cvt_pk_bf16(ot[tj][2] * rr * ngv[2] * sigmoidf_(g2), ot[tj][3] * rr * ngv[3] * sigmoidf_(g3));
                *(u32x2*)(ATT + (size_t)(b * T + t0 + t) * D + h * 128 + 16 * wave + 4 * fg) = w;
            }
            {
                const bf16x8 ka0 = frag(lds + L_KDT, 16 * wave + fr, PS, 8 * fg), ka1 = frag(lds + L_KDT, 16 * wave + fr, PS, 32 + 8 * fg);
                const f32x4 ge = *(const LAS f32x4*)(geL + 16 * wave + 4 * fg);
#pragma unroll
                for (int j = 0; j < 8; ++j) {
                    Sacc[j] = __builtin_amdgcn_mfma_f32_16x16x32_bf16(ka0, frag(lds + L_VT, 16 * j + fr, PS, 8 * fg), Sacc[j], 0, 0, 0);
                    Sacc[j] = __builtin_amdgcn_mfma_f32_16x16x32_bf16(ka1, frag(lds + L_VT, 16 * j + fr, PS, 32 + 8 * fg), Sacc[j], 0, 0, 0);
                    Sacc[j] = Sacc[j] * ge;
                    u32x2 w; w.x = pg8::cvt_pk_bf16(Sacc[j][0], Sacc[j][1]); w.y = pg8::cvt_pk_bf16(Sacc[j][2], Sacc[j][3]);
                    *(LAS u32x2*)(lds + L_ST + (16 * j + fr) * PK + (16 * wave + 4 * fg) * 2) = w;
                }
            }
            __syncthreads();
        }
    }
}
constexpr int PH_PER_LAYER = 10, N_PHASES = 1 + PH_PER_LAYER * DEPTH;
struct Args { const float* in[27]; float* out; unsigned char* ws; int ph_lo, ph_hi; };
__global__ void __launch_bounds__(512, 2) mk_fwd(Args args) {
    extern __shared__ __attribute__((aligned(16))) unsigned char lds[];
    Frame F;
    F.lds = (LAS unsigned char*)lds;
    F.LC = (volatile LAS unsigned*)(F.lds + LDSCTL_OFF);
    F.tid = threadIdx.x; F.lane = F.tid & 63; F.wave = __builtin_amdgcn_readfirstlane(F.tid >> 6); F.G = gridDim.x; F.bx = blockIdx.x;
    F.ws = (unsigned char*)(GAS unsigned char*)args.ws; F.ctl = (unsigned*)(F.ws + OFF_CTL); F.out = (float*)(GAS float*)args.out;
    for (int u = F.tid; u < (LDS_BYTES - LDSCTL_OFF) / 4; u += 512) F.LC[u] = 0u;
    __syncthreads();
    if (F.tid < 27) { const unsigned long long pv = (unsigned long long)args.in[F.tid]; F.LC[128 + 2 * F.tid] = (unsigned)pv; F.LC[129 + 2 * F.tid] = (unsigned)(pv >> 32); }
    __syncthreads();
    XcdBarrier bar; bar.bar = F.ctl + CW_BAR; bar.x = 0; bar.st = nullptr;
    if (!MK_PER_PHASE) bar = xcd_barrier_post(F.ctl + CW_BAR, F.LC);
    const int lo = args.ph_lo, hi = args.ph_hi;
#define IN(k) (lo <= (k) && (k) < hi)
#ifndef DBL_LNR
#define DBL_LNR 1
#endif
#ifndef DBL_COMB
#define DBL_COMB 1
#endif
#ifndef DBL_NG
#define DBL_NG 1
#endif
#ifndef DBL_GIN
#define DBL_GIN 1
#endif
#ifndef DBL_GOUT
#define DBL_GOUT 1
#endif
#ifndef DBL_GCMP
#define DBL_GCMP 1
#endif
#ifndef DBL_GUP
#define DBL_GUP 1
#endif
#ifndef DBL_GDN
#define DBL_GDN 1
#endif
#ifndef DBL_SCAN
#define DBL_SCAN 1
#endif
#ifndef DBL_P0
#define DBL_P0 1
#endif
#ifndef DBL_ATT
#define DBL_ATT 1
#endif
#define REP(n) _Pragma("unroll 1") for (int rep_ = 0; rep_ < (n); ++rep_)
#ifdef PROBE_A
#define STAMP(k) do { if (blockIdx.x == 0 && F.tid == 0) ((unsigned long long*)(F.ws + OFF_TAB + 65536))[(k)] = wall_clock64(); } while (0)
#else
#define STAMP(k) do {} while (0)
#endif
#define SEAM(k) do { if (!MK_PER_PHASE && (k) + 1 < hi) xcd_barrier(bar); else __syncthreads(); } while (0)

    STAMP(0);
    if (IN(0)) {
#ifndef NO_P0
 REP(DBL_P0) p0_prologue(F);
#endif
 SEAM(0); }

    for (int L = 0; L < DEPTH; ++L) {
        int Lo = L; asm volatile("; layer-local" : "+s"(Lo));
        const int kind = Lo % 3, slot = Lo / 3, pb = 1 + PH_PER_LAYER * Lo;
#define PHL Frame Fp = F; asm volatile("; phase-local" : "+v"(Fp.tid), "+s"(Fp.bx)); Fp.lane = Fp.tid & 63;
        const int ldp = kind == 0 ? NSA_LD : (kind == 1 ? ML_LD : HG_LD);
        if (IN(pb + 0)) { PHL STAMP(pb + 0);
            const bf16_t* Wt = kind == 0 ? WSP(bf16_t, OFF_W_NSAIN) + (size_t)slot * NSA_LD * D : (kind == 1 ? WSP(bf16_t, OFF_W_MLIN) : WSP(bf16_t, OFF_W_HGIN));
            pg8::APlain AS{WSP(bf16_t, OFF_XN), D}; pg8::BPlain BS{Wt, D}; pg8::StaticOrder S; S.init(NTOK / 256, ldp / 256, Fp.G, Fp.bx);
            pg8::EpiStore E{WSP(bf16_t, OFF_PROJ), ldp};
            #ifndef NO_GIN
            REP(DBL_GIN) pg8::gemm_phase<pg8::EpiStore, pg8::StaticOrder, pg8::APlain, pg8::BPlain>(Fp.lds, D, AS, BS, S, E);
#endif
            SEAM(pb + 0);
        }
        if (kind == 0) {
            if (IN(pb + 1)) { PHL STAMP(pb + 1);
                pg8::ACmp AS{WSP(bf16_t, OFF_PROJ), NSA_LD, 1024}; pg8::BGroup BS{WSP(bf16_t, OFF_W_CMP1) + (size_t)slot * 2 * 256 * 2048, 2048, (size_t)256 * 2048};
                pg8::CmpOrder S{Fp.G, Fp.bx};
                pg8::EpiCmpGelu E{WSP(bf16_t, OFF_HC), WSP(float, OFF_TAB) + TAB_CMPB + slot * 512};
                #ifndef NO_GCMP
                REP(DBL_GCMP) pg8::gemm_phase<pg8::EpiCmpGelu, pg8::CmpOrder, pg8::ACmp, pg8::BGroup>(Fp.lds, 2048, AS, BS, S, E);
#endif
                SEAM(pb + 1);
            }
            if (IN(pb + 2)) { PHL STAMP(pb + 2);
#ifndef NO_CMP2
 REP(DBL_GCMP) phase_nsa_cmp2(Fp, slot);
#endif
 SEAM(pb + 2); }
            if (IN(pb + 3)) { PHL STAMP(pb + 3);
#ifndef NO_ATTN
 REP(DBL_ATT) phase_nsa_attn_mfma(Fp, slot);
#endif
 SEAM(pb + 3); }
        } else if (kind == 1) {
            if (IN(pb + 1)) { PHL STAMP(pb + 1);
#ifdef MLS_CHECK
                {
                    const size_t n16 = (size_t)NTOK * D * 2 / 16; u32x4* HMv = WSP(u32x4, OFF_HM); u32x4* Y1 = WSP(u32x4, OFF_Y); u32x4* Y2 = WSP(u32x4, OFF_Y + 160 * MiB);
#pragma unroll 1
                    for (int rep_ = 0; rep_ < 3; ++rep_) {
                        phase_mlstm_scan_mfma(Fp);
                        xcd_barrier(bar);
                        if (rep_ < 2) { u32x4* dst = rep_ == 0 ? Y1 : Y2;
                            for (size_t i = (size_t)blockIdx.x * 512 + Fp.tid; i < n16; i += (size_t)Fp.G * 512) dst[i] = HMv[i];
                            xcd_barrier(bar); }
                    }
                    unsigned bad_bits = 0u; float md = 0.f, mr = 0.f;
                    for (size_t i = (size_t)blockIdx.x * 512 + Fp.tid; i < n16; i += (size_t)Fp.G * 512) { const u32x4 a = HMv[i], b2 = Y2[i], c1 = Y1[i];
                        if (a.x != b2.x || a.y != b2.y || a.z != b2.z || a.w != b2.w) bad_bits = 1u;
                        const unsigned aw[4] = {a.x, a.y, a.z, a.w}, cw[4] = {c1.x, c1.y, c1.z, c1.w};
#pragma unroll
                        for (int q = 0; q < 4; ++q) { const float a0 = __uint_as_float(aw[q] << 16), a1 = __uint_as_float(aw[q] & 0xffff0000u), r0 = __uint_as_float(cw[q] << 16), r1 = __uint_as_float(cw[q] & 0xffff0000u);
                            md = fmaxf(md, fmaxf(fabsf(a0 - r0), fabsf(a1 - r1))); mr = fmaxf(mr, fmaxf(fabsf(r0), fabsf(r1))); if (!(a0 == a0) || !(a1 == a1)) bad_bits |= 4u; } }
                    md = wave_max(md); mr = wave_max(mr);
                    if (Fp.lane == 0) { atomicMax(F.ctl + 9000, __float_as_uint(md)); atomicMax(F.ctl + 9001, __float_as_uint(mr)); }
                    if (bad_bits) atomicOr(F.ctl + 9002, bad_bits);
                }
#else
#ifndef NO_MLS
 REP(DBL_SCAN) phase_mlstm_scan_mfma(Fp);
#endif
#endif
 SEAM(pb + 1); }
            if (IN(pb + 2)) { PHL STAMP(pb + 2);
#ifndef NO_NG
 REP(DBL_NG) phase_norm_gate<256>(Fp, inptr(Fp, I_ML_NORM_G), ML_LD, 2048);
#endif
 SEAM(pb + 2); }
        } else {
            if (IN(pb + 1)) { PHL STAMP(pb + 1);
#ifndef NO_HGS
 REP(DBL_SCAN) phase_hgrn_scan_mfma(Fp);
#endif
 SEAM(pb + 1); }
        }
        if (IN(pb + 4)) { PHL STAMP(pb + 4);
            const bf16_t* Wt = kind == 0 ? WSP(bf16_t, OFF_W_NSAOUT) + (size_t)slot * D * D : (kind == 1 ? WSP(bf16_t, OFF_W_MLOUT) : WSP(bf16_t, OFF_W_HGOUT));
            pg8::APlain AS{WSP(bf16_t, OFF_ATT), D}; pg8::BPlain BS{Wt, D}; pg8::StaticOrder S; S.init(NTOK / 256, D / 256, Fp.G, Fp.bx);
            pg8::EpiStore E{WSP(bf16_t, OFF_HM), D};
            #ifndef NO_GOUT
            REP(DBL_GOUT) pg8::gemm_phase<pg8::EpiStore, pg8::StaticOrder, pg8::APlain, pg8::BPlain>(Fp.lds, D, AS, BS, S, E);
#endif
            SEAM(pb + 4);
        }
        if (IN(pb + 5)) { PHL STAMP(pb + 5);
#ifndef NO_LNR
 if (DBL_LNR > 1) phase_ln_router(Fp, Lo, true);
 phase_ln_router(Fp, Lo);
#endif
 SEAM(pb + 5); }
        if (IN(pb + 6)) { PHL STAMP(pb + 6);
#ifndef NO_SLOT
 phase_moe_slots(Fp, Lo);
#endif
 SEAM(pb + 6); }
        if (IN(pb + 7)) { PHL STAMP(pb + 7);
            moe_tile_table(Fp, Lo);
            pg8::AGather AS{WSP(bf16_t, OFF_XN), D, WSP(int, OFF_ROWT)}; pg8::BGroup BS{WSP(bf16_t, OFF_W_GU) + (size_t)Lo * NEXP * 2048 * D, D, (size_t)2048 * D};
            pg8::MoeOrder S; S.init(__builtin_amdgcn_readfirstlane((int)Fp.LC[40]), 8, Fp.G, Fp.bx); S.pend = (const LAS int*)(Fp.lds + LDSCTL_OFF + 32);
            pg8::EpiSwiglu E{WSP(bf16_t, OFF_H), inptr(Fp, I_MOE_B_GU) + (size_t)Lo * NEXP * 2048};
            #ifndef NO_GUP
            REP(DBL_GUP) pg8::gemm_phase<pg8::EpiSwiglu, pg8::MoeOrder, pg8::AGather, pg8::BGroup>(Fp.lds, D, AS, BS, S, E);
#endif
            SEAM(pb + 7);
        }
        if (IN(pb + 8)) { PHL STAMP(pb + 8);
            moe_tile_table(Fp, Lo);
            pg8::APlain AS{WSP(bf16_t, OFF_H), DFF}; pg8::BGroup BS{WSP(bf16_t, OFF_W_DN) + (size_t)Lo * NEXP * D * DFF, DFF, (size_t)D * DFF};
            pg8::MoeOrder S; S.init(__builtin_amdgcn_readfirstlane((int)Fp.LC[40]), 4, Fp.G, Fp.bx); S.pend = (const LAS int*)(Fp.lds + LDSCTL_OFF + 32);
            pg8::EpiDown E{WSP(bf16_t, OFF_Y), inptr(Fp, I_MOE_B_DOWN) + (size_t)Lo * NEXP * D, WSP(float, OFF_ROWG)};
            #ifndef NO_GDN
            REP(DBL_GDN) pg8::gemm_phase<pg8::EpiDown, pg8::MoeOrder, pg8::APlain, pg8::BGroup>(Fp.lds, DFF, AS, BS, S, E);
#endif
            SEAM(pb + 8);
        }
        if (IN(pb + 9)) { PHL STAMP(pb + 9);
#ifndef NO_COMB
 if (DBL_COMB > 1) phase_combine_ln(Fp, Lo, (float*)nullptr, true);
 phase_combine_ln(Fp, Lo, Lo == DEPTH - 1 ? Fp.out : (float*)nullptr);
#endif
 SEAM(pb + 9); }
    }
#ifdef MLS_CHECK
    xcd_barrier(bar);
    { const float md = __uint_as_float(__hip_atomic_load(F.ctl + 9000, RLX_AGENT)), mr = __uint_as_float(__hip_atomic_load(F.ctl + 9001, RLX_AGENT)); const unsigned bb = __hip_atomic_load(F.ctl + 9002, RLX_AGENT);
      float code = 10.f; if (md > 0.02f * mr) code = 100.f; if (md > 0.2f * mr) code = 300.f; if (bb & 1u) code *= 10.f; if (bb & 4u) code *= 100.f;
      for (size_t i = (size_t)blockIdx.x * 512 + F.tid; i < (size_t)NTOK * D; i += (size_t)F.G * 512) F.out[i] = code; }
#endif
#ifdef PROBE_A
    STAMP(N_PHASES);
    xcd_barrier(bar);
    {
        const unsigned long long* st = (const unsigned long long*)(F.ws + OFF_TAB + 65536);
        float cat[6] = {0.f, 0.f, 0.f, 0.f, 0.f, 0.f};
        unsigned long long prev = __hip_atomic_load(st + 0, RLX_AGENT);
        int pc = 0;
        for (int p = 1; p <= N_PHASES; ++p) {
            int c = -1;
            if (p < N_PHASES) { const int Lq = (p - 1) / PH_PER_LAYER, k = (p - 1) % PH_PER_LAYER, kind = Lq % 3;
                if (k == 3 && kind != 0) continue;
                c = (k == 0 || k == 4 || k == 7 || k == 8) ? 1 : (k == 1 ? (kind == 0 ? 1 : (kind == 1 ? 3 : 4)) : (k == 3 ? 2 : 5)); }
            const unsigned long long now = __hip_atomic_load(st + p, RLX_AGENT);
            const float us = (float)(now - prev) * 0.01f;
#pragma unroll
            for (int q = 0; q < 6; ++q) if (q == pc) cat[q] += us;
            prev = now; pc = c;
        }
        float va = 0.f, vb = 0.f;
#pragma unroll
        for (int q = 0; q < 6; ++q) { if (q == PROBE_A) va = cat[q]; if (q == PROBE_B) vb = cat[q]; }
        const float kfill = sqrtf(va);
        for (size_t i = (size_t)blockIdx.x * 512 + F.tid; i < (size_t)NTOK * D; i += (size_t)F.G * 512) F.out[i] = (i == 0) ? vb : kfill;
    }
#endif
#undef IN
#undef SEAM
#undef PHL
}

extern "C" void kernel_launch(void* const* d_in, const int* in_sizes, int n_in, void* d_out, int out_size, void* d_ws, size_t ws_size, hipStream_t stream) {
    static int grid = 0;
    if (grid == 0) {
        if (n_in != 27 || out_size != NTOK * D || ws_size < WS_END) { fprintf(stderr, "kernel_launch: unexpected shapes (n_in %d, out %d, ws %zu)\n", n_in, out_size, ws_size); grid = -1; return; }
        int dev = 0, cus = 0;
        if (hipGetDevice(&dev) != hipSuccess || hipDeviceGetAttribute(&cus, hipDeviceAttributeMultiprocessorCount, dev) != hipSuccess) { grid = -1; return; }
        if (hipFuncSetAttribute((const void*)mk_fwd, hipFuncAttributeMaxDynamicSharedMemorySize, LDS_BYTES) != hipSuccess) { fprintf(stderr, "kernel_launch: hipFuncSetAttribute failed\n"); grid = -1; return; }
        int per_cu = 0;
        if (hipOccupancyMaxActiveBlocksPerMultiprocessor(&per_cu, (const void*)mk_fwd, 512, LDS_BYTES) != hipSuccess || per_cu < 1) fprintf(stderr, "kernel_launch: occupancy query reports %d\n", per_cu);
        (void)hipGetLastError();
        grid = cus;
    }
    if (grid < 0) return;
    (void)hipMemsetAsync((char*)d_ws + OFF_CTL, 0, CTL_ZERO_BYTES, stream);
    Args a{};
    for (int i = 0; i < 27; ++i) a.in[i] = (const float*)d_in[i];
    a.out = (float*)d_out; a.ws = (unsigned char*)d_ws;
#if MK_PER_PHASE
    for (int p = 0; p < N_PHASES; ++p) {
        if (p > 0) { const int L = (p - 1) / PH_PER_LAYER, k = (p - 1) % PH_PER_LAYER, kind = L % 3; if (k == 3 && kind != 0) continue; }
        a.ph_lo = p; a.ph_hi = p + 1;
        hipLaunchKernelGGL(mk_fwd, dim3(grid), dim3(512), LDS_BYTES, stream, a);
    }
#else
    a.ph_lo = 0; a.ph_hi = N_PHASES;
    hipLaunchKernelGGL(mk_fwd, dim3(grid), dim3(512), LDS_BYTES, stream, a);
#endif
}
```

```cpp
#include <hip/hip_runtime.h>
#include <cstdio>
#include <cstdint>

#define LAS __attribute__((address_space(3)))
#define GAS __attribute__((address_space(1)))
typedef unsigned short bf16_t;
typedef short bf16x8 __attribute__((ext_vector_type(8)));
typedef float f32x4 __attribute__((ext_vector_type(4)));
typedef float f32x2 __attribute__((ext_vector_type(2)));
typedef unsigned u32x4 __attribute__((ext_vector_type(4)));
typedef unsigned u32x2 __attribute__((ext_vector_type(2)));
#define RLX_AGENT __ATOMIC_RELAXED, __HIP_MEMORY_SCOPE_AGENT
#define LDS_WAIT() asm volatile("s_waitcnt lgkmcnt(0)" ::: "memory")
#define VM_WAIT() asm volatile("s_waitcnt vmcnt(0)" ::: "memory")

#ifndef MK_PER_PHASE
#define MK_PER_PHASE 0
#endif

constexpr int D = 1024, BATCH = 32, T = 2048, NTOK = BATCH * T, DEPTH = 4;
constexpr int NSA_IN = 2608, NSA_LD = 2816, ML_IN = 3080, ML_LD = 3328, HG_LD = 4096;
constexpr int NEXP = 32, TOPK = 4, DFF = 1024;
constexpr int MOE_ROWS = 270336;
constexpr float LN_EPS = 1e-5f, RMS_EPS = 1e-6f;
constexpr float DN_ALPHA = 1.681792830507429f;
constexpr int NCMP = 127;

constexpr size_t MiB = 1u << 20;
constexpr size_t OFF_CTL = 0, CTL_ZERO_BYTES = 1 * MiB;
constexpr size_t OFF_TAB = 1 * MiB;
constexpr size_t OFF_TOKE = 2 * MiB;
constexpr size_t OFF_TOKG = 3 * MiB;
constexpr size_t OFF_TOKP = 4 * MiB;
constexpr size_t OFF_ROWT = 5 * MiB;
constexpr size_t OFF_ROWG = 7 * MiB;
constexpr size_t OFF_KC = 9 * MiB;
constexpr size_t OFF_HC = 17 * MiB;
constexpr size_t OFF_W_NSAIN = 33 * MiB;
constexpr size_t OFF_W_NSAOUT = 44 * MiB;
constexpr size_t OFF_W_MLIN = 48 * MiB;
constexpr size_t OFF_W_MLOUT = 55 * MiB;
constexpr size_t OFF_W_HGIN = 57 * MiB;
constexpr size_t OFF_W_HGOUT = 65 * MiB;
constexpr size_t OFF_W_CMP2 = 71 * MiB;
constexpr size_t OFF_W_CMP1 = 67 * MiB;
constexpr size_t OFF_W_GU = 72 * MiB;
constexpr size_t OFF_W_DN = 584 * MiB;
constexpr size_t OFF_XA = 840 * MiB;
constexpr size_t OFF_XN = 1096 * MiB;
constexpr size_t OFF_PROJ = 1224 * MiB;
constexpr size_t OFF_ATT = 1740 * MiB;
constexpr size_t OFF_HM = 1868 * MiB;
constexpr size_t OFF_H = 1996 * MiB;
constexpr size_t OFF_Y = 2526 * MiB;
constexpr size_t WS_END = 3056 * MiB;
constexpr int TAB_CMPB = 0;
constexpr int TAB_LB = 4096;
constexpr int TAB_RWT = 8192;
constexpr int CW_BAR = 4096;
constexpr int CW_CNT = 16384;
constexpr int CW_CUR = 16384 + 1024;

constexpr int RING_BYTES = 131072;
constexpr int LDSCTL_OFF = 155648;
constexpr int LDS_BYTES = 156672;

__device__ __forceinline__ float bf2f(bf16_t b) { return __uint_as_float(((unsigned)b) << 16); }
typedef float f32x2_t_ __attribute__((ext_vector_type(2))); typedef __bf16 bf16x2_t_ __attribute__((ext_vector_type(2)));
__device__ __forceinline__ unsigned pk2(float lo, float hi) { const f32x2_t_ v = {lo, hi}; const bf16x2_t_ b = __builtin_convertvector(v, bf16x2_t_); return __builtin_bit_cast(unsigned, b); }
__device__ __forceinline__ unsigned f2bf(float f) { return pk2(f, f) & 0xffffu; }
template <int CTRL> __device__ __forceinline__ float dpp_keep(float oldv, float v) { return __builtin_bit_cast(float, __builtin_amdgcn_update_dpp(__builtin_bit_cast(int, oldv), __builtin_bit_cast(int, v), CTRL, 0xF, 0xF, false)); }
__device__ __forceinline__ float rdlane(float v, int l) { return __builtin_bit_cast(float, __builtin_amdgcn_readlane(__builtin_bit_cast(int, v), l)); }
__device__ __forceinline__ float scan_add64(float x, int lane) {
    x += dpp_keep<0x111>(0.f, x); x += dpp_keep<0x112>(0.f, x); x += dpp_keep<0x114>(0.f, x); x += dpp_keep<0x118>(0.f, x);
    const float r0 = rdlane(x, 15), r1 = rdlane(x, 31), r2 = rdlane(x, 47); const int row = lane >> 4;
    return x + (row == 1 ? r0 : row == 2 ? r0 + r1 : row == 3 ? (r0 + r1) + r2 : 0.f);
}
__device__ __forceinline__ float scan_max64(float x, int lane) {
    x = fmaxf(x, dpp_keep<0x111>(-INFINITY, x)); x = fmaxf(x, dpp_keep<0x112>(-INFINITY, x)); x = fmaxf(x, dpp_keep<0x114>(-INFINITY, x)); x = fmaxf(x, dpp_keep<0x118>(-INFINITY, x));
    const float r0 = rdlane(x, 15), r1 = rdlane(x, 31), r2 = rdlane(x, 47); const int row = lane >> 4;
    return fmaxf(x, row == 1 ? r0 : row == 2 ? fmaxf(r0, r1) : row == 3 ? fmaxf(fmaxf(r0, r1), r2) : -INFINITY);
}
template <int CTRL> __device__ __forceinline__ float dppf(float v) { return __builtin_bit_cast(float, __builtin_amdgcn_update_dpp(0, __builtin_bit_cast(int, v), CTRL, 0xF, 0xF, true)); }
__device__ __forceinline__ float rdl(float v, int l) { return __builtin_bit_cast(float, __builtin_amdgcn_readlane(__builtin_bit_cast(int, v), l)); }
__device__ __forceinline__ float wave_sum(float v) {
    v += dppf<0xB1>(v); v += dppf<0x4E>(v); v += dppf<0x141>(v); v += dppf<0x140>(v);
    return (rdl(v, 0) + rdl(v, 16)) + (rdl(v, 32) + rdl(v, 48));
}
__device__ __forceinline__ float wave_max(float v) {
    v = fmaxf(v, dppf<0xB1>(v)); v = fmaxf(v, dppf<0x4E>(v)); v = fmaxf(v, dppf<0x141>(v)); v = fmaxf(v, dppf<0x140>(v));
    return fmaxf(fmaxf(rdl(v, 0), rdl(v, 16)), fmaxf(rdl(v, 32), rdl(v, 48)));
}
__device__ __forceinline__ float sigmoidf_(float x) { return __builtin_amdgcn_rcpf(1.0f + __expf(-x)); }

#define XB_TMO      128
#define XB_XCNT(j)  (256  + 64 * (j))
#define XB_XSUB(j)  (1280 + 64 * (j))
#define XB_XGEN(j)  (2304 + 64 * (j))
#define XB_TOP      3328
#define XB_TOPGEN   3392
#define XCD_BAR_WORDS 3456
#define XB_SPIN_CAP (1u << 20)

__device__ __forceinline__ unsigned xb_ld(unsigned* p)              { return __hip_atomic_load(p, __ATOMIC_RELAXED, __HIP_MEMORY_SCOPE_AGENT); }
__device__ __forceinline__ unsigned xb_add(unsigned* p, unsigned v) { return __hip_atomic_fetch_add(p, v, __ATOMIC_RELAXED, __HIP_MEMORY_SCOPE_AGENT); }
__device__ __forceinline__ unsigned xb_xcc_id() { return (unsigned)__builtin_amdgcn_s_getreg((3 << 11) | 20) & 0xFu; }
#define XB_SPIN(cond, bar) do { unsigned _sp = 0; while (cond) { __builtin_amdgcn_s_sleep(1); \
    if ((++_sp & 255u) == 0u) { if (xb_ld(&(bar)[XB_TMO])) break; if (_sp > XB_SPIN_CAP) { atomicAdd(&(bar)[XB_TMO], 1u); break; } } } } while (0)

struct XcdBarrier { unsigned* bar; unsigned x; volatile LAS unsigned* st; };

__device__ __forceinline__ XcdBarrier xcd_barrier_post(unsigned* bar, volatile LAS unsigned* st) {
    XcdBarrier b; b.bar = bar; b.x = xb_xcc_id(); b.st = st;
    if (threadIdx.x == 0) (void)xb_add(&bar[XB_XCNT(b.x)], 1u);
    return b;
}
__device__ __forceinline__ void xcd_barrier_complete(unsigned* bar, unsigned x, unsigned& nloc, unsigned& nx) {
    const unsigned G = gridDim.x * gridDim.y * gridDim.z;
    unsigned sum, cnt, mine, sp = 0u;
    for (;;) {
        sum = 0u; cnt = 0u; mine = 0u;
#pragma unroll
        for (unsigned j = 0; j < 16; ++j) { const unsigned c = xb_ld(&bar[XB_XCNT(j)]); sum += c; cnt += (c > 0u) ? 1u : 0u; }
        mine = xb_ld(&bar[XB_XCNT(x)]);
        if (sum == G) break;
        __builtin_amdgcn_s_sleep(1);
        if ((++sp & 255u) == 0u) { if (xb_ld(&bar[XB_TMO])) break; if (sp > XB_SPIN_CAP) { atomicAdd(&bar[XB_TMO], 1u); break; } }
    }
    nloc = mine > 0u ? mine : 1u; nx = cnt > 0u ? cnt : 1u;
}
__device__ __forceinline__ void xcd_barrier(const XcdBarrier& b) {
    asm volatile("s_waitcnt vmcnt(0)" ::: "memory");
    __syncthreads();
    if (threadIdx.x == 0) {
        unsigned* bar = b.bar; asm volatile("; barrier words" : "+s"(bar));
        __builtin_amdgcn_s_waitcnt(0);
        unsigned nloc = b.st[0], nx = b.st[1];
        if (nloc == 0u) { xcd_barrier_complete(bar, b.x, nloc, nx); b.st[0] = nloc; b.st[1] = nx; }
        const unsigned old = xb_add(&bar[XB_XSUB(b.x)], 1u);
        const unsigned gen = old / nloc;
        if (old + 1u == (gen + 1u) * nloc) {
            __builtin_amdgcn_fence(__ATOMIC_RELEASE, "agent");
            asm volatile("s_waitcnt vmcnt(0)" ::: "memory");
            const unsigned og = xb_add(&bar[XB_TOP], 1u);
            const unsigned tg = og / nx;
            if (og + 1u == (tg + 1u) * nx) xb_add(&bar[XB_TOPGEN], 1u);
            else XB_SPIN(xb_ld(&bar[XB_TOPGEN]) == tg, bar);
            __builtin_amdgcn_fence(__ATOMIC_ACQUIRE, "agent");
            xb_add(&bar[XB_XGEN(b.x)], 1u);
            asm volatile("s_waitcnt vmcnt(0)" ::: "memory");
        } else {
            XB_SPIN(xb_ld(&bar[XB_XGEN(b.x)]) == gen, bar);
            __builtin_amdgcn_fence(__ATOMIC_ACQUIRE, "agent");
            asm volatile("s_waitcnt vmcnt(0)" ::: "memory");
        }
    }
    __syncthreads();
}

namespace pg8 {
constexpr int BM = 256, BK = 64, HALF = 128, HTB = HALF * BK * 2, STAGE_BYTES = 8 * HTB, NXCD = 8, WGM = 8;
__host__ __device__ __forceinline__ int lds_byte(int r, int c) { const int st = (r >> 4) * 2 + (c >> 5), rr = r & 15, cc = c & 31, ob = rr * 64 + cc * 2; return st * 1024 + (ob ^ (((ob >> 9) & 1) << 5)); }
__host__ __device__ __forceinline__ void stage_rc(int b, int& R, int& C) { const int st = b / 1024, sb = b % 1024, swz = sb ^ (((sb >> 9) & 1) << 5); R = (st >> 1) * 16 + swz / 64; C = (st & 1) * 32 + (swz % 64) / 2; }
__host__ __device__ __forceinline__ int perm32(int rho) { const int n = rho >> 4, i = rho & 15; return 8 * (i >> 2) + 4 * n + (i & 3); }

struct Unit { int pm, pn, e; };

struct StaticOrder {
    int nM, nN, nwg, G, c, wgm = WGM;
    __device__ __forceinline__ void init(int nM_, int nN_, int G_, int c_) { nM = nM_; nN = nN_; nwg = nM * nN; G = G_; c = c_; }
    __device__ __forceinline__ bool next(int i, Unit& u) const {
        const long L = (long)i * G + c; if (L >= nwg) return false;
        int wgid = (int)L; { const int q = nwg / NXCD, r = nwg % NXCD, xcd = wgid % NXCD, off = wgid / NXCD; wgid = (xcd < r ? xcd * (q + 1) : r * (q + 1) + (xcd - r) * q) + off; }
        const int nig = wgm * nN, gid = wgid / nig, fm = gid * wgm, gsz = (nM - fm) < wgm ? (nM - fm) : wgm;
        u.pm = fm + ((wgid % nig) % gsz); u.pn = (wgid % nig) / gsz; u.e = 0; return true;
    }
};
struct MoeOrder : StaticOrder {
    const LAS int* pend;
    __device__ __forceinline__ bool next(int i, Unit& u) const {
        if (!StaticOrder::next(i, u)) return false;
        const int ln = __builtin_amdgcn_mbcnt_hi(~0u, __builtin_amdgcn_mbcnt_lo(~0u, 0u));
        const int pe = pend[ln & 31];
        const unsigned long long bal = __builtin_amdgcn_ballot_w64(ln < 31 && pe <= u.pm);
        u.e = __builtin_popcountll(bal); return true;
    }
};
struct CmpOrder {
    int G, c;
    __device__ __forceinline__ bool next(int i, Unit& u) const { const int L = i * G + c; if (L >= 128) return false; u.e = L >> 6; u.pm = L & 63; u.pn = 0; return true; }
};

__device__ __forceinline__ unsigned cvt_pk_bf16(float lo, float hi) { const f32x2_t_ v = {lo, hi}; const bf16x2_t_ b = __builtin_convertvector(v, bf16x2_t_); return __builtin_bit_cast(unsigned, b); }

struct APlain {
    static constexpr bool GATHER = false;
    const bf16_t* A; int lda;
    __device__ __forceinline__ int kstep() const { return BK * 2; }
    __device__ __forceinline__ const char* base(const Unit& u) const { return (const char*)A + (size_t)u.pm * BM * lda * 2; }
    __device__ __forceinline__ void offs(const Unit&, const int (&R)[2], const int (&C)[2], unsigned (&vo)[2][2]) const {
#pragma unroll
        for (int h = 0; h < 2; ++h)
#pragma unroll
            for (int i = 0; i < 2; ++i) vo[h][i] = (unsigned)((h * HALF + R[i]) * lda + C[i]) * 2u;
    }
};
struct AGather {
    static constexpr bool GATHER = true;
    const bf16_t* A; int lda; const int* idx;
    __device__ __forceinline__ int kstep() const { return BK * 2; }
    __device__ __forceinline__ const char* base(const Unit&) const { return (const char*)A; }
    __device__ __forceinline__ void offs(const Unit& u, const int (&R)[2], const int (&C)[2], unsigned (&vo)[2][2]) const {
#pragma unroll
        for (int h = 0; h < 2; ++h)
#pragma unroll
            for (int i = 0; i < 2; ++i) { const int row = idx[u.pm * BM + h * HALF + R[i]]; vo[h][i] = (unsigned)(row * lda + C[i]) * 2u; }
    }
};
struct ACmp {
    static constexpr bool GATHER = false;
    const bf16_t* P; int ld; int col0;
    __device__ __forceinline__ int kstep() const { return ld * 2; }
    __device__ __forceinline__ const char* base(const Unit& u) const { const int b = u.pm >> 1, g0 = (u.pm & 1) * 2; return (const char*)P + ((size_t)b * T * ld + col0 + u.e * 256 + g0 * 64) * 2; }
    __device__ __forceinline__ void offs(const Unit&, const int (&R)[2], const int (&C)[2], unsigned (&vo)[2][2]) const {
#pragma unroll
        for (int h = 0; h < 2; ++h)
#pragma unroll
            for (int i = 0; i < 2; ++i) vo[h][i] = (unsigned)(16 * R[i] * ld + h * 64 + C[i]) * 2u;
    }
};
struct BPlain { const bf16_t* Bt; int K; __device__ __forceinline__ const char* base(const Unit& u) const { return (const char*)Bt + (size_t)u.pn * BM * K * 2; } };
struct BGroup { const bf16_t* Bt; int K; size_t gstride;   __device__ __forceinline__ const char* base(const Unit& u) const { return (const char*)Bt + ((size_t)u.e * gstride + (size_t)u.pn * BM * K) * 2; } };

template <class Epi, class Sched, class ASrc, class BSrc, bool ALIGN_EPI = true, bool SP2 = true>
__device__ __forceinline__ void gemm_phase(LAS unsigned char* lds, const int K, const ASrc& AS, const BSrc& BS, const Sched& S, const Epi& E) {
    int tid = threadIdx.x; asm volatile("; phase-local tid" : "+v"(tid));
    const int wid = __builtin_amdgcn_readfirstlane(tid >> 6), lane = tid & 63, wr = wid >> 2, wc = wid & 3, fr = lane & 15, fq = lane >> 4;
    const int nt = K / BK;
    int Rs[2], Cs[2]; unsigned voffB[2];
#pragma unroll
    for (int i = 0; i < 2; ++i) { int R, C; stage_rc(tid * 16 + i * 8192, R, C); Rs[i] = R; Cs[i] = C; const int Rb = Epi::PERM ? ((R & ~31) + perm32(R & 31)) : R; voffB[i] = (unsigned)(Rb * K + C) * 2u; }
    const size_t kstepB = (size_t)(BK * 2), hstepB = (size_t)HALF * K * 2;
    const size_t kstepA = (size_t)AS.kstep();
    const unsigned ldsw = (unsigned)wid * 1024u;
    const int aoff = lds_byte(wr * 64 + fr, fq * 8), boff = lds_byte(wc * 32 + fr, fq * 8);
#define PG8_SA(b, h) (((b) * 2 + (h)) * HTB)
#define PG8_SB(b, h) ((4 + (b) * 2 + (h)) * HTB)
#define PG8_STAGEB(bufoff, gbase) do { _Pragma("unroll") for (int _i = 0; _i < 2; ++_i) \
        __builtin_amdgcn_global_load_lds((const unsigned*)((const char*)(gbase) + voffB[_i]), (LAS unsigned*)(lds + (bufoff) + ldsw + _i * 8192), 16, 0, 0); } while (0)
#define PG8_STAGEA(bufoff, gbase, o0, o1) do { \
        __builtin_amdgcn_global_load_lds((const unsigned*)((const char*)(gbase) + (o0)), (LAS unsigned*)(lds + (bufoff) + ldsw), 16, 0, 0); \
        __builtin_amdgcn_global_load_lds((const unsigned*)((const char*)(gbase) + (o1)), (LAS unsigned*)(lds + (bufoff) + ldsw + 8192), 16, 0, 0); } while (0)
#define PG8_LDA(dst, b, h) do { _Pragma("unroll") for (int m = 0; m < 4; ++m) _Pragma("unroll") for (int k = 0; k < 2; ++k) dst[m][k] = *(const LAS bf16x8*)(lds + PG8_SA(b, h) + aoff + m * 2048 + k * 1024); } while (0)
#define PG8_LDB(dst, b, h) do { _Pragma("unroll") for (int n = 0; n < 2; ++n) _Pragma("unroll") for (int k = 0; k < 2; ++k) dst[n][k] = *(const LAS bf16x8*)(lds + PG8_SB(b, h) + boff + n * 2048 + k * 1024); } while (0)
#define PG8_MMA(ai, bj, At, Bt) do { __builtin_amdgcn_s_setprio(1); _Pragma("unroll") for (int m = 0; m < 4; ++m) _Pragma("unroll") for (int n = 0; n < 2; ++n) _Pragma("unroll") for (int k = 0; k < 2; ++k) \
        acc[ai][bj][m][n] = __builtin_amdgcn_mfma_f32_16x16x32_bf16(Bt[n][k], At[m][k], acc[ai][bj][m][n], 0, 0, 0); __builtin_amdgcn_s_setprio(0); } while (0)
#define PG8_WAIT_V(n) asm volatile("s_waitcnt vmcnt(" #n ")" ::: "memory")
#define PG8_WAIT_L(n) asm volatile("s_waitcnt lgkmcnt(" #n ")" ::: "memory")
#define PG8_BAR __builtin_amdgcn_s_barrier()
#define PG8_SCHED __builtin_amdgcn_sched_barrier(0)
    Unit cur, nxt; int ui = 0;
    if (!S.next(0, cur)) return;
    f32x4 acc[2][2][4][2];
    E.init(acc, cur, wc, fq);
    bf16x8 At[4][2], B0[2][2], B1[2][2];
    unsigned vC[2][2];
    AS.offs(cur, Rs, Cs, vC);
    unsigned x00 = vC[0][0], x01 = vC[0][1], x10 = vC[1][0], x11 = vC[1][1];
    const char* cA = AS.base(cur); const char* cB = BS.base(cur);
    if constexpr (SP2) {
        PG8_STAGEB(PG8_SB(0, 0), cB); PG8_STAGEB(PG8_SB(0, 1), cB + hstepB); PG8_STAGEA(PG8_SA(0, 0), cA, vC[0][0], vC[0][1]); PG8_STAGEA(PG8_SA(0, 1), cA, vC[1][0], vC[1][1]);
        if (wr == 1) PG8_BAR;
        PG8_WAIT_V(2); PG8_BAR;
        PG8_STAGEB(PG8_SB(1, 0), cB + kstepB); PG8_STAGEA(PG8_SA(1, 0), cA + kstepA, vC[0][0], vC[0][1]); PG8_STAGEB(PG8_SB(1, 1), cB + hstepB + kstepB);
        PG8_WAIT_V(6); PG8_BAR;
    } else {
        PG8_STAGEB(PG8_SB(0, 0), cB); PG8_STAGEA(PG8_SA(0, 0), cA, vC[0][0], vC[0][1]); PG8_STAGEB(PG8_SB(0, 1), cB + hstepB); PG8_STAGEA(PG8_SA(0, 1), cA, vC[1][0], vC[1][1]);
        if (wr == 1) PG8_BAR;
        PG8_WAIT_V(4); PG8_BAR;
        PG8_STAGEB(PG8_SB(1, 0), cB + kstepB); PG8_STAGEA(PG8_SA(1, 0), cA + kstepA, vC[0][0], vC[0][1]); PG8_STAGEB(PG8_SB(1, 1), cB + hstepB + kstepB);
        PG8_WAIT_V(6); PG8_BAR;
    }
    for (;;) {
        const bool has_next = S.next(ui + 1, nxt);
        const char* nA = has_next ? AS.base(nxt) : cA; const char* nB = has_next ? BS.base(nxt) : cB;
        for (int t = 0; t < nt; t += 2) {
            const bool last = (t == nt - 2);
            const char* a1 = cA + (size_t)(t + 1) * kstepA;
            const char* a2 = last ? nA : cA + (size_t)(t + 2) * kstepA; const char* b2 = last ? nB : cB + (size_t)(t + 2) * kstepB;
            const char* a3 = a2 + kstepA; const char* b3 = b2 + kstepB;
            if constexpr (ASrc::GATHER) { if (last && has_next) { unsigned vn[2][2]; AS.offs(nxt, Rs, Cs, vn); x00 = vn[0][0]; x01 = vn[0][1]; x10 = vn[1][0]; x11 = vn[1][1]; } }
            if constexpr (SP2) {
            PG8_LDB(B0, 0, 0); PG8_LDB(B1, 0, 1); PG8_SCHED; PG8_LDA(At, 0, 0); PG8_STAGEA(PG8_SA(1, 1), a1, vC[1][0], vC[1][1]);
            PG8_WAIT_V(8); PG8_WAIT_L(0); PG8_BAR; PG8_MMA(0, 0, At, B0); PG8_MMA(0, 1, At, B1); PG8_BAR; PG8_SCHED;
            PG8_LDA(At, 0, 1); PG8_STAGEB(PG8_SB(0, 0), b2); PG8_STAGEB(PG8_SB(0, 1), b2 + hstepB); PG8_STAGEA(PG8_SA(0, 0), a2, x00, x01);
            PG8_WAIT_V(8); PG8_WAIT_L(0); PG8_BAR; PG8_MMA(1, 0, At, B0); PG8_MMA(1, 1, At, B1); PG8_BAR; PG8_SCHED;
            PG8_LDB(B0, 1, 0); PG8_LDB(B1, 1, 1); PG8_SCHED; PG8_LDA(At, 1, 0); PG8_STAGEA(PG8_SA(0, 1), a2, x10, x11);
            PG8_WAIT_V(8); PG8_WAIT_L(0); PG8_BAR; PG8_MMA(0, 0, At, B0); PG8_MMA(0, 1, At, B1); PG8_BAR; PG8_SCHED;
            PG8_LDA(At, 1, 1); PG8_STAGEB(PG8_SB(1, 0), b3); PG8_STAGEB(PG8_SB(1, 1), b3 + hstepB); PG8_STAGEA(PG8_SA(1, 0), a3, x00, x01);
            PG8_WAIT_V(8); PG8_WAIT_L(0); PG8_BAR; PG8_MMA(1, 0, At, B0); PG8_MMA(1, 1, At, B1); PG8_BAR; PG8_SCHED;
            } else {
            PG8_LDB(B0, 0, 0); PG8_SCHED; PG8_LDA(At, 0, 0); PG8_STAGEA(PG8_SA(1, 1), a1, vC[1][0], vC[1][1]);
            PG8_WAIT_L(8); PG8_BAR; PG8_WAIT_L(0); PG8_MMA(0, 0, At, B0); PG8_BAR; PG8_SCHED;
            PG8_LDB(B1, 0, 1); PG8_STAGEB(PG8_SB(0, 0), b2);
            PG8_BAR; PG8_WAIT_L(0); PG8_MMA(0, 1, At, B1); PG8_BAR;
            PG8_LDA(At, 0, 1); PG8_STAGEA(PG8_SA(0, 0), a2, x00, x01);
            PG8_BAR; PG8_WAIT_L(0); PG8_MMA(1, 0, At, B0); PG8_BAR; PG8_SCHED;
            PG8_STAGEB(PG8_SB(0, 1), b2 + hstepB);
            PG8_WAIT_V(6); PG8_BAR; PG8_MMA(1, 1, At, B1); PG8_BAR;
            PG8_LDB(B0, 1, 0); PG8_SCHED; PG8_LDA(At, 1, 0); PG8_STAGEA(PG8_SA(0, 1), a2, x10, x11);
            PG8_WAIT_L(8); PG8_BAR; PG8_WAIT_L(0); PG8_MMA(0, 0, At, B0); PG8_BAR; PG8_SCHED;
            PG8_LDB(B1, 1, 1); PG8_STAGEB(PG8_SB(1, 0), b3);
            PG8_BAR; PG8_WAIT_L(0); PG8_MMA(0, 1, At, B1); PG8_BAR;
            PG8_LDA(At, 1, 1); PG8_STAGEA(PG8_SA(1, 0), a3, x00, x01);
            PG8_BAR; PG8_WAIT_L(0); PG8_MMA(1, 0, At, B0); PG8_BAR; PG8_SCHED;
            PG8_STAGEB(PG8_SB(1, 1), b3 + hstepB);
            PG8_WAIT_V(6); PG8_BAR; PG8_MMA(1, 1, At, B1); PG8_BAR;
            }
        }
        if constexpr (ALIGN_EPI) { if (wr == 0) PG8_BAR; }
        E(acc, cur, wr, wc, fr, fq);
        if (!has_next) break;
        E.init(acc, nxt, wc, fq);
        cur = nxt; cA = nA; cB = nB; ++ui;
        if constexpr (ASrc::GATHER) { vC[0][0] = x00; vC[0][1] = x01; vC[1][0] = x10; vC[1][1] = x11; }
        if constexpr (ALIGN_EPI) { if (wr == 1) PG8_BAR; }
    }
    PG8_WAIT_V(0);
    if constexpr (!ALIGN_EPI) { if (wr == 0) PG8_BAR; }
    PG8_BAR;
#undef PG8_SA
#undef PG8_SB
#undef PG8_STAGEA
#undef PG8_STAGEB
#undef PG8_LDA
#undef PG8_LDB
#undef PG8_MMA
#undef PG8_WAIT_V
#undef PG8_WAIT_L
#undef PG8_BAR
#undef PG8_SCHED
}
}
namespace pg8 {
__device__ __forceinline__ float gelu_tanh(float x) {
    const float u = 0.7978845608028654f * (x + 0.044715f * x * x * x);
    const float e = __expf(-2.0f * fabsf(u)); float th = (1.0f - e) * __builtin_amdgcn_rcpf(1.0f + e); th = u < 0.f ? -th : th;
    return 0.5f * x * (1.0f + th);
}
struct EpiStore {
    static constexpr bool PERM = true;
    bf16_t* O; int ldc;
    __device__ __forceinline__ void init(f32x4 (&acc)[2][2][4][2], const Unit&, int, int) const {
#pragma unroll
        for (int a = 0; a < 2; ++a)
#pragma unroll
            for (int b = 0; b < 2; ++b)
#pragma unroll
                for (int m = 0; m < 4; ++m)
#pragma unroll
                    for (int n = 0; n < 2; ++n) acc[a][b][m][n] = (f32x4){0.f, 0.f, 0.f, 0.f};
    }
    __device__ __forceinline__ void operator()(const f32x4 (&acc)[2][2][4][2], const Unit& u, int wr, int wc, int fr, int fq) const {
        const int row0 = u.pm * BM + wr * 64 + fr, col0 = u.pn * BM + wc * 32 + 8 * fq;
#pragma unroll
        for (int ai = 0; ai < 2; ++ai)
#pragma unroll
            for (int m = 0; m < 4; ++m) { bf16_t* rowp = O + (size_t)(row0 + ai * HALF + m * 16) * ldc + col0;
#pragma unroll
                for (int bj = 0; bj < 2; ++bj) { const f32x4 v0 = acc[ai][bj][m][0], v1 = acc[ai][bj][m][1];
                    u32x4 w; w.x = cvt_pk_bf16(v0[0], v0[1]); w.y = cvt_pk_bf16(v0[2], v0[3]); w.z = cvt_pk_bf16(v1[0], v1[1]); w.w = cvt_pk_bf16(v1[2], v1[3]);
                    *(u32x4*)(rowp + bj * HALF) = w; } }
    }
};
struct EpiCmpGelu {
    static constexpr bool PERM = true;
    bf16_t* O; const float* bias;
    __device__ __forceinline__ void init(f32x4 (&acc)[2][2][4][2], const Unit&, int, int) const {
#pragma unroll
        for (int a = 0; a < 2; ++a)
#pragma unroll
            for (int b = 0; b < 2; ++b)
#pragma unroll
                for (int m = 0; m < 4; ++m)
#pragma unroll
                    for (int n = 0; n < 2; ++n) acc[a][b][m][n] = (f32x4){0.f, 0.f, 0.f, 0.f};
    }
    __device__ __forceinline__ void operator()(const f32x4 (&acc)[2][2][4][2], const Unit& u, int wr, int wc, int fr, int fq) const {
        const int row0 = u.pm * BM + wr * 64 + fr, col0 = wc * 32 + 8 * fq;
        bf16_t* Oj = O + (size_t)u.e * 16384 * 256; const float* bj_ = bias + u.e * 256;
        f32x4 bv[2][2];
#pragma unroll
        for (int bj = 0; bj < 2; ++bj)
#pragma unroll
            for (int n = 0; n < 2; ++n) bv[bj][n] = *(const f32x4*)(bj_ + col0 + bj * HALF + 4 * n);
#pragma unroll
        for (int ai = 0; ai < 2; ++ai)
#pragma unroll
            for (int m = 0; m < 4; ++m) { bf16_t* rowp = Oj + (size_t)(row0 + ai * HALF + m * 16) * 256 + col0;
#pragma unroll
                for (int bj = 0; bj < 2; ++bj) { f32x4 v0 = acc[ai][bj][m][0] + bv[bj][0], v1 = acc[ai][bj][m][1] + bv[bj][1];
#pragma unroll
                    for (int j = 0; j < 4; ++j) { v0[j] = gelu_tanh(v0[j]); v1[j] = gelu_tanh(v1[j]); }
                    u32x4 w; w.x = cvt_pk_bf16(v0[0], v0[1]); w.y = cvt_pk_bf16(v0[2], v0[3]); w.z = cvt_pk_bf16(v1[0], v1[1]); w.w = cvt_pk_bf16(v1[2], v1[3]);
                    *(u32x4*)(rowp + bj * HALF) = w; } }
    }
};
struct EpiSwiglu {
    static constexpr bool PERM = true;
    bf16_t* H; const float* bgu;
    __device__ __forceinline__ void init(f32x4 (&acc)[2][2][4][2], const Unit& u, int wc, int fq) const {
        const float* bg = bgu + (size_t)u.e * 2048 + u.pn * HALF + wc * 32 + 8 * fq;
#pragma unroll
        for (int n = 0; n < 2; ++n) { const f32x4 g = *(const f32x4*)(bg + 4 * n), up = *(const f32x4*)(bg + 1024 + 4 * n);
#pragma unroll
            for (int a = 0; a < 2; ++a)
#pragma unroll
                for (int m = 0; m < 4; ++m) { acc[a][0][m][n] = g; acc[a][1][m][n] = up; } }
    }
    __device__ __forceinline__ void operator()(const f32x4 (&acc)[2][2][4][2], const Unit& u, int wr, int wc, int fr, int fq) const {
        const int row0 = u.pm * BM + wr * 64 + fr, col0 = u.pn * HALF + wc * 32 + 8 * fq;
#pragma unroll
        for (int ai = 0; ai < 2; ++ai)
#pragma unroll
            for (int m = 0; m < 4; ++m) { bf16_t* rowp = H + (size_t)(row0 + ai * HALF + m * 16) * DFF + col0;
                unsigned wv[4];
#pragma unroll
                for (int n = 0; n < 2; ++n) { const f32x4 g = acc[ai][0][m][n], up = acc[ai][1][m][n];
#pragma unroll
                    for (int j = 0; j < 2; ++j) {
                        const f32x2 gg = {__builtin_amdgcn_fmed3f(g[2 * j], -3.0e38f, 7.0f), __builtin_amdgcn_fmed3f(g[2 * j + 1], -3.0e38f, 7.0f)};
                        const f32x2 uu = {__builtin_amdgcn_fmed3f(up[2 * j], -7.0f, 7.0f), __builtin_amdgcn_fmed3f(up[2 * j + 1], -7.0f, 7.0f)};
                        const f32x2 t = gg * -2.4554669595930156f;
                        f32x2 d = {__builtin_amdgcn_exp2f(t.x), __builtin_amdgcn_exp2f(t.y)}; d = d + 1.0f;
                        const f32x2 rr = {__builtin_amdgcn_rcpf(d.x), __builtin_amdgcn_rcpf(d.y)};
                        const f32x2 o = (uu + 1.0f) * gg * rr;
                        wv[2 * n + j] = cvt_pk_bf16(o.x, o.y); } }
                u32x4 w; w.x = wv[0]; w.y = wv[1]; w.z = wv[2]; w.w = wv[3];
                *(u32x4*)rowp = w; }
    }
};
struct EpiDown {
    static constexpr bool PERM = true;
    bf16_t* Y; const float* bd; const float* rgate;
    __device__ __forceinline__ void init(f32x4 (&acc)[2][2][4][2], const Unit& u, int wc, int fq) const {
        const float* b = bd + (size_t)u.e * 1024 + u.pn * BM + wc * 32 + 8 * fq;
#pragma unroll
        for (int bj = 0; bj < 2; ++bj)
#pragma unroll
            for (int n = 0; n < 2; ++n) { const f32x4 bv = *(const f32x4*)(b + bj * HALF + 4 * n);
#pragma unroll
                for (int a = 0; a < 2; ++a)
#pragma unroll
                    for (int m = 0; m < 4; ++m) acc[a][bj][m][n] = bv; }
    }
    __device__ __forceinline__ void operator()(const f32x4 (&acc)[2][2][4][2], const Unit& u, int wr, int wc, int fr, int fq) const {
        const int row0 = u.pm * BM + wr * 64 + fr, col0 = u.pn * BM + wc * 32 + 8 * fq;
#pragma unroll
        for (int ai = 0; ai < 2; ++ai)
#pragma unroll
            for (int m = 0; m < 4; ++m) { const int row = row0 + ai * HALF + m * 16; const float gt = rgate[row]; bf16_t* rowp = Y + (size_t)row * D + col0;
#pragma unroll
                for (int bj = 0; bj < 2; ++bj) { const f32x4 v0 = acc[ai][bj][m][0] * gt, v1 = acc[ai][bj][m][1] * gt;
                    u32x4 w; w.x = cvt_pk_bf16(v0[0], v0[1]); w.y = cvt_pk_bf16(v0[2], v0[3]); w.z = cvt_pk_bf16(v1[0], v1[1]); w.w = cvt_pk_bf16(v1[2], v1[3]);
                    *(u32x4*)(rowp + bj * HALF) = w; } }
    }
};
}
struct Frame {
    LAS unsigned char* lds;
    volatile LAS unsigned* LC;
    unsigned* ctl;
    unsigned char* ws;
    int tid, lane, wave, G, bx;
    float* out;
};
__device__ __forceinline__ size_t opaque_off(size_t o) { asm volatile("; ws offset" : "+s"(o)); return o; }
#define WSP(T_, off) ((T_*)(F.ws + opaque_off(off)))
__device__ __forceinline__ const float* inptr(const Frame& F, int i) {
    const unsigned lo = __builtin_amdgcn_readfirstlane(F.LC[128 + 2 * i]), hi = __builtin_amdgcn_readfirstlane(F.LC[129 + 2 * i]);
    const float* p = (const float*)(const GAS float*)(((unsigned long long)hi << 32) | (unsigned long long)lo);
    return p;
}
enum { I_X = 0, I_LN_G, I_LN_B, I_NSA_W_IN, I_NSA_CMP_POS, I_NSA_CMP_W1, I_NSA_CMP_B1, I_NSA_CMP_W2, I_NSA_CMP_B2, I_NSA_GATE_B, I_NSA_W_OUT,
       I_ML_W_IN, I_ML_CONV_W, I_ML_CONV_B, I_ML_GATE_B, I_ML_NORM_G, I_ML_W_OUT, I_HG_W_IN, I_HG_LOWER, I_HG_NORM_G, I_HG_W_OUT,
       I_ROUTER_W, I_ROUTER_B, I_MOE_W_GU, I_MOE_B_GU, I_MOE_W_DOWN, I_MOE_B_DOWN };

__device__ __forceinline__ void tr_load(f32x4 (&v)[16], const float* W, int N, int nvalid, int k0, int n0, int lane) {
    const int nn = n0 + 4 * (lane & 15); const bool ok = nn < nvalid; const int kr = lane >> 4;
#pragma unroll
    for (int i = 0; i < 16; ++i) v[i] = ok ? *(const f32x4*)(W + (size_t)(k0 + 4 * i + kr) * N + nn) : (f32x4){0.f, 0.f, 0.f, 0.f};
}
__device__ __forceinline__ void tr_store(const f32x4 (&v)[16], int K, bf16_t* WT, int drow, int k0, LAS float* scr, int lane) {
    const int kr = lane >> 4;
#pragma unroll
    for (int i = 0; i < 16; ++i) { LAS float* d = scr + (4 * i + kr) * 65 + 4 * (lane & 15); d[0] = v[i][0]; d[1] = v[i][1]; d[2] = v[i][2]; d[3] = v[i][3]; }
    LDS_WAIT();
    const int c = lane & 7;
#pragma unroll
    for (int j = 0; j < 8; ++j) { const int n = (lane >> 3) + 8 * j; const LAS float* s = scr + (8 * c) * 65 + n;
        u32x4 o; o.x = pk2(s[0 * 65], s[1 * 65]); o.y = pk2(s[2 * 65], s[3 * 65]); o.z = pk2(s[4 * 65], s[5 * 65]); o.w = pk2(s[6 * 65], s[7 * 65]);
        *(u32x4*)(WT + (size_t)(drow + n) * K + k0 + 8 * c) = o; }
    LDS_WAIT();
}
__device__ __forceinline__ void tr_class(Frame& F, const float* W, int nmat, int K, int N, int Npad, bf16_t* WT, bool gu, LAS float* scr, int gw, int NGW) {
    const int nblk = Npad / 64, per = (K / 64) * nblk; const long total = (long)nmat * per;
    f32x4 vbuf[16];
    long it = gw;
    if (it < total) { const int mat = (int)(it / per), r = (int)(it % per), kb = r / nblk, nb = r % nblk; tr_load(vbuf, W + (size_t)mat * K * N, N, N, kb * 64, nb * 64, F.lane); }
#pragma unroll 1
    for (; it < total; it += NGW) {
        const int mat = (int)(it / per), r = (int)(it % per), kb = r / nblk, nb = r % nblk, n0 = nb * 64;
        int drow = n0;
        if (gu) drow = (n0 < 1024) ? ((n0 >> 7) * 256 + (n0 & 127)) : ((((n0 - 1024) >> 7) * 256) + 128 + ((n0 - 1024) & 127));
        f32x4 cur[16];
#pragma unroll
        for (int i = 0; i < 16; ++i) cur[i] = vbuf[i];
        const long nx = it + NGW;
        if (nx < total) { const int mat2 = (int)(nx / per), r2 = (int)(nx % per), kb2 = r2 / nblk, nb2 = r2 % nblk; tr_load(vbuf, W + (size_t)mat2 * K * N, N, N, kb2 * 64, nb2 * 64, F.lane); }
        tr_store(cur, K, WT + (size_t)mat * Npad * K, drow, kb * 64, scr, F.lane);
    }
}
__device__ __forceinline__ void p0_prologue(Frame& F) {
    LAS float* scr = (LAS float*)(F.lds + F.wave * 16896);
    const int gw = F.bx * 8 + F.wave, NGW = F.G * 8;
    tr_class(F, inptr(F, I_MOE_W_GU), DEPTH * NEXP, D, 2 * DFF, 2 * DFF, WSP(bf16_t, OFF_W_GU), true, scr, gw, NGW);
    tr_class(F, inptr(F, I_MOE_W_DOWN), DEPTH * NEXP, DFF, D, D, WSP(bf16_t, OFF_W_DN), false, scr, gw, NGW);
    tr_class(F, inptr(F, I_NSA_W_IN), 2, D, NSA_IN, NSA_LD, WSP(bf16_t, OFF_W_NSAIN), false, scr, gw, NGW);
    tr_class(F, inptr(F, I_NSA_W_OUT), 2, D, D, D, WSP(bf16_t, OFF_W_NSAOUT), false, scr, gw, NGW);
    tr_class(F, inptr(F, I_ML_W_IN), 1, D, ML_IN, ML_LD, WSP(bf16_t, OFF_W_MLIN), false, scr, gw, NGW);
    tr_class(F, inptr(F, I_ML_W_OUT), 1, D, D, D, WSP(bf16_t, OFF_W_MLOUT), false, scr, gw, NGW);
    tr_class(F, inptr(F, I_HG_W_IN), 1, D, HG_LD, HG_LD, WSP(bf16_t, OFF_W_HGIN), false, scr, gw, NGW);
    tr_class(F, inptr(F, I_HG_W_OUT), 1, D, D, D, WSP(bf16_t, OFF_W_HGOUT), false, scr, gw, NGW);
    tr_class(F, inptr(F, I_NSA_CMP_W1), 4, 2048, 256, 256, WSP(bf16_t, OFF_W_CMP1), false, scr, gw, NGW);
    tr_class(F, inptr(F, I_NSA_CMP_W2), 4, 256, 64, 64, WSP(bf16_t, OFF_W_CMP2), false, scr, gw, NGW);
    const int gt = F.bx * 512 + F.tid;
    float* tab = WSP(float, OFF_TAB);
    if (gt < 1024) {
        const int lj = gt >> 8, n = gt & 255; const float* pos = inptr(F, I_NSA_CMP_POS) + (size_t)lj * 2048; const float* w1 = inptr(F, I_NSA_CMP_W1) + (size_t)lj * 2048 * 256;
        float a = inptr(F, I_NSA_CMP_B1)[lj * 256 + n];
        for (int k = 0; k < 2048; ++k) a += pos[k] * w1[(size_t)k * 256 + n];
        tab[TAB_CMPB + gt] = a;
    } else if (gt < 2048) {
        const int c = gt - 1024; float v[DEPTH], mx = -1e30f;
#pragma unroll
        for (int i = 0; i < DEPTH; ++i) { v[i] = inptr(F, I_HG_LOWER)[i * D + c]; mx = fmaxf(mx, v[i]); }
        float s = 0.f;
#pragma unroll
        for (int i = 0; i < DEPTH; ++i) { v[i] = __expf(v[i] - mx); s += v[i]; }
        tab[TAB_LB + c] = (v[1] + v[2]) / s;
    }
    { const float* rw = inptr(F, I_ROUTER_W); float* rwt = WSP(float, OFF_TAB) + TAB_RWT;
      for (int i = F.bx * 512 + F.tid; i < DEPTH * D * NEXP; i += F.G * 512) { const int l = i >> 15, r = i & 32767, k = r >> 5, e = r & 31; rwt[(l * NEXP + e) * D + k] = rw[i]; } }
    {
        const f32x4* xs = (const f32x4*)inptr(F, I_X); u32x2* xn = WSP(u32x2, OFF_XN);
        const size_t n4 = (size_t)NTOK * D / 4, stride = (size_t)F.G * 512;
        for (size_t i = (size_t)F.bx * 512 + F.tid; i < n4; i += stride) { const f32x4 v = xs[i]; u32x2 o; o.x = pk2(v[0], v[1]); o.y = pk2(v[2], v[3]); xn[i] = o; }
    }
}

__device__ __forceinline__ void split8(const f32x4& x0, const f32x4& x1, bf16x8& hi, bf16x8& lo) {
    u32x4 h, l;
    h.x = pk2(x0[0], x0[1]); h.y = pk2(x0[2], x0[3]); h.z = pk2(x1[0], x1[1]); h.w = pk2(x1[2], x1[3]);
    l.x = pk2(x0[0] - __uint_as_float(h.x << 16), x0[1] - __uint_as_float(h.x & 0xffff0000u)); l.y = pk2(x0[2] - __uint_as_float(h.y << 16), x0[3] - __uint_as_float(h.y & 0xffff0000u));
    l.z = pk2(x1[0] - __uint_as_float(h.z << 16), x1[1] - __uint_as_float(h.z & 0xffff0000u)); l.w = pk2(x1[2] - __uint_as_float(h.w << 16), x1[3] - __uint_as_float(h.w & 0xffff0000u));
    hi = __builtin_bit_cast(bf16x8, h); lo = __builtin_bit_cast(bf16x8, l);
}
__device__ __forceinline__ void phase_ln_router(Frame& F, int layer, bool dummy = false) {
    constexpr int SP = 1028;
    LAS float* LgL = (LAS float*)F.lds;
    LAS float* slab = LgL + 256 * 33;
    LAS float* part = slab + 16 * SP;
    if (F.tid < 32) F.LC[64 + F.tid] = 0u;
    __syncthreads();
    const float* g = inptr(F, I_LN_G) + (size_t)(layer * 2 + 0) * D; const float* bb = inptr(F, I_LN_B) + (size_t)(layer * 2 + 0) * D;
    const float* rb = inptr(F, I_ROUTER_B) + layer * NEXP;
    const float* rwt = WSP(float, OFF_TAB) + TAB_RWT + (size_t)layer * NEXP * D;
    const bf16_t* HM = WSP(bf16_t, OFF_HM); bf16_t* XN = dummy ? WSP(bf16_t, OFF_H + 256 * MiB) : WSP(bf16_t, OFF_XN);
    const bf16_t* XR = WSP(bf16_t, OFF_XN);
    int* toke = dummy ? WSP(int, OFF_H + 400 * MiB) : WSP(int, OFF_TOKE); float* tokg = dummy ? WSP(float, OFF_H + 402 * MiB) : WSP(float, OFF_TOKG);
    int lane = F.lane; asm volatile("; phase-local lane" : "+v"(lane));
    const int fr = lane & 15, fg = lane >> 4, wave = F.wave;
    const float rbv = rb[F.tid & 31];
    f32x4 gr[4], br[4];
    bf16x8 bh0[4], bl0[4], bh1[4], bl1[4];
    {
#pragma unroll
      for (int ks = 0; ks < 4; ++ks) { const float* q0 = rwt + (size_t)fr * D + 128 * wave + 32 * ks + 8 * fg; const float* q1 = q0 + (size_t)16 * D;
          const f32x4 w0 = *(const f32x4*)q0, w1 = *(const f32x4*)(q0 + 4), w2 = *(const f32x4*)q1, w3 = *(const f32x4*)(q1 + 4);
          split8(w0, w1, bh0[ks], bl0[ks]); split8(w2, w3, bh1[ks], bl1[ks]); }
#pragma unroll
      for (int j = 0; j < 4; ++j) { gr[j] = *((const f32x4*)g + lane + 64 * j); br[j] = *((const f32x4*)bb + lane + 64 * j); } }
    for (int blk = F.bx; blk < NTOK / 256; blk += F.G) {
        u32x2 xn_[2][4], hn_[2][4];
        { const int m0 = blk * 256 + 2 * wave;
#pragma unroll
          for (int q = 0; q < 2; ++q) { const u32x2* xr = (const u32x2*)(XR + (size_t)(m0 + q) * D) + lane; const u32x2* hr = (const u32x2*)(HM + (size_t)(m0 + q) * D) + lane;
#pragma unroll
            for (int j = 0; j < 4; ++j) { xn_[q][j] = xr[64 * j]; hn_[q][j] = hr[64 * j]; } } }
#pragma unroll 1
        for (int sub = 0; sub < 16; ++sub) {
            const int mb = blk * 256 + sub * 16 + 2 * wave;
            f32x4 v[2][4]; float s[2] = {0.f, 0.f};
#pragma unroll
            for (int q = 0; q < 2; ++q)
#pragma unroll
                for (int j = 0; j < 4; ++j) { const u32x2 xv = xn_[q][j]; const u32x2 hv = hn_[q][j];
                    v[q][j][0] = DN_ALPHA * __uint_as_float(xv.x << 16) + __uint_as_float(hv.x << 16); v[q][j][1] = DN_ALPHA * __uint_as_float(xv.x & 0xffff0000u) + __uint_as_float(hv.x & 0xffff0000u);
                    v[q][j][2] = DN_ALPHA * __uint_as_float(xv.y << 16) + __uint_as_float(hv.y << 16); v[q][j][3] = DN_ALPHA * __uint_as_float(xv.y & 0xffff0000u) + __uint_as_float(hv.y & 0xffff0000u);
                    s[q] += (v[q][j][0] + v[q][j][1]) + (v[q][j][2] + v[q][j][3]); }
            if (sub + 1 < 16) {
#pragma unroll
                for (int q = 0; q < 2; ++q) { const u32x2* xr = (const u32x2*)(XR + (size_t)(mb + 16 + q) * D) + lane; const u32x2* hr = (const u32x2*)(HM + (size_t)(mb + 16 + q) * D) + lane;
#pragma unroll
                    for (int j = 0; j < 4; ++j) { xn_[q][j] = xr[64 * j]; hn_[q][j] = hr[64 * j]; } } }
#pragma unroll
            for (int q = 0; q < 2; ++q) {
                const float mean = wave_sum(s[q]) * (1.f / D); float s2 = 0.f;
#pragma unroll
                for (int j = 0; j < 4; ++j) { v[q][j] = v[q][j] - mean; s2 += (v[q][j][0] * v[q][j][0] + v[q][j][1] * v[q][j][1]) + (v[q][j][2] * v[q][j][2] + v[q][j][3] * v[q][j][3]); }
                const float rstd = __builtin_amdgcn_rsqf(wave_sum(s2) * (1.f / D) + LN_EPS);
                u32x2* no = (u32x2*)(XN + (size_t)(mb + q) * D) + lane; LAS f32x4* so = (LAS f32x4*)(slab + (2 * wave + q) * SP) + lane;
#pragma unroll
                for (int j = 0; j < 4; ++j) { const f32x4 gv = gr[j], bv = br[j];
                    const f32x4 y = v[q][j] * rstd * gv + bv; so[64 * j] = y; u32x2 o; o.x = pk2(y[0], y[1]); o.y = pk2(y[2], y[3]); no[64 * j] = o; }
            }
            __syncthreads();
            {
                const LAS float* Ap = slab + fr * SP + 128 * wave + 8 * fg;
                f32x4 acc0 = (f32x4){0.f, 0.f, 0.f, 0.f}, acc1 = acc0;
#pragma unroll
                for (int ks = 0; ks < 4; ++ks) { bf16x8 ah, al; const f32x4 xa = *(const LAS f32x4*)(Ap + 32 * ks), xb = *(const LAS f32x4*)(Ap + 32 * ks + 4); split8(xa, xb, ah, al);
                    acc0 = __builtin_amdgcn_mfma_f32_16x16x32_bf16(ah, bh0[ks], acc0, 0, 0, 0); acc1 = __builtin_amdgcn_mfma_f32_16x16x32_bf16(ah, bh1[ks], acc1, 0, 0, 0);
                    acc0 = __builtin_amdgcn_mfma_f32_16x16x32_bf16(al, bh0[ks], acc0, 0, 0, 0); acc1 = __builtin_amdgcn_mfma_f32_16x16x32_bf16(al, bh1[ks], acc1, 0, 0, 0);
                    acc0 = __builtin_amdgcn_mfma_f32_16x16x32_bf16(ah, bl0[ks], acc0, 0, 0, 0); acc1 = __builtin_amdgcn_mfma_f32_16x16x32_bf16(ah, bl1[ks], acc1, 0, 0, 0); }
#pragma unroll
                for (int e = 0; e < 4; ++e) { LAS float* pr = part + (wave * 16 + 4 * fg + e) * 33; pr[fr] = acc0[e]; pr[16 + fr] = acc1[e]; }
            }
            __syncthreads();
            { const int row = F.tid >> 5, e = F.tid & 31; float lg = rbv;
#pragma unroll
              for (int w8 = 0; w8 < 8; ++w8) lg += part[(w8 * 16 + row) * 33 + e];
              LgL[(sub * 16 + row) * 33 + e] = lg; }
        }
        __syncthreads();
        if (F.tid < 256) {
            const int m = blk * 256 + F.tid; const LAS float* lr = LgL + F.tid * 33;
            unsigned taken = 0u; int se[TOPK]; float sv[TOPK];
#pragma unroll
            for (int k = 0; k < TOPK; ++k) { float best = -INFINITY; int bi = 0;
#pragma unroll 8
                for (int e = 0; e < NEXP; ++e) { const float c = ((taken >> e) & 1u) ? -INFINITY : lr[e]; if (c > best) { best = c; bi = e; } }
                se[k] = bi; sv[k] = best; taken |= 1u << bi; }
            float gs = 0.f, ge[TOPK];
#pragma unroll
            for (int k = 0; k < TOPK; ++k) { ge[k] = __expf(sv[k] - sv[0]); gs += ge[k]; }
            const float inv = __builtin_amdgcn_rcpf(gs);
#pragma unroll
            for (int k = 0; k < TOPK; ++k) { toke[m * 4 + k] = se[k]; tokg[m * 4 + k] = ge[k] * inv; __hip_atomic_fetch_add((LAS unsigned*)&F.LC[64 + se[k]], 1u, __ATOMIC_RELAXED, __HIP_MEMORY_SCOPE_WORKGROUP); }
        }
        __syncthreads();
    }
    if (F.tid < 32) { const unsigned c = F.LC[64 + F.tid]; if (c) __hip_atomic_fetch_add(F.ctl + (dummy ? 12288 : CW_CNT) + layer * 64 + F.tid, c, RLX_AGENT); }
    __syncthreads();
}

__device__ __forceinline__ void moe_tile_table(Frame& F, int layer) {
    if (F.tid < 64) {
        const int e = F.tid & 31;
        const unsigned c = __hip_atomic_load(F.ctl + CW_CNT + layer * 64 + e, RLX_AGENT);
        int acc = (int)((c + 255u) >> 8);
#pragma unroll
        for (int o = 1; o < 32; o <<= 1) { const int u = __shfl_up(acc, o); if (e >= o) acc += u; }
        if (F.tid < 32) { F.LC[8 + e] = (unsigned)acc; if (e == 31) F.LC[40] = (unsigned)acc; }
    }
    __syncthreads();
}
__device__ __forceinline__ void phase_moe_slots(Frame& F, int layer) {
    moe_tile_table(F, layer);
    const int* toke = WSP(int, OFF_TOKE); const float* tokg = WSP(float, OFF_TOKG);
    int* tokp = WSP(int, OFF_TOKP); int* rowt = WSP(int, OFF_ROWT); float* rowg = WSP(float, OFF_ROWG);
    for (int blk = F.bx; blk < NTOK / 256; blk += F.G) {
        if (F.tid < 32) F.LC[64 + F.tid] = 0u;
        __syncthreads();
        int e[2], rank[2];
#pragma unroll
        for (int q = 0; q < 2; ++q) { const int a = blk * 1024 + q * 512 + F.tid; e[q] = toke[a]; rank[q] = (int)__hip_atomic_fetch_add((LAS unsigned*)&F.LC[64 + e[q]], 1u, __ATOMIC_RELAXED, __HIP_MEMORY_SCOPE_WORKGROUP); }
        __syncthreads();
        if (F.tid < 32) { const unsigned c = F.LC[64 + F.tid]; const unsigned pstart = (F.tid ? F.LC[8 + F.tid - 1] : 0u) * 256u;
            F.LC[96 + F.tid] = pstart + (c ? __hip_atomic_fetch_add(F.ctl + CW_CUR + layer * 64 + F.tid, c, RLX_AGENT) : 0u); }
        __syncthreads();
#pragma unroll
        for (int q = 0; q < 2; ++q) { const int a = blk * 1024 + q * 512 + F.tid; const int pos = (int)F.LC[96 + e[q]] + rank[q];
            rowt[pos] = a >> 2; rowg[pos] = tokg[a]; tokp[a] = pos; }
        __syncthreads();
    }
    for (int e2 = F.bx; e2 < NEXP; e2 += F.G) {
        const unsigned c = __hip_atomic_load(F.ctl + CW_CNT + layer * 64 + e2, RLX_AGENT); const unsigned pstart = (e2 ? F.LC[8 + e2 - 1] : 0u) * 256u, pend = F.LC[8 + e2] * 256u;
        for (unsigned r = pstart + c + F.tid; r < pend; r += 512) { rowt[r] = 0; rowg[r] = 0.f; }
    }
}
__device__ __forceinline__ void phase_combine_ln(Frame& F, int layer, float* xo_base  , bool dummy = false) {
    const float* g = inptr(F, I_LN_G) + (size_t)(layer * 2 + 1) * D; const float* bb = inptr(F, I_LN_B) + (size_t)(layer * 2 + 1) * D;
    const bf16_t* XR = WSP(bf16_t, OFF_XN); bf16_t* XN = dummy ? WSP(bf16_t, OFF_H + 256 * MiB) : WSP(bf16_t, OFF_XN); const bf16_t* Y = WSP(bf16_t, OFF_Y); const int* tokp = WSP(int, OFF_TOKP);
    int lane = F.lane; asm volatile("; phase-local lane" : "+v"(lane)); const int gw = F.bx * 8 + F.wave, NGW = F.G * 8;
    u32x2 xq[4]; u32x2 yq[TOPK][4]; int posn[TOPK];
    f32x4 gr[4], br[4];
#pragma unroll
    for (int j = 0; j < 4; ++j) { gr[j] = *((const f32x4*)g + lane + 64 * j); br[j] = *((const f32x4*)bb + lane + 64 * j); }
    {
        int p0[TOPK];
#pragma unroll
        for (int k = 0; k < TOPK; ++k) p0[k] = (gw < NTOK) ? tokp[gw * 4 + k] : 0;
        if (gw < NTOK) { const u32x2* xr = (const u32x2*)(XR + (size_t)gw * D) + lane;
#pragma unroll
            for (int j = 0; j < 4; ++j) xq[j] = xr[64 * j];
#pragma unroll
            for (int k = 0; k < TOPK; ++k) { const u32x2* yr = (const u32x2*)(Y + (size_t)p0[k] * D) + lane;
#pragma unroll
                for (int j = 0; j < 4; ++j) yq[k][j] = __builtin_nontemporal_load(yr + 64 * j); } }
#pragma unroll
        for (int k = 0; k < TOPK; ++k) posn[k] = (gw + NGW < NTOK) ? tokp[(gw + NGW) * 4 + k] : 0;
    }
#pragma unroll 1
    for (int m = gw; m < NTOK; m += NGW) {
        f32x4 v[4]; float s = 0.f;
#pragma unroll
        for (int j = 0; j < 4; ++j) { const u32x2 xv = xq[j]; v[j][0] = DN_ALPHA * __uint_as_float(xv.x << 16); v[j][1] = DN_ALPHA * __uint_as_float(xv.x & 0xffff0000u); v[j][2] = DN_ALPHA * __uint_as_float(xv.y << 16); v[j][3] = DN_ALPHA * __uint_as_float(xv.y & 0xffff0000u); }
#pragma unroll
        for (int k = 0; k < TOPK; ++k) {
#pragma unroll
            for (int j = 0; j < 4; ++j) { const u32x2 hv = yq[k][j];
                v[j][0] += __uint_as_float(hv.x << 16); v[j][1] += __uint_as_float(hv.x & 0xffff0000u); v[j][2] += __uint_as_float(hv.y << 16); v[j][3] += __uint_as_float(hv.y & 0xffff0000u); } }
        if (m + NGW < NTOK) {
            const u32x2* xr = (const u32x2*)(XR + (size_t)(m + NGW) * D) + lane;
#pragma unroll
            for (int j = 0; j < 4; ++j) xq[j] = xr[64 * j];
#pragma unroll
            for (int k = 0; k < TOPK; ++k) { const u32x2* yr = (const u32x2*)(Y + (size_t)posn[k] * D) + lane;
#pragma unroll
                for (int j = 0; j < 4; ++j) yq[k][j] = __builtin_nontemporal_load(yr + 64 * j); }
#pragma unroll
            for (int k = 0; k < TOPK; ++k) posn[k] = (m + 2 * NGW < NTOK) ? tokp[(m + 2 * NGW) * 4 + k] : 0;
        }
#pragma unroll
        for (int j = 0; j < 4; ++j) s += (v[j][0] + v[j][1]) + (v[j][2] + v[j][3]);
        const float mean = wave_sum(s) * (1.f / D); float s2 = 0.f;
#pragma unroll
        for (int j = 0; j < 4; ++j) { v[j] = v[j] - mean; s2 += (v[j][0] * v[j][0] + v[j][1] * v[j][1]) + (v[j][2] * v[j][2] + v[j][3] * v[j][3]); }
        const float rstd = __builtin_amdgcn_rsqf(wave_sum(s2) * (1.f / D) + LN_EPS);
        u32x2* no = (u32x2*)(XN + (size_t)m * D) + lane;
#pragma unroll
        for (int j = 0; j < 4; ++j) { const f32x4 gv = gr[j], bv = br[j];
            v[j] = v[j] * rstd * gv + bv;
            if (xo_base) *((f32x4*)(xo_base + (size_t)m * D) + lane + 64 * j) = v[j];
            else { u32x2 o; o.x = pk2(v[j][0], v[j][1]); o.y = pk2(v[j][2], v[j][3]); no[64 * j] = o; } }
    }
}
__device__ __forceinline__ void phase_nsa_cmp2(Frame& F, int slot) {
    const bf16_t* HC = WSP(bf16_t, OFF_HC); bf16_t* KC = WSP(bf16_t, OFF_KC);
    const bf16_t* W2t = WSP(bf16_t, OFF_W_CMP2) + (size_t)slot * 2 * 64 * 256;
    const float* b2 = inptr(F, I_NSA_CMP_B2) + (size_t)slot * 2 * 64;
    int lane = F.lane; asm volatile("; phase-local lane" : "+v"(lane));
    const int fr = lane & 15, fg = lane >> 4, gw = F.bx * 8 + F.wave, NGW = F.G * 8;
    for (int blk = gw; blk < 2 * 1024; blk += NGW) {
        const int j = blk >> 10, r0 = (blk & 1023) * 16;
        const bf16_t* A = HC + ((size_t)j * 16384 + r0 + fr) * 256 + 8 * fg;
        const bf16_t* B = W2t + ((size_t)j * 64 + fr) * 256 + 8 * fg;
        f32x4 acc[4];
#pragma unroll
        for (int t = 0; t < 4; ++t) acc[t] = (f32x4){0.f, 0.f, 0.f, 0.f};
#pragma unroll
        for (int ks = 0; ks < 8; ++ks) { const bf16x8 a = *(const bf16x8*)(A + 32 * ks);
#pragma unroll
            for (int t = 0; t < 4; ++t) acc[t] = __builtin_amdgcn_mfma_f32_16x16x32_bf16(*(const bf16x8*)(B + (size_t)t * 16 * 256 + 32 * ks), a, acc[t], 0, 0, 0); }
        const int row = r0 + fr;
#pragma unroll
        for (int t = 0; t < 4; ++t) { const int d0 = 16 * t + 4 * fg; const f32x4 bv = *(const f32x4*)(b2 + j * 64 + d0);
            f32x4 v = acc[t] + bv; if ((row & 127) == 127) v = (f32x4){0.f, 0.f, 0.f, 0.f};
            u32x2 w; w.x = pg8::cvt_pk_bf16(v[0], v[1]); w.y = pg8::cvt_pk_bf16(v[2], v[3]);
            *(u32x2*)(KC + ((size_t)j * 16384 + row) * 64 + d0) = w; }
    }
}
typedef float f32x16 __attribute__((ext_vector_type(16)));
#define PP_SYNC() do { __builtin_amdgcn_sched_barrier(0); __syncthreads(); __builtin_amdgcn_sched_barrier(0); } while (0)
#ifndef SP_SCALAR
#define SP_SCALAR 0
#endif
#ifndef SP_FILL
#define SP_FILL 12
#endif
#ifndef XCMP
#define XCMP 0
#endif
#ifndef XSELN
#define XSELN 0
#endif
#ifndef XOUT
#define XOUT 0
#endif
namespace na {
constexpr int KP = 144;
constexpr int VP = 144;
__device__ __forceinline__ int vcol(int key) { return (key & ~15) | (key & 3) | ((key & 8) >> 1) | ((key & 4) << 1); }
constexpr int TILEB = 64 * KP;
constexpr int L_K = 0, L_V = 2 * TILEB, L_PQ = 4 * TILEB, SLB = 64 * 33, L_SEL = L_PQ + 4 * SLB * 4, L_OA = L_SEL + 4864;
constexpr float NEG = -1e30f;
constexpr float C1 = 0.125f * 1.4426950408889634f;
__device__ __forceinline__ int crow(int r, int hi) { return (r & 3) + 8 * (r >> 2) + 4 * hi; }
__device__ __forceinline__ bf16x8 pack8(const f32x16& p, int s1) {
    u32x4 w; w.x = pg8::cvt_pk_bf16(p[8 * s1 + 0], p[8 * s1 + 1]); w.y = pg8::cvt_pk_bf16(p[8 * s1 + 2], p[8 * s1 + 3]);
    w.z = pg8::cvt_pk_bf16(p[8 * s1 + 4], p[8 * s1 + 5]); w.w = pg8::cvt_pk_bf16(p[8 * s1 + 6], p[8 * s1 + 7]);
    return __builtin_bit_cast(bf16x8, w);
}
__device__ __forceinline__ void qk(f32x16& p0, f32x16& p1, const LAS unsigned char* Kt, const bf16x8 (&qf)[4], int r, int h) {
    const f32x16 z = {0.f, 0.f, 0.f, 0.f, 0.f, 0.f, 0.f, 0.f, 0.f, 0.f, 0.f, 0.f, 0.f, 0.f, 0.f, 0.f};
    bf16x8 a0[4], a1[4];
#pragma unroll
    for (int s = 0; s < 4; ++s) { a0[s] = *(const LAS bf16x8*)(Kt + r * KP + (16 * s + 8 * h) * 2); a1[s] = *(const LAS bf16x8*)(Kt + (32 + r) * KP + (16 * s + 8 * h) * 2); }
    __builtin_amdgcn_sched_barrier(0);
#pragma unroll
    for (int s = 0; s < 4; ++s) {
        p0 = __builtin_amdgcn_mfma_f32_32x32x16_bf16(a0[s], qf[s], s == 0 ? z : p0, 0, 0, 0);
        p1 = __builtin_amdgcn_mfma_f32_32x32x16_bf16(a1[s], qf[s], s == 0 ? z : p1, 0, 0, 0);
    }
}
__device__ __forceinline__ void pv(f32x16& o0, f32x16& o1, const LAS unsigned char* Vt, const f32x16& p0, const f32x16& p1, int r, int h) {
#pragma unroll
    for (int s = 0; s < 4; ++s) {
        const int s1 = s & 1;
        const bf16x8 bfrag = (s < 2) ? pack8(p0, s1) : pack8(p1, s1);
        const int key0 = 32 * (s >> 1) + 16 * s1 + 4 * h;
#pragma unroll
        for (int dh = 0; dh < 2; ++dh) {
            const bf16x8 a = *(const LAS bf16x8*)(Vt + (32 * dh + r) * VP + (key0 - 4 * h + 8 * h) * 2);
            if (dh == 0) o0 = __builtin_amdgcn_mfma_f32_32x32x16_bf16(a, bfrag, o0, 0, 0, 0);
            else o1 = __builtin_amdgcn_mfma_f32_32x32x16_bf16(a, bfrag, o1, 0, 0, 0);
        }
    }
}
__device__ __forceinline__ void pack_p(bf16x8 (&pb)[4], const f32x16& p0, const f32x16& p1) { pb[0] = pack8(p0, 0); pb[1] = pack8(p0, 1); pb[2] = pack8(p1, 0); pb[3] = pack8(p1, 1); }
__device__ __forceinline__ void pv2(f32x16& o0, f32x16& o1, const LAS unsigned char* Vt, const bf16x8 (&pb)[4], int r, int h) {
    bf16x8 a[4][2];
#pragma unroll
    for (int s = 0; s < 4; ++s) {
        const int key0 = 32 * (s >> 1) + 16 * (s & 1) + 4 * h;
#pragma unroll
        for (int dh = 0; dh < 2; ++dh) {
            a[s][dh] = *(const LAS bf16x8*)(Vt + (32 * dh + r) * VP + (key0 - 4 * h + 8 * h) * 2);
        }
    }
    __builtin_amdgcn_sched_barrier(0);
#pragma unroll
    for (int s = 0; s < 4; ++s) {
        o0 = __builtin_amdgcn_mfma_f32_32x32x16_bf16(a[s][0], pb[s], o0, 0, 0, 0);
        o1 = __builtin_amdgcn_mfma_f32_32x32x16_bf16(a[s][1], pb[s], o1, 0, 0, 0);
    }
}
__device__ __forceinline__ void softmax_step(f32x16& p0, f32x16& p1, float& m, float& l, f32x16& o0, f32x16& o1, bool lane_on = true) {
    constexpr float THR = 8.0f / C1;
    float mx = fmaxf(fmaxf(fmaxf(p0[0], p1[5]), fmaxf(p0[10], p1[15])), fmaxf(fmaxf(p1[0], p0[5]), fmaxf(p1[10], p0[15])));
    mx = lane_on ? mx : NEG;
    mx = fmaxf(mx, __shfl_xor(mx, 32));
    const float mn = (mx > m + THR) ? mx : m;
    const float muse = (mn < -1e29f) ? 0.f : mn;
    const bool grow = mn != m;
    const float mc = lane_on ? muse * C1 : 3.0e38f;
    f32x2 lsa = {0.f, 0.f}, lsb = {0.f, 0.f}; const f32x2 c1v = {C1, C1}, nmc = {-mc, -mc};
#pragma unroll
    for (int i = 0; i < 8; ++i) {
        f32x2 a = {p0[2 * i], p0[2 * i + 1]}, b = {p1[2 * i], p1[2 * i + 1]};
        a = __builtin_elementwise_fma(a, c1v, nmc); b = __builtin_elementwise_fma(b, c1v, nmc);
        a.x = __builtin_amdgcn_exp2f(a.x); a.y = __builtin_amdgcn_exp2f(a.y); b.x = __builtin_amdgcn_exp2f(b.x); b.y = __builtin_amdgcn_exp2f(b.y);
        p0[2 * i] = a.x; p0[2 * i + 1] = a.y; p1[2 * i] = b.x; p1[2 * i + 1] = b.y; lsa += a; lsb += b; }
    const float ls = (lsa.x + lsa.y) + (lsb.x + lsb.y);
    if (__builtin_amdgcn_ballot_w64(grow) != 0ull) {
        const float alpha = __builtin_amdgcn_exp2f((((m < -1e29f) ? 0.f : m) - muse) * C1);
        l = l * alpha;
#pragma unroll
        for (int i = 0; i < 16; ++i) { o0[i] *= alpha; o1[i] *= alpha; }
        m = mn;
    }
    l += ls;
}
__device__ __forceinline__ void softmax_heavy(f32x16& p0, f32x16& p1, const float m, float& l, float& mxraw, bool lane_on) {
    const float mx = fmaxf(fmaxf(fmaxf(p0[0], p1[5]), fmaxf(p0[10], p1[15])), fmaxf(fmaxf(p1[0], p0[5]), fmaxf(p1[10], p0[15])));
    mxraw = lane_on ? mx : NEG;
    const float muse = (m < -1e29f) ? 0.f : m;
    const float mc = lane_on ? muse * C1 : 3.0e38f;
#if SP_SCALAR
    float ls0 = 0.f, ls1 = 0.f;
#pragma unroll
    for (int i = 0; i < 16; ++i) { p0[i] = __builtin_amdgcn_exp2f(p0[i] * C1 - mc); p1[i] = __builtin_amdgcn_exp2f(p1[i] * C1 - mc); ls0 += p0[i]; ls1 += p1[i]; }
    l += ls0 + ls1;
#else
    f32x2 lsa = {0.f, 0.f}, lsb = {0.f, 0.f}; const f32x2 c1v = {C1, C1}, nmc = {-mc, -mc};
#pragma unroll
    for (int i = 0; i < 8; ++i) {
        f32x2 a = {p0[2 * i], p0[2 * i + 1]}, b = {p1[2 * i], p1[2 * i + 1]};
        a = __builtin_elementwise_fma(a, c1v, nmc); b = __builtin_elementwise_fma(b, c1v, nmc);
        a.x = __builtin_amdgcn_exp2f(a.x); a.y = __builtin_amdgcn_exp2f(a.y); b.x = __builtin_amdgcn_exp2f(b.x); b.y = __builtin_amdgcn_exp2f(b.y);
        p0[2 * i] = a.x; p0[2 * i + 1] = a.y; p1[2 * i] = b.x; p1[2 * i + 1] = b.y; lsa += a; lsb += b; }
    l += (lsa.x + lsa.y) + (lsb.x + lsb.y);
#endif
}
__device__ __forceinline__ void softmax_light(float mxraw, float& m, float& l, f32x16& o0, f32x16& o1) {
    constexpr float THR = 8.0f / C1;
    const float mx = fmaxf(mxraw, __shfl_xor(mxraw, 32));
    const float mn = (mx > m + THR) ? mx : m;
    if (__builtin_amdgcn_ballot_w64(mn != m) != 0ull) {
        const float alpha = __builtin_amdgcn_exp2f((((m < -1e29f) ? 0.f : m) - ((mn < -1e29f) ? 0.f : mn)) * C1);
        l = l * alpha;
#pragma unroll
        for (int i = 0; i < 16; ++i) { o0[i] *= alpha; o1[i] *= alpha; }
        m = mn;
    }
}
struct Stage { u32x4 k, v; };
__device__ __forceinline__ void stage_load(Stage& st, const bf16_t* ksrc, const bf16_t* vsrc, long stride, int tid) {
    const int key = tid >> 3, dc = tid & 7, vkey = tid & 63, vdc = tid >> 6;
    st.k = *(const u32x4*)(ksrc + (long)key * stride + dc * 8); st.v = *(const u32x4*)(vsrc + (long)vkey * stride + vdc * 8);
}
__device__ __forceinline__ void stage_store(const Stage& st, LAS unsigned char* Kt, LAS unsigned char* Vt, int tid) {
    const int key = tid >> 3, dc = tid & 7, vkey = tid & 63, vdc = tid >> 6;
    *(LAS u32x4*)(Kt + key * KP + dc * 16) = st.k;
    const unsigned w[4] = {st.v.x, st.v.y, st.v.z, st.v.w};
#pragma unroll
    for (int e = 0; e < 4; ++e) { *(LAS unsigned short*)(Vt + (vdc * 8 + 2 * e) * VP + vcol(vkey) * 2) = (unsigned short)(w[e] & 0xffffu); *(LAS unsigned short*)(Vt + (vdc * 8 + 2 * e + 1) * VP + vcol(vkey) * 2) = (unsigned short)(w[e] >> 16); }
}
__device__ __forceinline__ void pp_load(u32x4 (&sg)[2], const bf16_t* src, long stride, int t256, int kind) {
    if (kind == 0) {
#pragma unroll
        for (int j = 0; j < 2; ++j) { const int c = t256 + 256 * j; sg[j] = *(const u32x4*)(src + (long)(c >> 3) * stride + (c & 7) * 8); }
    } else {
#pragma unroll
        for (int j = 0; j < 2; ++j) { const int c = t256 + 256 * j; sg[j] = *(const u32x4*)(src + (long)(c & 63) * stride + (c >> 6) * 8); }
    }
}
__device__ __forceinline__ void pp_store(const u32x4 (&sg)[2], LAS unsigned char* Kt, LAS unsigned char* Vt, int t256, int kind) {
    if (kind == 0) {
#pragma unroll
        for (int j = 0; j < 2; ++j) { const int c = t256 + 256 * j; *(LAS u32x4*)(Kt + (c >> 3) * KP + (c & 7) * 16) = sg[j]; }
    } else {
#pragma unroll
        for (int j = 0; j < 2; ++j) { const int c = t256 + 256 * j, vkey = c & 63, vdc = c >> 6; const unsigned w[4] = {sg[j].x, sg[j].y, sg[j].z, sg[j].w};
#pragma unroll
            for (int e = 0; e < 4; ++e) { *(LAS unsigned short*)(Vt + (vdc * 8 + 2 * e) * VP + vcol(vkey) * 2) = (unsigned short)(w[e] & 0xffffu); *(LAS unsigned short*)(Vt + (vdc * 8 + 2 * e + 1) * VP + vcol(vkey) * 2) = (unsigned short)(w[e] >> 16); } }
    }
}
template <int BR> __device__ __forceinline__ int pp_next(int kb, unsigned live) {
    if (BR == 1) return kb + 1;
    const unsigned rem = live & ~((2u << kb) - 1u);
    return rem ? __builtin_ctz(rem) : 32;
}
template <int BR>
__device__ __forceinline__ void pp_soft(f32x16& p0, f32x16& p1, int h, int kb, int qb, int qq, const LAS unsigned* selm, const float m, float& l, float& mxraw) {
    bool mine = true;
    if (BR == 0) mine = (selm[qq] >> kb) & 1u;
    if (kb == qb) {
#pragma unroll
        for (int e = 0; e < 16; ++e) { const int kk = crow(e, h); if (kk > qq) p0[e] = NEG; if (kk + 32 > qq) p1[e] = NEG; }
    } else if (BR == 1 && kb == qb - 8) {
#pragma unroll
        for (int e = 0; e < 16; ++e) { const int kk = crow(e, h); if (kk <= qq) p0[e] = NEG; if (kk + 32 <= qq) p1[e] = NEG; }
    }
    softmax_heavy(p0, p1, m, l, mxraw, mine);
}
template <int BR, bool PRE>
__device__ __forceinline__ void pp_stream(LAS unsigned char* lds, const bf16_t* Pb, int ld, int g, int qb, int qq, int qh, int t256, int r, int h, unsigned live, const LAS unsigned* selm,
                                          const bf16x8 (&qf)[4], u32x4 (&sg)[2], f32x16& o0, f32x16& o1, float& m, float& l) {
    const int kind = qh ^ 1;
    const int soff = (BR == 0 ? (kind == 0 ? 1536 : 1792) : (kind == 0 ? 2048 : 2304)) + g * 64;
    const int first = BR == 0 ? 0 : (qb > 8 ? qb - 8 : 0);
    const int n = BR == 0 ? __builtin_popcount(live) : (qb - first + 1);
    int kb_load = first;
    if (!PRE) pp_load(sg, Pb + (size_t)(kb_load * 64) * ld + soff, ld, t256, kind);
    kb_load = pp_next<BR>(kb_load, live);
    pp_store(sg, lds + L_K, lds + L_V, t256, kind);
    { const int kc = kb_load < qb ? kb_load : qb; pp_load(sg, Pb + (size_t)(kc * 64) * ld + soff, ld, t256, kind); kb_load = pp_next<BR>(kb_load, live); }
    __syncthreads();
    int kb = first;
    f32x16 p0, p1; float mxraw = NEG; bf16x8 pb[4];
    if (qh == 0) {
        qk(p0, p1, lds + L_K, qf, r, h);
#pragma unroll 1
        for (int i = 0; i < n; ++i) {
            pp_soft<BR>(p0, p1, h, kb, qb, qq, selm, m, l, mxraw);
            pack_p(pb, p0, p1);
            kb = pp_next<BR>(kb, live);
            PP_SYNC();
            if (i + 1 < n) pp_store(sg, lds + L_K + ((i + 1) & 1) * TILEB, lds + L_V + ((i + 1) & 1) * TILEB, t256, kind);
            { const int kc = kb_load < qb ? kb_load : qb; pp_load(sg, Pb + (size_t)(kc * 64) * ld + soff, ld, t256, kind); kb_load = pp_next<BR>(kb_load, live); }
            if (i + 1 < n) qk(p0, p1, lds + L_K + ((i + 1) & 1) * TILEB, qf, r, h);
            pv2(o0, o1, lds + L_V + (i & 1) * TILEB, pb, r, h);
            softmax_light(mxraw, m, l, o0, o1);
            PP_SYNC();
        }
    } else {
#pragma unroll 1
        for (int i = 0; i < n; ++i) {
            qk(p0, p1, lds + L_K + (i & 1) * TILEB, qf, r, h);
            if (i > 0) { pv2(o0, o1, lds + L_V + ((i - 1) & 1) * TILEB, pb, r, h); softmax_light(mxraw, m, l, o0, o1); }
            if (i + 1 < n) pp_store(sg, lds + L_K + ((i + 1) & 1) * TILEB, lds + L_V + ((i + 1) & 1) * TILEB, t256, kind);
            { const int kc = kb_load < qb ? kb_load : qb; pp_load(sg, Pb + (size_t)(kc * 64) * ld + soff, ld, t256, kind); kb_load = pp_next<BR>(kb_load, live); }
            PP_SYNC();
            pp_soft<BR>(p0, p1, h, kb, qb, qq, selm, m, l, mxraw);
            pack_p(pb, p0, p1);
            kb = pp_next<BR>(kb, live);
            PP_SYNC();
        }
        pv2(o0, o1, lds + L_V + ((n - 1) & 1) * TILEB, pb, r, h);
    }
}
__device__ __forceinline__ void st_store_k(const u32x4& k, LAS unsigned char* Kt, int tid) { const int key = tid >> 3, dc = tid & 7; *(LAS u32x4*)(Kt + key * KP + dc * 16) = k; }
__device__ __forceinline__ void st_store_v(const u32x4& v, LAS unsigned char* Vt, int tid) {
    const int vkey = tid & 63, vdc = tid >> 6; const unsigned w[4] = {v.x, v.y, v.z, v.w};
#pragma unroll
    for (int e = 0; e < 4; ++e) { *(LAS unsigned short*)(Vt + (vdc * 8 + 2 * e) * VP + vcol(vkey) * 2) = (unsigned short)(w[e] & 0xffffu); *(LAS unsigned short*)(Vt + (vdc * 8 + 2 * e + 1) * VP + vcol(vkey) * 2) = (unsigned short)(w[e] >> 16); }
}
__device__ __forceinline__ u32x4 st_load_k(const bf16_t* ksrc, long stride, int tid) { return *(const u32x4*)(ksrc + (long)(tid >> 3) * stride + (tid & 7) * 8); }
__device__ __forceinline__ u32x4 st_load_v(const bf16_t* vsrc, long stride, int tid) { return *(const u32x4*)(vsrc + (long)(tid & 63) * stride + (tid >> 6) * 8); }
template <int BR>
__device__ __forceinline__ void sp_mask(f32x16& p0, f32x16& p1, int h, int kb, int qb, int qq) {
    if (kb == qb) {
#pragma unroll
        for (int e = 0; e < 16; ++e) { const int kk = crow(e, h); if (kk > qq) p0[e] = NEG; if (kk + 32 > qq) p1[e] = NEG; }
    } else if (BR == 1 && kb == qb - 8) {
#pragma unroll
        for (int e = 0; e < 16; ++e) { const int kk = crow(e, h); if (kk <= qq) p0[e] = NEG; if (kk + 32 <= qq) p1[e] = NEG; }
    }
}
template <int BR, bool PRE>
__device__ __forceinline__ void sp_stream(LAS unsigned char* lds, const bf16_t* Pb, int ld, int g, int qb, int qq, int tid, int r, int h, unsigned live, const LAS unsigned* selm,
                                          const bf16x8 (&qf)[4], Stage& st, f32x16& o0, f32x16& o1, float& m, float& l) {
    const int koff = (BR == 0 ? 1536 : 2048) + g * 64, voff = (BR == 0 ? 1792 : 2304) + g * 64;
    const int first = BR == 0 ? 0 : (qb > 8 ? qb - 8 : 0);
    const int n = BR == 0 ? __builtin_popcount(live) : (qb - first + 1);
    int kbK = first, kbV = first;
    if (!PRE) stage_load(st, Pb + (size_t)(first * 64) * ld + koff, Pb + (size_t)(first * 64) * ld + voff, ld, tid);
    kbK = pp_next<BR>(kbK, live); kbV = kbK;
    Stage s1; { const int kc = kbK < qb ? kbK : qb; stage_load(s1, Pb + (size_t)(kc * 64) * ld + koff, Pb + (size_t)(kc * 64) * ld + voff, ld, tid); }
    kbK = pp_next<BR>(kbK, live); kbV = kbK;
    stage_store(st, lds + L_K, lds + L_V, tid);
    st_store_k(s1.k, lds + L_K + TILEB, tid); st.v = s1.v;
    { const int kc = kbK < qb ? kbK : qb; st.k = st_load_k(Pb + (size_t)(kc * 64) * ld + koff, ld, tid); kbK = pp_next<BR>(kbK, live); }
    __syncthreads();
    f32x16 p0, p1; float mxraw = NEG; bf16x8 pb[4];
    qk(p0, p1, lds + L_K, qf, r, h);
    int kb = first, rk1 = 1, rk2 = 2;
#pragma unroll 1
    for (int i = 0; i < n; ++i) {
        if (i + 2 < n) st_store_k(st.k, lds + (rk2 == 2 ? L_PQ : L_K + rk2 * TILEB), tid);
        if (i + 1 < n) st_store_v(st.v, lds + L_V + ((i + 1) & 1) * TILEB, tid);
        { const int kc = kbK < qb ? kbK : qb, vc = kbV < qb ? kbV : qb;
          st.k = st_load_k(Pb + (size_t)(kc * 64) * ld + koff, ld, tid); st.v = st_load_v(Pb + (size_t)(vc * 64) * ld + voff, ld, tid); kbK = pp_next<BR>(kbK, live); kbV = pp_next<BR>(kbV, live); }
        bool mine = true;
        if (BR == 0) mine = (selm[qq] >> kb) & 1u;
        sp_mask<BR>(p0, p1, h, kb, qb, qq);
        f32x16 n0, n1;
        {
            const LAS unsigned char* Kt = lds + (rk1 == 2 ? L_PQ : L_K + rk1 * TILEB);
            const f32x16 z = {0.f, 0.f, 0.f, 0.f, 0.f, 0.f, 0.f, 0.f, 0.f, 0.f, 0.f, 0.f, 0.f, 0.f, 0.f, 0.f};
            bf16x8 a0[4], a1[4];
#pragma unroll
            for (int s = 0; s < 4; ++s) { a0[s] = *(const LAS bf16x8*)(Kt + r * KP + (16 * s + 8 * h) * 2); a1[s] = *(const LAS bf16x8*)(Kt + (32 + r) * KP + (16 * s + 8 * h) * 2); }
            __builtin_amdgcn_sched_barrier(0);
#pragma unroll
            for (int s = 0; s < 4; ++s) {
                n0 = __builtin_amdgcn_mfma_f32_32x32x16_bf16(a0[s], qf[s], s == 0 ? z : n0, 0, 0, 0);
                n1 = __builtin_amdgcn_mfma_f32_32x32x16_bf16(a1[s], qf[s], s == 0 ? z : n1, 0, 0, 0);
            }
            softmax_heavy(p0, p1, m, l, mxraw, mine);
            pack_p(pb, p0, p1);
#pragma unroll
            for (int j = 0; j < 8; ++j) { __builtin_amdgcn_sched_group_barrier(0x008, 1, 0); __builtin_amdgcn_sched_group_barrier(0x002, SP_FILL, 0); }
            __builtin_amdgcn_sched_barrier(0);
        }
        pv2(o0, o1, lds + L_V + (i & 1) * TILEB, pb, r, h);
        softmax_light(mxraw, m, l, o0, o1);
        p0 = n0; p1 = n1; kb = pp_next<BR>(kb, live); rk1 = rk2; rk2 = rk2 == 2 ? 0 : rk2 + 1;
        __syncthreads();
    }
}
}

__device__ __forceinline__ void phase_nsa_attn_mfma(Frame& F, int slot) {
    using namespace na;
    const bf16_t* P = WSP(bf16_t, OFF_PROJ); bf16_t* ATT = WSP(bf16_t, OFF_ATT);
    const bf16_t* KCb = WSP(bf16_t, OFF_KC); const bf16_t* VCb = KCb + (size_t)128 * 128 * 64;
    const float* gb = inptr(F, I_NSA_GATE_B) + slot * 48;
    int tid = F.tid; asm volatile("; phase-local tid" : "+v"(tid));
    const int wave = __builtin_amdgcn_readfirstlane(tid >> 6), lane = tid & 63, r = lane & 31, h = lane >> 5, hh = wave & 3, qh = wave >> 2;
    const int t256 = tid & 255;
    LAS unsigned char* lds = F.lds;
    LAS float* Pq = (LAS float*)(lds + L_PQ); LAS unsigned* selm = (LAS unsigned*)(lds + L_SEL);
    const int ld = NSA_LD;
    const int qq = qh * 32 + r;
#pragma unroll 1
    for (int it = F.bx; it < 4096; it += F.G) {
        const int sl = it & 255, rnd = it >> 8, bg = sl >> 1, par = sl & 1, qb = (rnd & 1) ? (31 - 2 * (rnd >> 1) - par) : (2 * (rnd >> 1) + par);
        const int b = bg >> 2, g = bg & 3, t = qb * 64 + qq;
        const bf16_t* Pb = P + (size_t)b * T * ld;
        const bf16_t* prow = Pb + (size_t)t * ld;
        bf16x8 qf[4];
#pragma unroll
        for (int s = 0; s < 4; ++s) qf[s] = *(const bf16x8*)(prow + g * 256 + hh * 64 + 16 * s + 8 * h);
        float gt[3];
#pragma unroll
        for (int j = 0; j < 3; ++j) gt[j] = sigmoidf_(bf2f(prow[2560 + g * 12 + hh * 3 + j]) + gb[g * 12 + hh * 3 + j]);
        LAS float* gsave = (LAS float*)(lds + L_SEL + 512) + tid * 2; gsave[0] = gt[1]; gsave[1] = gt[2];
        if (tid == 0) selm[64] = 0u;
        Stage st0, st1;
        stage_load(st0, KCb + (size_t)bg * 128 * 64, VCb + (size_t)bg * 128 * 64, 64, tid);
        stage_load(st1, KCb + (size_t)bg * 128 * 64 + 64 * 64, VCb + (size_t)bg * 128 * 64 + 64 * 64, 64, tid);
        stage_store(st0, lds + L_K, lds + L_V, tid);
        stage_store(st1, lds + L_K + TILEB, lds + L_V + TILEB, tid);
        __syncthreads();
        LAS float* oaL = (LAS float*)(lds + L_OA) + tid;
#pragma unroll 1
        for (int xr_ = 0; xr_ <= XCMP; ++xr_)
        {
            const int cmax = (t >= 31) ? (((t - 31) >> 4) < 126 ? ((t - 31) >> 4) : 126) : -1;
            f32x16 o0, o1; float m = NEG, l = 0.f;
#pragma unroll
            for (int i = 0; i < 16; ++i) { o0[i] = 0.f; o1[i] = 0.f; }
#pragma unroll 1
            for (int tl = 0; tl < 2; ++tl) {
                f32x16 p0, p1;
                qk(p0, p1, lds + L_K + tl * TILEB, qf, r, h);
#pragma unroll
                for (int i = 0; i < 16; ++i) { const int c = 64 * tl + crow(i, h); if (c > cmax) p0[i] = NEG; if (c + 32 > cmax) p1[i] = NEG; }
                softmax_step(p0, p1, m, l, o0, o1);
                pv(o0, o1, lds + L_V + tl * TILEB, p0, p1, r, h);
            }
            l += __shfl_xor(l, 32);
            const float inv = l > 0.f ? 1.0f / l : 0.f;
            const float cf = gt[0] * inv;
#pragma unroll
            for (int i = 0; i < 16; ++i) { oaL[512 * i] = cf * o0[i]; oaL[512 * (16 + i)] = cf * o1[i]; }
            const float mc = ((m < -1e29f) ? 0.f : m) * C1;
            LAS float* slab = Pq + hh * SLB + qq * 33;
#pragma unroll 1
            for (int tl = 1; tl >= 0; --tl) {
                f32x16 p0, p1;
                qk(p0, p1, lds + L_K + tl * TILEB, qf, r, h);
#pragma unroll
                for (int i = 0; i < 16; ++i) { const int c = 64 * tl + crow(i, h);
                    p0[i] = (c > cmax) ? 0.f : __builtin_amdgcn_exp2f(p0[i] * C1 - mc) * inv; p1[i] = (c + 32 > cmax) ? 0.f : __builtin_amdgcn_exp2f(p1[i] * C1 - mc) * inv; }
#pragma unroll
                for (int k = 0; k < 4; ++k) {
                    slab[16 * tl + 2 * k + h] = 2.0f * (p0[4 * k] + p0[4 * k + 1] + p0[4 * k + 2]) + p0[4 * k + 3];
                    slab[16 * tl + 8 + 2 * k + h] = 2.0f * (p1[4 * k] + p1[4 * k + 1] + p1[4 * k + 2]) + p1[4 * k + 3]; }
                LDS_WAIT();
#pragma unroll
                for (int k = 0; k < 4; ++k) { const int s0 = 16 * tl + 2 * k + h + 1, s1 = 16 * tl + 8 + 2 * k + h + 1;
                    slab[s0] += p0[4 * k + 3]; if (s1 < 32) slab[s1] += p1[4 * k + 3]; }
                LDS_WAIT();
            }
        }
        __syncthreads();
        Stage st;
        stage_load(st, Pb + 1536 + g * 64, Pb + 1792 + g * 64, ld, tid);
#pragma unroll 1
        for (int xr_ = 0; xr_ <= XSELN; ++xr_)
        {
            const int cur = qb, q = tid >> 3, sub = tid & 7;
            float scv[4];
#pragma unroll
            for (int j = 0; j < 4; ++j) { const int s_ = 4 * sub + j; const LAS float* pr = Pq + q * 33 + s_;
                const float imp = (pr[0] + pr[SLB]) + (pr[2 * SLB] + pr[3 * SLB]);
                const bool forced = (s_ == 0) || (s_ == cur) || (s_ == cur - 1);
                scv[j] = forced ? 1e30f : (s_ <= cur ? imp : NEG); }
            unsigned mask = 0u;
#pragma unroll 1
            for (int rd = 0; rd < 8; ++rd) {
                float bv = scv[0]; int bi = 4 * sub;
#pragma unroll
                for (int j = 1; j < 4; ++j) if (scv[j] > bv) { bv = scv[j]; bi = 4 * sub + j; }
#define SEL_STEP(CTRL) { const float ov = dppf<CTRL>(bv); const int oi = __float_as_int(dppf<CTRL>(__int_as_float(bi))); if (ov > bv || (ov == bv && oi < bi)) { bv = ov; bi = oi; } }
                SEL_STEP(0xB1) SEL_STEP(0x4E) SEL_STEP(0x141)
#undef SEL_STEP
                if (bv > -0.5e30f) mask |= 1u << bi;
#pragma unroll
                for (int j = 0; j < 4; ++j) if (bi == 4 * sub + j) scv[j] = -INFINITY;
            }
            if (sub == 0) selm[q] = mask;
            unsigned any = mask;
#pragma unroll
            for (int o = 8; o < 64; o <<= 1) any |= __shfl_xor(any, o);
            if (lane == 0) __hip_atomic_fetch_or(selm + 64, any, __ATOMIC_RELAXED, __HIP_MEMORY_SCOPE_WORKGROUP);
            __syncthreads();
        }
        const unsigned anymask = __builtin_amdgcn_readfirstlane(selm[64]);
        {
            f32x16 o0, o1; float m = NEG, l = 0.f;
#pragma unroll
            for (int i = 0; i < 16; ++i) { o0[i] = 0.f; o1[i] = 0.f; }
            const unsigned live = anymask & (qb == 31 ? 0xffffffffu : ((2u << qb) - 1u));
            sp_stream<0, true>(lds, Pb, ld, g, qb, qq, tid, r, h, live, selm, qf, st, o0, o1, m, l);
            l += __shfl_xor(l, 32);
            const float cf = l > 0.f ? gsave[0] / l : 0.f;
#pragma unroll
            for (int i = 0; i < 16; ++i) { oaL[512 * i] += cf * o0[i]; oaL[512 * (16 + i)] += cf * o1[i]; }
        }
        __syncthreads();
        {
            f32x16 o0, o1; float m = NEG, l = 0.f;
#pragma unroll
            for (int i = 0; i < 16; ++i) { o0[i] = 0.f; o1[i] = 0.f; }
            sp_stream<1, false>(lds, Pb, ld, g, qb, qq, tid, r, h, 0u, selm, qf, st, o0, o1, m, l);
            l += __shfl_xor(l, 32);
            const float cf = l > 0.f ? gsave[1] / l : 0.f;
#pragma unroll
            for (int i = 0; i < 16; ++i) { o0[i] = oaL[512 * i] + cf * o0[i]; o1[i] = oaL[512 * (16 + i)] + cf * o1[i]; }
            bf16_t* orow = ATT + (size_t)(b * T + t) * D + (g * 4 + hh) * 64 + 4 * h;
#pragma unroll 1
            for (int xr_ = 0; xr_ <= XOUT; ++xr_)
#pragma unroll
            for (int k = 0; k < 4; ++k) {
                u32x2 w0, w1; w0.x = pg8::cvt_pk_bf16(o0[4 * k], o0[4 * k + 1]); w0.y = pg8::cvt_pk_bf16(o0[4 * k + 2], o0[4 * k + 3]);
                w1.x = pg8::cvt_pk_bf16(o1[4 * k], o1[4 * k + 1]); w1.y = pg8::cvt_pk_bf16(o1[4 * k + 2], o1[4 * k + 3]);
                *(u32x2*)(orow + 8 * k) = w0; *(u32x2*)(orow + 32 + 8 * k) = w1;
            }
        }
        __syncthreads();
    }
}
__device__ __forceinline__ float logsigmoidf_(float x) { return fminf(x, 0.f) - log1pf(__expf(-fabsf(x))); }
__device__ __forceinline__ void phase_mlstm_scan(Frame& F) {
    constexpr int QP = 132;
    LAS float* qL = (LAS float*)F.lds;
    LAS float* kL = qL + 64 * QP;
    LAS float* vL = kL + 64 * QP;
    LAS float* SL = vL + 64 * 128;
    LAS float* vec = SL + 64 * 68;
    LAS float* bL = vec;
    LAS float* liL = vec + 64;
    LAS float* mtL = vec + 128;
    LAS float* wiL = vec + 192;
    LAS float* dnL = vec + 256;
    LAS float* wkL = vec + 320;
    LAS float* nL = vec + 384;
    LAS float* scl = vec + 512;
    LAS float* rsL = vec + 576;
    LAS float* qnL = vec + 640;
    const bf16_t* P = WSP(bf16_t, OFF_PROJ); bf16_t* HO = WSP(bf16_t, OFF_HM);
    int tid = F.tid; asm volatile("; phase-local tid" : "+v"(tid));
    const int lane = tid & 63, ld = ML_LD;
    int v_ = tid >> 2, kq = tid & 3;
    for (int item = F.bx; item < BATCH * 4 * 2; item += F.G) {
        const int vh = item & 1, h = (item >> 1) & 3, b = item >> 3;
        float C[32];
#pragma unroll
        for (int j = 0; j < 32; ++j) C[j] = 0.f;
        if (tid < 128) nL[tid] = 0.f;
        if (tid == 0) scl[0] = 0.f;
        __syncthreads();
#pragma unroll 1
        for (int ch = 0; ch < T / 64; ++ch) {
            asm volatile("; chunk-local" : "+v"(v_), "+v"(kq), "+v"(tid));
            const int t0 = ch * 64; const bf16_t* Pc = P + (size_t)(b * T + t0) * ld;
            {
                const int c2 = tid & 255, part = tid >> 8;
                const int col = (c2 < 128) ? (h * 128 + c2) : (512 + h * 128 + (c2 - 128));
                const float w0 = inptr(F, I_ML_CONV_W)[0 * 1024 + col], w1 = inptr(F, I_ML_CONV_W)[1 * 1024 + col], w2 = inptr(F, I_ML_CONV_W)[2 * 1024 + col], w3 = inptr(F, I_ML_CONV_W)[3 * 1024 + col], cb = inptr(F, I_ML_CONV_B)[col];
                const float scale = (c2 < 128) ? 1.0f : 0.08838834764831845f;
                const int r0 = part * 32;
                float x0 = (t0 + r0 - 3 >= 0) ? bf2f(Pc[(long)(r0 - 3) * ld + col]) : 0.f;
                float x1 = (t0 + r0 - 2 >= 0) ? bf2f(Pc[(long)(r0 - 2) * ld + col]) : 0.f;
                float x2 = (t0 + r0 - 1 >= 0) ? bf2f(Pc[(long)(r0 - 1) * ld + col]) : 0.f;
                LAS float* dst = (c2 < 128) ? (qL + c2) : (kL + (c2 - 128));
                for (int r = r0; r < r0 + 32; ++r) { const float x3 = bf2f(Pc[(long)r * ld + col]);
                    const float y = w0 * x0 + w1 * x1 + w2 * x2 + w3 * x3 + cb; dst[r * QP] = y * sigmoidf_(y) * scale; x0 = x1; x1 = x2; x2 = x3; }
                const int vc = tid & 127, vp = tid >> 7;
                for (int r = vp * 16; r < vp * 16 + 16; ++r) vL[r * 128 + vc] = bf2f(Pc[(long)r * ld + 1024 + h * 256 + vh * 128 + vc]);
                if (tid < 64) { liL[tid] = bf2f(Pc[(long)tid * ld + 3072 + h]) + inptr(F, I_ML_GATE_B)[h];
                    bL[tid] = logsigmoidf_(bf2f(Pc[(long)tid * ld + 3076 + h]) + inptr(F, I_ML_GATE_B)[4 + h]); }
            }
            __syncthreads();
            if (tid < 64) {
                float bb = bL[lane];
#pragma unroll
                for (int o = 1; o < 64; o <<= 1) { const float u = __shfl_up(bb, o); if (lane >= o) bb += u; }
                const float li = liL[lane]; float pm = li - bb;
#pragma unroll
                for (int o = 1; o < 64; o <<= 1) { const float u = __shfl_up(pm, o); if (lane >= o) pm = fmaxf(pm, u); }
                const float mprev = scl[0];
                const float mt = fmaxf(bb + mprev, bb + pm);
                const float bend = __shfl(bb, 63);
                const float decay = bend - bb + li;
                const float mnew = fmaxf(bend + mprev, wave_max(decay));
                bL[lane] = bb; mtL[lane] = mt; wiL[lane] = __expf(bb + mprev - mt); wkL[lane] = __expf(decay - mnew);
                if (lane == 0) { scl[1] = __expf(bend + mprev - mnew); scl[2] = mnew; }
            }
            __syncthreads();
            {
                const int t = tid >> 3, sg = tid & 7;
                float a[8];
#pragma unroll
                for (int j = 0; j < 8; ++j) a[j] = 0.f;
#pragma unroll 1
                for (int k4 = 0; k4 < 32; ++k4) { const f32x4 qv = *(const LAS f32x4*)(qL + t * QP + k4 * 4);
#pragma unroll
                    for (int j = 0; j < 8; ++j) { const f32x4 kv = *(const LAS f32x4*)(kL + (sg + 8 * j) * QP + k4 * 4); a[j] += (qv[0] * kv[0] + qv[1] * kv[1]) + (qv[2] * kv[2] + qv[3] * kv[3]); } }
                const float bt = bL[t], mt = mtL[t];
#pragma unroll
                for (int j = 0; j < 8; ++j) { const int s = sg + 8 * j; SL[t * 68 + s] = (s <= t) ? a[j] * __expf(bt - bL[s] + liL[s] - mt) : 0.f; }
            }
            __syncthreads();
            if (tid < 64) { float rs = 0.f; for (int s = 0; s < 64; ++s) rs += SL[tid * 68 + s]; rsL[tid] = rs; }
            else if (tid < 128) { const int t = tid - 64; float qn = 0.f; for (int k = 0; k < 128; ++k) qn += qL[t * QP + k] * nL[k]; qnL[t] = qn; }
            __syncthreads();
            if (tid < 64) { const float den = rsL[tid] + wiL[tid] * qnL[tid]; dnL[tid] = 1.0f / fmaxf(fabsf(den), __expf(-mtL[tid])); }
            __syncthreads();
            {
                float vr[16];
#pragma unroll
                for (int j = 0; j < 16; ++j) vr[j] = vL[(kq * 16 + j) * 128 + v_];
#pragma unroll 1
                for (int tg = 0; tg < 4; ++tg) {
                    float res[4];
#pragma unroll
                    for (int ti = 0; ti < 16; ++ti) { const int t = tg * 16 + ti;
                        float aC = 0.f, aS = 0.f;
#pragma unroll
                        for (int j4 = 0; j4 < 8; ++j4) { const f32x4 qv = *(const LAS f32x4*)(qL + t * QP + kq * 32 + j4 * 4);
                            aC += (qv[0] * C[j4 * 4] + qv[1] * C[j4 * 4 + 1]) + (qv[2] * C[j4 * 4 + 2] + qv[3] * C[j4 * 4 + 3]); }
#pragma unroll
                        for (int j4 = 0; j4 < 4; ++j4) { const f32x4 sv = *(const LAS f32x4*)(SL + t * 68 + kq * 16 + j4 * 4);
                            aS += (sv[0] * vr[j4 * 4] + sv[1] * vr[j4 * 4 + 1]) + (sv[2] * vr[j4 * 4 + 2] + sv[3] * vr[j4 * 4 + 3]); }
                        float tot = aS + wiL[t] * aC;
                        tot += __shfl_xor(tot, 1); tot += __shfl_xor(tot, 2);
                        tot *= dnL[t];
                        if ((ti & 3) == kq) res[ti >> 2] = tot;
                        asm volatile("" ::: "memory");
                    }
#pragma unroll
                    for (int q = 0; q < 4; ++q) { const int t = tg * 16 + q * 4 + kq; HO[(size_t)(b * T + t0 + t) * D + h * 256 + vh * 128 + v_] = (bf16_t)f2bf(res[q]); }
                }
            }
            __syncthreads();
            {
                const float cs = scl[1];
#pragma unroll
                for (int j = 0; j < 32; ++j) C[j] *= cs;
#pragma unroll 2
                for (int s = 0; s < 64; ++s) { const float a = vL[s * 128 + v_] * wkL[s];
#pragma unroll
                    for (int j4 = 0; j4 < 8; ++j4) { const f32x4 kv = *(const LAS f32x4*)(kL + s * QP + kq * 32 + j4 * 4);
                        C[j4 * 4] += a * kv[0]; C[j4 * 4 + 1] += a * kv[1]; C[j4 * 4 + 2] += a * kv[2]; C[j4 * 4 + 3] += a * kv[3]; } }
                if (tid < 128) { float nn = nL[tid] * cs; for (int s = 0; s < 64; ++s) nn += wkL[s] * kL[s * QP + tid]; nL[tid] = nn; }
                if (tid == 0) scl[0] = scl[2];
            }
            __syncthreads();
        }
    }
}
template <int HD>
__device__ __forceinline__ void phase_norm_gate(Frame& F, const float* norm_g, int ld, int gate_col0) {
    const bf16_t* HI = WSP(bf16_t, OFF_HM); const bf16_t* P = WSP(bf16_t, OFF_PROJ); bf16_t* ATT = WSP(bf16_t, OFF_ATT);
    int lane = F.lane; asm volatile("; phase-local lane" : "+v"(lane)); const int gw = F.bx * 8 + F.wave, NGW = F.G * 8;
    u32x2 hq[4], gq[4];
    f32x4 ngr[4];
#pragma unroll
    for (int j = 0; j < 4; ++j) ngr[j] = *((const f32x4*)norm_g + lane + 64 * j);
    if (gw < NTOK) { const u32x2* hr = (const u32x2*)(HI + (size_t)gw * D) + lane; const u32x2* gr = (const u32x2*)(P + (size_t)gw * ld + gate_col0) + lane;
#pragma unroll
        for (int j = 0; j < 4; ++j) { hq[j] = hr[64 * j]; gq[j] = gr[64 * j]; } }
#pragma unroll 1
    for (int m = gw; m < NTOK; m += NGW) {
        u32x2 hc[4], gc[4];
#pragma unroll
        for (int j = 0; j < 4; ++j) { hc[j] = hq[j]; gc[j] = gq[j]; }
        if (m + NGW < NTOK) { const u32x2* hr = (const u32x2*)(HI + (size_t)(m + NGW) * D) + lane; const u32x2* gr = (const u32x2*)(P + (size_t)(m + NGW) * ld + gate_col0) + lane;
#pragma unroll
            for (int j = 0; j < 4; ++j) { hq[j] = hr[64 * j]; gq[j] = gr[64 * j]; } }
        u32x2* orow = (u32x2*)(ATT + (size_t)m * D) + lane;
#pragma unroll
        for (int j = 0; j < 4; ++j) {
            const u32x2 hv = hc[j], gv = gc[j];
            float x[4] = {__uint_as_float(hv.x << 16), __uint_as_float(hv.x & 0xffff0000u), __uint_as_float(hv.y << 16), __uint_as_float(hv.y & 0xffff0000u)};
            const float gt[4] = {__uint_as_float(gv.x << 16), __uint_as_float(gv.x & 0xffff0000u), __uint_as_float(gv.y << 16), __uint_as_float(gv.y & 0xffff0000u)};
            float ss = (x[0] * x[0] + x[1] * x[1]) + (x[2] * x[2] + x[3] * x[3]);
#pragma unroll
            for (int o = 1; o < (HD == 256 ? 64 : 32); o <<= 1) ss += __shfl_xor(ss, o);
            const float r = __builtin_amdgcn_rsqf(ss * (1.0f / HD) + RMS_EPS);
            const f32x4 ng = ngr[j];
            float o4[4];
#pragma unroll
            for (int q = 0; q < 4; ++q) o4[q] = x[q] * r * ng[q] * sigmoidf_(gt[q]);
            u32x2 o; o.x = pk2(o4[0], o4[1]); o.y = pk2(o4[2], o4[3]); orow[64 * j] = o;
        }
    }
}

__device__ __forceinline__ void phase_hgrn_scan(Frame& F) {
    constexpr int QP = 132;
    LAS float* qL = (LAS float*)F.lds;
    LAS float* kL = qL + 32 * QP;
    LAS float* vL = kL + 32 * QP;
    LAS float* AL = vL + 32 * 128;
    LAS float* geL = AL + 32 * 36;
    const bf16_t* P = WSP(bf16_t, OFF_PROJ); bf16_t* HO = WSP(bf16_t, OFF_HM);
    const float* lbt = WSP(float, OFF_TAB) + TAB_LB;
    int tid = F.tid; asm volatile("; phase-local tid" : "+v"(tid));
    const int ld = HG_LD;
    int v_ = tid >> 2, kq = tid & 3;
    for (int item = F.bx; item < BATCH * 8; item += F.G) {
        const int h = item & 7, b = item >> 3;
        float S[32];
#pragma unroll
        for (int j = 0; j < 32; ++j) S[j] = 0.f;
#pragma unroll 1
        for (int ch = 0; ch < T / 32; ++ch) {
            asm volatile("; chunk-local" : "+v"(v_), "+v"(kq), "+v"(tid));
            const int t0 = ch * 32; const bf16_t* Pc = P + (size_t)(b * T + t0) * ld;
            { const int c = tid & 127, p4 = tid >> 7;
#pragma unroll 2
              for (int r = p4 * 8; r < p4 * 8 + 8; ++r) { qL[r * QP + c] = bf2f(Pc[(long)r * ld + h * 128 + c]); kL[r * QP + c] = bf2f(Pc[(long)r * ld + 1024 + h * 128 + c]); vL[r * 128 + c] = bf2f(Pc[(long)r * ld + 2048 + h * 128 + c]); } }
            __syncthreads();
            if (tid < 128) { const float lb = lbt[h * 128 + tid]; float G = 0.f;
#pragma unroll 2
                for (int r = 0; r < 32; ++r) { const float qr = qL[r * QP + tid], fr = kL[r * QP + tid];
                    const float f = lb + (1.0f - lb) * sigmoidf_(fr); G += __logf(f);
                    qL[r * QP + tid] = qr * sigmoidf_(qr) * __expf(G); kL[r * QP + tid] = (1.0f - f) * __expf(-G); }
                geL[tid] = __expf(G); }
            __syncthreads();
            { const int t = tid >> 4, sg = tid & 15;
              float a0 = 0.f, a1 = 0.f;
#pragma unroll 2
              for (int k4 = 0; k4 < 32; ++k4) { const f32x4 qv = *(const LAS f32x4*)(qL + t * QP + k4 * 4);
                  const f32x4 k0 = *(const LAS f32x4*)(kL + sg * QP + k4 * 4), k1 = *(const LAS f32x4*)(kL + (sg + 16) * QP + k4 * 4);
                  a0 += (qv[0] * k0[0] + qv[1] * k0[1]) + (qv[2] * k0[2] + qv[3] * k0[3]); a1 += (qv[0] * k1[0] + qv[1] * k1[1]) + (qv[2] * k1[2] + qv[3] * k1[3]); }
              AL[t * 36 + sg] = (sg <= t) ? a0 : 0.f; AL[t * 36 + sg + 16] = (sg + 16 <= t) ? a1 : 0.f; }
            __syncthreads();
            {
                float vr[8];
#pragma unroll
                for (int j = 0; j < 8; ++j) vr[j] = vL[(kq * 8 + j) * 128 + v_];
#pragma unroll 2
                for (int t = 0; t < 32; ++t) {
                    float a = 0.f;
#pragma unroll
                    for (int j4 = 0; j4 < 8; ++j4) { const f32x4 qv = *(const LAS f32x4*)(qL + t * QP + kq * 32 + j4 * 4);
                        a += (qv[0] * S[j4 * 4] + qv[1] * S[j4 * 4 + 1]) + (qv[2] * S[j4 * 4 + 2] + qv[3] * S[j4 * 4 + 3]); }
#pragma unroll
                    for (int j4 = 0; j4 < 2; ++j4) { const f32x4 sv = *(const LAS f32x4*)(AL + t * 36 + kq * 8 + j4 * 4);
                        a += (sv[0] * vr[j4 * 4] + sv[1] * vr[j4 * 4 + 1]) + (sv[2] * vr[j4 * 4 + 2] + sv[3] * vr[j4 * 4 + 3]); }
                    a += __shfl_xor(a, 1); a += __shfl_xor(a, 2);
                    if ((t & 3) == kq) HO[(size_t)(b * T + t0 + t) * D + h * 128 + v_] = (bf16_t)f2bf(a);
                    asm volatile("" ::: "memory");
                }
            }
            {
#pragma unroll 2
                for (int s = 0; s < 32; ++s) { const float a = vL[s * 128 + v_];
#pragma unroll
                    for (int j4 = 0; j4 < 8; ++j4) { const f32x4 kv = *(const LAS f32x4*)(kL + s * QP + kq * 32 + j4 * 4);
                        S[j4 * 4] += a * kv[0]; S[j4 * 4 + 1] += a * kv[1]; S[j4 * 4 + 2] += a * kv[2]; S[j4 * 4 + 3] += a * kv[3]; } }
#pragma unroll
                for (int j4 = 0; j4 < 8; ++j4) { const f32x4 ge = *(const LAS f32x4*)(geL + kq * 32 + j4 * 4);
                    S[j4 * 4] *= ge[0]; S[j4 * 4 + 1] *= ge[1]; S[j4 * 4 + 2] *= ge[2]; S[j4 * 4 + 3] *= ge[3]; }
            }
            __syncthreads();
        }
    }
}
namespace ml {
constexpr int PK = 272, PS = 144;
constexpr int L_Q = 0, L_KK = L_Q + 64 * PK, L_KWT = L_KK + 64 * PK, L_VT = L_KWT + 128 * PS, L_S = L_VT + 144 * PS, L_C = L_S + 64 * PS, L_VEC = L_C + 144 * PK;
typedef float f32x4_ __attribute__((ext_vector_type(4)));
__device__ __forceinline__ bf16x8 frag(const LAS unsigned char* base, int row, int pitch, int kelem) { return *(const LAS bf16x8*)(base + row * pitch + kelem * 2); }
}
__device__ __forceinline__ void phase_mlstm_scan_mfma(Frame& F) {
    using namespace ml;
    LAS unsigned char* lds = F.lds;
    LAS float* vec = (LAS float*)(lds + L_VEC);
    LAS float* bL = vec; LAS float* liL = vec + 64; LAS float* mtL = vec + 128; LAS float* wiL = vec + 192; LAS float* wkL = vec + 256; LAS float* scl = vec + 320;
    const bf16_t* P = WSP(bf16_t, OFF_PROJ); bf16_t* HO = WSP(bf16_t, OFF_HM);
    int tid = F.tid; asm volatile("; phase-local tid" : "+v"(tid));
    const int lane = tid & 63, wave = __builtin_amdgcn_readfirstlane(tid >> 6), ld = ML_LD;
    const int fr = lane & 15, fg = lane >> 4;
#pragma unroll 1
    for (int item = F.bx; item < BATCH * 4 * 2; item += F.G) {
        const int vh = item & 1, h = (item >> 1) & 3, b = item >> 3;
        f32x4 Cacc[9];
#pragma unroll
        for (int j = 0; j < 9; ++j) Cacc[j] = (f32x4){0.f, 0.f, 0.f, 0.f};
        for (int i = tid; i < 16 * 64; i += 512) { const int rr = i >> 6, s = i & 63; *(LAS unsigned short*)(lds + L_VT + (128 + rr) * PS + s * 2) = (rr == 0) ? (unsigned short)0x3F80 : (unsigned short)0; }
        for (int i = tid; i < 144 * PK / 4; i += 512) ((LAS unsigned*)(lds + L_C))[i] = 0u;
        if (tid == 0) scl[0] = 0.f;
        const int c2 = tid & 255, part = __builtin_amdgcn_readfirstlane(tid >> 8);
        const int col = (c2 < 128) ? (h * 128 + c2) : (512 + h * 128 + (c2 - 128));
        const float* cw = inptr(F, I_ML_CONV_W); const float* cbp = inptr(F, I_ML_CONV_B); const float* gbp = inptr(F, I_ML_GATE_B);
        const float w0 = cw[0 * 1024 + col], w1 = cw[1 * 1024 + col], w2 = cw[2 * 1024 + col], w3 = cw[3 * 1024 + col], cb = cbp[col];
        const float gbi = gbp[h], gbf = gbp[4 + h];
        const float qscale = (c2 < 128) ? 1.0f : 0.08838834764831845f;
        unsigned short xn[35]; u32x4 vn[2]; unsigned short gin = 0, gfn = 0;
        { const bf16_t* Pc = P + (size_t)(b * T) * ld; const int r0 = part * 32;
          const bf16_t* rp = Pc + (long)(r0 - 3) * ld;
#pragma unroll
          for (int i = 0; i < 35; ++i) { xn[i] = (r0 - 3 + i >= 0) ? rp[col] : (unsigned short)0; rp += ld; asm volatile("" : "+s"(rp)); }
          const int key = lane, dc2 = 2 * wave;
#pragma unroll
          for (int q = 0; q < 2; ++q) vn[q] = *(const u32x4*)(Pc + (long)key * ld + 1024 + h * 256 + vh * 128 + (dc2 + q) * 8);
          if (wave == 0) { gin = Pc[(long)lane * ld + 3072 + h]; gfn = Pc[(long)lane * ld + 3076 + h]; } }
        __syncthreads();
#pragma unroll 1
        for (int ch = 0; ch < T / 64; ++ch) {
            const int t0 = ch * 64; const bf16_t* Pc = P + (size_t)(b * T + t0) * ld;
            if (wave == 0) {
                const float li = bf2f(gin) + gbi;
                float bb = logsigmoidf_(bf2f(gfn) + gbf);
                bb = scan_add64(bb, lane);
                const float pm = scan_max64(li - bb, lane);
                const float mprev = scl[0];
                const float mt = fmaxf(bb + mprev, bb + pm);
                const float bend = rdlane(bb, 63);
                const float decay = bend - bb + li;
                const float mnew = fmaxf(bend + mprev, wave_max(decay));
                bL[lane] = bb; liL[lane] = li; mtL[lane] = mt; wiL[lane] = __expf(bb + mprev - mt); wkL[lane] = __expf(decay - mnew);
                if (lane == 0) { scl[1] = __expf(bend + mprev - mnew); scl[2] = mnew; }
            }
            __syncthreads();
            {
                const int r0 = part * 32;
                LAS unsigned char* rowbase = lds + ((c2 < 128) ? L_Q : L_KK) + (c2 & 127) * 2;
                unsigned kw4[4] = {0u, 0u, 0u, 0u};
#pragma unroll
                for (int i = 0; i < 32; ++i) { const int rr = r0 + i;
                    const float y = w0 * bf2f(xn[i]) + w1 * bf2f(xn[i + 1]) + w2 * bf2f(xn[i + 2]) + w3 * bf2f(xn[i + 3]) + cb; const float o = y * sigmoidf_(y) * qscale;
                    *(LAS unsigned short*)(rowbase + rr * PK) = (unsigned short)f2bf(o);
                    if (c2 >= 128) {
                        const unsigned kv = (unsigned)f2bf(o * wkL[rr]);
                        if (i & 1) kw4[(i >> 1) & 3] |= kv << 16; else kw4[(i >> 1) & 3] = kv;
                        if ((i & 7) == 7) { u32x4 wv; wv.x = kw4[0]; wv.y = kw4[1]; wv.z = kw4[2]; wv.w = kw4[3]; *(LAS u32x4*)(lds + L_KWT + (c2 - 128) * PS + (r0 + i - 7) * 2) = wv; } }
                    if ((i & 3) == 3) asm volatile("" ::: "memory"); }
                const int key = lane, dc2 = 2 * wave;
#pragma unroll
                for (int q = 0; q < 2; ++q) { const unsigned w[4] = {vn[q].x, vn[q].y, vn[q].z, vn[q].w};
#pragma unroll
                    for (int e = 0; e < 4; ++e) { const int vrow = (dc2 + q) * 8 + 2 * e;
                        *(LAS unsigned short*)(lds + L_VT + vrow * PS + key * 2) = (unsigned short)(w[e] & 0xffffu); *(LAS unsigned short*)(lds + L_VT + (vrow + 1) * PS + key * 2) = (unsigned short)(w[e] >> 16); } }
            }
            if (ch + 1 < T / 64) {
                const bf16_t* Pn = Pc + (size_t)64 * ld; const int r0 = part * 32;
                const bf16_t* rp = Pn + (long)(r0 - 3) * ld;
#pragma unroll
                for (int i = 0; i < 35; ++i) { xn[i] = rp[col]; rp += ld; asm volatile("" : "+s"(rp)); }
                const int key = lane, dc2 = 2 * wave;
#pragma unroll
                for (int q = 0; q < 2; ++q) vn[q] = *(const u32x4*)(Pn + (long)key * ld + 1024 + h * 256 + vh * 128 + (dc2 + q) * 8);
                if (wave == 0) { gin = Pn[(long)lane * ld + 3072 + h]; gfn = Pn[(long)lane * ld + 3076 + h]; }
            }
            __syncthreads();
#pragma unroll
            for (int q = 0; q < 2; ++q) {
                const int idx = 2 * wave + q, ti = idx >> 2, tj = idx & 3;
                f32x4 a = (f32x4){0.f, 0.f, 0.f, 0.f};
                if (ti <= tj) {
#pragma unroll
                    for (int ks = 0; ks < 4; ++ks) a = __builtin_amdgcn_mfma_f32_16x16x32_bf16(frag(lds + L_KK, 16 * ti + fr, PK, 32 * ks + 8 * fg), frag(lds + L_Q, 16 * tj + fr, PK, 32 * ks + 8 * fg), a, 0, 0, 0);
                    const int t = 16 * tj + fr; const float bt = bL[t], mt = mtL[t];
#pragma unroll
                    for (int e = 0; e < 4; ++e) { const int s = 16 * ti + 4 * fg + e; a[e] = (s <= t) ? a[e] * __expf(bt - bL[s] + liL[s] - mt) : 0.f; }
                }
                u32x2 w; w.x = pg8::cvt_pk_bf16(a[0], a[1]); w.y = pg8::cvt_pk_bf16(a[2], a[3]);
                *(LAS u32x2*)(lds + L_S + (16 * tj + fr) * PS + (16 * ti + 4 * fg) * 2) = w;
            }
            __syncthreads();
            {
#pragma unroll 1
                for (int tj = 0; tj < 4; ++tj) {
                    f32x4 a1 = (f32x4){0.f, 0.f, 0.f, 0.f}, a2 = a1, d1 = a1, d2 = a1;
#pragma unroll
                    for (int ks = 0; ks < 2; ++ks) { const bf16x8 bs = frag(lds + L_S, 16 * tj + fr, PS, 32 * ks + 8 * fg);
                        a1 = __builtin_amdgcn_mfma_f32_16x16x32_bf16(frag(lds + L_VT, 16 * wave + fr, PS, 32 * ks + 8 * fg), bs, a1, 0, 0, 0);
                        d1 = __builtin_amdgcn_mfma_f32_16x16x32_bf16(frag(lds + L_VT, 128 + fr, PS, 32 * ks + 8 * fg), bs, d1, 0, 0, 0); }
#pragma unroll
                    for (int ks = 0; ks < 4; ++ks) { const bf16x8 bq = frag(lds + L_Q, 16 * tj + fr, PK, 32 * ks + 8 * fg);
                        a2 = __builtin_amdgcn_mfma_f32_16x16x32_bf16(frag(lds + L_C, 16 * wave + fr, PK, 32 * ks + 8 * fg), bq, a2, 0, 0, 0);
                        d2 = __builtin_amdgcn_mfma_f32_16x16x32_bf16(frag(lds + L_C, 128 + fr, PK, 32 * ks + 8 * fg), bq, d2, 0, 0, 0); }
                    const int t = 16 * tj + fr; const float wi = wiL[t];
                    float den = d1[0] + wi * d2[0];
                    den = __shfl(den, fr);
                    const float inv = __builtin_amdgcn_rcpf(fmaxf(fabsf(den), __expf(-mtL[t])));
                    u32x2 w; w.x = pg8::cvt_pk_bf16((a1[0] + wi * a2[0]) * inv, (a1[1] + wi * a2[1]) * inv); w.y = pg8::cvt_pk_bf16((a1[2] + wi * a2[2]) * inv, (a1[3] + wi * a2[3]) * inv);
                    *(u32x2*)(HO + (size_t)(b * T + t0 + t) * D + h * 256 + vh * 128 + 16 * wave + 4 * fg) = w;
                }
            }
            __syncthreads();
            {
                const float cs = scl[1];
                const bf16x8 ka0 = frag(lds + L_KWT, 16 * wave + fr, PS, 8 * fg), ka1 = frag(lds + L_KWT, 16 * wave + fr, PS, 32 + 8 * fg);
#pragma unroll
                for (int j = 0; j < 9; ++j) {
                    Cacc[j] = Cacc[j] * cs;
                    Cacc[j] = __builtin_amdgcn_mfma_f32_16x16x32_bf16(ka0, frag(lds + L_VT, 16 * j + fr, PS, 8 * fg), Cacc[j], 0, 0, 0);
                    Cacc[j] = __builtin_amdgcn_mfma_f32_16x16x32_bf16(ka1, frag(lds + L_VT, 16 * j + fr, PS, 32 + 8 * fg), Cacc[j], 0, 0, 0);
                    u32x2 w; w.x = pg8::cvt_pk_bf16(Cacc[j][0], Cacc[j][1]); w.y = pg8::cvt_pk_bf16(Cacc[j][2], Cacc[j][3]);
                    *(LAS u32x2*)(lds + L_C + (16 * j + fr) * PK + (16 * wave + 4 * fg) * 2) = w;
                }
                if (tid == 0) scl[0] = scl[2];
            }
            __syncthreads();
        }
    }
}
namespace hg {
constexpr int PK = 272, PS = 144;
constexpr int L_QD = 0, L_KD = L_QD + 64 * PK, L_KDT = L_KD + 64 * PK, L_VT = L_KDT + 128 * PS, L_A = L_VT + 128 * PS, L_ST = L_A + 64 * PS, L_TOT = L_ST + 128 * PK, L_GE = L_TOT + 4 * 128 * 4, L_SSQ = L_GE + 128 * 4;
__device__ __forceinline__ bf16x8 frag(const LAS unsigned char* base, int row, int pitch, int kelem) { return *(const LAS bf16x8*)(base + row * pitch + kelem * 2); }
}
__device__ __forceinline__ void phase_hgrn_scan_mfma(Frame& F) {
    using namespace hg;
    LAS unsigned char* lds = F.lds;
    LAS float* totL = (LAS float*)(lds + L_TOT); LAS float* geL = (LAS float*)(lds + L_GE);
    const bf16_t* P = WSP(bf16_t, OFF_PROJ); bf16_t* ATT = WSP(bf16_t, OFF_ATT);
    const float* lbt = WSP(float, OFF_TAB) + TAB_LB; const float* norm_g = inptr(F, I_HG_NORM_G);
    LAS float* ssqL = (LAS float*)(F.lds + hg::L_SSQ);
    int tid = F.tid; asm volatile("; phase-local tid" : "+v"(tid));
    const int lane = tid & 63, wave = __builtin_amdgcn_readfirstlane(tid >> 6), ld = HG_LD;
    const int fr = lane & 15, fg = lane >> 4;
    const int kc = tid & 127, part = __builtin_amdgcn_readfirstlane(tid >> 7);
    const int vkey = lane, vdc2 = 2 * wave;
#pragma unroll 1
    for (int item = F.bx; item < BATCH * 8; item += F.G) {
        const int h = item & 7, b = item >> 3;
        f32x4 Sacc[8];
#pragma unroll
        for (int j = 0; j < 8; ++j) Sacc[j] = (f32x4){0.f, 0.f, 0.f, 0.f};
        for (int i = tid; i < 128 * PK / 4; i += 512) ((LAS unsigned*)(lds + L_ST))[i] = 0u;
        const float lb = lbt[h * 128 + kc];
        const f32x4 ngv = *(const f32x4*)(norm_g + h * 128 + 16 * wave + 4 * fg);
        unsigned short qn[16], fn[16]; u32x4 vn[2];
        { const bf16_t* Pc = P + (size_t)(b * T) * ld;
          const bf16_t* rp = Pc + (long)(16 * part) * ld + h * 128;
#pragma unroll
          for (int i = 0; i < 16; ++i) { qn[i] = rp[kc]; fn[i] = rp[1024 + kc]; rp += ld; asm volatile("" : "+s"(rp)); }
#pragma unroll
          for (int q = 0; q < 2; ++q) vn[q] = *(const u32x4*)(Pc + (long)vkey * ld + 2048 + h * 128 + (vdc2 + q) * 8); }
        __syncthreads();
#pragma unroll 1
        for (int ch = 0; ch < T / 64; ++ch) {
            const int t0 = ch * 64;
            float qs[16], kk[16], G[16]; u32x4 vv[2];
            {
                float run = 0.f;
#pragma unroll
                for (int i = 0; i < 16; ++i) { const float qr = bf2f(qn[i]), fraw = bf2f(fn[i]);
                    const float f = lb + (1.0f - lb) * sigmoidf_(fraw);
                    run += __logf(f); G[i] = run; qs[i] = qr * sigmoidf_(qr); kk[i] = 1.0f - f; }
                totL[part * 128 + kc] = run; vv[0] = vn[0]; vv[1] = vn[1];
            }
            __syncthreads();
            if (ch + 1 < T / 64) {
                const bf16_t* Pn = P + (size_t)(b * T + t0 + 64) * ld;
                const bf16_t* rp = Pn + (long)(16 * part) * ld + h * 128;
#pragma unroll
                for (int i = 0; i < 16; ++i) { qn[i] = rp[kc]; fn[i] = rp[1024 + kc]; rp += ld; asm volatile("" : "+s"(rp)); }
#pragma unroll
                for (int q = 0; q < 2; ++q) vn[q] = *(const u32x4*)(Pn + (long)vkey * ld + 2048 + h * 128 + (vdc2 + q) * 8);
            }
            {
                float off = 0.f, tot = 0.f;
#pragma unroll
                for (int p = 0; p < 4; ++p) { const float tp = totL[p * 128 + kc]; if (p < part) off += tp; tot += tp; }
                if (part == 3) geL[kc] = __expf(tot);
                unsigned kdw[8];
#pragma unroll
                for (int i = 0; i < 16; ++i) { const int r = 16 * part + i; const float g = G[i] + off;
                    const unsigned short qd = (unsigned short)f2bf(qs[i] * __expf(g)), kd = (unsigned short)f2bf(kk[i] * __expf(-g));
                    *(LAS unsigned short*)(lds + L_QD + r * PK + kc * 2) = qd; *(LAS unsigned short*)(lds + L_KD + r * PK + kc * 2) = kd;
                    if (i & 1) kdw[i >> 1] |= (unsigned)kd << 16; else kdw[i >> 1] = (unsigned)kd; }
                { u32x4 w0, w1; w0.x = kdw[0]; w0.y = kdw[1]; w0.z = kdw[2]; w0.w = kdw[3]; w1.x = kdw[4]; w1.y = kdw[5]; w1.z = kdw[6]; w1.w = kdw[7];
                  LAS u32x4* kp = (LAS u32x4*)(lds + L_KDT + kc * PS + (16 * part) * 2); kp[0] = w0; kp[1] = w1; }
#pragma unroll
                for (int q = 0; q < 2; ++q) { const unsigned w[4] = {vv[q].x, vv[q].y, vv[q].z, vv[q].w};
#pragma unroll
                    for (int e = 0; e < 4; ++e) { const int vrow = (vdc2 + q) * 8 + 2 * e;
                        *(LAS unsigned short*)(lds + L_VT + vrow * PS + vkey * 2) = (unsigned short)(w[e] & 0xffffu); *(LAS unsigned short*)(lds + L_VT + (vrow + 1) * PS + vkey * 2) = (unsigned short)(w[e] >> 16); } }
            }
            __syncthreads();
#pragma unroll
            for (int q = 0; q < 2; ++q) {
                const int idx = 2 * wave + q, ti = idx >> 2, tj = idx & 3;
                f32x4 a = (f32x4){0.f, 0.f, 0.f, 0.f};
                if (ti <= tj) {
#pragma unroll
                    for (int ks = 0; ks < 4; ++ks) a = __builtin_amdgcn_mfma_f32_16x16x32_bf16(frag(lds + L_KD, 16 * ti + fr, PK, 32 * ks + 8 * fg), frag(lds + L_QD, 16 * tj + fr, PK, 32 * ks + 8 * fg), a, 0, 0, 0);
                    const int t = 16 * tj + fr;
#pragma unroll
                    for (int e = 0; e < 4; ++e) { const int s = 16 * ti + 4 * fg + e; a[e] = (s <= t) ? a[e] : 0.f; }
                }
                u32x2 w; w.x = pg8::cvt_pk_bf16(a[0], a[1]); w.y = pg8::cvt_pk_bf16(a[2], a[3]);
                *(LAS u32x2*)(lds + L_A + (16 * tj + fr) * PS + (16 * ti + 4 * fg) * 2) = w;
            }
            __syncthreads();
            f32x4 ot[4]; u32x2 gq[4];
            const bf16_t* Pg = P + (size_t)(b * T + t0) * ld + 3072 + h * 128 + 16 * wave + 4 * fg;
#pragma unroll
            for (int tj = 0; tj < 4; ++tj) {
                f32x4 a = (f32x4){0.f, 0.f, 0.f, 0.f};
                gq[tj] = *(const u32x2*)(Pg + (size_t)(16 * tj + fr) * ld);
#pragma unroll
                for (int ks = 0; ks < 2; ++ks) a = __builtin_amdgcn_mfma_f32_16x16x32_bf16(frag(lds + L_VT, 16 * wave + fr, PS, 32 * ks + 8 * fg), frag(lds + L_A, 16 * tj + fr, PS, 32 * ks + 8 * fg), a, 0, 0, 0);
#pragma unroll
                for (int ks = 0; ks < 4; ++ks) a = __builtin_amdgcn_mfma_f32_16x16x32_bf16(frag(lds + L_ST, 16 * wave + fr, PK, 32 * ks + 8 * fg), frag(lds + L_QD, 16 * tj + fr, PK, 32 * ks + 8 * fg), a, 0, 0, 0);
                ot[tj] = a;
                float ss = (a[0] * a[0] + a[1] * a[1]) + (a[2] * a[2] + a[3] * a[3]);
                ss += __shfl_xor(ss, 16); ss += __shfl_xor(ss, 32);
                if (fg == 0) ssqL[wave * 64 + 16 * tj + fr] = ss;
            }
            __syncthreads();
#pragma unroll
            for (int tj = 0; tj < 4; ++tj) {
                const int t = 16 * tj + fr; float tot = 0.f;
#pragma unroll
                for (int w8 = 0; w8 < 8; ++w8) tot += ssqL[w8 * 64 + t];
                const float rr = __builtin_amdgcn_rsqf(tot * (1.0f / 128.0f) + RMS_EPS);
                const float g0 = __uint_as_float(gq[tj].x << 16), g1 = __uint_as_float(gq[tj].x & 0xffff0000u), g2 = __uint_as_float(gq[tj].y << 16), g3 = __uint_as_float(gq[tj].y & 0xffff0000u);
                u32x2 w; w.x = pg8::cvt_pk_bf16(ot[tj][0] * rr * ngv[0] * sigmoidf_(g0), ot[tj][1] * rr * ngv[1] * sigmoidf_(g1));
                w.y = pg8::cvt_pk_bf16(ot[tj][2] * rr * ngv[2] * sigmoidf_(g2), ot[tj][3] * rr * ngv[3] * sigmoidf_(g3));
                *(u32x2*)(ATT + (size_t)(b * T + t0 + t) * D + h * 128 + 16 * wave + 4 * fg) = w;
            }
            {
                const bf16x8 ka0 = frag(lds + L_KDT, 16 * wave + fr, PS, 8 * fg), ka1 = frag(lds + L_KDT, 16 * wave + fr, PS, 32 + 8 * fg);
                const f32x4 ge = *(const LAS f32x4*)(geL + 16 * wave + 4 * fg);
#pragma unroll
                for (int j = 0; j < 8; ++j) {
                    Sacc[j] = __builtin_amdgcn_mfma_f32_16x16x32_bf16(ka0, frag(lds + L_VT, 16 * j + fr, PS, 8 * fg), Sacc[j], 0, 0, 0);
                    Sacc[j] = __builtin_amdgcn_mfma_f32_16x16x32_bf16(ka1, frag(lds + L_VT, 16 * j + fr, PS, 32 + 8 * fg), Sacc[j], 0, 0, 0);
                    Sacc[j] = Sacc[j] * ge;
                    u32x2 w; w.x = pg8::cvt_pk_bf16(Sacc[j][0], Sacc[j][1]); w.y = pg8::cvt_pk_bf16(Sacc[j][2], Sacc[j][3]);
                    *(LAS u32x2*)(lds + L_ST + (16 * j + fr) * PK + (16 * wave + 4 * fg) * 2) = w;
                }
            }
            __syncthreads();
        }
    }
}
constexpr int PH_PER_LAYER = 10, N_PHASES = 1 + PH_PER_LAYER * DEPTH;
struct Args { const float* in[27]; float* out; unsigned char* ws; int ph_lo, ph_hi; };
__global__ void __launch_bounds__(512, 2) mk_fwd(Args args) {
    extern __shared__ __attribute__((aligned(16))) unsigned char lds[];
    Frame F;
    F.lds = (LAS unsigned char*)lds;
    F.LC = (volatile LAS unsigned*)(F.lds + LDSCTL_OFF);
    F.tid = threadIdx.x; F.lane = F.tid & 63; F.wave = __builtin_amdgcn_readfirstlane(F.tid >> 6); F.G = gridDim.x; F.bx = blockIdx.x;
    F.ws = (unsigned char*)(GAS unsigned char*)args.ws; F.ctl = (unsigned*)(F.ws + OFF_CTL); F.out = (float*)(GAS float*)args.out;
    for (int u = F.tid; u < (LDS_BYTES - LDSCTL_OFF) / 4; u += 512) F.LC[u] = 0u;
    __syncthreads();
    if (F.tid < 27) { const unsigned long long pv = (unsigned long long)args.in[F.tid]; F.LC[128 + 2 * F.tid] = (unsigned)pv; F.LC[129 + 2 * F.tid] = (unsigned)(pv >> 32); }
    __syncthreads();
    XcdBarrier bar; bar.bar = F.ctl + CW_BAR; bar.x = 0; bar.st = nullptr;
    if (!MK_PER_PHASE) bar = xcd_barrier_post(F.ctl + CW_BAR, F.LC);
    const int lo = args.ph_lo, hi = args.ph_hi;
#define IN(k) (lo <= (k) && (k) < hi)
#ifndef DBL_LNR
#define DBL_LNR 1
#endif
#ifndef DBL_COMB
#define DBL_COMB 1
#endif
#ifndef DBL_NG
#define DBL_NG 1
#endif
#ifndef DBL_GIN
#define DBL_GIN 1
#endif
#ifndef DBL_GOUT
#define DBL_GOUT 1
#endif
#ifndef DBL_GCMP
#define DBL_GCMP 1
#endif
#ifndef DBL_GUP
#define DBL_GUP 1
#endif
#ifndef DBL_GDN
#define DBL_GDN 1
#endif
#ifndef DBL_SCAN
#define DBL_SCAN 1
#endif
#ifndef DBL_P0
#define DBL_P0 1
#endif
#ifndef DBL_ATT
#define DBL_ATT 1
#endif
#define REP(n) _Pragma("unroll 1") for (int rep_ = 0; rep_ < (n); ++rep_)
#ifdef PROBE_A
#define STAMP(k) do { if (blockIdx.x == 0 && F.tid == 0) ((unsigned long long*)(F.ws + OFF_TAB + 65536))[(k)] = wall_clock64(); } while (0)
#else
#define STAMP(k) do {} while (0)
#endif
#define SEAM(k) do { if (!MK_PER_PHASE && (k) + 1 < hi) xcd_barrier(bar); else __syncthreads(); } while (0)

    STAMP(0);
    if (IN(0)) {
#ifndef NO_P0
 REP(DBL_P0) p0_prologue(F);
#endif
 SEAM(0); }

    for (int L = 0; L < DEPTH; ++L) {
        int Lo = L; asm volatile("; layer-local" : "+s"(Lo));
        const int kind = Lo % 3, slot = Lo / 3, pb = 1 + PH_PER_LAYER * Lo;
#define PHL Frame Fp = F; asm volatile("; phase-local" : "+v"(Fp.tid), "+s"(Fp.bx)); Fp.lane = Fp.tid & 63;
        const int ldp = kind == 0 ? NSA_LD : (kind == 1 ? ML_LD : HG_LD);
        if (IN(pb + 0)) { PHL STAMP(pb + 0);
            const bf16_t* Wt = kind == 0 ? WSP(bf16_t, OFF_W_NSAIN) + (size_t)slot * NSA_LD * D : (kind == 1 ? WSP(bf16_t, OFF_W_MLIN) : WSP(bf16_t, OFF_W_HGIN));
            pg8::APlain AS{WSP(bf16_t, OFF_XN), D}; pg8::BPlain BS{Wt, D}; pg8::StaticOrder S; S.init(NTOK / 256, ldp / 256, Fp.G, Fp.bx);
            pg8::EpiStore E{WSP(bf16_t, OFF_PROJ), ldp};
            #ifndef NO_GIN
            REP(DBL_GIN) pg8::gemm_phase<pg8::EpiStore, pg8::StaticOrder, pg8::APlain, pg8::BPlain>(Fp.lds, D, AS, BS, S, E);
#endif
            SEAM(pb + 0);
        }
        if (kind == 0) {
            if (IN(pb + 1)) { PHL STAMP(pb + 1);
                pg8::ACmp AS{WSP(bf16_t, OFF_PROJ), NSA_LD, 1024}; pg8::BGroup BS{WSP(bf16_t, OFF_W_CMP1) + (size_t)slot * 2 * 256 * 2048, 2048, (size_t)256 * 2048};
                pg8::CmpOrder S{Fp.G, Fp.bx};
                pg8::EpiCmpGelu E{WSP(bf16_t, OFF_HC), WSP(float, OFF_TAB) + TAB_CMPB + slot * 512};
                #ifndef NO_GCMP
                REP(DBL_GCMP) pg8::gemm_phase<pg8::EpiCmpGelu, pg8::CmpOrder, pg8::ACmp, pg8::BGroup>(Fp.lds, 2048, AS, BS, S, E);
#endif
                SEAM(pb + 1);
            }
            if (IN(pb + 2)) { PHL STAMP(pb + 2);
#ifndef NO_CMP2
 REP(DBL_GCMP) phase_nsa_cmp2(Fp, slot);
#endif
 SEAM(pb + 2); }
            if (IN(pb + 3)) { PHL STAMP(pb + 3);
#ifndef NO_ATTN
 REP(DBL_ATT) phase_nsa_attn_mfma(Fp, slot);
#endif
 SEAM(pb + 3); }
        } else if (kind == 1) {
            if (IN(pb + 1)) { PHL STAMP(pb + 1);
#ifdef MLS_CHECK
                {
                    const size_t n16 = (size_t)NTOK * D * 2 / 16; u32x4* HMv = WSP(u32x4, OFF_HM); u32x4* Y1 = WSP(u32x4, OFF_Y); u32x4* Y2 = WSP(u32x4, OFF_Y + 160 * MiB);
#pragma unroll 1
                    for (int rep_ = 0; rep_ < 3; ++rep_) {
                        phase_mlstm_scan_mfma(Fp);
                        xcd_barrier(bar);
                        if (rep_ < 2) { u32x4* dst = rep_ == 0 ? Y1 : Y2;
                            for (size_t i = (size_t)blockIdx.x * 512 + Fp.tid; i < n16; i += (size_t)Fp.G * 512) dst[i] = HMv[i];
                            xcd_barrier(bar); }
                    }
                    unsigned bad_bits = 0u; float md = 0.f, mr = 0.f;
                    for (size_t i = (size_t)blockIdx.x * 512 + Fp.tid; i < n16; i += (size_t)Fp.G * 512) { const u32x4 a = HMv[i], b2 = Y2[i], c1 = Y1[i];
                        if (a.x != b2.x || a.y != b2.y || a.z != b2.z || a.w != b2.w) bad_bits = 1u;
                        const unsigned aw[4] = {a.x, a.y, a.z, a.w}, cw[4] = {c1.x, c1.y, c1.z, c1.w};
#pragma unroll
                        for (int q = 0; q < 4; ++q) { const float a0 = __uint_as_float(aw[q] << 16), a1 = __uint_as_float(aw[q] & 0xffff0000u), r0 = __uint_as_float(cw[q] << 16), r1 = __uint_as_float(cw[q] & 0xffff0000u);
                            md = fmaxf(md, fmaxf(fabsf(a0 - r0), fabsf(a1 - r1))); mr = fmaxf(mr, fmaxf(fabsf(r0), fabsf(r1))); if (!(a0 == a0) || !(a1 == a1)) bad_bits |= 4u; } }
                    md = wave_max(md); mr = wave_max(mr);
                    if (Fp.lane == 0) { atomicMax(F.ctl + 9000, __float_as_uint(md)); atomicMax(F.ctl + 9001, __float_as_uint(mr)); }
                    if (bad_bits) atomicOr(F.ctl + 9002, bad_bits);
                }
#else
#ifndef NO_MLS
 REP(DBL_SCAN) phase_mlstm_scan_mfma(Fp);
#endif
#endif
 SEAM(pb + 1); }
            if (IN(pb + 2)) { PHL STAMP(pb + 2);
#ifndef NO_NG
 REP(DBL_NG) phase_norm_gate<256>(Fp, inptr(Fp, I_ML_NORM_G), ML_LD, 2048);
#endif
 SEAM(pb + 2); }
        } else {
            if (IN(pb + 1)) { PHL STAMP(pb + 1);
#ifndef NO_HGS
 REP(DBL_SCAN) phase_hgrn_scan_mfma(Fp);
#endif
 SEAM(pb + 1); }
        }
        if (IN(pb + 4)) { PHL STAMP(pb + 4);
            const bf16_t* Wt = kind == 0 ? WSP(bf16_t, OFF_W_NSAOUT) + (size_t)slot * D * D : (kind == 1 ? WSP(bf16_t, OFF_W_MLOUT) : WSP(bf16_t, OFF_W_HGOUT));
            pg8::APlain AS{WSP(bf16_t, OFF_ATT), D}; pg8::BPlain BS{Wt, D}; pg8::StaticOrder S; S.init(NTOK / 256, D / 256, Fp.G, Fp.bx);
            pg8::EpiStore E{WSP(bf16_t, OFF_HM), D};
            #ifndef NO_GOUT
            REP(DBL_GOUT) pg8::gemm_phase<pg8::EpiStore, pg8::StaticOrder, pg8::APlain, pg8::BPlain>(Fp.lds, D, AS, BS, S, E);
#endif
            SEAM(pb + 4);
        }
        if (IN(pb + 5)) { PHL STAMP(pb + 5);
#ifndef NO_LNR
 if (DBL_LNR > 1) phase_ln_router(Fp, Lo, true);
 phase_ln_router(Fp, Lo);
#endif
 SEAM(pb + 5); }
        if (IN(pb + 6)) { PHL STAMP(pb + 6);
#ifndef NO_SLOT
 phase_moe_slots(Fp, Lo);
#endif
 SEAM(pb + 6); }
        if (IN(pb + 7)) { PHL STAMP(pb + 7);
            moe_tile_table(Fp, Lo);
            pg8::AGather AS{WSP(bf16_t, OFF_XN), D, WSP(int, OFF_ROWT)}; pg8::BGroup BS{WSP(bf16_t, OFF_W_GU) + (size_t)Lo * NEXP * 2048 * D, D, (size_t)2048 * D};
            pg8::MoeOrder S; S.init(__builtin_amdgcn_readfirstlane((int)Fp.LC[40]), 8, Fp.G, Fp.bx); S.pend = (const LAS int*)(Fp.lds + LDSCTL_OFF + 32);
            pg8::EpiSwiglu E{WSP(bf16_t, OFF_H), inptr(Fp, I_MOE_B_GU) + (size_t)Lo * NEXP * 2048};
            #ifndef NO_GUP
            REP(DBL_GUP) pg8::gemm_phase<pg8::EpiSwiglu, pg8::MoeOrder, pg8::AGather, pg8::BGroup>(Fp.lds, D, AS, BS, S, E);
#endif
            SEAM(pb + 7);
        }
        if (IN(pb + 8)) { PHL STAMP(pb + 8);
            moe_tile_table(Fp, Lo);
            pg8::APlain AS{WSP(bf16_t, OFF_H), DFF}; pg8::BGroup BS{WSP(bf16_t, OFF_W_DN) + (size_t)Lo * NEXP * D * DFF, DFF, (size_t)D * DFF};
            pg8::MoeOrder S; S.init(__builtin_amdgcn_readfirstlane((int)Fp.LC[40]), 4, Fp.G, Fp.bx); S.pend = (const LAS int*)(Fp.lds + LDSCTL_OFF + 32);
            pg8::EpiDown E{WSP(bf16_t, OFF_Y), inptr(Fp, I_MOE_B_DOWN) + (size_t)Lo * NEXP * D, WSP(float, OFF_ROWG)};
            #ifndef NO_GDN
            REP(DBL_GDN) pg8::gemm_phase<pg8::EpiDown, pg8::MoeOrder, pg8::APlain, pg8::BGroup>(Fp.lds, DFF, AS, BS, S, E);
#endif
            SEAM(pb + 8);
        }
        if (IN(pb + 9)) { PHL STAMP(pb + 9);
#ifndef NO_COMB
 if (DBL_COMB > 1) phase_combine_ln(Fp, Lo, (float*)nullptr, true);
 phase_combine_ln(Fp, Lo, Lo == DEPTH - 1 ? Fp.out : (float*)nullptr);
#endif
 SEAM(pb + 9); }
    }
#ifdef MLS_CHECK
    xcd_barrier(bar);
    { const float md = __uint_as_float(__hip_atomic_load(F.ctl + 9000, RLX_AGENT)), mr = __uint_as_float(__hip_atomic_load(F.ctl + 9001, RLX_AGENT)); const unsigned bb = __hip_atomic_load(F.ctl + 9002, RLX_AGENT);
      float code = 10.f; if (md > 0.02f * mr) code = 100.f; if (md > 0.2f * mr) code = 300.f; if (bb & 1u) code *= 10.f; if (bb & 4u) code *= 100.f;
      for (size_t i = (size_t)blockIdx.x * 512 + F.tid; i < (size_t)NTOK * D; i += (size_t)F.G * 512) F.out[i] = code; }
#endif
#ifdef PROBE_A
    STAMP(N_PHASES);
    xcd_barrier(bar);
    {
        const unsigned long long* st = (const unsigned long long*)(F.ws + OFF_TAB + 65536);
        float cat[6] = {0.f, 0.f, 0.f, 0.f, 0.f, 0.f};
        unsigned long long prev = __hip_atomic_load(st + 0, RLX_AGENT);
        int pc = 0;
        for (int p = 1; p <= N_PHASES; ++p) {
            int c = -1;
            if (p < N_PHASES) { const int Lq = (p - 1) / PH_PER_LAYER, k = (p - 1) % PH_PER_LAYER, kind = Lq % 3;
                if (k == 3 && kind != 0) continue;
                c = (k == 0 || k == 4 || k == 7 || k == 8) ? 1 : (k == 1 ? (kind == 0 ? 1 : (kind == 1 ? 3 : 4)) : (k == 3 ? 2 : 5)); }
            const unsigned long long now = __hip_atomic_load(st + p, RLX_AGENT);
            const float us = (float)(now - prev) * 0.01f;
#pragma unroll
            for (int q = 0; q < 6; ++q) if (q == pc) cat[q] += us;
            prev = now; pc = c;
        }
        float va = 0.f, vb = 0.f;
#pragma unroll
        for (int q = 0; q < 6; ++q) { if (q == PROBE_A) va = cat[q]; if (q == PROBE_B) vb = cat[q]; }
        const float kfill = sqrtf(va);
        for (size_t i = (size_t)blockIdx.x * 512 + F.tid; i < (size_t)NTOK * D; i += (size_t)F.G * 512) F.out[i] = (i == 0) ? vb : kfill;
    }
#endif
#undef IN
#undef SEAM
#undef PHL
}

extern "C" void kernel_launch(void* const* d_in, const int* in_sizes, int n_in, void* d_out, int out_size, void* d_ws, size_t ws_size, hipStream_t stream) {
    static int grid = 0;
    if (grid == 0) {
        if (n_in != 27 || out_size != NTOK * D || ws_size < WS_END) { fprintf(stderr, "kernel_launch: unexpected shapes (n_in %d, out %d, ws %zu)\n", n_in, out_size, ws_size); grid = -1; return; }
        int dev = 0, cus = 0;
        if (hipGetDevice(&dev) != hipSuccess || hipDeviceGetAttribute(&cus, hipDeviceAttributeMultiprocessorCount, dev) != hipSuccess) { grid = -1; return; }
        if (hipFuncSetAttribute((const void*)mk_fwd, hipFuncAttributeMaxDynamicSharedMemorySize, LDS_BYTES) != hipSuccess) { fprintf(stderr, "kernel_launch: hipFuncSetAttribute failed\n"); grid = -1; return; }
        int per_cu = 0;
        if (hipOccupancyMaxActiveBlocksPerMultiprocessor(&per_cu, (const void*)mk_fwd, 512, LDS_BYTES) != hipSuccess || per_cu < 1) fprintf(stderr, "kernel_launch: occupancy query reports %d\n", per_cu);
        (void)hipGetLastError();
        grid = cus;
    }
    if (grid < 0) return;
    (void)hipMemsetAsync((char*)d_ws + OFF_CTL, 0, CTL_ZERO_BYTES, stream);
    Args a{};
    for (int i = 0; i < 27; ++i) a.in[i] = (const float*)d_in[i];
    a.out = (float*)d_out; a.ws = (unsigned char*)d_ws;
#if MK_PER_PHASE
    for (int p = 0; p < N_PHASES; ++p) {
        if (p > 0) { const int L = (p - 1) / PH_PER_LAYER, k = (p - 1) % PH_PER_LAYER, kind = L % 3; if (k == 3 && kind != 0) continue; }
        a.ph_lo = p; a.ph_hi = p + 1;
        hipLaunchKernelGGL(mk_fwd, dim3(grid), dim3(512), LDS_BYTES, stream, a);
    }
#else
    a.ph_lo = 0; a.ph_hi = N_PHASES;
    hipLaunchKernelGGL(mk_fwd, dim3(grid), dim3(512), LDS_BYTES, stream, a);
#endif
}
```
